# Optimizing an MI355X kernel written in HIP

```python
import math
import jax, jax.numpy as jnp
from jax import lax
import numpy as np

D_MODEL = 2048
BATCH = 4
SEQ = 8192
DEPTH = 1

D_PLE = 256
EPS = 1e-6
POOL_WINDOWS = (2, 4, 8, 16)
N_POOL_GROUPS = 4
D_POOL = D_MODEL // 2
POOL_GW = D_POOL // N_POOL_GROUPS
DN_HEADS = 8
DN_DK = 128
DN_DV = 128
D_DN_QK = DN_HEADS * DN_DK
D_DN_V = DN_HEADS * DN_DV
D_QKV = 2 * D_DN_QK + D_DN_V
CONV_K = 4
CHUNK = 64
D_IN = D_POOL + D_QKV + D_DN_V + 2 * DN_HEADS + 2 * D_MODEL
N_GROUPS = 4
EXPERTS_PER_GROUP = 8
N_EXPERTS = N_GROUPS * EXPERTS_PER_GROUP
TOP_K = 2
D_EXPERT = 512
MOE_BLOCK = 128

kernel_name = "hybrid_pool_deltanet_hmoe_block"


def rms_norm(x, gain):
    xf = x.astype(jnp.float32)
    y = xf * lax.rsqrt(jnp.mean(xf * xf, axis=-1, keepdims=True) + EPS)
    return (y * gain.astype(jnp.float32)).astype(x.dtype)


def l2_normalize(x):
    return x * lax.rsqrt(jnp.sum(x * x, axis=-1, keepdims=True) + EPS)


def split_columns(proj):
    sizes = (D_POOL, D_QKV, D_DN_V, DN_HEADS, DN_HEADS, D_MODEL, D_MODEL)
    parts = []
    start = 0
    for size in sizes:
        parts.append(proj[..., start:start + size])
        start += size
    return parts


def causal_pool_mixer(u, w_grp, scale):
    bsz, s, _ = u.shape
    ug = u.astype(jnp.float32).reshape(bsz, s, N_POOL_GROUPS, POOL_GW)
    t1 = jnp.arange(1, s + 1, dtype=jnp.float32)
    outs = []
    for gi, w in enumerate(POOL_WINDOWS):
        xg = ug[:, :, gi]
        c = jnp.cumsum(xg, axis=1)
        cp = jnp.pad(c, ((0, 0), (w, 0), (0, 0)))
        win = cp[:, w:] - cp[:, :s]
        cnt = jnp.minimum(t1, float(w))
        outs.append(win / cnt[None, :, None] - xg)
    d = jnp.stack(outs, axis=2).astype(u.dtype)
    y = jnp.einsum('bsgc,gcd->bsgd', d, w_grp).reshape(bsz, s, D_POOL)
    return y * scale


def causal_short_conv(u, w):
    s = u.shape[1]
    up = jnp.pad(u, ((0, 0), (CONV_K - 1, 0), (0, 0)))
    y = up[:, 0:s] * w[0]
    for k in range(1, CONV_K):
        y = y + up[:, k:k + s] * w[k]
    return jax.nn.silu(y)


def gated_delta_rule(q, k, v, g, beta):
    bsz, s, h, dk = q.shape
    dv = v.shape[-1]
    nc = s // CHUNK
    f32 = jnp.float32
    q = l2_normalize(q.astype(f32)) * (dk ** -0.5)
    k = l2_normalize(k.astype(f32))
    v = v.astype(f32)

    def to_chunks(t):
        return t.reshape(bsz, nc, CHUNK, h, t.shape[-1]).transpose(1, 0, 3, 2, 4)

    qc, kc, vc = to_chunks(q), to_chunks(k), to_chunks(v)
    gc = to_chunks(g.astype(f32)[..., None])[..., 0]
    bc = to_chunks(beta.astype(f32)[..., None])[..., 0]
    gcum = jnp.cumsum(gc, axis=-1)
    incl = jnp.tril(jnp.ones((CHUNK, CHUNK), dtype=bool))
    strict = jnp.tril(jnp.ones((CHUNK, CHUNK), dtype=bool), -1)
    decay = jnp.exp(jnp.where(incl, gcum[..., :, None] - gcum[..., None, :], -jnp.inf))
    kb = kc * bc[..., None]
    lower = jnp.where(strict, jnp.einsum('nbhid,nbhjd->nbhij', kb, kc) * decay, 0.0)
    a_mat = lower + jnp.eye(CHUNK, dtype=f32)
    rhs = jnp.concatenate([vc * bc[..., None], kb * jnp.exp(gcum)[..., None]], axis=-1)
    sol = lax.linalg.triangular_solve(a_mat, rhs, left_side=True, lower=True, unit_diagonal=True)
    u_c, w_c = sol[..., :dv], sol[..., dv:]

    def step(state, inp):
        q_i, k_i, u_i, w_i, g_i, dec_i = inp
        attn = jnp.einsum('bhid,bhjd->bhij', q_i, k_i) * dec_i
        v_new = u_i - jnp.einsum('bhcd,bhde->bhce', w_i, state)
        o = (jnp.einsum('bhcd,bhde->bhce', q_i * jnp.exp(g_i)[..., None], state)
             + jnp.einsum('bhij,bhje->bhie', attn, v_new))
        g_last = g_i[..., -1]
        k_dec = k_i * jnp.exp(g_last[..., None] - g_i)[..., None]
        state = state * jnp.exp(g_last)[..., None, None] + jnp.einsum('bhcd,bhce->bhde', k_dec, v_new)
        return state, o

    state0 = jnp.zeros((bsz, h, dk, dv), dtype=f32)
    _, o = lax.scan(step, state0, (qc, kc, u_c, w_c, gcum, decay))
    return o.transpose(1, 0, 3, 2, 4).reshape(bsz, s, h, dv)


def hierarchical_moe(xt, w_rg, b_rg, w_re, b_re, w_gate, w_up, w_down):
    t = xt.shape[0]
    xf = xt.astype(jnp.float32)
    logits_grp = xf @ w_rg.astype(jnp.float32) + b_rg.astype(jnp.float32)
    p_grp = jax.nn.softmax(logits_grp, axis=-1)
    gi = jnp.argmax(logits_grp, axis=-1)
    p_sel = jnp.take_along_axis(p_grp, gi[:, None], axis=1)[:, 0]
    logits_exp = (xf @ w_re.astype(jnp.float32) + b_re.astype(jnp.float32)).reshape(t, N_GROUPS, EXPERTS_PER_GROUP)
    le = jnp.take_along_axis(logits_exp, gi[:, None, None], axis=1)[:, 0]
    top_vals, top_idx = lax.top_k(le, TOP_K)
    weights = p_sel[:, None] * jax.nn.softmax(top_vals, axis=-1)
    expert_ids = gi[:, None] * EXPERTS_PER_GROUP + top_idx

    n_assign = t * TOP_K
    flat_e = expert_ids.reshape(n_assign).astype(jnp.int32)
    flat_w = weights.reshape(n_assign)
    order = jnp.argsort(flat_e)
    sorted_e = flat_e[order]
    sorted_tok = (order // TOP_K).astype(jnp.int32)
    sorted_w = flat_w[order]
    counts = jnp.bincount(flat_e, length=N_EXPERTS)
    starts = jnp.cumsum(counts) - counts
    padded = ((counts + MOE_BLOCK - 1) // MOE_BLOCK) * MOE_BLOCK
    pends = jnp.cumsum(padded)
    pstarts = pends - padded
    pos = pstarts[sorted_e] + (jnp.arange(n_assign) - starts[sorted_e])
    cap = n_assign + N_EXPERTS * MOE_BLOCK
    n_blocks = cap // MOE_BLOCK
    tok_pad = jnp.zeros((cap,), jnp.int32).at[pos].set(sorted_tok)
    w_pad = jnp.zeros((cap,), xt.dtype).at[pos].set(sorted_w.astype(xt.dtype))
    blk_e = jnp.minimum(jnp.searchsorted(pends, jnp.arange(n_blocks) * MOE_BLOCK, side='right'), N_EXPERTS - 1)

    def blk_step(acc, inp):
        idx, wt, e = inp
        xb = xt[idx]
        hmid = jax.nn.silu(xb @ w_gate[e]) * (xb @ w_up[e])
        yb = hmid @ w_down[e]
        return acc.at[idx].add(yb * wt[:, None]), None

    acc, _ = lax.scan(blk_step, jnp.zeros_like(xt),
                      (tok_pad.reshape(n_blocks, MOE_BLOCK), w_pad.reshape(n_blocks, MOE_BLOCK), blk_e))
    return acc


def setup_inputs(seed: int = 0) -> dict:
    key = jax.random.key(seed)
    ks = jax.random.split(key, 32)
    nrm = jax.random.normal
    f32 = jnp.float32
    x = nrm(ks[0], (BATCH, SEQ, D_MODEL), f32)
    p = nrm(ks[1], (DEPTH, BATCH, SEQ, D_PLE), f32)
    norm_mix = 1.0 + 0.02 * nrm(ks[2], (DEPTH, D_MODEL), f32)
    w_in = nrm(ks[3], (DEPTH, D_MODEL, D_IN), f32) * D_MODEL ** -0.5
    pool_w = nrm(ks[4], (DEPTH, N_POOL_GROUPS, POOL_GW, POOL_GW), f32) * POOL_GW ** -0.5
    pool_scale = 1.0 + 0.1 * nrm(ks[5], (DEPTH, D_POOL), f32)
    conv_w = nrm(ks[6], (DEPTH, CONV_K, D_QKV), f32) * CONV_K ** -0.5
    a_log = jnp.log(jax.random.uniform(ks[7], (DEPTH, DN_HEADS), f32, minval=1.0, maxval=16.0))
    dt = jnp.exp(jax.random.uniform(ks[8], (DEPTH, DN_HEADS), f32, minval=math.log(1e-3), maxval=math.log(0.1)))
    dt_bias = dt + jnp.log(-jnp.expm1(-dt))
    dn_norm = 1.0 + 0.02 * nrm(ks[9], (DEPTH, DN_DV), f32)
    w_up_pool = nrm(ks[10], (DEPTH, D_POOL, D_MODEL), f32) * D_POOL ** -0.5
    w_up_dn = nrm(ks[11], (DEPTH, D_DN_V, D_MODEL), f32) * D_DN_V ** -0.5
    w_out = nrm(ks[12], (DEPTH, D_MODEL, D_MODEL), f32) * D_MODEL ** -0.5
    norm_moe = 1.0 + 0.02 * nrm(ks[13], (DEPTH, D_MODEL), f32)
    w_router_group = nrm(ks[14], (DEPTH, D_MODEL, N_GROUPS), f32) * D_MODEL ** -0.5
    b_router_group = 0.01 * nrm(ks[15], (DEPTH, N_GROUPS), f32)
    w_router_expert = nrm(ks[16], (DEPTH, D_MODEL, N_EXPERTS), f32) * D_MODEL ** -0.5
    b_router_expert = 0.01 * nrm(ks[17], (DEPTH, N_EXPERTS), f32)
    w_gate = nrm(ks[18], (DEPTH, N_EXPERTS, D_MODEL, D_EXPERT), f32) * D_MODEL ** -0.5
    w_up = nrm(ks[19], (DEPTH, N_EXPERTS, D_MODEL, D_EXPERT), f32) * D_MODEL ** -0.5
    w_down = nrm(ks[20], (DEPTH, N_EXPERTS, D_EXPERT, D_MODEL), f32) * D_EXPERT ** -0.5
    norm_ple = 1.0 + 0.02 * nrm(ks[21], (DEPTH, D_MODEL), f32)
    w_ple_gate = nrm(ks[22], (DEPTH, D_MODEL, D_MODEL), f32) * D_MODEL ** -0.5
    w_ple_proj = nrm(ks[23], (DEPTH, D_PLE, D_MODEL), f32) * D_PLE ** -0.5
    norm_final = 1.0 + 0.02 * nrm(ks[24], (D_MODEL,), f32)
    return {"x": x, "p": p, "norm_mix": norm_mix, "w_in": w_in, "pool_w": pool_w,
            "pool_scale": pool_scale, "conv_w": conv_w, "a_log": a_log, "dt_bias": dt_bias,
            "dn_norm": dn_norm, "w_up_pool": w_up_pool, "w_up_dn": w_up_dn, "w_out": w_out,
            "norm_moe": norm_moe, "w_router_group": w_router_group, "b_router_group": b_router_group,
            "w_router_expert": w_router_expert, "b_router_expert": b_router_expert,
            "w_gate": w_gate, "w_up": w_up, "w_down": w_down, "norm_ple": norm_ple,
            "w_ple_gate": w_ple_gate, "w_ple_proj": w_ple_proj, "norm_final": norm_final}


def reference(x, p, norm_mix, w_in, pool_w, pool_scale, conv_w, a_log, dt_bias, dn_norm,
              w_up_pool, w_up_dn, w_out, norm_moe, w_router_group, b_router_group,
              w_router_expert, b_router_expert, w_gate, w_up, w_down, norm_ple,
              w_ple_gate, w_ple_proj, norm_final):
    bsz, s, d = x.shape
    h = x
    for i in range(DEPTH):
        n1 = rms_norm(h, norm_mix[i])
        proj = n1 @ w_in[i]
        u_pool, qkv, z, b_lin, a_lin, gate_pool, gate_dn = split_columns(proj)
        y_pool = causal_pool_mixer(u_pool, pool_w[i], pool_scale[i])
        qkv = causal_short_conv(qkv, conv_w[i])
        q = qkv[..., :D_DN_QK].reshape(bsz, s, DN_HEADS, DN_DK)
        k = qkv[..., D_DN_QK:2 * D_DN_QK].reshape(bsz, s, DN_HEADS, DN_DK)
        v = qkv[..., 2 * D_DN_QK:].reshape(bsz, s, DN_HEADS, DN_DV)
        beta = jax.nn.sigmoid(b_lin.astype(jnp.float32))
        g = -jnp.exp(a_log[i].astype(jnp.float32)) * jax.nn.softplus(a_lin.astype(jnp.float32) + dt_bias[i].astype(jnp.float32))
        o = gated_delta_rule(q, k, v, g, beta)
        o = rms_norm(o, dn_norm[i]) * jax.nn.silu(z.astype(jnp.float32).reshape(bsz, s, DN_HEADS, DN_DV))
        y_dn = o.reshape(bsz, s, D_DN_V).astype(x.dtype)
        merged = (jax.nn.sigmoid(gate_pool) * (y_pool @ w_up_pool[i])
                  + jax.nn.sigmoid(gate_dn) * (y_dn @ w_up_dn[i]))
        h = h + merged @ w_out[i]
        n2 = rms_norm(h, norm_moe[i])
        y_moe = hierarchical_moe(n2.reshape(bsz * s, d), w_router_group[i], b_router_group[i],
                                 w_router_expert[i], b_router_expert[i], w_gate[i], w_up[i], w_down[i])
        h = h + y_moe.reshape(bsz, s, d)
        n3 = rms_norm(h, norm_ple[i])
        h = h + jax.nn.sigmoid(n3 @ w_ple_gate[i]) * (p[i] @ w_ple_proj[i])
    return rms_norm(h, norm_final)
```

```cpp
#include <hip/hip_runtime.h>
#include <cstdio>
#include <cstdint>

#ifndef MK_N_LAUNCHES
#define MK_N_LAUNCHES 1
#endif

#define GAS __attribute__((address_space(1)))
#define LAS __attribute__((address_space(3)))
typedef unsigned short bf16;
typedef unsigned v4u __attribute__((ext_vector_type(4)));
typedef unsigned v2u __attribute__((ext_vector_type(2)));
typedef float f32x4 __attribute__((ext_vector_type(4)));
typedef float f32x16 __attribute__((ext_vector_type(16)));
typedef short bf16x8 __attribute__((ext_vector_type(8)));

constexpr int NB = 4, SEQ = 8192, T = NB * SEQ, D = 2048;
constexpr int D_PLE = 256, D_POOL = 1024, POOL_GW = 256, NH = 8, DK = 128, D_QKV = 3072, D_Z = 1024;
constexpr int D_IN = 9232, N_IN_PAD = 9216;
constexpr int NE = 32, EPG = 8, NGRP = 4, DE = 512;
constexpr float EPS = 1e-6f;
constexpr int NWAVES = 8, NTHR = 512;
constexpr int DN_UNITS = NB * NH * (SEQ / 64);
constexpr int STG_BYTES = 58368 + 16384;
constexpr int PKG_BYTES = 58368;

constexpr size_t MiB = 1u << 20;
constexpr size_t WS_CTL = 0, CTL_ZERO_BYTES = 65536;
constexpr size_t WS_WRT = 512 * 1024;
constexpr size_t WS_WIN = 1 * MiB;
constexpr size_t WS_WCOMB = 38 * MiB;
constexpr size_t WS_WUPDN = 42 * MiB;
constexpr size_t WS_WOUT = 46 * MiB;
constexpr size_t WS_WPLEG = 54 * MiB;
constexpr size_t WS_WPLEP = 62 * MiB;
constexpr size_t WS_WGU = 63 * MiB;
constexpr size_t WS_WDN = 191 * MiB;
constexpr size_t WS_BA = 255 * MiB;
constexpr size_t WS_G = 257 * MiB;
constexpr size_t WS_BETA = 258 * MiB;
constexpr size_t WS_LTK = 259 * MiB;
constexpr size_t WS_LW = 263 * MiB;
constexpr size_t WS_PBF = 267 * MiB;
constexpr size_t WS_N1 = 283 * MiB;
constexpr size_t WS_PKG = 283 * MiB;
constexpr size_t WS_UT = 511 * MiB;
constexpr size_t WS_OB = 575 * MiB;
constexpr size_t WS_QKV = 411 * MiB;
constexpr size_t WS_MP = 539 * MiB;
constexpr size_t WS_UPOOL = 603 * MiB;
constexpr size_t WS_Z = 667 * MiB;
constexpr size_t WS_GP = 731 * MiB;
constexpr size_t WS_GD = 859 * MiB;
constexpr size_t WS_END = 987 * MiB;
constexpr size_t OUT_D = 0, OUT_QKV2 = 64 * MiB;
constexpr int CW_CNT = 1024;
constexpr int CW_BAR = 4096;

constexpr int RING_OFF = 0, RING_BYTES = 153600;
constexpr int MISC_OFF = RING_BYTES;
constexpr int MISC_WORDS = 256;
constexpr int LDS_BYTES = 154624;

#define LDS_WAIT() asm volatile("s_waitcnt lgkmcnt(0)" ::: "memory")
#define VM_WAIT() asm volatile("s_waitcnt vmcnt(0)" ::: "memory")
#define LDS_BARRIER() do { asm volatile("s_waitcnt lgkmcnt(0)" ::: "memory"); __builtin_amdgcn_s_barrier(); asm volatile("" ::: "memory"); } while (0)
__device__ __forceinline__ float bflo(unsigned u) { return __uint_as_float(u << 16); }
__device__ __forceinline__ float bfhi(unsigned u) { return __uint_as_float(u & 0xffff0000u); }
__device__ __forceinline__ float bf2f(bf16 b) { return __uint_as_float((unsigned)b << 16); }
__device__ __forceinline__ unsigned f2bf(float f) { unsigned u = __float_as_uint(f); return (u + 0x7fffu + ((u >> 16) & 1u)) >> 16; }
typedef __bf16 bf16x2_t __attribute__((ext_vector_type(2)));
typedef float f32x2_t __attribute__((ext_vector_type(2)));
__device__ __forceinline__ unsigned pk2(float lo, float hi) { const f32x2_t v = {lo, hi}; const bf16x2_t b = __builtin_convertvector(v, bf16x2_t); return __builtin_bit_cast(unsigned, b); }
__device__ __forceinline__ float wave_sum(float v) {
#pragma unroll
    for (int o = 1; o < 64; o <<= 1) v += __shfl_xor(v, o);
    return v;
}
__device__ __forceinline__ float sigmoidf_(float x) { return 1.0f / (1.0f + __expf(-x)); }
__device__ __forceinline__ float siluf_(float x) { return x / (1.0f + __expf(-x)); }
__device__ __forceinline__ void store8bf(bf16* p, const float* v) {
    v4u o; o.x = pk2(v[0], v[1]); o.y = pk2(v[2], v[3]); o.z = pk2(v[4], v[5]); o.w = pk2(v[6], v[7]); *(v4u*)p = o;
}
__device__ __forceinline__ void load8bf(const bf16* p, float* v) {
    const v4u o = *(const v4u*)p; v[0] = bflo(o.x); v[1] = bfhi(o.x); v[2] = bflo(o.y); v[3] = bfhi(o.y); v[4] = bflo(o.z); v[5] = bfhi(o.z); v[6] = bflo(o.w); v[7] = bfhi(o.w);
}

__device__ __forceinline__ int tix(int row, int k, int kd16) { const int k16 = k & 15; return ((((row >> 5) * kd16 + (k >> 4)) * 64 + ((k16 >> 2) & 1) * 32 + (row & 31)) << 3) + (k16 & 3) + ((k16 >> 3) << 2); }


template <int J> __device__ __forceinline__ void fmac_bcast(float& acc, float l, float x) {
    asm volatile("v_fmac_f32_dpp %0, %1, %2 row_newbcast:%3 row_mask:0xf bank_mask:0xf" : "+v"(acc) : "v"(l), "v"(x), "n"(J));
}
template <int N> struct FmacChunk;
template <> struct FmacChunk<1> {
    static __device__ __forceinline__ void run(float& acc, float l, float x0) {
        asm volatile("v_fmac_f32_dpp %0, %1, %2 row_newbcast:0 row_mask:0xf bank_mask:0xf\n\t" : "+v"(acc) : "v"(l), "v"(x0));
    }
};
template <> struct FmacChunk<2> {
    static __device__ __forceinline__ void run(float& acc, float l, float x0, float x1) {
        asm volatile("v_fmac_f32_dpp %0, %1, %2 row_newbcast:0 row_mask:0xf bank_mask:0xf\n\t" "v_fmac_f32_dpp %0, %1, %3 row_newbcast:1 row_mask:0xf bank_mask:0xf\n\t" : "+v"(acc) : "v"(l), "v"(x0), "v"(x1));
    }
};
template <> struct FmacChunk<3> {
    static __device__ __forceinline__ void run(float& acc, float l, float x0, float x1, float x2) {
        asm volatile("v_fmac_f32_dpp %0, %1, %2 row_newbcast:0 row_mask:0xf bank_mask:0xf\n\t" "v_fmac_f32_dpp %0, %1, %3 row_newbcast:1 row_mask:0xf bank_mask:0xf\n\t" "v_fmac_f32_dpp %0, %1, %4 row_newbcast:2 row_mask:0xf bank_mask:0xf\n\t" : "+v"(acc) : "v"(l), "v"(x0), "v"(x1), "v"(x2));
    }
};
template <> struct FmacChunk<4> {
    static __device__ __forceinline__ void run(float& acc, float l, float x0, float x1, float x2, float x3) {
        asm volatile("v_fmac_f32_dpp %0, %1, %2 row_newbcast:0 row_mask:0xf bank_mask:0xf\n\t" "v_fmac_f32_dpp %0, %1, %3 row_newbcast:1 row_mask:0xf bank_mask:0xf\n\t" "v_fmac_f32_dpp %0, %1, %4 row_newbcast:2 row_mask:0xf bank_mask:0xf\n\t" "v_fmac_f32_dpp %0, %1, %5 row_newbcast:3 row_mask:0xf bank_mask:0xf\n\t" : "+v"(acc) : "v"(l), "v"(x0), "v"(x1), "v"(x2), "v"(x3));
    }
};
template <> struct FmacChunk<5> {
    static __device__ __forceinline__ void run(float& acc, float l, float x0, float x1, float x2, float x3, float x4) {
        asm volatile("v_fmac_f32_dpp %0, %1, %2 row_newbcast:0 row_mask:0xf bank_mask:0xf\n\t" "v_fmac_f32_dpp %0, %1, %3 row_newbcast:1 row_mask:0xf bank_mask:0xf\n\t" "v_fmac_f32_dpp %0, %1, %4 row_newbcast:2 row_mask:0xf bank_mask:0xf\n\t" "v_fmac_f32_dpp %0, %1, %5 row_newbcast:3 row_mask:0xf bank_mask:0xf\n\t" "v_fmac_f32_dpp %0, %1, %6 row_newbcast:4 row_mask:0xf bank_mask:0xf\n\t" : "+v"(acc) : "v"(l), "v"(x0), "v"(x1), "v"(x2), "v"(x3), "v"(x4));
    }
};
template <> struct FmacChunk<6> {
    static __device__ __forceinline__ void run(float& acc, float l, float x0, float x1, float x2, float x3, float x4, float x5) {
        asm volatile("v_fmac_f32_dpp %0, %1, %2 row_newbcast:0 row_mask:0xf bank_mask:0xf\n\t" "v_fmac_f32_dpp %0, %1, %3 row_newbcast:1 row_mask:0xf bank_mask:0xf\n\t" "v_fmac_f32_dpp %0, %1, %4 row_newbcast:2 row_mask:0xf bank_mask:0xf\n\t" "v_fmac_f32_dpp %0, %1, %5 row_newbcast:3 row_mask:0xf bank_mask:0xf\n\t" "v_fmac_f32_dpp %0, %1, %6 row_newbcast:4 row_mask:0xf bank_mask:0xf\n\t" "v_fmac_f32_dpp %0, %1, %7 row_newbcast:5 row_mask:0xf bank_mask:0xf\n\t" : "+v"(acc) : "v"(l), "v"(x0), "v"(x1), "v"(x2), "v"(x3), "v"(x4), "v"(x5));
    }
};
template <> struct FmacChunk<7> {
    static __device__ __forceinline__ void run(float& acc, float l, float x0, float x1, float x2, float x3, float x4, float x5, float x6) {
        asm volatile("v_fmac_f32_dpp %0, %1, %2 row_newbcast:0 row_mask:0xf bank_mask:0xf\n\t" "v_fmac_f32_dpp %0, %1, %3 row_newbcast:1 row_mask:0xf bank_mask:0xf\n\t" "v_fmac_f32_dpp %0, %1, %4 row_newbcast:2 row_mask:0xf bank_mask:0xf\n\t" "v_fmac_f32_dpp %0, %1, %5 row_newbcast:3 row_mask:0xf bank_mask:0xf\n\t" "v_fmac_f32_dpp %0, %1, %6 row_newbcast:4 row_mask:0xf bank_mask:0xf\n\t" "v_fmac_f32_dpp %0, %1, %7 row_newbcast:5 row_mask:0xf bank_mask:0xf\n\t" "v_fmac_f32_dpp %0, %1, %8 row_newbcast:6 row_mask:0xf bank_mask:0xf\n\t" : "+v"(acc) : "v"(l), "v"(x0), "v"(x1), "v"(x2), "v"(x3), "v"(x4), "v"(x5), "v"(x6));
    }
};
template <> struct FmacChunk<8> {
    static __device__ __forceinline__ void run(float& acc, float l, float x0, float x1, float x2, float x3, float x4, float x5, float x6, float x7) {
        asm volatile("v_fmac_f32_dpp %0, %1, %2 row_newbcast:0 row_mask:0xf bank_mask:0xf\n\t" "v_fmac_f32_dpp %0, %1, %3 row_newbcast:1 row_mask:0xf bank_mask:0xf\n\t" "v_fmac_f32_dpp %0, %1, %4 row_newbcast:2 row_mask:0xf bank_mask:0xf\n\t" "v_fmac_f32_dpp %0, %1, %5 row_newbcast:3 row_mask:0xf bank_mask:0xf\n\t" "v_fmac_f32_dpp %0, %1, %6 row_newbcast:4 row_mask:0xf bank_mask:0xf\n\t" "v_fmac_f32_dpp %0, %1, %7 row_newbcast:5 row_mask:0xf bank_mask:0xf\n\t" "v_fmac_f32_dpp %0, %1, %8 row_newbcast:6 row_mask:0xf bank_mask:0xf\n\t" "v_fmac_f32_dpp %0, %1, %9 row_newbcast:7 row_mask:0xf bank_mask:0xf\n\t" : "+v"(acc) : "v"(l), "v"(x0), "v"(x1), "v"(x2), "v"(x3), "v"(x4), "v"(x5), "v"(x6), "v"(x7));
    }
};
template <> struct FmacChunk<9> {
    static __device__ __forceinline__ void run(float& acc, float l, float x0, float x1, float x2, float x3, float x4, float x5, float x6, float x7, float x8) {
        asm volatile("v_fmac_f32_dpp %0, %1, %2 row_newbcast:0 row_mask:0xf bank_mask:0xf\n\t" "v_fmac_f32_dpp %0, %1, %3 row_newbcast:1 row_mask:0xf bank_mask:0xf\n\t" "v_fmac_f32_dpp %0, %1, %4 row_newbcast:2 row_mask:0xf bank_mask:0xf\n\t" "v_fmac_f32_dpp %0, %1, %5 row_newbcast:3 row_mask:0xf bank_mask:0xf\n\t" "v_fmac_f32_dpp %0, %1, %6 row_newbcast:4 row_mask:0xf bank_mask:0xf\n\t" "v_fmac_f32_dpp %0, %1, %7 row_newbcast:5 row_mask:0xf bank_mask:0xf\n\t" "v_fmac_f32_dpp %0, %1, %8 row_newbcast:6 row_mask:0xf bank_mask:0xf\n\t" "v_fmac_f32_dpp %0, %1, %9 row_newbcast:7 row_mask:0xf bank_mask:0xf\n\t" "v_fmac_f32_dpp %0, %1, %10 row_newbcast:8 row_mask:0xf bank_mask:0xf\n\t" : "+v"(acc) : "v"(l), "v"(x0), "v"(x1), "v"(x2), "v"(x3), "v"(x4), "v"(x5), "v"(x6), "v"(x7), "v"(x8));
    }
};
template <> struct FmacChunk<10> {
    static __device__ __forceinline__ void run(float& acc, float l, float x0, float x1, float x2, float x3, float x4, float x5, float x6, float x7, float x8, float x9) {
        asm volatile("v_fmac_f32_dpp %0, %1, %2 row_newbcast:0 row_mask:0xf bank_mask:0xf\n\t" "v_fmac_f32_dpp %0, %1, %3 row_newbcast:1 row_mask:0xf bank_mask:0xf\n\t" "v_fmac_f32_dpp %0, %1, %4 row_newbcast:2 row_mask:0xf bank_mask:0xf\n\t" "v_fmac_f32_dpp %0, %1, %5 row_newbcast:3 row_mask:0xf bank_mask:0xf\n\t" "v_fmac_f32_dpp %0, %1, %6 row_newbcast:4 row_mask:0xf bank_mask:0xf\n\t" "v_fmac_f32_dpp %0, %1, %7 row_newbcast:5 row_mask:0xf bank_mask:0xf\n\t" "v_fmac_f32_dpp %0, %1, %8 row_newbcast:6 row_mask:0xf bank_mask:0xf\n\t" "v_fmac_f32_dpp %0, %1, %9 row_newbcast:7 row_mask:0xf bank_mask:0xf\n\t" "v_fmac_f32_dpp %0, %1, %10 row_newbcast:8 row_mask:0xf bank_mask:0xf\n\t" "v_fmac_f32_dpp %0, %1, %11 row_newbcast:9 row_mask:0xf bank_mask:0xf\n\t" : "+v"(acc) : "v"(l), "v"(x0), "v"(x1), "v"(x2), "v"(x3), "v"(x4), "v"(x5), "v"(x6), "v"(x7), "v"(x8), "v"(x9));
    }
};
template <> struct FmacChunk<11> {
    static __device__ __forceinline__ void run(float& acc, float l, float x0, float x1, float x2, float x3, float x4, float x5, float x6, float x7, float x8, float x9, float x10) {
        asm volatile("v_fmac_f32_dpp %0, %1, %2 row_newbcast:0 row_mask:0xf bank_mask:0xf\n\t" "v_fmac_f32_dpp %0, %1, %3 row_newbcast:1 row_mask:0xf bank_mask:0xf\n\t" "v_fmac_f32_dpp %0, %1, %4 row_newbcast:2 row_mask:0xf bank_mask:0xf\n\t" "v_fmac_f32_dpp %0, %1, %5 row_newbcast:3 row_mask:0xf bank_mask:0xf\n\t" "v_fmac_f32_dpp %0, %1, %6 row_newbcast:4 row_mask:0xf bank_mask:0xf\n\t" "v_fmac_f32_dpp %0, %1, %7 row_newbcast:5 row_mask:0xf bank_mask:0xf\n\t" "v_fmac_f32_dpp %0, %1, %8 row_newbcast:6 row_mask:0xf bank_mask:0xf\n\t" "v_fmac_f32_dpp %0, %1, %9 row_newbcast:7 row_mask:0xf bank_mask:0xf\n\t" "v_fmac_f32_dpp %0, %1, %10 row_newbcast:8 row_mask:0xf bank_mask:0xf\n\t" "v_fmac_f32_dpp %0, %1, %11 row_newbcast:9 row_mask:0xf bank_mask:0xf\n\t" "v_fmac_f32_dpp %0, %1, %12 row_newbcast:10 row_mask:0xf bank_mask:0xf\n\t" : "+v"(acc) : "v"(l), "v"(x0), "v"(x1), "v"(x2), "v"(x3), "v"(x4), "v"(x5), "v"(x6), "v"(x7), "v"(x8), "v"(x9), "v"(x10));
    }
};
template <> struct FmacChunk<12> {
    static __device__ __forceinline__ void run(float& acc, float l, float x0, float x1, float x2, float x3, float x4, float x5, float x6, float x7, float x8, float x9, float x10, float x11) {
        asm volatile("v_fmac_f32_dpp %0, %1, %2 row_newbcast:0 row_mask:0xf bank_mask:0xf\n\t" "v_fmac_f32_dpp %0, %1, %3 row_newbcast:1 row_mask:0xf bank_mask:0xf\n\t" "v_fmac_f32_dpp %0, %1, %4 row_newbcast:2 row_mask:0xf bank_mask:0xf\n\t" "v_fmac_f32_dpp %0, %1, %5 row_newbcast:3 row_mask:0xf bank_mask:0xf\n\t" "v_fmac_f32_dpp %0, %1, %6 row_newbcast:4 row_mask:0xf bank_mask:0xf\n\t" "v_fmac_f32_dpp %0, %1, %7 row_newbcast:5 row_mask:0xf bank_mask:0xf\n\t" "v_fmac_f32_dpp %0, %1, %8 row_newbcast:6 row_mask:0xf bank_mask:0xf\n\t" "v_fmac_f32_dpp %0, %1, %9 row_newbcast:7 row_mask:0xf bank_mask:0xf\n\t" "v_fmac_f32_dpp %0, %1, %10 row_newbcast:8 row_mask:0xf bank_mask:0xf\n\t" "v_fmac_f32_dpp %0, %1, %11 row_newbcast:9 row_mask:0xf bank_mask:0xf\n\t" "v_fmac_f32_dpp %0, %1, %12 row_newbcast:10 row_mask:0xf bank_mask:0xf\n\t" "v_fmac_f32_dpp %0, %1, %13 row_newbcast:11 row_mask:0xf bank_mask:0xf\n\t" : "+v"(acc) : "v"(l), "v"(x0), "v"(x1), "v"(x2), "v"(x3), "v"(x4), "v"(x5), "v"(x6), "v"(x7), "v"(x8), "v"(x9), "v"(x10), "v"(x11));
    }
};
template <> struct FmacChunk<13> {
    static __device__ __forceinline__ void run(float& acc, float l, float x0, float x1, float x2, float x3, float x4, float x5, float x6, float x7, float x8, float x9, float x10, float x11, float x12) {
        asm volatile("v_fmac_f32_dpp %0, %1, %2 row_newbcast:0 row_mask:0xf bank_mask:0xf\n\t" "v_fmac_f32_dpp %0, %1, %3 row_newbcast:1 row_mask:0xf bank_mask:0xf\n\t" "v_fmac_f32_dpp %0, %1, %4 row_newbcast:2 row_mask:0xf bank_mask:0xf\n\t" "v_fmac_f32_dpp %0, %1, %5 row_newbcast:3 row_mask:0xf bank_mask:0xf\n\t" "v_fmac_f32_dpp %0, %1, %6 row_newbcast:4 row_mask:0xf bank_mask:0xf\n\t" "v_fmac_f32_dpp %0, %1, %7 row_newbcast:5 row_mask:0xf bank_mask:0xf\n\t" "v_fmac_f32_dpp %0, %1, %8 row_newbcast:6 row_mask:0xf bank_mask:0xf\n\t" "v_fmac_f32_dpp %0, %1, %9 row_newbcast:7 row_mask:0xf bank_mask:0xf\n\t" "v_fmac_f32_dpp %0, %1, %10 row_newbcast:8 row_mask:0xf bank_mask:0xf\n\t" "v_fmac_f32_dpp %0, %1, %11 row_newbcast:9 row_mask:0xf bank_mask:0xf\n\t" "v_fmac_f32_dpp %0, %1, %12 row_newbcast:10 row_mask:0xf bank_mask:0xf\n\t" "v_fmac_f32_dpp %0, %1, %13 row_newbcast:11 row_mask:0xf bank_mask:0xf\n\t" "v_fmac_f32_dpp %0, %1, %14 row_newbcast:12 row_mask:0xf bank_mask:0xf\n\t" : "+v"(acc) : "v"(l), "v"(x0), "v"(x1), "v"(x2), "v"(x3), "v"(x4), "v"(x5), "v"(x6), "v"(x7), "v"(x8), "v"(x9), "v"(x10), "v"(x11), "v"(x12));
    }
};
template <> struct FmacChunk<14> {
    static __device__ __forceinline__ void run(float& acc, float l, float x0, float x1, float x2, float x3, float x4, float x5, float x6, float x7, float x8, float x9, float x10, float x11, float x12, float x13) {
        asm volatile("v_fmac_f32_dpp %0, %1, %2 row_newbcast:0 row_mask:0xf bank_mask:0xf\n\t" "v_fmac_f32_dpp %0, %1, %3 row_newbcast:1 row_mask:0xf bank_mask:0xf\n\t" "v_fmac_f32_dpp %0, %1, %4 row_newbcast:2 row_mask:0xf bank_mask:0xf\n\t" "v_fmac_f32_dpp %0, %1, %5 row_newbcast:3 row_mask:0xf bank_mask:0xf\n\t" "v_fmac_f32_dpp %0, %1, %6 row_newbcast:4 row_mask:0xf bank_mask:0xf\n\t" "v_fmac_f32_dpp %0, %1, %7 row_newbcast:5 row_mask:0xf bank_mask:0xf\n\t" "v_fmac_f32_dpp %0, %1, %8 row_newbcast:6 row_mask:0xf bank_mask:0xf\n\t" "v_fmac_f32_dpp %0, %1, %9 row_newbcast:7 row_mask:0xf bank_mask:0xf\n\t" "v_fmac_f32_dpp %0, %1, %10 row_newbcast:8 row_mask:0xf bank_mask:0xf\n\t" "v_fmac_f32_dpp %0, %1, %11 row_newbcast:9 row_mask:0xf bank_mask:0xf\n\t" "v_fmac_f32_dpp %0, %1, %12 row_newbcast:10 row_mask:0xf bank_mask:0xf\n\t" "v_fmac_f32_dpp %0, %1, %13 row_newbcast:11 row_mask:0xf bank_mask:0xf\n\t" "v_fmac_f32_dpp %0, %1, %14 row_newbcast:12 row_mask:0xf bank_mask:0xf\n\t" "v_fmac_f32_dpp %0, %1, %15 row_newbcast:13 row_mask:0xf bank_mask:0xf\n\t" : "+v"(acc) : "v"(l), "v"(x0), "v"(x1), "v"(x2), "v"(x3), "v"(x4), "v"(x5), "v"(x6), "v"(x7), "v"(x8), "v"(x9), "v"(x10), "v"(x11), "v"(x12), "v"(x13));
    }
};
template <> struct FmacChunk<15> {
    static __device__ __forceinline__ void run(float& acc, float l, float x0, float x1, float x2, float x3, float x4, float x5, float x6, float x7, float x8, float x9, float x10, float x11, float x12, float x13, float x14) {
        asm volatile("v_fmac_f32_dpp %0, %1, %2 row_newbcast:0 row_mask:0xf bank_mask:0xf\n\t" "v_fmac_f32_dpp %0, %1, %3 row_newbcast:1 row_mask:0xf bank_mask:0xf\n\t" "v_fmac_f32_dpp %0, %1, %4 row_newbcast:2 row_mask:0xf bank_mask:0xf\n\t" "v_fmac_f32_dpp %0, %1, %5 row_newbcast:3 row_mask:0xf bank_mask:0xf\n\t" "v_fmac_f32_dpp %0, %1, %6 row_newbcast:4 row_mask:0xf bank_mask:0xf\n\t" "v_fmac_f32_dpp %0, %1, %7 row_newbcast:5 row_mask:0xf bank_mask:0xf\n\t" "v_fmac_f32_dpp %0, %1, %8 row_newbcast:6 row_mask:0xf bank_mask:0xf\n\t" "v_fmac_f32_dpp %0, %1, %9 row_newbcast:7 row_mask:0xf bank_mask:0xf\n\t" "v_fmac_f32_dpp %0, %1, %10 row_newbcast:8 row_mask:0xf bank_mask:0xf\n\t" "v_fmac_f32_dpp %0, %1, %11 row_newbcast:9 row_mask:0xf bank_mask:0xf\n\t" "v_fmac_f32_dpp %0, %1, %12 row_newbcast:10 row_mask:0xf bank_mask:0xf\n\t" "v_fmac_f32_dpp %0, %1, %13 row_newbcast:11 row_mask:0xf bank_mask:0xf\n\t" "v_fmac_f32_dpp %0, %1, %14 row_newbcast:12 row_mask:0xf bank_mask:0xf\n\t" "v_fmac_f32_dpp %0, %1, %15 row_newbcast:13 row_mask:0xf bank_mask:0xf\n\t" "v_fmac_f32_dpp %0, %1, %16 row_newbcast:14 row_mask:0xf bank_mask:0xf\n\t" : "+v"(acc) : "v"(l), "v"(x0), "v"(x1), "v"(x2), "v"(x3), "v"(x4), "v"(x5), "v"(x6), "v"(x7), "v"(x8), "v"(x9), "v"(x10), "v"(x11), "v"(x12), "v"(x13), "v"(x14));
    }
};
template <> struct FmacChunk<16> {
    static __device__ __forceinline__ void run(float& acc, float l, float x0, float x1, float x2, float x3, float x4, float x5, float x6, float x7, float x8, float x9, float x10, float x11, float x12, float x13, float x14, float x15) {
        asm volatile("v_fmac_f32_dpp %0, %1, %2 row_newbcast:0 row_mask:0xf bank_mask:0xf\n\t" "v_fmac_f32_dpp %0, %1, %3 row_newbcast:1 row_mask:0xf bank_mask:0xf\n\t" "v_fmac_f32_dpp %0, %1, %4 row_newbcast:2 row_mask:0xf bank_mask:0xf\n\t" "v_fmac_f32_dpp %0, %1, %5 row_newbcast:3 row_mask:0xf bank_mask:0xf\n\t" "v_fmac_f32_dpp %0, %1, %6 row_newbcast:4 row_mask:0xf bank_mask:0xf\n\t" "v_fmac_f32_dpp %0, %1, %7 row_newbcast:5 row_mask:0xf bank_mask:0xf\n\t" "v_fmac_f32_dpp %0, %1, %8 row_newbcast:6 row_mask:0xf bank_mask:0xf\n\t" "v_fmac_f32_dpp %0, %1, %9 row_newbcast:7 row_mask:0xf bank_mask:0xf\n\t" "v_fmac_f32_dpp %0, %1, %10 row_newbcast:8 row_mask:0xf bank_mask:0xf\n\t" "v_fmac_f32_dpp %0, %1, %11 row_newbcast:9 row_mask:0xf bank_mask:0xf\n\t" "v_fmac_f32_dpp %0, %1, %12 row_newbcast:10 row_mask:0xf bank_mask:0xf\n\t" "v_fmac_f32_dpp %0, %1, %13 row_newbcast:11 row_mask:0xf bank_mask:0xf\n\t" "v_fmac_f32_dpp %0, %1, %14 row_newbcast:12 row_mask:0xf bank_mask:0xf\n\t" "v_fmac_f32_dpp %0, %1, %15 row_newbcast:13 row_mask:0xf bank_mask:0xf\n\t" "v_fmac_f32_dpp %0, %1, %16 row_newbcast:14 row_mask:0xf bank_mask:0xf\n\t" "v_fmac_f32_dpp %0, %1, %17 row_newbcast:15 row_mask:0xf bank_mask:0xf\n\t" : "+v"(acc) : "v"(l), "v"(x0), "v"(x1), "v"(x2), "v"(x3), "v"(x4), "v"(x5), "v"(x6), "v"(x7), "v"(x8), "v"(x9), "v"(x10), "v"(x11), "v"(x12), "v"(x13), "v"(x14), "v"(x15));
    }
};
template <int N, int B> struct ChunkCall;
#define CC_ARGS1(B) x[B]
#define CC_ARGS2(B) CC_ARGS1(B), x[B + 1]
#define CC_ARGS3(B) CC_ARGS2(B), x[B + 2]
#define CC_ARGS4(B) CC_ARGS3(B), x[B + 3]
#define CC_ARGS5(B) CC_ARGS4(B), x[B + 4]
#define CC_ARGS6(B) CC_ARGS5(B), x[B + 5]
#define CC_ARGS7(B) CC_ARGS6(B), x[B + 6]
#define CC_ARGS8(B) CC_ARGS7(B), x[B + 7]
#define CC_ARGS9(B) CC_ARGS8(B), x[B + 8]
#define CC_ARGS10(B) CC_ARGS9(B), x[B + 9]
#define CC_ARGS11(B) CC_ARGS10(B), x[B + 10]
#define CC_ARGS12(B) CC_ARGS11(B), x[B + 11]
#define CC_ARGS13(B) CC_ARGS12(B), x[B + 12]
#define CC_ARGS14(B) CC_ARGS13(B), x[B + 13]
#define CC_ARGS15(B) CC_ARGS14(B), x[B + 14]
#define CC_ARGS16(B) CC_ARGS15(B), x[B + 15]
#define CC_DEF(N) template <int B> struct ChunkCall<N, B> { static __device__ __forceinline__ void run(float (&x)[64], float& acc, float l) { FmacChunk<N>::run(acc, l, CC_ARGS##N(B)); } };
CC_DEF(1) CC_DEF(2) CC_DEF(3) CC_DEF(4) CC_DEF(5) CC_DEF(6) CC_DEF(7) CC_DEF(8) CC_DEF(9) CC_DEF(10) CC_DEF(11) CC_DEF(12) CC_DEF(13) CC_DEF(14) CC_DEF(15) CC_DEF(16)
#undef CC_DEF
template <int N> struct QuadChunk;
template <> struct QuadChunk<1> {
    static __device__ __forceinline__ void run(float& a0, float& a1, float& a2, float& a3, float l0, float l1, float l2, float l3, float x0) {
        asm volatile("v_fmac_f32_dpp %0, %4, %8 row_newbcast:0 row_mask:0xf bank_mask:0xf\n\t" "v_fmac_f32_dpp %1, %5, %8 row_newbcast:0 row_mask:0xf bank_mask:0xf\n\t" "v_fmac_f32_dpp %2, %6, %8 row_newbcast:0 row_mask:0xf bank_mask:0xf\n\t" "v_fmac_f32_dpp %3, %7, %8 row_newbcast:0 row_mask:0xf bank_mask:0xf\n\t" : "+v"(a0), "+v"(a1), "+v"(a2), "+v"(a3) : "v"(l0), "v"(l1), "v"(l2), "v"(l3), "v"(x0));
    }
};
template <> struct QuadChunk<2> {
    static __device__ __forceinline__ void run(float& a0, float& a1, float& a2, float& a3, float l0, float l1, float l2, float l3, float x0, float x1) {
        asm volatile("v_fmac_f32_dpp %0, %4, %8 row_newbcast:0 row_mask:0xf bank_mask:0xf\n\t" "v_fmac_f32_dpp %1, %5, %8 row_newbcast:0 row_mask:0xf bank_mask:0xf\n\t" "v_fmac_f32_dpp %2, %6, %8 row_newbcast:0 row_mask:0xf bank_mask:0xf\n\t" "v_fmac_f32_dpp %3, %7, %8 row_newbcast:0 row_mask:0xf bank_mask:0xf\n\t" "v_fmac_f32_dpp %0, %4, %9 row_newbcast:1 row_mask:0xf bank_mask:0xf\n\t" "v_fmac_f32_dpp %1, %5, %9 row_newbcast:1 row_mask:0xf bank_mask:0xf\n\t" "v_fmac_f32_dpp %2, %6, %9 row_newbcast:1 row_mask:0xf bank_mask:0xf\n\t" "v_fmac_f32_dpp %3, %7, %9 row_newbcast:1 row_mask:0xf bank_mask:0xf\n\t" : "+v"(a0), "+v"(a1), "+v"(a2), "+v"(a3) : "v"(l0), "v"(l1), "v"(l2), "v"(l3), "v"(x0), "v"(x1));
    }
};
template <> struct QuadChunk<3> {
    static __device__ __forceinline__ void run(float& a0, float& a1, float& a2, float& a3, float l0, float l1, float l2, float l3, float x0, float x1, float x2) {
        asm volatile("v_fmac_f32_dpp %0, %4, %8 row_newbcast:0 row_mask:0xf bank_mask:0xf\n\t" "v_fmac_f32_dpp %1, %5, %8 row_newbcast:0 row_mask:0xf bank_mask:0xf\n\t" "v_fmac_f32_dpp %2, %6, %8 row_newbcast:0 row_mask:0xf bank_mask:0xf\n\t" "v_fmac_f32_dpp %3, %7, %8 row_newbcast:0 row_mask:0xf bank_mask:0xf\n\t" "v_fmac_f32_dpp %0, %4, %9 row_newbcast:1 row_mask:0xf bank_mask:0xf\n\t" "v_fmac_f32_dpp %1, %5, %9 row_newbcast:1 row_mask:0xf bank_mask:0xf\n\t" "v_fmac_f32_dpp %2, %6, %9 row_newbcast:1 row_mask:0xf bank_mask:0xf\n\t" "v_fmac_f32_dpp %3, %7, %9 row_newbcast:1 row_mask:0xf bank_mask:0xf\n\t" "v_fmac_f32_dpp %0, %4, %10 row_newbcast:2 row_mask:0xf bank_mask:0xf\n\t" "v_fmac_f32_dpp %1, %5, %10 row_newbcast:2 row_mask:0xf bank_mask:0xf\n\t" "v_fmac_f32_dpp %2, %6, %10 row_newbcast:2 row_mask:0xf bank_mask:0xf\n\t" "v_fmac_f32_dpp %3, %7, %10 row_newbcast:2 row_mask:0xf bank_mask:0xf\n\t" : "+v"(a0), "+v"(a1), "+v"(a2), "+v"(a3) : "v"(l0), "v"(l1), "v"(l2), "v"(l3), "v"(x0), "v"(x1), "v"(x2));
    }
};
template <> struct QuadChunk<4> {
    static __device__ __forceinline__ void run(float& a0, float& a1, float& a2, float& a3, float l0, float l1, float l2, float l3, float x0, float x1, float x2, float x3) {
        asm volatile("v_fmac_f32_dpp %0, %4, %8 row_newbcast:0 row_mask:0xf bank_mask:0xf\n\t" "v_fmac_f32_dpp %1, %5, %8 row_newbcast:0 row_mask:0xf bank_mask:0xf\n\t" "v_fmac_f32_dpp %2, %6, %8 row_newbcast:0 row_mask:0xf bank_mask:0xf\n\t" "v_fmac_f32_dpp %3, %7, %8 row_newbcast:0 row_mask:0xf bank_mask:0xf\n\t" "v_fmac_f32_dpp %0, %4, %9 row_newbcast:1 row_mask:0xf bank_mask:0xf\n\t" "v_fmac_f32_dpp %1, %5, %9 row_newbcast:1 row_mask:0xf bank_mask:0xf\n\t" "v_fmac_f32_dpp %2, %6, %9 row_newbcast:1 row_mask:0xf bank_mask:0xf\n\t" "v_fmac_f32_dpp %3, %7, %9 row_newbcast:1 row_mask:0xf bank_mask:0xf\n\t" "v_fmac_f32_dpp %0, %4, %10 row_newbcast:2 row_mask:0xf bank_mask:0xf\n\t" "v_fmac_f32_dpp %1, %5, %10 row_newbcast:2 row_mask:0xf bank_mask:0xf\n\t" "v_fmac_f32_dpp %2, %6, %10 row_newbcast:2 row_mask:0xf bank_mask:0xf\n\t" "v_fmac_f32_dpp %3, %7, %10 row_newbcast:2 row_mask:0xf bank_mask:0xf\n\t" "v_fmac_f32_dpp %0, %4, %11 row_newbcast:3 row_mask:0xf bank_mask:0xf\n\t" "v_fmac_f32_dpp %1, %5, %11 row_newbcast:3 row_mask:0xf bank_mask:0xf\n\t" "v_fmac_f32_dpp %2, %6, %11 row_newbcast:3 row_mask:0xf bank_mask:0xf\n\t" "v_fmac_f32_dpp %3, %7, %11 row_newbcast:3 row_mask:0xf bank_mask:0xf\n\t" : "+v"(a0), "+v"(a1), "+v"(a2), "+v"(a3) : "v"(l0), "v"(l1), "v"(l2), "v"(l3), "v"(x0), "v"(x1), "v"(x2), "v"(x3));
    }
};
template <> struct QuadChunk<5> {
    static __device__ __forceinline__ void run(float& a0, float& a1, float& a2, float& a3, float l0, float l1, float l2, float l3, float x0, float x1, float x2, float x3, float x4) {
        asm volatile("v_fmac_f32_dpp %0, %4, %8 row_newbcast:0 row_mask:0xf bank_mask:0xf\n\t" "v_fmac_f32_dpp %1, %5, %8 row_newbcast:0 row_mask:0xf bank_mask:0xf\n\t" "v_fmac_f32_dpp %2, %6, %8 row_newbcast:0 row_mask:0xf bank_mask:0xf\n\t" "v_fmac_f32_dpp %3, %7, %8 row_newbcast:0 row_mask:0xf bank_mask:0xf\n\t" "v_fmac_f32_dpp %0, %4, %9 row_newbcast:1 row_mask:0xf bank_mask:0xf\n\t" "v_fmac_f32_dpp %1, %5, %9 row_newbcast:1 row_mask:0xf bank_mask:0xf\n\t" "v_fmac_f32_dpp %2, %6, %9 row_newbcast:1 row_mask:0xf bank_mask:0xf\n\t" "v_fmac_f32_dpp %3, %7, %9 row_newbcast:1 row_mask:0xf bank_mask:0xf\n\t" "v_fmac_f32_dpp %0, %4, %10 row_newbcast:2 row_mask:0xf bank_mask:0xf\n\t" "v_fmac_f32_dpp %1, %5, %10 row_newbcast:2 row_mask:0xf bank_mask:0xf\n\t" "v_fmac_f32_dpp %2, %6, %10 row_newbcast:2 row_mask:0xf bank_mask:0xf\n\t" "v_fmac_f32_dpp %3, %7, %10 row_newbcast:2 row_mask:0xf bank_mask:0xf\n\t" "v_fmac_f32_dpp %0, %4, %11 row_newbcast:3 row_mask:0xf bank_mask:0xf\n\t" "v_fmac_f32_dpp %1, %5, %11 row_newbcast:3 row_mask:0xf bank_mask:0xf\n\t" "v_fmac_f32_dpp %2, %6, %11 row_newbcast:3 row_mask:0xf bank_mask:0xf\n\t" "v_fmac_f32_dpp %3, %7, %11 row_newbcast:3 row_mask:0xf bank_mask:0xf\n\t" "v_fmac_f32_dpp %0, %4, %12 row_newbcast:4 row_mask:0xf bank_mask:0xf\n\t" "v_fmac_f32_dpp %1, %5, %12 row_newbcast:4 row_mask:0xf bank_mask:0xf\n\t" "v_fmac_f32_dpp %2, %6, %12 row_newbcast:4 row_mask:0xf bank_mask:0xf\n\t" "v_fmac_f32_dpp %3, %7, %12 row_newbcast:4 row_mask:0xf bank_mask:0xf\n\t" : "+v"(a0), "+v"(a1), "+v"(a2), "+v"(a3) : "v"(l0), "v"(l1), "v"(l2), "v"(l3), "v"(x0), "v"(x1), "v"(x2), "v"(x3), "v"(x4));
    }
};
template <> struct QuadChunk<6> {
    static __device__ __forceinline__ void run(float& a0, float& a1, float& a2, float& a3, float l0, float l1, float l2, float l3, float x0, float x1, float x2, float x3, float x4, float x5) {
        asm volatile("v_fmac_f32_dpp %0, %4, %8 row_newbcast:0 row_mask:0xf bank_mask:0xf\n\t" "v_fmac_f32_dpp %1, %5, %8 row_newbcast:0 row_mask:0xf bank_mask:0xf\n\t" "v_fmac_f32_dpp %2, %6, %8 row_newbcast:0 row_mask:0xf bank_mask:0xf\n\t" "v_fmac_f32_dpp %3, %7, %8 row_newbcast:0 row_mask:0xf bank_mask:0xf\n\t" "v_fmac_f32_dpp %0, %4, %9 row_newbcast:1 row_mask:0xf bank_mask:0xf\n\t" "v_fmac_f32_dpp %1, %5, %9 row_newbcast:1 row_mask:0xf bank_mask:0xf\n\t" "v_fmac_f32_dpp %2, %6, %9 row_newbcast:1 row_mask:0xf bank_mask:0xf\n\t" "v_fmac_f32_dpp %3, %7, %9 row_newbcast:1 row_mask:0xf bank_mask:0xf\n\t" "v_fmac_f32_dpp %0, %4, %10 row_newbcast:2 row_mask:0xf bank_mask:0xf\n\t" "v_fmac_f32_dpp %1, %5, %10 row_newbcast:2 row_mask:0xf bank_mask:0xf\n\t" "v_fmac_f32_dpp %2, %6, %10 row_newbcast:2 row_mask:0xf bank_mask:0xf\n\t" "v_fmac_f32_dpp %3, %7, %10 row_newbcast:2 row_mask:0xf bank_mask:0xf\n\t" "v_fmac_f32_dpp %0, %4, %11 row_newbcast:3 row_mask:0xf bank_mask:0xf\n\t" "v_fmac_f32_dpp %1, %5, %11 row_newbcast:3 row_mask:0xf bank_mask:0xf\n\t" "v_fmac_f32_dpp %2, %6, %11 row_newbcast:3 row_mask:0xf bank_mask:0xf\n\t" "v_fmac_f32_dpp %3, %7, %11 row_newbcast:3 row_mask:0xf bank_mask:0xf\n\t" "v_fmac_f32_dpp %0, %4, %12 row_newbcast:4 row_mask:0xf bank_mask:0xf\n\t" "v_fmac_f32_dpp %1, %5, %12 row_newbcast:4 row_mask:0xf bank_mask:0xf\n\t" "v_fmac_f32_dpp %2, %6, %12 row_newbcast:4 row_mask:0xf bank_mask:0xf\n\t" "v_fmac_f32_dpp %3, %7, %12 row_newbcast:4 row_mask:0xf bank_mask:0xf\n\t" "v_fmac_f32_dpp %0, %4, %13 row_newbcast:5 row_mask:0xf bank_mask:0xf\n\t" "v_fmac_f32_dpp %1, %5, %13 row_newbcast:5 row_mask:0xf bank_mask:0xf\n\t" "v_fmac_f32_dpp %2, %6, %13 row_newbcast:5 row_mask:0xf bank_mask:0xf\n\t" "v_fmac_f32_dpp %3, %7, %13 row_newbcast:5 row_mask:0xf bank_mask:0xf\n\t" : "+v"(a0), "+v"(a1), "+v"(a2), "+v"(a3) : "v"(l0), "v"(l1), "v"(l2), "v"(l3), "v"(x0), "v"(x1), "v"(x2), "v"(x3), "v"(x4), "v"(x5));
    }
};
template <> struct QuadChunk<7> {
    static __device__ __forceinline__ void run(float& a0, float& a1, float& a2, float& a3, float l0, float l1, float l2, float l3, float x0, float x1, float x2, float x3, float x4, float x5, float x6) {
        asm volatile("v_fmac_f32_dpp %0, %4, %8 row_newbcast:0 row_mask:0xf bank_mask:0xf\n\t" "v_fmac_f32_dpp %1, %5, %8 row_newbcast:0 row_mask:0xf bank_mask:0xf\n\t" "v_fmac_f32_dpp %2, %6, %8 row_newbcast:0 row_mask:0xf bank_mask:0xf\n\t" "v_fmac_f32_dpp %3, %7, %8 row_newbcast:0 row_mask:0xf bank_mask:0xf\n\t" "v_fmac_f32_dpp %0, %4, %9 row_newbcast:1 row_mask:0xf bank_mask:0xf\n\t" "v_fmac_f32_dpp %1, %5, %9 row_newbcast:1 row_mask:0xf bank_mask:0xf\n\t" "v_fmac_f32_dpp %2, %6, %9 row_newbcast:1 row_mask:0xf bank_mask:0xf\n\t" "v_fmac_f32_dpp %3, %7, %9 row_newbcast:1 row_mask:0xf bank_mask:0xf\n\t" "v_fmac_f32_dpp %0, %4, %10 row_newbcast:2 row_mask:0xf bank_mask:0xf\n\t" "v_fmac_f32_dpp %1, %5, %10 row_newbcast:2 row_mask:0xf bank_mask:0xf\n\t" "v_fmac_f32_dpp %2, %6, %10 row_newbcast:2 row_mask:0xf bank_mask:0xf\n\t" "v_fmac_f32_dpp %3, %7, %10 row_newbcast:2 row_mask:0xf bank_mask:0xf\n\t" "v_fmac_f32_dpp %0, %4, %11 row_newbcast:3 row_mask:0xf bank_mask:0xf\n\t" "v_fmac_f32_dpp %1, %5, %11 row_newbcast:3 row_mask:0xf bank_mask:0xf\n\t" "v_fmac_f32_dpp %2, %6, %11 row_newbcast:3 row_mask:0xf bank_mask:0xf\n\t" "v_fmac_f32_dpp %3, %7, %11 row_newbcast:3 row_mask:0xf bank_mask:0xf\n\t" "v_fmac_f32_dpp %0, %4, %12 row_newbcast:4 row_mask:0xf bank_mask:0xf\n\t" "v_fmac_f32_dpp %1, %5, %12 row_newbcast:4 row_mask:0xf bank_mask:0xf\n\t" "v_fmac_f32_dpp %2, %6, %12 row_newbcast:4 row_mask:0xf bank_mask:0xf\n\t" "v_fmac_f32_dpp %3, %7, %12 row_newbcast:4 row_mask:0xf bank_mask:0xf\n\t" "v_fmac_f32_dpp %0, %4, %13 row_newbcast:5 row_mask:0xf bank_mask:0xf\n\t" "v_fmac_f32_dpp %1, %5, %13 row_newbcast:5 row_mask:0xf bank_mask:0xf\n\t" "v_fmac_f32_dpp %2, %6, %13 row_newbcast:5 row_mask:0xf bank_mask:0xf\n\t" "v_fmac_f32_dpp %3, %7, %13 row_newbcast:5 row_mask:0xf bank_mask:0xf\n\t" "v_fmac_f32_dpp %0, %4, %14 row_newbcast:6 row_mask:0xf bank_mask:0xf\n\t" "v_fmac_f32_dpp %1, %5, %14 row_newbcast:6 row_mask:0xf bank_mask:0xf\n\t" "v_fmac_f32_dpp %2, %6, %14 row_newbcast:6 row_mask:0xf bank_mask:0xf\n\t" "v_fmac_f32_dpp %3, %7, %14 row_newbcast:6 row_mask:0xf bank_mask:0xf\n\t" : "+v"(a0), "+v"(a1), "+v"(a2), "+v"(a3) : "v"(l0), "v"(l1), "v"(l2), "v"(l3), "v"(x0), "v"(x1), "v"(x2), "v"(x3), "v"(x4), "v"(x5), "v"(x6));
    }
};
template <> struct QuadChunk<8> {
    static __device__ __forceinline__ void run(float& a0, float& a1, float& a2, float& a3, float l0, float l1, float l2, float l3, float x0, float x1, float x2, float x3, float x4, float x5, float x6, float x7) {
        asm volatile("v_fmac_f32_dpp %0, %4, %8 row_newbcast:0 row_mask:0xf bank_mask:0xf\n\t" "v_fmac_f32_dpp %1, %5, %8 row_newbcast:0 row_mask:0xf bank_mask:0xf\n\t" "v_fmac_f32_dpp %2, %6, %8 row_newbcast:0 row_mask:0xf bank_mask:0xf\n\t" "v_fmac_f32_dpp %3, %7, %8 row_newbcast:0 row_mask:0xf bank_mask:0xf\n\t" "v_fmac_f32_dpp %0, %4, %9 row_newbcast:1 row_mask:0xf bank_mask:0xf\n\t" "v_fmac_f32_dpp %1, %5, %9 row_newbcast:1 row_mask:0xf bank_mask:0xf\n\t" "v_fmac_f32_dpp %2, %6, %9 row_newbcast:1 row_mask:0xf bank_mask:0xf\n\t" "v_fmac_f32_dpp %3, %7, %9 row_newbcast:1 row_mask:0xf bank_mask:0xf\n\t" "v_fmac_f32_dpp %0, %4, %10 row_newbcast:2 row_mask:0xf bank_mask:0xf\n\t" "v_fmac_f32_dpp %1, %5, %10 row_newbcast:2 row_mask:0xf bank_mask:0xf\n\t" "v_fmac_f32_dpp %2, %6, %10 row_newbcast:2 row_mask:0xf bank_mask:0xf\n\t" "v_fmac_f32_dpp %3, %7, %10 row_newbcast:2 row_mask:0xf bank_mask:0xf\n\t" "v_fmac_f32_dpp %0, %4, %11 row_newbcast:3 row_mask:0xf bank_mask:0xf\n\t" "v_fmac_f32_dpp %1, %5, %11 row_newbcast:3 row_mask:0xf bank_mask:0xf\n\t" "v_fmac_f32_dpp %2, %6, %11 row_newbcast:3 row_mask:0xf bank_mask:0xf\n\t" "v_fmac_f32_dpp %3, %7, %11 row_newbcast:3 row_mask:0xf bank_mask:0xf\n\t" "v_fmac_f32_dpp %0, %4, %12 row_newbcast:4 row_mask:0xf bank_mask:0xf\n\t" "v_fmac_f32_dpp %1, %5, %12 row_newbcast:4 row_mask:0xf bank_mask:0xf\n\t" "v_fmac_f32_dpp %2, %6, %12 row_newbcast:4 row_mask:0xf bank_mask:0xf\n\t" "v_fmac_f32_dpp %3, %7, %12 row_newbcast:4 row_mask:0xf bank_mask:0xf\n\t" "v_fmac_f32_dpp %0, %4, %13 row_newbcast:5 row_mask:0xf bank_mask:0xf\n\t" "v_fmac_f32_dpp %1, %5, %13 row_newbcast:5 row_mask:0xf bank_mask:0xf\n\t" "v_fmac_f32_dpp %2, %6, %13 row_newbcast:5 row_mask:0xf bank_mask:0xf\n\t" "v_fmac_f32_dpp %3, %7, %13 row_newbcast:5 row_mask:0xf bank_mask:0xf\n\t" "v_fmac_f32_dpp %0, %4, %14 row_newbcast:6 row_mask:0xf bank_mask:0xf\n\t" "v_fmac_f32_dpp %1, %5, %14 row_newbcast:6 row_mask:0xf bank_mask:0xf\n\t" "v_fmac_f32_dpp %2, %6, %14 row_newbcast:6 row_mask:0xf bank_mask:0xf\n\t" "v_fmac_f32_dpp %3, %7, %14 row_newbcast:6 row_mask:0xf bank_mask:0xf\n\t" "v_fmac_f32_dpp %0, %4, %15 row_newbcast:7 row_mask:0xf bank_mask:0xf\n\t" "v_fmac_f32_dpp %1, %5, %15 row_newbcast:7 row_mask:0xf bank_mask:0xf\n\t" "v_fmac_f32_dpp %2, %6, %15 row_newbcast:7 row_mask:0xf bank_mask:0xf\n\t" "v_fmac_f32_dpp %3, %7, %15 row_newbcast:7 row_mask:0xf bank_mask:0xf\n\t" : "+v"(a0), "+v"(a1), "+v"(a2), "+v"(a3) : "v"(l0), "v"(l1), "v"(l2), "v"(l3), "v"(x0), "v"(x1), "v"(x2), "v"(x3), "v"(x4), "v"(x5), "v"(x6), "v"(x7));
    }
};
template <> struct QuadChunk<9> {
    static __device__ __forceinline__ void run(float& a0, float& a1, float& a2, float& a3, float l0, float l1, float l2, float l3, float x0, float x1, float x2, float x3, float x4, float x5, float x6, float x7, float x8) {
        asm volatile("v_fmac_f32_dpp %0, %4, %8 row_newbcast:0 row_mask:0xf bank_mask:0xf\n\t" "v_fmac_f32_dpp %1, %5, %8 row_newbcast:0 row_mask:0xf bank_mask:0xf\n\t" "v_fmac_f32_dpp %2, %6, %8 row_newbcast:0 row_mask:0xf bank_mask:0xf\n\t" "v_fmac_f32_dpp %3, %7, %8 row_newbcast:0 row_mask:0xf bank_mask:0xf\n\t" "v_fmac_f32_dpp %0, %4, %9 row_newbcast:1 row_mask:0xf bank_mask:0xf\n\t" "v_fmac_f32_dpp %1, %5, %9 row_newbcast:1 row_mask:0xf bank_mask:0xf\n\t" "v_fmac_f32_dpp %2, %6, %9 row_newbcast:1 row_mask:0xf bank_mask:0xf\n\t" "v_fmac_f32_dpp %3, %7, %9 row_newbcast:1 row_mask:0xf bank_mask:0xf\n\t" "v_fmac_f32_dpp %0, %4, %10 row_newbcast:2 row_mask:0xf bank_mask:0xf\n\t" "v_fmac_f32_dpp %1, %5, %10 row_newbcast:2 row_mask:0xf bank_mask:0xf\n\t" "v_fmac_f32_dpp %2, %6, %10 row_newbcast:2 row_mask:0xf bank_mask:0xf\n\t" "v_fmac_f32_dpp %3, %7, %10 row_newbcast:2 row_mask:0xf bank_mask:0xf\n\t" "v_fmac_f32_dpp %0, %4, %11 row_newbcast:3 row_mask:0xf bank_mask:0xf\n\t" "v_fmac_f32_dpp %1, %5, %11 row_newbcast:3 row_mask:0xf bank_mask:0xf\n\t" "v_fmac_f32_dpp %2, %6, %11 row_newbcast:3 row_mask:0xf bank_mask:0xf\n\t" "v_fmac_f32_dpp %3, %7, %11 row_newbcast:3 row_mask:0xf bank_mask:0xf\n\t" "v_fmac_f32_dpp %0, %4, %12 row_newbcast:4 row_mask:0xf bank_mask:0xf\n\t" "v_fmac_f32_dpp %1, %5, %12 row_newbcast:4 row_mask:0xf bank_mask:0xf\n\t" "v_fmac_f32_dpp %2, %6, %12 row_newbcast:4 row_mask:0xf bank_mask:0xf\n\t" "v_fmac_f32_dpp %3, %7, %12 row_newbcast:4 row_mask:0xf bank_mask:0xf\n\t" "v_fmac_f32_dpp %0, %4, %13 row_newbcast:5 row_mask:0xf bank_mask:0xf\n\t" "v_fmac_f32_dpp %1, %5, %13 row_newbcast:5 row_mask:0xf bank_mask:0xf\n\t" "v_fmac_f32_dpp %2, %6, %13 row_newbcast:5 row_mask:0xf bank_mask:0xf\n\t" "v_fmac_f32_dpp %3, %7, %13 row_newbcast:5 row_mask:0xf bank_mask:0xf\n\t" "v_fmac_f32_dpp %0, %4, %14 row_newbcast:6 row_mask:0xf bank_mask:0xf\n\t" "v_fmac_f32_dpp %1, %5, %14 row_newbcast:6 row_mask:0xf bank_mask:0xf\n\t" "v_fmac_f32_dpp %2, %6, %14 row_newbcast:6 row_mask:0xf bank_mask:0xf\n\t" "v_fmac_f32_dpp %3, %7, %14 row_newbcast:6 row_mask:0xf bank_mask:0xf\n\t" "v_fmac_f32_dpp %0, %4, %15 row_newbcast:7 row_mask:0xf bank_mask:0xf\n\t" "v_fmac_f32_dpp %1, %5, %15 row_newbcast:7 row_mask:0xf bank_mask:0xf\n\t" "v_fmac_f32_dpp %2, %6, %15 row_newbcast:7 row_mask:0xf bank_mask:0xf\n\t" "v_fmac_f32_dpp %3, %7, %15 row_newbcast:7 row_mask:0xf bank_mask:0xf\n\t" "v_fmac_f32_dpp %0, %4, %16 row_newbcast:8 row_mask:0xf bank_mask:0xf\n\t" "v_fmac_f32_dpp %1, %5, %16 row_newbcast:8 row_mask:0xf bank_mask:0xf\n\t" "v_fmac_f32_dpp %2, %6, %16 row_newbcast:8 row_mask:0xf bank_mask:0xf\n\t" "v_fmac_f32_dpp %3, %7, %16 row_newbcast:8 row_mask:0xf bank_mask:0xf\n\t" : "+v"(a0), "+v"(a1), "+v"(a2), "+v"(a3) : "v"(l0), "v"(l1), "v"(l2), "v"(l3), "v"(x0), "v"(x1), "v"(x2), "v"(x3), "v"(x4), "v"(x5), "v"(x6), "v"(x7), "v"(x8));
    }
};
template <> struct QuadChunk<10> {
    static __device__ __forceinline__ void run(float& a0, float& a1, float& a2, float& a3, float l0, float l1, float l2, float l3, float x0, float x1, float x2, float x3, float x4, float x5, float x6, float x7, float x8, float x9) {
        asm volatile("v_fmac_f32_dpp %0, %4, %8 row_newbcast:0 row_mask:0xf bank_mask:0xf\n\t" "v_fmac_f32_dpp %1, %5, %8 row_newbcast:0 row_mask:0xf bank_mask:0xf\n\t" "v_fmac_f32_dpp %2, %6, %8 row_newbcast:0 row_mask:0xf bank_mask:0xf\n\t" "v_fmac_f32_dpp %3, %7, %8 row_newbcast:0 row_mask:0xf bank_mask:0xf\n\t" "v_fmac_f32_dpp %0, %4, %9 row_newbcast:1 row_mask:0xf bank_mask:0xf\n\t" "v_fmac_f32_dpp %1, %5, %9 row_newbcast:1 row_mask:0xf bank_mask:0xf\n\t" "v_fmac_f32_dpp %2, %6, %9 row_newbcast:1 row_mask:0xf bank_mask:0xf\n\t" "v_fmac_f32_dpp %3, %7, %9 row_newbcast:1 row_mask:0xf bank_mask:0xf\n\t" "v_fmac_f32_dpp %0, %4, %10 row_newbcast:2 row_mask:0xf bank_mask:0xf\n\t" "v_fmac_f32_dpp %1, %5, %10 row_newbcast:2 row_mask:0xf bank_mask:0xf\n\t" "v_fmac_f32_dpp %2, %6, %10 row_newbcast:2 row_mask:0xf bank_mask:0xf\n\t" "v_fmac_f32_dpp %3, %7, %10 row_newbcast:2 row_mask:0xf bank_mask:0xf\n\t" "v_fmac_f32_dpp %0, %4, %11 row_newbcast:3 row_mask:0xf bank_mask:0xf\n\t" "v_fmac_f32_dpp %1, %5, %11 row_newbcast:3 row_mask:0xf bank_mask:0xf\n\t" "v_fmac_f32_dpp %2, %6, %11 row_newbcast:3 row_mask:0xf bank_mask:0xf\n\t" "v_fmac_f32_dpp %3, %7, %11 row_newbcast:3 row_mask:0xf bank_mask:0xf\n\t" "v_fmac_f32_dpp %0, %4, %12 row_newbcast:4 row_mask:0xf bank_mask:0xf\n\t" "v_fmac_f32_dpp %1, %5, %12 row_newbcast:4 row_mask:0xf bank_mask:0xf\n\t" "v_fmac_f32_dpp %2, %6, %12 row_newbcast:4 row_mask:0xf bank_mask:0xf\n\t" "v_fmac_f32_dpp %3, %7, %12 row_newbcast:4 row_mask:0xf bank_mask:0xf\n\t" "v_fmac_f32_dpp %0, %4, %13 row_newbcast:5 row_mask:0xf bank_mask:0xf\n\t" "v_fmac_f32_dpp %1, %5, %13 row_newbcast:5 row_mask:0xf bank_mask:0xf\n\t" "v_fmac_f32_dpp %2, %6, %13 row_newbcast:5 row_mask:0xf bank_mask:0xf\n\t" "v_fmac_f32_dpp %3, %7, %13 row_newbcast:5 row_mask:0xf bank_mask:0xf\n\t" "v_fmac_f32_dpp %0, %4, %14 row_newbcast:6 row_mask:0xf bank_mask:0xf\n\t" "v_fmac_f32_dpp %1, %5, %14 row_newbcast:6 row_mask:0xf bank_mask:0xf\n\t" "v_fmac_f32_dpp %2, %6, %14 row_newbcast:6 row_mask:0xf bank_mask:0xf\n\t" "v_fmac_f32_dpp %3, %7, %14 row_newbcast:6 row_mask:0xf bank_mask:0xf\n\t" "v_fmac_f32_dpp %0, %4, %15 row_newbcast:7 row_mask:0xf bank_mask:0xf\n\t" "v_fmac_f32_dpp %1, %5, %15 row_newbcast:7 row_mask:0xf bank_mask:0xf\n\t" "v_fmac_f32_dpp %2, %6, %15 row_newbcast:7 row_mask:0xf bank_mask:0xf\n\t" "v_fmac_f32_dpp %3, %7, %15 row_newbcast:7 row_mask:0xf bank_mask:0xf\n\t" "v_fmac_f32_dpp %0, %4, %16 row_newbcast:8 row_mask:0xf bank_mask:0xf\n\t" "v_fmac_f32_dpp %1, %5, %16 row_newbcast:8 row_mask:0xf bank_mask:0xf\n\t" "v_fmac_f32_dpp %2, %6, %16 row_newbcast:8 row_mask:0xf bank_mask:0xf\n\t" "v_fmac_f32_dpp %3, %7, %16 row_newbcast:8 row_mask:0xf bank_mask:0xf\n\t" "v_fmac_f32_dpp %0, %4, %17 row_newbcast:9 row_mask:0xf bank_mask:0xf\n\t" "v_fmac_f32_dpp %1, %5, %17 row_newbcast:9 row_mask:0xf bank_mask:0xf\n\t" "v_fmac_f32_dpp %2, %6, %17 row_newbcast:9 row_mask:0xf bank_mask:0xf\n\t" "v_fmac_f32_dpp %3, %7, %17 row_newbcast:9 row_mask:0xf bank_mask:0xf\n\t" : "+v"(a0), "+v"(a1), "+v"(a2), "+v"(a3) : "v"(l0), "v"(l1), "v"(l2), "v"(l3), "v"(x0), "v"(x1), "v"(x2), "v"(x3), "v"(x4), "v"(x5), "v"(x6), "v"(x7), "v"(x8), "v"(x9));
    }
};
template <> struct QuadChunk<11> {
    static __device__ __forceinline__ void run(float& a0, float& a1, float& a2, float& a3, float l0, float l1, float l2, float l3, float x0, float x1, float x2, float x3, float x4, float x5, float x6, float x7, float x8, float x9, float x10) {
        asm volatile("v_fmac_f32_dpp %0, %4, %8 row_newbcast:0 row_mask:0xf bank_mask:0xf\n\t" "v_fmac_f32_dpp %1, %5, %8 row_newbcast:0 row_mask:0xf bank_mask:0xf\n\t" "v_fmac_f32_dpp %2, %6, %8 row_newbcast:0 row_mask:0xf bank_mask:0xf\n\t" "v_fmac_f32_dpp %3, %7, %8 row_newbcast:0 row_mask:0xf bank_mask:0xf\n\t" "v_fmac_f32_dpp %0, %4, %9 row_newbcast:1 row_mask:0xf bank_mask:0xf\n\t" "v_fmac_f32_dpp %1, %5, %9 row_newbcast:1 row_mask:0xf bank_mask:0xf\n\t" "v_fmac_f32_dpp %2, %6, %9 row_newbcast:1 row_mask:0xf bank_mask:0xf\n\t" "v_fmac_f32_dpp %3, %7, %9 row_newbcast:1 row_mask:0xf bank_mask:0xf\n\t" "v_fmac_f32_dpp %0, %4, %10 row_newbcast:2 row_mask:0xf bank_mask:0xf\n\t" "v_fmac_f32_dpp %1, %5, %10 row_newbcast:2 row_mask:0xf bank_mask:0xf\n\t" "v_fmac_f32_dpp %2, %6, %10 row_newbcast:2 row_mask:0xf bank_mask:0xf\n\t" "v_fmac_f32_dpp %3, %7, %10 row_newbcast:2 row_mask:0xf bank_mask:0xf\n\t" "v_fmac_f32_dpp %0, %4, %11 row_newbcast:3 row_mask:0xf bank_mask:0xf\n\t" "v_fmac_f32_dpp %1, %5, %11 row_newbcast:3 row_mask:0xf bank_mask:0xf\n\t" "v_fmac_f32_dpp %2, %6, %11 row_newbcast:3 row_mask:0xf bank_mask:0xf\n\t" "v_fmac_f32_dpp %3, %7, %11 row_newbcast:3 row_mask:0xf bank_mask:0xf\n\t" "v_fmac_f32_dpp %0, %4, %12 row_newbcast:4 row_mask:0xf bank_mask:0xf\n\t" "v_fmac_f32_dpp %1, %5, %12 row_newbcast:4 row_mask:0xf bank_mask:0xf\n\t" "v_fmac_f32_dpp %2, %6, %12 row_newbcast:4 row_mask:0xf bank_mask:0xf\n\t" "v_fmac_f32_dpp %3, %7, %12 row_newbcast:4 row_mask:0xf bank_mask:0xf\n\t" "v_fmac_f32_dpp %0, %4, %13 row_newbcast:5 row_mask:0xf bank_mask:0xf\n\t" "v_fmac_f32_dpp %1, %5, %13 row_newbcast:5 row_mask:0xf bank_mask:0xf\n\t" "v_fmac_f32_dpp %2, %6, %13 row_newbcast:5 row_mask:0xf bank_mask:0xf\n\t" "v_fmac_f32_dpp %3, %7, %13 row_newbcast:5 row_mask:0xf bank_mask:0xf\n\t" "v_fmac_f32_dpp %0, %4, %14 row_newbcast:6 row_mask:0xf bank_mask:0xf\n\t" "v_fmac_f32_dpp %1, %5, %14 row_newbcast:6 row_mask:0xf bank_mask:0xf\n\t" "v_fmac_f32_dpp %2, %6, %14 row_newbcast:6 row_mask:0xf bank_mask:0xf\n\t" "v_fmac_f32_dpp %3, %7, %14 row_newbcast:6 row_mask:0xf bank_mask:0xf\n\t" "v_fmac_f32_dpp %0, %4, %15 row_newbcast:7 row_mask:0xf bank_mask:0xf\n\t" "v_fmac_f32_dpp %1, %5, %15 row_newbcast:7 row_mask:0xf bank_mask:0xf\n\t" "v_fmac_f32_dpp %2, %6, %15 row_newbcast:7 row_mask:0xf bank_mask:0xf\n\t" "v_fmac_f32_dpp %3, %7, %15 row_newbcast:7 row_mask:0xf bank_mask:0xf\n\t" "v_fmac_f32_dpp %0, %4, %16 row_newbcast:8 row_mask:0xf bank_mask:0xf\n\t" "v_fmac_f32_dpp %1, %5, %16 row_newbcast:8 row_mask:0xf bank_mask:0xf\n\t" "v_fmac_f32_dpp %2, %6, %16 row_newbcast:8 row_mask:0xf bank_mask:0xf\n\t" "v_fmac_f32_dpp %3, %7, %16 row_newbcast:8 row_mask:0xf bank_mask:0xf\n\t" "v_fmac_f32_dpp %0, %4, %17 row_newbcast:9 row_mask:0xf bank_mask:0xf\n\t" "v_fmac_f32_dpp %1, %5, %17 row_newbcast:9 row_mask:0xf bank_mask:0xf\n\t" "v_fmac_f32_dpp %2, %6, %17 row_newbcast:9 row_mask:0xf bank_mask:0xf\n\t" "v_fmac_f32_dpp %3, %7, %17 row_newbcast:9 row_mask:0xf bank_mask:0xf\n\t" "v_fmac_f32_dpp %0, %4, %18 row_newbcast:10 row_mask:0xf bank_mask:0xf\n\t" "v_fmac_f32_dpp %1, %5, %18 row_newbcast:10 row_mask:0xf bank_mask:0xf\n\t" "v_fmac_f32_dpp %2, %6, %18 row_newbcast:10 row_mask:0xf bank_mask:0xf\n\t" "v_fmac_f32_dpp %3, %7, %18 row_newbcast:10 row_mask:0xf bank_mask:0xf\n\t" : "+v"(a0), "+v"(a1), "+v"(a2), "+v"(a3) : "v"(l0), "v"(l1), "v"(l2), "v"(l3), "v"(x0), "v"(x1), "v"(x2), "v"(x3), "v"(x4), "v"(x5), "v"(x6), "v"(x7), "v"(x8), "v"(x9), "v"(x10));
    }
};
template <> struct QuadChunk<12> {
    static __device__ __forceinline__ void run(float& a0, float& a1, float& a2, float& a3, float l0, float l1, float l2, float l3, float x0, float x1, float x2, float x3, float x4, float x5, float x6, float x7, float x8, float x9, float x10, float x11) {
        asm volatile("v_fmac_f32_dpp %0, %4, %8 row_newbcast:0 row_mask:0xf bank_mask:0xf\n\t" "v_fmac_f32_dpp %1, %5, %8 row_newbcast:0 row_mask:0xf bank_mask:0xf\n\t" "v_fmac_f32_dpp %2, %6, %8 row_newbcast:0 row_mask:0xf bank_mask:0xf\n\t" "v_fmac_f32_dpp %3, %7, %8 row_newbcast:0 row_mask:0xf bank_mask:0xf\n\t" "v_fmac_f32_dpp %0, %4, %9 row_newbcast:1 row_mask:0xf bank_mask:0xf\n\t" "v_fmac_f32_dpp %1, %5, %9 row_newbcast:1 row_mask:0xf bank_mask:0xf\n\t" "v_fmac_f32_dpp %2, %6, %9 row_newbcast:1 row_mask:0xf bank_mask:0xf\n\t" "v_fmac_f32_dpp %3, %7, %9 row_newbcast:1 row_mask:0xf bank_mask:0xf\n\t" "v_fmac_f32_dpp %0, %4, %10 row_newbcast:2 row_mask:0xf bank_mask:0xf\n\t" "v_fmac_f32_dpp %1, %5, %10 row_newbcast:2 row_mask:0xf bank_mask:0xf\n\t" "v_fmac_f32_dpp %2, %6, %10 row_newbcast:2 row_mask:0xf bank_mask:0xf\n\t" "v_fmac_f32_dpp %3, %7, %10 row_newbcast:2 row_mask:0xf bank_mask:0xf\n\t" "v_fmac_f32_dpp %0, %4, %11 row_newbcast:3 row_mask:0xf bank_mask:0xf\n\t" "v_fmac_f32_dpp %1, %5, %11 row_newbcast:3 row_mask:0xf bank_mask:0xf\n\t" "v_fmac_f32_dpp %2, %6, %11 row_newbcast:3 row_mask:0xf bank_mask:0xf\n\t" "v_fmac_f32_dpp %3, %7, %11 row_newbcast:3 row_mask:0xf bank_mask:0xf\n\t" "v_fmac_f32_dpp %0, %4, %12 row_newbcast:4 row_mask:0xf bank_mask:0xf\n\t" "v_fmac_f32_dpp %1, %5, %12 row_newbcast:4 row_mask:0xf bank_mask:0xf\n\t" "v_fmac_f32_dpp %2, %6, %12 row_newbcast:4 row_mask:0xf bank_mask:0xf\n\t" "v_fmac_f32_dpp %3, %7, %12 row_newbcast:4 row_mask:0xf bank_mask:0xf\n\t" "v_fmac_f32_dpp %0, %4, %13 row_newbcast:5 row_mask:0xf bank_mask:0xf\n\t" "v_fmac_f32_dpp %1, %5, %13 row_newbcast:5 row_mask:0xf bank_mask:0xf\n\t" "v_fmac_f32_dpp %2, %6, %13 row_newbcast:5 row_mask:0xf bank_mask:0xf\n\t" "v_fmac_f32_dpp %3, %7, %13 row_newbcast:5 row_mask:0xf bank_mask:0xf\n\t" "v_fmac_f32_dpp %0, %4, %14 row_newbcast:6 row_mask:0xf bank_mask:0xf\n\t" "v_fmac_f32_dpp %1, %5, %14 row_newbcast:6 row_mask:0xf bank_mask:0xf\n\t" "v_fmac_f32_dpp %2, %6, %14 row_newbcast:6 row_mask:0xf bank_mask:0xf\n\t" "v_fmac_f32_dpp %3, %7, %14 row_newbcast:6 row_mask:0xf bank_mask:0xf\n\t" "v_fmac_f32_dpp %0, %4, %15 row_newbcast:7 row_mask:0xf bank_mask:0xf\n\t" "v_fmac_f32_dpp %1, %5, %15 row_newbcast:7 row_mask:0xf bank_mask:0xf\n\t" "v_fmac_f32_dpp %2, %6, %15 row_newbcast:7 row_mask:0xf bank_mask:0xf\n\t" "v_fmac_f32_dpp %3, %7, %15 row_newbcast:7 row_mask:0xf bank_mask:0xf\n\t" "v_fmac_f32_dpp %0, %4, %16 row_newbcast:8 row_mask:0xf bank_mask:0xf\n\t" "v_fmac_f32_dpp %1, %5, %16 row_newbcast:8 row_mask:0xf bank_mask:0xf\n\t" "v_fmac_f32_dpp %2, %6, %16 row_newbcast:8 row_mask:0xf bank_mask:0xf\n\t" "v_fmac_f32_dpp %3, %7, %16 row_newbcast:8 row_mask:0xf bank_mask:0xf\n\t" "v_fmac_f32_dpp %0, %4, %17 row_newbcast:9 row_mask:0xf bank_mask:0xf\n\t" "v_fmac_f32_dpp %1, %5, %17 row_newbcast:9 row_mask:0xf bank_mask:0xf\n\t" "v_fmac_f32_dpp %2, %6, %17 row_newbcast:9 row_mask:0xf bank_mask:0xf\n\t" "v_fmac_f32_dpp %3, %7, %17 row_newbcast:9 row_mask:0xf bank_mask:0xf\n\t" "v_fmac_f32_dpp %0, %4, %18 row_newbcast:10 row_mask:0xf bank_mask:0xf\n\t" "v_fmac_f32_dpp %1, %5, %18 row_newbcast:10 row_mask:0xf bank_mask:0xf\n\t" "v_fmac_f32_dpp %2, %6, %18 row_newbcast:10 row_mask:0xf bank_mask:0xf\n\t" "v_fmac_f32_dpp %3, %7, %18 row_newbcast:10 row_mask:0xf bank_mask:0xf\n\t" "v_fmac_f32_dpp %0, %4, %19 row_newbcast:11 row_mask:0xf bank_mask:0xf\n\t" "v_fmac_f32_dpp %1, %5, %19 row_newbcast:11 row_mask:0xf bank_mask:0xf\n\t" "v_fmac_f32_dpp %2, %6, %19 row_newbcast:11 row_mask:0xf bank_mask:0xf\n\t" "v_fmac_f32_dpp %3, %7, %19 row_newbcast:11 row_mask:0xf bank_mask:0xf\n\t" : "+v"(a0), "+v"(a1), "+v"(a2), "+v"(a3) : "v"(l0), "v"(l1), "v"(l2), "v"(l3), "v"(x0), "v"(x1), "v"(x2), "v"(x3), "v"(x4), "v"(x5), "v"(x6), "v"(x7), "v"(x8), "v"(x9), "v"(x10), "v"(x11));
    }
};
template <> struct QuadChunk<13> {
    static __device__ __forceinline__ void run(float& a0, float& a1, float& a2, float& a3, float l0, float l1, float l2, float l3, float x0, float x1, float x2, float x3, float x4, float x5, float x6, float x7, float x8, float x9, float x10, float x11, float x12) {
        asm volatile("v_fmac_f32_dpp %0, %4, %8 row_newbcast:0 row_mask:0xf bank_mask:0xf\n\t" "v_fmac_f32_dpp %1, %5, %8 row_newbcast:0 row_mask:0xf bank_mask:0xf\n\t" "v_fmac_f32_dpp %2, %6, %8 row_newbcast:0 row_mask:0xf bank_mask:0xf\n\t" "v_fmac_f32_dpp %3, %7, %8 row_newbcast:0 row_mask:0xf bank_mask:0xf\n\t" "v_fmac_f32_dpp %0, %4, %9 row_newbcast:1 row_mask:0xf bank_mask:0xf\n\t" "v_fmac_f32_dpp %1, %5, %9 row_newbcast:1 row_mask:0xf bank_mask:0xf\n\t" "v_fmac_f32_dpp %2, %6, %9 row_newbcast:1 row_mask:0xf bank_mask:0xf\n\t" "v_fmac_f32_dpp %3, %7, %9 row_newbcast:1 row_mask:0xf bank_mask:0xf\n\t" "v_fmac_f32_dpp %0, %4, %10 row_newbcast:2 row_mask:0xf bank_mask:0xf\n\t" "v_fmac_f32_dpp %1, %5, %10 row_newbcast:2 row_mask:0xf bank_mask:0xf\n\t" "v_fmac_f32_dpp %2, %6, %10 row_newbcast:2 row_mask:0xf bank_mask:0xf\n\t" "v_fmac_f32_dpp %3, %7, %10 row_newbcast:2 row_mask:0xf bank_mask:0xf\n\t" "v_fmac_f32_dpp %0, %4, %11 row_newbcast:3 row_mask:0xf bank_mask:0xf\n\t" "v_fmac_f32_dpp %1, %5, %11 row_newbcast:3 row_mask:0xf bank_mask:0xf\n\t" "v_fmac_f32_dpp %2, %6, %11 row_newbcast:3 row_mask:0xf bank_mask:0xf\n\t" "v_fmac_f32_dpp %3, %7, %11 row_newbcast:3 row_mask:0xf bank_mask:0xf\n\t" "v_fmac_f32_dpp %0, %4, %12 row_newbcast:4 row_mask:0xf bank_mask:0xf\n\t" "v_fmac_f32_dpp %1, %5, %12 row_newbcast:4 row_mask:0xf bank_mask:0xf\n\t" "v_fmac_f32_dpp %2, %6, %12 row_newbcast:4 row_mask:0xf bank_mask:0xf\n\t" "v_fmac_f32_dpp %3, %7, %12 row_newbcast:4 row_mask:0xf bank_mask:0xf\n\t" "v_fmac_f32_dpp %0, %4, %13 row_newbcast:5 row_mask:0xf bank_mask:0xf\n\t" "v_fmac_f32_dpp %1, %5, %13 row_newbcast:5 row_mask:0xf bank_mask:0xf\n\t" "v_fmac_f32_dpp %2, %6, %13 row_newbcast:5 row_mask:0xf bank_mask:0xf\n\t" "v_fmac_f32_dpp %3, %7, %13 row_newbcast:5 row_mask:0xf bank_mask:0xf\n\t" "v_fmac_f32_dpp %0, %4, %14 row_newbcast:6 row_mask:0xf bank_mask:0xf\n\t" "v_fmac_f32_dpp %1, %5, %14 row_newbcast:6 row_mask:0xf bank_mask:0xf\n\t" "v_fmac_f32_dpp %2, %6, %14 row_newbcast:6 row_mask:0xf bank_mask:0xf\n\t" "v_fmac_f32_dpp %3, %7, %14 row_newbcast:6 row_mask:0xf bank_mask:0xf\n\t" "v_fmac_f32_dpp %0, %4, %15 row_newbcast:7 row_mask:0xf bank_mask:0xf\n\t" "v_fmac_f32_dpp %1, %5, %15 row_newbcast:7 row_mask:0xf bank_mask:0xf\n\t" "v_fmac_f32_dpp %2, %6, %15 row_newbcast:7 row_mask:0xf bank_mask:0xf\n\t" "v_fmac_f32_dpp %3, %7, %15 row_newbcast:7 row_mask:0xf bank_mask:0xf\n\t" "v_fmac_f32_dpp %0, %4, %16 row_newbcast:8 row_mask:0xf bank_mask:0xf\n\t" "v_fmac_f32_dpp %1, %5, %16 row_newbcast:8 row_mask:0xf bank_mask:0xf\n\t" "v_fmac_f32_dpp %2, %6, %16 row_newbcast:8 row_mask:0xf bank_mask:0xf\n\t" "v_fmac_f32_dpp %3, %7, %16 row_newbcast:8 row_mask:0xf bank_mask:0xf\n\t" "v_fmac_f32_dpp %0, %4, %17 row_newbcast:9 row_mask:0xf bank_mask:0xf\n\t" "v_fmac_f32_dpp %1, %5, %17 row_newbcast:9 row_mask:0xf bank_mask:0xf\n\t" "v_fmac_f32_dpp %2, %6, %17 row_newbcast:9 row_mask:0xf bank_mask:0xf\n\t" "v_fmac_f32_dpp %3, %7, %17 row_newbcast:9 row_mask:0xf bank_mask:0xf\n\t" "v_fmac_f32_dpp %0, %4, %18 row_newbcast:10 row_mask:0xf bank_mask:0xf\n\t" "v_fmac_f32_dpp %1, %5, %18 row_newbcast:10 row_mask:0xf bank_mask:0xf\n\t" "v_fmac_f32_dpp %2, %6, %18 row_newbcast:10 row_mask:0xf bank_mask:0xf\n\t" "v_fmac_f32_dpp %3, %7, %18 row_newbcast:10 row_mask:0xf bank_mask:0xf\n\t" "v_fmac_f32_dpp %0, %4, %19 row_newbcast:11 row_mask:0xf bank_mask:0xf\n\t" "v_fmac_f32_dpp %1, %5, %19 row_newbcast:11 row_mask:0xf bank_mask:0xf\n\t" "v_fmac_f32_dpp %2, %6, %19 row_newbcast:11 row_mask:0xf bank_mask:0xf\n\t" "v_fmac_f32_dpp %3, %7, %19 row_newbcast:11 row_mask:0xf bank_mask:0xf\n\t" "v_fmac_f32_dpp %0, %4, %20 row_newbcast:12 row_mask:0xf bank_mask:0xf\n\t" "v_fmac_f32_dpp %1, %5, %20 row_newbcast:12 row_mask:0xf bank_mask:0xf\n\t" "v_fmac_f32_dpp %2, %6, %20 row_newbcast:12 row_mask:0xf bank_mask:0xf\n\t" "v_fmac_f32_dpp %3, %7, %20 row_newbcast:12 row_mask:0xf bank_mask:0xf\n\t" : "+v"(a0), "+v"(a1), "+v"(a2), "+v"(a3) : "v"(l0), "v"(l1), "v"(l2), "v"(l3), "v"(x0), "v"(x1), "v"(x2), "v"(x3), "v"(x4), "v"(x5), "v"(x6), "v"(x7), "v"(x8), "v"(x9), "v"(x10), "v"(x11), "v"(x12));
    }
};
template <> struct QuadChunk<14> {
    static __device__ __forceinline__ void run(float& a0, float& a1, float& a2, float& a3, float l0, float l1, float l2, float l3, float x0, float x1, float x2, float x3, float x4, float x5, float x6, float x7, float x8, float x9, float x10, float x11, float x12, float x13) {
        asm volatile("v_fmac_f32_dpp %0, %4, %8 row_newbcast:0 row_mask:0xf bank_mask:0xf\n\t" "v_fmac_f32_dpp %1, %5, %8 row_newbcast:0 row_mask:0xf bank_mask:0xf\n\t" "v_fmac_f32_dpp %2, %6, %8 row_newbcast:0 row_mask:0xf bank_mask:0xf\n\t" "v_fmac_f32_dpp %3, %7, %8 row_newbcast:0 row_mask:0xf bank_mask:0xf\n\t" "v_fmac_f32_dpp %0, %4, %9 row_newbcast:1 row_mask:0xf bank_mask:0xf\n\t" "v_fmac_f32_dpp %1, %5, %9 row_newbcast:1 row_mask:0xf bank_mask:0xf\n\t" "v_fmac_f32_dpp %2, %6, %9 row_newbcast:1 row_mask:0xf bank_mask:0xf\n\t" "v_fmac_f32_dpp %3, %7, %9 row_newbcast:1 row_mask:0xf bank_mask:0xf\n\t" "v_fmac_f32_dpp %0, %4, %10 row_newbcast:2 row_mask:0xf bank_mask:0xf\n\t" "v_fmac_f32_dpp %1, %5, %10 row_newbcast:2 row_mask:0xf bank_mask:0xf\n\t" "v_fmac_f32_dpp %2, %6, %10 row_newbcast:2 row_mask:0xf bank_mask:0xf\n\t" "v_fmac_f32_dpp %3, %7, %10 row_newbcast:2 row_mask:0xf bank_mask:0xf\n\t" "v_fmac_f32_dpp %0, %4, %11 row_newbcast:3 row_mask:0xf bank_mask:0xf\n\t" "v_fmac_f32_dpp %1, %5, %11 row_newbcast:3 row_mask:0xf bank_mask:0xf\n\t" "v_fmac_f32_dpp %2, %6, %11 row_newbcast:3 row_mask:0xf bank_mask:0xf\n\t" "v_fmac_f32_dpp %3, %7, %11 row_newbcast:3 row_mask:0xf bank_mask:0xf\n\t" "v_fmac_f32_dpp %0, %4, %12 row_newbcast:4 row_mask:0xf bank_mask:0xf\n\t" "v_fmac_f32_dpp %1, %5, %12 row_newbcast:4 row_mask:0xf bank_mask:0xf\n\t" "v_fmac_f32_dpp %2, %6, %12 row_newbcast:4 row_mask:0xf bank_mask:0xf\n\t" "v_fmac_f32_dpp %3, %7, %12 row_newbcast:4 row_mask:0xf bank_mask:0xf\n\t" "v_fmac_f32_dpp %0, %4, %13 row_newbcast:5 row_mask:0xf bank_mask:0xf\n\t" "v_fmac_f32_dpp %1, %5, %13 row_newbcast:5 row_mask:0xf bank_mask:0xf\n\t" "v_fmac_f32_dpp %2, %6, %13 row_newbcast:5 row_mask:0xf bank_mask:0xf\n\t" "v_fmac_f32_dpp %3, %7, %13 row_newbcast:5 row_mask:0xf bank_mask:0xf\n\t" "v_fmac_f32_dpp %0, %4, %14 row_newbcast:6 row_mask:0xf bank_mask:0xf\n\t" "v_fmac_f32_dpp %1, %5, %14 row_newbcast:6 row_mask:0xf bank_mask:0xf\n\t" "v_fmac_f32_dpp %2, %6, %14 row_newbcast:6 row_mask:0xf bank_mask:0xf\n\t" "v_fmac_f32_dpp %3, %7, %14 row_newbcast:6 row_mask:0xf bank_mask:0xf\n\t" "v_fmac_f32_dpp %0, %4, %15 row_newbcast:7 row_mask:0xf bank_mask:0xf\n\t" "v_fmac_f32_dpp %1, %5, %15 row_newbcast:7 row_mask:0xf bank_mask:0xf\n\t" "v_fmac_f32_dpp %2, %6, %15 row_newbcast:7 row_mask:0xf bank_mask:0xf\n\t" "v_fmac_f32_dpp %3, %7, %15 row_newbcast:7 row_mask:0xf bank_mask:0xf\n\t" "v_fmac_f32_dpp %0, %4, %16 row_newbcast:8 row_mask:0xf bank_mask:0xf\n\t" "v_fmac_f32_dpp %1, %5, %16 row_newbcast:8 row_mask:0xf bank_mask:0xf\n\t" "v_fmac_f32_dpp %2, %6, %16 row_newbcast:8 row_mask:0xf bank_mask:0xf\n\t" "v_fmac_f32_dpp %3, %7, %16 row_newbcast:8 row_mask:0xf bank_mask:0xf\n\t" "v_fmac_f32_dpp %0, %4, %17 row_newbcast:9 row_mask:0xf bank_mask:0xf\n\t" "v_fmac_f32_dpp %1, %5, %17 row_newbcast:9 row_mask:0xf bank_mask:0xf\n\t" "v_fmac_f32_dpp %2, %6, %17 row_newbcast:9 row_mask:0xf bank_mask:0xf\n\t" "v_fmac_f32_dpp %3, %7, %17 row_newbcast:9 row_mask:0xf bank_mask:0xf\n\t" "v_fmac_f32_dpp %0, %4, %18 row_newbcast:10 row_mask:0xf bank_mask:0xf\n\t" "v_fmac_f32_dpp %1, %5, %18 row_newbcast:10 row_mask:0xf bank_mask:0xf\n\t" "v_fmac_f32_dpp %2, %6, %18 row_newbcast:10 row_mask:0xf bank_mask:0xf\n\t" "v_fmac_f32_dpp %3, %7, %18 row_newbcast:10 row_mask:0xf bank_mask:0xf\n\t" "v_fmac_f32_dpp %0, %4, %19 row_newbcast:11 row_mask:0xf bank_mask:0xf\n\t" "v_fmac_f32_dpp %1, %5, %19 row_newbcast:11 row_mask:0xf bank_mask:0xf\n\t" "v_fmac_f32_dpp %2, %6, %19 row_newbcast:11 row_mask:0xf bank_mask:0xf\n\t" "v_fmac_f32_dpp %3, %7, %19 row_newbcast:11 row_mask:0xf bank_mask:0xf\n\t" "v_fmac_f32_dpp %0, %4, %20 row_newbcast:12 row_mask:0xf bank_mask:0xf\n\t" "v_fmac_f32_dpp %1, %5, %20 row_newbcast:12 row_mask:0xf bank_mask:0xf\n\t" "v_fmac_f32_dpp %2, %6, %20 row_newbcast:12 row_mask:0xf bank_mask:0xf\n\t" "v_fmac_f32_dpp %3, %7, %20 row_newbcast:12 row_mask:0xf bank_mask:0xf\n\t" "v_fmac_f32_dpp %0, %4, %21 row_newbcast:13 row_mask:0xf bank_mask:0xf\n\t" "v_fmac_f32_dpp %1, %5, %21 row_newbcast:13 row_mask:0xf bank_mask:0xf\n\t" "v_fmac_f32_dpp %2, %6, %21 row_newbcast:13 row_mask:0xf bank_mask:0xf\n\t" "v_fmac_f32_dpp %3, %7, %21 row_newbcast:13 row_mask:0xf bank_mask:0xf\n\t" : "+v"(a0), "+v"(a1), "+v"(a2), "+v"(a3) : "v"(l0), "v"(l1), "v"(l2), "v"(l3), "v"(x0), "v"(x1), "v"(x2), "v"(x3), "v"(x4), "v"(x5), "v"(x6), "v"(x7), "v"(x8), "v"(x9), "v"(x10), "v"(x11), "v"(x12), "v"(x13));
    }
};
template <> struct QuadChunk<15> {
    static __device__ __forceinline__ void run(float& a0, float& a1, float& a2, float& a3, float l0, float l1, float l2, float l3, float x0, float x1, float x2, float x3, float x4, float x5, float x6, float x7, float x8, float x9, float x10, float x11, float x12, float x13, float x14) {
        asm volatile("v_fmac_f32_dpp %0, %4, %8 row_newbcast:0 row_mask:0xf bank_mask:0xf\n\t" "v_fmac_f32_dpp %1, %5, %8 row_newbcast:0 row_mask:0xf bank_mask:0xf\n\t" "v_fmac_f32_dpp %2, %6, %8 row_newbcast:0 row_mask:0xf bank_mask:0xf\n\t" "v_fmac_f32_dpp %3, %7, %8 row_newbcast:0 row_mask:0xf bank_mask:0xf\n\t" "v_fmac_f32_dpp %0, %4, %9 row_newbcast:1 row_mask:0xf bank_mask:0xf\n\t" "v_fmac_f32_dpp %1, %5, %9 row_newbcast:1 row_mask:0xf bank_mask:0xf\n\t" "v_fmac_f32_dpp %2, %6, %9 row_newbcast:1 row_mask:0xf bank_mask:0xf\n\t" "v_fmac_f32_dpp %3, %7, %9 row_newbcast:1 row_mask:0xf bank_mask:0xf\n\t" "v_fmac_f32_dpp %0, %4, %10 row_newbcast:2 row_mask:0xf bank_mask:0xf\n\t" "v_fmac_f32_dpp %1, %5, %10 row_newbcast:2 row_mask:0xf bank_mask:0xf\n\t" "v_fmac_f32_dpp %2, %6, %10 row_newbcast:2 row_mask:0xf bank_mask:0xf\n\t" "v_fmac_f32_dpp %3, %7, %10 row_newbcast:2 row_mask:0xf bank_mask:0xf\n\t" "v_fmac_f32_dpp %0, %4, %11 row_newbcast:3 row_mask:0xf bank_mask:0xf\n\t" "v_fmac_f32_dpp %1, %5, %11 row_newbcast:3 row_mask:0xf bank_mask:0xf\n\t" "v_fmac_f32_dpp %2, %6, %11 row_newbcast:3 row_mask:0xf bank_mask:0xf\n\t" "v_fmac_f32_dpp %3, %7, %11 row_newbcast:3 row_mask:0xf bank_mask:0xf\n\t" "v_fmac_f32_dpp %0, %4, %12 row_newbcast:4 row_mask:0xf bank_mask:0xf\n\t" "v_fmac_f32_dpp %1, %5, %12 row_newbcast:4 row_mask:0xf bank_mask:0xf\n\t" "v_fmac_f32_dpp %2, %6, %12 row_newbcast:4 row_mask:0xf bank_mask:0xf\n\t" "v_fmac_f32_dpp %3, %7, %12 row_newbcast:4 row_mask:0xf bank_mask:0xf\n\t" "v_fmac_f32_dpp %0, %4, %13 row_newbcast:5 row_mask:0xf bank_mask:0xf\n\t" "v_fmac_f32_dpp %1, %5, %13 row_newbcast:5 row_mask:0xf bank_mask:0xf\n\t" "v_fmac_f32_dpp %2, %6, %13 row_newbcast:5 row_mask:0xf bank_mask:0xf\n\t" "v_fmac_f32_dpp %3, %7, %13 row_newbcast:5 row_mask:0xf bank_mask:0xf\n\t" "v_fmac_f32_dpp %0, %4, %14 row_newbcast:6 row_mask:0xf bank_mask:0xf\n\t" "v_fmac_f32_dpp %1, %5, %14 row_newbcast:6 row_mask:0xf bank_mask:0xf\n\t" "v_fmac_f32_dpp %2, %6, %14 row_newbcast:6 row_mask:0xf bank_mask:0xf\n\t" "v_fmac_f32_dpp %3, %7, %14 row_newbcast:6 row_mask:0xf bank_mask:0xf\n\t" "v_fmac_f32_dpp %0, %4, %15 row_newbcast:7 row_mask:0xf bank_mask:0xf\n\t" "v_fmac_f32_dpp %1, %5, %15 row_newbcast:7 row_mask:0xf bank_mask:0xf\n\t" "v_fmac_f32_dpp %2, %6, %15 row_newbcast:7 row_mask:0xf bank_mask:0xf\n\t" "v_fmac_f32_dpp %3, %7, %15 row_newbcast:7 row_mask:0xf bank_mask:0xf\n\t" "v_fmac_f32_dpp %0, %4, %16 row_newbcast:8 row_mask:0xf bank_mask:0xf\n\t" "v_fmac_f32_dpp %1, %5, %16 row_newbcast:8 row_mask:0xf bank_mask:0xf\n\t" "v_fmac_f32_dpp %2, %6, %16 row_newbcast:8 row_mask:0xf bank_mask:0xf\n\t" "v_fmac_f32_dpp %3, %7, %16 row_newbcast:8 row_mask:0xf bank_mask:0xf\n\t" "v_fmac_f32_dpp %0, %4, %17 row_newbcast:9 row_mask:0xf bank_mask:0xf\n\t" "v_fmac_f32_dpp %1, %5, %17 row_newbcast:9 row_mask:0xf bank_mask:0xf\n\t" "v_fmac_f32_dpp %2, %6, %17 row_newbcast:9 row_mask:0xf bank_mask:0xf\n\t" "v_fmac_f32_dpp %3, %7, %17 row_newbcast:9 row_mask:0xf bank_mask:0xf\n\t" "v_fmac_f32_dpp %0, %4, %18 row_newbcast:10 row_mask:0xf bank_mask:0xf\n\t" "v_fmac_f32_dpp %1, %5, %18 row_newbcast:10 row_mask:0xf bank_mask:0xf\n\t" "v_fmac_f32_dpp %2, %6, %18 row_newbcast:10 row_mask:0xf bank_mask:0xf\n\t" "v_fmac_f32_dpp %3, %7, %18 row_newbcast:10 row_mask:0xf bank_mask:0xf\n\t" "v_fmac_f32_dpp %0, %4, %19 row_newbcast:11 row_mask:0xf bank_mask:0xf\n\t" "v_fmac_f32_dpp %1, %5, %19 row_newbcast:11 row_mask:0xf bank_mask:0xf\n\t" "v_fmac_f32_dpp %2, %6, %19 row_newbcast:11 row_mask:0xf bank_mask:0xf\n\t" "v_fmac_f32_dpp %3, %7, %19 row_newbcast:11 row_mask:0xf bank_mask:0xf\n\t" "v_fmac_f32_dpp %0, %4, %20 row_newbcast:12 row_mask:0xf bank_mask:0xf\n\t" "v_fmac_f32_dpp %1, %5, %20 row_newbcast:12 row_mask:0xf bank_mask:0xf\n\t" "v_fmac_f32_dpp %2, %6, %20 row_newbcast:12 row_mask:0xf bank_mask:0xf\n\t" "v_fmac_f32_dpp %3, %7, %20 row_newbcast:12 row_mask:0xf bank_mask:0xf\n\t" "v_fmac_f32_dpp %0, %4, %21 row_newbcast:13 row_mask:0xf bank_mask:0xf\n\t" "v_fmac_f32_dpp %1, %5, %21 row_newbcast:13 row_mask:0xf bank_mask:0xf\n\t" "v_fmac_f32_dpp %2, %6, %21 row_newbcast:13 row_mask:0xf bank_mask:0xf\n\t" "v_fmac_f32_dpp %3, %7, %21 row_newbcast:13 row_mask:0xf bank_mask:0xf\n\t" "v_fmac_f32_dpp %0, %4, %22 row_newbcast:14 row_mask:0xf bank_mask:0xf\n\t" "v_fmac_f32_dpp %1, %5, %22 row_newbcast:14 row_mask:0xf bank_mask:0xf\n\t" "v_fmac_f32_dpp %2, %6, %22 row_newbcast:14 row_mask:0xf bank_mask:0xf\n\t" "v_fmac_f32_dpp %3, %7, %22 row_newbcast:14 row_mask:0xf bank_mask:0xf\n\t" : "+v"(a0), "+v"(a1), "+v"(a2), "+v"(a3) : "v"(l0), "v"(l1), "v"(l2), "v"(l3), "v"(x0), "v"(x1), "v"(x2), "v"(x3), "v"(x4), "v"(x5), "v"(x6), "v"(x7), "v"(x8), "v"(x9), "v"(x10), "v"(x11), "v"(x12), "v"(x13), "v"(x14));
    }
};
template <> struct QuadChunk<16> {
    static __device__ __forceinline__ void run(float& a0, float& a1, float& a2, float& a3, float l0, float l1, float l2, float l3, float x0, float x1, float x2, float x3, float x4, float x5, float x6, float x7, float x8, float x9, float x10, float x11, float x12, float x13, float x14, float x15) {
        asm volatile("v_fmac_f32_dpp %0, %4, %8 row_newbcast:0 row_mask:0xf bank_mask:0xf\n\t" "v_fmac_f32_dpp %1, %5, %8 row_newbcast:0 row_mask:0xf bank_mask:0xf\n\t" "v_fmac_f32_dpp %2, %6, %8 row_newbcast:0 row_mask:0xf bank_mask:0xf\n\t" "v_fmac_f32_dpp %3, %7, %8 row_newbcast:0 row_mask:0xf bank_mask:0xf\n\t" "v_fmac_f32_dpp %0, %4, %9 row_newbcast:1 row_mask:0xf bank_mask:0xf\n\t" "v_fmac_f32_dpp %1, %5, %9 row_newbcast:1 row_mask:0xf bank_mask:0xf\n\t" "v_fmac_f32_dpp %2, %6, %9 row_newbcast:1 row_mask:0xf bank_mask:0xf\n\t" "v_fmac_f32_dpp %3, %7, %9 row_newbcast:1 row_mask:0xf bank_mask:0xf\n\t" "v_fmac_f32_dpp %0, %4, %10 row_newbcast:2 row_mask:0xf bank_mask:0xf\n\t" "v_fmac_f32_dpp %1, %5, %10 row_newbcast:2 row_mask:0xf bank_mask:0xf\n\t" "v_fmac_f32_dpp %2, %6, %10 row_newbcast:2 row_mask:0xf bank_mask:0xf\n\t" "v_fmac_f32_dpp %3, %7, %10 row_newbcast:2 row_mask:0xf bank_mask:0xf\n\t" "v_fmac_f32_dpp %0, %4, %11 row_newbcast:3 row_mask:0xf bank_mask:0xf\n\t" "v_fmac_f32_dpp %1, %5, %11 row_newbcast:3 row_mask:0xf bank_mask:0xf\n\t" "v_fmac_f32_dpp %2, %6, %11 row_newbcast:3 row_mask:0xf bank_mask:0xf\n\t" "v_fmac_f32_dpp %3, %7, %11 row_newbcast:3 row_mask:0xf bank_mask:0xf\n\t" "v_fmac_f32_dpp %0, %4, %12 row_newbcast:4 row_mask:0xf bank_mask:0xf\n\t" "v_fmac_f32_dpp %1, %5, %12 row_newbcast:4 row_mask:0xf bank_mask:0xf\n\t" "v_fmac_f32_dpp %2, %6, %12 row_newbcast:4 row_mask:0xf bank_mask:0xf\n\t" "v_fmac_f32_dpp %3, %7, %12 row_newbcast:4 row_mask:0xf bank_mask:0xf\n\t" "v_fmac_f32_dpp %0, %4, %13 row_newbcast:5 row_mask:0xf bank_mask:0xf\n\t" "v_fmac_f32_dpp %1, %5, %13 row_newbcast:5 row_mask:0xf bank_mask:0xf\n\t" "v_fmac_f32_dpp %2, %6, %13 row_newbcast:5 row_mask:0xf bank_mask:0xf\n\t" "v_fmac_f32_dpp %3, %7, %13 row_newbcast:5 row_mask:0xf bank_mask:0xf\n\t" "v_fmac_f32_dpp %0, %4, %14 row_newbcast:6 row_mask:0xf bank_mask:0xf\n\t" "v_fmac_f32_dpp %1, %5, %14 row_newbcast:6 row_mask:0xf bank_mask:0xf\n\t" "v_fmac_f32_dpp %2, %6, %14 row_newbcast:6 row_mask:0xf bank_mask:0xf\n\t" "v_fmac_f32_dpp %3, %7, %14 row_newbcast:6 row_mask:0xf bank_mask:0xf\n\t" "v_fmac_f32_dpp %0, %4, %15 row_newbcast:7 row_mask:0xf bank_mask:0xf\n\t" "v_fmac_f32_dpp %1, %5, %15 row_newbcast:7 row_mask:0xf bank_mask:0xf\n\t" "v_fmac_f32_dpp %2, %6, %15 row_newbcast:7 row_mask:0xf bank_mask:0xf\n\t" "v_fmac_f32_dpp %3, %7, %15 row_newbcast:7 row_mask:0xf bank_mask:0xf\n\t" "v_fmac_f32_dpp %0, %4, %16 row_newbcast:8 row_mask:0xf bank_mask:0xf\n\t" "v_fmac_f32_dpp %1, %5, %16 row_newbcast:8 row_mask:0xf bank_mask:0xf\n\t" "v_fmac_f32_dpp %2, %6, %16 row_newbcast:8 row_mask:0xf bank_mask:0xf\n\t" "v_fmac_f32_dpp %3, %7, %16 row_newbcast:8 row_mask:0xf bank_mask:0xf\n\t" "v_fmac_f32_dpp %0, %4, %17 row_newbcast:9 row_mask:0xf bank_mask:0xf\n\t" "v_fmac_f32_dpp %1, %5, %17 row_newbcast:9 row_mask:0xf bank_mask:0xf\n\t" "v_fmac_f32_dpp %2, %6, %17 row_newbcast:9 row_mask:0xf bank_mask:0xf\n\t" "v_fmac_f32_dpp %3, %7, %17 row_newbcast:9 row_mask:0xf bank_mask:0xf\n\t" "v_fmac_f32_dpp %0, %4, %18 row_newbcast:10 row_mask:0xf bank_mask:0xf\n\t" "v_fmac_f32_dpp %1, %5, %18 row_newbcast:10 row_mask:0xf bank_mask:0xf\n\t" "v_fmac_f32_dpp %2, %6, %18 row_newbcast:10 row_mask:0xf bank_mask:0xf\n\t" "v_fmac_f32_dpp %3, %7, %18 row_newbcast:10 row_mask:0xf bank_mask:0xf\n\t" "v_fmac_f32_dpp %0, %4, %19 row_newbcast:11 row_mask:0xf bank_mask:0xf\n\t" "v_fmac_f32_dpp %1, %5, %19 row_newbcast:11 row_mask:0xf bank_mask:0xf\n\t" "v_fmac_f32_dpp %2, %6, %19 row_newbcast:11 row_mask:0xf bank_mask:0xf\n\t" "v_fmac_f32_dpp %3, %7, %19 row_newbcast:11 row_mask:0xf bank_mask:0xf\n\t" "v_fmac_f32_dpp %0, %4, %20 row_newbcast:12 row_mask:0xf bank_mask:0xf\n\t" "v_fmac_f32_dpp %1, %5, %20 row_newbcast:12 row_mask:0xf bank_mask:0xf\n\t" "v_fmac_f32_dpp %2, %6, %20 row_newbcast:12 row_mask:0xf bank_mask:0xf\n\t" "v_fmac_f32_dpp %3, %7, %20 row_newbcast:12 row_mask:0xf bank_mask:0xf\n\t" "v_fmac_f32_dpp %0, %4, %21 row_newbcast:13 row_mask:0xf bank_mask:0xf\n\t" "v_fmac_f32_dpp %1, %5, %21 row_newbcast:13 row_mask:0xf bank_mask:0xf\n\t" "v_fmac_f32_dpp %2, %6, %21 row_newbcast:13 row_mask:0xf bank_mask:0xf\n\t" "v_fmac_f32_dpp %3, %7, %21 row_newbcast:13 row_mask:0xf bank_mask:0xf\n\t" "v_fmac_f32_dpp %0, %4, %22 row_newbcast:14 row_mask:0xf bank_mask:0xf\n\t" "v_fmac_f32_dpp %1, %5, %22 row_newbcast:14 row_mask:0xf bank_mask:0xf\n\t" "v_fmac_f32_dpp %2, %6, %22 row_newbcast:14 row_mask:0xf bank_mask:0xf\n\t" "v_fmac_f32_dpp %3, %7, %22 row_newbcast:14 row_mask:0xf bank_mask:0xf\n\t" "v_fmac_f32_dpp %0, %4, %23 row_newbcast:15 row_mask:0xf bank_mask:0xf\n\t" "v_fmac_f32_dpp %1, %5, %23 row_newbcast:15 row_mask:0xf bank_mask:0xf\n\t" "v_fmac_f32_dpp %2, %6, %23 row_newbcast:15 row_mask:0xf bank_mask:0xf\n\t" "v_fmac_f32_dpp %3, %7, %23 row_newbcast:15 row_mask:0xf bank_mask:0xf\n\t" : "+v"(a0), "+v"(a1), "+v"(a2), "+v"(a3) : "v"(l0), "v"(l1), "v"(l2), "v"(l3), "v"(x0), "v"(x1), "v"(x2), "v"(x3), "v"(x4), "v"(x5), "v"(x6), "v"(x7), "v"(x8), "v"(x9), "v"(x10), "v"(x11), "v"(x12), "v"(x13), "v"(x14), "v"(x15));
    }
};
template <int N, int B> struct QuadCall;
#define QC_DEF(N) template <int B> struct QuadCall<N, B> { static __device__ __forceinline__ void run(float (&x)[64], int I, float (&l)[4][4], int Q); };
#undef QC_DEF
#define QC_DEF(N) template <int B> struct QuadCallI { };
#undef QC_DEF
template <int N, int B, int I, int Q> struct QuadDo;
#define QD_DEF(N) template <int B, int I, int Q> struct QuadDo<N, B, I, Q> { static __device__ __forceinline__ void run(float (&x)[64], const float (&l)[4][4]) { QuadChunk<N>::run(x[I], x[I + 1], x[I + 2], x[I + 3], l[0][Q], l[1][Q], l[2][Q], l[3][Q], CC_ARGS##N(B)); } };
QD_DEF(1) QD_DEF(2) QD_DEF(3) QD_DEF(4) QD_DEF(5) QD_DEF(6) QD_DEF(7) QD_DEF(8) QD_DEF(9) QD_DEF(10) QD_DEF(11) QD_DEF(12) QD_DEF(13) QD_DEF(14) QD_DEF(15) QD_DEF(16)
#undef QD_DEF
template <int I, int Q> struct SolveQuadBlocks {
    static __device__ __forceinline__ void run(float (&x)[64], const float (&l)[4][4]) {
        if constexpr (Q > 0) SolveQuadBlocks<I, Q - 1>::run(x, l);
        constexpr int n = (I - 16 * Q) < 16 ? (I - 16 * Q) : 16;
        QuadDo<n, 16 * Q, I, Q>::run(x, l);
    }
};
template <int I> struct SolveRows {
    static __device__ __forceinline__ void run(float (&x)[64], const LAS float* Ls, int l15) {
        if constexpr (I > 0) SolveRows<I - 4>::run(x, Ls, l15);
        float l[4][4];
#pragma unroll
        for (int r = 0; r < 4; ++r)
#pragma unroll
            for (int q = 0; q < 4; ++q) l[r][q] = (16 * q < I + 3) ? Ls[(I + r) * 68 + 16 * q + l15] : 0.f;
        if constexpr (I > 0) SolveQuadBlocks<I, (I - 1) / 16>::run(x, l);
        constexpr int QB = I >> 4, L0 = I & 15;
        fmac_bcast<L0>(x[I + 1], l[1][QB], x[I]);
        fmac_bcast<L0>(x[I + 2], l[2][QB], x[I]); fmac_bcast<L0>(x[I + 3], l[3][QB], x[I]);
        fmac_bcast<L0 + 1>(x[I + 2], l[2][QB], x[I + 1]); fmac_bcast<L0 + 1>(x[I + 3], l[3][QB], x[I + 1]);
        fmac_bcast<L0 + 2>(x[I + 3], l[3][QB], x[I + 2]);
        if ((I & 7) == 4) asm volatile("" ::: "memory");
    }
};

#define XB_TMO      128
#define XB_XCNT(j)  (256  + 64 * (j))
#define XB_XSUB(j)  (1280 + 64 * (j))
#define XB_XGEN(j)  (2304 + 64 * (j))
#define XB_TOP      3328
#define XB_TOPGEN   3392
#define XCD_BAR_WORDS 3456
#define XB_SPIN_CAP (1u << 18)
__device__ __forceinline__ unsigned xb_ld(unsigned* p)              { return __hip_atomic_load(p, __ATOMIC_RELAXED, __HIP_MEMORY_SCOPE_AGENT); }
__device__ __forceinline__ unsigned xb_add(unsigned* p, unsigned v) { return __hip_atomic_fetch_add(p, v, __ATOMIC_RELAXED, __HIP_MEMORY_SCOPE_AGENT); }
__device__ __forceinline__ unsigned xb_xcc_id() { return (unsigned)__builtin_amdgcn_s_getreg((3 << 11) | 20) & 0xFu; }
#define XB_SPIN(cond, bar) do { unsigned _sp = 0; while (cond) { __builtin_amdgcn_s_sleep(1); \
    if ((++_sp & 255u) == 0u) { if (xb_ld(&(bar)[XB_TMO])) break; if (_sp > XB_SPIN_CAP) { atomicAdd(&(bar)[XB_TMO], 1u); break; } } } } while (0)
struct XcdBarrier { unsigned* bar; unsigned x; volatile LAS unsigned* st; };
__device__ __forceinline__ XcdBarrier xcd_barrier_post(unsigned* bar, volatile LAS unsigned* st) {
    XcdBarrier b; b.bar = bar; b.x = xb_xcc_id(); b.st = st;
    if (threadIdx.x == 0) (void)xb_add(&bar[XB_XCNT(b.x)], 1u);
    return b;
}
__device__ __forceinline__ void xcd_barrier_complete(unsigned* bar, unsigned x, unsigned& nloc, unsigned& nx) {
    const unsigned G = gridDim.x * gridDim.y * gridDim.z;
    unsigned sum, cnt, mine, sp = 0u;
    for (;;) {
        sum = 0u; cnt = 0u; mine = 0u;
#pragma unroll
        for (unsigned j = 0; j < 16; ++j) { const unsigned c = xb_ld(&bar[XB_XCNT(j)]); sum += c; cnt += (c > 0u) ? 1u : 0u; mine = (j == x) ? c : mine; }
        if (sum == G) break;
        __builtin_amdgcn_s_sleep(1);
        if ((++sp & 255u) == 0u) { if (xb_ld(&bar[XB_TMO])) break; if (sp > XB_SPIN_CAP) { atomicAdd(&bar[XB_TMO], 1u); break; } }
    }
    nloc = mine > 0u ? mine : 1u; nx = cnt > 0u ? cnt : 1u;
}
__device__ __forceinline__ void xcd_barrier(const XcdBarrier& b) {
    asm volatile("s_waitcnt vmcnt(0)" ::: "memory");
    __syncthreads();
    if (threadIdx.x == 0) {
        unsigned* bar = b.bar;
        __builtin_amdgcn_s_waitcnt(0);
        unsigned nloc = b.st[0], nx = b.st[1];
        if (nloc == 0u) { xcd_barrier_complete(bar, b.x, nloc, nx); b.st[0] = nloc; b.st[1] = nx; }
        const unsigned old = xb_add(&bar[XB_XSUB(b.x)], 1u);
        const unsigned gen = old / nloc;
        if (old + 1u == (gen + 1u) * nloc) {
            __builtin_amdgcn_fence(__ATOMIC_RELEASE, "agent");
            asm volatile("s_waitcnt vmcnt(0)" ::: "memory");
            const unsigned og = xb_add(&bar[XB_TOP], 1u);
            const unsigned tg = og / nx;
            if (og + 1u == (tg + 1u) * nx) xb_add(&bar[XB_TOPGEN], 1u);
            else XB_SPIN(xb_ld(&bar[XB_TOPGEN]) == tg, bar);
            __builtin_amdgcn_fence(__ATOMIC_ACQUIRE, "agent");
            xb_add(&bar[XB_XGEN(b.x)], 1u);
            asm volatile("s_waitcnt vmcnt(0)" ::: "memory");
        } else {
            XB_SPIN(xb_ld(&bar[XB_XGEN(b.x)]) == gen, bar);
            __builtin_amdgcn_fence(__ATOMIC_ACQUIRE, "agent");
            asm volatile("s_waitcnt vmcnt(0)" ::: "memory");
        }
    }
    __syncthreads();
}

struct Frame {
    LAS unsigned char* lds;
    volatile LAS unsigned* MISC;
    unsigned* ctl;
    int tid, lane, wave, vcu, G;
    const float* in[25]; float* out; unsigned char* ws;
};
enum { I_X = 0, I_P, I_NORM_MIX, I_W_IN, I_POOL_W, I_POOL_SCALE, I_CONV_W, I_A_LOG, I_DT_BIAS, I_DN_NORM, I_W_UP_POOL, I_W_UP_DN, I_W_OUT, I_NORM_MOE,
       I_W_RG, I_B_RG, I_W_RE, I_B_RE, I_W_GATE, I_W_UP, I_W_DOWN, I_NORM_PLE, I_W_PLE_GATE, I_W_PLE_PROJ, I_NORM_FINAL };

struct Unit { int pn, e, arow0, nrows, lrow0; };
template <int RB> struct DenseSched {
    int nM, nN, G, c, K;
    __device__ __forceinline__ void init(int M, int N, int K_, int G_, int c_) { nM = M / RB; nN = N / 256; G = G_; c = c_; K = K_; }
    __device__ __forceinline__ bool next(int i, Unit& u) const {
        const long L = (long)i * G + c; if (L >= (long)nM * nN) return false;
        const int pm = (int)(L / nN); u.pn = (int)(L % nN); u.e = 0; u.arow0 = pm * RB; u.nrows = RB; u.lrow0 = 0; return true;
    }
    __device__ __forceinline__ int arow(const Unit& u, int r) const { return u.arow0 + r; }
    __device__ __forceinline__ size_t boff(const Unit& u) const { return (size_t)u.pn * 256 * K; }
};
template <int RB, bool GATHER> struct MoeSched {
    const LAS int* pre; const LAS int* base; const int* ltk; int nN, G, c, K, Nfull;
    __device__ __forceinline__ bool next(int i, Unit& u) const {
        const long L = (long)i * G + c; if (L >= (long)pre[NE] * nN) return false;
        const int blk = (int)(L / nN); u.pn = (int)(L % nN);
        int e = 0;
        for (int j = 1; j < NE; ++j) if (pre[j] <= blk) e = j;
        const int rb = blk - pre[e]; const int cnt = base[e + 1] - base[e];
        const int nr = (cnt - rb * RB) < RB ? (cnt - rb * RB) : RB;
        u.e = __builtin_amdgcn_readfirstlane(e); u.lrow0 = __builtin_amdgcn_readfirstlane(rb * RB); u.arow0 = __builtin_amdgcn_readfirstlane(base[e] + rb * RB); u.nrows = __builtin_amdgcn_readfirstlane(nr);
        u.pn = __builtin_amdgcn_readfirstlane(u.pn); return true;
    }
    __device__ __forceinline__ int arow(const Unit& u, int r) const {
        const int rr = r < u.nrows ? r : u.nrows - 1;
        if (GATHER) return ltk[(size_t)u.e * T + u.lrow0 + rr] >> 1;
        return u.arow0 + rr;
    }
    __device__ __forceinline__ size_t boff(const Unit& u) const { return ((size_t)u.e * Nfull + (size_t)u.pn * 256) * K; }
};
template <int RB> __device__ __forceinline__ void moe_tables(Frame& F, LAS int* pre, LAS int* base) {
    __syncthreads();
    if (F.tid == 0) { int p = 0, b = 0; for (int e = 0; e < NE; ++e) { const int c = (int)F.ctl[CW_CNT + 64 * e]; pre[e] = p; base[e] = b; p += (c + RB - 1) / RB; b += c; } pre[NE] = p; base[NE] = b; }
    __syncthreads();
}

constexpr int SG_RB = 64, SG_BK = 32, SG_ALD = 68, SG_BLD = 260;
template <class Epi, class Sched>
__device__ __forceinline__ void sgemm_phase(Frame& F, const bf16* A, const bf16* Bt, int K, const Sched& S, const Epi& E) {
    LAS float* As = (LAS float*)(F.lds + RING_OFF);
    LAS float* Bs = As + SG_BK * SG_ALD;
    const int tid = F.tid, rg = tid >> 4, cg = tid & 15;
    const int la = tid >> 3, kq = (tid & 7) * 4;
    const int nb = tid >> 1, kh = (tid & 1) * 16;
    for (int i = 0;; ++i) {
        Unit u; if (!S.next(i, u)) break;
        const bf16* ap = A + (size_t)S.arow(u, la) * K + kq;
        const bf16* bp = Bt + S.boff(u) + (size_t)nb * K + kh;
        float acc[2][16];
#pragma unroll
        for (int a = 0; a < 2; ++a)
#pragma unroll
            for (int b = 0; b < 16; ++b) acc[a][b] = 0.f;
        for (int k0 = 0; k0 < K; k0 += SG_BK) {
            const v2u av = *(const v2u*)(ap + k0);
            const v4u b0 = *(const v4u*)(bp + k0), b1 = *(const v4u*)(bp + k0 + 8);
            __syncthreads();
            As[(kq + 0) * SG_ALD + la] = bflo(av.x); As[(kq + 1) * SG_ALD + la] = bfhi(av.x); As[(kq + 2) * SG_ALD + la] = bflo(av.y); As[(kq + 3) * SG_ALD + la] = bfhi(av.y);
            Bs[(kh + 0) * SG_BLD + nb] = bflo(b0.x); Bs[(kh + 1) * SG_BLD + nb] = bfhi(b0.x); Bs[(kh + 2) * SG_BLD + nb] = bflo(b0.y); Bs[(kh + 3) * SG_BLD + nb] = bfhi(b0.y);
            Bs[(kh + 4) * SG_BLD + nb] = bflo(b0.z); Bs[(kh + 5) * SG_BLD + nb] = bfhi(b0.z); Bs[(kh + 6) * SG_BLD + nb] = bflo(b0.w); Bs[(kh + 7) * SG_BLD + nb] = bfhi(b0.w);
            Bs[(kh + 8) * SG_BLD + nb] = bflo(b1.x); Bs[(kh + 9) * SG_BLD + nb] = bfhi(b1.x); Bs[(kh + 10) * SG_BLD + nb] = bflo(b1.y); Bs[(kh + 11) * SG_BLD + nb] = bfhi(b1.y);
            Bs[(kh + 12) * SG_BLD + nb] = bflo(b1.z); Bs[(kh + 13) * SG_BLD + nb] = bfhi(b1.z); Bs[(kh + 14) * SG_BLD + nb] = bflo(b1.w); Bs[(kh + 15) * SG_BLD + nb] = bfhi(b1.w);
            __syncthreads();
#pragma unroll 8
            for (int kk = 0; kk < SG_BK; ++kk) {
                const float a0 = As[kk * SG_ALD + rg], a1 = As[kk * SG_ALD + rg + 32];
                const f32x4 p0 = *(const LAS f32x4*)(Bs + kk * SG_BLD + 8 * cg), p1 = *(const LAS f32x4*)(Bs + kk * SG_BLD + 8 * cg + 4);
                const f32x4 p2 = *(const LAS f32x4*)(Bs + kk * SG_BLD + 128 + 8 * cg), p3 = *(const LAS f32x4*)(Bs + kk * SG_BLD + 128 + 8 * cg + 4);
#pragma unroll
                for (int j = 0; j < 4; ++j) {
                    acc[0][j] += a0 * p0[j]; acc[0][4 + j] += a0 * p1[j]; acc[0][8 + j] += a0 * p2[j]; acc[0][12 + j] += a0 * p3[j];
                    acc[1][j] += a1 * p0[j]; acc[1][4 + j] += a1 * p1[j]; acc[1][8 + j] += a1 * p2[j]; acc[1][12 + j] += a1 * p3[j];
                }
            }
        }
#pragma unroll
        for (int a = 0; a < 2; ++a) { const int r = rg + 32 * a; if (r < u.nrows) E.store(u, r, 8 * cg, &acc[a][0], &acc[a][8]); }
    }
    __syncthreads();
}


namespace pg8 {
constexpr int BM = 256, BK = 64, HALF = 128, HTB = HALF * BK * 2, STAGE_BYTES = 8 * HTB, NXCD = 8, WGM = 8;
__host__ __device__ __forceinline__ int lds_byte(int r, int c) { const int st = (r >> 4) * 2 + (c >> 5), rr = r & 15, cc = c & 31, ob = rr * 64 + cc * 2; return st * 1024 + (ob ^ (((ob >> 9) & 1) << 5)); }
__host__ __device__ __forceinline__ void stage_rc(int b, int& R, int& C) { const int st = b / 1024, sb = b % 1024, swz = sb ^ (((sb >> 9) & 1) << 5); R = (st >> 1) * 16 + swz / 64; C = (st & 1) * 32 + (swz % 64) / 2; }
__host__ __device__ __forceinline__ int perm32(int rho) { const int n = rho >> 4, i = rho & 15; return 8 * (i >> 2) + 4 * n + (i & 3); }

struct DenseOrder {
    int nM, nN, nwg, G, c, K;
    __device__ __forceinline__ void init(int M, int N, int K_, int G_, int c_) { nM = M / BM; nN = N / BM; nwg = nM * nN; G = G_; c = c_; K = K_; }
    __device__ __forceinline__ bool next(int i, Unit& u) const {
        const long L = (long)i * G + c; if (L >= nwg) return false;
        int wgid = (int)L; { const int q = nwg / NXCD, r = nwg % NXCD, xcd = wgid % NXCD, off = wgid / NXCD; wgid = (xcd < r ? xcd * (q + 1) : r * (q + 1) + (xcd - r) * q) + off; }
        const int nig = WGM * nN, gid = wgid / nig, fm = gid * WGM, gsz = (nM - fm) < WGM ? (nM - fm) : WGM;
        u.pn = (wgid % nig) / gsz; u.e = 0; u.arow0 = (fm + ((wgid % nig) % gsz)) * BM; u.nrows = BM; u.lrow0 = 0; return true;
    }
    __device__ __forceinline__ int arow(const Unit& u, int r) const { return u.arow0 + r; }
    __device__ __forceinline__ size_t boff(const Unit& u) const { return (size_t)u.pn * 256 * K; }
};

template <class Epi, class Sched, bool GATHER, bool ALIGN_EPI = true, bool SP2 = true>
__device__ __forceinline__ void gemm_phase(LAS unsigned char* lds, const bf16* Ag, const bf16* Btg, const int K, const Sched& S, const Epi& E) {
    const int tid = threadIdx.x, wid = __builtin_amdgcn_readfirstlane(tid >> 6), lane = tid & 63, wr = wid >> 2, wc = wid & 3, fr = lane & 15, fq = lane >> 4;
    const int nt = K / BK;
    unsigned voffA[2], voffB[2]; int RA[2], CA[2];
#pragma unroll
    for (int i = 0; i < 2; ++i) { int R, C; stage_rc(tid * 16 + i * 8192, R, C); const int Rb = (R & ~31) + perm32(R & 31);
        voffA[i] = (unsigned)(R * K + C) * 2u; voffB[i] = (unsigned)(Rb * K + C) * 2u; RA[i] = R; CA[i] = C; }
    const size_t kstep = (size_t)(BK * 2);
    const size_t hstep = (size_t)HALF * K * 2;
    const unsigned ldsw = (unsigned)wid * 1024u;
    const int aoff = lds_byte(wr * 64 + fr, fq * 8), boff = lds_byte(wc * 32 + fr, fq * 8);
#define PG8_SA(b, h) (((b) * 2 + (h)) * HTB)
#define PG8_SB(b, h) ((4 + (b) * 2 + (h)) * HTB)
#define PG8_STAGE(bufoff, gbase, voff) do { _Pragma("unroll") for (int _i = 0; _i < 2; ++_i) \
        __builtin_amdgcn_global_load_lds((const unsigned*)((const char*)(gbase) + (voff)[_i]), (LAS unsigned*)(lds + (bufoff) + ldsw + _i * 8192), 16, 0, 0); } while (0)
#define PG8_STAGE_A(bufoff, base, vg, h, ko) do { if (GATHER) { PG8_STAGE(bufoff, (const char*)Ag + (ko), vg[h]); } else { PG8_STAGE(bufoff, (base) + (h) * hstep + (ko), voffA); } } while (0)
#define PG8_LDA(dst, b, h) do { _Pragma("unroll") for (int m = 0; m < 4; ++m) _Pragma("unroll") for (int k = 0; k < 2; ++k) dst[m][k] = *(const LAS bf16x8*)(lds + PG8_SA(b, h) + aoff + m * 2048 + k * 1024); } while (0)
#define PG8_LDB(dst, b, h) do { _Pragma("unroll") for (int n = 0; n < 2; ++n) _Pragma("unroll") for (int k = 0; k < 2; ++k) dst[n][k] = *(const LAS bf16x8*)(lds + PG8_SB(b, h) + boff + n * 2048 + k * 1024); } while (0)
#define PG8_MMA(ai, bj, At, Bt) do { __builtin_amdgcn_s_setprio(1); _Pragma("unroll") for (int m = 0; m < 4; ++m) _Pragma("unroll") for (int n = 0; n < 2; ++n) _Pragma("unroll") for (int k = 0; k < 2; ++k) \
        acc[ai][bj][m][n] = __builtin_amdgcn_mfma_f32_16x16x32_bf16(Bt[n][k], At[m][k], acc[ai][bj][m][n], 0, 0, 0); __builtin_amdgcn_s_setprio(0); } while (0)
#define PG8_WAIT_V(n) asm volatile("s_waitcnt vmcnt(" #n ")" ::: "memory")
#define PG8_WAIT_L(n) asm volatile("s_waitcnt lgkmcnt(" #n ")" ::: "memory")
#define PG8_BAR __builtin_amdgcn_s_barrier()
#define PG8_SCHED __builtin_amdgcn_sched_barrier(0)
#define PG8_ROWOFFS(dst, un) do { _Pragma("unroll") for (int _h = 0; _h < 2; ++_h) _Pragma("unroll") for (int _i = 0; _i < 2; ++_i) \
        dst[_h][_i] = ((unsigned)S.arow(un, _h * HALF + RA[_i]) * (unsigned)K + (unsigned)CA[_i]) * 2u; } while (0)
    Unit cur, nxt; int ui = 0;
    if (!S.next(0, cur)) return;
    f32x4 acc[2][2][4][2];
#pragma unroll
    for (int a = 0; a < 2; ++a)
#pragma unroll
        for (int b = 0; b < 2; ++b)
#pragma unroll
            for (int m = 0; m < 4; ++m)
#pragma unroll
                for (int n = 0; n < 2; ++n) acc[a][b][m][n] = (f32x4){0.f, 0.f, 0.f, 0.f};
    bf16x8 At[4][2], B0[2][2], B1[2][2];
    unsigned vc[2][2], vn[2][2];
    if (GATHER) { PG8_ROWOFFS(vc, cur); }
    const char* cA = GATHER ? (const char*)Ag : (const char*)Ag + (size_t)cur.arow0 * K * 2; const char* cB = (const char*)Btg + S.boff(cur) * 2;
    if constexpr (SP2) {
        PG8_STAGE(PG8_SB(0, 0), cB, voffB); PG8_STAGE(PG8_SB(0, 1), cB + hstep, voffB); PG8_STAGE_A(PG8_SA(0, 0), cA, vc, 0, 0); PG8_STAGE_A(PG8_SA(0, 1), cA, vc, 1, 0);
        if (wr == 1) PG8_BAR;
        PG8_WAIT_V(2); PG8_BAR;
        PG8_STAGE(PG8_SB(1, 0), cB + kstep, voffB); PG8_STAGE_A(PG8_SA(1, 0), cA, vc, 0, kstep); PG8_STAGE(PG8_SB(1, 1), cB + hstep + kstep, voffB);
        PG8_WAIT_V(6); PG8_BAR;
    } else {
        PG8_STAGE(PG8_SB(0, 0), cB, voffB); PG8_STAGE_A(PG8_SA(0, 0), cA, vc, 0, 0); PG8_STAGE(PG8_SB(0, 1), cB + hstep, voffB); PG8_STAGE_A(PG8_SA(0, 1), cA, vc, 1, 0);
        if (wr == 1) PG8_BAR;
        PG8_WAIT_V(4); PG8_BAR;
        PG8_STAGE(PG8_SB(1, 0), cB + kstep, voffB); PG8_STAGE_A(PG8_SA(1, 0), cA, vc, 0, kstep); PG8_STAGE(PG8_SB(1, 1), cB + hstep + kstep, voffB);
        PG8_WAIT_V(6); PG8_BAR;
    }
    for (;;) {
        const bool has_next = S.next(ui + 1, nxt);
        const char* nA = GATHER ? cA : (has_next ? (const char*)Ag + (size_t)nxt.arow0 * K * 2 : cA); const char* nB = has_next ? (const char*)Btg + S.boff(nxt) * 2 : cB;
        if (GATHER) { if (has_next) { PG8_ROWOFFS(vn, nxt); } else {
#pragma unroll
            for (int _h = 0; _h < 2; ++_h)
#pragma unroll
                for (int _i = 0; _i < 2; ++_i) vn[_h][_i] = vc[_h][_i]; } }
#pragma unroll 1
        for (int t = 0; t < nt; t += 2) {
            const bool last = (t == nt - 2);
            const size_t k1 = (size_t)(t + 1) * kstep;
            const size_t k2 = last ? 0 : (size_t)(t + 2) * kstep, k3 = k2 + kstep;
            const char* a2 = last ? nA : cA; const char* b2 = (last ? nB : cB) + k2; const char* b3 = b2 + kstep;
            unsigned v2[2][2];
#pragma unroll
            for (int _h = 0; _h < 2; ++_h)
#pragma unroll
                for (int _i = 0; _i < 2; ++_i) v2[_h][_i] = last ? vn[_h][_i] : vc[_h][_i];
            if constexpr (SP2) {
            PG8_LDB(B0, 0, 0); PG8_LDB(B1, 0, 1); PG8_SCHED; PG8_LDA(At, 0, 0); PG8_STAGE_A(PG8_SA(1, 1), cA, vc, 1, k1);
            PG8_WAIT_V(8); PG8_WAIT_L(0); PG8_BAR; PG8_MMA(0, 0, At, B0); PG8_MMA(0, 1, At, B1); PG8_BAR; PG8_SCHED;
            PG8_LDA(At, 0, 1); PG8_STAGE(PG8_SB(0, 0), b2, voffB); PG8_STAGE(PG8_SB(0, 1), b2 + hstep, voffB); PG8_STAGE_A(PG8_SA(0, 0), a2, v2, 0, k2);
            PG8_WAIT_V(8); PG8_WAIT_L(0); PG8_BAR; PG8_MMA(1, 0, At, B0); PG8_MMA(1, 1, At, B1); PG8_BAR; PG8_SCHED;
            PG8_LDB(B0, 1, 0); PG8_LDB(B1, 1, 1); PG8_SCHED; PG8_LDA(At, 1, 0); PG8_STAGE_A(PG8_SA(0, 1), a2, v2, 1, k2);
            PG8_WAIT_V(8); PG8_WAIT_L(0); PG8_BAR; PG8_MMA(0, 0, At, B0); PG8_MMA(0, 1, At, B1); PG8_BAR; PG8_SCHED;
            PG8_LDA(At, 1, 1); PG8_STAGE(PG8_SB(1, 0), b3, voffB); PG8_STAGE(PG8_SB(1, 1), b3 + hstep, voffB); PG8_STAGE_A(PG8_SA(1, 0), a2, v2, 0, k3);
            PG8_WAIT_V(8); PG8_WAIT_L(0); PG8_BAR; PG8_MMA(1, 0, At, B0); PG8_MMA(1, 1, At, B1); PG8_BAR; PG8_SCHED;
            } else {
            PG8_LDB(B0, 0, 0); PG8_SCHED; PG8_LDA(At, 0, 0); PG8_STAGE_A(PG8_SA(1, 1), cA, vc, 1, k1);
            PG8_WAIT_L(8); PG8_BAR; PG8_WAIT_L(0); PG8_MMA(0, 0, At, B0); PG8_BAR; PG8_SCHED;
            PG8_LDB(B1, 0, 1); PG8_STAGE(PG8_SB(0, 0), b2, voffB);
            PG8_BAR; PG8_WAIT_L(0); PG8_MMA(0, 1, At, B1); PG8_BAR;
            PG8_LDA(At, 0, 1); PG8_STAGE_A(PG8_SA(0, 0), a2, v2, 0, k2);
            PG8_BAR; PG8_WAIT_L(0); PG8_MMA(1, 0, At, B0); PG8_BAR; PG8_SCHED;
            PG8_STAGE(PG8_SB(0, 1), b2 + hstep, voffB);
            PG8_WAIT_V(6); PG8_BAR; PG8_MMA(1, 1, At, B1); PG8_BAR;
            PG8_LDB(B0, 1, 0); PG8_SCHED; PG8_LDA(At, 1, 0); PG8_STAGE_A(PG8_SA(0, 1), a2, v2, 1, k2);
            PG8_WAIT_L(8); PG8_BAR; PG8_WAIT_L(0); PG8_MMA(0, 0, At, B0); PG8_BAR; PG8_SCHED;
            PG8_LDB(B1, 1, 1); PG8_STAGE(PG8_SB(1, 0), b3, voffB);
            PG8_BAR; PG8_WAIT_L(0); PG8_MMA(0, 1, At, B1); PG8_BAR;
            PG8_LDA(At, 1, 1); PG8_STAGE_A(PG8_SA(1, 0), a2, v2, 0, k3);
            PG8_BAR; PG8_WAIT_L(0); PG8_MMA(1, 0, At, B0); PG8_BAR; PG8_SCHED;
            PG8_STAGE(PG8_SB(1, 1), b3 + hstep, voffB);
            PG8_WAIT_V(6); PG8_BAR; PG8_MMA(1, 1, At, B1); PG8_BAR;
            }
        }
        if constexpr (ALIGN_EPI) { if (wr == 0) PG8_BAR; }
        {
#pragma unroll
            for (int ai = 0; ai < 2; ++ai)
#pragma unroll
                for (int m = 0; m < 4; ++m) { const int r = ai * HALF + wr * 64 + m * 16 + fr;
                    if (r < cur.nrows) { float v0[8], v1[8];
#pragma unroll
                        for (int i = 0; i < 4; ++i) { v0[i] = acc[ai][0][m][0][i]; v0[4 + i] = acc[ai][0][m][1][i]; v1[i] = acc[ai][1][m][0][i]; v1[4 + i] = acc[ai][1][m][1][i]; }
                        E.store(cur, r, wc * 32 + 8 * fq, v0, v1); }
                    if (Epi::FENCE && (m & 1)) asm volatile("" ::: "memory"); }
        }
        if (!has_next) break;
#pragma unroll
        for (int a = 0; a < 2; ++a)
#pragma unroll
            for (int b = 0; b < 2; ++b)
#pragma unroll
                for (int m = 0; m < 4; ++m)
#pragma unroll
                    for (int n = 0; n < 2; ++n) acc[a][b][m][n] = (f32x4){0.f, 0.f, 0.f, 0.f};
        cur = nxt; cA = nA; cB = nB; ++ui;
        if (GATHER) {
#pragma unroll
            for (int _h = 0; _h < 2; ++_h)
#pragma unroll
                for (int _i = 0; _i < 2; ++_i) vc[_h][_i] = vn[_h][_i]; }
        if constexpr (ALIGN_EPI) { if (wr == 1) PG8_BAR; }
    }
    PG8_WAIT_V(0);
    if constexpr (!ALIGN_EPI) { if (wr == 0) PG8_BAR; }
    PG8_BAR;
#undef PG8_SA
#undef PG8_SB
#undef PG8_STAGE
#undef PG8_STAGE_A
#undef PG8_LDA
#undef PG8_LDB
#undef PG8_MMA
#undef PG8_WAIT_V
#undef PG8_WAIT_L
#undef PG8_BAR
#undef PG8_SCHED
#undef PG8_ROWOFFS
}
}

struct EpiInProj { static constexpr bool FENCE = false;
    bf16 *upool, *qkv, *z, *gp, *gd; float* ba;
    __device__ __forceinline__ void store(const Unit& u, int r, int cit, const float* v0, const float* v1) const {
        const size_t row = (size_t)(u.arow0 + r); const int pn = u.pn;
        if (pn < 4) { bf16* p = upool + row * D_POOL + pn * 256 + cit; store8bf(p, v0); store8bf(p + 128, v1); }
        else if (pn < 16) { bf16* p = qkv + row * D_QKV + (pn - 4) * 256 + cit; store8bf(p, v0); store8bf(p + 128, v1); }
        else if (pn < 20) { float a[8], b[8];
#pragma unroll
            for (int i = 0; i < 8; ++i) { a[i] = siluf_(v0[i]); b[i] = siluf_(v1[i]); }
            bf16* p = z + row * D_Z + (pn - 16) * 256 + cit; store8bf(p, a); store8bf(p + 128, b); }
        else if (pn < 36) { float a[8], b[8];
#pragma unroll
            for (int i = 0; i < 8; ++i) { a[i] = sigmoidf_(v0[i]); b[i] = sigmoidf_(v1[i]); }
            bf16* p = (pn < 28 ? gp + row * D + (pn - 20) * 256 : gd + row * D + (pn - 28) * 256) + cit; store8bf(p, a); store8bf(p + 128, b); }
    }
};
struct EpiPool { static constexpr bool FENCE = false;
    const bf16* gp; bf16* mp;
    __device__ __forceinline__ void store(const Unit& u, int r, int cit, const float* v0, const float* v1) const {
        const size_t off = (size_t)(u.arow0 + r) * D + u.pn * 256 + cit; float g0[8], g1[8], a[8], b[8]; load8bf(gp + off, g0); load8bf(gp + off + 128, g1);
#pragma unroll
        for (int i = 0; i < 8; ++i) { a[i] = g0[i] * v0[i]; b[i] = g1[i] * v1[i]; }
        store8bf(mp + off, a); store8bf(mp + off + 128, b);
    }
};
struct EpiMerge { static constexpr bool FENCE = false;
    const bf16* gd; const bf16* mp; bf16* mg;
    __device__ __forceinline__ void store(const Unit& u, int r, int cit, const float* v0, const float* v1) const {
        const size_t off = (size_t)(u.arow0 + r) * D + u.pn * 256 + cit; float g0[8], g1[8], m0[8], m1[8]; load8bf(gd + off, g0); load8bf(gd + off + 128, g1); load8bf(mp + off, m0); load8bf(mp + off + 128, m1);
#pragma unroll
        for (int i = 0; i < 8; ++i) { m0[i] += g0[i] * v0[i]; m1[i] += g1[i] * v1[i]; }
        store8bf(mg + off, m0); store8bf(mg + off + 128, m1);
    }
};
struct EpiResid { static constexpr bool FENCE = false;
    const float* x; float* h;
    __device__ __forceinline__ void store(const Unit& u, int r, int cit, const float* v0, const float* v1) const {
        const size_t off = (size_t)(u.arow0 + r) * D + u.pn * 256 + cit;
#pragma unroll
        for (int q = 0; q < 2; ++q) { const f32x4 a = *(const f32x4*)(x + off + 4 * q), b = *(const f32x4*)(x + off + 128 + 4 * q);
            *(f32x4*)(h + off + 4 * q) = (f32x4){a[0] + v0[4 * q], a[1] + v0[4 * q + 1], a[2] + v0[4 * q + 2], a[3] + v0[4 * q + 3]};
            *(f32x4*)(h + off + 128 + 4 * q) = (f32x4){b[0] + v1[4 * q], b[1] + v1[4 * q + 1], b[2] + v1[4 * q + 2], b[3] + v1[4 * q + 3]}; }
    }
};
struct EpiMoe1 { static constexpr bool FENCE = false;
    bf16* hmid;
    __device__ __forceinline__ void store(const Unit& u, int r, int cit, const float* v0, const float* v1) const {
        float a[8];
#pragma unroll
        for (int i = 0; i < 8; ++i) a[i] = siluf_(v0[i]) * v1[i];
        store8bf(hmid + (size_t)(u.arow0 + r) * DE + u.pn * 128 + cit, a);
    }
};
struct EpiMoe2 { static constexpr bool FENCE = true;
    const int* ltk; const float* lw; bf16 *y0, *y1;
    __device__ __forceinline__ void store(const Unit& u, int r, int cit, const float* v0, const float* v1) const {
        const size_t li = (size_t)u.e * T + u.lrow0 + r; const int tk = ltk[li]; const float w = lw[li];
        bf16* y = ((tk & 1) ? y1 : y0) + (size_t)(tk >> 1) * D + u.pn * 256 + cit; float a[8], b[8];
#pragma unroll
        for (int i = 0; i < 8; ++i) { a[i] = w * v0[i]; b[i] = w * v1[i]; }
        store8bf(y, a); store8bf(y + 128, b);
    }
};
struct EpiBf16Plain { static constexpr bool FENCE = false;
    bf16* o;
    __device__ __forceinline__ void store(const Unit& u, int r, int cit, const float* v0, const float* v1) const {
        bf16* p = o + (size_t)(u.arow0 + r) * D + u.pn * 256 + cit; store8bf(p, v0); store8bf(p + 128, v1);
    }
};
struct EpiPle { static constexpr bool FENCE = false;
    const bf16* pp; float* h;
    __device__ __forceinline__ void store(const Unit& u, int r, int cit, const float* v0, const float* v1) const {
        const size_t off = (size_t)(u.arow0 + r) * D + u.pn * 256 + cit; float p0[8], p1[8]; load8bf(pp + off, p0); load8bf(pp + off + 128, p1);
#pragma unroll
        for (int q = 0; q < 2; ++q) { const f32x4 a = *(const f32x4*)(h + off + 4 * q), b = *(const f32x4*)(h + off + 128 + 4 * q); f32x4 oa, ob;
#pragma unroll
            for (int i = 0; i < 4; ++i) { oa[i] = a[i] + sigmoidf_(v0[4 * q + i]) * p0[4 * q + i]; ob[i] = b[i] + sigmoidf_(v1[4 * q + i]) * p1[4 * q + i]; }
            *(f32x4*)(h + off + 4 * q) = oa; *(f32x4*)(h + off + 128 + 4 * q) = ob; }
    }
};

__device__ __forceinline__ void transpose_item(const float* W, int ldw, int K, int k0, int c0, int nvalid, bf16* WT, int r0, LAS float* scr, int lane) {
    (void)scr;
    const int kb = lane >> 3, nb = lane & 7; const bool ok = 4 * nb < nvalid;
    const float* src = W + (size_t)(k0 + 8 * kb) * ldw + c0 + 4 * nb;
    f32x4 v[8];
#pragma unroll
    for (int i = 0; i < 8; ++i) v[i] = ok ? *(const f32x4*)(src + (size_t)i * ldw) : (f32x4){0.f, 0.f, 0.f, 0.f};
    bf16* dst = WT + (size_t)(r0 + 4 * nb) * K + k0 + 8 * kb;
#pragma unroll
    for (int e = 0; e < 4; ++e) { v4u o; o.x = pk2(v[0][e], v[1][e]); o.y = pk2(v[2][e], v[3][e]); o.z = pk2(v[4][e], v[5][e]); o.w = pk2(v[6][e], v[7][e]); *(v4u*)(dst + (size_t)e * K) = o; }
}
__device__ __forceinline__ void transpose_job(const float* W, int K, int N, bf16* WT, LAS float* scr, int gw, int NGW, int lane) {
    const int nblk = N / 32, items = (K / 64) * nblk;
    for (int it = gw; it < items; it += NGW) { const int kb = it / nblk, nb = it % nblk; transpose_item(W, N, K, 64 * kb, 32 * nb, 32, WT, 32 * nb, scr, lane); }
}
__device__ __forceinline__ void rms_row_bf16(const float* xrow, const float* gain, bf16* orow, int lane) {
    const f32x4* xr = (const f32x4*)xrow + lane; const f32x4* gr = (const f32x4*)gain + lane;
    f32x4 v[8]; float s = 0.f;
#pragma unroll
    for (int j = 0; j < 8; ++j) { v[j] = xr[64 * j]; s += (v[j].x * v[j].x + v[j].y * v[j].y) + (v[j].z * v[j].z + v[j].w * v[j].w); }
    const float rstd = 1.0f / sqrtf(wave_sum(s) * (1.f / D) + EPS);
    v2u* o8 = (v2u*)orow + lane;
#pragma unroll
    for (int j = 0; j < 8; ++j) { const f32x4 g = gr[64 * j]; v2u o; o.x = pk2(v[j].x * rstd * g.x, v[j].y * rstd * g.y); o.y = pk2(v[j].z * rstd * g.z, v[j].w * rstd * g.w); o8[64 * j] = o; }
}


__device__ __forceinline__ void route_row(Frame& F, const LAS float* lgp, float rs, int t, LAS unsigned* lcnt, LAS int* ent, int ei) {
    float gl[4];
#pragma unroll
    for (int o = 0; o < 4; ++o) gl[o] = lgp[o] * rs + F.in[I_B_RG][o];
    int gi = 0; float gm = gl[0];
#pragma unroll
    for (int o = 1; o < 4; ++o) if (gl[o] > gm) { gm = gl[o]; gi = o; }
    float den = 0.f;
#pragma unroll
    for (int o = 0; o < 4; ++o) den += __expf(gl[o] - gm);
    const float psel = 1.0f / den;
    float le[8];
#pragma unroll
    for (int q = 0; q < 8; ++q) le[q] = lgp[4 + 8 * gi + q] * rs + F.in[I_B_RE][gi * 8 + q];
    int i0 = 0; float v0 = le[0];
#pragma unroll
    for (int q = 1; q < 8; ++q) if (le[q] > v0) { v0 = le[q]; i0 = q; }
    int i1 = -1; float v1 = -3.0e38f;
#pragma unroll
    for (int q = 0; q < 8; ++q) if (q != i0 && le[q] > v1) { v1 = le[q]; i1 = q; }
    const float e1 = __expf(v1 - v0); const float w0 = psel / (1.0f + e1), w1 = psel * e1 / (1.0f + e1);
    const int ea = gi * 8 + i0, ebx = gi * 8 + i1;
    const unsigned sa = atomicAdd((unsigned*)(lcnt + ea), 1u), sb = atomicAdd((unsigned*)(lcnt + ebx), 1u);
    ent[4 * ei + 0] = (ea << 16) | (int)sa; ent[4 * ei + 1] = 2 * t; ent[4 * ei + 2] = __float_as_int(w0); ent[4 * ei + 3] = 0;
    ent[4 * (ei + 1) + 0] = (ebx << 16) | (int)sb; ent[4 * (ei + 1) + 1] = 2 * t + 1; ent[4 * (ei + 1) + 2] = __float_as_int(w1); ent[4 * (ei + 1) + 3] = 0;
}

enum { PH_PRO = 0, PH_INPROJ, PH_TOKLOC, PH_DNA, PH_DN, PH_YDN, PH_MERGE, PH_OUT, PH_ROUTE, PH_MOE1, PH_MOE2, PH_N3, PH_PP, PH_PLE, PH_FINAL, NPHASE };
struct Args { const float* in[25]; float* out; unsigned char* ws; int ph_lo, ph_hi, flags, pad; };
__global__ void __launch_bounds__(NTHR, 2) fwd(Args args) {
    extern __shared__ __attribute__((aligned(16))) unsigned char lds_raw[];
    Frame F;
    F.lds = (LAS unsigned char*)lds_raw; F.MISC = (volatile LAS unsigned*)(F.lds + MISC_OFF);
    F.tid = threadIdx.x; F.lane = F.tid & 63; F.wave = __builtin_amdgcn_readfirstlane(F.tid >> 6);
    F.G = gridDim.x; { const int bx = blockIdx.x; F.vcu = (F.G % 8 == 0) ? (bx % 8) * (F.G / 8) + bx / 8 : bx; }
    F.ws = args.ws; F.ctl = (unsigned*)(args.ws + WS_CTL); F.out = args.out;
#pragma unroll
    for (int i = 0; i < 25; ++i) F.in[i] = args.in[i];
    for (int u = F.tid; u < MISC_WORDS; u += NTHR) F.MISC[u] = 0u;
    __syncthreads();
    XcdBarrier bar; bar.bar = F.ctl + CW_BAR; bar.x = 0; bar.st = nullptr;
    if (MK_N_LAUNCHES == 1) bar = xcd_barrier_post(F.ctl + CW_BAR, F.MISC + 8);
    const int lo = args.ph_lo, hi = args.ph_hi;
#define IN(k) (lo <= (k) && (k) < hi)
#define SEAM(k) do { if (MK_N_LAUNCHES == 1 && IN(k) && IN((k) + 1)) xcd_barrier(bar); } while (0)
    unsigned char* ws = F.ws;
    bf16* WIN = (bf16*)(ws + WS_WIN); bf16* WCOMB = (bf16*)(ws + WS_WCOMB); bf16* WUPDN = (bf16*)(ws + WS_WUPDN); bf16* WOUT = (bf16*)(ws + WS_WOUT);
    bf16* WPLEG = (bf16*)(ws + WS_WPLEG); bf16* WPLEP = (bf16*)(ws + WS_WPLEP); bf16* WGU = (bf16*)(ws + WS_WGU); bf16* WDN = (bf16*)(ws + WS_WDN);
    float* BA = (float*)(ws + WS_BA); float* GG = (float*)(ws + WS_G); float* BETA = (float*)(ws + WS_BETA);
    int* LTK = (int*)(ws + WS_LTK); float* LW = (float*)(ws + WS_LW); bf16* PBF = (bf16*)(ws + WS_PBF);
    bf16* WRH = (bf16*)(ws + WS_WRT); bf16* WRL = WRH + 48 * D;
    unsigned char* PKG = ws + WS_PKG; bf16* UT = (bf16*)(ws + WS_UT); bf16* OB = (bf16*)(ws + WS_OB);
    bf16* N1 = (bf16*)(ws + WS_N1); bf16* QKV = (bf16*)(ws + WS_QKV); float* OBUF = (float*)(ws + WS_QKV); bf16* PP = (bf16*)(ws + WS_QKV);
    bf16* MP = (bf16*)((unsigned char*)F.out + OUT_QKV2); bf16* MERGED = (bf16*)(ws + WS_QKV);     bf16* UPOOL = (bf16*)(ws + WS_UPOOL); bf16* ZS = (bf16*)(ws + WS_Z); bf16* HMID = (bf16*)(ws + WS_Z);
    bf16* GP = (bf16*)(ws + WS_GP); bf16* GD = (bf16*)(ws + WS_GD); bf16* Y0 = GP; bf16* Y1 = GD;
    bf16* DBUF = (bf16*)((unsigned char*)F.out + OUT_D); bf16* QKV2 = (bf16*)((unsigned char*)F.out + OUT_QKV2); float* H = F.out;
    const int gw = F.vcu * NWAVES + F.wave, NGW = F.G * NWAVES, lane = F.lane;

    if (IN(PH_PRO)) {
        LAS float* scr = (LAS float*)(F.lds + RING_OFF + F.wave * 16384);
        {
            const int nblk = N_IN_PAD / 32, items = (D / 64) * nblk;
            for (int it = gw; it < items; it += NGW) { const int kb = it / nblk, nb = it % nblk, r0 = 32 * nb; int c0, nv;
                if (r0 < 5120) { c0 = r0; nv = 32; } else { c0 = r0 + 16; nv = 32; }
                transpose_item(F.in[I_W_IN], D_IN, D, 64 * kb, c0, nv, WIN, r0, scr, lane); }
        }
        transpose_job(F.in[I_W_UP_DN], D_Z, D, WUPDN, scr, gw, NGW, lane);
        transpose_job(F.in[I_W_OUT], D, D, WOUT, scr, gw, NGW, lane);
        transpose_job(F.in[I_W_PLE_GATE], D, D, WPLEG, scr, gw, NGW, lane);
        transpose_job(F.in[I_W_PLE_PROJ], D_PLE, D, WPLEP, scr, gw, NGW, lane);
        {
            const float* pw = F.in[I_POOL_W]; const float* ps = F.in[I_POOL_SCALE]; const float* wu = F.in[I_W_UP_POOL];
            const int items = (D_POOL / 8) * (D / 64);
            for (int it = gw; it < items; it += NGW) { const int kg = it / (D / 64), nb = it % (D / 64), k0 = 8 * kg, g = k0 >> 8, kk0 = k0 & 255, n = 64 * nb + lane;
                float acc[8];
#pragma unroll
                for (int i = 0; i < 8; ++i) acc[i] = 0.f;
                for (int j = 0; j < POOL_GW; ++j) { const float wv = wu[(size_t)(256 * g + j) * D + n] * ps[256 * g + j];
#pragma unroll
                    for (int i = 0; i < 8; ++i) acc[i] += pw[(size_t)g * POOL_GW * POOL_GW + (size_t)(kk0 + i) * POOL_GW + j] * wv; }
                store8bf(WCOMB + (size_t)n * D_POOL + k0, acc); }
        }
        {
            const float* gm = F.in[I_NORM_MOE]; const float* wrg = F.in[I_W_RG]; const float* wre = F.in[I_W_RE];
            for (int idx = gw * 64 + lane; idx < 48 * D; idx += NGW * 64) { const int n = idx / D, k = idx % D;
                const float v = n < 4 ? gm[k] * wrg[(size_t)k * NGRP + n] : (n < 36 ? gm[k] * wre[(size_t)k * NE + (n - 4)] : 0.f);
                const unsigned hi = f2bf(v); WRH[idx] = (bf16)hi; WRL[idx] = (bf16)f2bf(v - __uint_as_float(hi << 16)); }
        }
        {
            const float* gain = F.in[I_NORM_MIX]; const float* win = F.in[I_W_IN];
            __syncthreads();
            LAS float* LGp = (LAS float*)(F.lds + RING_OFF);
            LAS float* SSp = LGp + 8 * 256;
            LAS float* RS = SSp + 128;
            const int row = lane & 15, g = lane >> 4, wv = F.wave;
            bf16x8 wbh[8], wbl[8];
#pragma unroll
            for (int J = 0; J < 8; ++J) { unsigned hh[4], ll[4];
#pragma unroll
                for (int q = 0; q < 4; ++q) { const int k = 256 * wv + 32 * J + 8 * g + 2 * q; const float v0 = gain[k] * win[(size_t)k * D_IN + 5120 + row], v1 = gain[k + 1] * win[(size_t)(k + 1) * D_IN + 5120 + row];
                    hh[q] = pk2(v0, v1); ll[q] = pk2(v0 - bflo(hh[q]), v1 - bfhi(hh[q])); }
                wbh[J] = __builtin_bit_cast(bf16x8, (v4u){hh[0], hh[1], hh[2], hh[3]}); wbl[J] = __builtin_bit_cast(bf16x8, (v4u){ll[0], ll[1], ll[2], ll[3]}); }
            for (int task = F.vcu; task < T / 16; task += F.G) {
                const int r0 = task * 16; const float* hp_ = F.in[I_X] + (size_t)(r0 + row) * D + 256 * wv + 8 * g;
                f32x4 a[8][2];
#pragma unroll
                for (int J = 0; J < 8; ++J) { a[J][0] = *(const f32x4*)(hp_ + 32 * J); a[J][1] = *(const f32x4*)(hp_ + 32 * J + 4); }
                f32x4 acc = (f32x4){0.f, 0.f, 0.f, 0.f}; float ss = 0.f;
#pragma unroll
                for (int J = 0; J < 8; ++J) { const f32x4 x0 = a[J][0], x1 = a[J][1];
                    ss += ((x0.x * x0.x + x0.y * x0.y) + (x0.z * x0.z + x0.w * x0.w)) + ((x1.x * x1.x + x1.y * x1.y) + (x1.z * x1.z + x1.w * x1.w));
                    const unsigned h0 = pk2(x0.x, x0.y), h1 = pk2(x0.z, x0.w), h2_ = pk2(x1.x, x1.y), h3 = pk2(x1.z, x1.w);
                    const unsigned l0 = pk2(x0.x - bflo(h0), x0.y - bfhi(h0)), l1 = pk2(x0.z - bflo(h1), x0.w - bfhi(h1)), l2 = pk2(x1.x - bflo(h2_), x1.y - bfhi(h2_)), l3 = pk2(x1.z - bflo(h3), x1.w - bfhi(h3));
                    const bf16x8 ah = __builtin_bit_cast(bf16x8, (v4u){h0, h1, h2_, h3}), al = __builtin_bit_cast(bf16x8, (v4u){l0, l1, l2, l3});
                    acc = __builtin_amdgcn_mfma_f32_16x16x32_bf16(ah, wbh[J], acc, 0, 0, 0); acc = __builtin_amdgcn_mfma_f32_16x16x32_bf16(al, wbh[J], acc, 0, 0, 0); acc = __builtin_amdgcn_mfma_f32_16x16x32_bf16(ah, wbl[J], acc, 0, 0, 0); }
                ss += __shfl_xor(ss, 16); ss += __shfl_xor(ss, 32);
                __syncthreads();
#pragma unroll
                for (int reg = 0; reg < 4; ++reg) LGp[wv * 256 + (4 * g + reg) * 16 + row] = acc[reg];
                if (g == 0) SSp[wv * 16 + row] = ss;
                __syncthreads();
                if (F.tid < 16) { float s8 = 0.f;
#pragma unroll
                    for (int w8 = 0; w8 < 8; ++w8) s8 += SSp[w8 * 16 + F.tid];
                    RS[F.tid] = 1.0f / sqrtf(s8 * (1.f / D) + EPS); }
                __syncthreads();
                if (F.tid < 256) { float s8 = 0.f;
#pragma unroll
                    for (int w8 = 0; w8 < 8; ++w8) s8 += LGp[w8 * 256 + F.tid];
                    BA[(size_t)(r0 + (F.tid >> 4)) * 16 + (F.tid & 15)] = s8 * RS[F.tid >> 4]; }
                {   const float rs = RS[row]; bf16* op = N1 + (size_t)(r0 + row) * D + 256 * wv + 8 * g; const float* gp = gain + 256 * wv + 8 * g;
#pragma unroll
                    for (int J = 0; J < 8; ++J) { const f32x4 g0 = *(const f32x4*)(gp + 32 * J), g1 = *(const f32x4*)(gp + 32 * J + 4); const f32x4 x0 = a[J][0], x1 = a[J][1];
                        v4u o; o.x = pk2(x0.x * rs * g0.x, x0.y * rs * g0.y); o.y = pk2(x0.z * rs * g0.z, x0.w * rs * g0.w); o.z = pk2(x1.x * rs * g1.x, x1.y * rs * g1.y); o.w = pk2(x1.z * rs * g1.z, x1.w * rs * g1.w);
                        *(v4u*)(op + 32 * J) = o; }
                }
            }
            __syncthreads();
        }
        for (int m = gw; m < T; m += NGW) { const f32x4 v = *((const f32x4*)(F.in[I_P] + (size_t)m * D_PLE) + lane); v2u o; o.x = pk2(v.x, v.y); o.y = pk2(v.z, v.w); *((v2u*)(PBF + (size_t)m * D_PLE) + lane) = o; }
    }
    SEAM(PH_PRO);
    if (IN(PH_INPROJ)) {
        pg8::DenseOrder S; S.init(T, N_IN_PAD, D, F.G, (int)blockIdx.x);
        EpiInProj E{UPOOL, QKV, ZS, GP, GD, BA};
        pg8::gemm_phase<EpiInProj, pg8::DenseOrder, false>(F.lds + RING_OFF, N1, WIN, D, S, E);
    }
    SEAM(PH_INPROJ);
    if (IN(PH_TOKLOC)) {
        const float* cw = F.in[I_CONV_W];
        LAS float* red = (LAS float*)(F.lds + RING_OFF + F.wave * 4608);
        LAS float* SC = red + 1024;
        for (int item = gw; item < 2048 * 12; item += NGW) {
            const int run = item / 12, blk = item % 12, t0 = run * 16, s0 = t0 % SEQ, c = blk * 256 + 4 * lane;
            v2u u[19];
#pragma unroll
            for (int i = 0; i < 19; ++i) { u[i] = (s0 - 3 + i >= 0) ? *(const v2u*)(QKV + (size_t)(t0 - 3 + i) * D_QKV + c) : (v2u){0u, 0u}; }
            f32x4 w[4];
#pragma unroll
            for (int kk = 0; kk < 4; ++kk) w[kk] = *(const f32x4*)(cw + kk * D_QKV + c);
            f32x4 y[16];
#pragma unroll
            for (int tt = 0; tt < 16; ++tt) { f32x4 a = (f32x4){0.f, 0.f, 0.f, 0.f};
#pragma unroll
                for (int kk = 0; kk < 4; ++kk) { const v2u x = u[tt + kk]; a.x += bflo(x.x) * w[kk].x; a.y += bfhi(x.x) * w[kk].y; a.z += bflo(x.y) * w[kk].z; a.w += bfhi(x.y) * w[kk].w; }
                a.x = siluf_(a.x); a.y = siluf_(a.y); a.z = siluf_(a.z); a.w = siluf_(a.w); y[tt] = a; }
            if (blk < 8) {
#pragma unroll
                for (int tt = 0; tt < 16; ++tt) red[tt * 64 + lane] = (y[tt].x * y[tt].x + y[tt].y * y[tt].y) + (y[tt].z * y[tt].z + y[tt].w * y[tt].w);
                asm volatile("s_waitcnt lgkmcnt(0)" ::: "memory");
                {   const int tt = lane & 15, hd = (lane >> 4) & 1, part = lane >> 5; float sm = 0.f;
#pragma unroll
                    for (int i = 0; i < 16; ++i) sm += red[tt * 64 + hd * 32 + part * 16 + ((i + lane) & 15)];
                    sm += __shfl_xor(sm, 32);
                    float rr = 1.0f / sqrtf(sm + EPS); if (blk < 4) rr *= 0.08838834764831845f;
                    if (part == 0) SC[hd * 16 + tt] = rr; }
                asm volatile("s_waitcnt lgkmcnt(0)" ::: "memory");
#pragma unroll
                for (int q4 = 0; q4 < 4; ++q4) { const f32x4 sc = *(const LAS f32x4*)(SC + (lane >> 5) * 16 + 4 * q4);
#pragma unroll
                    for (int i = 0; i < 4; ++i) y[4 * q4 + i] = y[4 * q4 + i] * sc[i]; }
                asm volatile("s_waitcnt lgkmcnt(0)" ::: "memory");
            }
#pragma unroll
            for (int tt = 0; tt < 16; ++tt) { v2u o; o.x = pk2(y[tt].x, y[tt].y); o.y = pk2(y[tt].z, y[tt].w); *(v2u*)(QKV2 + (size_t)(t0 + tt) * D_QKV + c) = o; }
        }
        for (int item = gw; item < 1024 * 4; item += NGW) {
            const int run = item >> 2, gi = item & 3, t0 = run * 32, s0 = t0 % SEQ, c = gi * 256 + 4 * lane;
#define POOL_BODY(W) { v2u u[31 + W]; \
                _Pragma("unroll") for (int i = 0; i < 31 + W; ++i) u[i] = (s0 - (W - 1) + i >= 0) ? *(const v2u*)(UPOOL + (size_t)(t0 - (W - 1) + i) * D_POOL + c) : (v2u){0u, 0u}; \
                _Pragma("unroll") for (int tt = 0; tt < 32; ++tt) { f32x4 sm = (f32x4){0.f, 0.f, 0.f, 0.f}; \
                    _Pragma("unroll") for (int j = 0; j < W; ++j) { const v2u x = u[tt + j]; sm.x += bflo(x.x); sm.y += bfhi(x.x); sm.z += bflo(x.y); sm.w += bfhi(x.y); } \
                    const v2u xc = u[tt + W - 1]; const float inv = 1.0f / (float)((s0 + tt + 1) < W ? (s0 + tt + 1) : W); \
                    v2u o; o.x = pk2(sm.x * inv - bflo(xc.x), sm.y * inv - bfhi(xc.x)); o.y = pk2(sm.z * inv - bflo(xc.y), sm.w * inv - bfhi(xc.y)); \
                    *(v2u*)(DBUF + (size_t)(t0 + tt) * D_POOL + c) = o; } }
            if (gi == 0) POOL_BODY(2) else if (gi == 1) POOL_BODY(4) else if (gi == 2) POOL_BODY(8) else POOL_BODY(16)
#undef POOL_BODY
        }
        for (int idx = gw * 64 + lane; idx < T * NH; idx += NGW * 64) { const int t = idx >> 3, hh = idx & 7; const float bl = BA[(size_t)t * 16 + hh], al = BA[(size_t)t * 16 + 8 + hh]; const float xx = al + F.in[I_DT_BIAS][hh];
            const float sp = xx > 20.f ? xx : log1pf(__expf(xx)); GG[idx] = -__expf(F.in[I_A_LOG][hh]) * sp; BETA[idx] = sigmoidf_(bl); }
    }
    SEAM(PH_TOKLOC);
    if (IN(PH_DNA)) {
        const int hb = F.tid >> 8, t4 = F.tid & 255, wq = t4 >> 6;
        LAS unsigned char* hl = F.lds + RING_OFF + hb * 62464;
        LAS bf16* Ks = (LAS bf16*)hl;
        LAS bf16* Qs = Ks + 64 * 136;
        LAS float* Ls = (LAS float*)(hl + 2 * 17408);
        LAS float* gs = (LAS float*)(hl + 3 * 17408);
        LAS bf16* IMG = (LAS bf16*)(hl + 3 * 17408 + 2048);
        LAS bf16* UWI = Qs;
        for (int up = F.vcu; up < DN_UNITS / 2; up += F.G) {
            const int unit = up * 2 + hb, bh = unit >> 7, cch = unit & 127, b = bh >> 3, h = bh & 7; const size_t tok0 = (size_t)b * SEQ + (size_t)cch * 64;
            unsigned char* pk = PKG + (size_t)unit * PKG_BYTES; bf16* pW = (bf16*)pk; bf16* pQ = (bf16*)(pk + 16384); bf16* pA = (bf16*)(pk + 32768); bf16* pKT = (bf16*)(pk + 40960); float* pS = (float*)(pk + 57344);
            bf16* pU = UT + (size_t)unit * 8192;
            __syncthreads();
            if (t4 < 64) { gs[t4] = GG[(tok0 + t4) * NH + h]; gs[64 + t4] = BETA[(tok0 + t4) * NH + h]; }
#pragma unroll
            for (int i = 0; i < 4; ++i) { const int idx = t4 + 256 * i, row = idx >> 4, ch = idx & 15;
                *(LAS v4u*)(Ks + row * 136 + ch * 8) = *(const v4u*)(QKV2 + (tok0 + row) * D_QKV + 1024 + h * 128 + ch * 8);
                *(LAS v4u*)(Qs + row * 136 + ch * 8) = *(const v4u*)(QKV2 + (tok0 + row) * D_QKV + h * 128 + ch * 8); }
            __syncthreads();
            if (t4 < 64) { float a = 0.f; for (int j = 0; j <= t4; ++j) a += gs[j]; gs[128 + t4] = a; }
            __syncthreads();
            if (t4 < 64) { const float gl = gs[128 + 63], gc = gs[128 + t4]; gs[192 + t4] = __expf(gc); gs[256 + t4] = __expf(gl - gc); }
            {
                const int c = lane & 15, gq = lane >> 4;
                f32x4 kk[4], qk[4];
#pragma unroll
                for (int jb = 0; jb < 4; ++jb) { kk[jb] = (f32x4){0.f, 0.f, 0.f, 0.f}; qk[jb] = (f32x4){0.f, 0.f, 0.f, 0.f}; }
#pragma unroll
                for (int ks = 0; ks < 4; ++ks) {
                    const bf16x8 aK = *(const LAS bf16x8*)(Ks + (16 * wq + c) * 136 + 32 * ks + 8 * gq), aQ = *(const LAS bf16x8*)(Qs + (16 * wq + c) * 136 + 32 * ks + 8 * gq);
#pragma unroll
                    for (int jb = 0; jb < 4; ++jb) { const bf16x8 bK = *(const LAS bf16x8*)(Ks + (16 * jb + c) * 136 + 32 * ks + 8 * gq);
                        kk[jb] = __builtin_amdgcn_mfma_f32_16x16x32_bf16(aK, bK, kk[jb], 0, 0, 0); qk[jb] = __builtin_amdgcn_mfma_f32_16x16x32_bf16(aQ, bK, qk[jb], 0, 0, 0); }
                }
#pragma unroll
                for (int reg = 0; reg < 4; ++reg) { const int row = 16 * wq + 4 * gq + reg; const float gi = gs[128 + row], bi = gs[64 + row];
#pragma unroll
                    for (int jb = 0; jb < 4; ++jb) { const int col = 16 * jb + c; const float dec = (row >= col) ? __expf(gi - gs[128 + col]) : 0.f;
                        Ls[row * 68 + col] = (row > col) ? -(bi * kk[jb][reg] * dec) : 0.f;
                        IMG[tix(row, col, 4)] = (bf16)f2bf(qk[jb][reg] * dec); } }
            }
#pragma unroll 1
            for (int it = 0; it < 8; ++it) { const int idx = t4 + 256 * it;
                { const int row = idx >> 5, k4 = (idx & 31) * 4; const v2u qv = *(const LAS v2u*)(Qs + row * 136 + k4); const float eg = __expf(gs[128 + row]);
                  v2u o; o.x = pk2(bflo(qv.x) * eg, bfhi(qv.x) * eg); o.y = pk2(bflo(qv.y) * eg, bfhi(qv.y) * eg); *(v2u*)(pQ + tix(row, k4, 8)) = o; }
                { const int dk = idx >> 4, i4 = (idx & 15) * 4; const float gl_ = gs[128 + 63];
                  const float k0 = bf2f(Ks[i4 * 136 + dk]) * __expf(gl_ - gs[128 + i4]), k1 = bf2f(Ks[(i4 + 1) * 136 + dk]) * __expf(gl_ - gs[128 + i4 + 1]);
                  const float k2 = bf2f(Ks[(i4 + 2) * 136 + dk]) * __expf(gl_ - gs[128 + i4 + 2]), k3 = bf2f(Ks[(i4 + 3) * 136 + dk]) * __expf(gl_ - gs[128 + i4 + 3]);
                  v2u o; o.x = pk2(k0, k1); o.y = pk2(k2, k3); *(v2u*)(pKT + tix(dk, i4, 4)) = o; } }
            if (t4 == 0) pS[128] = __expf(gs[128 + 63]);
            __syncthreads();
#pragma unroll
            for (int i = 0; i < 2; ++i) { const int idx = t4 + 256 * i; *(v4u*)(pA + idx * 8) = *(const LAS v4u*)(IMG + idx * 8); }
            float x[64];
            {
                if (t4 < 128) {
#pragma unroll
                    for (int i = 0; i < 64; ++i) x[i] = gs[64 + i] * bf2f(QKV2[(tok0 + i) * D_QKV + 2048 + h * 128 + t4]);
                } else {
#pragma unroll
                    for (int i = 0; i < 64; ++i) x[i] = gs[64 + i] * bf2f(Ks[i * 136 + (t4 - 128)]) * gs[192 + i];
                }
                SolveRows<60>::run(x, Ls, lane & 15);
            }
            __syncthreads();
            if (t4 < 128) { const int w = t4 >> 5, c = t4 & 31;
#pragma unroll
                for (int i = 0; i < 64; ++i) { const int rt = i >> 5, i32 = i & 31, hh = (i32 >> 2) & 1, reg = (i32 & 3) + 4 * (i32 >> 3); UWI[(((w * 2 + rt) * 64 + hh * 32 + c) << 4) + reg] = (bf16)f2bf(x[i]); }
            } else { const int dk = t4 - 128;
#pragma unroll
                for (int i = 0; i < 64; ++i) UWI[8192 + tix(i, dk, 8)] = (bf16)f2bf(-x[i]);
            }
            __syncthreads();
#pragma unroll
            for (int i = 0; i < 4; ++i) { const int idx = t4 + 256 * i; *(v4u*)(pU + idx * 8) = *(const LAS v4u*)(UWI + idx * 8); *(v4u*)(pW + idx * 8) = *(const LAS v4u*)(UWI + 8192 + idx * 8); }
        }
        __syncthreads();
    }
    SEAM(PH_DNA);
    if (IN(PH_DN)) {
        if ((int)blockIdx.x < NB * NH) { if (!(args.flags & 1)) {
            const int bh = (int)blockIdx.x, b = bh >> 3, hh = bh & 7; const size_t tokb = (size_t)b * SEQ;
            const unsigned char* pkg0 = PKG + (size_t)bh * 128 * PKG_BYTES; const bf16* ut0 = UT + (size_t)bh * 128 * 8192;
            const bool loader = F.wave >= 4; const int lt = F.tid - 256;
            if (loader) {
                v4u la[19], lb[19];
                constexpr int NCH = STG_BYTES / 16, NPK = PKG_BYTES / 16;
#define DN_LD(dst, pn) do { const int pn_ = (pn) < 127 ? (pn) : 127; const unsigned char* src_ = pkg0 + (size_t)pn_ * PKG_BYTES; const unsigned char* usrc_ = (const unsigned char*)(ut0 + (size_t)pn_ * 8192); _Pragma("unroll") for (int i = 0; i < 19; ++i) { int idx = lt + 256 * i; idx = idx < NCH ? idx : NCH - 1; \
        dst[i] = *(const v4u*)((idx < NPK) ? (src_ + (size_t)idx * 16) : (usrc_ + (size_t)(idx - NPK) * 16)); } } while (0)
#define DN_ST(srcr, stg) do { _Pragma("unroll") for (int i = 0; i < 19; ++i) { const int idx = lt + 256 * i; if (idx < NCH) *(LAS v4u*)(F.lds + RING_OFF + (stg) * STG_BYTES + idx * 16) = srcr[i]; } } while (0)
                DN_LD(la, 0); DN_ST(la, 0); DN_LD(la, 1); DN_LD(lb, 2);
                for (int n = 0; n < 128; n += 2) {
                    LDS_BARRIER();
                    DN_ST(la, 1); DN_LD(la, n + 3);
                    LDS_BARRIER();
                    DN_ST(lb, 0); DN_LD(lb, n + 4);
                }
#undef DN_LD
#undef DN_ST
            } else {
            const int w = F.wave & 3, r = lane & 31, h2 = lane >> 5;
            f32x16 S[4]; bf16x8 Sb[8];
#pragma unroll
            for (int d = 0; d < 4; ++d)
#pragma unroll
                for (int i = 0; i < 16; ++i) S[d][i] = 0.f;
#pragma unroll
            for (int s = 0; s < 8; ++s)
#pragma unroll
                for (int i = 0; i < 8; ++i) Sb[s][i] = 0;
            for (int n = 0; n < 128; ++n) {
                LDS_BARRIER();
                {
                    LAS unsigned char* st = F.lds + RING_OFF + (n & 1) * STG_BYTES;
                    const LAS float* sc = (const LAS float*)(st + 57344);
#define FRAG(off, f) (*(const LAS bf16x8*)(st + (off) + (f) * 1024 + lane * 16))
#define MF(a, b, c) __builtin_amdgcn_mfma_f32_32x32x16_bf16((a), (b), (c), 0, 0, 0)
#define SB() __builtin_amdgcn_sched_barrier(0)
                    f32x16 vn[2], qs[2];
#pragma unroll
                    for (int rt = 0; rt < 2; ++rt) {
#pragma unroll
                        for (int q = 0; q < 2; ++q) { const v4u u4 = *(const LAS v4u*)(st + PKG_BYTES + (((w * 2 + rt) * 64 + lane) << 5) + q * 16);
                            vn[rt][8 * q + 0] = bflo(u4.x); vn[rt][8 * q + 1] = bfhi(u4.x); vn[rt][8 * q + 2] = bflo(u4.y); vn[rt][8 * q + 3] = bfhi(u4.y);
                            vn[rt][8 * q + 4] = bflo(u4.z); vn[rt][8 * q + 5] = bfhi(u4.z); vn[rt][8 * q + 6] = bflo(u4.w); vn[rt][8 * q + 7] = bfhi(u4.w); }
#pragma unroll
                        for (int i = 0; i < 16; ++i) qs[rt][i] = 0.f; }
                    bf16x8 fa[4], fb[4];
                    fa[0] = FRAG(0, 0); fa[1] = FRAG(0, 8); fa[2] = FRAG(16384, 0); fa[3] = FRAG(16384, 8);
                    fb[0] = FRAG(0, 1); fb[1] = FRAG(0, 9); fb[2] = FRAG(16384, 1); fb[3] = FRAG(16384, 9);
                    SB();
#pragma unroll
                    for (int s = 0; s < 8; s += 2) {
                        vn[0] = MF(fa[0], Sb[s], vn[0]); vn[1] = MF(fa[1], Sb[s], vn[1]); qs[0] = MF(fa[2], Sb[s], qs[0]); qs[1] = MF(fa[3], Sb[s], qs[1]);
                        SB();
                        if (s + 2 < 8) { fa[0] = FRAG(0, s + 2); fa[1] = FRAG(0, 8 + s + 2); fa[2] = FRAG(16384, s + 2); fa[3] = FRAG(16384, 8 + s + 2); }
                        SB();
                        vn[0] = MF(fb[0], Sb[s + 1], vn[0]); vn[1] = MF(fb[1], Sb[s + 1], vn[1]); qs[0] = MF(fb[2], Sb[s + 1], qs[0]); qs[1] = MF(fb[3], Sb[s + 1], qs[1]);
                        SB();
                        if (s + 3 < 8) { fb[0] = FRAG(0, s + 3); fb[1] = FRAG(0, 8 + s + 3); fb[2] = FRAG(16384, s + 3); fb[3] = FRAG(16384, 8 + s + 3); }
                        SB();
                    }
                    bf16x8 ga[6], gb[6];
#define LD6(dst, sp) do { dst[0] = FRAG(32768, sp); dst[1] = FRAG(32768, 4 + (sp)); dst[2] = FRAG(40960, sp); dst[3] = FRAG(40960, 4 + (sp)); dst[4] = FRAG(40960, 8 + (sp)); dst[5] = FRAG(40960, 12 + (sp)); } while (0)
                    LD6(ga, 0); LD6(gb, 1);
                    const float egl = sc[128];
                    SB();
                    bf16x8 vb[4];
#pragma unroll
                    for (int sp = 0; sp < 4; ++sp) { const int rt = sp >> 1, base = 8 * (sp & 1); unsigned pv[4];
#pragma unroll
                        for (int jj = 0; jj < 4; ++jj) pv[jj] = pk2(vn[rt][base + 2 * jj], vn[rt][base + 2 * jj + 1]);
                        vb[sp] = __builtin_bit_cast(bf16x8, (v4u){pv[0], pv[1], pv[2], pv[3]}); }
#pragma unroll
                    for (int d = 0; d < 4; ++d)
#pragma unroll
                        for (int i = 0; i < 16; ++i) S[d][i] *= egl;
                    SB();
#pragma unroll
                    for (int sp = 0; sp < 4; sp += 2) {
                        qs[0] = MF(ga[0], vb[sp], qs[0]); qs[1] = MF(ga[1], vb[sp], qs[1]); S[0] = MF(ga[2], vb[sp], S[0]); S[1] = MF(ga[3], vb[sp], S[1]); S[2] = MF(ga[4], vb[sp], S[2]); S[3] = MF(ga[5], vb[sp], S[3]);
                        SB();
                        if (sp + 2 < 4) LD6(ga, sp + 2);
                        SB();
                        qs[0] = MF(gb[0], vb[sp + 1], qs[0]); qs[1] = MF(gb[1], vb[sp + 1], qs[1]); S[0] = MF(gb[2], vb[sp + 1], S[0]); S[1] = MF(gb[3], vb[sp + 1], S[1]); S[2] = MF(gb[4], vb[sp + 1], S[2]); S[3] = MF(gb[5], vb[sp + 1], S[3]);
                        SB();
                        if (sp + 3 < 4) LD6(gb, sp + 3);
                        SB();
                    }
#undef LD6
#undef FRAG
#undef MF
#undef SB
#pragma unroll
                    for (int s = 0; s < 8; ++s) { const int d = s >> 1, base = 8 * (s & 1); unsigned pv[4];
#pragma unroll
                        for (int jj = 0; jj < 4; ++jj) pv[jj] = pk2(S[d][base + 2 * jj], S[d][base + 2 * jj + 1]);
                        Sb[s] = __builtin_bit_cast(bf16x8, (v4u){pv[0], pv[1], pv[2], pv[3]}); }
                    {   bf16* ob = OB + (tokb + (size_t)n * 64) * D_Z + hh * 128 + 32 * w + r;
#pragma unroll
                        for (int rt = 0; rt < 2; ++rt)
#pragma unroll
                            for (int rp = 0; rp < 8; ++rp) { const int reg = 2 * rp, row = 32 * rt + (reg & 3) + 8 * (reg >> 2) + 4 * h2; const unsigned pv = pk2(qs[rt][reg], qs[rt][reg + 1]);
                                ob[(size_t)row * D_Z] = (bf16)(pv & 0xffffu); ob[(size_t)(row + 1) * D_Z] = (bf16)(pv >> 16); } }
                }
            }
            }
        } } else if (!(args.flags & 2)) {
            pg8::DenseOrder S; S.init(T, D, D_POOL, F.G - NB * NH, (int)blockIdx.x - NB * NH); EpiPool E{GP, MP};
            pg8::gemm_phase<EpiPool, pg8::DenseOrder, false>(F.lds + RING_OFF, DBUF, WCOMB, D_POOL, S, E);
            __syncthreads();
            LAS float* scr = (LAS float*)(F.lds + RING_OFF + F.wave * 16384);
            const int gw2 = ((int)blockIdx.x - NB * NH) * NWAVES + F.wave, NGW2 = (F.G - NB * NH) * NWAVES;
        {
            const int items = NE * (D / 64) * 32;
            for (int it = gw2; it < items; it += NGW2) { const int e = it / (32 * 32), rem = it % (32 * 32), kb = rem / 32, nb = rem % 32;
                const int r0 = 32 * nb, pn = r0 >> 8, rin = r0 & 255; const bool up = rin >= 128; const int c0 = pn * 128 + (rin & 127);
                transpose_item((up ? F.in[I_W_UP] : F.in[I_W_GATE]) + (size_t)e * D * DE, DE, D, 64 * kb, c0, 32, WGU + (size_t)e * 1024 * D, r0, scr, lane); }
        }
        {
            const int per = (DE / 64) * (D / 32), items = NE * per;
            for (int it = gw2; it < items; it += NGW2) { const int e = it / per, rem = it % per, kb = rem / (D / 32), nb = rem % (D / 32);
                transpose_item(F.in[I_W_DOWN] + (size_t)e * DE * D, D, DE, 64 * kb, 32 * nb, 32, WDN + (size_t)e * D * DE, 32 * nb, scr, lane); }
        }
        }
        __syncthreads();
    }
    SEAM(PH_DN);
    if (IN(PH_YDN)) {
        bf16* YDN = N1; const float* dn = F.in[I_DN_NORM];
        for (int it = gw; it < T * NH; it += NGW) { const int t = it / NH, h = it % NH; const size_t off = (size_t)t * D_Z + h * 128 + 2 * lane;
            const unsigned ou = *(const unsigned*)(OB + off); const float o0 = bflo(ou), o1 = bfhi(ou); const float r = 1.0f / sqrtf(wave_sum(o0 * o0 + o1 * o1) * (1.f / 128.f) + EPS);
            const unsigned zu = *(const unsigned*)(ZS + off); *(unsigned*)(YDN + off) = pk2(o0 * r * dn[2 * lane] * bflo(zu), o1 * r * dn[2 * lane + 1] * bfhi(zu)); }
    }
    SEAM(PH_YDN);
    if (IN(PH_MERGE)) { pg8::DenseOrder S; S.init(T, D, D_Z, F.G, (int)blockIdx.x); EpiMerge E{GD, MP, MERGED}; pg8::gemm_phase<EpiMerge, pg8::DenseOrder, false>(F.lds + RING_OFF, N1, WUPDN, D_Z, S, E); }
    SEAM(PH_MERGE);
    if (IN(PH_OUT)) { pg8::DenseOrder S; S.init(T, D, D, F.G, (int)blockIdx.x); EpiResid E{F.in[I_X], H}; pg8::gemm_phase<EpiResid, pg8::DenseOrder, false>(F.lds + RING_OFF, MERGED, WOUT, D, S, E); }
    SEAM(PH_OUT);
    if (IN(PH_ROUTE)) {
        const float* gain = F.in[I_NORM_MOE];
        LAS float* LGp = (LAS float*)(F.lds + RING_OFF);
        LAS float* LGs = LGp + 8 * 768;
        LAS float* SSp = LGs + 768;
        LAS float* RS = SSp + 128;
        LAS unsigned* LCNT = (LAS unsigned*)(RS + 16);
        LAS int* ENT = (LAS int*)(LCNT + 64);
        if (F.tid < 64) LCNT[F.tid] = 0u;
        int ntok = 0;
        __syncthreads();
        const int row = lane & 15, g = lane >> 4, wv = F.wave;
        const bf16* wph = WRH + (size_t)row * D + 256 * wv + 8 * g;
#define RT_LOAD(dst, tsk) do { const float* hp_ = H + (size_t)((tsk) * 16 + row) * D + 256 * wv + 8 * g; _Pragma("unroll") for (int J = 0; J < 8; ++J) { dst[J][0] = *(const f32x4*)(hp_ + 32 * J); dst[J][1] = *(const f32x4*)(hp_ + 32 * J + 4); } } while (0)
#define RT_BODY(a, an, task, ntask) do { \
            const int r0 = (task) * 16; \
            f32x4 acc0 = (f32x4){0.f, 0.f, 0.f, 0.f}, acc1 = acc0, acc2 = acc0; float ss = 0.f; \
            _Pragma("unroll") for (int J = 0; J < 8; ++J) { \
                const f32x4 x0 = a[J][0], x1 = a[J][1]; \
                ss += ((x0.x * x0.x + x0.y * x0.y) + (x0.z * x0.z + x0.w * x0.w)) + ((x1.x * x1.x + x1.y * x1.y) + (x1.z * x1.z + x1.w * x1.w)); \
                const unsigned h0 = pk2(x0.x, x0.y), h1 = pk2(x0.z, x0.w), h2_ = pk2(x1.x, x1.y), h3 = pk2(x1.z, x1.w); \
                const unsigned l0 = pk2(x0.x - bflo(h0), x0.y - bfhi(h0)), l1 = pk2(x0.z - bflo(h1), x0.w - bfhi(h1)), l2 = pk2(x1.x - bflo(h2_), x1.y - bfhi(h2_)), l3 = pk2(x1.z - bflo(h3), x1.w - bfhi(h3)); \
                const bf16x8 ah = __builtin_bit_cast(bf16x8, (v4u){h0, h1, h2_, h3}), al = __builtin_bit_cast(bf16x8, (v4u){l0, l1, l2, l3}); \
                acc0 = __builtin_amdgcn_mfma_f32_16x16x32_bf16(ah, wb[J][0], acc0, 0, 0, 0); acc1 = __builtin_amdgcn_mfma_f32_16x16x32_bf16(ah, wb[J][1], acc1, 0, 0, 0); acc2 = __builtin_amdgcn_mfma_f32_16x16x32_bf16(ah, wb[J][2], acc2, 0, 0, 0); \
                acc0 = __builtin_amdgcn_mfma_f32_16x16x32_bf16(al, wb[J][0], acc0, 0, 0, 0); acc1 = __builtin_amdgcn_mfma_f32_16x16x32_bf16(al, wb[J][1], acc1, 0, 0, 0); acc2 = __builtin_amdgcn_mfma_f32_16x16x32_bf16(al, wb[J][2], acc2, 0, 0, 0); } \
            ss += __shfl_xor(ss, 16); ss += __shfl_xor(ss, 32); \
            __syncthreads(); \
            _Pragma("unroll") for (int reg = 0; reg < 4; ++reg) { LAS float* q = LGp + wv * 768 + (4 * g + reg) * 48 + row; q[0] = acc0[reg]; q[16] = acc1[reg]; q[32] = acc2[reg]; } \
            if (g == 0) SSp[wv * 16 + row] = ss; \
            __syncthreads(); \
            for (int e = F.tid; e < 768; e += NTHR) { float s8 = 0.f; _Pragma("unroll") for (int w8 = 0; w8 < 8; ++w8) s8 += LGp[w8 * 768 + e]; LGs[e] = s8; } \
            if (F.tid < 16) { float s8 = 0.f; _Pragma("unroll") for (int w8 = 0; w8 < 8; ++w8) s8 += SSp[w8 * 16 + F.tid]; RS[F.tid] = 1.0f / sqrtf(s8 * (1.f / D) + EPS); } \
            __syncthreads(); \
            if (F.tid < 16) route_row(F, LGs + F.tid * 48, RS[F.tid], r0 + F.tid, LCNT, ENT, 2 * (ntok + F.tid)); ntok += 16; \
            { const float rs = RS[row]; bf16* op = N1 + (size_t)(r0 + row) * D + 256 * wv + 8 * g; const float* gp = gain + 256 * wv + 8 * g; \
              _Pragma("unroll") for (int J = 0; J < 8; ++J) { const f32x4 g0 = *(const f32x4*)(gp + 32 * J), g1 = *(const f32x4*)(gp + 32 * J + 4); const f32x4 x0 = a[J][0], x1 = a[J][1]; \
                v4u o; o.x = pk2(x0.x * rs * g0.x, x0.y * rs * g0.y); o.y = pk2(x0.z * rs * g0.z, x0.w * rs * g0.w); o.z = pk2(x1.x * rs * g1.x, x1.y * rs * g1.y); o.w = pk2(x1.z * rs * g1.z, x1.w * rs * g1.w); \
                *(v4u*)(op + 32 * J) = o; } } } while (0)
        f32x4 ra[8][2];
        bf16x8 wb[8][3];
#pragma unroll
        for (int J = 0; J < 8; ++J)
#pragma unroll
            for (int t3 = 0; t3 < 3; ++t3) wb[J][t3] = *(const bf16x8*)(wph + 16 * t3 * D + 32 * J);
        for (int task = F.vcu; task < T / 16; task += F.G) { RT_LOAD(ra, task); RT_BODY(ra, ra, task, 0); }
#undef RT_LOAD
#undef RT_BODY
        __syncthreads();
        if (F.tid < NE) LCNT[32 + F.tid] = atomicAdd(&F.ctl[CW_CNT + 64 * F.tid], LCNT[F.tid]);
        __syncthreads();
        for (int i = F.tid; i < 2 * ntok; i += NTHR) { const int es = ENT[4 * i], e = es >> 16, slot = (int)LCNT[32 + e] + (es & 0xffff); LTK[(size_t)e * T + slot] = ENT[4 * i + 1]; LW[(size_t)e * T + slot] = __int_as_float(ENT[4 * i + 2]); }
        __syncthreads();
    }
    SEAM(PH_ROUTE);
    if (IN(PH_MOE1)) {
        LAS int* pre = (LAS int*)(F.lds + MISC_OFF + 256); LAS int* base = pre + 40;
        moe_tables<256>(F, pre, base);
        MoeSched<256, true> S{pre, base, LTK, 4, F.G, F.vcu, D, 1024};
        EpiMoe1 E{HMID}; pg8::gemm_phase<EpiMoe1, MoeSched<256, true>, true>(F.lds + RING_OFF, N1, WGU, D, S, E);
    }
    SEAM(PH_MOE1);
    if (IN(PH_MOE2)) {
        LAS int* pre = (LAS int*)(F.lds + MISC_OFF + 256); LAS int* base = pre + 40;
        moe_tables<256>(F, pre, base);
        MoeSched<256, false> S{pre, base, LTK, 8, F.G, F.vcu, DE, D};
        EpiMoe2 E{LTK, LW, Y0, Y1}; pg8::gemm_phase<EpiMoe2, MoeSched<256, false>, false>(F.lds + RING_OFF, HMID, WDN, DE, S, E);
    }
    SEAM(PH_MOE2);
    if (IN(PH_N3)) {
        const float* gain = F.in[I_NORM_PLE];
        for (int t = gw; t < T; t += NGW) {
            f32x4* hr = (f32x4*)(H + (size_t)t * D) + lane; const f32x4* gr = (const f32x4*)gain + lane;
            const v2u* y0r = (const v2u*)(Y0 + (size_t)t * D) + lane; const v2u* y1r = (const v2u*)(Y1 + (size_t)t * D) + lane;
            f32x4 v[8]; float s = 0.f;
#pragma unroll
            for (int j = 0; j < 8; ++j) { const v2u a = y0r[64 * j], b = y1r[64 * j]; f32x4 x = hr[64 * j];
                x.x += bflo(a.x) + bflo(b.x); x.y += bfhi(a.x) + bfhi(b.x); x.z += bflo(a.y) + bflo(b.y); x.w += bfhi(a.y) + bfhi(b.y);
                v[j] = x; hr[64 * j] = x; s += (x.x * x.x + x.y * x.y) + (x.z * x.z + x.w * x.w); }
            const float rstd = 1.0f / sqrtf(wave_sum(s) * (1.f / D) + EPS);
            v2u* o8 = (v2u*)(N1 + (size_t)t * D) + lane;
#pragma unroll
            for (int j = 0; j < 8; ++j) { const f32x4 g = gr[64 * j]; v2u o; o.x = pk2(v[j].x * rstd * g.x, v[j].y * rstd * g.y); o.y = pk2(v[j].z * rstd * g.z, v[j].w * rstd * g.w); o8[64 * j] = o; }
        }
    }
    SEAM(PH_N3);
    if (IN(PH_PP)) { pg8::DenseOrder S; S.init(T, D, D_PLE, F.G, (int)blockIdx.x); EpiBf16Plain E{PP}; pg8::gemm_phase<EpiBf16Plain, pg8::DenseOrder, false>(F.lds + RING_OFF, PBF, WPLEP, D_PLE, S, E); }
    SEAM(PH_PP);
    if (IN(PH_PLE)) { pg8::DenseOrder S; S.init(T, D, D, F.G, (int)blockIdx.x); EpiPle E{PP, H}; pg8::gemm_phase<EpiPle, pg8::DenseOrder, false>(F.lds + RING_OFF, N1, WPLEG, D, S, E); }
    SEAM(PH_PLE);
    if (IN(PH_FINAL)) {
        const float* gain = F.in[I_NORM_FINAL];
        for (int t = gw; t < T; t += NGW) {
            f32x4* hr = (f32x4*)(H + (size_t)t * D) + lane; const f32x4* gr = (const f32x4*)gain + lane;
            f32x4 v[8]; float s = 0.f;
#pragma unroll
            for (int j = 0; j < 8; ++j) { v[j] = hr[64 * j]; s += (v[j].x * v[j].x + v[j].y * v[j].y) + (v[j].z * v[j].z + v[j].w * v[j].w); }
            const float rstd = 1.0f / sqrtf(wave_sum(s) * (1.f / D) + EPS);
#pragma unroll
            for (int j = 0; j < 8; ++j) { const f32x4 g = gr[64 * j]; hr[64 * j] = v[j] * rstd * g; }
        }
    }
#undef IN
#undef SEAM
}

extern "C" void kernel_launch(void* const* d_in, const int* in_sizes, int n_in, void* d_out, int out_size, void* d_ws, size_t ws_size, hipStream_t stream) {
    static int grid = 0;
    if (grid == 0) {
        if (n_in != 25 || in_sizes[0] != T * D || out_size != T * D || ws_size < WS_END) { fprintf(stderr, "kernel_launch: unexpected shapes (n_in %d, in0 %d, out %d, ws %zu); nothing launched\n", n_in, n_in > 0 ? in_sizes[0] : -1, out_size, ws_size); grid = -1; return; }
        int dev = 0, cus = 0, per_cu = 0;
        if (hipGetDevice(&dev) != hipSuccess || hipDeviceGetAttribute(&cus, hipDeviceAttributeMultiprocessorCount, dev) != hipSuccess) { grid = -1; return; }
        if (hipFuncSetAttribute((const void*)fwd, hipFuncAttributeMaxDynamicSharedMemorySize, LDS_BYTES) != hipSuccess) { fprintf(stderr, "kernel_launch: hipFuncSetAttribute failed\n"); grid = -1; return; }
        if (hipOccupancyMaxActiveBlocksPerMultiprocessor(&per_cu, (const void*)fwd, NTHR, LDS_BYTES) != hipSuccess || per_cu < 1) fprintf(stderr, "kernel_launch: occupancy query reports %d\n", per_cu);
        (void)hipGetLastError();
        grid = cus;
    }
    if (grid < 0) return;
    (void)hipMemsetAsync((char*)d_ws + WS_CTL, 0, CTL_ZERO_BYTES, stream);
    Args a{};
    for (int i = 0; i < 25; ++i) a.in[i] = (const float*)d_in[i];
    a.out = (float*)d_out; a.ws = (unsigned char*)d_ws;
    if (MK_N_LAUNCHES == 1) { a.ph_lo = 0; a.ph_hi = NPHASE; hipLaunchKernelGGL(fwd, dim3(grid), dim3(NTHR), LDS_BYTES, stream, a); }
    else for (int k = 0; k < NPHASE; ++k) { a.ph_lo = k; a.ph_hi = k + 1; hipLaunchKernelGGL(fwd, dim3(grid), dim3(NTHR), LDS_BYTES, stream, a); }
}
```

```cpp
#include <hip/hip_runtime.h>
#include <cstdio>
#include <cstdint>

#ifndef MK_N_LAUNCHES
#define MK_N_LAUNCHES 1
#endif

#define GAS __attribute__((address_space(1)))
#define LAS __attribute__((address_space(3)))
typedef unsigned short bf16;
typedef unsigned v4u __attribute__((ext_vector_type(4)));
typedef unsigned v2u __attribute__((ext_vector_type(2)));
typedef float f32x4 __attribute__((ext_vector_type(4)));
typedef float f32x16 __attribute__((ext_vector_type(16)));
typedef short bf16x8 __attribute__((ext_vector_type(8)));

constexpr int NB = 4, SEQ = 8192, T = NB * SEQ, D = 2048;
constexpr int D_PLE = 256, D_POOL = 1024, POOL_GW = 256, NH = 8, DK = 128, D_QKV = 3072, D_Z = 1024;
constexpr int D_IN = 9232, N_IN_PAD = 9216;
constexpr int NE = 32, EPG = 8, NGRP = 4, DE = 512;
constexpr float EPS = 1e-6f;
constexpr int NWAVES = 8, NTHR = 512;
constexpr int DN_UNITS = NB * NH * (SEQ / 64);
constexpr int STG_BYTES = 58368 + 16384;
constexpr int PKG_BYTES = 58368;

constexpr size_t MiB = 1u << 20;
constexpr size_t WS_CTL = 0, CTL_ZERO_BYTES = 65536;
constexpr size_t WS_WRT = 512 * 1024;
constexpr size_t WS_WIN = 1 * MiB;
constexpr size_t WS_WCOMB = 38 * MiB;
constexpr size_t WS_WUPDN = 42 * MiB;
constexpr size_t WS_WOUT = 46 * MiB;
constexpr size_t WS_WPLEG = 54 * MiB;
constexpr size_t WS_WPLEP = 62 * MiB;
constexpr size_t WS_WGU = 63 * MiB;
constexpr size_t WS_WDN = 191 * MiB;
constexpr size_t WS_BA = 255 * MiB;
constexpr size_t WS_G = 257 * MiB;
constexpr size_t WS_BETA = 258 * MiB;
constexpr size_t WS_LTK = 259 * MiB;
constexpr size_t WS_LW = 263 * MiB;
constexpr size_t WS_PBF = 267 * MiB;
constexpr size_t WS_N1 = 283 * MiB;
constexpr size_t WS_PKG = 283 * MiB;
constexpr size_t WS_UT = 511 * MiB;
constexpr size_t WS_OB = 575 * MiB;
constexpr size_t WS_QKV = 411 * MiB;
constexpr size_t WS_MP = 539 * MiB;
constexpr size_t WS_UPOOL = 603 * MiB;
constexpr size_t WS_Z = 667 * MiB;
constexpr size_t WS_GP = 731 * MiB;
constexpr size_t WS_GD = 859 * MiB;
constexpr size_t WS_END = 987 * MiB;
constexpr size_t OUT_D = 0, OUT_QKV2 = 64 * MiB;
constexpr int CW_CNT = 1024;
constexpr int CW_BAR = 4096;

constexpr int RING_OFF = 0, RING_BYTES = 153600;
constexpr int MISC_OFF = RING_BYTES;
constexpr int MISC_WORDS = 256;
constexpr int LDS_BYTES = 154624;

#define LDS_WAIT() asm volatile("s_waitcnt lgkmcnt(0)" ::: "memory")
#define VM_WAIT() asm volatile("s_waitcnt vmcnt(0)" ::: "memory")
#define LDS_BARRIER() do { asm volatile("s_waitcnt lgkmcnt(0)" ::: "memory"); __builtin_amdgcn_s_barrier(); asm volatile("" ::: "memory"); } while (0)
__device__ __forceinline__ float bflo(unsigned u) { return __uint_as_float(u << 16); }
__device__ __forceinline__ float bfhi(unsigned u) { return __uint_as_float(u & 0xffff0000u); }
__device__ __forceinline__ float bf2f(bf16 b) { return __uint_as_float((unsigned)b << 16); }
__device__ __forceinline__ unsigned f2bf(float f) { unsigned u = __float_as_uint(f); return (u + 0x7fffu + ((u >> 16) & 1u)) >> 16; }
typedef __bf16 bf16x2_t __attribute__((ext_vector_type(2)));
typedef float f32x2_t __attribute__((ext_vector_type(2)));
__device__ __forceinline__ unsigned pk2(float lo, float hi) { const f32x2_t v = {lo, hi}; const bf16x2_t b = __builtin_convertvector(v, bf16x2_t); return __builtin_bit_cast(unsigned, b); }
__device__ __forceinline__ float wave_sum(float v) {
#pragma unroll
    for (int o = 1; o < 64; o <<= 1) v += __shfl_xor(v, o);
    return v;
}
__device__ __forceinline__ float sigmoidf_(float x) { return 1.0f / (1.0f + __expf(-x)); }
__device__ __forceinline__ float siluf_(float x) { return x / (1.0f + __expf(-x)); }
__device__ __forceinline__ void store8bf(bf16* p, const float* v) {
    v4u o; o.x = pk2(v[0], v[1]); o.y = pk2(v[2], v[3]); o.z = pk2(v[4], v[5]); o.w = pk2(v[6], v[7]); *(v4u*)p = o;
}
__device__ __forceinline__ void load8bf(const bf16* p, float* v) {
    const v4u o = *(const v4u*)p; v[0] = bflo(o.x); v[1] = bfhi(o.x); v[2] = bflo(o.y); v[3] = bfhi(o.y); v[4] = bflo(o.z); v[5] = bfhi(o.z); v[6] = bflo(o.w); v[7] = bfhi(o.w);
}

__device__ __forceinline__ int tix(int row, int k, int kd16) { const int k16 = k & 15; return ((((row >> 5) * kd16 + (k >> 4)) * 64 + ((k16 >> 2) & 1) * 32 + (row & 31)) << 3) + (k16 & 3) + ((k16 >> 3) << 2); }


template <int J> __device__ __forceinline__ void fmac_bcast(float& acc, float l, float x) {
    asm volatile("v_fmac_f32_dpp %0, %1, %2 row_newbcast:%3 row_mask:0xf bank_mask:0xf" : "+v"(acc) : "v"(l), "v"(x), "n"(J));
}
template <int N> struct FmacChunk;
template <> struct FmacChunk<1> {
    static __device__ __forceinline__ void run(float& acc, float l, float x0) {
        asm volatile("v_fmac_f32_dpp %0, %1, %2 row_newbcast:0 row_mask:0xf bank_mask:0xf\n\t" : "+v"(acc) : "v"(l), "v"(x0));
    }
};
template <> struct FmacChunk<2> {
    static __device__ __forceinline__ void run(float& acc, float l, float x0, float x1) {
        asm volatile("v_fmac_f32_dpp %0, %1, %2 row_newbcast:0 row_mask:0xf bank_mask:0xf\n\t" "v_fmac_f32_dpp %0, %1, %3 row_newbcast:1 row_mask:0xf bank_mask:0xf\n\t" : "+v"(acc) : "v"(l), "v"(x0), "v"(x1));
    }
};
template <> struct FmacChunk<3> {
    static __device__ __forceinline__ void run(float& acc, float l, float x0, float x1, float x2) {
        asm volatile("v_fmac_f32_dpp %0, %1, %2 row_newbcast:0 row_mask:0xf bank_mask:0xf\n\t" "v_fmac_f32_dpp %0, %1, %3 row_newbcast:1 row_mask:0xf bank_mask:0xf\n\t" "v_fmac_f32_dpp %0, %1, %4 row_newbcast:2 row_mask:0xf bank_mask:0xf\n\t" : "+v"(acc) : "v"(l), "v"(x0), "v"(x1), "v"(x2));
    }
};
template <> struct FmacChunk<4> {
    static __device__ __forceinline__ void run(float& acc, float l, float x0, float x1, float x2, float x3) {
        asm volatile("v_fmac_f32_dpp %0, %1, %2 row_newbcast:0 row_mask:0xf bank_mask:0xf\n\t" "v_fmac_f32_dpp %0, %1, %3 row_newbcast:1 row_mask:0xf bank_mask:0xf\n\t" "v_fmac_f32_dpp %0, %1, %4 row_newbcast:2 row_mask:0xf bank_mask:0xf\n\t" "v_fmac_f32_dpp %0, %1, %5 row_newbcast:3 row_mask:0xf bank_mask:0xf\n\t" : "+v"(acc) : "v"(l), "v"(x0), "v"(x1), "v"(x2), "v"(x3));
    }
};
template <> struct FmacChunk<5> {
    static __device__ __forceinline__ void run(float& acc, float l, float x0, float x1, float x2, float x3, float x4) {
        asm volatile("v_fmac_f32_dpp %0, %1, %2 row_newbcast:0 row_mask:0xf bank_mask:0xf\n\t" "v_fmac_f32_dpp %0, %1, %3 row_newbcast:1 row_mask:0xf bank_mask:0xf\n\t" "v_fmac_f32_dpp %0, %1, %4 row_newbcast:2 row_mask:0xf bank_mask:0xf\n\t" "v_fmac_f32_dpp %0, %1, %5 row_newbcast:3 row_mask:0xf bank_mask:0xf\n\t" "v_fmac_f32_dpp %0, %1, %6 row_newbcast:4 row_mask:0xf bank_mask:0xf\n\t" : "+v"(acc) : "v"(l), "v"(x0), "v"(x1), "v"(x2), "v"(x3), "v"(x4));
    }
};
template <> struct FmacChunk<6> {
    static __device__ __forceinline__ void run(float& acc, float l, float x0, float x1, float x2, float x3, float x4, float x5) {
        asm volatile("v_fmac_f32_dpp %0, %1, %2 row_newbcast:0 row_mask:0xf bank_mask:0xf\n\t" "v_fmac_f32_dpp %0, %1, %3 row_newbcast:1 row_mask:0xf bank_mask:0xf\n\t" "v_fmac_f32_dpp %0, %1, %4 row_newbcast:2 row_mask:0xf bank_mask:0xf\n\t" "v_fmac_f32_dpp %0, %1, %5 row_newbcast:3 row_mask:0xf bank_mask:0xf\n\t" "v_fmac_f32_dpp %0, %1, %6 row_newbcast:4 row_mask:0xf bank_mask:0xf\n\t" "v_fmac_f32_dpp %0, %1, %7 row_newbcast:5 row_mask:0xf bank_mask:0xf\n\t" : "+v"(acc) : "v"(l), "v"(x0), "v"(x1), "v"(x2), "v"(x3), "v"(x4), "v"(x5));
    }
};
template <> struct FmacChunk<7> {
    static __device__ __forceinline__ void run(float& acc, float l, float x0, float x1, float x2, float x3, float x4, float x5, float x6) {
        asm volatile("v_fmac_f32_dpp %0, %1, %2 row_newbcast:0 row_mask:0xf bank_mask:0xf\n\t" "v_fmac_f32_dpp %0, %1, %3 row_newbcast:1 row_mask:0xf bank_mask:0xf\n\t" "v_fmac_f32_dpp %0, %1, %4 row_newbcast:2 row_mask:0xf bank_mask:0xf\n\t" "v_fmac_f32_dpp %0, %1, %5 row_newbcast:3 row_mask:0xf bank_mask:0xf\n\t" "v_fmac_f32_dpp %0, %1, %6 row_newbcast:4 row_mask:0xf bank_mask:0xf\n\t" "v_fmac_f32_dpp %0, %1, %7 row_newbcast:5 row_mask:0xf bank_mask:0xf\n\t" "v_fmac_f32_dpp %0, %1, %8 row_newbcast:6 row_mask:0xf bank_mask:0xf\n\t" : "+v"(acc) : "v"(l), "v"(x0), "v"(x1), "v"(x2), "v"(x3), "v"(x4), "v"(x5), "v"(x6));
    }
};
template <> struct FmacChunk<8> {
    static __device__ __forceinline__ void run(float& acc, float l, float x0, float x1, float x2, float x3, float x4, float x5, float x6, float x7) {
        asm volatile("v_fmac_f32_dpp %0, %1, %2 row_newbcast:0 row_mask:0xf bank_mask:0xf\n\t" "v_fmac_f32_dpp %0, %1, %3 row_newbcast:1 row_mask:0xf bank_mask:0xf\n\t" "v_fmac_f32_dpp %0, %1, %4 row_newbcast:2 row_mask:0xf bank_mask:0xf\n\t" "v_fmac_f32_dpp %0, %1, %5 row_newbcast:3 row_mask:0xf bank_mask:0xf\n\t" "v_fmac_f32_dpp %0, %1, %6 row_newbcast:4 row_mask:0xf bank_mask:0xf\n\t" "v_fmac_f32_dpp %0, %1, %7 row_newbcast:5 row_mask:0xf bank_mask:0xf\n\t" "v_fmac_f32_dpp %0, %1, %8 row_newbcast:6 row_mask:0xf bank_mask:0xf\n\t" "v_fmac_f32_dpp %0, %1, %9 row_newbcast:7 row_mask:0xf bank_mask:0xf\n\t" : "+v"(acc) : "v"(l), "v"(x0), "v"(x1), "v"(x2), "v"(x3), "v"(x4), "v"(x5), "v"(x6), "v"(x7));
    }
};
template <> struct FmacChunk<9> {
    static __device__ __forceinline__ void run(float& acc, float l, float x0, float x1, float x2, float x3, float x4, float x5, float x6, float x7, float x8) {
        asm volatile("v_fmac_f32_dpp %0, %1, %2 row_newbcast:0 row_mask:0xf bank_mask:0xf\n\t" "v_fmac_f32_dpp %0, %1, %3 row_newbcast:1 row_mask:0xf bank_mask:0xf\n\t" "v_fmac_f32_dpp %0, %1, %4 row_newbcast:2 row_mask:0xf bank_mask:0xf\n\t" "v_fmac_f32_dpp %0, %1, %5 row_newbcast:3 row_mask:0xf bank_mask:0xf\n\t" "v_fmac_f32_dpp %0, %1, %6 row_newbcast:4 row_mask:0xf bank_mask:0xf\n\t" "v_fmac_f32_dpp %0, %1, %7 row_newbcast:5 row_mask:0xf bank_mask:0xf\n\t" "v_fmac_f32_dpp %0, %1, %8 row_newbcast:6 row_mask:0xf bank_mask:0xf\n\t" "v_fmac_f32_dpp %0, %1, %9 row_newbcast:7 row_mask:0xf bank_mask:0xf\n\t" "v_fmac_f32_dpp %0, %1, %10 row_newbcast:8 row_mask:0xf bank_mask:0xf\n\t" : "+v"(acc) : "v"(l), "v"(x0), "v"(x1), "v"(x2), "v"(x3), "v"(x4), "v"(x5), "v"(x6), "v"(x7), "v"(x8));
    }
};
template <> struct FmacChunk<10> {
    static __device__ __forceinline__ void run(float& acc, float l, float x0, float x1, float x2, float x3, float x4, float x5, float x6, float x7, float x8, float x9) {
        asm volatile("v_fmac_f32_dpp %0, %1, %2 row_newbcast:0 row_mask:0xf bank_mask:0xf\n\t" "v_fmac_f32_dpp %0, %1, %3 row_newbcast:1 row_mask:0xf bank_mask:0xf\n\t" "v_fmac_f32_dpp %0, %1, %4 row_newbcast:2 row_mask:0xf bank_mask:0xf\n\t" "v_fmac_f32_dpp %0, %1, %5 row_newbcast:3 row_mask:0xf bank_mask:0xf\n\t" "v_fmac_f32_dpp %0, %1, %6 row_newbcast:4 row_mask:0xf bank_mask:0xf\n\t" "v_fmac_f32_dpp %0, %1, %7 row_newbcast:5 row_mask:0xf bank_mask:0xf\n\t" "v_fmac_f32_dpp %0, %1, %8 row_newbcast:6 row_mask:0xf bank_mask:0xf\n\t" "v_fmac_f32_dpp %0, %1, %9 row_newbcast:7 row_mask:0xf bank_mask:0xf\n\t" "v_fmac_f32_dpp %0, %1, %10 row_newbcast:8 row_mask:0xf bank_mask:0xf\n\t" "v_fmac_f32_dpp %0, %1, %11 row_newbcast:9 row_mask:0xf bank_mask:0xf\n\t" : "+v"(acc) : "v"(l), "v"(x0), "v"(x1), "v"(x2), "v"(x3), "v"(x4), "v"(x5), "v"(x6), "v"(x7), "v"(x8), "v"(x9));
    }
};
template <> struct FmacChunk<11> {
    static __device__ __forceinline__ void run(float& acc, float l, float x0, float x1, float x2, float x3, float x4, float x5, float x6, float x7, float x8, float x9, float x10) {
        asm volatile("v_fmac_f32_dpp %0, %1, %2 row_newbcast:0 row_mask:0xf bank_mask:0xf\n\t" "v_fmac_f32_dpp %0, %1, %3 row_newbcast:1 row_mask:0xf bank_mask:0xf\n\t" "v_fmac_f32_dpp %0, %1, %4 row_newbcast:2 row_mask:0xf bank_mask:0xf\n\t" "v_fmac_f32_dpp %0, %1, %5 row_newbcast:3 row_mask:0xf bank_mask:0xf\n\t" "v_fmac_f32_dpp %0, %1, %6 row_newbcast:4 row_mask:0xf bank_mask:0xf\n\t" "v_fmac_f32_dpp %0, %1, %7 row_newbcast:5 row_mask:0xf bank_mask:0xf\n\t" "v_fmac_f32_dpp %0, %1, %8 row_newbcast:6 row_mask:0xf bank_mask:0xf\n\t" "v_fmac_f32_dpp %0, %1, %9 row_newbcast:7 row_mask:0xf bank_mask:0xf\n\t" "v_fmac_f32_dpp %0, %1, %10 row_newbcast:8 row_mask:0xf bank_mask:0xf\n\t" "v_fmac_f32_dpp %0, %1, %11 row_newbcast:9 row_mask:0xf bank_mask:0xf\n\t" "v_fmac_f32_dpp %0, %1, %12 row_newbcast:10 row_mask:0xf bank_mask:0xf\n\t" : "+v"(acc) : "v"(l), "v"(x0), "v"(x1), "v"(x2), "v"(x3), "v"(x4), "v"(x5), "v"(x6), "v"(x7), "v"(x8), "v"(x9), "v"(x10));
    }
};
template <> struct FmacChunk<12> {
    static __device__ __forceinline__ void run(float& acc, float l, float x0, float x1, float x2, float x3, float x4, float x5, float x6, float x7, float x8, float x9, float x10, float x11) {
        asm volatile("v_fmac_f32_dpp %0, %1, %2 row_newbcast:0 row_mask:0xf bank_mask:0xf\n\t" "v_fmac_f32_dpp %0, %1, %3 row_newbcast:1 row_mask:0xf bank_mask:0xf\n\t" "v_fmac_f32_dpp %0, %1, %4 row_newbcast:2 row_mask:0xf bank_mask:0xf\n\t" "v_fmac_f32_dpp %0, %1, %5 row_newbcast:3 row_mask:0xf bank_mask:0xf\n\t" "v_fmac_f32_dpp %0, %1, %6 row_newbcast:4 row_mask:0xf bank_mask:0xf\n\t" "v_fmac_f32_dpp %0, %1, %7 row_newbcast:5 row_mask:0xf bank_mask:0xf\n\t" "v_fmac_f32_dpp %0, %1, %8 row_newbcast:6 row_mask:0xf bank_mask:0xf\n\t" "v_fmac_f32_dpp %0, %1, %9 row_newbcast:7 row_mask:0xf bank_mask:0xf\n\t" "v_fmac_f32_dpp %0, %1, %10 row_newbcast:8 row_mask:0xf bank_mask:0xf\n\t" "v_fmac_f32_dpp %0, %1, %11 row_newbcast:9 row_mask:0xf bank_mask:0xf\n\t" "v_fmac_f32_dpp %0, %1, %12 row_newbcast:10 row_mask:0xf bank_mask:0xf\n\t" "v_fmac_f32_dpp %0, %1, %13 row_newbcast:11 row_mask:0xf bank_mask:0xf\n\t" : "+v"(acc) : "v"(l), "v"(x0), "v"(x1), "v"(x2), "v"(x3), "v"(x4), "v"(x5), "v"(x6), "v"(x7), "v"(x8), "v"(x9), "v"(x10), "v"(x11));
    }
};
template <> struct FmacChunk<13> {
    static __device__ __forceinline__ void run(float& acc, float l, float x0, float x1, float x2, float x3, float x4, float x5, float x6, float x7, float x8, float x9, float x10, float x11, float x12) {
        asm volatile("v_fmac_f32_dpp %0, %1, %2 row_newbcast:0 row_mask:0xf bank_mask:0xf\n\t" "v_fmac_f32_dpp %0, %1, %3 row_newbcast:1 row_mask:0xf bank_mask:0xf\n\t" "v_fmac_f32_dpp %0, %1, %4 row_newbcast:2 row_mask:0xf bank_mask:0xf\n\t" "v_fmac_f32_dpp %0, %1, %5 row_newbcast:3 row_mask:0xf bank_mask:0xf\n\t" "v_fmac_f32_dpp %0, %1, %6 row_newbcast:4 row_mask:0xf bank_mask:0xf\n\t" "v_fmac_f32_dpp %0, %1, %7 row_newbcast:5 row_mask:0xf bank_mask:0xf\n\t" "v_fmac_f32_dpp %0, %1, %8 row_newbcast:6 row_mask:0xf bank_mask:0xf\n\t" "v_fmac_f32_dpp %0, %1, %9 row_newbcast:7 row_mask:0xf bank_mask:0xf\n\t" "v_fmac_f32_dpp %0, %1, %10 row_newbcast:8 row_mask:0xf bank_mask:0xf\n\t" "v_fmac_f32_dpp %0, %1, %11 row_newbcast:9 row_mask:0xf bank_mask:0xf\n\t" "v_fmac_f32_dpp %0, %1, %12 row_newbcast:10 row_mask:0xf bank_mask:0xf\n\t" "v_fmac_f32_dpp %0, %1, %13 row_newbcast:11 row_mask:0xf bank_mask:0xf\n\t" "v_fmac_f32_dpp %0, %1, %14 row_newbcast:12 row_mask:0xf bank_mask:0xf\n\t" : "+v"(acc) : "v"(l), "v"(x0), "v"(x1), "v"(x2), "v"(x3), "v"(x4), "v"(x5), "v"(x6), "v"(x7), "v"(x8), "v"(x9), "v"(x10), "v"(x11), "v"(x12));
    }
};
template <> struct FmacChunk<14> {
    static __device__ __forceinline__ void run(float& acc, float l, float x0, float x1, float x2, float x3, float x4, float x5, float x6, float x7, float x8, float x9, float x10, float x11, float x12, float x13) {
        asm volatile("v_fmac_f32_dpp %0, %1, %2 row_newbcast:0 row_mask:0xf bank_mask:0xf\n\t" "v_fmac_f32_dpp %0, %1, %3 row_newbcast:1 row_mask:0xf bank_mask:0xf\n\t" "v_fmac_f32_dpp %0, %1, %4 row_newbcast:2 row_mask:0xf bank_mask:0xf\n\t" "v_fmac_f32_dpp %0, %1, %5 row_newbcast:3 row_mask:0xf bank_mask:0xf\n\t" "v_fmac_f32_dpp %0, %1, %6 row_newbcast:4 row_mask:0xf bank_mask:0xf\n\t" "v_fmac_f32_dpp %0, %1, %7 row_newbcast:5 row_mask:0xf bank_mask:0xf\n\t" "v_fmac_f32_dpp %0, %1, %8 row_newbcast:6 row_mask:0xf bank_mask:0xf\n\t" "v_fmac_f32_dpp %0, %1, %9 row_newbcast:7 row_mask:0xf bank_mask:0xf\n\t" "v_fmac_f32_dpp %0, %1, %10 row_newbcast:8 row_mask:0xf bank_mask:0xf\n\t" "v_fmac_f32_dpp %0, %1, %11 row_newbcast:9 row_mask:0xf bank_mask:0xf\n\t" "v_fmac_f32_dpp %0, %1, %12 row_newbcast:10 row_mask:0xf bank_mask:0xf\n\t" "v_fmac_f32_dpp %0, %1, %13 row_newbcast:11 row_mask:0xf bank_mask:0xf\n\t" "v_fmac_f32_dpp %0, %1, %14 row_newbcast:12 row_mask:0xf bank_mask:0xf\n\t" "v_fmac_f32_dpp %0, %1, %15 row_newbcast:13 row_mask:0xf bank_mask:0xf\n\t" : "+v"(acc) : "v"(l), "v"(x0), "v"(x1), "v"(x2), "v"(x3), "v"(x4), "v"(x5), "v"(x6), "v"(x7), "v"(x8), "v"(x9), "v"(x10), "v"(x11), "v"(x12), "v"(x13));
    }
};
template <> struct FmacChunk<15> {
    static __device__ __forceinline__ void run(float& acc, float l, float x0, float x1, float x2, float x3, float x4, float x5, float x6, float x7, float x8, float x9, float x10, float x11, float x12, float x13, float x14) {
        asm volatile("v_fmac_f32_dpp %0, %1, %2 row_newbcast:0 row_mask:0xf bank_mask:0xf\n\t" "v_fmac_f32_dpp %0, %1, %3 row_newbcast:1 row_mask:0xf bank_mask:0xf\n\t" "v_fmac_f32_dpp %0, %1, %4 row_newbcast:2 row_mask:0xf bank_mask:0xf\n\t" "v_fmac_f32_dpp %0, %1, %5 row_newbcast:3 row_mask:0xf bank_mask:0xf\n\t" "v_fmac_f32_dpp %0, %1, %6 row_newbcast:4 row_mask:0xf bank_mask:0xf\n\t" "v_fmac_f32_dpp %0, %1, %7 row_newbcast:5 row_mask:0xf bank_mask:0xf\n\t" "v_fmac_f32_dpp %0, %1, %8 row_newbcast:6 row_mask:0xf bank_mask:0xf\n\t" "v_fmac_f32_dpp %0, %1, %9 row_newbcast:7 row_mask:0xf bank_mask:0xf\n\t" "v_fmac_f32_dpp %0, %1, %10 row_newbcast:8 row_mask:0xf bank_mask:0xf\n\t" "v_fmac_f32_dpp %0, %1, %11 row_newbcast:9 row_mask:0xf bank_mask:0xf\n\t" "v_fmac_f32_dpp %0, %1, %12 row_newbcast:10 row_mask:0xf bank_mask:0xf\n\t" "v_fmac_f32_dpp %0, %1, %13 row_newbcast:11 row_mask:0xf bank_mask:0xf\n\t" "v_fmac_f32_dpp %0, %1, %14 row_newbcast:12 row_mask:0xf bank_mask:0xf\n\t" "v_fmac_f32_dpp %0, %1, %15 row_newbcast:13 row_mask:0xf bank_mask:0xf\n\t" "v_fmac_f32_dpp %0, %1, %16 row_newbcast:14 row_mask:0xf bank_mask:0xf\n\t" : "+v"(acc) : "v"(l), "v"(x0), "v"(x1), "v"(x2), "v"(x3), "v"(x4), "v"(x5), "v"(x6), "v"(x7), "v"(x8), "v"(x9), "v"(x10), "v"(x11), "v"(x12), "v"(x13), "v"(x14));
    }
};
template <> struct FmacChunk<16> {
    static __device__ __forceinline__ void run(float& acc, float l, float x0, float x1, float x2, float x3, float x4, float x5, float x6, float x7, float x8, float x9, float x10, float x11, float x12, float x13, float x14, float x15) {
        asm volatile("v_fmac_f32_dpp %0, %1, %2 row_newbcast:0 row_mask:0xf bank_mask:0xf\n\t" "v_fmac_f32_dpp %0, %1, %3 row_newbcast:1 row_mask:0xf bank_mask:0xf\n\t" "v_fmac_f32_dpp %0, %1, %4 row_newbcast:2 row_mask:0xf bank_mask:0xf\n\t" "v_fmac_f32_dpp %0, %1, %5 row_newbcast:3 row_mask:0xf bank_mask:0xf\n\t" "v_fmac_f32_dpp %0, %1, %6 row_newbcast:4 row_mask:0xf bank_mask:0xf\n\t" "v_fmac_f32_dpp %0, %1, %7 row_newbcast:5 row_mask:0xf bank_mask:0xf\n\t" "v_fmac_f32_dpp %0, %1, %8 row_newbcast:6 row_mask:0xf bank_mask:0xf\n\t" "v_fmac_f32_dpp %0, %1, %9 row_newbcast:7 row_mask:0xf bank_mask:0xf\n\t" "v_fmac_f32_dpp %0, %1, %10 row_newbcast:8 row_mask:0xf bank_mask:0xf\n\t" "v_fmac_f32_dpp %0, %1, %11 row_newbcast:9 row_mask:0xf bank_mask:0xf\n\t" "v_fmac_f32_dpp %0, %1, %12 row_newbcast:10 row_mask:0xf bank_mask:0xf\n\t" "v_fmac_f32_dpp %0, %1, %13 row_newbcast:11 row_mask:0xf bank_mask:0xf\n\t" "v_fmac_f32_dpp %0, %1, %14 row_newbcast:12 row_mask:0xf bank_mask:0xf\n\t" "v_fmac_f32_dpp %0, %1, %15 row_newbcast:13 row_mask:0xf bank_mask:0xf\n\t" "v_fmac_f32_dpp %0, %1, %16 row_newbcast:14 row_mask:0xf bank_mask:0xf\n\t" "v_fmac_f32_dpp %0, %1, %17 row_newbcast:15 row_mask:0xf bank_mask:0xf\n\t" : "+v"(acc) : "v"(l), "v"(x0), "v"(x1), "v"(x2), "v"(x3), "v"(x4), "v"(x5), "v"(x6), "v"(x7), "v"(x8), "v"(x9), "v"(x10), "v"(x11), "v"(x12), "v"(x13), "v"(x14), "v"(x15));
    }
};
template <int N, int B> struct ChunkCall;
#define CC_ARGS1(B) x[B]
#define CC_ARGS2(B) CC_ARGS1(B), x[B + 1]
#define CC_ARGS3(B) CC_ARGS2(B), x[B + 2]
#define CC_ARGS4(B) CC_ARGS3(B), x[B + 3]
#define CC_ARGS5(B) CC_ARGS4(B), x[B + 4]
#define CC_ARGS6(B) CC_ARGS5(B), x[B + 5]
#define CC_ARGS7(B) CC_ARGS6(B), x[B + 6]
#define CC_ARGS8(B) CC_ARGS7(B), x[B + 7]
#define CC_ARGS9(B) CC_ARGS8(B), x[B + 8]
#define CC_ARGS10(B) CC_ARGS9(B), x[B + 9]
#define CC_ARGS11(B) CC_ARGS10(B), x[B + 10]
#define CC_ARGS12(B) CC_ARGS11(B), x[B + 11]
#define CC_ARGS13(B) CC_ARGS12(B), x[B + 12]
#define CC_ARGS14(B) CC_ARGS13(B), x[B + 13]
#define CC_ARGS15(B) CC_ARGS14(B), x[B + 14]
#define CC_ARGS16(B) CC_ARGS15(B), x[B + 15]
#define CC_DEF(N) template <int B> struct ChunkCall<N, B> { static __device__ __forceinline__ void run(float (&x)[64], float& acc, float l) { FmacChunk<N>::run(acc, l, CC_ARGS##N(B)); } };
CC_DEF(1) CC_DEF(2) CC_DEF(3) CC_DEF(4) CC_DEF(5) CC_DEF(6) CC_DEF(7) CC_DEF(8) CC_DEF(9) CC_DEF(10) CC_DEF(11) CC_DEF(12) CC_DEF(13) CC_DEF(14) CC_DEF(15) CC_DEF(16)
#undef CC_DEF
template <int N> struct QuadChunk;
template <> struct QuadChunk<1> {
    static __device__ __forceinline__ void run(float& a0, float& a1, float& a2, float& a3, float l0, float l1, float l2, float l3, float x0) {
        asm volatile("v_fmac_f32_dpp %0, %4, %8 row_newbcast:0 row_mask:0xf bank_mask:0xf\n\t" "v_fmac_f32_dpp %1, %5, %8 row_newbcast:0 row_mask:0xf bank_mask:0xf\n\t" "v_fmac_f32_dpp %2, %6, %8 row_newbcast:0 row_mask:0xf bank_mask:0xf\n\t" "v_fmac_f32_dpp %3, %7, %8 row_newbcast:0 row_mask:0xf bank_mask:0xf\n\t" : "+v"(a0), "+v"(a1), "+v"(a2), "+v"(a3) : "v"(l0), "v"(l1), "v"(l2), "v"(l3), "v"(x0));
    }
};
template <> struct QuadChunk<2> {
    static __device__ __forceinline__ void run(float& a0, float& a1, float& a2, float& a3, float l0, float l1, float l2, float l3, float x0, float x1) {
        asm volatile("v_fmac_f32_dpp %0, %4, %8 row_newbcast:0 row_mask:0xf bank_mask:0xf\n\t" "v_fmac_f32_dpp %1, %5, %8 row_newbcast:0 row_mask:0xf bank_mask:0xf\n\t" "v_fmac_f32_dpp %2, %6, %8 row_newbcast:0 row_mask:0xf bank_mask:0xf\n\t" "v_fmac_f32_dpp %3, %7, %8 row_newbcast:0 row_mask:0xf bank_mask:0xf\n\t" "v_fmac_f32_dpp %0, %4, %9 row_newbcast:1 row_mask:0xf bank_mask:0xf\n\t" "v_fmac_f32_dpp %1, %5, %9 row_newbcast:1 row_mask:0xf bank_mask:0xf\n\t" "v_fmac_f32_dpp %2, %6, %9 row_newbcast:1 row_mask:0xf bank_mask:0xf\n\t" "v_fmac_f32_dpp %3, %7, %9 row_newbcast:1 row_mask:0xf bank_mask:0xf\n\t" : "+v"(a0), "+v"(a1), "+v"(a2), "+v"(a3) : "v"(l0), "v"(l1), "v"(l2), "v"(l3), "v"(x0), "v"(x1));
    }
};
template <> struct QuadChunk<3> {
    static __device__ __forceinline__ void run(float& a0, float& a1, float& a2, float& a3, float l0, float l1, float l2, float l3, float x0, float x1, float x2) {
        asm volatile("v_fmac_f32_dpp %0, %4, %8 row_newbcast:0 row_mask:0xf bank_mask:0xf\n\t" "v_fmac_f32_dpp %1, %5, %8 row_newbcast:0 row_mask:0xf bank_mask:0xf\n\t" "v_fmac_f32_dpp %2, %6, %8 row_newbcast:0 row_mask:0xf bank_mask:0xf\n\t" "v_fmac_f32_dpp %3, %7, %8 row_newbcast:0 row_mask:0xf bank_mask:0xf\n\t" "v_fmac_f32_dpp %0, %4, %9 row_newbcast:1 row_mask:0xf bank_mask:0xf\n\t" "v_fmac_f32_dpp %1, %5, %9 row_newbcast:1 row_mask:0xf bank_mask:0xf\n\t" "v_fmac_f32_dpp %2, %6, %9 row_newbcast:1 row_mask:0xf bank_mask:0xf\n\t" "v_fmac_f32_dpp %3, %7, %9 row_newbcast:1 row_mask:0xf bank_mask:0xf\n\t" "v_fmac_f32_dpp %0, %4, %10 row_newbcast:2 row_mask:0xf bank_mask:0xf\n\t" "v_fmac_f32_dpp %1, %5, %10 row_newbcast:2 row_mask:0xf bank_mask:0xf\n\t" "v_fmac_f32_dpp %2, %6, %10 row_newbcast:2 row_mask:0xf bank_mask:0xf\n\t" "v_fmac_f32_dpp %3, %7, %10 row_newbcast:2 row_mask:0xf bank_mask:0xf\n\t" : "+v"(a0), "+v"(a1), "+v"(a2), "+v"(a3) : "v"(l0), "v"(l1), "v"(l2), "v"(l3), "v"(x0), "v"(x1), "v"(x2));
    }
};
template <> struct QuadChunk<4> {
    static __device__ __forceinline__ void run(float& a0, float& a1, float& a2, float& a3, float l0, float l1, float l2, float l3, float x0, float x1, float x2, float x3) {
        asm volatile("v_fmac_f32_dpp %0, %4, %8 row_newbcast:0 row_mask:0xf bank_mask:0xf\n\t" "v_fmac_f32_dpp %1, %5, %8 row_newbcast:0 row_mask:0xf bank_mask:0xf\n\t" "v_fmac_f32_dpp %2, %6, %8 row_newbcast:0 row_mask:0xf bank_mask:0xf\n\t" "v_fmac_f32_dpp %3, %7, %8 row_newbcast:0 row_mask:0xf bank_mask:0xf\n\t" "v_fmac_f32_dpp %0, %4, %9 row_newbcast:1 row_mask:0xf bank_mask:0xf\n\t" "v_fmac_f32_dpp %1, %5, %9 row_newbcast:1 row_mask:0xf bank_mask:0xf\n\t" "v_fmac_f32_dpp %2, %6, %9 row_newbcast:1 row_mask:0xf bank_mask:0xf\n\t" "v_fmac_f32_dpp %3, %7, %9 row_newbcast:1 row_mask:0xf bank_mask:0xf\n\t" "v_fmac_f32_dpp %0, %4, %10 row_newbcast:2 row_mask:0xf bank_mask:0xf\n\t" "v_fmac_f32_dpp %1, %5, %10 row_newbcast:2 row_mask:0xf bank_mask:0xf\n\t" "v_fmac_f32_dpp %2, %6, %10 row_newbcast:2 row_mask:0xf bank_mask:0xf\n\t" "v_fmac_f32_dpp %3, %7, %10 row_newbcast:2 row_mask:0xf bank_mask:0xf\n\t" "v_fmac_f32_dpp %0, %4, %11 row_newbcast:3 row_mask:0xf bank_mask:0xf\n\t" "v_fmac_f32_dpp %1, %5, %11 row_newbcast:3 row_mask:0xf bank_mask:0xf\n\t" "v_fmac_f32_dpp %2, %6, %11 row_newbcast:3 row_mask:0xf bank_mask:0xf\n\t" "v_fmac_f32_dpp %3, %7, %11 row_newbcast:3 row_mask:0xf bank_mask:0xf\n\t" : "+v"(a0), "+v"(a1), "+v"(a2), "+v"(a3) : "v"(l0), "v"(l1), "v"(l2), "v"(l3), "v"(x0), "v"(x1), "v"(x2), "v"(x3));
    }
};
template <> struct QuadChunk<5> {
    static __device__ __forceinline__ void run(float& a0, float& a1, float& a2, float& a3, float l0, float l1, float l2, float l3, float x0, float x1, float x2, float x3, float x4) {
        asm volatile("v_fmac_f32_dpp %0, %4, %8 row_newbcast:0 row_mask:0xf bank_mask:0xf\n\t" "v_fmac_f32_dpp %1, %5, %8 row_newbcast:0 row_mask:0xf bank_mask:0xf\n\t" "v_fmac_f32_dpp %2, %6, %8 row_newbcast:0 row_mask:0xf bank_mask:0xf\n\t" "v_fmac_f32_dpp %3, %7, %8 row_newbcast:0 row_mask:0xf bank_mask:0xf\n\t" "v_fmac_f32_dpp %0, %4, %9 row_newbcast:1 row_mask:0xf bank_mask:0xf\n\t" "v_fmac_f32_dpp %1, %5, %9 row_newbcast:1 row_mask:0xf bank_mask:0xf\n\t" "v_fmac_f32_dpp %2, %6, %9 row_newbcast:1 row_mask:0xf bank_mask:0xf\n\t" "v_fmac_f32_dpp %3, %7, %9 row_newbcast:1 row_mask:0xf bank_mask:0xf\n\t" "v_fmac_f32_dpp %0, %4, %10 row_newbcast:2 row_mask:0xf bank_mask:0xf\n\t" "v_fmac_f32_dpp %1, %5, %10 row_newbcast:2 row_mask:0xf bank_mask:0xf\n\t" "v_fmac_f32_dpp %2, %6, %10 row_newbcast:2 row_mask:0xf bank_mask:0xf\n\t" "v_fmac_f32_dpp %3, %7, %10 row_newbcast:2 row_mask:0xf bank_mask:0xf\n\t" "v_fmac_f32_dpp %0, %4, %11 row_newbcast:3 row_mask:0xf bank_mask:0xf\n\t" "v_fmac_f32_dpp %1, %5, %11 row_newbcast:3 row_mask:0xf bank_mask:0xf\n\t" "v_fmac_f32_dpp %2, %6, %11 row_newbcast:3 row_mask:0xf bank_mask:0xf\n\t" "v_fmac_f32_dpp %3, %7, %11 row_newbcast:3 row_mask:0xf bank_mask:0xf\n\t" "v_fmac_f32_dpp %0, %4, %12 row_newbcast:4 row_mask:0xf bank_mask:0xf\n\t" "v_fmac_f32_dpp %1, %5, %12 row_newbcast:4 row_mask:0xf bank_mask:0xf\n\t" "v_fmac_f32_dpp %2, %6, %12 row_newbcast:4 row_mask:0xf bank_mask:0xf\n\t" "v_fmac_f32_dpp %3, %7, %12 row_newbcast:4 row_mask:0xf bank_mask:0xf\n\t" : "+v"(a0), "+v"(a1), "+v"(a2), "+v"(a3) : "v"(l0), "v"(l1), "v"(l2), "v"(l3), "v"(x0), "v"(x1), "v"(x2), "v"(x3), "v"(x4));
    }
};
template <> struct QuadChunk<6> {
    static __device__ __forceinline__ void run(float& a0, float& a1, float& a2, float& a3, float l0, float l1, float l2, float l3, float x0, float x1, float x2, float x3, float x4, float x5) {
        asm volatile("v_fmac_f32_dpp %0, %4, %8 row_newbcast:0 row_mask:0xf bank_mask:0xf\n\t" "v_fmac_f32_dpp %1, %5, %8 row_newbcast:0 row_mask:0xf bank_mask:0xf\n\t" "v_fmac_f32_dpp %2, %6, %8 row_newbcast:0 row_mask:0xf bank_mask:0xf\n\t" "v_fmac_f32_dpp %3, %7, %8 row_newbcast:0 row_mask:0xf bank_mask:0xf\n\t" "v_fmac_f32_dpp %0, %4, %9 row_newbcast:1 row_mask:0xf bank_mask:0xf\n\t" "v_fmac_f32_dpp %1, %5, %9 row_newbcast:1 row_mask:0xf bank_mask:0xf\n\t" "v_fmac_f32_dpp %2, %6, %9 row_newbcast:1 row_mask:0xf bank_mask:0xf\n\t" "v_fmac_f32_dpp %3, %7, %9 row_newbcast:1 row_mask:0xf bank_mask:0xf\n\t" "v_fmac_f32_dpp %0, %4, %10 row_newbcast:2 row_mask:0xf bank_mask:0xf\n\t" "v_fmac_f32_dpp %1, %5, %10 row_newbcast:2 row_mask:0xf bank_mask:0xf\n\t" "v_fmac_f32_dpp %2, %6, %10 row_newbcast:2 row_mask:0xf bank_mask:0xf\n\t" "v_fmac_f32_dpp %3, %7, %10 row_newbcast:2 row_mask:0xf bank_mask:0xf\n\t" "v_fmac_f32_dpp %0, %4, %11 row_newbcast:3 row_mask:0xf bank_mask:0xf\n\t" "v_fmac_f32_dpp %1, %5, %11 row_newbcast:3 row_mask:0xf bank_mask:0xf\n\t" "v_fmac_f32_dpp %2, %6, %11 row_newbcast:3 row_mask:0xf bank_mask:0xf\n\t" "v_fmac_f32_dpp %3, %7, %11 row_newbcast:3 row_mask:0xf bank_mask:0xf\n\t" "v_fmac_f32_dpp %0, %4, %12 row_newbcast:4 row_mask:0xf bank_mask:0xf\n\t" "v_fmac_f32_dpp %1, %5, %12 row_newbcast:4 row_mask:0xf bank_mask:0xf\n\t" "v_fmac_f32_dpp %2, %6, %12 row_newbcast:4 row_mask:0xf bank_mask:0xf\n\t" "v_fmac_f32_dpp %3, %7, %12 row_newbcast:4 row_mask:0xf bank_mask:0xf\n\t" "v_fmac_f32_dpp %0, %4, %13 row_newbcast:5 row_mask:0xf bank_mask:0xf\n\t" "v_fmac_f32_dpp %1, %5, %13 row_newbcast:5 row_mask:0xf bank_mask:0xf\n\t" "v_fmac_f32_dpp %2, %6, %13 row_newbcast:5 row_mask:0xf bank_mask:0xf\n\t" "v_fmac_f32_dpp %3, %7, %13 row_newbcast:5 row_mask:0xf bank_mask:0xf\n\t" : "+v"(a0), "+v"(a1), "+v"(a2), "+v"(a3) : "v"(l0), "v"(l1), "v"(l2), "v"(l3), "v"(x0), "v"(x1), "v"(x2), "v"(x3), "v"(x4), "v"(x5));
    }
};
template <> struct QuadChunk<7> {
    static __device__ __forceinline__ void run(float& a0, float& a1, float& a2, float& a3, float l0, float l1, float l2, float l3, float x0, float x1, float x2, float x3, float x4, float x5, float x6) {
        asm volatile("v_fmac_f32_dpp %0, %4, %8 row_newbcast:0 row_mask:0xf bank_mask:0xf\n\t" "v_fmac_f32_dpp %1, %5, %8 row_newbcast:0 row_mask:0xf bank_mask:0xf\n\t" "v_fmac_f32_dpp %2, %6, %8 row_newbcast:0 row_mask:0xf bank_mask:0xf\n\t" "v_fmac_f32_dpp %3, %7, %8 row_newbcast:0 row_mask:0xf bank_mask:0xf\n\t" "v_fmac_f32_dpp %0, %4, %9 row_newbcast:1 row_mask:0xf bank_mask:0xf\n\t" "v_fmac_f32_dpp %1, %5, %9 row_newbcast:1 row_mask:0xf bank_mask:0xf\n\t" "v_fmac_f32_dpp %2, %6, %9 row_newbcast:1 row_mask:0xf bank_mask:0xf\n\t" "v_fmac_f32_dpp %3, %7, %9 row_newbcast:1 row_mask:0xf bank_mask:0xf\n\t" "v_fmac_f32_dpp %0, %4, %10 row_newbcast:2 row_mask:0xf bank_mask:0xf\n\t" "v_fmac_f32_dpp %1, %5, %10 row_newbcast:2 row_mask:0xf bank_mask:0xf\n\t" "v_fmac_f32_dpp %2, %6, %10 row_newbcast:2 row_mask:0xf bank_mask:0xf\n\t" "v_fmac_f32_dpp %3, %7, %10 row_newbcast:2 row_mask:0xf bank_mask:0xf\n\t" "v_fmac_f32_dpp %0, %4, %11 row_newbcast:3 row_mask:0xf bank_mask:0xf\n\t" "v_fmac_f32_dpp %1, %5, %11 row_newbcast:3 row_mask:0xf bank_mask:0xf\n\t" "v_fmac_f32_dpp %2, %6, %11 row_newbcast:3 row_mask:0xf bank_mask:0xf\n\t" "v_fmac_f32_dpp %3, %7, %11 row_newbcast:3 row_mask:0xf bank_mask:0xf\n\t" "v_fmac_f32_dpp %0, %4, %12 row_newbcast:4 row_mask:0xf bank_mask:0xf\n\t" "v_fmac_f32_dpp %1, %5, %12 row_newbcast:4 row_mask:0xf bank_mask:0xf\n\t" "v_fmac_f32_dpp %2, %6, %12 row_newbcast:4 row_mask:0xf bank_mask:0xf\n\t" "v_fmac_f32_dpp %3, %7, %12 row_newbcast:4 row_mask:0xf bank_mask:0xf\n\t" "v_fmac_f32_dpp %0, %4, %13 row_newbcast:5 row_mask:0xf bank_mask:0xf\n\t" "v_fmac_f32_dpp %1, %5, %13 row_newbcast:5 row_mask:0xf bank_mask:0xf\n\t" "v_fmac_f32_dpp %2, %6, %13 row_newbcast:5 row_mask:0xf bank_mask:0xf\n\t" "v_fmac_f32_dpp %3, %7, %13 row_newbcast:5 row_mask:0xf bank_mask:0xf\n\t" "v_fmac_f32_dpp %0, %4, %14 row_newbcast:6 row_mask:0xf bank_mask:0xf\n\t" "v_fmac_f32_dpp %1, %5, %14 row_newbcast:6 row_mask:0xf bank_mask:0xf\n\t" "v_fmac_f32_dpp %2, %6, %14 row_newbcast:6 row_mask:0xf bank_mask:0xf\n\t" "v_fmac_f32_dpp %3, %7, %14 row_newbcast:6 row_mask:0xf bank_mask:0xf\n\t" : "+v"(a0), "+v"(a1), "+v"(a2), "+v"(a3) : "v"(l0), "v"(l1), "v"(l2), "v"(l3), "v"(x0), "v"(x1), "v"(x2), "v"(x3), "v"(x4), "v"(x5), "v"(x6));
    }
};
template <> struct QuadChunk<8> {
    static __device__ __forceinline__ void run(float& a0, float& a1, float& a2, float& a3, float l0, float l1, float l2, float l3, float x0, float x1, float x2, float x3, float x4, float x5, float x6, float x7) {
        asm volatile("v_fmac_f32_dpp %0, %4, %8 row_newbcast:0 row_mask:0xf bank_mask:0xf\n\t" "v_fmac_f32_dpp %1, %5, %8 row_newbcast:0 row_mask:0xf bank_mask:0xf\n\t" "v_fmac_f32_dpp %2, %6, %8 row_newbcast:0 row_mask:0xf bank_mask:0xf\n\t" "v_fmac_f32_dpp %3, %7, %8 row_newbcast:0 row_mask:0xf bank_mask:0xf\n\t" "v_fmac_f32_dpp %0, %4, %9 row_newbcast:1 row_mask:0xf bank_mask:0xf\n\t" "v_fmac_f32_dpp %1, %5, %9 row_newbcast:1 row_mask:0xf bank_mask:0xf\n\t" "v_fmac_f32_dpp %2, %6, %9 row_newbcast:1 row_mask:0xf bank_mask:0xf\n\t" "v_fmac_f32_dpp %3, %7, %9 row_newbcast:1 row_mask:0xf bank_mask:0xf\n\t" "v_fmac_f32_dpp %0, %4, %10 row_newbcast:2 row_mask:0xf bank_mask:0xf\n\t" "v_fmac_f32_dpp %1, %5, %10 row_newbcast:2 row_mask:0xf bank_mask:0xf\n\t" "v_fmac_f32_dpp %2, %6, %10 row_newbcast:2 row_mask:0xf bank_mask:0xf\n\t" "v_fmac_f32_dpp %3, %7, %10 row_newbcast:2 row_mask:0xf bank_mask:0xf\n\t" "v_fmac_f32_dpp %0, %4, %11 row_newbcast:3 row_mask:0xf bank_mask:0xf\n\t" "v_fmac_f32_dpp %1, %5, %11 row_newbcast:3 row_mask:0xf bank_mask:0xf\n\t" "v_fmac_f32_dpp %2, %6, %11 row_newbcast:3 row_mask:0xf bank_mask:0xf\n\t" "v_fmac_f32_dpp %3, %7, %11 row_newbcast:3 row_mask:0xf bank_mask:0xf\n\t" "v_fmac_f32_dpp %0, %4, %12 row_newbcast:4 row_mask:0xf bank_mask:0xf\n\t" "v_fmac_f32_dpp %1, %5, %12 row_newbcast:4 row_mask:0xf bank_mask:0xf\n\t" "v_fmac_f32_dpp %2, %6, %12 row_newbcast:4 row_mask:0xf bank_mask:0xf\n\t" "v_fmac_f32_dpp %3, %7, %12 row_newbcast:4 row_mask:0xf bank_mask:0xf\n\t" "v_fmac_f32_dpp %0, %4, %13 row_newbcast:5 row_mask:0xf bank_mask:0xf\n\t" "v_fmac_f32_dpp %1, %5, %13 row_newbcast:5 row_mask:0xf bank_mask:0xf\n\t" "v_fmac_f32_dpp %2, %6, %13 row_newbcast:5 row_mask:0xf bank_mask:0xf\n\t" "v_fmac_f32_dpp %3, %7, %13 row_newbcast:5 row_mask:0xf bank_mask:0xf\n\t" "v_fmac_f32_dpp %0, %4, %14 row_newbcast:6 row_mask:0xf bank_mask:0xf\n\t" "v_fmac_f32_dpp %1, %5, %14 row_newbcast:6 row_mask:0xf bank_mask:0xf\n\t" "v_fmac_f32_dpp %2, %6, %14 row_newbcast:6 row_mask:0xf bank_mask:0xf\n\t" "v_fmac_f32_dpp %3, %7, %14 row_newbcast:6 row_mask:0xf bank_mask:0xf\n\t" "v_fmac_f32_dpp %0, %4, %15 row_newbcast:7 row_mask:0xf bank_mask:0xf\n\t" "v_fmac_f32_dpp %1, %5, %15 row_newbcast:7 row_mask:0xf bank_mask:0xf\n\t" "v_fmac_f32_dpp %2, %6, %15 row_newbcast:7 row_mask:0xf bank_mask:0xf\n\t" "v_fmac_f32_dpp %3, %7, %15 row_newbcast:7 row_mask:0xf bank_mask:0xf\n\t" : "+v"(a0), "+v"(a1), "+v"(a2), "+v"(a3) : "v"(l0), "v"(l1), "v"(l2), "v"(l3), "v"(x0), "v"(x1), "v"(x2), "v"(x3), "v"(x4), "v"(x5), "v"(x6), "v"(x7));
    }
};
template <> struct QuadChunk<9> {
    static __device__ __forceinline__ void run(float& a0, float& a1, float& a2, float& a3, float l0, float l1, float l2, float l3, float x0, float x1, float x2, float x3, float x4, float x5, float x6, float x7, float x8) {
        asm volatile("v_fmac_f32_dpp %0, %4, %8 row_newbcast:0 row_mask:0xf bank_mask:0xf\n\t" "v_fmac_f32_dpp %1, %5, %8 row_newbcast:0 row_mask:0xf bank_mask:0xf\n\t" "v_fmac_f32_dpp %2, %6, %8 row_newbcast:0 row_mask:0xf bank_mask:0xf\n\t" "v_fmac_f32_dpp %3, %7, %8 row_newbcast:0 row_mask:0xf bank_mask:0xf\n\t" "v_fmac_f32_dpp %0, %4, %9 row_newbcast:1 row_mask:0xf bank_mask:0xf\n\t" "v_fmac_f32_dpp %1, %5, %9 row_newbcast:1 row_mask:0xf bank_mask:0xf\n\t" "v_fmac_f32_dpp %2, %6, %9 row_newbcast:1 row_mask:0xf bank_mask:0xf\n\t" "v_fmac_f32_dpp %3, %7, %9 row_newbcast:1 row_mask:0xf bank_mask:0xf\n\t" "v_fmac_f32_dpp %0, %4, %10 row_newbcast:2 row_mask:0xf bank_mask:0xf\n\t" "v_fmac_f32_dpp %1, %5, %10 row_newbcast:2 row_mask:0xf bank_mask:0xf\n\t" "v_fmac_f32_dpp %2, %6, %10 row_newbcast:2 row_mask:0xf bank_mask:0xf\n\t" "v_fmac_f32_dpp %3, %7, %10 row_newbcast:2 row_mask:0xf bank_mask:0xf\n\t" "v_fmac_f32_dpp %0, %4, %11 row_newbcast:3 row_mask:0xf bank_mask:0xf\n\t" "v_fmac_f32_dpp %1, %5, %11 row_newbcast:3 row_mask:0xf bank_mask:0xf\n\t" "v_fmac_f32_dpp %2, %6, %11 row_newbcast:3 row_mask:0xf bank_mask:0xf\n\t" "v_fmac_f32_dpp %3, %7, %11 row_newbcast:3 row_mask:0xf bank_mask:0xf\n\t" "v_fmac_f32_dpp %0, %4, %12 row_newbcast:4 row_mask:0xf bank_mask:0xf\n\t" "v_fmac_f32_dpp %1, %5, %12 row_newbcast:4 row_mask:0xf bank_mask:0xf\n\t" "v_fmac_f32_dpp %2, %6, %12 row_newbcast:4 row_mask:0xf bank_mask:0xf\n\t" "v_fmac_f32_dpp %3, %7, %12 row_newbcast:4 row_mask:0xf bank_mask:0xf\n\t" "v_fmac_f32_dpp %0, %4, %13 row_newbcast:5 row_mask:0xf bank_mask:0xf\n\t" "v_fmac_f32_dpp %1, %5, %13 row_newbcast:5 row_mask:0xf bank_mask:0xf\n\t" "v_fmac_f32_dpp %2, %6, %13 row_newbcast:5 row_mask:0xf bank_mask:0xf\n\t" "v_fmac_f32_dpp %3, %7, %13 row_newbcast:5 row_mask:0xf bank_mask:0xf\n\t" "v_fmac_f32_dpp %0, %4, %14 row_newbcast:6 row_mask:0xf bank_mask:0xf\n\t" "v_fmac_f32_dpp %1, %5, %14 row_newbcast:6 row_mask:0xf bank_mask:0xf\n\t" "v_fmac_f32_dpp %2, %6, %14 row_newbcast:6 row_mask:0xf bank_mask:0xf\n\t" "v_fmac_f32_dpp %3, %7, %14 row_newbcast:6 row_mask:0xf bank_mask:0xf\n\t" "v_fmac_f32_dpp %0, %4, %15 row_newbcast:7 row_mask:0xf bank_mask:0xf\n\t" "v_fmac_f32_dpp %1, %5, %15 row_newbcast:7 row_mask:0xf bank_mask:0xf\n\t" "v_fmac_f32_dpp %2, %6, %15 row_newbcast:7 row_mask:0xf bank_mask:0xf\n\t" "v_fmac_f32_dpp %3, %7, %15 row_newbcast:7 row_mask:0xf bank_mask:0xf\n\t" "v_fmac_f32_dpp %0, %4, %16 row_newbcast:8 row_mask:0xf bank_mask:0xf\n\t" "v_fmac_f32_dpp %1, %5, %16 row_newbcast:8 row_mask:0xf bank_mask:0xf\n\t" "v_fmac_f32_dpp %2, %6, %16 row_newbcast:8 row_mask:0xf bank_mask:0xf\n\t" "v_fmac_f32_dpp %3, %7, %16 row_newbcast:8 row_mask:0xf bank_mask:0xf\n\t" : "+v"(a0), "+v"(a1), "+v"(a2), "+v"(a3) : "v"(l0), "v"(l1), "v"(l2), "v"(l3), "v"(x0), "v"(x1), "v"(x2), "v"(x3), "v"(x4), "v"(x5), "v"(x6), "v"(x7), "v"(x8));
    }
};
template <> struct QuadChunk<10> {
    static __device__ __forceinline__ void run(float& a0, float& a1, float& a2, float& a3, float l0, float l1, float l2, float l3, float x0, float x1, float x2, float x3, float x4, float x5, float x6, float x7, float x8, float x9) {
        asm volatile("v_fmac_f32_dpp %0, %4, %8 row_newbcast:0 row_mask:0xf bank_mask:0xf\n\t" "v_fmac_f32_dpp %1, %5, %8 row_newbcast:0 row_mask:0xf bank_mask:0xf\n\t" "v_fmac_f32_dpp %2, %6, %8 row_newbcast:0 row_mask:0xf bank_mask:0xf\n\t" "v_fmac_f32_dpp %3, %7, %8 row_newbcast:0 row_mask:0xf bank_mask:0xf\n\t" "v_fmac_f32_dpp %0, %4, %9 row_newbcast:1 row_mask:0xf bank_mask:0xf\n\t" "v_fmac_f32_dpp %1, %5, %9 row_newbcast:1 row_mask:0xf bank_mask:0xf\n\t" "v_fmac_f32_dpp %2, %6, %9 row_newbcast:1 row_mask:0xf bank_mask:0xf\n\t" "v_fmac_f32_dpp %3, %7, %9 row_newbcast:1 row_mask:0xf bank_mask:0xf\n\t" "v_fmac_f32_dpp %0, %4, %10 row_newbcast:2 row_mask:0xf bank_mask:0xf\n\t" "v_fmac_f32_dpp %1, %5, %10 row_newbcast:2 row_mask:0xf bank_mask:0xf\n\t" "v_fmac_f32_dpp %2, %6, %10 row_newbcast:2 row_mask:0xf bank_mask:0xf\n\t" "v_fmac_f32_dpp %3, %7, %10 row_newbcast:2 row_mask:0xf bank_mask:0xf\n\t" "v_fmac_f32_dpp %0, %4, %11 row_newbcast:3 row_mask:0xf bank_mask:0xf\n\t" "v_fmac_f32_dpp %1, %5, %11 row_newbcast:3 row_mask:0xf bank_mask:0xf\n\t" "v_fmac_f32_dpp %2, %6, %11 row_newbcast:3 row_mask:0xf bank_mask:0xf\n\t" "v_fmac_f32_dpp %3, %7, %11 row_newbcast:3 row_mask:0xf bank_mask:0xf\n\t" "v_fmac_f32_dpp %0, %4, %12 row_newbcast:4 row_mask:0xf bank_mask:0xf\n\t" "v_fmac_f32_dpp %1, %5, %12 row_newbcast:4 row_mask:0xf bank_mask:0xf\n\t" "v_fmac_f32_dpp %2, %6, %12 row_newbcast:4 row_mask:0xf bank_mask:0xf\n\t" "v_fmac_f32_dpp %3, %7, %12 row_newbcast:4 row_mask:0xf bank_mask:0xf\n\t" "v_fmac_f32_dpp %0, %4, %13 row_newbcast:5 row_mask:0xf bank_mask:0xf\n\t" "v_fmac_f32_dpp %1, %5, %13 row_newbcast:5 row_mask:0xf bank_mask:0xf\n\t" "v_fmac_f32_dpp %2, %6, %13 row_newbcast:5 row_mask:0xf bank_mask:0xf\n\t" "v_fmac_f32_dpp %3, %7, %13 row_newbcast:5 row_mask:0xf bank_mask:0xf\n\t" "v_fmac_f32_dpp %0, %4, %14 row_newbcast:6 row_mask:0xf bank_mask:0xf\n\t" "v_fmac_f32_dpp %1, %5, %14 row_newbcast:6 row_mask:0xf bank_mask:0xf\n\t" "v_fmac_f32_dpp %2, %6, %14 row_newbcast:6 row_mask:0xf bank_mask:0xf\n\t" "v_fmac_f32_dpp %3, %7, %14 row_newbcast:6 row_mask:0xf bank_mask:0xf\n\t" "v_fmac_f32_dpp %0, %4, %15 row_newbcast:7 row_mask:0xf bank_mask:0xf\n\t" "v_fmac_f32_dpp %1, %5, %15 row_newbcast:7 row_mask:0xf bank_mask:0xf\n\t" "v_fmac_f32_dpp %2, %6, %15 row_newbcast:7 row_mask:0xf bank_mask:0xf\n\t" "v_fmac_f32_dpp %3, %7, %15 row_newbcast:7 row_mask:0xf bank_mask:0xf\n\t" "v_fmac_f32_dpp %0, %4, %16 row_newbcast:8 row_mask:0xf bank_mask:0xf\n\t" "v_fmac_f32_dpp %1, %5, %16 row_newbcast:8 row_mask:0xf bank_mask:0xf\n\t" "v_fmac_f32_dpp %2, %6, %16 row_newbcast:8 row_mask:0xf bank_mask:0xf\n\t" "v_fmac_f32_dpp %3, %7, %16 row_newbcast:8 row_mask:0xf bank_mask:0xf\n\t" "v_fmac_f32_dpp %0, %4, %17 row_newbcast:9 row_mask:0xf bank_mask:0xf\n\t" "v_fmac_f32_dpp %1, %5, %17 row_newbcast:9 row_mask:0xf bank_mask:0xf\n\t" "v_fmac_f32_dpp %2, %6, %17 row_newbcast:9 row_mask:0xf bank_mask:0xf\n\t" "v_fmac_f32_dpp %3, %7, %17 row_newbcast:9 row_mask:0xf bank_mask:0xf\n\t" : "+v"(a0), "+v"(a1), "+v"(a2), "+v"(a3) : "v"(l0), "v"(l1), "v"(l2), "v"(l3), "v"(x0), "v"(x1), "v"(x2), "v"(x3), "v"(x4), "v"(x5), "v"(x6), "v"(x7), "v"(x8), "v"(x9));
    }
};
template <> struct QuadChunk<11> {
    static __device__ __forceinline__ void run(float& a0, float& a1, float& a2, float& a3, float l0, float l1, float l2, float l3, float x0, float x1, float x2, float x3, float x4, float x5, float x6, float x7, float x8, float x9, float x10) {
        asm volatile("v_fmac_f32_dpp %0, %4, %8 row_newbcast:0 row_mask:0xf bank_mask:0xf\n\t" "v_fmac_f32_dpp %1, %5, %8 row_newbcast:0 row_mask:0xf bank_mask:0xf\n\t" "v_fmac_f32_dpp %2, %6, %8 row_newbcast:0 row_mask:0xf bank_mask:0xf\n\t" "v_fmac_f32_dpp %3, %7, %8 row_newbcast:0 row_mask:0xf bank_mask:0xf\n\t" "v_fmac_f32_dpp %0, %4, %9 row_newbcast:1 row_mask:0xf bank_mask:0xf\n\t" "v_fmac_f32_dpp %1, %5, %9 row_newbcast:1 row_mask:0xf bank_mask:0xf\n\t" "v_fmac_f32_dpp %2, %6, %9 row_newbcast:1 row_mask:0xf bank_mask:0xf\n\t" "v_fmac_f32_dpp %3, %7, %9 row_newbcast:1 row_mask:0xf bank_mask:0xf\n\t" "v_fmac_f32_dpp %0, %4, %10 row_newbcast:2 row_mask:0xf bank_mask:0xf\n\t" "v_fmac_f32_dpp %1, %5, %10 row_newbcast:2 row_mask:0xf bank_mask:0xf\n\t" "v_fmac_f32_dpp %2, %6, %10 row_newbcast:2 row_mask:0xf bank_mask:0xf\n\t" "v_fmac_f32_dpp %3, %7, %10 row_newbcast:2 row_mask:0xf bank_mask:0xf\n\t" "v_fmac_f32_dpp %0, %4, %11 row_newbcast:3 row_mask:0xf bank_mask:0xf\n\t" "v_fmac_f32_dpp %1, %5, %11 row_newbcast:3 row_mask:0xf bank_mask:0xf\n\t" "v_fmac_f32_dpp %2, %6, %11 row_newbcast:3 row_mask:0xf bank_mask:0xf\n\t" "v_fmac_f32_dpp %3, %7, %11 row_newbcast:3 row_mask:0xf bank_mask:0xf\n\t" "v_fmac_f32_dpp %0, %4, %12 row_newbcast:4 row_mask:0xf bank_mask:0xf\n\t" "v_fmac_f32_dpp %1, %5, %12 row_newbcast:4 row_mask:0xf bank_mask:0xf\n\t" "v_fmac_f32_dpp %2, %6, %12 row_newbcast:4 row_mask:0xf bank_mask:0xf\n\t" "v_fmac_f32_dpp %3, %7, %12 row_newbcast:4 row_mask:0xf bank_mask:0xf\n\t" "v_fmac_f32_dpp %0, %4, %13 row_newbcast:5 row_mask:0xf bank_mask:0xf\n\t" "v_fmac_f32_dpp %1, %5, %13 row_newbcast:5 row_mask:0xf bank_mask:0xf\n\t" "v_fmac_f32_dpp %2, %6, %13 row_newbcast:5 row_mask:0xf bank_mask:0xf\n\t" "v_fmac_f32_dpp %3, %7, %13 row_newbcast:5 row_mask:0xf bank_mask:0xf\n\t" "v_fmac_f32_dpp %0, %4, %14 row_newbcast:6 row_mask:0xf bank_mask:0xf\n\t" "v_fmac_f32_dpp %1, %5, %14 row_newbcast:6 row_mask:0xf bank_mask:0xf\n\t" "v_fmac_f32_dpp %2, %6, %14 row_newbcast:6 row_mask:0xf bank_mask:0xf\n\t" "v_fmac_f32_dpp %3, %7, %14 row_newbcast:6 row_mask:0xf bank_mask:0xf\n\t" "v_fmac_f32_dpp %0, %4, %15 row_newbcast:7 row_mask:0xf bank_mask:0xf\n\t" "v_fmac_f32_dpp %1, %5, %15 row_newbcast:7 row_mask:0xf bank_mask:0xf\n\t" "v_fmac_f32_dpp %2, %6, %15 row_newbcast:7 row_mask:0xf bank_mask:0xf\n\t" "v_fmac_f32_dpp %3, %7, %15 row_newbcast:7 row_mask:0xf bank_mask:0xf\n\t" "v_fmac_f32_dpp %0, %4, %16 row_newbcast:8 row_mask:0xf bank_mask:0xf\n\t" "v_fmac_f32_dpp %1, %5, %16 row_newbcast:8 row_mask:0xf bank_mask:0xf\n\t" "v_fmac_f32_dpp %2, %6, %16 row_newbcast:8 row_mask:0xf bank_mask:0xf\n\t" "v_fmac_f32_dpp %3, %7, %16 row_newbcast:8 row_mask:0xf bank_mask:0xf\n\t" "v_fmac_f32_dpp %0, %4, %17 row_newbcast:9 row_mask:0xf bank_mask:0xf\n\t" "v_fmac_f32_dpp %1, %5, %17 row_newbcast:9 row_mask:0xf bank_mask:0xf\n\t" "v_fmac_f32_dpp %2, %6, %17 row_newbcast:9 row_mask:0xf bank_mask:0xf\n\t" "v_fmac_f32_dpp %3, %7, %17 row_newbcast:9 row_mask:0xf bank_mask:0xf\n\t" "v_fmac_f32_dpp %0, %4, %18 row_newbcast:10 row_mask:0xf bank_mask:0xf\n\t" "v_fmac_f32_dpp %1, %5, %18 row_newbcast:10 row_mask:0xf bank_mask:0xf\n\t" "v_fmac_f32_dpp %2, %6, %18 row_newbcast:10 row_mask:0xf bank_mask:0xf\n\t" "v_fmac_f32_dpp %3, %7, %18 row_newbcast:10 row_mask:0xf bank_mask:0xf\n\t" : "+v"(a0), "+v"(a1), "+v"(a2), "+v"(a3) : "v"(l0), "v"(l1), "v"(l2), "v"(l3), "v"(x0), "v"(x1), "v"(x2), "v"(x3), "v"(x4), "v"(x5), "v"(x6), "v"(x7), "v"(x8), "v"(x9), "v"(x10));
    }
};
template <> struct QuadChunk<12> {
    static __device__ __forceinline__ void run(float& a0, float& a1, float& a2, float& a3, float l0, float l1, float l2, float l3, float x0, float x1, float x2, float x3, float x4, float x5, float x6, float x7, float x8, float x9, float x10, float x11) {
        asm volatile("v_fmac_f32_dpp %0, %4, %8 row_newbcast:0 row_mask:0xf bank_mask:0xf\n\t" "v_fmac_f32_dpp %1, %5, %8 row_newbcast:0 row_mask:0xf bank_mask:0xf\n\t" "v_fmac_f32_dpp %2, %6, %8 row_newbcast:0 row_mask:0xf bank_mask:0xf\n\t" "v_fmac_f32_dpp %3, %7, %8 row_newbcast:0 row_mask:0xf bank_mask:0xf\n\t" "v_fmac_f32_dpp %0, %4, %9 row_newbcast:1 row_mask:0xf bank_mask:0xf\n\t" "v_fmac_f32_dpp %1, %5, %9 row_newbcast:1 row_mask:0xf bank_mask:0xf\n\t" "v_fmac_f32_dpp %2, %6, %9 row_newbcast:1 row_mask:0xf bank_mask:0xf\n\t" "v_fmac_f32_dpp %3, %7, %9 row_newbcast:1 row_mask:0xf bank_mask:0xf\n\t" "v_fmac_f32_dpp %0, %4, %10 row_newbcast:2 row_mask:0xf bank_mask:0xf\n\t" "v_fmac_f32_dpp %1, %5, %10 row_newbcast:2 row_mask:0xf bank_mask:0xf\n\t" "v_fmac_f32_dpp %2, %6, %10 row_newbcast:2 row_mask:0xf bank_mask:0xf\n\t" "v_fmac_f32_dpp %3, %7, %10 row_newbcast:2 row_mask:0xf bank_mask:0xf\n\t" "v_fmac_f32_dpp %0, %4, %11 row_newbcast:3 row_mask:0xf bank_mask:0xf\n\t" "v_fmac_f32_dpp %1, %5, %11 row_newbcast:3 row_mask:0xf bank_mask:0xf\n\t" "v_fmac_f32_dpp %2, %6, %11 row_newbcast:3 row_mask:0xf bank_mask:0xf\n\t" "v_fmac_f32_dpp %3, %7, %11 row_newbcast:3 row_mask:0xf bank_mask:0xf\n\t" "v_fmac_f32_dpp %0, %4, %12 row_newbcast:4 row_mask:0xf bank_mask:0xf\n\t" "v_fmac_f32_dpp %1, %5, %12 row_newbcast:4 row_mask:0xf bank_mask:0xf\n\t" "v_fmac_f32_dpp %2, %6, %12 row_newbcast:4 row_mask:0xf bank_mask:0xf\n\t" "v_fmac_f32_dpp %3, %7, %12 row_newbcast:4 row_mask:0xf bank_mask:0xf\n\t" "v_fmac_f32_dpp %0, %4, %13 row_newbcast:5 row_mask:0xf bank_mask:0xf\n\t" "v_fmac_f32_dpp %1, %5, %13 row_newbcast:5 row_mask:0xf bank_mask:0xf\n\t" "v_fmac_f32_dpp %2, %6, %13 row_newbcast:5 row_mask:0xf bank_mask:0xf\n\t" "v_fmac_f32_dpp %3, %7, %13 row_newbcast:5 row_mask:0xf bank_mask:0xf\n\t" "v_fmac_f32_dpp %0, %4, %14 row_newbcast:6 row_mask:0xf bank_mask:0xf\n\t" "v_fmac_f32_dpp %1, %5, %14 row_newbcast:6 row_mask:0xf bank_mask:0xf\n\t" "v_fmac_f32_dpp %2, %6, %14 row_newbcast:6 row_mask:0xf bank_mask:0xf\n\t" "v_fmac_f32_dpp %3, %7, %14 row_newbcast:6 row_mask:0xf bank_mask:0xf\n\t" "v_fmac_f32_dpp %0, %4, %15 row_newbcast:7 row_mask:0xf bank_mask:0xf\n\t" "v_fmac_f32_dpp %1, %5, %15 row_newbcast:7 row_mask:0xf bank_mask:0xf\n\t" "v_fmac_f32_dpp %2, %6, %15 row_newbcast:7 row_mask:0xf bank_mask:0xf\n\t" "v_fmac_f32_dpp %3, %7, %15 row_newbcast:7 row_mask:0xf bank_mask:0xf\n\t" "v_fmac_f32_dpp %0, %4, %16 row_newbcast:8 row_mask:0xf bank_mask:0xf\n\t" "v_fmac_f32_dpp %1, %5, %16 row_newbcast:8 row_mask:0xf bank_mask:0xf\n\t" "v_fmac_f32_dpp %2, %6, %16 row_newbcast:8 row_mask:0xf bank_mask:0xf\n\t" "v_fmac_f32_dpp %3, %7, %16 row_newbcast:8 row_mask:0xf bank_mask:0xf\n\t" "v_fmac_f32_dpp %0, %4, %17 row_newbcast:9 row_mask:0xf bank_mask:0xf\n\t" "v_fmac_f32_dpp %1, %5, %17 row_newbcast:9 row_mask:0xf bank_mask:0xf\n\t" "v_fmac_f32_dpp %2, %6, %17 row_newbcast:9 row_mask:0xf bank_mask:0xf\n\t" "v_fmac_f32_dpp %3, %7, %17 row_newbcast:9 row_mask:0xf bank_mask:0xf\n\t" "v_fmac_f32_dpp %0, %4, %18 row_newbcast:10 row_mask:0xf bank_mask:0xf\n\t" "v_fmac_f32_dpp %1, %5, %18 row_newbcast:10 row_mask:0xf bank_mask:0xf\n\t" "v_fmac_f32_dpp %2, %6, %18 row_newbcast:10 row_mask:0xf bank_mask:0xf\n\t" "v_fmac_f32_dpp %3, %7, %18 row_newbcast:10 row_mask:0xf bank_mask:0xf\n\t" "v_fmac_f32_dpp %0, %4, %19 row_newbcast:11 row_mask:0xf bank_mask:0xf\n\t" "v_fmac_f32_dpp %1, %5, %19 row_newbcast:11 row_mask:0xf bank_mask:0xf\n\t" "v_fmac_f32_dpp %2, %6, %19 row_newbcast:11 row_mask:0xf bank_mask:0xf\n\t" "v_fmac_f32_dpp %3, %7, %19 row_newbcast:11 row_mask:0xf bank_mask:0xf\n\t" : "+v"(a0), "+v"(a1), "+v"(a2), "+v"(a3) : "v"(l0), "v"(l1), "v"(l2), "v"(l3), "v"(x0), "v"(x1), "v"(x2), "v"(x3), "v"(x4), "v"(x5), "v"(x6), "v"(x7), "v"(x8), "v"(x9), "v"(x10), "v"(x11));
    }
};
template <> struct QuadChunk<13> {
    static __device__ __forceinline__ void run(float& a0, float& a1, float& a2, float& a3, float l0, float l1, float l2, float l3, float x0, float x1, float x2, float x3, float x4, float x5, float x6, float x7, float x8, float x9, float x10, float x11, float x12) {
        asm volatile("v_fmac_f32_dpp %0, %4, %8 row_newbcast:0 row_mask:0xf bank_mask:0xf\n\t" "v_fmac_f32_dpp %1, %5, %8 row_newbcast:0 row_mask:0xf bank_mask:0xf\n\t" "v_fmac_f32_dpp %2, %6, %8 row_newbcast:0 row_mask:0xf bank_mask:0xf\n\t" "v_fmac_f32_dpp %3, %7, %8 row_newbcast:0 row_mask:0xf bank_mask:0xf\n\t" "v_fmac_f32_dpp %0, %4, %9 row_newbcast:1 row_mask:0xf bank_mask:0xf\n\t" "v_fmac_f32_dpp %1, %5, %9 row_newbcast:1 row_mask:0xf bank_mask:0xf\n\t" "v_fmac_f32_dpp %2, %6, %9 row_newbcast:1 row_mask:0xf bank_mask:0xf\n\t" "v_fmac_f32_dpp %3, %7, %9 row_newbcast:1 row_mask:0xf bank_mask:0xf\n\t" "v_fmac_f32_dpp %0, %4, %10 row_newbcast:2 row_mask:0xf bank_mask:0xf\n\t" "v_fmac_f32_dpp %1, %5, %10 row_newbcast:2 row_mask:0xf bank_mask:0xf\n\t" "v_fmac_f32_dpp %2, %6, %10 row_newbcast:2 row_mask:0xf bank_mask:0xf\n\t" "v_fmac_f32_dpp %3, %7, %10 row_newbcast:2 row_mask:0xf bank_mask:0xf\n\t" "v_fmac_f32_dpp %0, %4, %11 row_newbcast:3 row_mask:0xf bank_mask:0xf\n\t" "v_fmac_f32_dpp %1, %5, %11 row_newbcast:3 row_mask:0xf bank_mask:0xf\n\t" "v_fmac_f32_dpp %2, %6, %11 row_newbcast:3 row_mask:0xf bank_mask:0xf\n\t" "v_fmac_f32_dpp %3, %7, %11 row_newbcast:3 row_mask:0xf bank_mask:0xf\n\t" "v_fmac_f32_dpp %0, %4, %12 row_newbcast:4 row_mask:0xf bank_mask:0xf\n\t" "v_fmac_f32_dpp %1, %5, %12 row_newbcast:4 row_mask:0xf bank_mask:0xf\n\t" "v_fmac_f32_dpp %2, %6, %12 row_newbcast:4 row_mask:0xf bank_mask:0xf\n\t" "v_fmac_f32_dpp %3, %7, %12 row_newbcast:4 row_mask:0xf bank_mask:0xf\n\t" "v_fmac_f32_dpp %0, %4, %13 row_newbcast:5 row_mask:0xf bank_mask:0xf\n\t" "v_fmac_f32_dpp %1, %5, %13 row_newbcast:5 row_mask:0xf bank_mask:0xf\n\t" "v_fmac_f32_dpp %2, %6, %13 row_newbcast:5 row_mask:0xf bank_mask:0xf\n\t" "v_fmac_f32_dpp %3, %7, %13 row_newbcast:5 row_mask:0xf bank_mask:0xf\n\t" "v_fmac_f32_dpp %0, %4, %14 row_newbcast:6 row_mask:0xf bank_mask:0xf\n\t" "v_fmac_f32_dpp %1, %5, %14 row_newbcast:6 row_mask:0xf bank_mask:0xf\n\t" "v_fmac_f32_dpp %2, %6, %14 row_newbcast:6 row_mask:0xf bank_mask:0xf\n\t" "v_fmac_f32_dpp %3, %7, %14 row_newbcast:6 row_mask:0xf bank_mask:0xf\n\t" "v_fmac_f32_dpp %0, %4, %15 row_newbcast:7 row_mask:0xf bank_mask:0xf\n\t" "v_fmac_f32_dpp %1, %5, %15 row_newbcast:7 row_mask:0xf bank_mask:0xf\n\t" "v_fmac_f32_dpp %2, %6, %15 row_newbcast:7 row_mask:0xf bank_mask:0xf\n\t" "v_fmac_f32_dpp %3, %7, %15 row_newbcast:7 row_mask:0xf bank_mask:0xf\n\t" "v_fmac_f32_dpp %0, %4, %16 row_newbcast:8 row_mask:0xf bank_mask:0xf\n\t" "v_fmac_f32_dpp %1, %5, %16 row_newbcast:8 row_mask:0xf bank_mask:0xf\n\t" "v_fmac_f32_dpp %2, %6, %16 row_newbcast:8 row_mask:0xf bank_mask:0xf\n\t" "v_fmac_f32_dpp %3, %7, %16 row_newbcast:8 row_mask:0xf bank_mask:0xf\n\t" "v_fmac_f32_dpp %0, %4, %17 row_newbcast:9 row_mask:0xf bank_mask:0xf\n\t" "v_fmac_f32_dpp %1, %5, %17 row_newbcast:9 row_mask:0xf bank_mask:0xf\n\t" "v_fmac_f32_dpp %2, %6, %17 row_newbcast:9 row_mask:0xf bank_mask:0xf\n\t" "v_fmac_f32_dpp %3, %7, %17 row_newbcast:9 row_mask:0xf bank_mask:0xf\n\t" "v_fmac_f32_dpp %0, %4, %18 row_newbcast:10 row_mask:0xf bank_mask:0xf\n\t" "v_fmac_f32_dpp %1, %5, %18 row_newbcast:10 row_mask:0xf bank_mask:0xf\n\t" "v_fmac_f32_dpp %2, %6, %18 row_newbcast:10 row_mask:0xf bank_mask:0xf\n\t" "v_fmac_f32_dpp %3, %7, %18 row_newbcast:10 row_mask:0xf bank_mask:0xf\n\t" "v_fmac_f32_dpp %0, %4, %19 row_newbcast:11 row_mask:0xf bank_mask:0xf\n\t" "v_fmac_f32_dpp %1, %5, %19 row_newbcast:11 row_mask:0xf bank_mask:0xf\n\t" "v_fmac_f32_dpp %2, %6, %19 row_newbcast:11 row_mask:0xf bank_mask:0xf\n\t" "v_fmac_f32_dpp %3, %7, %19 row_newbcast:11 row_mask:0xf bank_mask:0xf\n\t" "v_fmac_f32_dpp %0, %4, %20 row_newbcast:12 row_mask:0xf bank_mask:0xf\n\t" "v_fmac_f32_dpp %1, %5, %20 row_newbcast:12 row_mask:0xf bank_mask:0xf\n\t" "v_fmac_f32_dpp %2, %6, %20 row_newbcast:12 row_mask:0xf bank_mask:0xf\n\t" "v_fmac_f32_dpp %3, %7, %20 row_newbcast:12 row_mask:0xf bank_mask:0xf\n\t" : "+v"(a0), "+v"(a1), "+v"(a2), "+v"(a3) : "v"(l0), "v"(l1), "v"(l2), "v"(l3), "v"(x0), "v"(x1), "v"(x2), "v"(x3), "v"(x4), "v"(x5), "v"(x6), "v"(x7), "v"(x8), "v"(x9), "v"(x10), "v"(x11), "v"(x12));
    }
};
template <> struct QuadChunk<14> {
    static __device__ __forceinline__ void run(float& a0, float& a1, float& a2, float& a3, float l0, float l1, float l2, float l3, float x0, float x1, float x2, float x3, float x4, float x5, float x6, float x7, float x8, float x9, float x10, float x11, float x12, float x13) {
        asm volatile("v_fmac_f32_dpp %0, %4, %8 row_newbcast:0 row_mask:0xf bank_mask:0xf\n\t" "v_fmac_f32_dpp %1, %5, %8 row_newbcast:0 row_mask:0xf bank_mask:0xf\n\t" "v_fmac_f32_dpp %2, %6, %8 row_newbcast:0 row_mask:0xf bank_mask:0xf\n\t" "v_fmac_f32_dpp %3, %7, %8 row_newbcast:0 row_mask:0xf bank_mask:0xf\n\t" "v_fmac_f32_dpp %0, %4, %9 row_newbcast:1 row_mask:0xf bank_mask:0xf\n\t" "v_fmac_f32_dpp %1, %5, %9 row_newbcast:1 row_mask:0xf bank_mask:0xf\n\t" "v_fmac_f32_dpp %2, %6, %9 row_newbcast:1 row_mask:0xf bank_mask:0xf\n\t" "v_fmac_f32_dpp %3, %7, %9 row_newbcast:1 row_mask:0xf bank_mask:0xf\n\t" "v_fmac_f32_dpp %0, %4, %10 row_newbcast:2 row_mask:0xf bank_mask:0xf\n\t" "v_fmac_f32_dpp %1, %5, %10 row_newbcast:2 row_mask:0xf bank_mask:0xf\n\t" "v_fmac_f32_dpp %2, %6, %10 row_newbcast:2 row_mask:0xf bank_mask:0xf\n\t" "v_fmac_f32_dpp %3, %7, %10 row_newbcast:2 row_mask:0xf bank_mask:0xf\n\t" "v_fmac_f32_dpp %0, %4, %11 row_newbcast:3 row_mask:0xf bank_mask:0xf\n\t" "v_fmac_f32_dpp %1, %5, %11 row_newbcast:3 row_mask:0xf bank_mask:0xf\n\t" "v_fmac_f32_dpp %2, %6, %11 row_newbcast:3 row_mask:0xf bank_mask:0xf\n\t" "v_fmac_f32_dpp %3, %7, %11 row_newbcast:3 row_mask:0xf bank_mask:0xf\n\t" "v_fmac_f32_dpp %0, %4, %12 row_newbcast:4 row_mask:0xf bank_mask:0xf\n\t" "v_fmac_f32_dpp %1, %5, %12 row_newbcast:4 row_mask:0xf bank_mask:0xf\n\t" "v_fmac_f32_dpp %2, %6, %12 row_newbcast:4 row_mask:0xf bank_mask:0xf\n\t" "v_fmac_f32_dpp %3, %7, %12 row_newbcast:4 row_mask:0xf bank_mask:0xf\n\t" "v_fmac_f32_dpp %0, %4, %13 row_newbcast:5 row_mask:0xf bank_mask:0xf\n\t" "v_fmac_f32_dpp %1, %5, %13 row_newbcast:5 row_mask:0xf bank_mask:0xf\n\t" "v_fmac_f32_dpp %2, %6, %13 row_newbcast:5 row_mask:0xf bank_mask:0xf\n\t" "v_fmac_f32_dpp %3, %7, %13 row_newbcast:5 row_mask:0xf bank_mask:0xf\n\t" "v_fmac_f32_dpp %0, %4, %14 row_newbcast:6 row_mask:0xf bank_mask:0xf\n\t" "v_fmac_f32_dpp %1, %5, %14 row_newbcast:6 row_mask:0xf bank_mask:0xf\n\t" "v_fmac_f32_dpp %2, %6, %14 row_newbcast:6 row_mask:0xf bank_mask:0xf\n\t" "v_fmac_f32_dpp %3, %7, %14 row_newbcast:6 row_mask:0xf bank_mask:0xf\n\t" "v_fmac_f32_dpp %0, %4, %15 row_newbcast:7 row_mask:0xf bank_mask:0xf\n\t" "v_fmac_f32_dpp %1, %5, %15 row_newbcast:7 row_mask:0xf bank_mask:0xf\n\t" "v_fmac_f32_dpp %2, %6, %15 row_newbcast:7 row_mask:0xf bank_mask:0xf\n\t" "v_fmac_f32_dpp %3, %7, %15 row_newbcast:7 row_mask:0xf bank_mask:0xf\n\t" "v_fmac_f32_dpp %0, %4, %16 row_newbcast:8 row_mask:0xf bank_mask:0xf\n\t" "v_fmac_f32_dpp %1, %5, %16 row_newbcast:8 row_mask:0xf bank_mask:0xf\n\t" "v_fmac_f32_dpp %2, %6, %16 row_newbcast:8 row_mask:0xf bank_mask:0xf\n\t" "v_fmac_f32_dpp %3, %7, %16 row_newbcast:8 row_mask:0xf bank_mask:0xf\n\t" "v_fmac_f32_dpp %0, %4, %17 row_newbcast:9 row_mask:0xf bank_mask:0xf\n\t" "v_fmac_f32_dpp %1, %5, %17 row_newbcast:9 row_mask:0xf bank_mask:0xf\n\t" "v_fmac_f32_dpp %2, %6, %17 row_newbcast:9 row_mask:0xf bank_mask:0xf\n\t" "v_fmac_f32_dpp %3, %7, %17 row_newbcast:9 row_mask:0xf bank_mask:0xf\n\t" "v_fmac_f32_dpp %0, %4, %18 row_newbcast:10 row_mask:0xf bank_mask:0xf\n\t" "v_fmac_f32_dpp %1, %5, %18 row_newbcast:10 row_mask:0xf bank_mask:0xf\n\t" "v_fmac_f32_dpp %2, %6, %18 row_newbcast:10 row_mask:0xf bank_mask:0xf\n\t" "v_fmac_f32_dpp %3, %7, %18 row_newbcast:10 row_mask:0xf bank_mask:0xf\n\t" "v_fmac_f32_dpp %0, %4, %19 row_newbcast:11 row_mask:0xf bank_mask:0xf\n\t" "v_fmac_f32_dpp %1, %5, %19 row_newbcast:11 row_mask:0xf bank_mask:0xf\n\t" "v_fmac_f32_dpp %2, %6, %19 row_newbcast:11 row_mask:0xf bank_mask:0xf\n\t" "v_fmac_f32_dpp %3, %7, %19 row_newbcast:11 row_mask:0xf bank_mask:0xf\n\t" "v_fmac_f32_dpp %0, %4, %20 row_newbcast:12 row_mask:0xf bank_mask:0xf\n\t" "v_fmac_f32_dpp %1, %5, %20 row_newbcast:12 row_mask:0xf bank_mask:0xf\n\t" "v_fmac_f32_dpp %2, %6, %20 row_newbcast:12 row_mask:0xf bank_mask:0xf\n\t" "v_fmac_f32_dpp %3, %7, %20 row_newbcast:12 row_mask:0xf bank_mask:0xf\n\t" "v_fmac_f32_dpp %0, %4, %21 row_newbcast:13 row_mask:0xf bank_mask:0xf\n\t" "v_fmac_f32_dpp %1, %5, %21 row_newbcast:13 row_mask:0xf bank_mask:0xf\n\t" "v_fmac_f32_dpp %2, %6, %21 row_newbcast:13 row_mask:0xf bank_mask:0xf\n\t" "v_fmac_f32_dpp %3, %7, %21 row_newbcast:13 row_mask:0xf bank_mask:0xf\n\t" : "+v"(a0), "+v"(a1), "+v"(a2), "+v"(a3) : "v"(l0), "v"(l1), "v"(l2), "v"(l3), "v"(x0), "v"(x1), "v"(x2), "v"(x3), "v"(x4), "v"(x5), "v"(x6), "v"(x7), "v"(x8), "v"(x9), "v"(x10), "v"(x11), "v"(x12), "v"(x13));
    }
};
template <> struct QuadChunk<15> {
    static __device__ __forceinline__ void run(float& a0, float& a1, float& a2, float& a3, float l0, float l1, float l2, float l3, float x0, float x1, float x2, float x3, float x4, float x5, float x6, float x7, float x8, float x9, float x10, float x11, float x12, float x13, float x14) {
        asm volatile("v_fmac_f32_dpp %0, %4, %8 row_newbcast:0 row_mask:0xf bank_mask:0xf\n\t" "v_fmac_f32_dpp %1, %5, %8 row_newbcast:0 row_mask:0xf bank_mask:0xf\n\t" "v_fmac_f32_dpp %2, %6, %8 row_newbcast:0 row_mask:0xf bank_mask:0xf\n\t" "v_fmac_f32_dpp %3, %7, %8 row_newbcast:0 row_mask:0xf bank_mask:0xf\n\t" "v_fmac_f32_dpp %0, %4, %9 row_newbcast:1 row_mask:0xf bank_mask:0xf\n\t" "v_fmac_f32_dpp %1, %5, %9 row_newbcast:1 row_mask:0xf bank_mask:0xf\n\t" "v_fmac_f32_dpp %2, %6, %9 row_newbcast:1 row_mask:0xf bank_mask:0xf\n\t" "v_fmac_f32_dpp %3, %7, %9 row_newbcast:1 row_mask:0xf bank_mask:0xf\n\t" "v_fmac_f32_dpp %0, %4, %10 row_newbcast:2 row_mask:0xf bank_mask:0xf\n\t" "v_fmac_f32_dpp %1, %5, %10 row_newbcast:2 row_mask:0xf bank_mask:0xf\n\t" "v_fmac_f32_dpp %2, %6, %10 row_newbcast:2 row_mask:0xf bank_mask:0xf\n\t" "v_fmac_f32_dpp %3, %7, %10 row_newbcast:2 row_mask:0xf bank_mask:0xf\n\t" "v_fmac_f32_dpp %0, %4, %11 row_newbcast:3 row_mask:0xf bank_mask:0xf\n\t" "v_fmac_f32_dpp %1, %5, %11 row_newbcast:3 row_mask:0xf bank_mask:0xf\n\t" "v_fmac_f32_dpp %2, %6, %11 row_newbcast:3 row_mask:0xf bank_mask:0xf\n\t" "v_fmac_f32_dpp %3, %7, %11 row_newbcast:3 row_mask:0xf bank_mask:0xf\n\t" "v_fmac_f32_dpp %0, %4, %12 row_newbcast:4 row_mask:0xf bank_mask:0xf\n\t" "v_fmac_f32_dpp %1, %5, %12 row_newbcast:4 row_mask:0xf bank_mask:0xf\n\t" "v_fmac_f32_dpp %2, %6, %12 row_newbcast:4 row_mask:0xf bank_mask:0xf\n\t" "v_fmac_f32_dpp %3, %7, %12 row_newbcast:4 row_mask:0xf bank_mask:0xf\n\t" "v_fmac_f32_dpp %0, %4, %13 row_newbcast:5 row_mask:0xf bank_mask:0xf\n\t" "v_fmac_f32_dpp %1, %5, %13 row_newbcast:5 row_mask:0xf bank_mask:0xf\n\t" "v_fmac_f32_dpp %2, %6, %13 row_newbcast:5 row_mask:0xf bank_mask:0xf\n\t" "v_fmac_f32_dpp %3, %7, %13 row_newbcast:5 row_mask:0xf bank_mask:0xf\n\t" "v_fmac_f32_dpp %0, %4, %14 row_newbcast:6 row_mask:0xf bank_mask:0xf\n\t" "v_fmac_f32_dpp %1, %5, %14 row_newbcast:6 row_mask:0xf bank_mask:0xf\n\t" "v_fmac_f32_dpp %2, %6, %14 row_newbcast:6 row_mask:0xf bank_mask:0xf\n\t" "v_fmac_f32_dpp %3, %7, %14 row_newbcast:6 row_mask:0xf bank_mask:0xf\n\t" "v_fmac_f32_dpp %0, %4, %15 row_newbcast:7 row_mask:0xf bank_mask:0xf\n\t" "v_fmac_f32_dpp %1, %5, %15 row_newbcast:7 row_mask:0xf bank_mask:0xf\n\t" "v_fmac_f32_dpp %2, %6, %15 row_newbcast:7 row_mask:0xf bank_mask:0xf\n\t" "v_fmac_f32_dpp %3, %7, %15 row_newbcast:7 row_mask:0xf bank_mask:0xf\n\t" "v_fmac_f32_dpp %0, %4, %16 row_newbcast:8 row_mask:0xf bank_mask:0xf\n\t" "v_fmac_f32_dpp %1, %5, %16 row_newbcast:8 row_mask:0xf bank_mask:0xf\n\t" "v_fmac_f32_dpp %2, %6, %16 row_newbcast:8 row_mask:0xf bank_mask:0xf\n\t" "v_fmac_f32_dpp %3, %7, %16 row_newbcast:8 row_mask:0xf bank_mask:0xf\n\t" "v_fmac_f32_dpp %0, %4, %17 row_newbcast:9 row_mask:0xf bank_mask:0xf\n\t" "v_fmac_f32_dpp %1, %5, %17 row_newbcast:9 row_mask:0xf bank_mask:0xf\n\t" "v_fmac_f32_dpp %2, %6, %17 row_newbcast:9 row_mask:0xf bank_mask:0xf\n\t" "v_fmac_f32_dpp %3, %7, %17 row_newbcast:9 row_mask:0xf bank_mask:0xf\n\t" "v_fmac_f32_dpp %0, %4, %18 row_newbcast:10 row_mask:0xf bank_mask:0xf\n\t" "v_fmac_f32_dpp %1, %5, %18 row_newbcast:10 row_mask:0xf bank_mask:0xf\n\t" "v_fmac_f32_dpp %2, %6, %18 row_newbcast:10 row_mask:0xf bank_mask:0xf\n\t" "v_fmac_f32_dpp %3, %7, %18 row_newbcast:10 row_mask:0xf bank_mask:0xf\n\t" "v_fmac_f32_dpp %0, %4, %19 row_newbcast:11 row_mask:0xf bank_mask:0xf\n\t" "v_fmac_f32_dpp %1, %5, %19 row_newbcast:11 row_mask:0xf bank_mask:0xf\n\t" "v_fmac_f32_dpp %2, %6, %19 row_newbcast:11 row_mask:0xf bank_mask:0xf\n\t" "v_fmac_f32_dpp %3, %7, %19 row_newbcast:11 row_mask:0xf bank_mask:0xf\n\t" "v_fmac_f32_dpp %0, %4, %20 row_newbcast:12 row_mask:0xf bank_mask:0xf\n\t" "v_fmac_f32_dpp %1, %5, %20 row_newbcast:12 row_mask:0xf bank_mask:0xf\n\t" "v_fmac_f32_dpp %2, %6, %20 row_newbcast:12 row_mask:0xf bank_mask:0xf\n\t" "v_fmac_f32_dpp %3, %7, %20 row_newbcast:12 row_mask:0xf bank_mask:0xf\n\t" "v_fmac_f32_dpp %0, %4, %21 row_newbcast:13 row_mask:0xf bank_mask:0xf\n\t" "v_fmac_f32_dpp %1, %5, %21 row_newbcast:13 row_mask:0xf bank_mask:0xf\n\t" "v_fmac_f32_dpp %2, %6, %21 row_newbcast:13 row_mask:0xf bank_mask:0xf\n\t" "v_fmac_f32_dpp %3, %7, %21 row_newbcast:13 row_mask:0xf bank_mask:0xf\n\t" "v_fmac_f32_dpp %0, %4, %22 row_newbcast:14 row_mask:0xf bank_mask:0xf\n\t" "v_fmac_f32_dpp %1, %5, %22 row_newbcast:14 row_mask:0xf bank_mask:0xf\n\t" "v_fmac_f32_dpp %2, %6, %22 row_newbcast:14 row_mask:0xf bank_mask:0xf\n\t" "v_fmac_f32_dpp %3, %7, %22 row_newbcast:14 row_mask:0xf bank_mask:0xf\n\t" : "+v"(a0), "+v"(a1), "+v"(a2), "+v"(a3) : "v"(l0), "v"(l1), "v"(l2), "v"(l3), "v"(x0), "v"(x1), "v"(x2), "v"(x3), "v"(x4), "v"(x5), "v"(x6), "v"(x7), "v"(x8), "v"(x9), "v"(x10), "v"(x11), "v"(x12), "v"(x13), "v"(x14));
    }
};
template <> struct QuadChunk<16> {
    static __device__ __forceinline__ void run(float& a0, float& a1, float& a2, float& a3, float l0, float l1, float l2, float l3, float x0, float x1, float x2, float x3, float x4, float x5, float x6, float x7, float x8, float x9, float x10, float x11, float x12, float x13, float x14, float x15) {
        asm volatile("v_fmac_f32_dpp %0, %4, %8 row_newbcast:0 row_mask:0xf bank_mask:0xf\n\t" "v_fmac_f32_dpp %1, %5, %8 row_newbcast:0 row_mask:0xf bank_mask:0xf\n\t" "v_fmac_f32_dpp %2, %6, %8 row_newbcast:0 row_mask:0xf bank_mask:0xf\n\t" "v_fmac_f32_dpp %3, %7, %8 row_newbcast:0 row_mask:0xf bank_mask:0xf\n\t" "v_fmac_f32_dpp %0, %4, %9 row_newbcast:1 row_mask:0xf bank_mask:0xf\n\t" "v_fmac_f32_dpp %1, %5, %9 row_newbcast:1 row_mask:0xf bank_mask:0xf\n\t" "v_fmac_f32_dpp %2, %6, %9 row_newbcast:1 row_mask:0xf bank_mask:0xf\n\t" "v_fmac_f32_dpp %3, %7, %9 row_newbcast:1 row_mask:0xf bank_mask:0xf\n\t" "v_fmac_f32_dpp %0, %4, %10 row_newbcast:2 row_mask:0xf bank_mask:0xf\n\t" "v_fmac_f32_dpp %1, %5, %10 row_newbcast:2 row_mask:0xf bank_mask:0xf\n\t" "v_fmac_f32_dpp %2, %6, %10 row_newbcast:2 row_mask:0xf bank_mask:0xf\n\t" "v_fmac_f32_dpp %3, %7, %10 row_newbcast:2 row_mask:0xf bank_mask:0xf\n\t" "v_fmac_f32_dpp %0, %4, %11 row_newbcast:3 row_mask:0xf bank_mask:0xf\n\t" "v_fmac_f32_dpp %1, %5, %11 row_newbcast:3 row_mask:0xf bank_mask:0xf\n\t" "v_fmac_f32_dpp %2, %6, %11 row_newbcast:3 row_mask:0xf bank_mask:0xf\n\t" "v_fmac_f32_dpp %3, %7, %11 row_newbcast:3 row_mask:0xf bank_mask:0xf\n\t" "v_fmac_f32_dpp %0, %4, %12 row_newbcast:4 row_mask:0xf bank_mask:0xf\n\t" "v_fmac_f32_dpp %1, %5, %12 row_newbcast:4 row_mask:0xf bank_mask:0xf\n\t" "v_fmac_f32_dpp %2, %6, %12 row_newbcast:4 row_mask:0xf bank_mask:0xf\n\t" "v_fmac_f32_dpp %3, %7, %12 row_newbcast:4 row_mask:0xf bank_mask:0xf\n\t" "v_fmac_f32_dpp %0, %4, %13 row_newbcast:5 row_mask:0xf bank_mask:0xf\n\t" "v_fmac_f32_dpp %1, %5, %13 row_newbcast:5 row_mask:0xf bank_mask:0xf\n\t" "v_fmac_f32_dpp %2, %6, %13 row_newbcast:5 row_mask:0xf bank_mask:0xf\n\t" "v_fmac_f32_dpp %3, %7, %13 row_newbcast:5 row_mask:0xf bank_mask:0xf\n\t" "v_fmac_f32_dpp %0, %4, %14 row_newbcast:6 row_mask:0xf bank_mask:0xf\n\t" "v_fmac_f32_dpp %1, %5, %14 row_newbcast:6 row_mask:0xf bank_mask:0xf\n\t" "v_fmac_f32_dpp %2, %6, %14 row_newbcast:6 row_mask:0xf bank_mask:0xf\n\t" "v_fmac_f32_dpp %3, %7, %14 row_newbcast:6 row_mask:0xf bank_mask:0xf\n\t" "v_fmac_f32_dpp %0, %4, %15 row_newbcast:7 row_mask:0xf bank_mask:0xf\n\t" "v_fmac_f32_dpp %1, %5, %15 row_newbcast:7 row_mask:0xf bank_mask:0xf\n\t" "v_fmac_f32_dpp %2, %6, %15 row_newbcast:7 row_mask:0xf bank_mask:0xf\n\t" "v_fmac_f32_dpp %3, %7, %15 row_newbcast:7 row_mask:0xf bank_mask:0xf\n\t" "v_fmac_f32_dpp %0, %4, %16 row_newbcast:8 row_mask:0xf bank_mask:0xf\n\t" "v_fmac_f32_dpp %1, %5, %16 row_newbcast:8 row_mask:0xf bank_mask:0xf\n\t" "v_fmac_f32_dpp %2, %6, %16 row_newbcast:8 row_mask:0xf bank_mask:0xf\n\t" "v_fmac_f32_dpp %3, %7, %16 row_newbcast:8 row_mask:0xf bank_mask:0xf\n\t" "v_fmac_f32_dpp %0, %4, %17 row_newbcast:9 row_mask:0xf bank_mask:0xf\n\t" "v_fmac_f32_dpp %1, %5, %17 row_newbcast:9 row_mask:0xf bank_mask:0xf\n\t" "v_fmac_f32_dpp %2, %6, %17 row_newbcast:9 row_mask:0xf bank_mask:0xf\n\t" "v_fmac_f32_dpp %3, %7, %17 row_newbcast:9 row_mask:0xf bank_mask:0xf\n\t" "v_fmac_f32_dpp %0, %4, %18 row_newbcast:10 row_mask:0xf bank_mask:0xf\n\t" "v_fmac_f32_dpp %1, %5, %18 row_newbcast:10 row_mask:0xf bank_mask:0xf\n\t" "v_fmac_f32_dpp %2, %6, %18 row_newbcast:10 row_mask:0xf bank_mask:0xf\n\t" "v_fmac_f32_dpp %3, %7, %18 row_newbcast:10 row_mask:0xf bank_mask:0xf\n\t" "v_fmac_f32_dpp %0, %4, %19 row_newbcast:11 row_mask:0xf bank_mask:0xf\n\t" "v_fmac_f32_dpp %1, %5, %19 row_newbcast:11 row_mask:0xf bank_mask:0xf\n\t" "v_fmac_f32_dpp %2, %6, %19 row_newbcast:11 row_mask:0xf bank_mask:0xf\n\t" "v_fmac_f32_dpp %3, %7, %19 row_newbcast:11 row_mask:0xf bank_mask:0xf\n\t" "v_fmac_f32_dpp %0, %4, %20 row_newbcast:12 row_mask:0xf bank_mask:0xf\n\t" "v_fmac_f32_dpp %1, %5, %20 row_newbcast:12 row_mask:0xf bank_mask:0xf\n\t" "v_fmac_f32_dpp %2, %6, %20 row_newbcast:12 row_mask:0xf bank_mask:0xf\n\t" "v_fmac_f32_dpp %3, %7, %20 row_newbcast:12 row_mask:0xf bank_mask:0xf\n\t" "v_fmac_f32_dpp %0, %4, %21 row_newbcast:13 row_mask:0xf bank_mask:0xf\n\t" "v_fmac_f32_dpp %1, %5, %21 row_newbcast:13 row_mask:0xf bank_mask:0xf\n\t" "v_fmac_f32_dpp %2, %6, %21 row_newbcast:13 row_mask:0xf bank_mask:0xf\n\t" "v_fmac_f32_dpp %3, %7, %21 row_newbcast:13 row_mask:0xf bank_mask:0xf\n\t" "v_fmac_f32_dpp %0, %4, %22 row_newbcast:14 row_mask:0xf bank_mask:0xf\n\t" "v_fmac_f32_dpp %1, %5, %22 row_newbcast:14 row_mask:0xf bank_mask:0xf\n\t" "v_fmac_f32_dpp %2, %6, %22 row_newbcast:14 row_mask:0xf bank_mask:0xf\n\t" "v_fmac_f32_dpp %3, %7, %22 row_newbcast:14 row_mask:0xf bank_mask:0xf\n\t" "v_fmac_f32_dpp %0, %4, %23 row_newbcast:15 row_mask:0xf bank_mask:0xf\n\t" "v_fmac_f32_dpp %1, %5, %23 row_newbcast:15 row_mask:0xf bank_mask:0xf\n\t" "v_fmac_f32_dpp %2, %6, %23 row_newbcast:15 row_mask:0xf bank_mask:0xf\n\t" "v_fmac_f32_dpp %3, %7, %23 row_newbcast:15 row_mask:0xf bank_mask:0xf\n\t" : "+v"(a0), "+v"(a1), "+v"(a2), "+v"(a3) : "v"(l0), "v"(l1), "v"(l2), "v"(l3), "v"(x0), "v"(x1), "v"(x2), "v"(x3), "v"(x4), "v"(x5), "v"(x6), "v"(x7), "v"(x8), "v"(x9), "v"(x10), "v"(x11), "v"(x12), "v"(x13), "v"(x14), "v"(x15));
    }
};
template <int N, int B> struct QuadCall;
#define QC_DEF(N) template <int B> struct QuadCall<N, B> { static __device__ __forceinline__ void run(float (&x)[64], int I, float (&l)[4][4], int Q); };
#undef QC_DEF
#define QC_DEF(N) template <int B> struct QuadCallI { };
#undef QC_DEF
template <int N, int B, int I, int Q> struct QuadDo;
#define QD_DEF(N) template <int B, int I, int Q> struct QuadDo<N, B, I, Q> { static __device__ __forceinline__ void run(float (&x)[64], const float (&l)[4][4]) { QuadChunk<N>::run(x[I], x[I + 1], x[I + 2], x[I + 3], l[0][Q], l[1][Q], l[2][Q], l[3][Q], CC_ARGS##N(B)); } };
QD_DEF(1) QD_DEF(2) QD_DEF(3) QD_DEF(4) QD_DEF(5) QD_DEF(6) QD_DEF(7) QD_DEF(8) QD_DEF(9) QD_DEF(10) QD_DEF(11) QD_DEF(12) QD_DEF(13) QD_DEF(14) QD_DEF(15) QD_DEF(16)
#undef QD_DEF
template <int I, int Q> struct SolveQuadBlocks {
    static __device__ __forceinline__ void run(float (&x)[64], const float (&l)[4][4]) {
        if constexpr (Q > 0) SolveQuadBlocks<I, Q - 1>::run(x, l);
        constexpr int n = (I - 16 * Q) < 16 ? (I - 16 * Q) : 16;
        QuadDo<n, 16 * Q, I, Q>::run(x, l);
    }
};
template <int I> struct SolveRows {
    static __device__ __forceinline__ void run(float (&x)[64], const LAS float* Ls, int l15) {
        if constexpr (I > 0) SolveRows<I - 4>::run(x, Ls, l15);
        float l[4][4];
#pragma unroll
        for (int r = 0; r < 4; ++r)
#pragma unroll
            for (int q = 0; q < 4; ++q) l[r][q] = (16 * q < I + 3) ? Ls[(I + r) * 68 + 16 * q + l15] : 0.f;
        if constexpr (I > 0) SolveQuadBlocks<I, (I - 1) / 16>::run(x, l);
        constexpr int QB = I >> 4, L0 = I & 15;
        fmac_bcast<L0>(x[I + 1], l[1][QB], x[I]);
        fmac_bcast<L0>(x[I + 2], l[2][QB], x[I]); fmac_bcast<L0>(x[I + 3], l[3][QB], x[I]);
        fmac_bcast<L0 + 1>(x[I + 2], l[2][QB], x[I + 1]); fmac_bcast<L0 + 1>(x[I + 3], l[3][QB], x[I + 1]);
        fmac_bcast<L0 + 2>(x[I + 3], l[3][QB], x[I + 2]);
        if ((I & 7) == 4) asm volatile("" ::: "memory");
    }
};

#define XB_TMO      128
#define XB_XCNT(j)  (256  + 64 * (j))
#define XB_XSUB(j)  (1280 + 64 * (j))
#define XB_XGEN(j)  (2304 + 64 * (j))
#define XB_TOP      3328
#define XB_TOPGEN   3392
#define XCD_BAR_WORDS 3456
#define XB_SPIN_CAP (1u << 18)
__device__ __forceinline__ unsigned xb_ld(unsigned* p)              { return __hip_atomic_load(p, __ATOMIC_RELAXED, __HIP_MEMORY_SCOPE_AGENT); }
__device__ __forceinline__ unsigned xb_add(unsigned* p, unsigned v) { return __hip_atomic_fetch_add(p, v, __ATOMIC_RELAXED, __HIP_MEMORY_SCOPE_AGENT); }
__device__ __forceinline__ unsigned xb_xcc_id() { return (unsigned)__builtin_amdgcn_s_getreg((3 << 11) | 20) & 0xFu; }
#define XB_SPIN(cond, bar) do { unsigned _sp = 0; while (cond) { __builtin_amdgcn_s_sleep(1); \
    if ((++_sp & 255u) == 0u) { if (xb_ld(&(bar)[XB_TMO])) break; if (_sp > XB_SPIN_CAP) { atomicAdd(&(bar)[XB_TMO], 1u); break; } } } } while (0)
struct XcdBarrier { unsigned* bar; unsigned x; volatile LAS unsigned* st; };
__device__ __forceinline__ XcdBarrier xcd_barrier_post(unsigned* bar, volatile LAS unsigned* st) {
    XcdBarrier b; b.bar = bar; b.x = xb_xcc_id(); b.st = st;
    if (threadIdx.x == 0) (void)xb_add(&bar[XB_XCNT(b.x)], 1u);
    return b;
}
__device__ __forceinline__ void xcd_barrier_complete(unsigned* bar, unsigned x, unsigned& nloc, unsigned& nx) {
    const unsigned G = gridDim.x * gridDim.y * gridDim.z;
    unsigned sum, cnt, mine, sp = 0u;
    for (;;) {
        sum = 0u; cnt = 0u; mine = 0u;
#pragma unroll
        for (unsigned j = 0; j < 16; ++j) { const unsigned c = xb_ld(&bar[XB_XCNT(j)]); sum += c; cnt += (c > 0u) ? 1u : 0u; mine = (j == x) ? c : mine; }
        if (sum == G) break;
        __builtin_amdgcn_s_sleep(1);
        if ((++sp & 255u) == 0u) { if (xb_ld(&bar[XB_TMO])) break; if (sp > XB_SPIN_CAP) { atomicAdd(&bar[XB_TMO], 1u); break; } }
    }
    nloc = mine > 0u ? mine : 1u; nx = cnt > 0u ? cnt : 1u;
}
__device__ __forceinline__ void xcd_barrier(const XcdBarrier& b) {
    asm volatile("s_waitcnt vmcnt(0)" ::: "memory");
    __syncthreads();
    if (threadIdx.x == 0) {
        unsigned* bar = b.bar;
        __builtin_amdgcn_s_waitcnt(0);
        unsigned nloc = b.st[0], nx = b.st[1];
        if (nloc == 0u) { xcd_barrier_complete(bar, b.x, nloc, nx); b.st[0] = nloc; b.st[1] = nx; }
        const unsigned old = xb_add(&bar[XB_XSUB(b.x)], 1u);
        const unsigned gen = old / nloc;
        if (old + 1u == (gen + 1u) * nloc) {
            __builtin_amdgcn_fence(__ATOMIC_RELEASE, "agent");
            asm volatile("s_waitcnt vmcnt(0)" ::: "memory");
            const unsigned og = xb_add(&bar[XB_TOP], 1u);
            const unsigned tg = og / nx;
            if (og + 1u == (tg + 1u) * nx) xb_add(&bar[XB_TOPGEN], 1u);
            else XB_SPIN(xb_ld(&bar[XB_TOPGEN]) == tg, bar);
            __builtin_amdgcn_fence(__ATOMIC_ACQUIRE, "agent");
            xb_add(&bar[XB_XGEN(b.x)], 1u);
            asm volatile("s_waitcnt vmcnt(0)" ::: "memory");
        } else {
            XB_SPIN(xb_ld(&bar[XB_XGEN(b.x)]) == gen, bar);
            __builtin_amdgcn_fence(__ATOMIC_ACQUIRE, "agent");
            asm volatile("s_waitcnt vmcnt(0)" ::: "memory");
        }
    }
    __syncthreads();
}

struct Frame {
    LAS unsigned char* lds;
    volatile LAS unsigned* MISC;
    unsigned* ctl;
    int tid, lane, wave, vcu, G;
    const float* in[25]; float* out; unsigned char* ws;
};
enum { I_X = 0, I_P, I_NORM_MIX, I_W_IN, I_POOL_W, I_POOL_SCALE, I_CONV_W, I_A_LOG, I_DT_BIAS, I_DN_NORM, I_W_UP_POOL, I_W_UP_DN, I_W_OUT, I_NORM_MOE,
       I_W_RG, I_B_RG, I_W_RE, I_B_RE, I_W_GATE, I_W_UP, I_W_DOWN, I_NORM_PLE, I_W_PLE_GATE, I_W_PLE_PROJ, I_NORM_FINAL };

struct Unit { int pn, e, arow0, nrows, lrow0; };
template <int RB> struct DenseSched {
    int nM, nN, G, c, K;
    __device__ __forceinline__ void init(int M, int N, int K_, int G_, int c_) { nM = M / RB; nN = N / 256; G = G_; c = c_; K = K_; }
    __device__ __forceinline__ bool next(int i, Unit& u) const {
        const long L = (long)i * G + c; if (L >= (long)nM * nN) return false;
        const int pm = (int)(L / nN); u.pn = (int)(L % nN); u.e = 0; u.arow0 = pm * RB; u.nrows = RB; u.lrow0 = 0; return true;
    }
    __device__ __forceinline__ int arow(const Unit& u, int r) const { return u.arow0 + r; }
    __device__ __forceinline__ size_t boff(const Unit& u) const { return (size_t)u.pn * 256 * K; }
};
template <int RB, bool GATHER> struct MoeSched {
    const LAS int* pre; const LAS int* base; const int* ltk; int nN, G, c, K, Nfull;
    __device__ __forceinline__ bool next(int i, Unit& u) const {
        const long L = (long)i * G + c; if (L >= (long)pre[NE] * nN) return false;
        const int blk = (int)(L / nN); u.pn = (int)(L % nN);
        int e = 0;
        for (int j = 1; j < NE; ++j) if (pre[j] <= blk) e = j;
        const int rb = blk - pre[e]; const int cnt = base[e + 1] - base[e];
        const int nr = (cnt - rb * RB) < RB ? (cnt - rb * RB) : RB;
        u.e = __builtin_amdgcn_readfirstlane(e); u.lrow0 = __builtin_amdgcn_readfirstlane(rb * RB); u.arow0 = __builtin_amdgcn_readfirstlane(base[e] + rb * RB); u.nrows = __builtin_amdgcn_readfirstlane(nr);
        u.pn = __builtin_amdgcn_readfirstlane(u.pn); return true;
    }
    __device__ __forceinline__ int arow(const Unit& u, int r) const {
        const int rr = r < u.nrows ? r : u.nrows - 1;
        if (GATHER) return ltk[(size_t)u.e * T + u.lrow0 + rr] >> 1;
        return u.arow0 + rr;
    }
    __device__ __forceinline__ size_t boff(const Unit& u) const { return ((size_t)u.e * Nfull + (size_t)u.pn * 256) * K; }
};
template <int RB> __device__ __forceinline__ void moe_tables(Frame& F, LAS int* pre, LAS int* base) {
    __syncthreads();
    if (F.tid == 0) { int p = 0, b = 0; for (int e = 0; e < NE; ++e) { const int c = (int)F.ctl[CW_CNT + 64 * e]; pre[e] = p; base[e] = b; p += (c + RB - 1) / RB; b += c; } pre[NE] = p; base[NE] = b; }
    __syncthreads();
}

constexpr int SG_RB = 64, SG_BK = 32, SG_ALD = 68, SG_BLD = 260;
template <class Epi, class Sched>
__device__ __forceinline__ void sgemm_phase(Frame& F, const bf16* A, const bf16* Bt, int K, const Sched& S, const Epi& E) {
    LAS float* As = (LAS float*)(F.lds + RING_OFF);
    LAS float* Bs = As + SG_BK * SG_ALD;
    const int tid = F.tid, rg = tid >> 4, cg = tid & 15;
    const int la = tid >> 3, kq = (tid & 7) * 4;
    const int nb = tid >> 1, kh = (tid & 1) * 16;
    for (int i = 0;; ++i) {
        Unit u; if (!S.next(i, u)) break;
        const bf16* ap = A + (size_t)S.arow(u, la) * K + kq;
        const bf16* bp = Bt + S.boff(u) + (size_t)nb * K + kh;
        float acc[2][16];
#pragma unroll
        for (int a = 0; a < 2; ++a)
#pragma unroll
            for (int b = 0; b < 16; ++b) acc[a][b] = 0.f;
        for (int k0 = 0; k0 < K; k0 += SG_BK) {
            const v2u av = *(const v2u*)(ap + k0);
            const v4u b0 = *(const v4u*)(bp + k0), b1 = *(const v4u*)(bp + k0 + 8);
            __syncthreads();
            As[(kq + 0) * SG_ALD + la] = bflo(av.x); As[(kq + 1) * SG_ALD + la] = bfhi(av.x); As[(kq + 2) * SG_ALD + la] = bflo(av.y); As[(kq + 3) * SG_ALD + la] = bfhi(av.y);
            Bs[(kh + 0) * SG_BLD + nb] = bflo(b0.x); Bs[(kh + 1) * SG_BLD + nb] = bfhi(b0.x); Bs[(kh + 2) * SG_BLD + nb] = bflo(b0.y); Bs[(kh + 3) * SG_BLD + nb] = bfhi(b0.y);
            Bs[(kh + 4) * SG_BLD + nb] = bflo(b0.z); Bs[(kh + 5) * SG_BLD + nb] = bfhi(b0.z); Bs[(kh + 6) * SG_BLD + nb] = bflo(b0.w); Bs[(kh + 7) * SG_BLD + nb] = bfhi(b0.w);
            Bs[(kh + 8) * SG_BLD + nb] = bflo(b1.x); Bs[(kh + 9) * SG_BLD + nb] = bfhi(b1.x); Bs[(kh + 10) * SG_BLD + nb] = bflo(b1.y); Bs[(kh + 11) * SG_BLD + nb] = bfhi(b1.y);
            Bs[(kh + 12) * SG_BLD + nb] = bflo(b1.z); Bs[(kh + 13) * SG_BLD + nb] = bfhi(b1.z); Bs[(kh + 14) * SG_BLD + nb] = bflo(b1.w); Bs[(kh + 15) * SG_BLD + nb] = bfhi(b1.w);
            __syncthreads();
#pragma unroll 8
            for (int kk = 0; kk < SG_BK; ++kk) {
                const float a0 = As[kk * SG_ALD + rg], a1 = As[kk * SG_ALD + rg + 32];
                const f32x4 p0 = *(const LAS f32x4*)(Bs + kk * SG_BLD + 8 * cg), p1 = *(const LAS f32x4*)(Bs + kk * SG_BLD + 8 * cg + 4);
                const f32x4 p2 = *(const LAS f32x4*)(Bs + kk * SG_BLD + 128 + 8 * cg), p3 = *(const LAS f32x4*)(Bs + kk * SG_BLD + 128 + 8 * cg + 4);
#pragma unroll
                for (int j = 0; j < 4; ++j) {
                    acc[0][j] += a0 * p0[j]; acc[0][4 + j] += a0 * p1[j]; acc[0][8 + j] += a0 * p2[j]; acc[0][12 + j] += a0 * p3[j];
                    acc[1][j] += a1 * p0[j]; acc[1][4 + j] += a1 * p1[j]; acc[1][8 + j] += a1 * p2[j]; acc[1][12 + j] += a1 * p3[j];
                }
            }
        }
#pragma unroll
        for (int a = 0; a < 2; ++a) { const int r = rg + 32 * a; if (r < u.nrows) E.store(u, r, 8 * cg, &acc[a][0], &acc[a][8]); }
    }
    __syncthreads();
}


namespace pg8 {
constexpr int BM = 256, BK = 64, HALF = 128, HTB = HALF * BK * 2, STAGE_BYTES = 8 * HTB, NXCD = 8, WGM = 8;
__host__ __device__ __forceinline__ int lds_byte(int r, int c) { const int st = (r >> 4) * 2 + (c >> 5), rr = r & 15, cc = c & 31, ob = rr * 64 + cc * 2; return st * 1024 + (ob ^ (((ob >> 9) & 1) << 5)); }
__host__ __device__ __forceinline__ void stage_rc(int b, int& R, int& C) { const int st = b / 1024, sb = b % 1024, swz = sb ^ (((sb >> 9) & 1) << 5); R = (st >> 1) * 16 + swz / 64; C = (st & 1) * 32 + (swz % 64) / 2; }
__host__ __device__ __forceinline__ int perm32(int rho) { const int n = rho >> 4, i = rho & 15; return 8 * (i >> 2) + 4 * n + (i & 3); }

struct DenseOrder {
    int nM, nN, nwg, G, c, K;
    __device__ __forceinline__ void init(int M, int N, int K_, int G_, int c_) { nM = M / BM; nN = N / BM; nwg = nM * nN; G = G_; c = c_; K = K_; }
    __device__ __forceinline__ bool next(int i, Unit& u) const {
        const long L = (long)i * G + c; if (L >= nwg) return false;
        int wgid = (int)L; { const int q = nwg / NXCD, r = nwg % NXCD, xcd = wgid % NXCD, off = wgid / NXCD; wgid = (xcd < r ? xcd * (q + 1) : r * (q + 1) + (xcd - r) * q) + off; }
        const int nig = WGM * nN, gid = wgid / nig, fm = gid * WGM, gsz = (nM - fm) < WGM ? (nM - fm) : WGM;
        u.pn = (wgid % nig) / gsz; u.e = 0; u.arow0 = (fm + ((wgid % nig) % gsz)) * BM; u.nrows = BM; u.lrow0 = 0; return true;
    }
    __device__ __forceinline__ int arow(const Unit& u, int r) const { return u.arow0 + r; }
    __device__ __forceinline__ size_t boff(const Unit& u) const { return (size_t)u.pn * 256 * K; }
};

template <class Epi, class Sched, bool GATHER, bool ALIGN_EPI = true, bool SP2 = true>
__device__ __forceinline__ void gemm_phase(LAS unsigned char* lds, const bf16* Ag, const bf16* Btg, const int K, const Sched& S, const Epi& E) {
    const int tid = threadIdx.x, wid = __builtin_amdgcn_readfirstlane(tid >> 6), lane = tid & 63, wr = wid >> 2, wc = wid & 3, fr = lane & 15, fq = lane >> 4;
    const int nt = K / BK;
    unsigned voffA[2], voffB[2]; int RA[2], CA[2];
#pragma unroll
    for (int i = 0; i < 2; ++i) { int R, C; stage_rc(tid * 16 + i * 8192, R, C); const int Rb = (R & ~31) + perm32(R & 31);
        voffA[i] = (unsigned)(R * K + C) * 2u; voffB[i] = (unsigned)(Rb * K + C) * 2u; RA[i] = R; CA[i] = C; }
    const size_t kstep = (size_t)(BK * 2);
    const size_t hstep = (size_t)HALF * K * 2;
    const unsigned ldsw = (unsigned)wid * 1024u;
    const int aoff = lds_byte(wr * 64 + fr, fq * 8), boff = lds_byte(wc * 32 + fr, fq * 8);
#define PG8_SA(b, h) (((b) * 2 + (h)) * HTB)
#define PG8_SB(b, h) ((4 + (b) * 2 + (h)) * HTB)
#define PG8_STAGE(bufoff, gbase, voff) do { _Pragma("unroll") for (int _i = 0; _i < 2; ++_i) \
        __builtin_amdgcn_global_load_lds((const unsigned*)((const char*)(gbase) + (voff)[_i]), (LAS unsigned*)(lds + (bufoff) + ldsw + _i * 8192), 16, 0, 0); } while (0)
#define PG8_STAGE_A(bufoff, base, vg, h, ko) do { if (GATHER) { PG8_STAGE(bufoff, (const char*)Ag + (ko), vg[h]); } else { PG8_STAGE(bufoff, (base) + (h) * hstep + (ko), voffA); } } while (0)
#define PG8_LDA(dst, b, h) do { _Pragma("unroll") for (int m = 0; m < 4; ++m) _Pragma("unroll") for (int k = 0; k < 2; ++k) dst[m][k] = *(const LAS bf16x8*)(lds + PG8_SA(b, h) + aoff + m * 2048 + k * 1024); } while (0)
#define PG8_LDB(dst, b, h) do { _Pragma("unroll") for (int n = 0; n < 2; ++n) _Pragma("unroll") for (int k = 0; k < 2; ++k) dst[n][k] = *(const LAS bf16x8*)(lds + PG8_SB(b, h) + boff + n * 2048 + k * 1024); } while (0)
#define PG8_MMA(ai, bj, At, Bt) do { __builtin_amdgcn_s_setprio(1); _Pragma("unroll") for (int m = 0; m < 4; ++m) _Pragma("unroll") for (int n = 0; n < 2; ++n) _Pragma("unroll") for (int k = 0; k < 2; ++k) \
        acc[ai][bj][m][n] = __builtin_amdgcn_mfma_f32_16x16x32_bf16(Bt[n][k], At[m][k], acc[ai][bj][m][n], 0, 0, 0); __builtin_amdgcn_s_setprio(0); } while (0)
#define PG8_WAIT_V(n) asm volatile("s_waitcnt vmcnt(" #n ")" ::: "memory")
#define PG8_WAIT_L(n) asm volatile("s_waitcnt lgkmcnt(" #n ")" ::: "memory")
#define PG8_BAR __builtin_amdgcn_s_barrier()
#define PG8_SCHED __builtin_amdgcn_sched_barrier(0)
#define PG8_ROWOFFS(dst, un) do { _Pragma("unroll") for (int _h = 0; _h < 2; ++_h) _Pragma("unroll") for (int _i = 0; _i < 2; ++_i) \
        dst[_h][_i] = ((unsigned)S.arow(un, _h * HALF + RA[_i]) * (unsigned)K + (unsigned)CA[_i]) * 2u; } while (0)
    Unit cur, nxt; int ui = 0;
    if (!S.next(0, cur)) return;
    f32x4 acc[2][2][4][2];
#pragma unroll
    for (int a = 0; a < 2; ++a)
#pragma unroll
        for (int b = 0; b < 2; ++b)
#pragma unroll
            for (int m = 0; m < 4; ++m)
#pragma unroll
                for (int n = 0; n < 2; ++n) acc[a][b][m][n] = (f32x4){0.f, 0.f, 0.f, 0.f};
    bf16x8 At[4][2], B0[2][2], B1[2][2];
    unsigned vc[2][2], vn[2][2];
    if (GATHER) { PG8_ROWOFFS(vc, cur); }
    const char* cA = GATHER ? (const char*)Ag : (const char*)Ag + (size_t)cur.arow0 * K * 2; const char* cB = (const char*)Btg + S.boff(cur) * 2;
    if constexpr (SP2) {
        PG8_STAGE(PG8_SB(0, 0), cB, voffB); PG8_STAGE(PG8_SB(0, 1), cB + hstep, voffB); PG8_STAGE_A(PG8_SA(0, 0), cA, vc, 0, 0); PG8_STAGE_A(PG8_SA(0, 1), cA, vc, 1, 0);
        if (wr == 1) PG8_BAR;
        PG8_WAIT_V(2); PG8_BAR;
        PG8_STAGE(PG8_SB(1, 0), cB + kstep, voffB); PG8_STAGE_A(PG8_SA(1, 0), cA, vc, 0, kstep); PG8_STAGE(PG8_SB(1, 1), cB + hstep + kstep, voffB);
        PG8_WAIT_V(6); PG8_BAR;
    } else {
        PG8_STAGE(PG8_SB(0, 0), cB, voffB); PG8_STAGE_A(PG8_SA(0, 0), cA, vc, 0, 0); PG8_STAGE(PG8_SB(0, 1), cB + hstep, voffB); PG8_STAGE_A(PG8_SA(0, 1), cA, vc, 1, 0);
        if (wr == 1) PG8_BAR;
        PG8_WAIT_V(4); PG8_BAR;
        PG8_STAGE(PG8_SB(1, 0), cB + kstep, voffB); PG8_STAGE_A(PG8_SA(1, 0), cA, vc, 0, kstep); PG8_STAGE(PG8_SB(1, 1), cB + hstep + kstep, voffB);
        PG8_WAIT_V(6); PG8_BAR;
    }
    for (;;) {
        const bool has_next = S.next(ui + 1, nxt);
        const char* nA = GATHER ? cA : (has_next ? (const char*)Ag + (size_t)nxt.arow0 * K * 2 : cA); const char* nB = has_next ? (const char*)Btg + S.boff(nxt) * 2 : cB;
        if (GATHER) { if (has_next) { PG8_ROWOFFS(vn, nxt); } else {
#pragma unroll
            for (int _h = 0; _h < 2; ++_h)
#pragma unroll
                for (int _i = 0; _i < 2; ++_i) vn[_h][_i] = vc[_h][_i]; } }
#pragma unroll 1
        for (int t = 0; t < nt; t += 2) {
            const bool last = (t == nt - 2);
            const size_t k1 = (size_t)(t + 1) * kstep;
            const size_t k2 = last ? 0 : (size_t)(t + 2) * kstep, k3 = k2 + kstep;
            const char* a2 = last ? nA : cA; const char* b2 = (last ? nB : cB) + k2; const char* b3 = b2 + kstep;
            unsigned v2[2][2];
#pragma unroll
            for (int _h = 0; _h < 2; ++_h)
#pragma unroll
                for (int _i = 0; _i < 2; ++_i) v2[_h][_i] = last ? vn[_h][_i] : vc[_h][_i];
            if constexpr (SP2) {
            PG8_LDB(B0, 0, 0); PG8_LDB(B1, 0, 1); PG8_SCHED; PG8_LDA(At, 0, 0); PG8_STAGE_A(PG8_SA(1, 1), cA, vc, 1, k1);
            PG8_WAIT_V(8); PG8_WAIT_L(0); PG8_BAR; PG8_MMA(0, 0, At, B0); PG8_MMA(0, 1, At, B1); PG8_BAR; PG8_SCHED;
            PG8_LDA(At, 0, 1); PG8_STAGE(PG8_SB(0, 0), b2, voffB); PG8_STAGE(PG8_SB(0, 1), b2 + hstep, voffB); PG8_STAGE_A(PG8_SA(0, 0), a2, v2, 0, k2);
            PG8_WAIT_V(8); PG8_WAIT_L(0); PG8_BAR; PG8_MMA(1, 0, At, B0); PG8_MMA(1, 1, At, B1); PG8_BAR; PG8_SCHED;
            PG8_LDB(B0, 1, 0); PG8_LDB(B1, 1, 1); PG8_SCHED; PG8_LDA(At, 1, 0); PG8_STAGE_A(PG8_SA(0, 1), a2, v2, 1, k2);
            PG8_WAIT_V(8); PG8_WAIT_L(0); PG8_BAR; PG8_MMA(0, 0, At, B0); PG8_MMA(0, 1, At, B1); PG8_BAR; PG8_SCHED;
            PG8_LDA(At, 1, 1); PG8_STAGE(PG8_SB(1, 0), b3, voffB); PG8_STAGE(PG8_SB(1, 1), b3 + hstep, voffB); PG8_STAGE_A(PG8_SA(1, 0), a2, v2, 0, k3);
            PG8_WAIT_V(8); PG8_WAIT_L(0); PG8_BAR; PG8_MMA(1, 0, At, B0); PG8_MMA(1, 1, At, B1); PG8_BAR; PG8_SCHED;
            } else {
            PG8_LDB(B0, 0, 0); PG8_SCHED; PG8_LDA(At, 0, 0); PG8_STAGE_A(PG8_SA(1, 1), cA, vc, 1, k1);
            PG8_WAIT_L(8); PG8_BAR; PG8_WAIT_L(0); PG8_MMA(0, 0, At, B0); PG8_BAR; PG8_SCHED;
            PG8_LDB(B1, 0, 1); PG8_STAGE(PG8_SB(0, 0), b2, voffB);
            PG8_BAR; PG8_WAIT_L(0); PG8_MMA(0, 1, At, B1); PG8_BAR;
            PG8_LDA(At, 0, 1); PG8_STAGE_A(PG8_SA(0, 0), a2, v2, 0, k2);
            PG8_BAR; PG8_WAIT_L(0); PG8_MMA(1, 0, At, B0); PG8_BAR; PG8_SCHED;
            PG8_STAGE(PG8_SB(0, 1), b2 + hstep, voffB);
            PG8_WAIT_V(6); PG8_BAR; PG8_MMA(1, 1, At, B1); PG8_BAR;
            PG8_LDB(B0, 1, 0); PG8_SCHED; PG8_LDA(At, 1, 0); PG8_STAGE_A(PG8_SA(0, 1), a2, v2, 1, k2);
            PG8_WAIT_L(8); PG8_BAR; PG8_WAIT_L(0); PG8_MMA(0, 0, At, B0); PG8_BAR; PG8_SCHED;
            PG8_LDB(B1, 1, 1); PG8_STAGE(PG8_SB(1, 0), b3, voffB);
            PG8_BAR; PG8_WAIT_L(0); PG8_MMA(0, 1, At, B1); PG8_BAR;
            PG8_LDA(At, 1, 1); PG8_STAGE_A(PG8_SA(1, 0), a2, v2, 0, k3);
            PG8_BAR; PG8_WAIT_L(0); PG8_MMA(1, 0, At, B0); PG8_BAR; PG8_SCHED;
            PG8_STAGE(PG8_SB(1, 1), b3 + hstep, voffB);
            PG8_WAIT_V(6); PG8_BAR; PG8_MMA(1, 1, At, B1); PG8_BAR;
            }
        }
        if constexpr (ALIGN_EPI) { if (wr == 0) PG8_BAR; }
        {
#pragma unroll
            for (int ai = 0; ai < 2; ++ai)
#pragma unroll
                for (int m = 0; m < 4; ++m) { const int r = ai * HALF + wr * 64 + m * 16 + fr;
                    if (r < cur.nrows) { float v0[8], v1[8];
#pragma unroll
                        for (int i = 0; i < 4; ++i) { v0[i] = acc[ai][0][m][0][i]; v0[4 + i] = acc[ai][0][m][1][i]; v1[i] = acc[ai][1][m][0][i]; v1[4 + i] = acc[ai][1][m][1][i]; }
                        E.store(cur, r, wc * 32 + 8 * fq, v0, v1); }
                    if (Epi::FENCE && (m & 1)) asm volatile("" ::: "memory"); }
        }
        if (!has_next) break;
#pragma unroll
        for (int a = 0; a < 2; ++a)
#pragma unroll
            for (int b = 0; b < 2; ++b)
#pragma unroll
                for (int m = 0; m < 4; ++m)
#pragma unroll
                    for (int n = 0; n < 2; ++n) acc[a][b][m][n] = (f32x4){0.f, 0.f, 0.f, 0.f};
        cur = nxt; cA = nA; cB = nB; ++ui;
        if (GATHER) {
#pragma unroll
            for (int _h = 0; _h < 2; ++_h)
#pragma unroll
                for (int _i = 0; _i < 2; ++_i) vc[_h][_i] = vn[_h][_i]; }
        if constexpr (ALIGN_EPI) { if (wr == 1) PG8_BAR; }
    }
    PG8_WAIT_V(0);
    if constexpr (!ALIGN_EPI) { if (wr == 0) PG8_BAR; }
    PG8_BAR;
#undef PG8_SA
#undef PG8_SB
#undef PG8_STAGE
#undef PG8_STAGE_A
#undef PG8_LDA
#undef PG8_LDB
#undef PG8_MMA
#undef PG8_WAIT_V
#undef PG8_WAIT_L
#undef PG8_BAR
#undef PG8_SCHED
#undef PG8_ROWOFFS
}
}

struct EpiInProj { static constexpr bool FENCE = false;
    bf16 *upool, *qkv, *z, *gp, *gd; float* ba;
    __device__ __forceinline__ void store(const Unit& u, int r, int cit, const float* v0, const float* v1) const {
        const size_t row = (size_t)(u.arow0 + r); const int pn = u.pn;
        if (pn < 4) { bf16* p = upool + row * D_POOL + pn * 256 + cit; store8bf(p, v0); store8bf(p + 128, v1); }
        else if (pn < 16) { bf16* p = qkv + row * D_QKV + (pn - 4) * 256 + cit; store8bf(p, v0); store8bf(p + 128, v1); }
        else if (pn < 20) { float a[8], b[8];
#pragma unroll
            for (int i = 0; i < 8; ++i) { a[i] = siluf_(v0[i]); b[i] = siluf_(v1[i]); }
            bf16* p = z + row * D_Z + (pn - 16) * 256 + cit; store8bf(p, a); store8bf(p + 128, b); }
        else if (pn < 36) { float a[8], b[8];
#pragma unroll
            for (int i = 0; i < 8; ++i) { a[i] = sigmoidf_(v0[i]); b[i] = sigmoidf_(v1[i]); }
            bf16* p = (pn < 28 ? gp + row * D + (pn - 20) * 256 : gd + row * D + (pn - 28) * 256) + cit; store8bf(p, a); store8bf(p + 128, b); }
    }
};
struct EpiPool { static constexpr bool FENCE = false;
    const bf16* gp; bf16* mp;
    __device__ __forceinline__ void store(const Unit& u, int r, int cit, const float* v0, const float* v1) const {
        const size_t off = (size_t)(u.arow0 + r) * D + u.pn * 256 + cit; float g0[8], g1[8], a[8], b[8]; load8bf(gp + off, g0); load8bf(gp + off + 128, g1);
#pragma unroll
        for (int i = 0; i < 8; ++i) { a[i] = g0[i] * v0[i]; b[i] = g1[i] * v1[i]; }
        store8bf(mp + off, a); store8bf(mp + off + 128, b);
    }
};
struct EpiMerge { static constexpr bool FENCE = false;
    const bf16* gd; const bf16* mp; bf16* mg;
    __device__ __forceinline__ void store(const Unit& u, int r, int cit, const float* v0, const float* v1) const {
        const size_t off = (size_t)(u.arow0 + r) * D + u.pn * 256 + cit; float g0[8], g1[8], m0[8], m1[8]; load8bf(gd + off, g0); load8bf(gd + off + 128, g1); load8bf(mp + off, m0); load8bf(mp + off + 128, m1);
#pragma unroll
        for (int i = 0; i < 8; ++i) { m0[i] += g0[i] * v0[i]; m1[i] += g1[i] * v1[i]; }
        store8bf(mg + off, m0); store8bf(mg + off + 128, m1);
    }
};
struct EpiResid { static constexpr bool FENCE = false;
    const float* x; float* h;
    __device__ __forceinline__ void store(const Unit& u, int r, int cit, const float* v0, const float* v1) const {
        const size_t off = (size_t)(u.arow0 + r) * D + u.pn * 256 + cit;
#pragma unroll
        for (int q = 0; q < 2; ++q) { const f32x4 a = *(const f32x4*)(x + off + 4 * q), b = *(const f32x4*)(x + off + 128 + 4 * q);
            *(f32x4*)(h + off + 4 * q) = (f32x4){a[0] + v0[4 * q], a[1] + v0[4 * q + 1], a[2] + v0[4 * q + 2], a[3] + v0[4 * q + 3]};
            *(f32x4*)(h + off + 128 + 4 * q) = (f32x4){b[0] + v1[4 * q], b[1] + v1[4 * q + 1], b[2] + v1[4 * q + 2], b[3] + v1[4 * q + 3]}; }
    }
};
struct EpiMoe1 { static constexpr bool FENCE = false;
    bf16* hmid;
    __device__ __forceinline__ void store(const Unit& u, int r, int cit, const float* v0, const float* v1) const {
        float a[8];
#pragma unroll
        for (int i = 0; i < 8; ++i) a[i] = siluf_(v0[i]) * v1[i];
        store8bf(hmid + (size_t)(u.arow0 + r) * DE + u.pn * 128 + cit, a);
    }
};
struct EpiMoe2 { static constexpr bool FENCE = true;
    const int* ltk; const float* lw; bf16 *y0, *y1;
    __device__ __forceinline__ void store(const Unit& u, int r, int cit, const float* v0, const float* v1) const {
        const size_t li = (size_t)u.e * T + u.lrow0 + r; const int tk = ltk[li]; const float w = lw[li];
        bf16* y = ((tk & 1) ? y1 : y0) + (size_t)(tk >> 1) * D + u.pn * 256 + cit; float a[8], b[8];
#pragma unroll
        for (int i = 0; i < 8; ++i) { a[i] = w * v0[i]; b[i] = w * v1[i]; }
        store8bf(y, a); store8bf(y + 128, b);
    }
};
struct EpiBf16Plain { static constexpr bool FENCE = false;
    bf16* o;
    __device__ __forceinline__ void store(const Unit& u, int r, int cit, const float* v0, const float* v1) const {
        bf16* p = o + (size_t)(u.arow0 + r) * D + u.pn * 256 + cit; store8bf(p, v0); store8bf(p + 128, v1);
    }
};
struct EpiPle { static constexpr bool FENCE = false;
    const bf16* pp; float* h;
    __device__ __forceinline__ void store(const Unit& u, int r, int cit, const float* v0, const float* v1) const {
        const size_t off = (size_t)(u.arow0 + r) * D + u.pn * 256 + cit; float p0[8], p1[8]; load8bf(pp + off, p0); load8bf(pp + off + 128, p1);
#pragma unroll
        for (int q = 0; q < 2; ++q) { const f32x4 a = *(const f32x4*)(h + off + 4 * q), b = *(const f32x4*)(h + off + 128 + 4 * q); f32x4 oa, ob;
#pragma unroll
            for (int i = 0; i < 4; ++i) { oa[i] = a[i] + sigmoidf_(v0[4 * q + i]) * p0[4 * q + i]; ob[i] = b[i] + sigmoidf_(v1[4 * q + i]) * p1[4 * q + i]; }
            *(f32x4*)(h + off + 4 * q) = oa; *(f32x4*)(h + off + 128 + 4 * q) = ob; }
    }
};

__device__ __forceinline__ void transpose_item(const float* W, int ldw, int K, int k0, int c0, int nvalid, bf16* WT, int r0, LAS float* scr, int lane) {
    (void)scr;
    const int kb = lane >> 3, nb = lane & 7; const bool ok = 4 * nb < nvalid;
    const float* src = W + (size_t)(k0 + 8 * kb) * ldw + c0 + 4 * nb;
    f32x4 v[8];
#pragma unroll
    for (int i = 0; i < 8; ++i) v[i] = ok ? *(const f32x4*)(src + (size_t)i * ldw) : (f32x4){0.f, 0.f, 0.f, 0.f};
    bf16* dst = WT + (size_t)(r0 + 4 * nb) * K + k0 + 8 * kb;
#pragma unroll
    for (int e = 0; e < 4; ++e) { v4u o; o.x = pk2(v[0][e], v[1][e]); o.y = pk2(v[2][e], v[3][e]); o.z = pk2(v[4][e], v[5][e]); o.w = pk2(v[6][e], v[7][e]); *(v4u*)(dst + (size_t)e * K) = o; }
}
__device__ __forceinline__ void transpose_job(const float* W, int K, int N, bf16* WT, LAS float* scr, int gw, int NGW, int lane) {
    const int nblk = N / 32, items = (K / 64) * nblk;
    for (int it = gw; it < items; it += NGW) { const int kb = it / nblk, nb = it % nblk; transpose_item(W, N, K, 64 * kb, 32 * nb, 32, WT, 32 * nb, scr, lane); }
}
__device__ __forceinline__ void rms_row_bf16(const float* xrow, const float* gain, bf16* orow, int lane) {
    const f32x4* xr = (const f32x4*)xrow + lane; const f32x4* gr = (const f32x4*)gain + lane;
    f32x4 v[8]; float s = 0.f;
#pragma unroll
    for (int j = 0; j < 8; ++j) { v[j] = xr[64 * j]; s += (v[j].x * v[j].x + v[j].y * v[j].y) + (v[j].z * v[j].z + v[j].w * v[j].w); }
    const float rstd = 1.0f / sqrtf(wave_sum(s) * (1.f / D) + EPS);
    v2u* o8 = (v2u*)orow + lane;
#pragma unroll
    for (int j = 0; j < 8; ++j) { const f32x4 g = gr[64 * j]; v2u o; o.x = pk2(v[j].x * rstd * g.x, v[j].y * rstd * g.y); o.y = pk2(v[j].z * rstd * g.z, v[j].w * rstd * g.w); o8[64 * j] = o; }
}


__device__ __forceinline__ void route_row(Frame& F, const LAS float* lgp, float rs, int t, LAS unsigned* lcnt, LAS int* ent, int ei) {
    float gl[4];
#pragma unroll
    for (int o = 0; o < 4; ++o) gl[o] = lgp[o] * rs + F.in[I_B_RG][o];
    int gi = 0; float gm = gl[0];
#pragma unroll
    for (int o = 1; o < 4; ++o) if (gl[o] > gm) { gm = gl[o]; gi = o; }
    float den = 0.f;
#pragma unroll
    for (int o = 0; o < 4; ++o) den += __expf(gl[o] - gm);
    const float psel = 1.0f / den;
    float le[8];
#pragma unroll
    for (int q = 0; q < 8; ++q) le[q] = lgp[4 + 8 * gi + q] * rs + F.in[I_B_RE][gi * 8 + q];
    int i0 = 0; float v0 = le[0];
#pragma unroll
    for (int q = 1; q < 8; ++q) if (le[q] > v0) { v0 = le[q]; i0 = q; }
    int i1 = -1; float v1 = -3.0e38f;
#pragma unroll
    for (int q = 0; q < 8; ++q) if (q != i0 && le[q] > v1) { v1 = le[q]; i1 = q; }
    const float e1 = __expf(v1 - v0); const float w0 = psel / (1.0f + e1), w1 = psel * e1 / (1.0f + e1);
    const int ea = gi * 8 + i0, ebx = gi * 8 + i1;
    const unsigned sa = atomicAdd((unsigned*)(lcnt + ea), 1u), sb = atomicAdd((unsigned*)(lcnt + ebx), 1u);
    ent[4 * ei + 0] = (ea << 16) | (int)sa; ent[4 * ei + 1] = 2 * t; ent[4 * ei + 2] = __float_as_int(w0); ent[4 * ei + 3] = 0;
    ent[4 * (ei + 1) + 0] = (ebx << 16) | (int)sb; ent[4 * (ei + 1) + 1] = 2 * t + 1; ent[4 * (ei + 1) + 2] = __float_as_int(w1); ent[4 * (ei + 1) + 3] = 0;
}

enum { PH_PRO = 0, PH_INPROJ, PH_TOKLOC, PH_DNA, PH_DN, PH_YDN, PH_MERGE, PH_OUT, PH_ROUTE, PH_MOE1, PH_MOE2, PH_N3, PH_PP, PH_PLE, PH_FINAL, NPHASE };
struct Args { const float* in[25]; float* out; unsigned char* ws; int ph_lo, ph_hi, flags, pad; };
__global__ void __launch_bounds__(NTHR, 2) fwd(Args args) {
    extern __shared__ __attribute__((aligned(16))) unsigned char lds_raw[];
    Frame F;
    F.lds = (LAS unsigned char*)lds_raw; F.MISC = (volatile LAS unsigned*)(F.lds + MISC_OFF);
    F.tid = threadIdx.x; F.lane = F.tid & 63; F.wave = __builtin_amdgcn_readfirstlane(F.tid >> 6);
    F.G = gridDim.x; { const int bx = blockIdx.x; F.vcu = (F.G % 8 == 0) ? (bx % 8) * (F.G / 8) + bx / 8 : bx; }
    F.ws = args.ws; F.ctl = (unsigned*)(args.ws + WS_CTL); F.out = args.out;
#pragma unroll
    for (int i = 0; i < 25; ++i) F.in[i] = args.in[i];
    for (int u = F.tid; u < MISC_WORDS; u += NTHR) F.MISC[u] = 0u;
    __syncthreads();
    XcdBarrier bar; bar.bar = F.ctl + CW_BAR; bar.x = 0; bar.st = nullptr;
    if (MK_N_LAUNCHES == 1) bar = xcd_barrier_post(F.ctl + CW_BAR, F.MISC + 8);
    const int lo = args.ph_lo, hi = args.ph_hi;
#define IN(k) (lo <= (k) && (k) < hi)
#define SEAM(k) do { if (MK_N_LAUNCHES == 1 && IN(k) && IN((k) + 1)) xcd_barrier(bar); } while (0)
    unsigned char* ws = F.ws;
    bf16* WIN = (bf16*)(ws + WS_WIN); bf16* WCOMB = (bf16*)(ws + WS_WCOMB); bf16* WUPDN = (bf16*)(ws + WS_WUPDN); bf16* WOUT = (bf16*)(ws + WS_WOUT);
    bf16* WPLEG = (bf16*)(ws + WS_WPLEG); bf16* WPLEP = (bf16*)(ws + WS_WPLEP); bf16* WGU = (bf16*)(ws + WS_WGU); bf16* WDN = (bf16*)(ws + WS_WDN);
    float* BA = (float*)(ws + WS_BA); float* GG = (float*)(ws + WS_G); float* BETA = (float*)(ws + WS_BETA);
    int* LTK = (int*)(ws + WS_LTK); float* LW = (float*)(ws + WS_LW); bf16* PBF = (bf16*)(ws + WS_PBF);
    bf16* WRH = (bf16*)(ws + WS_WRT); bf16* WRL = WRH + 48 * D;
    unsigned char* PKG = ws + WS_PKG; bf16* UT = (bf16*)(ws + WS_UT); bf16* OB = (bf16*)(ws + WS_OB);
    bf16* N1 = (bf16*)(ws + WS_N1); bf16* QKV = (bf16*)(ws + WS_QKV); float* OBUF = (float*)(ws + WS_QKV); bf16* PP = (bf16*)(ws + WS_QKV);
    bf16* MP = (bf16*)((unsigned char*)F.out + OUT_QKV2); bf16* MERGED = (bf16*)(ws + WS_QKV);     bf16* UPOOL = (bf16*)(ws + WS_UPOOL); bf16* ZS = (bf16*)(ws + WS_Z); bf16* HMID = (bf16*)(ws + WS_Z);
    bf16* GP = (bf16*)(ws + WS_GP); bf16* GD = (bf16*)(ws + WS_GD); bf16* Y0 = GP; bf16* Y1 = GD;
    bf16* DBUF = (bf16*)((unsigned char*)F.out + OUT_D); bf16* QKV2 = (bf16*)((unsigned char*)F.out + OUT_QKV2); float* H = F.out;
    const int gw = F.vcu * NWAVES + F.wave, NGW = F.G * NWAVES, lane = F.lane;

    if (IN(PH_PRO)) {
        LAS float* scr = (LAS float*)(F.lds + RING_OFF + F.wave * 16384);
        {
            const int nblk = N_IN_PAD / 32, items = (D / 64) * nblk;
            for (int it = gw; it < items; it += NGW) { const int kb = it / nblk, nb = it % nblk, r0 = 32 * nb; int c0, nv;
                if (r0 < 5120) { c0 = r0; nv = 32; } else { c0 = r0 + 16; nv = 32; }
                transpose_item(F.in[I_W_IN], D_IN, D, 64 * kb, c0, nv, WIN, r0, scr, lane); }
        }
        transpose_job(F.in[I_W_UP_DN], D_Z, D, WUPDN, scr, gw, NGW, lane);
        transpose_job(F.in[I_W_OUT], D, D, WOUT, scr, gw, NGW, lane);
        transpose_job(F.in[I_W_PLE_GATE], D, D, WPLEG, scr, gw, NGW, lane);
        transpose_job(F.in[I_W_PLE_PROJ], D_PLE, D, WPLEP, scr, gw, NGW, lane);
        {
            const float* pw = F.in[I_POOL_W]; const float* ps = F.in[I_POOL_SCALE]; const float* wu = F.in[I_W_UP_POOL];
            const int items = (D_POOL / 8) * (D / 64);
            for (int it = gw; it < items; it += NGW) { const int kg = it / (D / 64), nb = it % (D / 64), k0 = 8 * kg, g = k0 >> 8, kk0 = k0 & 255, n = 64 * nb + lane;
                float acc[8];
#pragma unroll
                for (int i = 0; i < 8; ++i) acc[i] = 0.f;
                for (int j = 0; j < POOL_GW; ++j) { const float wv = wu[(size_t)(256 * g + j) * D + n] * ps[256 * g + j];
#pragma unroll
                    for (int i = 0; i < 8; ++i) acc[i] += pw[(size_t)g * POOL_GW * POOL_GW + (size_t)(kk0 + i) * POOL_GW + j] * wv; }
                store8bf(WCOMB + (size_t)n * D_POOL + k0, acc); }
        }
        {
            const float* gm = F.in[I_NORM_MOE]; const float* wrg = F.in[I_W_RG]; const float* wre = F.in[I_W_RE];
            for (int idx = gw * 64 + lane; idx < 48 * D; idx += NGW * 64) { const int n = idx / D, k = idx % D;
                const float v = n < 4 ? gm[k] * wrg[(size_t)k * NGRP + n] : (n < 36 ? gm[k] * wre[(size_t)k * NE + (n - 4)] : 0.f);
                const unsigned hi = f2bf(v); WRH[idx] = (bf16)hi; WRL[idx] = (bf16)f2bf(v - __uint_as_float(hi << 16)); }
        }
        {
            const float* gain = F.in[I_NORM_MIX]; const float* win = F.in[I_W_IN];
            __syncthreads();
            LAS float* LGp = (LAS float*)(F.lds + RING_OFF);
            LAS float* SSp = LGp + 8 * 256;
            LAS float* RS = SSp + 128;
            const int row = lane & 15, g = lane >> 4, wv = F.wave;
            bf16x8 wbh[8], wbl[8];
#pragma unroll
            for (int J = 0; J < 8; ++J) { unsigned hh[4], ll[4];
#pragma unroll
                for (int q = 0; q < 4; ++q) { const int k = 256 * wv + 32 * J + 8 * g + 2 * q; const float v0 = gain[k] * win[(size_t)k * D_IN + 5120 + row], v1 = gain[k + 1] * win[(size_t)(k + 1) * D_IN + 5120 + row];
                    hh[q] = pk2(v0, v1); ll[q] = pk2(v0 - bflo(hh[q]), v1 - bfhi(hh[q])); }
                wbh[J] = __builtin_bit_cast(bf16x8, (v4u){hh[0], hh[1], hh[2], hh[3]}); wbl[J] = __builtin_bit_cast(bf16x8, (v4u){ll[0], ll[1], ll[2], ll[3]}); }
            for (int task = F.vcu; task < T / 16; task += F.G) {
                const int r0 = task * 16; const float* hp_ = F.in[I_X] + (size_t)(r0 + row) * D + 256 * wv + 8 * g;
                f32x4 a[8][2];
#pragma unroll
                for (int J = 0; J < 8; ++J) { a[J][0] = *(const f32x4*)(hp_ + 32 * J); a[J][1] = *(const f32x4*)(hp_ + 32 * J + 4); }
                f32x4 acc = (f32x4){0.f, 0.f, 0.f, 0.f}; float ss = 0.f;
#pragma unroll
                for (int J = 0; J < 8; ++J) { const f32x4 x0 = a[J][0], x1 = a[J][1];
                    ss += ((x0.x * x0.x + x0.y * x0.y) + (x0.z * x0.z + x0.w * x0.w)) + ((x1.x * x1.x + x1.y * x1.y) + (x1.z * x1.z + x1.w * x1.w));
                    const unsigned h0 = pk2(x0.x, x0.y), h1 = pk2(x0.z, x0.w), h2_ = pk2(x1.x, x1.y), h3 = pk2(x1.z, x1.w);
                    const unsigned l0 = pk2(x0.x - bflo(h0), x0.y - bfhi(h0)), l1 = pk2(x0.z - bflo(h1), x0.w - bfhi(h1)), l2 = pk2(x1.x - bflo(h2_), x1.y - bfhi(h2_)), l3 = pk2(x1.z - bflo(h3), x1.w - bfhi(h3));
                    const bf16x8 ah = __builtin_bit_cast(bf16x8, (v4u){h0, h1, h2_, h3}), al = __builtin_bit_cast(bf16x8, (v4u){l0, l1, l2, l3});
                    acc = __builtin_amdgcn_mfma_f32_16x16x32_bf16(ah, wbh[J], acc, 0, 0, 0); acc = __builtin_amdgcn_mfma_f32_16x16x32_bf16(al, wbh[J], acc, 0, 0, 0); acc = __builtin_amdgcn_mfma_f32_16x16x32_bf16(ah, wbl[J], acc, 0, 0, 0); }
                ss += __shfl_xor(ss, 16); ss += __shfl_xor(ss, 32);
                __syncthreads();
#pragma unroll
                for (int reg = 0; reg < 4; ++reg) LGp[wv * 256 + (4 * g + reg) * 16 + row] = acc[reg];
                if (g == 0) SSp[wv * 16 + row] = ss;
                __syncthreads();
                if (F.tid < 16) { float s8 = 0.f;
#pragma unroll
                    for (int w8 = 0; w8 < 8; ++w8) s8 += SSp[w8 * 16 + F.tid];
                    RS[F.tid] = 1.0f / sqrtf(s8 * (1.f / D) + EPS); }
                __syncthreads();
                if (F.tid < 256) { float s8 = 0.f;
#pragma unroll
                    for (int w8 = 0; w8 < 8; ++w8) s8 += LGp[w8 * 256 + F.tid];
                    BA[(size_t)(r0 + (F.tid >> 4)) * 16 + (F.tid & 15)] = s8 * RS[F.tid >> 4]; }
                {   const float rs = RS[row]; bf16* op = N1 + (size_t)(r0 + row) * D + 256 * wv + 8 * g; const float* gp = gain + 256 * wv + 8 * g;
#pragma unroll
                    for (int J = 0; J < 8; ++J) { const f32x4 g0 = *(const f32x4*)(gp + 32 * J), g1 = *(const f32x4*)(gp + 32 * J + 4); const f32x4 x0 = a[J][0], x1 = a[J][1];
                        v4u o; o.x = pk2(x0.x * rs * g0.x, x0.y * rs * g0.y); o.y = pk2(x0.z * rs * g0.z, x0.w * rs * g0.w); o.z = pk2(x1.x * rs * g1.x, x1.y * rs * g1.y); o.w = pk2(x1.z * rs * g1.z, x1.w * rs * g1.w);
                        *(v4u*)(op + 32 * J) = o; }
                }
            }
            __syncthreads();
        }
        for (int m = gw; m < T; m += NGW) { const f32x4 v = *((const f32x4*)(F.in[I_P] + (size_t)m * D_PLE) + lane); v2u o; o.x = pk2(v.x, v.y); o.y = pk2(v.z, v.w); *((v2u*)(PBF + (size_t)m * D_PLE) + lane) = o; }
    }
    SEAM(PH_PRO);
    if (IN(PH_INPROJ)) {
        pg8::DenseOrder S; S.init(T, N_IN_PAD, D, F.G, (int)blockIdx.x);
        EpiInProj E{UPOOL, QKV, ZS, GP, GD, BA};
        pg8::gemm_phase<EpiInProj, pg8::DenseOrder, false>(F.lds + RING_OFF, N1, WIN, D, S, E);
    }
    SEAM(PH_INPROJ);
    if (IN(PH_TOKLOC)) {
        const float* cw = F.in[I_CONV_W];
        LAS float* red = (LAS float*)(F.lds + RING_OFF + F.wave * 4608);
        LAS float* SC = red + 1024;
        for (int item = gw; item < 2048 * 12; item += NGW) {
            const int run = item / 12, blk = item % 12, t0 = run * 16, s0 = t0 % SEQ, c = blk * 256 + 4 * lane;
            v2u u[19];
#pragma unroll
            for (int i = 0; i < 19; ++i) { u[i] = (s0 - 3 + i >= 0) ? *(const v2u*)(QKV + (size_t)(t0 - 3 + i) * D_QKV + c) : (v2u){0u, 0u}; }
            f32x4 w[4];
#pragma unroll
            for (int kk = 0; kk < 4; ++kk) w[kk] = *(const f32x4*)(cw + kk * D_QKV + c);
            f32x4 y[16];
#pragma unroll
            for (int tt = 0; tt < 16; ++tt) { f32x4 a = (f32x4){0.f, 0.f, 0.f, 0.f};
#pragma unroll
                for (int kk = 0; kk < 4; ++kk) { const v2u x = u[tt + kk]; a.x += bflo(x.x) * w[kk].x; a.y += bfhi(x.x) * w[kk].y; a.z += bflo(x.y) * w[kk].z; a.w += bfhi(x.y) * w[kk].w; }
                a.x = siluf_(a.x); a.y = siluf_(a.y); a.z = siluf_(a.z); a.w = siluf_(a.w); y[tt] = a; }
            if (blk < 8) {
#pragma unroll
                for (int tt = 0; tt < 16; ++tt) red[tt * 64 + lane] = (y[tt].x * y[tt].x + y[tt].y * y[tt].y) + (y[tt].z * y[tt].z + y[tt].w * y[tt].w);
                asm volatile("s_waitcnt lgkmcnt(0)" ::: "memory");
                {   const int tt = lane & 15, hd = (lane >> 4) & 1, part = lane >> 5; float sm = 0.f;
#pragma unroll
                    for (int i = 0; i < 16; ++i) sm += red[tt * 64 + hd * 32 + part * 16 + ((i + lane) & 15)];
                    sm += __shfl_xor(sm, 32);
                    float rr = 1.0f / sqrtf(sm + EPS); if (blk < 4) rr *= 0.08838834764831845f;
                    if (part == 0) SC[hd * 16 + tt] = rr; }
                asm volatile("s_waitcnt lgkmcnt(0)" ::: "memory");
#pragma unroll
                for (int q4 = 0; q4 < 4; ++q4) { const f32x4 sc = *(const LAS f32x4*)(SC + (lane >> 5) * 16 + 4 * q4);
#pragma unroll
                    for (int i = 0; i < 4; ++i) y[4 * q4 + i] = y[4 * q4 + i] * sc[i]; }
                asm volatile("s_waitcnt lgkmcnt(0)" ::: "memory");
            }
#pragma unroll
            for (int tt = 0; tt < 16; ++tt) { v2u o; o.x = pk2(y[tt].x, y[tt].y); o.y = pk2(y[tt].z, y[tt].w); *(v2u*)(QKV2 + (size_t)(t0 + tt) * D_QKV + c) = o; }
        }
        for (int item = gw; item < 1024 * 4; item += NGW) {
            const int run = item >> 2, gi = item & 3, t0 = run * 32, s0 = t0 % SEQ, c = gi * 256 + 4 * lane;
#define POOL_BODY(W) { v2u u[31 + W]; \
                _Pragma("unroll") for (int i = 0; i < 31 + W; ++i) u[i] = (s0 - (W - 1) + i >= 0) ? *(const v2u*)(UPOOL + (size_t)(t0 - (W - 1) + i) * D_POOL + c) : (v2u){0u, 0u}; \
                _Pragma("unroll") for (int tt = 0; tt < 32; ++tt) { f32x4 sm = (f32x4){0.f, 0.f, 0.f, 0.f}; \
                    _Pragma("unroll") for (int j = 0; j < W; ++j) { const v2u x = u[tt + j]; sm.x += bflo(x.x); sm.y += bfhi(x.x); sm.z += bflo(x.y); sm.w += bfhi(x.y); } \
                    const v2u xc = u[tt + W - 1]; const float inv = 1.0f / (float)((s0 + tt + 1) < W ? (s0 + tt + 1) : W); \
                    v2u o; o.x = pk2(sm.x * inv - bflo(xc.x), sm.y * inv - bfhi(xc.x)); o.y = pk2(sm.z * inv - bflo(xc.y), sm.w * inv - bfhi(xc.y)); \
                    *(v2u*)(DBUF + (size_t)(t0 + tt) * D_POOL + c) = o; } }
            if (gi == 0) POOL_BODY(2) else if (gi == 1) POOL_BODY(4) else if (gi == 2) POOL_BODY(8) else POOL_BODY(16)
#undef POOL_BODY
        }
        for (int idx = gw * 64 + lane; idx < T * NH; idx += NGW * 64) { const int t = idx >> 3, hh = idx & 7; const float bl = BA[(size_t)t * 16 + hh], al = BA[(size_t)t * 16 + 8 + hh]; const float xx = al + F.in[I_DT_BIAS][hh];
            const float sp = xx > 20.f ? xx : log1pf(__expf(xx)); GG[idx] = -__expf(F.in[I_A_LOG][hh]) * sp; BETA[idx] = sigmoidf_(bl); }
    }
    SEAM(PH_TOKLOC);
    if (IN(PH_DNA)) {
        const int hb = F.tid >> 8, t4 = F.tid & 255, wq = t4 >> 6;
        LAS unsigned char* hl = F.lds + RING_OFF + hb * 62464;
        LAS bf16* Ks = (LAS bf16*)hl;
        LAS bf16* Qs = Ks + 64 * 136;
        LAS float* Ls = (LAS float*)(hl + 2 * 17408);
        LAS float* gs = (LAS float*)(hl + 3 * 17408);
        LAS bf16* IMG = (LAS bf16*)(hl + 3 * 17408 + 2048);
        LAS bf16* UWI = Qs;
        for (int up = F.vcu; up < DN_UNITS / 2; up += F.G) {
            const int unit = up * 2 + hb, bh = unit >> 7, cch = unit & 127, b = bh >> 3, h = bh & 7; const size_t tok0 = (size_t)b * SEQ + (size_t)cch * 64;
            unsigned char* pk = PKG + (size_t)unit * PKG_BYTES; bf16* pW = (bf16*)pk; bf16* pQ = (bf16*)(pk + 16384); bf16* pA = (bf16*)(pk + 32768); bf16* pKT = (bf16*)(pk + 40960); float* pS = (float*)(pk + 57344);
            bf16* pU = UT + (size_t)unit * 8192;
            __syncthreads();
            if (t4 < 64) { gs[t4] = GG[(tok0 + t4) * NH + h]; gs[64 + t4] = BETA[(tok0 + t4) * NH + h]; }
#pragma unroll
            for (int i = 0; i < 4; ++i) { const int idx = t4 + 256 * i, row = idx >> 4, ch = idx & 15;
                *(LAS v4u*)(Ks + row * 136 + ch * 8) = *(const v4u*)(QKV2 + (tok0 + row) * D_QKV + 1024 + h * 128 + ch * 8);
                *(LAS v4u*)(Qs + row * 136 + ch * 8) = *(const v4u*)(QKV2 + (tok0 + row) * D_QKV + h * 128 + ch * 8); }
            __syncthreads();
            if (t4 < 64) {
                float a = gs[t4];
#pragma unroll
                for (int o = 1; o < 64; o <<= 1) { const float tv = __shfl_up(a, o); if (lane >= o) a += tv; }
                gs[128 + t4] = a; }
            __syncthreads();
            if (t4 < 64) { const float gl = gs[128 + 63], gc = gs[128 + t4]; gs[192 + t4] = __expf(gc); gs[256 + t4] = __expf(gl - gc); }
            {
                const int c = lane & 15, gq = lane >> 4;
                f32x4 kk[4], qk[4];
#pragma unroll
                for (int jb = 0; jb < 4; ++jb) { kk[jb] = (f32x4){0.f, 0.f, 0.f, 0.f}; qk[jb] = (f32x4){0.f, 0.f, 0.f, 0.f}; }
#pragma unroll
                for (int ks = 0; ks < 4; ++ks) {
                    const bf16x8 aK = *(const LAS bf16x8*)(Ks + (16 * wq + c) * 136 + 32 * ks + 8 * gq), aQ = *(const LAS bf16x8*)(Qs + (16 * wq + c) * 136 + 32 * ks + 8 * gq);
#pragma unroll
                    for (int jb = 0; jb < 4; ++jb) { const bf16x8 bK = *(const LAS bf16x8*)(Ks + (16 * jb + c) * 136 + 32 * ks + 8 * gq);
                        kk[jb] = __builtin_amdgcn_mfma_f32_16x16x32_bf16(aK, bK, kk[jb], 0, 0, 0); qk[jb] = __builtin_amdgcn_mfma_f32_16x16x32_bf16(aQ, bK, qk[jb], 0, 0, 0); }
                }
#pragma unroll
                for (int reg = 0; reg < 4; ++reg) { const int row = 16 * wq + 4 * gq + reg; const float gi = gs[128 + row], bi = gs[64 + row];
#pragma unroll
                    for (int jb = 0; jb < 4; ++jb) { const int col = 16 * jb + c; const float dec = (row >= col) ? __expf(gi - gs[128 + col]) : 0.f;
                        Ls[row * 68 + col] = (row > col) ? -(bi * kk[jb][reg] * dec) : 0.f;
                        IMG[tix(row, col, 4)] = (bf16)f2bf(qk[jb][reg] * dec); } }
            }
#pragma unroll 1
            for (int it = 0; it < 8; ++it) { const int idx = t4 + 256 * it;
                { const int row = idx >> 5, k4 = (idx & 31) * 4; const v2u qv = *(const LAS v2u*)(Qs + row * 136 + k4); const float eg = __expf(gs[128 + row]);
                  v2u o; o.x = pk2(bflo(qv.x) * eg, bfhi(qv.x) * eg); o.y = pk2(bflo(qv.y) * eg, bfhi(qv.y) * eg); *(v2u*)(pQ + tix(row, k4, 8)) = o; }
                { const int dk = idx >> 4, i4 = (idx & 15) * 4; const float gl_ = gs[128 + 63];
                  const float k0 = bf2f(Ks[i4 * 136 + dk]) * __expf(gl_ - gs[128 + i4]), k1 = bf2f(Ks[(i4 + 1) * 136 + dk]) * __expf(gl_ - gs[128 + i4 + 1]);
                  const float k2 = bf2f(Ks[(i4 + 2) * 136 + dk]) * __expf(gl_ - gs[128 + i4 + 2]), k3 = bf2f(Ks[(i4 + 3) * 136 + dk]) * __expf(gl_ - gs[128 + i4 + 3]);
                  v2u o; o.x = pk2(k0, k1); o.y = pk2(k2, k3); *(v2u*)(pKT + tix(dk, i4, 4)) = o; } }
            if (t4 == 0) pS[128] = __expf(gs[128 + 63]);
            __syncthreads();
#pragma unroll
            for (int i = 0; i < 2; ++i) { const int idx = t4 + 256 * i; *(v4u*)(pA + idx * 8) = *(const LAS v4u*)(IMG + idx * 8); }
            float x[64];
            {
                if (t4 < 128) {
#pragma unroll
                    for (int i = 0; i < 64; ++i) x[i] = gs[64 + i] * bf2f(QKV2[(tok0 + i) * D_QKV + 2048 + h * 128 + t4]);
                } else {
#pragma unroll
                    for (int i = 0; i < 64; ++i) x[i] = gs[64 + i] * bf2f(Ks[i * 136 + (t4 - 128)]) * gs[192 + i];
                }
                SolveRows<60>::run(x, Ls, lane & 15);
            }
            __syncthreads();
            if (t4 < 128) { const int w = t4 >> 5, c = t4 & 31;
#pragma unroll
                for (int i = 0; i < 64; ++i) { const int rt = i >> 5, i32 = i & 31, hh = (i32 >> 2) & 1, reg = (i32 & 3) + 4 * (i32 >> 3); UWI[(((w * 2 + rt) * 64 + hh * 32 + c) << 4) + reg] = (bf16)f2bf(x[i]); }
            } else { const int dk = t4 - 128;
#pragma unroll
                for (int i = 0; i < 64; ++i) UWI[8192 + tix(i, dk, 8)] = (bf16)f2bf(-x[i]);
            }
            __syncthreads();
#pragma unroll
            for (int i = 0; i < 4; ++i) { const int idx = t4 + 256 * i; *(v4u*)(pU + idx * 8) = *(const LAS v4u*)(UWI + idx * 8); *(v4u*)(pW + idx * 8) = *(const LAS v4u*)(UWI + 8192 + idx * 8); }
        }
        __syncthreads();
    }
    SEAM(PH_DNA);
    if (IN(PH_DN)) {
        if ((int)blockIdx.x < NB * NH) { if (!(args.flags & 1)) {
            const int bh = (int)blockIdx.x, b = bh >> 3, hh = bh & 7; const size_t tokb = (size_t)b * SEQ;
            const unsigned char* pkg0 = PKG + (size_t)bh * 128 * PKG_BYTES; const bf16* ut0 = UT + (size_t)bh * 128 * 8192;
            const bool loader = F.wave >= 4; const int lt = F.tid - 256;
            if (loader) {
                v4u la[19], lb[19];
                constexpr int NCH = STG_BYTES / 16, NPK = PKG_BYTES / 16;
#define DN_LD(dst, pn) do { const int pn_ = (pn) < 127 ? (pn) : 127; const unsigned char* src_ = pkg0 + (size_t)pn_ * PKG_BYTES; const unsigned char* usrc_ = (const unsigned char*)(ut0 + (size_t)pn_ * 8192); _Pragma("unroll") for (int i = 0; i < 19; ++i) { int idx = lt + 256 * i; idx = idx < NCH ? idx : NCH - 1; \
        dst[i] = *(const v4u*)((idx < NPK) ? (src_ + (size_t)idx * 16) : (usrc_ + (size_t)(idx - NPK) * 16)); } } while (0)
#define DN_ST(srcr, stg) do { _Pragma("unroll") for (int i = 0; i < 19; ++i) { const int idx = lt + 256 * i; if (idx < NCH) *(LAS v4u*)(F.lds + RING_OFF + (stg) * STG_BYTES + idx * 16) = srcr[i]; } } while (0)
                DN_LD(la, 0); DN_ST(la, 0); DN_LD(la, 1); DN_LD(lb, 2);
                for (int n = 0; n < 128; n += 2) {
                    LDS_BARRIER();
                    DN_ST(la, 1); DN_LD(la, n + 3);
                    LDS_BARRIER();
                    DN_ST(lb, 0); DN_LD(lb, n + 4);
                }
#undef DN_LD
#undef DN_ST
            } else {
            const int w = F.wave & 3, r = lane & 31, h2 = lane >> 5;
            f32x16 S[4]; bf16x8 Sb[8];
#pragma unroll
            for (int d = 0; d < 4; ++d)
#pragma unroll
                for (int i = 0; i < 16; ++i) S[d][i] = 0.f;
#pragma unroll
            for (int s = 0; s < 8; ++s)
#pragma unroll
                for (int i = 0; i < 8; ++i) Sb[s][i] = 0;
            for (int n = 0; n < 128; ++n) {
                LDS_BARRIER();
                {
                    LAS unsigned char* st = F.lds + RING_OFF + (n & 1) * STG_BYTES;
                    const LAS float* sc = (const LAS float*)(st + 57344);
#define FRAG(off, f) (*(const LAS bf16x8*)(st + (off) + (f) * 1024 + lane * 16))
#define MF(a, b, c) __builtin_amdgcn_mfma_f32_32x32x16_bf16((a), (b), (c), 0, 0, 0)
#define SB() __builtin_amdgcn_sched_barrier(0)
                    f32x16 vn[2], qs[2];
#pragma unroll
                    for (int rt = 0; rt < 2; ++rt) {
#pragma unroll
                        for (int q = 0; q < 2; ++q) { const v4u u4 = *(const LAS v4u*)(st + PKG_BYTES + (((w * 2 + rt) * 64 + lane) << 5) + q * 16);
                            vn[rt][8 * q + 0] = bflo(u4.x); vn[rt][8 * q + 1] = bfhi(u4.x); vn[rt][8 * q + 2] = bflo(u4.y); vn[rt][8 * q + 3] = bfhi(u4.y);
                            vn[rt][8 * q + 4] = bflo(u4.z); vn[rt][8 * q + 5] = bfhi(u4.z); vn[rt][8 * q + 6] = bflo(u4.w); vn[rt][8 * q + 7] = bfhi(u4.w); }
#pragma unroll
                        for (int i = 0; i < 16; ++i) qs[rt][i] = 0.f; }
                    bf16x8 fa[4], fb[4];
                    fa[0] = FRAG(0, 0); fa[1] = FRAG(0, 8); fa[2] = FRAG(16384, 0); fa[3] = FRAG(16384, 8);
                    fb[0] = FRAG(0, 1); fb[1] = FRAG(0, 9); fb[2] = FRAG(16384, 1); fb[3] = FRAG(16384, 9);
                    SB();
#pragma unroll
                    for (int s = 0; s < 8; s += 2) {
                        vn[0] = MF(fa[0], Sb[s], vn[0]); vn[1] = MF(fa[1], Sb[s], vn[1]); qs[0] = MF(fa[2], Sb[s], qs[0]); qs[1] = MF(fa[3], Sb[s], qs[1]);
                        SB();
                        if (s + 2 < 8) { fa[0] = FRAG(0, s + 2); fa[1] = FRAG(0, 8 + s + 2); fa[2] = FRAG(16384, s + 2); fa[3] = FRAG(16384, 8 + s + 2); }
                        SB();
                        vn[0] = MF(fb[0], Sb[s + 1], vn[0]); vn[1] = MF(fb[1], Sb[s + 1], vn[1]); qs[0] = MF(fb[2], Sb[s + 1], qs[0]); qs[1] = MF(fb[3], Sb[s + 1], qs[1]);
                        SB();
                        if (s + 3 < 8) { fb[0] = FRAG(0, s + 3); fb[1] = FRAG(0, 8 + s + 3); fb[2] = FRAG(16384, s + 3); fb[3] = FRAG(16384, 8 + s + 3); }
                        SB();
                    }
                    bf16x8 ga[6], gb[6];
#define LD6(dst, sp) do { dst[0] = FRAG(32768, sp); dst[1] = FRAG(32768, 4 + (sp)); dst[2] = FRAG(40960, sp); dst[3] = FRAG(40960, 4 + (sp)); dst[4] = FRAG(40960, 8 + (sp)); dst[5] = FRAG(40960, 12 + (sp)); } while (0)
                    LD6(ga, 0); LD6(gb, 1);
                    const float egl = sc[128];
                    SB();
                    bf16x8 vb[4];
#pragma unroll
                    for (int sp = 0; sp < 4; ++sp) { const int rt = sp >> 1, base = 8 * (sp & 1); unsigned pv[4];
#pragma unroll
                        for (int jj = 0; jj < 4; ++jj) pv[jj] = pk2(vn[rt][base + 2 * jj], vn[rt][base + 2 * jj + 1]);
                        vb[sp] = __builtin_bit_cast(bf16x8, (v4u){pv[0], pv[1], pv[2], pv[3]}); }
#pragma unroll
                    for (int d = 0; d < 4; ++d)
#pragma unroll
                        for (int i = 0; i < 16; ++i) S[d][i] *= egl;
                    SB();
#pragma unroll
                    for (int sp = 0; sp < 4; sp += 2) {
                        qs[0] = MF(ga[0], vb[sp], qs[0]); qs[1] = MF(ga[1], vb[sp], qs[1]); S[0] = MF(ga[2], vb[sp], S[0]); S[1] = MF(ga[3], vb[sp], S[1]); S[2] = MF(ga[4], vb[sp], S[2]); S[3] = MF(ga[5], vb[sp], S[3]);
                        SB();
                        if (sp + 2 < 4) LD6(ga, sp + 2);
                        SB();
                        qs[0] = MF(gb[0], vb[sp + 1], qs[0]); qs[1] = MF(gb[1], vb[sp + 1], qs[1]); S[0] = MF(gb[2], vb[sp + 1], S[0]); S[1] = MF(gb[3], vb[sp + 1], S[1]); S[2] = MF(gb[4], vb[sp + 1], S[2]); S[3] = MF(gb[5], vb[sp + 1], S[3]);
                        SB();
                        if (sp + 3 < 4) LD6(gb, sp + 3);
                        SB();
                    }
#undef LD6
#undef FRAG
#undef MF
#undef SB
#pragma unroll
                    for (int s = 0; s < 8; ++s) { const int d = s >> 1, base = 8 * (s & 1); unsigned pv[4];
#pragma unroll
                        for (int jj = 0; jj < 4; ++jj) pv[jj] = pk2(S[d][base + 2 * jj], S[d][base + 2 * jj + 1]);
                        Sb[s] = __builtin_bit_cast(bf16x8, (v4u){pv[0], pv[1], pv[2], pv[3]}); }
                    {   bf16* ob = OB + (tokb + (size_t)n * 64) * D_Z + hh * 128 + 32 * w + r;
#pragma unroll
                        for (int rt = 0; rt < 2; ++rt)
#pragma unroll
                            for (int rp = 0; rp < 8; ++rp) { const int reg = 2 * rp, row = 32 * rt + (reg & 3) + 8 * (reg >> 2) + 4 * h2; const unsigned pv = pk2(qs[rt][reg], qs[rt][reg + 1]);
                                ob[(size_t)row * D_Z] = (bf16)(pv & 0xffffu); ob[(size_t)(row + 1) * D_Z] = (bf16)(pv >> 16); } }
                }
            }
            }
        } } else if (!(args.flags & 2)) {
            pg8::DenseOrder S; S.init(T, D, D_POOL, F.G - NB * NH, (int)blockIdx.x - NB * NH); EpiPool E{GP, MP};
            pg8::gemm_phase<EpiPool, pg8::DenseOrder, false>(F.lds + RING_OFF, DBUF, WCOMB, D_POOL, S, E);
            __syncthreads();
            LAS float* scr = (LAS float*)(F.lds + RING_OFF + F.wave * 16384);
            const int gw2 = ((int)blockIdx.x - NB * NH) * NWAVES + F.wave, NGW2 = (F.G - NB * NH) * NWAVES;
        {
            const int items = NE * (D / 64) * 32;
            for (int it = gw2; it < items; it += NGW2) { const int e = it / (32 * 32), rem = it % (32 * 32), kb = rem / 32, nb = rem % 32;
                const int r0 = 32 * nb, pn = r0 >> 8, rin = r0 & 255; const bool up = rin >= 128; const int c0 = pn * 128 + (rin & 127);
                transpose_item((up ? F.in[I_W_UP] : F.in[I_W_GATE]) + (size_t)e * D * DE, DE, D, 64 * kb, c0, 32, WGU + (size_t)e * 1024 * D, r0, scr, lane); }
        }
        {
            const int per = (DE / 64) * (D / 32), items = NE * per;
            for (int it = gw2; it < items; it += NGW2) { const int e = it / per, rem = it % per, kb = rem / (D / 32), nb = rem % (D / 32);
                transpose_item(F.in[I_W_DOWN] + (size_t)e * DE * D, D, DE, 64 * kb, 32 * nb, 32, WDN + (size_t)e * D * DE, 32 * nb, scr, lane); }
        }
        }
        __syncthreads();
    }
    SEAM(PH_DN);
    if (IN(PH_YDN)) {
        bf16* YDN = N1; const float* dn = F.in[I_DN_NORM];
        for (int it = gw; it < T * NH; it += NGW) { const int t = it / NH, h = it % NH; const size_t off = (size_t)t * D_Z + h * 128 + 2 * lane;
            const unsigned ou = *(const unsigned*)(OB + off); const float o0 = bflo(ou), o1 = bfhi(ou); const float r = 1.0f / sqrtf(wave_sum(o0 * o0 + o1 * o1) * (1.f / 128.f) + EPS);
            const unsigned zu = *(const unsigned*)(ZS + off); *(unsigned*)(YDN + off) = pk2(o0 * r * dn[2 * lane] * bflo(zu), o1 * r * dn[2 * lane + 1] * bfhi(zu)); }
    }
    SEAM(PH_YDN);
    if (IN(PH_MERGE)) { pg8::DenseOrder S; S.init(T, D, D_Z, F.G, (int)blockIdx.x); EpiMerge E{GD, MP, MERGED}; pg8::gemm_phase<EpiMerge, pg8::DenseOrder, false>(F.lds + RING_OFF, N1, WUPDN, D_Z, S, E); }
    SEAM(PH_MERGE);
    if (IN(PH_OUT)) { pg8::DenseOrder S; S.init(T, D, D, F.G, (int)blockIdx.x); EpiResid E{F.in[I_X], H}; pg8::gemm_phase<EpiResid, pg8::DenseOrder, false>(F.lds + RING_OFF, MERGED, WOUT, D, S, E); }
    SEAM(PH_OUT);
    if (IN(PH_ROUTE)) {
        const float* gain = F.in[I_NORM_MOE];
        LAS float* LGp = (LAS float*)(F.lds + RING_OFF);
        LAS float* LGs = LGp + 8 * 768;
        LAS float* SSp = LGs + 768;
        LAS float* RS = SSp + 128;
        LAS unsigned* LCNT = (LAS unsigned*)(RS + 16);
        LAS int* ENT = (LAS int*)(LCNT + 64);
        if (F.tid < 64) LCNT[F.tid] = 0u;
        int ntok = 0;
        __syncthreads();
        const int row = lane & 15, g = lane >> 4, wv = F.wave;
        const bf16* wph = WRH + (size_t)row * D + 256 * wv + 8 * g;
#define RT_LOAD(dst, tsk) do { const float* hp_ = H + (size_t)((tsk) * 16 + row) * D + 256 * wv + 8 * g; _Pragma("unroll") for (int J = 0; J < 8; ++J) { dst[J][0] = *(const f32x4*)(hp_ + 32 * J); dst[J][1] = *(const f32x4*)(hp_ + 32 * J + 4); } } while (0)
#define RT_BODY(a, an, task, ntask) do { \
            const int r0 = (task) * 16; \
            f32x4 acc0 = (f32x4){0.f, 0.f, 0.f, 0.f}, acc1 = acc0, acc2 = acc0; float ss = 0.f; \
            _Pragma("unroll") for (int J = 0; J < 8; ++J) { \
                const f32x4 x0 = a[J][0], x1 = a[J][1]; \
                ss += ((x0.x * x0.x + x0.y * x0.y) + (x0.z * x0.z + x0.w * x0.w)) + ((x1.x * x1.x + x1.y * x1.y) + (x1.z * x1.z + x1.w * x1.w)); \
                const unsigned h0 = pk2(x0.x, x0.y), h1 = pk2(x0.z, x0.w), h2_ = pk2(x1.x, x1.y), h3 = pk2(x1.z, x1.w); \
                const unsigned l0 = pk2(x0.x - bflo(h0), x0.y - bfhi(h0)), l1 = pk2(x0.z - bflo(h1), x0.w - bfhi(h1)), l2 = pk2(x1.x - bflo(h2_), x1.y - bfhi(h2_)), l3 = pk2(x1.z - bflo(h3), x1.w - bfhi(h3)); \
                const bf16x8 ah = __builtin_bit_cast(bf16x8, (v4u){h0, h1, h2_, h3}), al = __builtin_bit_cast(bf16x8, (v4u){l0, l1, l2, l3}); \
                acc0 = __builtin_amdgcn_mfma_f32_16x16x32_bf16(ah, wb[J][0], acc0, 0, 0, 0); acc1 = __builtin_amdgcn_mfma_f32_16x16x32_bf16(ah, wb[J][1], acc1, 0, 0, 0); acc2 = __builtin_amdgcn_mfma_f32_16x16x32_bf16(ah, wb[J][2], acc2, 0, 0, 0); \
                acc0 = __builtin_amdgcn_mfma_f32_16x16x32_bf16(al, wb[J][0], acc0, 0, 0, 0); acc1 = __builtin_amdgcn_mfma_f32_16x16x32_bf16(al, wb[J][1], acc1, 0, 0, 0); acc2 = __builtin_amdgcn_mfma_f32_16x16x32_bf16(al, wb[J][2], acc2, 0, 0, 0); } \
            ss += __shfl_xor(ss, 16); ss += __shfl_xor(ss, 32); \
            __syncthreads(); \
            _Pragma("unroll") for (int reg = 0; reg < 4; ++reg) { LAS float* q = LGp + wv * 768 + (4 * g + reg) * 48 + row; q[0] = acc0[reg]; q[16] = acc1[reg]; q[32] = acc2[reg]; } \
            if (g == 0) SSp[wv * 16 + row] = ss; \
            __syncthreads(); \
            for (int e = F.tid; e < 768; e += NTHR) { float s8 = 0.f; _Pragma("unroll") for (int w8 = 0; w8 < 8; ++w8) s8 += LGp[w8 * 768 + e]; LGs[e] = s8; } \
            if (F.tid < 16) { float s8 = 0.f; _Pragma("unroll") for (int w8 = 0; w8 < 8; ++w8) s8 += SSp[w8 * 16 + F.tid]; RS[F.tid] = 1.0f / sqrtf(s8 * (1.f / D) + EPS); } \
            __syncthreads(); \
            if (F.tid < 16) route_row(F, LGs + F.tid * 48, RS[F.tid], r0 + F.tid, LCNT, ENT, 2 * (ntok + F.tid)); ntok += 16; \
            { const float rs = RS[row]; bf16* op = N1 + (size_t)(r0 + row) * D + 256 * wv + 8 * g; const float* gp = gain + 256 * wv + 8 * g; \
              _Pragma("unroll") for (int J = 0; J < 8; ++J) { const f32x4 g0 = *(const f32x4*)(gp + 32 * J), g1 = *(const f32x4*)(gp + 32 * J + 4); const f32x4 x0 = a[J][0], x1 = a[J][1]; \
                v4u o; o.x = pk2(x0.x * rs * g0.x, x0.y * rs * g0.y); o.y = pk2(x0.z * rs * g0.z, x0.w * rs * g0.w); o.z = pk2(x1.x * rs * g1.x, x1.y * rs * g1.y); o.w = pk2(x1.z * rs * g1.z, x1.w * rs * g1.w); \
                *(v4u*)(op + 32 * J) = o; } } } while (0)
        f32x4 ra[8][2];
        bf16x8 wb[8][3];
#pragma unroll
        for (int J = 0; J < 8; ++J)
#pragma unroll
            for (int t3 = 0; t3 < 3; ++t3) wb[J][t3] = *(const bf16x8*)(wph + 16 * t3 * D + 32 * J);
        for (int task = F.vcu; task < T / 16; task += F.G) { RT_LOAD(ra, task); RT_BODY(ra, ra, task, 0); }
#undef RT_LOAD
#undef RT_BODY
        __syncthreads();
        if (F.tid < NE) LCNT[32 + F.tid] = atomicAdd(&F.ctl[CW_CNT + 64 * F.tid], LCNT[F.tid]);
        __syncthreads();
        for (int i = F.tid; i < 2 * ntok; i += NTHR) { const int es = ENT[4 * i], e = es >> 16, slot = (int)LCNT[32 + e] + (es & 0xffff); LTK[(size_t)e * T + slot] = ENT[4 * i + 1]; LW[(size_t)e * T + slot] = __int_as_float(ENT[4 * i + 2]); }
        __syncthreads();
    }
    SEAM(PH_ROUTE);
    if (IN(PH_MOE1)) {
        LAS int* pre = (LAS int*)(F.lds + MISC_OFF + 256); LAS int* base = pre + 40;
        moe_tables<256>(F, pre, base);
        MoeSched<256, true> S{pre, base, LTK, 4, F.G, F.vcu, D, 1024};
        EpiMoe1 E{HMID}; pg8::gemm_phase<EpiMoe1, MoeSched<256, true>, true>(F.lds + RING_OFF, N1, WGU, D, S, E);
    }
    SEAM(PH_MOE1);
    if (IN(PH_MOE2)) {
        LAS int* pre = (LAS int*)(F.lds + MISC_OFF + 256); LAS int* base = pre + 40;
        moe_tables<256>(F, pre, base);
        MoeSched<256, false> S{pre, base, LTK, 8, F.G, F.vcu, DE, D};
        EpiMoe2 E{LTK, LW, Y0, Y1}; pg8::gemm_phase<EpiMoe2, MoeSched<256, false>, false>(F.lds + RING_OFF, HMID, WDN, DE, S, E);
    }
    SEAM(PH_MOE2);
    if (IN(PH_N3)) {
        const float* gain = F.in[I_NORM_PLE];
        for (int t = gw; t < T; t += NGW) {
            f32x4* hr = (f32x4*)(H + (size_t)t * D) + lane; const f32x4* gr = (const f32x4*)gain + lane;
            const v2u* y0r = (const v2u*)(Y0 + (size_t)t * D) + lane; const v2u* y1r = (const v2u*)(Y1 + (size_t)t * D) + lane;
            f32x4 v[8]; float s = 0.f;
#pragma unroll
            for (int j = 0; j < 8; ++j) { const v2u a = y0r[64 * j], b = y1r[64 * j]; f32x4 x = hr[64 * j];
                x.x += bflo(a.x) + bflo(b.x); x.y += bfhi(a.x) + bfhi(b.x); x.z += bflo(a.y) + bflo(b.y); x.w += bfhi(a.y) + bfhi(b.y);
                v[j] = x; hr[64 * j] = x; s += (x.x * x.x + x.y * x.y) + (x.z * x.z + x.w * x.w); }
            const float rstd = 1.0f / sqrtf(wave_sum(s) * (1.f / D) + EPS);
            v2u* o8 = (v2u*)(N1 + (size_t)t * D) + lane;
#pragma unroll
            for (int j = 0; j < 8; ++j) { const f32x4 g = gr[64 * j]; v2u o; o.x = pk2(v[j].x * rstd * g.x, v[j].y * rstd * g.y); o.y = pk2(v[j].z * rstd * g.z, v[j].w * rstd * g.w); o8[64 * j] = o; }
        }
    }
    SEAM(PH_N3);
    if (IN(PH_PP)) { pg8::DenseOrder S; S.init(T, D, D_PLE, F.G, (int)blockIdx.x); EpiBf16Plain E{PP}; pg8::gemm_phase<EpiBf16Plain, pg8::DenseOrder, false>(F.lds + RING_OFF, PBF, WPLEP, D_PLE, S, E); }
    SEAM(PH_PP);
    if (IN(PH_PLE)) { pg8::DenseOrder S; S.init(T, D, D, F.G, (int)blockIdx.x); EpiPle E{PP, H}; pg8::gemm_phase<EpiPle, pg8::DenseOrder, false>(F.lds + RING_OFF, N1, WPLEG, D, S, E); }
    SEAM(PH_PLE);
    if (IN(PH_FINAL)) {
        const float* gain = F.in[I_NORM_FINAL];
        for (int t = gw; t < T; t += NGW) {
            f32x4* hr = (f32x4*)(H + (size_t)t * D) + lane; const f32x4* gr = (const f32x4*)gain + lane;
            f32x4 v[8]; float s = 0.f;
#pragma unroll
            for (int j = 0; j < 8; ++j) { v[j] = hr[64 * j]; s += (v[j].x * v[j].x + v[j].y * v[j].y) + (v[j].z * v[j].z + v[j].w * v[j].w); }
            const float rstd = 1.0f / sqrtf(wave_sum(s) * (1.f / D) + EPS);
#pragma unroll
            for (int j = 0; j < 8; ++j) { const f32x4 g = gr[64 * j]; hr[64 * j] = v[j] * rstd * g; }
        }
    }
#undef IN
#undef SEAM
}

extern "C" void kernel_launch(void* const* d_in, const int* in_sizes, int n_in, void* d_out, int out_size, void* d_ws, size_t ws_size, hipStream_t stream) {
    static int grid = 0;
    if (grid == 0) {
        if (n_in != 25 || in_sizes[0] != T * D || out_size != T * D || ws_size < WS_END) { fprintf(stderr, "kernel_launch: unexpected shapes (n_in %d, in0 %d, out %d, ws %zu); nothing launched\n", n_in, n_in > 0 ? in_sizes[0] : -1, out_size, ws_size); grid = -1; return; }
        int dev = 0, cus = 0, per_cu = 0;
        if (hipGetDevice(&dev) != hipSuccess || hipDeviceGetAttribute(&cus, hipDeviceAttributeMultiprocessorCount, dev) != hipSuccess) { grid = -1; return; }
        if (hipFuncSetAttribute((const void*)fwd, hipFuncAttributeMaxDynamicSharedMemorySize, LDS_BYTES) != hipSuccess) { fprintf(stderr, "kernel_launch: hipFuncSetAttribute failed\n"); grid = -1; return; }
        if (hipOccupancyMaxActiveBlocksPerMultiprocessor(&per_cu, (const void*)fwd, NTHR, LDS_BYTES) != hipSuccess || per_cu < 1) fprintf(stderr, "kernel_launch: occupancy query reports %d\n", per_cu);
        (void)hipGetLastError();
        grid = cus;
    }
    if (grid < 0) return;
    (void)hipMemsetAsync((char*)d_ws + WS_CTL, 0, CTL_ZERO_BYTES, stream);
    Args a{};
    for (int i = 0; i < 25; ++i) a.in[i] = (const float*)d_in[i];
    a.out = (float*)d_out; a.ws = (unsigned char*)d_ws;
    if (MK_N_LAUNCHES == 1) { a.ph_lo = 0; a.ph_hi = NPHASE; hipLaunchKernelGGL(fwd, dim3(grid), dim3(NTHR), LDS_BYTES, stream, a); }
    else for (int k = 0; k < NPHASE; ++k) { a.ph_lo = k; a.ph_hi = k + 1; hipLaunchKernelGGL(fwd, dim3(grid), dim3(NTHR), LDS_BYTES, stream, a); }
}
```

```cpp
#include <hip/hip_runtime.h>
#include <cstdio>
#include <cstdint>

#ifndef MK_N_LAUNCHES
#define MK_N_LAUNCHES 1
#endif

#define GAS __attribute__((address_space(1)))
#define LAS __attribute__((address_space(3)))
typedef unsigned short bf16;
typedef unsigned v4u __attribute__((ext_vector_type(4)));
typedef unsigned v2u __attribute__((ext_vector_type(2)));
typedef float f32x4 __attribute__((ext_vector_type(4)));
typedef float f32x16 __attribute__((ext_vector_type(16)));
typedef short bf16x8 __attribute__((ext_vector_type(8)));

constexpr int NB = 4, SEQ = 8192, T = NB * SEQ, D = 2048;
constexpr int D_PLE = 256, D_POOL = 1024, POOL_GW = 256, NH = 8, DK = 128, D_QKV = 3072, D_Z = 1024;
constexpr int D_IN = 9232, N_IN_PAD = 9216;
constexpr int NE = 32, EPG = 8, NGRP = 4, DE = 512;
constexpr float EPS = 1e-6f;
constexpr int NWAVES = 8, NTHR = 512;
constexpr int DN_UNITS = NB * NH * (SEQ / 64);
constexpr int STG_BYTES = 58368 + 16384;
constexpr int PKG_BYTES = 58368;

constexpr size_t MiB = 1u << 20;
constexpr size_t WS_CTL = 0, CTL_ZERO_BYTES = 65536;
constexpr size_t WS_WRT = 512 * 1024;
constexpr size_t WS_WIN = 1 * MiB;
constexpr size_t WS_WCOMB = 38 * MiB;
constexpr size_t WS_WUPDN = 42 * MiB;
constexpr size_t WS_WOUT = 46 * MiB;
constexpr size_t WS_WPLEG = 54 * MiB;
constexpr size_t WS_WPLEP = 62 * MiB;
constexpr size_t WS_WGU = 63 * MiB;
constexpr size_t WS_WDN = 191 * MiB;
constexpr size_t WS_BA = 255 * MiB;
constexpr size_t WS_G = 257 * MiB;
constexpr size_t WS_BETA = 258 * MiB;
constexpr size_t WS_LTK = 259 * MiB;
constexpr size_t WS_LW = 263 * MiB;
constexpr size_t WS_PBF = 267 * MiB;
constexpr size_t WS_N1 = 283 * MiB;
constexpr size_t WS_PKG = 283 * MiB;
constexpr size_t WS_UT = 511 * MiB;
constexpr size_t WS_OB = 575 * MiB;
constexpr size_t WS_QKV = 411 * MiB;
constexpr size_t WS_MP = 539 * MiB;
constexpr size_t WS_UPOOL = 603 * MiB;
constexpr size_t WS_Z = 667 * MiB;
constexpr size_t WS_GP = 731 * MiB;
constexpr size_t WS_GD = 859 * MiB;
constexpr size_t WS_END = 987 * MiB;
constexpr size_t OUT_D = 0, OUT_QKV2 = 64 * MiB;
constexpr int CW_CNT = 1024;
constexpr int CW_BAR = 4096;

constexpr int RING_OFF = 0, RING_BYTES = 153600;
constexpr int MISC_OFF = RING_BYTES;
constexpr int MISC_WORDS = 256;
constexpr int OT_OFF = 154624;
constexpr int LDS_BYTES = 162816;

#define LDS_WAIT() asm volatile("s_waitcnt lgkmcnt(0)" ::: "memory")
#define VM_WAIT() asm volatile("s_waitcnt vmcnt(0)" ::: "memory")
#define LDS_BARRIER() do { asm volatile("s_waitcnt lgkmcnt(0)" ::: "memory"); __builtin_amdgcn_s_barrier(); asm volatile("" ::: "memory"); } while (0)
__device__ __forceinline__ float bflo(unsigned u) { return __uint_as_float(u << 16); }
__device__ __forceinline__ float bfhi(unsigned u) { return __uint_as_float(u & 0xffff0000u); }
__device__ __forceinline__ float bf2f(bf16 b) { return __uint_as_float((unsigned)b << 16); }
__device__ __forceinline__ unsigned f2bf(float f) { unsigned u = __float_as_uint(f); return (u + 0x7fffu + ((u >> 16) & 1u)) >> 16; }
typedef __bf16 bf16x2_t __attribute__((ext_vector_type(2)));
typedef float f32x2_t __attribute__((ext_vector_type(2)));
__device__ __forceinline__ unsigned pk2(float lo, float hi) { const f32x2_t v = {lo, hi}; const bf16x2_t b = __builtin_convertvector(v, bf16x2_t); return __builtin_bit_cast(unsigned, b); }
__device__ __forceinline__ float wave_sum(float v) {
#pragma unroll
    for (int o = 1; o < 64; o <<= 1) v += __shfl_xor(v, o);
    return v;
}
__device__ __forceinline__ float sigmoidf_(float x) { return __builtin_amdgcn_rcpf(1.0f + __builtin_amdgcn_exp2f(-1.4426950408889634f * x)); }
__device__ __forceinline__ float siluf_(float x) { return x * __builtin_amdgcn_rcpf(1.0f + __builtin_amdgcn_exp2f(-1.4426950408889634f * x)); }
__device__ __forceinline__ void store8bf(bf16* p, const float* v) {
    v4u o; o.x = pk2(v[0], v[1]); o.y = pk2(v[2], v[3]); o.z = pk2(v[4], v[5]); o.w = pk2(v[6], v[7]); *(v4u*)p = o;
}
__device__ __forceinline__ void load8bf(const bf16* p, float* v) {
    const v4u o = *(const v4u*)p; v[0] = bflo(o.x); v[1] = bfhi(o.x); v[2] = bflo(o.y); v[3] = bfhi(o.y); v[4] = bflo(o.z); v[5] = bfhi(o.z); v[6] = bflo(o.w); v[7] = bfhi(o.w);
}

__device__ __forceinline__ int tix(int row, int k, int kd16) { const int k16 = k & 15; return ((((row >> 5) * kd16 + (k >> 4)) * 64 + ((k16 >> 2) & 1) * 32 + (row & 31)) << 3) + (k16 & 3) + ((k16 >> 3) << 2); }


template <int J> __device__ __forceinline__ void fmac_bcast(float& acc, float l, float x) {
    asm volatile("v_fmac_f32_dpp %0, %1, %2 row_newbcast:%3 row_mask:0xf bank_mask:0xf" : "+v"(acc) : "v"(l), "v"(x), "n"(J));
}
template <int N> struct FmacChunk;
template <> struct FmacChunk<1> {
    static __device__ __forceinline__ void run(float& acc, float l, float x0) {
        asm volatile("v_fmac_f32_dpp %0, %1, %2 row_newbcast:0 row_mask:0xf bank_mask:0xf\n\t" : "+v"(acc) : "v"(l), "v"(x0));
    }
};
template <> struct FmacChunk<2> {
    static __device__ __forceinline__ void run(float& acc, float l, float x0, float x1) {
        asm volatile("v_fmac_f32_dpp %0, %1, %2 row_newbcast:0 row_mask:0xf bank_mask:0xf\n\t" "v_fmac_f32_dpp %0, %1, %3 row_newbcast:1 row_mask:0xf bank_mask:0xf\n\t" : "+v"(acc) : "v"(l), "v"(x0), "v"(x1));
    }
};
template <> struct FmacChunk<3> {
    static __device__ __forceinline__ void run(float& acc, float l, float x0, float x1, float x2) {
        asm volatile("v_fmac_f32_dpp %0, %1, %2 row_newbcast:0 row_mask:0xf bank_mask:0xf\n\t" "v_fmac_f32_dpp %0, %1, %3 row_newbcast:1 row_mask:0xf bank_mask:0xf\n\t" "v_fmac_f32_dpp %0, %1, %4 row_newbcast:2 row_mask:0xf bank_mask:0xf\n\t" : "+v"(acc) : "v"(l), "v"(x0), "v"(x1), "v"(x2));
    }
};
template <> struct FmacChunk<4> {
    static __device__ __forceinline__ void run(float& acc, float l, float x0, float x1, float x2, float x3) {
        asm volatile("v_fmac_f32_dpp %0, %1, %2 row_newbcast:0 row_mask:0xf bank_mask:0xf\n\t" "v_fmac_f32_dpp %0, %1, %3 row_newbcast:1 row_mask:0xf bank_mask:0xf\n\t" "v_fmac_f32_dpp %0, %1, %4 row_newbcast:2 row_mask:0xf bank_mask:0xf\n\t" "v_fmac_f32_dpp %0, %1, %5 row_newbcast:3 row_mask:0xf bank_mask:0xf\n\t" : "+v"(acc) : "v"(l), "v"(x0), "v"(x1), "v"(x2), "v"(x3));
    }
};
template <> struct FmacChunk<5> {
    static __device__ __forceinline__ void run(float& acc, float l, float x0, float x1, float x2, float x3, float x4) {
        asm volatile("v_fmac_f32_dpp %0, %1, %2 row_newbcast:0 row_mask:0xf bank_mask:0xf\n\t" "v_fmac_f32_dpp %0, %1, %3 row_newbcast:1 row_mask:0xf bank_mask:0xf\n\t" "v_fmac_f32_dpp %0, %1, %4 row_newbcast:2 row_mask:0xf bank_mask:0xf\n\t" "v_fmac_f32_dpp %0, %1, %5 row_newbcast:3 row_mask:0xf bank_mask:0xf\n\t" "v_fmac_f32_dpp %0, %1, %6 row_newbcast:4 row_mask:0xf bank_mask:0xf\n\t" : "+v"(acc) : "v"(l), "v"(x0), "v"(x1), "v"(x2), "v"(x3), "v"(x4));
    }
};
template <> struct FmacChunk<6> {
    static __device__ __forceinline__ void run(float& acc, float l, float x0, float x1, float x2, float x3, float x4, float x5) {
        asm volatile("v_fmac_f32_dpp %0, %1, %2 row_newbcast:0 row_mask:0xf bank_mask:0xf\n\t" "v_fmac_f32_dpp %0, %1, %3 row_newbcast:1 row_mask:0xf bank_mask:0xf\n\t" "v_fmac_f32_dpp %0, %1, %4 row_newbcast:2 row_mask:0xf bank_mask:0xf\n\t" "v_fmac_f32_dpp %0, %1, %5 row_newbcast:3 row_mask:0xf bank_mask:0xf\n\t" "v_fmac_f32_dpp %0, %1, %6 row_newbcast:4 row_mask:0xf bank_mask:0xf\n\t" "v_fmac_f32_dpp %0, %1, %7 row_newbcast:5 row_mask:0xf bank_mask:0xf\n\t" : "+v"(acc) : "v"(l), "v"(x0), "v"(x1), "v"(x2), "v"(x3), "v"(x4), "v"(x5));
    }
};
template <> struct FmacChunk<7> {
    static __device__ __forceinline__ void run(float& acc, float l, float x0, float x1, float x2, float x3, float x4, float x5, float x6) {
        asm volatile("v_fmac_f32_dpp %0, %1, %2 row_newbcast:0 row_mask:0xf bank_mask:0xf\n\t" "v_fmac_f32_dpp %0, %1, %3 row_newbcast:1 row_mask:0xf bank_mask:0xf\n\t" "v_fmac_f32_dpp %0, %1, %4 row_newbcast:2 row_mask:0xf bank_mask:0xf\n\t" "v_fmac_f32_dpp %0, %1, %5 row_newbcast:3 row_mask:0xf bank_mask:0xf\n\t" "v_fmac_f32_dpp %0, %1, %6 row_newbcast:4 row_mask:0xf bank_mask:0xf\n\t" "v_fmac_f32_dpp %0, %1, %7 row_newbcast:5 row_mask:0xf bank_mask:0xf\n\t" "v_fmac_f32_dpp %0, %1, %8 row_newbcast:6 row_mask:0xf bank_mask:0xf\n\t" : "+v"(acc) : "v"(l), "v"(x0), "v"(x1), "v"(x2), "v"(x3), "v"(x4), "v"(x5), "v"(x6));
    }
};
template <> struct FmacChunk<8> {
    static __device__ __forceinline__ void run(float& acc, float l, float x0, float x1, float x2, float x3, float x4, float x5, float x6, float x7) {
        asm volatile("v_fmac_f32_dpp %0, %1, %2 row_newbcast:0 row_mask:0xf bank_mask:0xf\n\t" "v_fmac_f32_dpp %0, %1, %3 row_newbcast:1 row_mask:0xf bank_mask:0xf\n\t" "v_fmac_f32_dpp %0, %1, %4 row_newbcast:2 row_mask:0xf bank_mask:0xf\n\t" "v_fmac_f32_dpp %0, %1, %5 row_newbcast:3 row_mask:0xf bank_mask:0xf\n\t" "v_fmac_f32_dpp %0, %1, %6 row_newbcast:4 row_mask:0xf bank_mask:0xf\n\t" "v_fmac_f32_dpp %0, %1, %7 row_newbcast:5 row_mask:0xf bank_mask:0xf\n\t" "v_fmac_f32_dpp %0, %1, %8 row_newbcast:6 row_mask:0xf bank_mask:0xf\n\t" "v_fmac_f32_dpp %0, %1, %9 row_newbcast:7 row_mask:0xf bank_mask:0xf\n\t" : "+v"(acc) : "v"(l), "v"(x0), "v"(x1), "v"(x2), "v"(x3), "v"(x4), "v"(x5), "v"(x6), "v"(x7));
    }
};
template <> struct FmacChunk<9> {
    static __device__ __forceinline__ void run(float& acc, float l, float x0, float x1, float x2, float x3, float x4, float x5, float x6, float x7, float x8) {
        asm volatile("v_fmac_f32_dpp %0, %1, %2 row_newbcast:0 row_mask:0xf bank_mask:0xf\n\t" "v_fmac_f32_dpp %0, %1, %3 row_newbcast:1 row_mask:0xf bank_mask:0xf\n\t" "v_fmac_f32_dpp %0, %1, %4 row_newbcast:2 row_mask:0xf bank_mask:0xf\n\t" "v_fmac_f32_dpp %0, %1, %5 row_newbcast:3 row_mask:0xf bank_mask:0xf\n\t" "v_fmac_f32_dpp %0, %1, %6 row_newbcast:4 row_mask:0xf bank_mask:0xf\n\t" "v_fmac_f32_dpp %0, %1, %7 row_newbcast:5 row_mask:0xf bank_mask:0xf\n\t" "v_fmac_f32_dpp %0, %1, %8 row_newbcast:6 row_mask:0xf bank_mask:0xf\n\t" "v_fmac_f32_dpp %0, %1, %9 row_newbcast:7 row_mask:0xf bank_mask:0xf\n\t" "v_fmac_f32_dpp %0, %1, %10 row_newbcast:8 row_mask:0xf bank_mask:0xf\n\t" : "+v"(acc) : "v"(l), "v"(x0), "v"(x1), "v"(x2), "v"(x3), "v"(x4), "v"(x5), "v"(x6), "v"(x7), "v"(x8));
    }
};
template <> struct FmacChunk<10> {
    static __device__ __forceinline__ void run(float& acc, float l, float x0, float x1, float x2, float x3, float x4, float x5, float x6, float x7, float x8, float x9) {
        asm volatile("v_fmac_f32_dpp %0, %1, %2 row_newbcast:0 row_mask:0xf bank_mask:0xf\n\t" "v_fmac_f32_dpp %0, %1, %3 row_newbcast:1 row_mask:0xf bank_mask:0xf\n\t" "v_fmac_f32_dpp %0, %1, %4 row_newbcast:2 row_mask:0xf bank_mask:0xf\n\t" "v_fmac_f32_dpp %0, %1, %5 row_newbcast:3 row_mask:0xf bank_mask:0xf\n\t" "v_fmac_f32_dpp %0, %1, %6 row_newbcast:4 row_mask:0xf bank_mask:0xf\n\t" "v_fmac_f32_dpp %0, %1, %7 row_newbcast:5 row_mask:0xf bank_mask:0xf\n\t" "v_fmac_f32_dpp %0, %1, %8 row_newbcast:6 row_mask:0xf bank_mask:0xf\n\t" "v_fmac_f32_dpp %0, %1, %9 row_newbcast:7 row_mask:0xf bank_mask:0xf\n\t" "v_fmac_f32_dpp %0, %1, %10 row_newbcast:8 row_mask:0xf bank_mask:0xf\n\t" "v_fmac_f32_dpp %0, %1, %11 row_newbcast:9 row_mask:0xf bank_mask:0xf\n\t" : "+v"(acc) : "v"(l), "v"(x0), "v"(x1), "v"(x2), "v"(x3), "v"(x4), "v"(x5), "v"(x6), "v"(x7), "v"(x8), "v"(x9));
    }
};
template <> struct FmacChunk<11> {
    static __device__ __forceinline__ void run(float& acc, float l, float x0, float x1, float x2, float x3, float x4, float x5, float x6, float x7, float x8, float x9, float x10) {
        asm volatile("v_fmac_f32_dpp %0, %1, %2 row_newbcast:0 row_mask:0xf bank_mask:0xf\n\t" "v_fmac_f32_dpp %0, %1, %3 row_newbcast:1 row_mask:0xf bank_mask:0xf\n\t" "v_fmac_f32_dpp %0, %1, %4 row_newbcast:2 row_mask:0xf bank_mask:0xf\n\t" "v_fmac_f32_dpp %0, %1, %5 row_newbcast:3 row_mask:0xf bank_mask:0xf\n\t" "v_fmac_f32_dpp %0, %1, %6 row_newbcast:4 row_mask:0xf bank_mask:0xf\n\t" "v_fmac_f32_dpp %0, %1, %7 row_newbcast:5 row_mask:0xf bank_mask:0xf\n\t" "v_fmac_f32_dpp %0, %1, %8 row_newbcast:6 row_mask:0xf bank_mask:0xf\n\t" "v_fmac_f32_dpp %0, %1, %9 row_newbcast:7 row_mask:0xf bank_mask:0xf\n\t" "v_fmac_f32_dpp %0, %1, %10 row_newbcast:8 row_mask:0xf bank_mask:0xf\n\t" "v_fmac_f32_dpp %0, %1, %11 row_newbcast:9 row_mask:0xf bank_mask:0xf\n\t" "v_fmac_f32_dpp %0, %1, %12 row_newbcast:10 row_mask:0xf bank_mask:0xf\n\t" : "+v"(acc) : "v"(l), "v"(x0), "v"(x1), "v"(x2), "v"(x3), "v"(x4), "v"(x5), "v"(x6), "v"(x7), "v"(x8), "v"(x9), "v"(x10));
    }
};
template <> struct FmacChunk<12> {
    static __device__ __forceinline__ void run(float& acc, float l, float x0, float x1, float x2, float x3, float x4, float x5, float x6, float x7, float x8, float x9, float x10, float x11) {
        asm volatile("v_fmac_f32_dpp %0, %1, %2 row_newbcast:0 row_mask:0xf bank_mask:0xf\n\t" "v_fmac_f32_dpp %0, %1, %3 row_newbcast:1 row_mask:0xf bank_mask:0xf\n\t" "v_fmac_f32_dpp %0, %1, %4 row_newbcast:2 row_mask:0xf bank_mask:0xf\n\t" "v_fmac_f32_dpp %0, %1, %5 row_newbcast:3 row_mask:0xf bank_mask:0xf\n\t" "v_fmac_f32_dpp %0, %1, %6 row_newbcast:4 row_mask:0xf bank_mask:0xf\n\t" "v_fmac_f32_dpp %0, %1, %7 row_newbcast:5 row_mask:0xf bank_mask:0xf\n\t" "v_fmac_f32_dpp %0, %1, %8 row_newbcast:6 row_mask:0xf bank_mask:0xf\n\t" "v_fmac_f32_dpp %0, %1, %9 row_newbcast:7 row_mask:0xf bank_mask:0xf\n\t" "v_fmac_f32_dpp %0, %1, %10 row_newbcast:8 row_mask:0xf bank_mask:0xf\n\t" "v_fmac_f32_dpp %0, %1, %11 row_newbcast:9 row_mask:0xf bank_mask:0xf\n\t" "v_fmac_f32_dpp %0, %1, %12 row_newbcast:10 row_mask:0xf bank_mask:0xf\n\t" "v_fmac_f32_dpp %0, %1, %13 row_newbcast:11 row_mask:0xf bank_mask:0xf\n\t" : "+v"(acc) : "v"(l), "v"(x0), "v"(x1), "v"(x2), "v"(x3), "v"(x4), "v"(x5), "v"(x6), "v"(x7), "v"(x8), "v"(x9), "v"(x10), "v"(x11));
    }
};
template <> struct FmacChunk<13> {
    static __device__ __forceinline__ void run(float& acc, float l, float x0, float x1, float x2, float x3, float x4, float x5, float x6, float x7, float x8, float x9, float x10, float x11, float x12) {
        asm volatile("v_fmac_f32_dpp %0, %1, %2 row_newbcast:0 row_mask:0xf bank_mask:0xf\n\t" "v_fmac_f32_dpp %0, %1, %3 row_newbcast:1 row_mask:0xf bank_mask:0xf\n\t" "v_fmac_f32_dpp %0, %1, %4 row_newbcast:2 row_mask:0xf bank_mask:0xf\n\t" "v_fmac_f32_dpp %0, %1, %5 row_newbcast:3 row_mask:0xf bank_mask:0xf\n\t" "v_fmac_f32_dpp %0, %1, %6 row_newbcast:4 row_mask:0xf bank_mask:0xf\n\t" "v_fmac_f32_dpp %0, %1, %7 row_newbcast:5 row_mask:0xf bank_mask:0xf\n\t" "v_fmac_f32_dpp %0, %1, %8 row_newbcast:6 row_mask:0xf bank_mask:0xf\n\t" "v_fmac_f32_dpp %0, %1, %9 row_newbcast:7 row_mask:0xf bank_mask:0xf\n\t" "v_fmac_f32_dpp %0, %1, %10 row_newbcast:8 row_mask:0xf bank_mask:0xf\n\t" "v_fmac_f32_dpp %0, %1, %11 row_newbcast:9 row_mask:0xf bank_mask:0xf\n\t" "v_fmac_f32_dpp %0, %1, %12 row_newbcast:10 row_mask:0xf bank_mask:0xf\n\t" "v_fmac_f32_dpp %0, %1, %13 row_newbcast:11 row_mask:0xf bank_mask:0xf\n\t" "v_fmac_f32_dpp %0, %1, %14 row_newbcast:12 row_mask:0xf bank_mask:0xf\n\t" : "+v"(acc) : "v"(l), "v"(x0), "v"(x1), "v"(x2), "v"(x3), "v"(x4), "v"(x5), "v"(x6), "v"(x7), "v"(x8), "v"(x9), "v"(x10), "v"(x11), "v"(x12));
    }
};
template <> struct FmacChunk<14> {
    static __device__ __forceinline__ void run(float& acc, float l, float x0, float x1, float x2, float x3, float x4, float x5, float x6, float x7, float x8, float x9, float x10, float x11, float x12, float x13) {
        asm volatile("v_fmac_f32_dpp %0, %1, %2 row_newbcast:0 row_mask:0xf bank_mask:0xf\n\t" "v_fmac_f32_dpp %0, %1, %3 row_newbcast:1 row_mask:0xf bank_mask:0xf\n\t" "v_fmac_f32_dpp %0, %1, %4 row_newbcast:2 row_mask:0xf bank_mask:0xf\n\t" "v_fmac_f32_dpp %0, %1, %5 row_newbcast:3 row_mask:0xf bank_mask:0xf\n\t" "v_fmac_f32_dpp %0, %1, %6 row_newbcast:4 row_mask:0xf bank_mask:0xf\n\t" "v_fmac_f32_dpp %0, %1, %7 row_newbcast:5 row_mask:0xf bank_mask:0xf\n\t" "v_fmac_f32_dpp %0, %1, %8 row_newbcast:6 row_mask:0xf bank_mask:0xf\n\t" "v_fmac_f32_dpp %0, %1, %9 row_newbcast:7 row_mask:0xf bank_mask:0xf\n\t" "v_fmac_f32_dpp %0, %1, %10 row_newbcast:8 row_mask:0xf bank_mask:0xf\n\t" "v_fmac_f32_dpp %0, %1, %11 row_newbcast:9 row_mask:0xf bank_mask:0xf\n\t" "v_fmac_f32_dpp %0, %1, %12 row_newbcast:10 row_mask:0xf bank_mask:0xf\n\t" "v_fmac_f32_dpp %0, %1, %13 row_newbcast:11 row_mask:0xf bank_mask:0xf\n\t" "v_fmac_f32_dpp %0, %1, %14 row_newbcast:12 row_mask:0xf bank_mask:0xf\n\t" "v_fmac_f32_dpp %0, %1, %15 row_newbcast:13 row_mask:0xf bank_mask:0xf\n\t" : "+v"(acc) : "v"(l), "v"(x0), "v"(x1), "v"(x2), "v"(x3), "v"(x4), "v"(x5), "v"(x6), "v"(x7), "v"(x8), "v"(x9), "v"(x10), "v"(x11), "v"(x12), "v"(x13));
    }
};
template <> struct FmacChunk<15> {
    static __device__ __forceinline__ void run(float& acc, float l, float x0, float x1, float x2, float x3, float x4, float x5, float x6, float x7, float x8, float x9, float x10, float x11, float x12, float x13, float x14) {
        asm volatile("v_fmac_f32_dpp %0, %1, %2 row_newbcast:0 row_mask:0xf bank_mask:0xf\n\t" "v_fmac_f32_dpp %0, %1, %3 row_newbcast:1 row_mask:0xf bank_mask:0xf\n\t" "v_fmac_f32_dpp %0, %1, %4 row_newbcast:2 row_mask:0xf bank_mask:0xf\n\t" "v_fmac_f32_dpp %0, %1, %5 row_newbcast:3 row_mask:0xf bank_mask:0xf\n\t" "v_fmac_f32_dpp %0, %1, %6 row_newbcast:4 row_mask:0xf bank_mask:0xf\n\t" "v_fmac_f32_dpp %0, %1, %7 row_newbcast:5 row_mask:0xf bank_mask:0xf\n\t" "v_fmac_f32_dpp %0, %1, %8 row_newbcast:6 row_mask:0xf bank_mask:0xf\n\t" "v_fmac_f32_dpp %0, %1, %9 row_newbcast:7 row_mask:0xf bank_mask:0xf\n\t" "v_fmac_f32_dpp %0, %1, %10 row_newbcast:8 row_mask:0xf bank_mask:0xf\n\t" "v_fmac_f32_dpp %0, %1, %11 row_newbcast:9 row_mask:0xf bank_mask:0xf\n\t" "v_fmac_f32_dpp %0, %1, %12 row_newbcast:10 row_mask:0xf bank_mask:0xf\n\t" "v_fmac_f32_dpp %0, %1, %13 row_newbcast:11 row_mask:0xf bank_mask:0xf\n\t" "v_fmac_f32_dpp %0, %1, %14 row_newbcast:12 row_mask:0xf bank_mask:0xf\n\t" "v_fmac_f32_dpp %0, %1, %15 row_newbcast:13 row_mask:0xf bank_mask:0xf\n\t" "v_fmac_f32_dpp %0, %1, %16 row_newbcast:14 row_mask:0xf bank_mask:0xf\n\t" : "+v"(acc) : "v"(l), "v"(x0), "v"(x1), "v"(x2), "v"(x3), "v"(x4), "v"(x5), "v"(x6), "v"(x7), "v"(x8), "v"(x9), "v"(x10), "v"(x11), "v"(x12), "v"(x13), "v"(x14));
    }
};
template <> struct FmacChunk<16> {
    static __device__ __forceinline__ void run(float& acc, float l, float x0, float x1, float x2, float x3, float x4, float x5, float x6, float x7, float x8, float x9, float x10, float x11, float x12, float x13, float x14, float x15) {
        asm volatile("v_fmac_f32_dpp %0, %1, %2 row_newbcast:0 row_mask:0xf bank_mask:0xf\n\t" "v_fmac_f32_dpp %0, %1, %3 row_newbcast:1 row_mask:0xf bank_mask:0xf\n\t" "v_fmac_f32_dpp %0, %1, %4 row_newbcast:2 row_mask:0xf bank_mask:0xf\n\t" "v_fmac_f32_dpp %0, %1, %5 row_newbcast:3 row_mask:0xf bank_mask:0xf\n\t" "v_fmac_f32_dpp %0, %1, %6 row_newbcast:4 row_mask:0xf bank_mask:0xf\n\t" "v_fmac_f32_dpp %0, %1, %7 row_newbcast:5 row_mask:0xf bank_mask:0xf\n\t" "v_fmac_f32_dpp %0, %1, %8 row_newbcast:6 row_mask:0xf bank_mask:0xf\n\t" "v_fmac_f32_dpp %0, %1, %9 row_newbcast:7 row_mask:0xf bank_mask:0xf\n\t" "v_fmac_f32_dpp %0, %1, %10 row_newbcast:8 row_mask:0xf bank_mask:0xf\n\t" "v_fmac_f32_dpp %0, %1, %11 row_newbcast:9 row_mask:0xf bank_mask:0xf\n\t" "v_fmac_f32_dpp %0, %1, %12 row_newbcast:10 row_mask:0xf bank_mask:0xf\n\t" "v_fmac_f32_dpp %0, %1, %13 row_newbcast:11 row_mask:0xf bank_mask:0xf\n\t" "v_fmac_f32_dpp %0, %1, %14 row_newbcast:12 row_mask:0xf bank_mask:0xf\n\t" "v_fmac_f32_dpp %0, %1, %15 row_newbcast:13 row_mask:0xf bank_mask:0xf\n\t" "v_fmac_f32_dpp %0, %1, %16 row_newbcast:14 row_mask:0xf bank_mask:0xf\n\t" "v_fmac_f32_dpp %0, %1, %17 row_newbcast:15 row_mask:0xf bank_mask:0xf\n\t" : "+v"(acc) : "v"(l), "v"(x0), "v"(x1), "v"(x2), "v"(x3), "v"(x4), "v"(x5), "v"(x6), "v"(x7), "v"(x8), "v"(x9), "v"(x10), "v"(x11), "v"(x12), "v"(x13), "v"(x14), "v"(x15));
    }
};
template <int N, int B> struct ChunkCall;
#define CC_ARGS1(B) x[B]
#define CC_ARGS2(B) CC_ARGS1(B), x[B + 1]
#define CC_ARGS3(B) CC_ARGS2(B), x[B + 2]
#define CC_ARGS4(B) CC_ARGS3(B), x[B + 3]
#define CC_ARGS5(B) CC_ARGS4(B), x[B + 4]
#define CC_ARGS6(B) CC_ARGS5(B), x[B + 5]
#define CC_ARGS7(B) CC_ARGS6(B), x[B + 6]
#define CC_ARGS8(B) CC_ARGS7(B), x[B + 7]
#define CC_ARGS9(B) CC_ARGS8(B), x[B + 8]
#define CC_ARGS10(B) CC_ARGS9(B), x[B + 9]
#define CC_ARGS11(B) CC_ARGS10(B), x[B + 10]
#define CC_ARGS12(B) CC_ARGS11(B), x[B + 11]
#define CC_ARGS13(B) CC_ARGS12(B), x[B + 12]
#define CC_ARGS14(B) CC_ARGS13(B), x[B + 13]
#define CC_ARGS15(B) CC_ARGS14(B), x[B + 14]
#define CC_ARGS16(B) CC_ARGS15(B), x[B + 15]
#define CC_DEF(N) template <int B> struct ChunkCall<N, B> { static __device__ __forceinline__ void run(float (&x)[64], float& acc, float l) { FmacChunk<N>::run(acc, l, CC_ARGS##N(B)); } };
CC_DEF(1) CC_DEF(2) CC_DEF(3) CC_DEF(4) CC_DEF(5) CC_DEF(6) CC_DEF(7) CC_DEF(8) CC_DEF(9) CC_DEF(10) CC_DEF(11) CC_DEF(12) CC_DEF(13) CC_DEF(14) CC_DEF(15) CC_DEF(16)
#undef CC_DEF
template <int N> struct QuadChunk;
template <> struct QuadChunk<1> {
    static __device__ __forceinline__ void run(float& a0, float& a1, float& a2, float& a3, float l0, float l1, float l2, float l3, float x0) {
        asm volatile("v_fmac_f32_dpp %0, %4, %8 row_newbcast:0 row_mask:0xf bank_mask:0xf\n\t" "v_fmac_f32_dpp %1, %5, %8 row_newbcast:0 row_mask:0xf bank_mask:0xf\n\t" "v_fmac_f32_dpp %2, %6, %8 row_newbcast:0 row_mask:0xf bank_mask:0xf\n\t" "v_fmac_f32_dpp %3, %7, %8 row_newbcast:0 row_mask:0xf bank_mask:0xf\n\t" : "+v"(a0), "+v"(a1), "+v"(a2), "+v"(a3) : "v"(l0), "v"(l1), "v"(l2), "v"(l3), "v"(x0));
    }
};
template <> struct QuadChunk<2> {
    static __device__ __forceinline__ void run(float& a0, float& a1, float& a2, float& a3, float l0, float l1, float l2, float l3, float x0, float x1) {
        asm volatile("v_fmac_f32_dpp %0, %4, %8 row_newbcast:0 row_mask:0xf bank_mask:0xf\n\t" "v_fmac_f32_dpp %1, %5, %8 row_newbcast:0 row_mask:0xf bank_mask:0xf\n\t" "v_fmac_f32_dpp %2, %6, %8 row_newbcast:0 row_mask:0xf bank_mask:0xf\n\t" "v_fmac_f32_dpp %3, %7, %8 row_newbcast:0 row_mask:0xf bank_mask:0xf\n\t" "v_fmac_f32_dpp %0, %4, %9 row_newbcast:1 row_mask:0xf bank_mask:0xf\n\t" "v_fmac_f32_dpp %1, %5, %9 row_newbcast:1 row_mask:0xf bank_mask:0xf\n\t" "v_fmac_f32_dpp %2, %6, %9 row_newbcast:1 row_mask:0xf bank_mask:0xf\n\t" "v_fmac_f32_dpp %3, %7, %9 row_newbcast:1 row_mask:0xf bank_mask:0xf\n\t" : "+v"(a0), "+v"(a1), "+v"(a2), "+v"(a3) : "v"(l0), "v"(l1), "v"(l2), "v"(l3), "v"(x0), "v"(x1));
    }
};
template <> struct QuadChunk<3> {
    static __device__ __forceinline__ void run(float& a0, float& a1, float& a2, float& a3, float l0, float l1, float l2, float l3, float x0, float x1, float x2) {
        asm volatile("v_fmac_f32_dpp %0, %4, %8 row_newbcast:0 row_mask:0xf bank_mask:0xf\n\t" "v_fmac_f32_dpp %1, %5, %8 row_newbcast:0 row_mask:0xf bank_mask:0xf\n\t" "v_fmac_f32_dpp %2, %6, %8 row_newbcast:0 row_mask:0xf bank_mask:0xf\n\t" "v_fmac_f32_dpp %3, %7, %8 row_newbcast:0 row_mask:0xf bank_mask:0xf\n\t" "v_fmac_f32_dpp %0, %4, %9 row_newbcast:1 row_mask:0xf bank_mask:0xf\n\t" "v_fmac_f32_dpp %1, %5, %9 row_newbcast:1 row_mask:0xf bank_mask:0xf\n\t" "v_fmac_f32_dpp %2, %6, %9 row_newbcast:1 row_mask:0xf bank_mask:0xf\n\t" "v_fmac_f32_dpp %3, %7, %9 row_newbcast:1 row_mask:0xf bank_mask:0xf\n\t" "v_fmac_f32_dpp %0, %4, %10 row_newbcast:2 row_mask:0xf bank_mask:0xf\n\t" "v_fmac_f32_dpp %1, %5, %10 row_newbcast:2 row_mask:0xf bank_mask:0xf\n\t" "v_fmac_f32_dpp %2, %6, %10 row_newbcast:2 row_mask:0xf bank_mask:0xf\n\t" "v_fmac_f32_dpp %3, %7, %10 row_newbcast:2 row_mask:0xf bank_mask:0xf\n\t" : "+v"(a0), "+v"(a1), "+v"(a2), "+v"(a3) : "v"(l0), "v"(l1), "v"(l2), "v"(l3), "v"(x0), "v"(x1), "v"(x2));
    }
};
template <> struct QuadChunk<4> {
    static __device__ __forceinline__ void run(float& a0, float& a1, float& a2, float& a3, float l0, float l1, float l2, float l3, float x0, float x1, float x2, float x3) {
        asm volatile("v_fmac_f32_dpp %0, %4, %8 row_newbcast:0 row_mask:0xf bank_mask:0xf\n\t" "v_fmac_f32_dpp %1, %5, %8 row_newbcast:0 row_mask:0xf bank_mask:0xf\n\t" "v_fmac_f32_dpp %2, %6, %8 row_newbcast:0 row_mask:0xf bank_mask:0xf\n\t" "v_fmac_f32_dpp %3, %7, %8 row_newbcast:0 row_mask:0xf bank_mask:0xf\n\t" "v_fmac_f32_dpp %0, %4, %9 row_newbcast:1 row_mask:0xf bank_mask:0xf\n\t" "v_fmac_f32_dpp %1, %5, %9 row_newbcast:1 row_mask:0xf bank_mask:0xf\n\t" "v_fmac_f32_dpp %2, %6, %9 row_newbcast:1 row_mask:0xf bank_mask:0xf\n\t" "v_fmac_f32_dpp %3, %7, %9 row_newbcast:1 row_mask:0xf bank_mask:0xf\n\t" "v_fmac_f32_dpp %0, %4, %10 row_newbcast:2 row_mask:0xf bank_mask:0xf\n\t" "v_fmac_f32_dpp %1, %5, %10 row_newbcast:2 row_mask:0xf bank_mask:0xf\n\t" "v_fmac_f32_dpp %2, %6, %10 row_newbcast:2 row_mask:0xf bank_mask:0xf\n\t" "v_fmac_f32_dpp %3, %7, %10 row_newbcast:2 row_mask:0xf bank_mask:0xf\n\t" "v_fmac_f32_dpp %0, %4, %11 row_newbcast:3 row_mask:0xf bank_mask:0xf\n\t" "v_fmac_f32_dpp %1, %5, %11 row_newbcast:3 row_mask:0xf bank_mask:0xf\n\t" "v_fmac_f32_dpp %2, %6, %11 row_newbcast:3 row_mask:0xf bank_mask:0xf\n\t" "v_fmac_f32_dpp %3, %7, %11 row_newbcast:3 row_mask:0xf bank_mask:0xf\n\t" : "+v"(a0), "+v"(a1), "+v"(a2), "+v"(a3) : "v"(l0), "v"(l1), "v"(l2), "v"(l3), "v"(x0), "v"(x1), "v"(x2), "v"(x3));
    }
};
template <> struct QuadChunk<5> {
    static __device__ __forceinline__ void run(float& a0, float& a1, float& a2, float& a3, float l0, float l1, float l2, float l3, float x0, float x1, float x2, float x3, float x4) {
        asm volatile("v_fmac_f32_dpp %0, %4, %8 row_newbcast:0 row_mask:0xf bank_mask:0xf\n\t" "v_fmac_f32_dpp %1, %5, %8 row_newbcast:0 row_mask:0xf bank_mask:0xf\n\t" "v_fmac_f32_dpp %2, %6, %8 row_newbcast:0 row_mask:0xf bank_mask:0xf\n\t" "v_fmac_f32_dpp %3, %7, %8 row_newbcast:0 row_mask:0xf bank_mask:0xf\n\t" "v_fmac_f32_dpp %0, %4, %9 row_newbcast:1 row_mask:0xf bank_mask:0xf\n\t" "v_fmac_f32_dpp %1, %5, %9 row_newbcast:1 row_mask:0xf bank_mask:0xf\n\t" "v_fmac_f32_dpp %2, %6, %9 row_newbcast:1 row_mask:0xf bank_mask:0xf\n\t" "v_fmac_f32_dpp %3, %7, %9 row_newbcast:1 row_mask:0xf bank_mask:0xf\n\t" "v_fmac_f32_dpp %0, %4, %10 row_newbcast:2 row_mask:0xf bank_mask:0xf\n\t" "v_fmac_f32_dpp %1, %5, %10 row_newbcast:2 row_mask:0xf bank_mask:0xf\n\t" "v_fmac_f32_dpp %2, %6, %10 row_newbcast:2 row_mask:0xf bank_mask:0xf\n\t" "v_fmac_f32_dpp %3, %7, %10 row_newbcast:2 row_mask:0xf bank_mask:0xf\n\t" "v_fmac_f32_dpp %0, %4, %11 row_newbcast:3 row_mask:0xf bank_mask:0xf\n\t" "v_fmac_f32_dpp %1, %5, %11 row_newbcast:3 row_mask:0xf bank_mask:0xf\n\t" "v_fmac_f32_dpp %2, %6, %11 row_newbcast:3 row_mask:0xf bank_mask:0xf\n\t" "v_fmac_f32_dpp %3, %7, %11 row_newbcast:3 row_mask:0xf bank_mask:0xf\n\t" "v_fmac_f32_dpp %0, %4, %12 row_newbcast:4 row_mask:0xf bank_mask:0xf\n\t" "v_fmac_f32_dpp %1, %5, %12 row_newbcast:4 row_mask:0xf bank_mask:0xf\n\t" "v_fmac_f32_dpp %2, %6, %12 row_newbcast:4 row_mask:0xf bank_mask:0xf\n\t" "v_fmac_f32_dpp %3, %7, %12 row_newbcast:4 row_mask:0xf bank_mask:0xf\n\t" : "+v"(a0), "+v"(a1), "+v"(a2), "+v"(a3) : "v"(l0), "v"(l1), "v"(l2), "v"(l3), "v"(x0), "v"(x1), "v"(x2), "v"(x3), "v"(x4));
    }
};
template <> struct QuadChunk<6> {
    static __device__ __forceinline__ void run(float& a0, float& a1, float& a2, float& a3, float l0, float l1, float l2, float l3, float x0, float x1, float x2, float x3, float x4, float x5) {
        asm volatile("v_fmac_f32_dpp %0, %4, %8 row_newbcast:0 row_mask:0xf bank_mask:0xf\n\t" "v_fmac_f32_dpp %1, %5, %8 row_newbcast:0 row_mask:0xf bank_mask:0xf\n\t" "v_fmac_f32_dpp %2, %6, %8 row_newbcast:0 row_mask:0xf bank_mask:0xf\n\t" "v_fmac_f32_dpp %3, %7, %8 row_newbcast:0 row_mask:0xf bank_mask:0xf\n\t" "v_fmac_f32_dpp %0, %4, %9 row_newbcast:1 row_mask:0xf bank_mask:0xf\n\t" "v_fmac_f32_dpp %1, %5, %9 row_newbcast:1 row_mask:0xf bank_mask:0xf\n\t" "v_fmac_f32_dpp %2, %6, %9 row_newbcast:1 row_mask:0xf bank_mask:0xf\n\t" "v_fmac_f32_dpp %3, %7, %9 row_newbcast:1 row_mask:0xf bank_mask:0xf\n\t" "v_fmac_f32_dpp %0, %4, %10 row_newbcast:2 row_mask:0xf bank_mask:0xf\n\t" "v_fmac_f32_dpp %1, %5, %10 row_newbcast:2 row_mask:0xf bank_mask:0xf\n\t" "v_fmac_f32_dpp %2, %6, %10 row_newbcast:2 row_mask:0xf bank_mask:0xf\n\t" "v_fmac_f32_dpp %3, %7, %10 row_newbcast:2 row_mask:0xf bank_mask:0xf\n\t" "v_fmac_f32_dpp %0, %4, %11 row_newbcast:3 row_mask:0xf bank_mask:0xf\n\t" "v_fmac_f32_dpp %1, %5, %11 row_newbcast:3 row_mask:0xf bank_mask:0xf\n\t" "v_fmac_f32_dpp %2, %6, %11 row_newbcast:3 row_mask:0xf bank_mask:0xf\n\t" "v_fmac_f32_dpp %3, %7, %11 row_newbcast:3 row_mask:0xf bank_mask:0xf\n\t" "v_fmac_f32_dpp %0, %4, %12 row_newbcast:4 row_mask:0xf bank_mask:0xf\n\t" "v_fmac_f32_dpp %1, %5, %12 row_newbcast:4 row_mask:0xf bank_mask:0xf\n\t" "v_fmac_f32_dpp %2, %6, %12 row_newbcast:4 row_mask:0xf bank_mask:0xf\n\t" "v_fmac_f32_dpp %3, %7, %12 row_newbcast:4 row_mask:0xf bank_mask:0xf\n\t" "v_fmac_f32_dpp %0, %4, %13 row_newbcast:5 row_mask:0xf bank_mask:0xf\n\t" "v_fmac_f32_dpp %1, %5, %13 row_newbcast:5 row_mask:0xf bank_mask:0xf\n\t" "v_fmac_f32_dpp %2, %6, %13 row_newbcast:5 row_mask:0xf bank_mask:0xf\n\t" "v_fmac_f32_dpp %3, %7, %13 row_newbcast:5 row_mask:0xf bank_mask:0xf\n\t" : "+v"(a0), "+v"(a1), "+v"(a2), "+v"(a3) : "v"(l0), "v"(l1), "v"(l2), "v"(l3), "v"(x0), "v"(x1), "v"(x2), "v"(x3), "v"(x4), "v"(x5));
    }
};
template <> struct QuadChunk<7> {
    static __device__ __forceinline__ void run(float& a0, float& a1, float& a2, float& a3, float l0, float l1, float l2, float l3, float x0, float x1, float x2, float x3, float x4, float x5, float x6) {
        asm volatile("v_fmac_f32_dpp %0, %4, %8 row_newbcast:0 row_mask:0xf bank_mask:0xf\n\t" "v_fmac_f32_dpp %1, %5, %8 row_newbcast:0 row_mask:0xf bank_mask:0xf\n\t" "v_fmac_f32_dpp %2, %6, %8 row_newbcast:0 row_mask:0xf bank_mask:0xf\n\t" "v_fmac_f32_dpp %3, %7, %8 row_newbcast:0 row_mask:0xf bank_mask:0xf\n\t" "v_fmac_f32_dpp %0, %4, %9 row_newbcast:1 row_mask:0xf bank_mask:0xf\n\t" "v_fmac_f32_dpp %1, %5, %9 row_newbcast:1 row_mask:0xf bank_mask:0xf\n\t" "v_fmac_f32_dpp %2, %6, %9 row_newbcast:1 row_mask:0xf bank_mask:0xf\n\t" "v_fmac_f32_dpp %3, %7, %9 row_newbcast:1 row_mask:0xf bank_mask:0xf\n\t" "v_fmac_f32_dpp %0, %4, %10 row_newbcast:2 row_mask:0xf bank_mask:0xf\n\t" "v_fmac_f32_dpp %1, %5, %10 row_newbcast:2 row_mask:0xf bank_mask:0xf\n\t" "v_fmac_f32_dpp %2, %6, %10 row_newbcast:2 row_mask:0xf bank_mask:0xf\n\t" "v_fmac_f32_dpp %3, %7, %10 row_newbcast:2 row_mask:0xf bank_mask:0xf\n\t" "v_fmac_f32_dpp %0, %4, %11 row_newbcast:3 row_mask:0xf bank_mask:0xf\n\t" "v_fmac_f32_dpp %1, %5, %11 row_newbcast:3 row_mask:0xf bank_mask:0xf\n\t" "v_fmac_f32_dpp %2, %6, %11 row_newbcast:3 row_mask:0xf bank_mask:0xf\n\t" "v_fmac_f32_dpp %3, %7, %11 row_newbcast:3 row_mask:0xf bank_mask:0xf\n\t" "v_fmac_f32_dpp %0, %4, %12 row_newbcast:4 row_mask:0xf bank_mask:0xf\n\t" "v_fmac_f32_dpp %1, %5, %12 row_newbcast:4 row_mask:0xf bank_mask:0xf\n\t" "v_fmac_f32_dpp %2, %6, %12 row_newbcast:4 row_mask:0xf bank_mask:0xf\n\t" "v_fmac_f32_dpp %3, %7, %12 row_newbcast:4 row_mask:0xf bank_mask:0xf\n\t" "v_fmac_f32_dpp %0, %4, %13 row_newbcast:5 row_mask:0xf bank_mask:0xf\n\t" "v_fmac_f32_dpp %1, %5, %13 row_newbcast:5 row_mask:0xf bank_mask:0xf\n\t" "v_fmac_f32_dpp %2, %6, %13 row_newbcast:5 row_mask:0xf bank_mask:0xf\n\t" "v_fmac_f32_dpp %3, %7, %13 row_newbcast:5 row_mask:0xf bank_mask:0xf\n\t" "v_fmac_f32_dpp %0, %4, %14 row_newbcast:6 row_mask:0xf bank_mask:0xf\n\t" "v_fmac_f32_dpp %1, %5, %14 row_newbcast:6 row_mask:0xf bank_mask:0xf\n\t" "v_fmac_f32_dpp %2, %6, %14 row_newbcast:6 row_mask:0xf bank_mask:0xf\n\t" "v_fmac_f32_dpp %3, %7, %14 row_newbcast:6 row_mask:0xf bank_mask:0xf\n\t" : "+v"(a0), "+v"(a1), "+v"(a2), "+v"(a3) : "v"(l0), "v"(l1), "v"(l2), "v"(l3), "v"(x0), "v"(x1), "v"(x2), "v"(x3), "v"(x4), "v"(x5), "v"(x6));
    }
};
template <> struct QuadChunk<8> {
    static __device__ __forceinline__ void run(float& a0, float& a1, float& a2, float& a3, float l0, float l1, float l2, float l3, float x0, float x1, float x2, float x3, float x4, float x5, float x6, float x7) {
        asm volatile("v_fmac_f32_dpp %0, %4, %8 row_newbcast:0 row_mask:0xf bank_mask:0xf\n\t" "v_fmac_f32_dpp %1, %5, %8 row_newbcast:0 row_mask:0xf bank_mask:0xf\n\t" "v_fmac_f32_dpp %2, %6, %8 row_newbcast:0 row_mask:0xf bank_mask:0xf\n\t" "v_fmac_f32_dpp %3, %7, %8 row_newbcast:0 row_mask:0xf bank_mask:0xf\n\t" "v_fmac_f32_dpp %0, %4, %9 row_newbcast:1 row_mask:0xf bank_mask:0xf\n\t" "v_fmac_f32_dpp %1, %5, %9 row_newbcast:1 row_mask:0xf bank_mask:0xf\n\t" "v_fmac_f32_dpp %2, %6, %9 row_newbcast:1 row_mask:0xf bank_mask:0xf\n\t" "v_fmac_f32_dpp %3, %7, %9 row_newbcast:1 row_mask:0xf bank_mask:0xf\n\t" "v_fmac_f32_dpp %0, %4, %10 row_newbcast:2 row_mask:0xf bank_mask:0xf\n\t" "v_fmac_f32_dpp %1, %5, %10 row_newbcast:2 row_mask:0xf bank_mask:0xf\n\t" "v_fmac_f32_dpp %2, %6, %10 row_newbcast:2 row_mask:0xf bank_mask:0xf\n\t" "v_fmac_f32_dpp %3, %7, %10 row_newbcast:2 row_mask:0xf bank_mask:0xf\n\t" "v_fmac_f32_dpp %0, %4, %11 row_newbcast:3 row_mask:0xf bank_mask:0xf\n\t" "v_fmac_f32_dpp %1, %5, %11 row_newbcast:3 row_mask:0xf bank_mask:0xf\n\t" "v_fmac_f32_dpp %2, %6, %11 row_newbcast:3 row_mask:0xf bank_mask:0xf\n\t" "v_fmac_f32_dpp %3, %7, %11 row_newbcast:3 row_mask:0xf bank_mask:0xf\n\t" "v_fmac_f32_dpp %0, %4, %12 row_newbcast:4 row_mask:0xf bank_mask:0xf\n\t" "v_fmac_f32_dpp %1, %5, %12 row_newbcast:4 row_mask:0xf bank_mask:0xf\n\t" "v_fmac_f32_dpp %2, %6, %12 row_newbcast:4 row_mask:0xf bank_mask:0xf\n\t" "v_fmac_f32_dpp %3, %7, %12 row_newbcast:4 row_mask:0xf bank_mask:0xf\n\t" "v_fmac_f32_dpp %0, %4, %13 row_newbcast:5 row_mask:0xf bank_mask:0xf\n\t" "v_fmac_f32_dpp %1, %5, %13 row_newbcast:5 row_mask:0xf bank_mask:0xf\n\t" "v_fmac_f32_dpp %2, %6, %13 row_newbcast:5 row_mask:0xf bank_mask:0xf\n\t" "v_fmac_f32_dpp %3, %7, %13 row_newbcast:5 row_mask:0xf bank_mask:0xf\n\t" "v_fmac_f32_dpp %0, %4, %14 row_newbcast:6 row_mask:0xf bank_mask:0xf\n\t" "v_fmac_f32_dpp %1, %5, %14 row_newbcast:6 row_mask:0xf bank_mask:0xf\n\t" "v_fmac_f32_dpp %2, %6, %14 row_newbcast:6 row_mask:0xf bank_mask:0xf\n\t" "v_fmac_f32_dpp %3, %7, %14 row_newbcast:6 row_mask:0xf bank_mask:0xf\n\t" "v_fmac_f32_dpp %0, %4, %15 row_newbcast:7 row_mask:0xf bank_mask:0xf\n\t" "v_fmac_f32_dpp %1, %5, %15 row_newbcast:7 row_mask:0xf bank_mask:0xf\n\t" "v_fmac_f32_dpp %2, %6, %15 row_newbcast:7 row_mask:0xf bank_mask:0xf\n\t" "v_fmac_f32_dpp %3, %7, %15 row_newbcast:7 row_mask:0xf bank_mask:0xf\n\t" : "+v"(a0), "+v"(a1), "+v"(a2), "+v"(a3) : "v"(l0), "v"(l1), "v"(l2), "v"(l3), "v"(x0), "v"(x1), "v"(x2), "v"(x3), "v"(x4), "v"(x5), "v"(x6), "v"(x7));
    }
};
template <> struct QuadChunk<9> {
    static __device__ __forceinline__ void run(float& a0, float& a1, float& a2, float& a3, float l0, float l1, float l2, float l3, float x0, float x1, float x2, float x3, float x4, float x5, float x6, float x7, float x8) {
        asm volatile("v_fmac_f32_dpp %0, %4, %8 row_newbcast:0 row_mask:0xf bank_mask:0xf\n\t" "v_fmac_f32_dpp %1, %5, %8 row_newbcast:0 row_mask:0xf bank_mask:0xf\n\t" "v_fmac_f32_dpp %2, %6, %8 row_newbcast:0 row_mask:0xf bank_mask:0xf\n\t" "v_fmac_f32_dpp %3, %7, %8 row_newbcast:0 row_mask:0xf bank_mask:0xf\n\t" "v_fmac_f32_dpp %0, %4, %9 row_newbcast:1 row_mask:0xf bank_mask:0xf\n\t" "v_fmac_f32_dpp %1, %5, %9 row_newbcast:1 row_mask:0xf bank_mask:0xf\n\t" "v_fmac_f32_dpp %2, %6, %9 row_newbcast:1 row_mask:0xf bank_mask:0xf\n\t" "v_fmac_f32_dpp %3, %7, %9 row_newbcast:1 row_mask:0xf bank_mask:0xf\n\t" "v_fmac_f32_dpp %0, %4, %10 row_newbcast:2 row_mask:0xf bank_mask:0xf\n\t" "v_fmac_f32_dpp %1, %5, %10 row_newbcast:2 row_mask:0xf bank_mask:0xf\n\t" "v_fmac_f32_dpp %2, %6, %10 row_newbcast:2 row_mask:0xf bank_mask:0xf\n\t" "v_fmac_f32_dpp %3, %7, %10 row_newbcast:2 row_mask:0xf bank_mask:0xf\n\t" "v_fmac_f32_dpp %0, %4, %11 row_newbcast:3 row_mask:0xf bank_mask:0xf\n\t" "v_fmac_f32_dpp %1, %5, %11 row_newbcast:3 row_mask:0xf bank_mask:0xf\n\t" "v_fmac_f32_dpp %2, %6, %11 row_newbcast:3 row_mask:0xf bank_mask:0xf\n\t" "v_fmac_f32_dpp %3, %7, %11 row_newbcast:3 row_mask:0xf bank_mask:0xf\n\t" "v_fmac_f32_dpp %0, %4, %12 row_newbcast:4 row_mask:0xf bank_mask:0xf\n\t" "v_fmac_f32_dpp %1, %5, %12 row_newbcast:4 row_mask:0xf bank_mask:0xf\n\t" "v_fmac_f32_dpp %2, %6, %12 row_newbcast:4 row_mask:0xf bank_mask:0xf\n\t" "v_fmac_f32_dpp %3, %7, %12 row_newbcast:4 row_mask:0xf bank_mask:0xf\n\t" "v_fmac_f32_dpp %0, %4, %13 row_newbcast:5 row_mask:0xf bank_mask:0xf\n\t" "v_fmac_f32_dpp %1, %5, %13 row_newbcast:5 row_mask:0xf bank_mask:0xf\n\t" "v_fmac_f32_dpp %2, %6, %13 row_newbcast:5 row_mask:0xf bank_mask:0xf\n\t" "v_fmac_f32_dpp %3, %7, %13 row_newbcast:5 row_mask:0xf bank_mask:0xf\n\t" "v_fmac_f32_dpp %0, %4, %14 row_newbcast:6 row_mask:0xf bank_mask:0xf\n\t" "v_fmac_f32_dpp %1, %5, %14 row_newbcast:6 row_mask:0xf bank_mask:0xf\n\t" "v_fmac_f32_dpp %2, %6, %14 row_newbcast:6 row_mask:0xf bank_mask:0xf\n\t" "v_fmac_f32_dpp %3, %7, %14 row_newbcast:6 row_mask:0xf bank_mask:0xf\n\t" "v_fmac_f32_dpp %0, %4, %15 row_newbcast:7 row_mask:0xf bank_mask:0xf\n\t" "v_fmac_f32_dpp %1, %5, %15 row_newbcast:7 row_mask:0xf bank_mask:0xf\n\t" "v_fmac_f32_dpp %2, %6, %15 row_newbcast:7 row_mask:0xf bank_mask:0xf\n\t" "v_fmac_f32_dpp %3, %7, %15 row_newbcast:7 row_mask:0xf bank_mask:0xf\n\t" "v_fmac_f32_dpp %0, %4, %16 row_newbcast:8 row_mask:0xf bank_mask:0xf\n\t" "v_fmac_f32_dpp %1, %5, %16 row_newbcast:8 row_mask:0xf bank_mask:0xf\n\t" "v_fmac_f32_dpp %2, %6, %16 row_newbcast:8 row_mask:0xf bank_mask:0xf\n\t" "v_fmac_f32_dpp %3, %7, %16 row_newbcast:8 row_mask:0xf bank_mask:0xf\n\t" : "+v"(a0), "+v"(a1), "+v"(a2), "+v"(a3) : "v"(l0), "v"(l1), "v"(l2), "v"(l3), "v"(x0), "v"(x1), "v"(x2), "v"(x3), "v"(x4), "v"(x5), "v"(x6), "v"(x7), "v"(x8));
    }
};
template <> struct QuadChunk<10> {
    static __device__ __forceinline__ void run(float& a0, float& a1, float& a2, float& a3, float l0, float l1, float l2, float l3, float x0, float x1, float x2, float x3, float x4, float x5, float x6, float x7, float x8, float x9) {
        asm volatile("v_fmac_f32_dpp %0, %4, %8 row_newbcast:0 row_mask:0xf bank_mask:0xf\n\t" "v_fmac_f32_dpp %1, %5, %8 row_newbcast:0 row_mask:0xf bank_mask:0xf\n\t" "v_fmac_f32_dpp %2, %6, %8 row_newbcast:0 row_mask:0xf bank_mask:0xf\n\t" "v_fmac_f32_dpp %3, %7, %8 row_newbcast:0 row_mask:0xf bank_mask:0xf\n\t" "v_fmac_f32_dpp %0, %4, %9 row_newbcast:1 row_mask:0xf bank_mask:0xf\n\t" "v_fmac_f32_dpp %1, %5, %9 row_newbcast:1 row_mask:0xf bank_mask:0xf\n\t" "v_fmac_f32_dpp %2, %6, %9 row_newbcast:1 row_mask:0xf bank_mask:0xf\n\t" "v_fmac_f32_dpp %3, %7, %9 row_newbcast:1 row_mask:0xf bank_mask:0xf\n\t" "v_fmac_f32_dpp %0, %4, %10 row_newbcast:2 row_mask:0xf bank_mask:0xf\n\t" "v_fmac_f32_dpp %1, %5, %10 row_newbcast:2 row_mask:0xf bank_mask:0xf\n\t" "v_fmac_f32_dpp %2, %6, %10 row_newbcast:2 row_mask:0xf bank_mask:0xf\n\t" "v_fmac_f32_dpp %3, %7, %10 row_newbcast:2 row_mask:0xf bank_mask:0xf\n\t" "v_fmac_f32_dpp %0, %4, %11 row_newbcast:3 row_mask:0xf bank_mask:0xf\n\t" "v_fmac_f32_dpp %1, %5, %11 row_newbcast:3 row_mask:0xf bank_mask:0xf\n\t" "v_fmac_f32_dpp %2, %6, %11 row_newbcast:3 row_mask:0xf bank_mask:0xf\n\t" "v_fmac_f32_dpp %3, %7, %11 row_newbcast:3 row_mask:0xf bank_mask:0xf\n\t" "v_fmac_f32_dpp %0, %4, %12 row_newbcast:4 row_mask:0xf bank_mask:0xf\n\t" "v_fmac_f32_dpp %1, %5, %12 row_newbcast:4 row_mask:0xf bank_mask:0xf\n\t" "v_fmac_f32_dpp %2, %6, %12 row_newbcast:4 row_mask:0xf bank_mask:0xf\n\t" "v_fmac_f32_dpp %3, %7, %12 row_newbcast:4 row_mask:0xf bank_mask:0xf\n\t" "v_fmac_f32_dpp %0, %4, %13 row_newbcast:5 row_mask:0xf bank_mask:0xf\n\t" "v_fmac_f32_dpp %1, %5, %13 row_newbcast:5 row_mask:0xf bank_mask:0xf\n\t" "v_fmac_f32_dpp %2, %6, %13 row_newbcast:5 row_mask:0xf bank_mask:0xf\n\t" "v_fmac_f32_dpp %3, %7, %13 row_newbcast:5 row_mask:0xf bank_mask:0xf\n\t" "v_fmac_f32_dpp %0, %4, %14 row_newbcast:6 row_mask:0xf bank_mask:0xf\n\t" "v_fmac_f32_dpp %1, %5, %14 row_newbcast:6 row_mask:0xf bank_mask:0xf\n\t" "v_fmac_f32_dpp %2, %6, %14 row_newbcast:6 row_mask:0xf bank_mask:0xf\n\t" "v_fmac_f32_dpp %3, %7, %14 row_newbcast:6 row_mask:0xf bank_mask:0xf\n\t" "v_fmac_f32_dpp %0, %4, %15 row_newbcast:7 row_mask:0xf bank_mask:0xf\n\t" "v_fmac_f32_dpp %1, %5, %15 row_newbcast:7 row_mask:0xf bank_mask:0xf\n\t" "v_fmac_f32_dpp %2, %6, %15 row_newbcast:7 row_mask:0xf bank_mask:0xf\n\t" "v_fmac_f32_dpp %3, %7, %15 row_newbcast:7 row_mask:0xf bank_mask:0xf\n\t" "v_fmac_f32_dpp %0, %4, %16 row_newbcast:8 row_mask:0xf bank_mask:0xf\n\t" "v_fmac_f32_dpp %1, %5, %16 row_newbcast:8 row_mask:0xf bank_mask:0xf\n\t" "v_fmac_f32_dpp %2, %6, %16 row_newbcast:8 row_mask:0xf bank_mask:0xf\n\t" "v_fmac_f32_dpp %3, %7, %16 row_newbcast:8 row_mask:0xf bank_mask:0xf\n\t" "v_fmac_f32_dpp %0, %4, %17 row_newbcast:9 row_mask:0xf bank_mask:0xf\n\t" "v_fmac_f32_dpp %1, %5, %17 row_newbcast:9 row_mask:0xf bank_mask:0xf\n\t" "v_fmac_f32_dpp %2, %6, %17 row_newbcast:9 row_mask:0xf bank_mask:0xf\n\t" "v_fmac_f32_dpp %3, %7, %17 row_newbcast:9 row_mask:0xf bank_mask:0xf\n\t" : "+v"(a0), "+v"(a1), "+v"(a2), "+v"(a3) : "v"(l0), "v"(l1), "v"(l2), "v"(l3), "v"(x0), "v"(x1), "v"(x2), "v"(x3), "v"(x4), "v"(x5), "v"(x6), "v"(x7), "v"(x8), "v"(x9));
    }
};
template <> struct QuadChunk<11> {
    static __device__ __forceinline__ void run(float& a0, float& a1, float& a2, float& a3, float l0, float l1, float l2, float l3, float x0, float x1, float x2, float x3, float x4, float x5, float x6, float x7, float x8, float x9, float x10) {
        asm volatile("v_fmac_f32_dpp %0, %4, %8 row_newbcast:0 row_mask:0xf bank_mask:0xf\n\t" "v_fmac_f32_dpp %1, %5, %8 row_newbcast:0 row_mask:0xf bank_mask:0xf\n\t" "v_fmac_f32_dpp %2, %6, %8 row_newbcast:0 row_mask:0xf bank_mask:0xf\n\t" "v_fmac_f32_dpp %3, %7, %8 row_newbcast:0 row_mask:0xf bank_mask:0xf\n\t" "v_fmac_f32_dpp %0, %4, %9 row_newbcast:1 row_mask:0xf bank_mask:0xf\n\t" "v_fmac_f32_dpp %1, %5, %9 row_newbcast:1 row_mask:0xf bank_mask:0xf\n\t" "v_fmac_f32_dpp %2, %6, %9 row_newbcast:1 row_mask:0xf bank_mask:0xf\n\t" "v_fmac_f32_dpp %3, %7, %9 row_newbcast:1 row_mask:0xf bank_mask:0xf\n\t" "v_fmac_f32_dpp %0, %4, %10 row_newbcast:2 row_mask:0xf bank_mask:0xf\n\t" "v_fmac_f32_dpp %1, %5, %10 row_newbcast:2 row_mask:0xf bank_mask:0xf\n\t" "v_fmac_f32_dpp %2, %6, %10 row_newbcast:2 row_mask:0xf bank_mask:0xf\n\t" "v_fmac_f32_dpp %3, %7, %10 row_newbcast:2 row_mask:0xf bank_mask:0xf\n\t" "v_fmac_f32_dpp %0, %4, %11 row_newbcast:3 row_mask:0xf bank_mask:0xf\n\t" "v_fmac_f32_dpp %1, %5, %11 row_newbcast:3 row_mask:0xf bank_mask:0xf\n\t" "v_fmac_f32_dpp %2, %6, %11 row_newbcast:3 row_mask:0xf bank_mask:0xf\n\t" "v_fmac_f32_dpp %3, %7, %11 row_newbcast:3 row_mask:0xf bank_mask:0xf\n\t" "v_fmac_f32_dpp %0, %4, %12 row_newbcast:4 row_mask:0xf bank_mask:0xf\n\t" "v_fmac_f32_dpp %1, %5, %12 row_newbcast:4 row_mask:0xf bank_mask:0xf\n\t" "v_fmac_f32_dpp %2, %6, %12 row_newbcast:4 row_mask:0xf bank_mask:0xf\n\t" "v_fmac_f32_dpp %3, %7, %12 row_newbcast:4 row_mask:0xf bank_mask:0xf\n\t" "v_fmac_f32_dpp %0, %4, %13 row_newbcast:5 row_mask:0xf bank_mask:0xf\n\t" "v_fmac_f32_dpp %1, %5, %13 row_newbcast:5 row_mask:0xf bank_mask:0xf\n\t" "v_fmac_f32_dpp %2, %6, %13 row_newbcast:5 row_mask:0xf bank_mask:0xf\n\t" "v_fmac_f32_dpp %3, %7, %13 row_newbcast:5 row_mask:0xf bank_mask:0xf\n\t" "v_fmac_f32_dpp %0, %4, %14 row_newbcast:6 row_mask:0xf bank_mask:0xf\n\t" "v_fmac_f32_dpp %1, %5, %14 row_newbcast:6 row_mask:0xf bank_mask:0xf\n\t" "v_fmac_f32_dpp %2, %6, %14 row_newbcast:6 row_mask:0xf bank_mask:0xf\n\t" "v_fmac_f32_dpp %3, %7, %14 row_newbcast:6 row_mask:0xf bank_mask:0xf\n\t" "v_fmac_f32_dpp %0, %4, %15 row_newbcast:7 row_mask:0xf bank_mask:0xf\n\t" "v_fmac_f32_dpp %1, %5, %15 row_newbcast:7 row_mask:0xf bank_mask:0xf\n\t" "v_fmac_f32_dpp %2, %6, %15 row_newbcast:7 row_mask:0xf bank_mask:0xf\n\t" "v_fmac_f32_dpp %3, %7, %15 row_newbcast:7 row_mask:0xf bank_mask:0xf\n\t" "v_fmac_f32_dpp %0, %4, %16 row_newbcast:8 row_mask:0xf bank_mask:0xf\n\t" "v_fmac_f32_dpp %1, %5, %16 row_newbcast:8 row_mask:0xf bank_mask:0xf\n\t" "v_fmac_f32_dpp %2, %6, %16 row_newbcast:8 row_mask:0xf bank_mask:0xf\n\t" "v_fmac_f32_dpp %3, %7, %16 row_newbcast:8 row_mask:0xf bank_mask:0xf\n\t" "v_fmac_f32_dpp %0, %4, %17 row_newbcast:9 row_mask:0xf bank_mask:0xf\n\t" "v_fmac_f32_dpp %1, %5, %17 row_newbcast:9 row_mask:0xf bank_mask:0xf\n\t" "v_fmac_f32_dpp %2, %6, %17 row_newbcast:9 row_mask:0xf bank_mask:0xf\n\t" "v_fmac_f32_dpp %3, %7, %17 row_newbcast:9 row_mask:0xf bank_mask:0xf\n\t" "v_fmac_f32_dpp %0, %4, %18 row_newbcast:10 row_mask:0xf bank_mask:0xf\n\t" "v_fmac_f32_dpp %1, %5, %18 row_newbcast:10 row_mask:0xf bank_mask:0xf\n\t" "v_fmac_f32_dpp %2, %6, %18 row_newbcast:10 row_mask:0xf bank_mask:0xf\n\t" "v_fmac_f32_dpp %3, %7, %18 row_newbcast:10 row_mask:0xf bank_mask:0xf\n\t" : "+v"(a0), "+v"(a1), "+v"(a2), "+v"(a3) : "v"(l0), "v"(l1), "v"(l2), "v"(l3), "v"(x0), "v"(x1), "v"(x2), "v"(x3), "v"(x4), "v"(x5), "v"(x6), "v"(x7), "v"(x8), "v"(x9), "v"(x10));
    }
};
template <> struct QuadChunk<12> {
    static __device__ __forceinline__ void run(float& a0, float& a1, float& a2, float& a3, float l0, float l1, float l2, float l3, float x0, float x1, float x2, float x3, float x4, float x5, float x6, float x7, float x8, float x9, float x10, float x11) {
        asm volatile("v_fmac_f32_dpp %0, %4, %8 row_newbcast:0 row_mask:0xf bank_mask:0xf\n\t" "v_fmac_f32_dpp %1, %5, %8 row_newbcast:0 row_mask:0xf bank_mask:0xf\n\t" "v_fmac_f32_dpp %2, %6, %8 row_newbcast:0 row_mask:0xf bank_mask:0xf\n\t" "v_fmac_f32_dpp %3, %7, %8 row_newbcast:0 row_mask:0xf bank_mask:0xf\n\t" "v_fmac_f32_dpp %0, %4, %9 row_newbcast:1 row_mask:0xf bank_mask:0xf\n\t" "v_fmac_f32_dpp %1, %5, %9 row_newbcast:1 row_mask:0xf bank_mask:0xf\n\t" "v_fmac_f32_dpp %2, %6, %9 row_newbcast:1 row_mask:0xf bank_mask:0xf\n\t" "v_fmac_f32_dpp %3, %7, %9 row_newbcast:1 row_mask:0xf bank_mask:0xf\n\t" "v_fmac_f32_dpp %0, %4, %10 row_newbcast:2 row_mask:0xf bank_mask:0xf\n\t" "v_fmac_f32_dpp %1, %5, %10 row_newbcast:2 row_mask:0xf bank_mask:0xf\n\t" "v_fmac_f32_dpp %2, %6, %10 row_newbcast:2 row_mask:0xf bank_mask:0xf\n\t" "v_fmac_f32_dpp %3, %7, %10 row_newbcast:2 row_mask:0xf bank_mask:0xf\n\t" "v_fmac_f32_dpp %0, %4, %11 row_newbcast:3 row_mask:0xf bank_mask:0xf\n\t" "v_fmac_f32_dpp %1, %5, %11 row_newbcast:3 row_mask:0xf bank_mask:0xf\n\t" "v_fmac_f32_dpp %2, %6, %11 row_newbcast:3 row_mask:0xf bank_mask:0xf\n\t" "v_fmac_f32_dpp %3, %7, %11 row_newbcast:3 row_mask:0xf bank_mask:0xf\n\t" "v_fmac_f32_dpp %0, %4, %12 row_newbcast:4 row_mask:0xf bank_mask:0xf\n\t" "v_fmac_f32_dpp %1, %5, %12 row_newbcast:4 row_mask:0xf bank_mask:0xf\n\t" "v_fmac_f32_dpp %2, %6, %12 row_newbcast:4 row_mask:0xf bank_mask:0xf\n\t" "v_fmac_f32_dpp %3, %7, %12 row_newbcast:4 row_mask:0xf bank_mask:0xf\n\t" "v_fmac_f32_dpp %0, %4, %13 row_newbcast:5 row_mask:0xf bank_mask:0xf\n\t" "v_fmac_f32_dpp %1, %5, %13 row_newbcast:5 row_mask:0xf bank_mask:0xf\n\t" "v_fmac_f32_dpp %2, %6, %13 row_newbcast:5 row_mask:0xf bank_mask:0xf\n\t" "v_fmac_f32_dpp %3, %7, %13 row_newbcast:5 row_mask:0xf bank_mask:0xf\n\t" "v_fmac_f32_dpp %0, %4, %14 row_newbcast:6 row_mask:0xf bank_mask:0xf\n\t" "v_fmac_f32_dpp %1, %5, %14 row_newbcast:6 row_mask:0xf bank_mask:0xf\n\t" "v_fmac_f32_dpp %2, %6, %14 row_newbcast:6 row_mask:0xf bank_mask:0xf\n\t" "v_fmac_f32_dpp %3, %7, %14 row_newbcast:6 row_mask:0xf bank_mask:0xf\n\t" "v_fmac_f32_dpp %0, %4, %15 row_newbcast:7 row_mask:0xf bank_mask:0xf\n\t" "v_fmac_f32_dpp %1, %5, %15 row_newbcast:7 row_mask:0xf bank_mask:0xf\n\t" "v_fmac_f32_dpp %2, %6, %15 row_newbcast:7 row_mask:0xf bank_mask:0xf\n\t" "v_fmac_f32_dpp %3, %7, %15 row_newbcast:7 row_mask:0xf bank_mask:0xf\n\t" "v_fmac_f32_dpp %0, %4, %16 row_newbcast:8 row_mask:0xf bank_mask:0xf\n\t" "v_fmac_f32_dpp %1, %5, %16 row_newbcast:8 row_mask:0xf bank_mask:0xf\n\t" "v_fmac_f32_dpp %2, %6, %16 row_newbcast:8 row_mask:0xf bank_mask:0xf\n\t" "v_fmac_f32_dpp %3, %7, %16 row_newbcast:8 row_mask:0xf bank_mask:0xf\n\t" "v_fmac_f32_dpp %0, %4, %17 row_newbcast:9 row_mask:0xf bank_mask:0xf\n\t" "v_fmac_f32_dpp %1, %5, %17 row_newbcast:9 row_mask:0xf bank_mask:0xf\n\t" "v_fmac_f32_dpp %2, %6, %17 row_newbcast:9 row_mask:0xf bank_mask:0xf\n\t" "v_fmac_f32_dpp %3, %7, %17 row_newbcast:9 row_mask:0xf bank_mask:0xf\n\t" "v_fmac_f32_dpp %0, %4, %18 row_newbcast:10 row_mask:0xf bank_mask:0xf\n\t" "v_fmac_f32_dpp %1, %5, %18 row_newbcast:10 row_mask:0xf bank_mask:0xf\n\t" "v_fmac_f32_dpp %2, %6, %18 row_newbcast:10 row_mask:0xf bank_mask:0xf\n\t" "v_fmac_f32_dpp %3, %7, %18 row_newbcast:10 row_mask:0xf bank_mask:0xf\n\t" "v_fmac_f32_dpp %0, %4, %19 row_newbcast:11 row_mask:0xf bank_mask:0xf\n\t" "v_fmac_f32_dpp %1, %5, %19 row_newbcast:11 row_mask:0xf bank_mask:0xf\n\t" "v_fmac_f32_dpp %2, %6, %19 row_newbcast:11 row_mask:0xf bank_mask:0xf\n\t" "v_fmac_f32_dpp %3, %7, %19 row_newbcast:11 row_mask:0xf bank_mask:0xf\n\t" : "+v"(a0), "+v"(a1), "+v"(a2), "+v"(a3) : "v"(l0), "v"(l1), "v"(l2), "v"(l3), "v"(x0), "v"(x1), "v"(x2), "v"(x3), "v"(x4), "v"(x5), "v"(x6), "v"(x7), "v"(x8), "v"(x9), "v"(x10), "v"(x11));
    }
};
template <> struct QuadChunk<13> {
    static __device__ __forceinline__ void run(float& a0, float& a1, float& a2, float& a3, float l0, float l1, float l2, float l3, float x0, float x1, float x2, float x3, float x4, float x5, float x6, float x7, float x8, float x9, float x10, float x11, float x12) {
        asm volatile("v_fmac_f32_dpp %0, %4, %8 row_newbcast:0 row_mask:0xf bank_mask:0xf\n\t" "v_fmac_f32_dpp %1, %5, %8 row_newbcast:0 row_mask:0xf bank_mask:0xf\n\t" "v_fmac_f32_dpp %2, %6, %8 row_newbcast:0 row_mask:0xf bank_mask:0xf\n\t" "v_fmac_f32_dpp %3, %7, %8 row_newbcast:0 row_mask:0xf bank_mask:0xf\n\t" "v_fmac_f32_dpp %0, %4, %9 row_newbcast:1 row_mask:0xf bank_mask:0xf\n\t" "v_fmac_f32_dpp %1, %5, %9 row_newbcast:1 row_mask:0xf bank_mask:0xf\n\t" "v_fmac_f32_dpp %2, %6, %9 row_newbcast:1 row_mask:0xf bank_mask:0xf\n\t" "v_fmac_f32_dpp %3, %7, %9 row_newbcast:1 row_mask:0xf bank_mask:0xf\n\t" "v_fmac_f32_dpp %0, %4, %10 row_newbcast:2 row_mask:0xf bank_mask:0xf\n\t" "v_fmac_f32_dpp %1, %5, %10 row_newbcast:2 row_mask:0xf bank_mask:0xf\n\t" "v_fmac_f32_dpp %2, %6, %10 row_newbcast:2 row_mask:0xf bank_mask:0xf\n\t" "v_fmac_f32_dpp %3, %7, %10 row_newbcast:2 row_mask:0xf bank_mask:0xf\n\t" "v_fmac_f32_dpp %0, %4, %11 row_newbcast:3 row_mask:0xf bank_mask:0xf\n\t" "v_fmac_f32_dpp %1, %5, %11 row_newbcast:3 row_mask:0xf bank_mask:0xf\n\t" "v_fmac_f32_dpp %2, %6, %11 row_newbcast:3 row_mask:0xf bank_mask:0xf\n\t" "v_fmac_f32_dpp %3, %7, %11 row_newbcast:3 row_mask:0xf bank_mask:0xf\n\t" "v_fmac_f32_dpp %0, %4, %12 row_newbcast:4 row_mask:0xf bank_mask:0xf\n\t" "v_fmac_f32_dpp %1, %5, %12 row_newbcast:4 row_mask:0xf bank_mask:0xf\n\t" "v_fmac_f32_dpp %2, %6, %12 row_newbcast:4 row_mask:0xf bank_mask:0xf\n\t" "v_fmac_f32_dpp %3, %7, %12 row_newbcast:4 row_mask:0xf bank_mask:0xf\n\t" "v_fmac_f32_dpp %0, %4, %13 row_newbcast:5 row_mask:0xf bank_mask:0xf\n\t" "v_fmac_f32_dpp %1, %5, %13 row_newbcast:5 row_mask:0xf bank_mask:0xf\n\t" "v_fmac_f32_dpp %2, %6, %13 row_newbcast:5 row_mask:0xf bank_mask:0xf\n\t" "v_fmac_f32_dpp %3, %7, %13 row_newbcast:5 row_mask:0xf bank_mask:0xf\n\t" "v_fmac_f32_dpp %0, %4, %14 row_newbcast:6 row_mask:0xf bank_mask:0xf\n\t" "v_fmac_f32_dpp %1, %5, %14 row_newbcast:6 row_mask:0xf bank_mask:0xf\n\t" "v_fmac_f32_dpp %2, %6, %14 row_newbcast:6 row_mask:0xf bank_mask:0xf\n\t" "v_fmac_f32_dpp %3, %7, %14 row_newbcast:6 row_mask:0xf bank_mask:0xf\n\t" "v_fmac_f32_dpp %0, %4, %15 row_newbcast:7 row_mask:0xf bank_mask:0xf\n\t" "v_fmac_f32_dpp %1, %5, %15 row_newbcast:7 row_mask:0xf bank_mask:0xf\n\t" "v_fmac_f32_dpp %2, %6, %15 row_newbcast:7 row_mask:0xf bank_mask:0xf\n\t" "v_fmac_f32_dpp %3, %7, %15 row_newbcast:7 row_mask:0xf bank_mask:0xf\n\t" "v_fmac_f32_dpp %0, %4, %16 row_newbcast:8 row_mask:0xf bank_mask:0xf\n\t" "v_fmac_f32_dpp %1, %5, %16 row_newbcast:8 row_mask:0xf bank_mask:0xf\n\t" "v_fmac_f32_dpp %2, %6, %16 row_newbcast:8 row_mask:0xf bank_mask:0xf\n\t" "v_fmac_f32_dpp %3, %7, %16 row_newbcast:8 row_mask:0xf bank_mask:0xf\n\t" "v_fmac_f32_dpp %0, %4, %17 row_newbcast:9 row_mask:0xf bank_mask:0xf\n\t" "v_fmac_f32_dpp %1, %5, %17 row_newbcast:9 row_mask:0xf bank_mask:0xf\n\t" "v_fmac_f32_dpp %2, %6, %17 row_newbcast:9 row_mask:0xf bank_mask:0xf\n\t" "v_fmac_f32_dpp %3, %7, %17 row_newbcast:9 row_mask:0xf bank_mask:0xf\n\t" "v_fmac_f32_dpp %0, %4, %18 row_newbcast:10 row_mask:0xf bank_mask:0xf\n\t" "v_fmac_f32_dpp %1, %5, %18 row_newbcast:10 row_mask:0xf bank_mask:0xf\n\t" "v_fmac_f32_dpp %2, %6, %18 row_newbcast:10 row_mask:0xf bank_mask:0xf\n\t" "v_fmac_f32_dpp %3, %7, %18 row_newbcast:10 row_mask:0xf bank_mask:0xf\n\t" "v_fmac_f32_dpp %0, %4, %19 row_newbcast:11 row_mask:0xf bank_mask:0xf\n\t" "v_fmac_f32_dpp %1, %5, %19 row_newbcast:11 row_mask:0xf bank_mask:0xf\n\t" "v_fmac_f32_dpp %2, %6, %19 row_newbcast:11 row_mask:0xf bank_mask:0xf\n\t" "v_fmac_f32_dpp %3, %7, %19 row_newbcast:11 row_mask:0xf bank_mask:0xf\n\t" "v_fmac_f32_dpp %0, %4, %20 row_newbcast:12 row_mask:0xf bank_mask:0xf\n\t" "v_fmac_f32_dpp %1, %5, %20 row_newbcast:12 row_mask:0xf bank_mask:0xf\n\t" "v_fmac_f32_dpp %2, %6, %20 row_newbcast:12 row_mask:0xf bank_mask:0xf\n\t" "v_fmac_f32_dpp %3, %7, %20 row_newbcast:12 row_mask:0xf bank_mask:0xf\n\t" : "+v"(a0), "+v"(a1), "+v"(a2), "+v"(a3) : "v"(l0), "v"(l1), "v"(l2), "v"(l3), "v"(x0), "v"(x1), "v"(x2), "v"(x3), "v"(x4), "v"(x5), "v"(x6), "v"(x7), "v"(x8), "v"(x9), "v"(x10), "v"(x11), "v"(x12));
    }
};
template <> struct QuadChunk<14> {
    static __device__ __forceinline__ void run(float& a0, float& a1, float& a2, float& a3, float l0, float l1, float l2, float l3, float x0, float x1, float x2, float x3, float x4, float x5, float x6, float x7, float x8, float x9, float x10, float x11, float x12, float x13) {
        asm volatile("v_fmac_f32_dpp %0, %4, %8 row_newbcast:0 row_mask:0xf bank_mask:0xf\n\t" "v_fmac_f32_dpp %1, %5, %8 row_newbcast:0 row_mask:0xf bank_mask:0xf\n\t" "v_fmac_f32_dpp %2, %6, %8 row_newbcast:0 row_mask:0xf bank_mask:0xf\n\t" "v_fmac_f32_dpp %3, %7, %8 row_newbcast:0 row_mask:0xf bank_mask:0xf\n\t" "v_fmac_f32_dpp %0, %4, %9 row_newbcast:1 row_mask:0xf bank_mask:0xf\n\t" "v_fmac_f32_dpp %1, %5, %9 row_newbcast:1 row_mask:0xf bank_mask:0xf\n\t" "v_fmac_f32_dpp %2, %6, %9 row_newbcast:1 row_mask:0xf bank_mask:0xf\n\t" "v_fmac_f32_dpp %3, %7, %9 row_newbcast:1 row_mask:0xf bank_mask:0xf\n\t" "v_fmac_f32_dpp %0, %4, %10 row_newbcast:2 row_mask:0xf bank_mask:0xf\n\t" "v_fmac_f32_dpp %1, %5, %10 row_newbcast:2 row_mask:0xf bank_mask:0xf\n\t" "v_fmac_f32_dpp %2, %6, %10 row_newbcast:2 row_mask:0xf bank_mask:0xf\n\t" "v_fmac_f32_dpp %3, %7, %10 row_newbcast:2 row_mask:0xf bank_mask:0xf\n\t" "v_fmac_f32_dpp %0, %4, %11 row_newbcast:3 row_mask:0xf bank_mask:0xf\n\t" "v_fmac_f32_dpp %1, %5, %11 row_newbcast:3 row_mask:0xf bank_mask:0xf\n\t" "v_fmac_f32_dpp %2, %6, %11 row_newbcast:3 row_mask:0xf bank_mask:0xf\n\t" "v_fmac_f32_dpp %3, %7, %11 row_newbcast:3 row_mask:0xf bank_mask:0xf\n\t" "v_fmac_f32_dpp %0, %4, %12 row_newbcast:4 row_mask:0xf bank_mask:0xf\n\t" "v_fmac_f32_dpp %1, %5, %12 row_newbcast:4 row_mask:0xf bank_mask:0xf\n\t" "v_fmac_f32_dpp %2, %6, %12 row_newbcast:4 row_mask:0xf bank_mask:0xf\n\t" "v_fmac_f32_dpp %3, %7, %12 row_newbcast:4 row_mask:0xf bank_mask:0xf\n\t" "v_fmac_f32_dpp %0, %4, %13 row_newbcast:5 row_mask:0xf bank_mask:0xf\n\t" "v_fmac_f32_dpp %1, %5, %13 row_newbcast:5 row_mask:0xf bank_mask:0xf\n\t" "v_fmac_f32_dpp %2, %6, %13 row_newbcast:5 row_mask:0xf bank_mask:0xf\n\t" "v_fmac_f32_dpp %3, %7, %13 row_newbcast:5 row_mask:0xf bank_mask:0xf\n\t" "v_fmac_f32_dpp %0, %4, %14 row_newbcast:6 row_mask:0xf bank_mask:0xf\n\t" "v_fmac_f32_dpp %1, %5, %14 row_newbcast:6 row_mask:0xf bank_mask:0xf\n\t" "v_fmac_f32_dpp %2, %6, %14 row_newbcast:6 row_mask:0xf bank_mask:0xf\n\t" "v_fmac_f32_dpp %3, %7, %14 row_newbcast:6 row_mask:0xf bank_mask:0xf\n\t" "v_fmac_f32_dpp %0, %4, %15 row_newbcast:7 row_mask:0xf bank_mask:0xf\n\t" "v_fmac_f32_dpp %1, %5, %15 row_newbcast:7 row_mask:0xf bank_mask:0xf\n\t" "v_fmac_f32_dpp %2, %6, %15 row_newbcast:7 row_mask:0xf bank_mask:0xf\n\t" "v_fmac_f32_dpp %3, %7, %15 row_newbcast:7 row_mask:0xf bank_mask:0xf\n\t" "v_fmac_f32_dpp %0, %4, %16 row_newbcast:8 row_mask:0xf bank_mask:0xf\n\t" "v_fmac_f32_dpp %1, %5, %16 row_newbcast:8 row_mask:0xf bank_mask:0xf\n\t" "v_fmac_f32_dpp %2, %6, %16 row_newbcast:8 row_mask:0xf bank_mask:0xf\n\t" "v_fmac_f32_dpp %3, %7, %16 row_newbcast:8 row_mask:0xf bank_mask:0xf\n\t" "v_fmac_f32_dpp %0, %4, %17 row_newbcast:9 row_mask:0xf bank_mask:0xf\n\t" "v_fmac_f32_dpp %1, %5, %17 row_newbcast:9 row_mask:0xf bank_mask:0xf\n\t" "v_fmac_f32_dpp %2, %6, %17 row_newbcast:9 row_mask:0xf bank_mask:0xf\n\t" "v_fmac_f32_dpp %3, %7, %17 row_newbcast:9 row_mask:0xf bank_mask:0xf\n\t" "v_fmac_f32_dpp %0, %4, %18 row_newbcast:10 row_mask:0xf bank_mask:0xf\n\t" "v_fmac_f32_dpp %1, %5, %18 row_newbcast:10 row_mask:0xf bank_mask:0xf\n\t" "v_fmac_f32_dpp %2, %6, %18 row_newbcast:10 row_mask:0xf bank_mask:0xf\n\t" "v_fmac_f32_dpp %3, %7, %18 row_newbcast:10 row_mask:0xf bank_mask:0xf\n\t" "v_fmac_f32_dpp %0, %4, %19 row_newbcast:11 row_mask:0xf bank_mask:0xf\n\t" "v_fmac_f32_dpp %1, %5, %19 row_newbcast:11 row_mask:0xf bank_mask:0xf\n\t" "v_fmac_f32_dpp %2, %6, %19 row_newbcast:11 row_mask:0xf bank_mask:0xf\n\t" "v_fmac_f32_dpp %3, %7, %19 row_newbcast:11 row_mask:0xf bank_mask:0xf\n\t" "v_fmac_f32_dpp %0, %4, %20 row_newbcast:12 row_mask:0xf bank_mask:0xf\n\t" "v_fmac_f32_dpp %1, %5, %20 row_newbcast:12 row_mask:0xf bank_mask:0xf\n\t" "v_fmac_f32_dpp %2, %6, %20 row_newbcast:12 row_mask:0xf bank_mask:0xf\n\t" "v_fmac_f32_dpp %3, %7, %20 row_newbcast:12 row_mask:0xf bank_mask:0xf\n\t" "v_fmac_f32_dpp %0, %4, %21 row_newbcast:13 row_mask:0xf bank_mask:0xf\n\t" "v_fmac_f32_dpp %1, %5, %21 row_newbcast:13 row_mask:0xf bank_mask:0xf\n\t" "v_fmac_f32_dpp %2, %6, %21 row_newbcast:13 row_mask:0xf bank_mask:0xf\n\t" "v_fmac_f32_dpp %3, %7, %21 row_newbcast:13 row_mask:0xf bank_mask:0xf\n\t" : "+v"(a0), "+v"(a1), "+v"(a2), "+v"(a3) : "v"(l0), "v"(l1), "v"(l2), "v"(l3), "v"(x0), "v"(x1), "v"(x2), "v"(x3), "v"(x4), "v"(x5), "v"(x6), "v"(x7), "v"(x8), "v"(x9), "v"(x10), "v"(x11), "v"(x12), "v"(x13));
    }
};
template <> struct QuadChunk<15> {
    static __device__ __forceinline__ void run(float& a0, float& a1, float& a2, float& a3, float l0, float l1, float l2, float l3, float x0, float x1, float x2, float x3, float x4, float x5, float x6, float x7, float x8, float x9, float x10, float x11, float x12, float x13, float x14) {
        asm volatile("v_fmac_f32_dpp %0, %4, %8 row_newbcast:0 row_mask:0xf bank_mask:0xf\n\t" "v_fmac_f32_dpp %1, %5, %8 row_newbcast:0 row_mask:0xf bank_mask:0xf\n\t" "v_fmac_f32_dpp %2, %6, %8 row_newbcast:0 row_mask:0xf bank_mask:0xf\n\t" "v_fmac_f32_dpp %3, %7, %8 row_newbcast:0 row_mask:0xf bank_mask:0xf\n\t" "v_fmac_f32_dpp %0, %4, %9 row_newbcast:1 row_mask:0xf bank_mask:0xf\n\t" "v_fmac_f32_dpp %1, %5, %9 row_newbcast:1 row_mask:0xf bank_mask:0xf\n\t" "v_fmac_f32_dpp %2, %6, %9 row_newbcast:1 row_mask:0xf bank_mask:0xf\n\t" "v_fmac_f32_dpp %3, %7, %9 row_newbcast:1 row_mask:0xf bank_mask:0xf\n\t" "v_fmac_f32_dpp %0, %4, %10 row_newbcast:2 row_mask:0xf bank_mask:0xf\n\t" "v_fmac_f32_dpp %1, %5, %10 row_newbcast:2 row_mask:0xf bank_mask:0xf\n\t" "v_fmac_f32_dpp %2, %6, %10 row_newbcast:2 row_mask:0xf bank_mask:0xf\n\t" "v_fmac_f32_dpp %3, %7, %10 row_newbcast:2 row_mask:0xf bank_mask:0xf\n\t" "v_fmac_f32_dpp %0, %4, %11 row_newbcast:3 row_mask:0xf bank_mask:0xf\n\t" "v_fmac_f32_dpp %1, %5, %11 row_newbcast:3 row_mask:0xf bank_mask:0xf\n\t" "v_fmac_f32_dpp %2, %6, %11 row_newbcast:3 row_mask:0xf bank_mask:0xf\n\t" "v_fmac_f32_dpp %3, %7, %11 row_newbcast:3 row_mask:0xf bank_mask:0xf\n\t" "v_fmac_f32_dpp %0, %4, %12 row_newbcast:4 row_mask:0xf bank_mask:0xf\n\t" "v_fmac_f32_dpp %1, %5, %12 row_newbcast:4 row_mask:0xf bank_mask:0xf\n\t" "v_fmac_f32_dpp %2, %6, %12 row_newbcast:4 row_mask:0xf bank_mask:0xf\n\t" "v_fmac_f32_dpp %3, %7, %12 row_newbcast:4 row_mask:0xf bank_mask:0xf\n\t" "v_fmac_f32_dpp %0, %4, %13 row_newbcast:5 row_mask:0xf bank_mask:0xf\n\t" "v_fmac_f32_dpp %1, %5, %13 row_newbcast:5 row_mask:0xf bank_mask:0xf\n\t" "v_fmac_f32_dpp %2, %6, %13 row_newbcast:5 row_mask:0xf bank_mask:0xf\n\t" "v_fmac_f32_dpp %3, %7, %13 row_newbcast:5 row_mask:0xf bank_mask:0xf\n\t" "v_fmac_f32_dpp %0, %4, %14 row_newbcast:6 row_mask:0xf bank_mask:0xf\n\t" "v_fmac_f32_dpp %1, %5, %14 row_newbcast:6 row_mask:0xf bank_mask:0xf\n\t" "v_fmac_f32_dpp %2, %6, %14 row_newbcast:6 row_mask:0xf bank_mask:0xf\n\t" "v_fmac_f32_dpp %3, %7, %14 row_newbcast:6 row_mask:0xf bank_mask:0xf\n\t" "v_fmac_f32_dpp %0, %4, %15 row_newbcast:7 row_mask:0xf bank_mask:0xf\n\t" "v_fmac_f32_dpp %1, %5, %15 row_newbcast:7 row_mask:0xf bank_mask:0xf\n\t" "v_fmac_f32_dpp %2, %6, %15 row_newbcast:7 row_mask:0xf bank_mask:0xf\n\t" "v_fmac_f32_dpp %3, %7, %15 row_newbcast:7 row_mask:0xf bank_mask:0xf\n\t" "v_fmac_f32_dpp %0, %4, %16 row_newbcast:8 row_mask:0xf bank_mask:0xf\n\t" "v_fmac_f32_dpp %1, %5, %16 row_newbcast:8 row_mask:0xf bank_mask:0xf\n\t" "v_fmac_f32_dpp %2, %6, %16 row_newbcast:8 row_mask:0xf bank_mask:0xf\n\t" "v_fmac_f32_dpp %3, %7, %16 row_newbcast:8 row_mask:0xf bank_mask:0xf\n\t" "v_fmac_f32_dpp %0, %4, %17 row_newbcast:9 row_mask:0xf bank_mask:0xf\n\t" "v_fmac_f32_dpp %1, %5, %17 row_newbcast:9 row_mask:0xf bank_mask:0xf\n\t" "v_fmac_f32_dpp %2, %6, %17 row_newbcast:9 row_mask:0xf bank_mask:0xf\n\t" "v_fmac_f32_dpp %3, %7, %17 row_newbcast:9 row_mask:0xf bank_mask:0xf\n\t" "v_fmac_f32_dpp %0, %4, %18 row_newbcast:10 row_mask:0xf bank_mask:0xf\n\t" "v_fmac_f32_dpp %1, %5, %18 row_newbcast:10 row_mask:0xf bank_mask:0xf\n\t" "v_fmac_f32_dpp %2, %6, %18 row_newbcast:10 row_mask:0xf bank_mask:0xf\n\t" "v_fmac_f32_dpp %3, %7, %18 row_newbcast:10 row_mask:0xf bank_mask:0xf\n\t" "v_fmac_f32_dpp %0, %4, %19 row_newbcast:11 row_mask:0xf bank_mask:0xf\n\t" "v_fmac_f32_dpp %1, %5, %19 row_newbcast:11 row_mask:0xf bank_mask:0xf\n\t" "v_fmac_f32_dpp %2, %6, %19 row_newbcast:11 row_mask:0xf bank_mask:0xf\n\t" "v_fmac_f32_dpp %3, %7, %19 row_newbcast:11 row_mask:0xf bank_mask:0xf\n\t" "v_fmac_f32_dpp %0, %4, %20 row_newbcast:12 row_mask:0xf bank_mask:0xf\n\t" "v_fmac_f32_dpp %1, %5, %20 row_newbcast:12 row_mask:0xf bank_mask:0xf\n\t" "v_fmac_f32_dpp %2, %6, %20 row_newbcast:12 row_mask:0xf bank_mask:0xf\n\t" "v_fmac_f32_dpp %3, %7, %20 row_newbcast:12 row_mask:0xf bank_mask:0xf\n\t" "v_fmac_f32_dpp %0, %4, %21 row_newbcast:13 row_mask:0xf bank_mask:0xf\n\t" "v_fmac_f32_dpp %1, %5, %21 row_newbcast:13 row_mask:0xf bank_mask:0xf\n\t" "v_fmac_f32_dpp %2, %6, %21 row_newbcast:13 row_mask:0xf bank_mask:0xf\n\t" "v_fmac_f32_dpp %3, %7, %21 row_newbcast:13 row_mask:0xf bank_mask:0xf\n\t" "v_fmac_f32_dpp %0, %4, %22 row_newbcast:14 row_mask:0xf bank_mask:0xf\n\t" "v_fmac_f32_dpp %1, %5, %22 row_newbcast:14 row_mask:0xf bank_mask:0xf\n\t" "v_fmac_f32_dpp %2, %6, %22 row_newbcast:14 row_mask:0xf bank_mask:0xf\n\t" "v_fmac_f32_dpp %3, %7, %22 row_newbcast:14 row_mask:0xf bank_mask:0xf\n\t" : "+v"(a0), "+v"(a1), "+v"(a2), "+v"(a3) : "v"(l0), "v"(l1), "v"(l2), "v"(l3), "v"(x0), "v"(x1), "v"(x2), "v"(x3), "v"(x4), "v"(x5), "v"(x6), "v"(x7), "v"(x8), "v"(x9), "v"(x10), "v"(x11), "v"(x12), "v"(x13), "v"(x14));
    }
};
template <> struct QuadChunk<16> {
    static __device__ __forceinline__ void run(float& a0, float& a1, float& a2, float& a3, float l0, float l1, float l2, float l3, float x0, float x1, float x2, float x3, float x4, float x5, float x6, float x7, float x8, float x9, float x10, float x11, float x12, float x13, float x14, float x15) {
        asm volatile("v_fmac_f32_dpp %0, %4, %8 row_newbcast:0 row_mask:0xf bank_mask:0xf\n\t" "v_fmac_f32_dpp %1, %5, %8 row_newbcast:0 row_mask:0xf bank_mask:0xf\n\t" "v_fmac_f32_dpp %2, %6, %8 row_newbcast:0 row_mask:0xf bank_mask:0xf\n\t" "v_fmac_f32_dpp %3, %7, %8 row_newbcast:0 row_mask:0xf bank_mask:0xf\n\t" "v_fmac_f32_dpp %0, %4, %9 row_newbcast:1 row_mask:0xf bank_mask:0xf\n\t" "v_fmac_f32_dpp %1, %5, %9 row_newbcast:1 row_mask:0xf bank_mask:0xf\n\t" "v_fmac_f32_dpp %2, %6, %9 row_newbcast:1 row_mask:0xf bank_mask:0xf\n\t" "v_fmac_f32_dpp %3, %7, %9 row_newbcast:1 row_mask:0xf bank_mask:0xf\n\t" "v_fmac_f32_dpp %0, %4, %10 row_newbcast:2 row_mask:0xf bank_mask:0xf\n\t" "v_fmac_f32_dpp %1, %5, %10 row_newbcast:2 row_mask:0xf bank_mask:0xf\n\t" "v_fmac_f32_dpp %2, %6, %10 row_newbcast:2 row_mask:0xf bank_mask:0xf\n\t" "v_fmac_f32_dpp %3, %7, %10 row_newbcast:2 row_mask:0xf bank_mask:0xf\n\t" "v_fmac_f32_dpp %0, %4, %11 row_newbcast:3 row_mask:0xf bank_mask:0xf\n\t" "v_fmac_f32_dpp %1, %5, %11 row_newbcast:3 row_mask:0xf bank_mask:0xf\n\t" "v_fmac_f32_dpp %2, %6, %11 row_newbcast:3 row_mask:0xf bank_mask:0xf\n\t" "v_fmac_f32_dpp %3, %7, %11 row_newbcast:3 row_mask:0xf bank_mask:0xf\n\t" "v_fmac_f32_dpp %0, %4, %12 row_newbcast:4 row_mask:0xf bank_mask:0xf\n\t" "v_fmac_f32_dpp %1, %5, %12 row_newbcast:4 row_mask:0xf bank_mask:0xf\n\t" "v_fmac_f32_dpp %2, %6, %12 row_newbcast:4 row_mask:0xf bank_mask:0xf\n\t" "v_fmac_f32_dpp %3, %7, %12 row_newbcast:4 row_mask:0xf bank_mask:0xf\n\t" "v_fmac_f32_dpp %0, %4, %13 row_newbcast:5 row_mask:0xf bank_mask:0xf\n\t" "v_fmac_f32_dpp %1, %5, %13 row_newbcast:5 row_mask:0xf bank_mask:0xf\n\t" "v_fmac_f32_dpp %2, %6, %13 row_newbcast:5 row_mask:0xf bank_mask:0xf\n\t" "v_fmac_f32_dpp %3, %7, %13 row_newbcast:5 row_mask:0xf bank_mask:0xf\n\t" "v_fmac_f32_dpp %0, %4, %14 row_newbcast:6 row_mask:0xf bank_mask:0xf\n\t" "v_fmac_f32_dpp %1, %5, %14 row_newbcast:6 row_mask:0xf bank_mask:0xf\n\t" "v_fmac_f32_dpp %2, %6, %14 row_newbcast:6 row_mask:0xf bank_mask:0xf\n\t" "v_fmac_f32_dpp %3, %7, %14 row_newbcast:6 row_mask:0xf bank_mask:0xf\n\t" "v_fmac_f32_dpp %0, %4, %15 row_newbcast:7 row_mask:0xf bank_mask:0xf\n\t" "v_fmac_f32_dpp %1, %5, %15 row_newbcast:7 row_mask:0xf bank_mask:0xf\n\t" "v_fmac_f32_dpp %2, %6, %15 row_newbcast:7 row_mask:0xf bank_mask:0xf\n\t" "v_fmac_f32_dpp %3, %7, %15 row_newbcast:7 row_mask:0xf bank_mask:0xf\n\t" "v_fmac_f32_dpp %0, %4, %16 row_newbcast:8 row_mask:0xf bank_mask:0xf\n\t" "v_fmac_f32_dpp %1, %5, %16 row_newbcast:8 row_mask:0xf bank_mask:0xf\n\t" "v_fmac_f32_dpp %2, %6, %16 row_newbcast:8 row_mask:0xf bank_mask:0xf\n\t" "v_fmac_f32_dpp %3, %7, %16 row_newbcast:8 row_mask:0xf bank_mask:0xf\n\t" "v_fmac_f32_dpp %0, %4, %17 row_newbcast:9 row_mask:0xf bank_mask:0xf\n\t" "v_fmac_f32_dpp %1, %5, %17 row_newbcast:9 row_mask:0xf bank_mask:0xf\n\t" "v_fmac_f32_dpp %2, %6, %17 row_newbcast:9 row_mask:0xf bank_mask:0xf\n\t" "v_fmac_f32_dpp %3, %7, %17 row_newbcast:9 row_mask:0xf bank_mask:0xf\n\t" "v_fmac_f32_dpp %0, %4, %18 row_newbcast:10 row_mask:0xf bank_mask:0xf\n\t" "v_fmac_f32_dpp %1, %5, %18 row_newbcast:10 row_mask:0xf bank_mask:0xf\n\t" "v_fmac_f32_dpp %2, %6, %18 row_newbcast:10 row_mask:0xf bank_mask:0xf\n\t" "v_fmac_f32_dpp %3, %7, %18 row_newbcast:10 row_mask:0xf bank_mask:0xf\n\t" "v_fmac_f32_dpp %0, %4, %19 row_newbcast:11 row_mask:0xf bank_mask:0xf\n\t" "v_fmac_f32_dpp %1, %5, %19 row_newbcast:11 row_mask:0xf bank_mask:0xf\n\t" "v_fmac_f32_dpp %2, %6, %19 row_newbcast:11 row_mask:0xf bank_mask:0xf\n\t" "v_fmac_f32_dpp %3, %7, %19 row_newbcast:11 row_mask:0xf bank_mask:0xf\n\t" "v_fmac_f32_dpp %0, %4, %20 row_newbcast:12 row_mask:0xf bank_mask:0xf\n\t" "v_fmac_f32_dpp %1, %5, %20 row_newbcast:12 row_mask:0xf bank_mask:0xf\n\t" "v_fmac_f32_dpp %2, %6, %20 row_newbcast:12 row_mask:0xf bank_mask:0xf\n\t" "v_fmac_f32_dpp %3, %7, %20 row_newbcast:12 row_mask:0xf bank_mask:0xf\n\t" "v_fmac_f32_dpp %0, %4, %21 row_newbcast:13 row_mask:0xf bank_mask:0xf\n\t" "v_fmac_f32_dpp %1, %5, %21 row_newbcast:13 row_mask:0xf bank_mask:0xf\n\t" "v_fmac_f32_dpp %2, %6, %21 row_newbcast:13 row_mask:0xf bank_mask:0xf\n\t" "v_fmac_f32_dpp %3, %7, %21 row_newbcast:13 row_mask:0xf bank_mask:0xf\n\t" "v_fmac_f32_dpp %0, %4, %22 row_newbcast:14 row_mask:0xf bank_mask:0xf\n\t" "v_fmac_f32_dpp %1, %5, %22 row_newbcast:14 row_mask:0xf bank_mask:0xf\n\t" "v_fmac_f32_dpp %2, %6, %22 row_newbcast:14 row_mask:0xf bank_mask:0xf\n\t" "v_fmac_f32_dpp %3, %7, %22 row_newbcast:14 row_mask:0xf bank_mask:0xf\n\t" "v_fmac_f32_dpp %0, %4, %23 row_newbcast:15 row_mask:0xf bank_mask:0xf\n\t" "v_fmac_f32_dpp %1, %5, %23 row_newbcast:15 row_mask:0xf bank_mask:0xf\n\t" "v_fmac_f32_dpp %2, %6, %23 row_newbcast:15 row_mask:0xf bank_mask:0xf\n\t" "v_fmac_f32_dpp %3, %7, %23 row_newbcast:15 row_mask:0xf bank_mask:0xf\n\t" : "+v"(a0), "+v"(a1), "+v"(a2), "+v"(a3) : "v"(l0), "v"(l1), "v"(l2), "v"(l3), "v"(x0), "v"(x1), "v"(x2), "v"(x3), "v"(x4), "v"(x5), "v"(x6), "v"(x7), "v"(x8), "v"(x9), "v"(x10), "v"(x11), "v"(x12), "v"(x13), "v"(x14), "v"(x15));
    }
};
template <int N, int B> struct QuadCall;
#define QC_DEF(N) template <int B> struct QuadCall<N, B> { static __device__ __forceinline__ void run(float (&x)[64], int I, float (&l)[4][4], int Q); };
#undef QC_DEF
#define QC_DEF(N) template <int B> struct QuadCallI { };
#undef QC_DEF
template <int N, int B, int I, int Q> struct QuadDo;
#define QD_DEF(N) template <int B, int I, int Q> struct QuadDo<N, B, I, Q> { static __device__ __forceinline__ void run(float (&x)[64], const float (&l)[4][4]) { QuadChunk<N>::run(x[I], x[I + 1], x[I + 2], x[I + 3], l[0][Q], l[1][Q], l[2][Q], l[3][Q], CC_ARGS##N(B)); } };
QD_DEF(1) QD_DEF(2) QD_DEF(3) QD_DEF(4) QD_DEF(5) QD_DEF(6) QD_DEF(7) QD_DEF(8) QD_DEF(9) QD_DEF(10) QD_DEF(11) QD_DEF(12) QD_DEF(13) QD_DEF(14) QD_DEF(15) QD_DEF(16)
#undef QD_DEF
template <int I, int Q> struct SolveQuadBlocks {
    static __device__ __forceinline__ void run(float (&x)[64], const float (&l)[4][4]) {
        if constexpr (Q > 0) SolveQuadBlocks<I, Q - 1>::run(x, l);
        constexpr int n = (I - 16 * Q) < 16 ? (I - 16 * Q) : 16;
        QuadDo<n, 16 * Q, I, Q>::run(x, l);
    }
};
template <int I> struct SolveRows {
    static __device__ __forceinline__ void run(float (&x)[64], const LAS float* Ls, int l15) {
        if constexpr (I > 0) SolveRows<I - 4>::run(x, Ls, l15);
        float l[4][4];
#pragma unroll
        for (int r = 0; r < 4; ++r)
#pragma unroll
            for (int q = 0; q < 4; ++q) l[r][q] = (16 * q < I + 3) ? Ls[(I + r) * 68 + 16 * q + l15] : 0.f;
        if constexpr (I > 0) SolveQuadBlocks<I, (I - 1) / 16>::run(x, l);
        constexpr int QB = I >> 4, L0 = I & 15;
        fmac_bcast<L0>(x[I + 1], l[1][QB], x[I]);
        fmac_bcast<L0>(x[I + 2], l[2][QB], x[I]); fmac_bcast<L0>(x[I + 3], l[3][QB], x[I]);
        fmac_bcast<L0 + 1>(x[I + 2], l[2][QB], x[I + 1]); fmac_bcast<L0 + 1>(x[I + 3], l[3][QB], x[I + 1]);
        fmac_bcast<L0 + 2>(x[I + 3], l[3][QB], x[I + 2]);
        if ((I & 7) == 4) asm volatile("" ::: "memory");
    }
};

#define XB_TMO      128
#define XB_XCNT(j)  (256  + 64 * (j))
#define XB_XSUB(j)  (1280 + 64 * (j))
#define XB_XGEN(j)  (2304 + 64 * (j))
#define XB_TOP      3328
#define XB_TOPGEN   3392
#define XCD_BAR_WORDS 3456
#define XB_SPIN_CAP (1u << 18)
__device__ __forceinline__ unsigned xb_ld(unsigned* p)              { return __hip_atomic_load(p, __ATOMIC_RELAXED, __HIP_MEMORY_SCOPE_AGENT); }
__device__ __forceinline__ unsigned xb_add(unsigned* p, unsigned v) { return __hip_atomic_fetch_add(p, v, __ATOMIC_RELAXED, __HIP_MEMORY_SCOPE_AGENT); }
__device__ __forceinline__ unsigned xb_xcc_id() { return (unsigned)__builtin_amdgcn_s_getreg((3 << 11) | 20) & 0xFu; }
#define XB_SPIN(cond, bar) do { unsigned _sp = 0; while (cond) { __builtin_amdgcn_s_sleep(1); \
    if ((++_sp & 255u) == 0u) { if (xb_ld(&(bar)[XB_TMO])) break; if (_sp > XB_SPIN_CAP) { atomicAdd(&(bar)[XB_TMO], 1u); break; } } } } while (0)
struct XcdBarrier { unsigned* bar; unsigned x; volatile LAS unsigned* st; };
__device__ __forceinline__ XcdBarrier xcd_barrier_post(unsigned* bar, volatile LAS unsigned* st) {
    XcdBarrier b; b.bar = bar; b.x = xb_xcc_id(); b.st = st;
    if (threadIdx.x == 0) (void)xb_add(&bar[XB_XCNT(b.x)], 1u);
    return b;
}
__device__ __forceinline__ void xcd_barrier_complete(unsigned* bar, unsigned x, unsigned& nloc, unsigned& nx) {
    const unsigned G = gridDim.x * gridDim.y * gridDim.z;
    unsigned sum, cnt, mine, sp = 0u;
    for (;;) {
        sum = 0u; cnt = 0u; mine = 0u;
#pragma unroll
        for (unsigned j = 0; j < 16; ++j) { const unsigned c = xb_ld(&bar[XB_XCNT(j)]); sum += c; cnt += (c > 0u) ? 1u : 0u; mine = (j == x) ? c : mine; }
        if (sum == G) break;
        __builtin_amdgcn_s_sleep(1);
        if ((++sp & 255u) == 0u) { if (xb_ld(&bar[XB_TMO])) break; if (sp > XB_SPIN_CAP) { atomicAdd(&bar[XB_TMO], 1u); break; } }
    }
    nloc = mine > 0u ? mine : 1u; nx = cnt > 0u ? cnt : 1u;
}
__device__ __forceinline__ void xcd_barrier(const XcdBarrier& b) {
    asm volatile("s_waitcnt vmcnt(0)" ::: "memory");
    __syncthreads();
    if (threadIdx.x == 0) {
        unsigned* bar = b.bar;
        __builtin_amdgcn_s_waitcnt(0);
        unsigned nloc = b.st[0], nx = b.st[1];
        if (nloc == 0u) { xcd_barrier_complete(bar, b.x, nloc, nx); b.st[0] = nloc; b.st[1] = nx; }
        const unsigned old = xb_add(&bar[XB_XSUB(b.x)], 1u);
        const unsigned gen = old / nloc;
        if (old + 1u == (gen + 1u) * nloc) {
            __builtin_amdgcn_fence(__ATOMIC_RELEASE, "agent");
            asm volatile("s_waitcnt vmcnt(0)" ::: "memory");
            const unsigned og = xb_add(&bar[XB_TOP], 1u);
            const unsigned tg = og / nx;
            if (og + 1u == (tg + 1u) * nx) xb_add(&bar[XB_TOPGEN], 1u);
            else XB_SPIN(xb_ld(&bar[XB_TOPGEN]) == tg, bar);
            __builtin_amdgcn_fence(__ATOMIC_ACQUIRE, "agent");
            xb_add(&bar[XB_XGEN(b.x)], 1u);
            asm volatile("s_waitcnt vmcnt(0)" ::: "memory");
        } else {
            XB_SPIN(xb_ld(&bar[XB_XGEN(b.x)]) == gen, bar);
            __builtin_amdgcn_fence(__ATOMIC_ACQUIRE, "agent");
            asm volatile("s_waitcnt vmcnt(0)" ::: "memory");
        }
    }
    __syncthreads();
}

struct Frame {
    LAS unsigned char* lds;
    volatile LAS unsigned* MISC;
    unsigned* ctl;
    int tid, lane, wave, vcu, G;
    const float* in[25]; float* out; unsigned char* ws;
};
enum { I_X = 0, I_P, I_NORM_MIX, I_W_IN, I_POOL_W, I_POOL_SCALE, I_CONV_W, I_A_LOG, I_DT_BIAS, I_DN_NORM, I_W_UP_POOL, I_W_UP_DN, I_W_OUT, I_NORM_MOE,
       I_W_RG, I_B_RG, I_W_RE, I_B_RE, I_W_GATE, I_W_UP, I_W_DOWN, I_NORM_PLE, I_W_PLE_GATE, I_W_PLE_PROJ, I_NORM_FINAL };

struct Unit { int pn, e, arow0, nrows, lrow0; };
template <int RB> struct DenseSched {
    int nM, nN, G, c, K;
    __device__ __forceinline__ void init(int M, int N, int K_, int G_, int c_) { nM = M / RB; nN = N / 256; G = G_; c = c_; K = K_; }
    __device__ __forceinline__ bool next(int i, Unit& u) const {
        const long L = (long)i * G + c; if (L >= (long)nM * nN) return false;
        const int pm = (int)(L / nN); u.pn = (int)(L % nN); u.e = 0; u.arow0 = pm * RB; u.nrows = RB; u.lrow0 = 0; return true;
    }
    __device__ __forceinline__ int arow(const Unit& u, int r) const { return u.arow0 + r; }
    __device__ __forceinline__ size_t boff(const Unit& u) const { return (size_t)u.pn * 256 * K; }
};
template <int RB, bool GATHER> struct MoeSched {
    const LAS int* pre; const LAS int* base; const int* ltk; int nN, G, c, K, Nfull;
    __device__ __forceinline__ bool next(int i, Unit& u) const {
        const long L = (long)i * G + c; if (L >= (long)pre[NE] * nN) return false;
        const int blk = (int)(L / nN); u.pn = (int)(L % nN);
        int e = 0;
        for (int j = 1; j < NE; ++j) if (pre[j] <= blk) e = j;
        const int rb = blk - pre[e]; const int cnt = base[e + 1] - base[e];
        const int nr = (cnt - rb * RB) < RB ? (cnt - rb * RB) : RB;
        u.e = __builtin_amdgcn_readfirstlane(e); u.lrow0 = __builtin_amdgcn_readfirstlane(rb * RB); u.arow0 = __builtin_amdgcn_readfirstlane(base[e] + rb * RB); u.nrows = __builtin_amdgcn_readfirstlane(nr);
        u.pn = __builtin_amdgcn_readfirstlane(u.pn); return true;
    }
    __device__ __forceinline__ int arow(const Unit& u, int r) const {
        const int rr = r < u.nrows ? r : u.nrows - 1;
        if (GATHER) return ltk[(size_t)u.e * T + u.lrow0 + rr] >> 1;
        return u.arow0 + rr;
    }
    __device__ __forceinline__ size_t boff(const Unit& u) const { return ((size_t)u.e * Nfull + (size_t)u.pn * 256) * K; }
};
template <int RB> __device__ __forceinline__ void moe_tables(Frame& F, LAS int* pre, LAS int* base) {
    __syncthreads();
    if (F.tid == 0) { int p = 0, b = 0; for (int e = 0; e < NE; ++e) { const int c = (int)F.ctl[CW_CNT + 64 * e]; pre[e] = p; base[e] = b; p += (c + RB - 1) / RB; b += c; } pre[NE] = p; base[NE] = b; }
    __syncthreads();
}

constexpr int SG_RB = 64, SG_BK = 32, SG_ALD = 68, SG_BLD = 260;
template <class Epi, class Sched>
__device__ __forceinline__ void sgemm_phase(Frame& F, const bf16* A, const bf16* Bt, int K, const Sched& S, const Epi& E) {
    LAS float* As = (LAS float*)(F.lds + RING_OFF);
    LAS float* Bs = As + SG_BK * SG_ALD;
    const int tid = F.tid, rg = tid >> 4, cg = tid & 15;
    const int la = tid >> 3, kq = (tid & 7) * 4;
    const int nb = tid >> 1, kh = (tid & 1) * 16;
    for (int i = 0;; ++i) {
        Unit u; if (!S.next(i, u)) break;
        const bf16* ap = A + (size_t)S.arow(u, la) * K + kq;
        const bf16* bp = Bt + S.boff(u) + (size_t)nb * K + kh;
        float acc[2][16];
#pragma unroll
        for (int a = 0; a < 2; ++a)
#pragma unroll
            for (int b = 0; b < 16; ++b) acc[a][b] = 0.f;
        for (int k0 = 0; k0 < K; k0 += SG_BK) {
            const v2u av = *(const v2u*)(ap + k0);
            const v4u b0 = *(const v4u*)(bp + k0), b1 = *(const v4u*)(bp + k0 + 8);
            __syncthreads();
            As[(kq + 0) * SG_ALD + la] = bflo(av.x); As[(kq + 1) * SG_ALD + la] = bfhi(av.x); As[(kq + 2) * SG_ALD + la] = bflo(av.y); As[(kq + 3) * SG_ALD + la] = bfhi(av.y);
            Bs[(kh + 0) * SG_BLD + nb] = bflo(b0.x); Bs[(kh + 1) * SG_BLD + nb] = bfhi(b0.x); Bs[(kh + 2) * SG_BLD + nb] = bflo(b0.y); Bs[(kh + 3) * SG_BLD + nb] = bfhi(b0.y);
            Bs[(kh + 4) * SG_BLD + nb] = bflo(b0.z); Bs[(kh + 5) * SG_BLD + nb] = bfhi(b0.z); Bs[(kh + 6) * SG_BLD + nb] = bflo(b0.w); Bs[(kh + 7) * SG_BLD + nb] = bfhi(b0.w);
            Bs[(kh + 8) * SG_BLD + nb] = bflo(b1.x); Bs[(kh + 9) * SG_BLD + nb] = bfhi(b1.x); Bs[(kh + 10) * SG_BLD + nb] = bflo(b1.y); Bs[(kh + 11) * SG_BLD + nb] = bfhi(b1.y);
            Bs[(kh + 12) * SG_BLD + nb] = bflo(b1.z); Bs[(kh + 13) * SG_BLD + nb] = bfhi(b1.z); Bs[(kh + 14) * SG_BLD + nb] = bflo(b1.w); Bs[(kh + 15) * SG_BLD + nb] = bfhi(b1.w);
            __syncthreads();
#pragma unroll 8
            for (int kk = 0; kk < SG_BK; ++kk) {
                const float a0 = As[kk * SG_ALD + rg], a1 = As[kk * SG_ALD + rg + 32];
                const f32x4 p0 = *(const LAS f32x4*)(Bs + kk * SG_BLD + 8 * cg), p1 = *(const LAS f32x4*)(Bs + kk * SG_BLD + 8 * cg + 4);
                const f32x4 p2 = *(const LAS f32x4*)(Bs + kk * SG_BLD + 128 + 8 * cg), p3 = *(const LAS f32x4*)(Bs + kk * SG_BLD + 128 + 8 * cg + 4);
#pragma unroll
                for (int j = 0; j < 4; ++j) {
                    acc[0][j] += a0 * p0[j]; acc[0][4 + j] += a0 * p1[j]; acc[0][8 + j] += a0 * p2[j]; acc[0][12 + j] += a0 * p3[j];
                    acc[1][j] += a1 * p0[j]; acc[1][4 + j] += a1 * p1[j]; acc[1][8 + j] += a1 * p2[j]; acc[1][12 + j] += a1 * p3[j];
                }
            }
        }
#pragma unroll
        for (int a = 0; a < 2; ++a) { const int r = rg + 32 * a; if (r < u.nrows) E.store(u, r, 8 * cg, &acc[a][0], &acc[a][8]); }
    }
    __syncthreads();
}


namespace pg8 {
constexpr int BM = 256, BK = 64, HALF = 128, HTB = HALF * BK * 2, STAGE_BYTES = 8 * HTB, NXCD = 8, WGM = 8;
__host__ __device__ __forceinline__ int lds_byte(int r, int c) { const int st = (r >> 4) * 2 + (c >> 5), rr = r & 15, cc = c & 31, ob = rr * 64 + cc * 2; return st * 1024 + (ob ^ (((ob >> 9) & 1) << 5)); }
__host__ __device__ __forceinline__ void stage_rc(int b, int& R, int& C) { const int st = b / 1024, sb = b % 1024, swz = sb ^ (((sb >> 9) & 1) << 5); R = (st >> 1) * 16 + swz / 64; C = (st & 1) * 32 + (swz % 64) / 2; }
__host__ __device__ __forceinline__ int perm32(int rho) { const int n = rho >> 4, i = rho & 15; return 8 * (i >> 2) + 4 * n + (i & 3); }

struct DenseOrder {
    int nM, nN, nwg, G, c, K;
    __device__ __forceinline__ void init(int M, int N, int K_, int G_, int c_) { nM = M / BM; nN = N / BM; nwg = nM * nN; G = G_; c = c_; K = K_; }
    __device__ __forceinline__ bool next(int i, Unit& u) const {
        const long L = (long)i * G + c; if (L >= nwg) return false;
        int wgid = (int)L; { const int q = nwg / NXCD, r = nwg % NXCD, xcd = wgid % NXCD, off = wgid / NXCD; wgid = (xcd < r ? xcd * (q + 1) : r * (q + 1) + (xcd - r) * q) + off; }
        const int nig = WGM * nN, gid = wgid / nig, fm = gid * WGM, gsz = (nM - fm) < WGM ? (nM - fm) : WGM;
        u.pn = (wgid % nig) / gsz; u.e = 0; u.arow0 = (fm + ((wgid % nig) % gsz)) * BM; u.nrows = BM; u.lrow0 = 0; return true;
    }
    __device__ __forceinline__ int arow(const Unit& u, int r) const { return u.arow0 + r; }
    __device__ __forceinline__ size_t boff(const Unit& u) const { return (size_t)u.pn * 256 * K; }
};

template <class Epi, class Sched, bool GATHER, bool ALIGN_EPI = true, bool SP2 = true>
__device__ __forceinline__ void gemm_phase(LAS unsigned char* lds, const bf16* Ag, const bf16* Btg, const int K, const Sched& S, const Epi& E) {
    const int tid = threadIdx.x, wid = __builtin_amdgcn_readfirstlane(tid >> 6), lane = tid & 63, wr = wid >> 2, wc = wid & 3, fr = lane & 15, fq = lane >> 4;
    const int nt = K / BK;
    unsigned voffA[2], voffB[2]; int RA[2], CA[2];
#pragma unroll
    for (int i = 0; i < 2; ++i) { int R, C; stage_rc(tid * 16 + i * 8192, R, C); const int Rb = (R & ~31) + perm32(R & 31);
        voffA[i] = (unsigned)(R * K + C) * 2u; voffB[i] = (unsigned)(Rb * K + C) * 2u; RA[i] = R; CA[i] = C; }
    const size_t kstep = (size_t)(BK * 2);
    const size_t hstep = (size_t)HALF * K * 2;
    const unsigned ldsw = (unsigned)wid * 1024u;
    const int aoff = lds_byte(wr * 64 + fr, fq * 8), boff = lds_byte(wc * 32 + fr, fq * 8);
#define PG8_SA(b, h) (((b) * 2 + (h)) * HTB)
#define PG8_SB(b, h) ((4 + (b) * 2 + (h)) * HTB)
#define PG8_STAGE(bufoff, gbase, voff) do { _Pragma("unroll") for (int _i = 0; _i < 2; ++_i) \
        __builtin_amdgcn_global_load_lds((const unsigned*)((const char*)(gbase) + (voff)[_i]), (LAS unsigned*)(lds + (bufoff) + ldsw + _i * 8192), 16, 0, 0); } while (0)
#define PG8_STAGE_A(bufoff, base, vg, h, ko) do { if (GATHER) { PG8_STAGE(bufoff, (const char*)Ag + (ko), vg[h]); } else { PG8_STAGE(bufoff, (base) + (h) * hstep + (ko), voffA); } } while (0)
#define PG8_LDA(dst, b, h) do { _Pragma("unroll") for (int m = 0; m < 4; ++m) _Pragma("unroll") for (int k = 0; k < 2; ++k) dst[m][k] = *(const LAS bf16x8*)(lds + PG8_SA(b, h) + aoff + m * 2048 + k * 1024); } while (0)
#define PG8_LDB(dst, b, h) do { _Pragma("unroll") for (int n = 0; n < 2; ++n) _Pragma("unroll") for (int k = 0; k < 2; ++k) dst[n][k] = *(const LAS bf16x8*)(lds + PG8_SB(b, h) + boff + n * 2048 + k * 1024); } while (0)
#define PG8_MMA(ai, bj, At, Bt) do { __builtin_amdgcn_s_setprio(1); _Pragma("unroll") for (int m = 0; m < 4; ++m) _Pragma("unroll") for (int n = 0; n < 2; ++n) _Pragma("unroll") for (int k = 0; k < 2; ++k) \
        acc[ai][bj][m][n] = __builtin_amdgcn_mfma_f32_16x16x32_bf16(Bt[n][k], At[m][k], acc[ai][bj][m][n], 0, 0, 0); __builtin_amdgcn_s_setprio(0); } while (0)
#define PG8_WAIT_V(n) asm volatile("s_waitcnt vmcnt(" #n ")" ::: "memory")
#define PG8_WAIT_L(n) asm volatile("s_waitcnt lgkmcnt(" #n ")" ::: "memory")
#define PG8_BAR __builtin_amdgcn_s_barrier()
#define PG8_SCHED __builtin_amdgcn_sched_barrier(0)
#define PG8_ROWOFFS(dst, un) do { _Pragma("unroll") for (int _h = 0; _h < 2; ++_h) _Pragma("unroll") for (int _i = 0; _i < 2; ++_i) \
        dst[_h][_i] = ((unsigned)S.arow(un, _h * HALF + RA[_i]) * (unsigned)K + (unsigned)CA[_i]) * 2u; } while (0)
    Unit cur, nxt; int ui = 0;
    if (!S.next(0, cur)) return;
    f32x4 acc[2][2][4][2];
#pragma unroll
    for (int a = 0; a < 2; ++a)
#pragma unroll
        for (int b = 0; b < 2; ++b)
#pragma unroll
            for (int m = 0; m < 4; ++m)
#pragma unroll
                for (int n = 0; n < 2; ++n) acc[a][b][m][n] = (f32x4){0.f, 0.f, 0.f, 0.f};
    bf16x8 At[4][2], B0[2][2], B1[2][2];
    unsigned vc[2][2], vn[2][2];
    if (GATHER) { PG8_ROWOFFS(vc, cur); }
    const char* cA = GATHER ? (const char*)Ag : (const char*)Ag + (size_t)cur.arow0 * K * 2; const char* cB = (const char*)Btg + S.boff(cur) * 2;
    if constexpr (SP2) {
        PG8_STAGE(PG8_SB(0, 0), cB, voffB); PG8_STAGE(PG8_SB(0, 1), cB + hstep, voffB); PG8_STAGE_A(PG8_SA(0, 0), cA, vc, 0, 0); PG8_STAGE_A(PG8_SA(0, 1), cA, vc, 1, 0);
        if (wr == 1) PG8_BAR;
        PG8_WAIT_V(2); PG8_BAR;
        PG8_STAGE(PG8_SB(1, 0), cB + kstep, voffB); PG8_STAGE_A(PG8_SA(1, 0), cA, vc, 0, kstep); PG8_STAGE(PG8_SB(1, 1), cB + hstep + kstep, voffB);
        PG8_WAIT_V(6); PG8_BAR;
    } else {
        PG8_STAGE(PG8_SB(0, 0), cB, voffB); PG8_STAGE_A(PG8_SA(0, 0), cA, vc, 0, 0); PG8_STAGE(PG8_SB(0, 1), cB + hstep, voffB); PG8_STAGE_A(PG8_SA(0, 1), cA, vc, 1, 0);
        if (wr == 1) PG8_BAR;
        PG8_WAIT_V(4); PG8_BAR;
        PG8_STAGE(PG8_SB(1, 0), cB + kstep, voffB); PG8_STAGE_A(PG8_SA(1, 0), cA, vc, 0, kstep); PG8_STAGE(PG8_SB(1, 1), cB + hstep + kstep, voffB);
        PG8_WAIT_V(6); PG8_BAR;
    }
    for (;;) {
        const bool has_next = S.next(ui + 1, nxt);
        const char* nA = GATHER ? cA : (has_next ? (const char*)Ag + (size_t)nxt.arow0 * K * 2 : cA); const char* nB = has_next ? (const char*)Btg + S.boff(nxt) * 2 : cB;
        if (GATHER) { if (has_next) { PG8_ROWOFFS(vn, nxt); } else {
#pragma unroll
            for (int _h = 0; _h < 2; ++_h)
#pragma unroll
                for (int _i = 0; _i < 2; ++_i) vn[_h][_i] = vc[_h][_i]; } }
#pragma unroll 1
        for (int t = 0; t < nt; t += 2) {
            const bool last = (t == nt - 2);
            const size_t k1 = (size_t)(t + 1) * kstep;
            const size_t k2 = last ? 0 : (size_t)(t + 2) * kstep, k3 = k2 + kstep;
            const char* a2 = last ? nA : cA; const char* b2 = (last ? nB : cB) + k2; const char* b3 = b2 + kstep;
            unsigned v2[2][2];
#pragma unroll
            for (int _h = 0; _h < 2; ++_h)
#pragma unroll
                for (int _i = 0; _i < 2; ++_i) v2[_h][_i] = last ? vn[_h][_i] : vc[_h][_i];
            if constexpr (SP2) {
            PG8_LDB(B0, 0, 0); PG8_LDB(B1, 0, 1); PG8_SCHED; PG8_LDA(At, 0, 0); PG8_STAGE_A(PG8_SA(1, 1), cA, vc, 1, k1);
            PG8_WAIT_V(8); PG8_WAIT_L(0); PG8_BAR; PG8_MMA(0, 0, At, B0); PG8_MMA(0, 1, At, B1); PG8_BAR; PG8_SCHED;
            PG8_LDA(At, 0, 1); PG8_STAGE(PG8_SB(0, 0), b2, voffB); PG8_STAGE(PG8_SB(0, 1), b2 + hstep, voffB); PG8_STAGE_A(PG8_SA(0, 0), a2, v2, 0, k2);
            PG8_WAIT_V(8); PG8_WAIT_L(0); PG8_BAR; PG8_MMA(1, 0, At, B0); PG8_MMA(1, 1, At, B1); PG8_BAR; PG8_SCHED;
            PG8_LDB(B0, 1, 0); PG8_LDB(B1, 1, 1); PG8_SCHED; PG8_LDA(At, 1, 0); PG8_STAGE_A(PG8_SA(0, 1), a2, v2, 1, k2);
            PG8_WAIT_V(8); PG8_WAIT_L(0); PG8_BAR; PG8_MMA(0, 0, At, B0); PG8_MMA(0, 1, At, B1); PG8_BAR; PG8_SCHED;
            PG8_LDA(At, 1, 1); PG8_STAGE(PG8_SB(1, 0), b3, voffB); PG8_STAGE(PG8_SB(1, 1), b3 + hstep, voffB); PG8_STAGE_A(PG8_SA(1, 0), a2, v2, 0, k3);
            PG8_WAIT_V(8); PG8_WAIT_L(0); PG8_BAR; PG8_MMA(1, 0, At, B0); PG8_MMA(1, 1, At, B1); PG8_BAR; PG8_SCHED;
            } else {
            PG8_LDB(B0, 0, 0); PG8_SCHED; PG8_LDA(At, 0, 0); PG8_STAGE_A(PG8_SA(1, 1), cA, vc, 1, k1);
            PG8_WAIT_L(8); PG8_BAR; PG8_WAIT_L(0); PG8_MMA(0, 0, At, B0); PG8_BAR; PG8_SCHED;
            PG8_LDB(B1, 0, 1); PG8_STAGE(PG8_SB(0, 0), b2, voffB);
            PG8_BAR; PG8_WAIT_L(0); PG8_MMA(0, 1, At, B1); PG8_BAR;
            PG8_LDA(At, 0, 1); PG8_STAGE_A(PG8_SA(0, 0), a2, v2, 0, k2);
            PG8_BAR; PG8_WAIT_L(0); PG8_MMA(1, 0, At, B0); PG8_BAR; PG8_SCHED;
            PG8_STAGE(PG8_SB(0, 1), b2 + hstep, voffB);
            PG8_WAIT_V(6); PG8_BAR; PG8_MMA(1, 1, At, B1); PG8_BAR;
            PG8_LDB(B0, 1, 0); PG8_SCHED; PG8_LDA(At, 1, 0); PG8_STAGE_A(PG8_SA(0, 1), a2, v2, 1, k2);
            PG8_WAIT_L(8); PG8_BAR; PG8_WAIT_L(0); PG8_MMA(0, 0, At, B0); PG8_BAR; PG8_SCHED;
            PG8_LDB(B1, 1, 1); PG8_STAGE(PG8_SB(1, 0), b3, voffB);
            PG8_BAR; PG8_WAIT_L(0); PG8_MMA(0, 1, At, B1); PG8_BAR;
            PG8_LDA(At, 1, 1); PG8_STAGE_A(PG8_SA(1, 0), a2, v2, 0, k3);
            PG8_BAR; PG8_WAIT_L(0); PG8_MMA(1, 0, At, B0); PG8_BAR; PG8_SCHED;
            PG8_STAGE(PG8_SB(1, 1), b3 + hstep, voffB);
            PG8_WAIT_V(6); PG8_BAR; PG8_MMA(1, 1, At, B1); PG8_BAR;
            }
        }
        if constexpr (ALIGN_EPI) { if (wr == 0) PG8_BAR; }
        {
#pragma unroll
            for (int ai = 0; ai < 2; ++ai)
#pragma unroll
                for (int m = 0; m < 4; ++m) { const int r = ai * HALF + wr * 64 + m * 16 + fr;
                    if (r < cur.nrows) { float v0[8], v1[8];
#pragma unroll
                        for (int i = 0; i < 4; ++i) { v0[i] = acc[ai][0][m][0][i]; v0[4 + i] = acc[ai][0][m][1][i]; v1[i] = acc[ai][1][m][0][i]; v1[4 + i] = acc[ai][1][m][1][i]; }
                        E.store(cur, r, wc * 32 + 8 * fq, v0, v1); }
                    if (Epi::FENCE && (m & 1)) asm volatile("" ::: "memory"); }
        }
        if (!has_next) break;
#pragma unroll
        for (int a = 0; a < 2; ++a)
#pragma unroll
            for (int b = 0; b < 2; ++b)
#pragma unroll
                for (int m = 0; m < 4; ++m)
#pragma unroll
                    for (int n = 0; n < 2; ++n) acc[a][b][m][n] = (f32x4){0.f, 0.f, 0.f, 0.f};
        cur = nxt; cA = nA; cB = nB; ++ui;
        if (GATHER) {
#pragma unroll
            for (int _h = 0; _h < 2; ++_h)
#pragma unroll
                for (int _i = 0; _i < 2; ++_i) vc[_h][_i] = vn[_h][_i]; }
        if constexpr (ALIGN_EPI) { if (wr == 1) PG8_BAR; }
    }
    PG8_WAIT_V(0);
    if constexpr (!ALIGN_EPI) { if (wr == 0) PG8_BAR; }
    PG8_BAR;
#undef PG8_SA
#undef PG8_SB
#undef PG8_STAGE
#undef PG8_STAGE_A
#undef PG8_LDA
#undef PG8_LDB
#undef PG8_MMA
#undef PG8_WAIT_V
#undef PG8_WAIT_L
#undef PG8_BAR
#undef PG8_SCHED
#undef PG8_ROWOFFS
}
}

struct EpiInProj { static constexpr bool FENCE = false;
    bf16 *upool, *qkv, *z, *gp, *gd; float* ba;
    __device__ __forceinline__ void store(const Unit& u, int r, int cit, const float* v0, const float* v1) const {
        const size_t row = (size_t)(u.arow0 + r); const int pn = u.pn;
        if (pn < 4) { bf16* p = upool + row * D_POOL + pn * 256 + cit; store8bf(p, v0); store8bf(p + 128, v1); }
        else if (pn < 16) { bf16* p = qkv + row * D_QKV + (pn - 4) * 256 + cit; store8bf(p, v0); store8bf(p + 128, v1); }
        else if (pn < 20) { float a[8], b[8];
#pragma unroll
            for (int i = 0; i < 8; ++i) { a[i] = siluf_(v0[i]); b[i] = siluf_(v1[i]); }
            bf16* p = z + row * D_Z + (pn - 16) * 256 + cit; store8bf(p, a); store8bf(p + 128, b); }
        else if (pn < 36) { float a[8], b[8];
#pragma unroll
            for (int i = 0; i < 8; ++i) { a[i] = sigmoidf_(v0[i]); b[i] = sigmoidf_(v1[i]); }
            bf16* p = (pn < 28 ? gp + row * D + (pn - 20) * 256 : gd + row * D + (pn - 28) * 256) + cit; store8bf(p, a); store8bf(p + 128, b); }
    }
};
struct EpiPool { static constexpr bool FENCE = false;
    const bf16* gp; bf16* mp;
    __device__ __forceinline__ void store(const Unit& u, int r, int cit, const float* v0, const float* v1) const {
        const size_t off = (size_t)(u.arow0 + r) * D + u.pn * 256 + cit; float g0[8], g1[8], a[8], b[8]; load8bf(gp + off, g0); load8bf(gp + off + 128, g1);
#pragma unroll
        for (int i = 0; i < 8; ++i) { a[i] = g0[i] * v0[i]; b[i] = g1[i] * v1[i]; }
        store8bf(mp + off, a); store8bf(mp + off + 128, b);
    }
};
struct EpiMerge { static constexpr bool FENCE = false;
    const bf16* gd; const bf16* mp; bf16* mg;
    __device__ __forceinline__ void store(const Unit& u, int r, int cit, const float* v0, const float* v1) const {
        const size_t off = (size_t)(u.arow0 + r) * D + u.pn * 256 + cit; float g0[8], g1[8], m0[8], m1[8]; load8bf(gd + off, g0); load8bf(gd + off + 128, g1); load8bf(mp + off, m0); load8bf(mp + off + 128, m1);
#pragma unroll
        for (int i = 0; i < 8; ++i) { m0[i] += g0[i] * v0[i]; m1[i] += g1[i] * v1[i]; }
        store8bf(mg + off, m0); store8bf(mg + off + 128, m1);
    }
};
struct EpiResid { static constexpr bool FENCE = false;
    const float* x; float* h;
    __device__ __forceinline__ void store(const Unit& u, int r, int cit, const float* v0, const float* v1) const {
        const size_t off = (size_t)(u.arow0 + r) * D + u.pn * 256 + cit;
#pragma unroll
        for (int q = 0; q < 2; ++q) { const f32x4 a = *(const f32x4*)(x + off + 4 * q), b = *(const f32x4*)(x + off + 128 + 4 * q);
            *(f32x4*)(h + off + 4 * q) = (f32x4){a[0] + v0[4 * q], a[1] + v0[4 * q + 1], a[2] + v0[4 * q + 2], a[3] + v0[4 * q + 3]};
            *(f32x4*)(h + off + 128 + 4 * q) = (f32x4){b[0] + v1[4 * q], b[1] + v1[4 * q + 1], b[2] + v1[4 * q + 2], b[3] + v1[4 * q + 3]}; }
    }
};
struct EpiMoe1 { static constexpr bool FENCE = false;
    bf16* hmid;
    __device__ __forceinline__ void store(const Unit& u, int r, int cit, const float* v0, const float* v1) const {
        float a[8];
#pragma unroll
        for (int i = 0; i < 8; ++i) a[i] = siluf_(v0[i]) * v1[i];
        store8bf(hmid + (size_t)(u.arow0 + r) * DE + u.pn * 128 + cit, a);
    }
};
struct EpiMoe2 { static constexpr bool FENCE = true;
    const int* ltk; const float* lw; bf16 *y0, *y1;
    __device__ __forceinline__ void store(const Unit& u, int r, int cit, const float* v0, const float* v1) const {
        const size_t li = (size_t)u.e * T + u.lrow0 + r; const int tk = ltk[li]; const float w = lw[li];
        bf16* y = ((tk & 1) ? y1 : y0) + (size_t)(tk >> 1) * D + u.pn * 256 + cit; float a[8], b[8];
#pragma unroll
        for (int i = 0; i < 8; ++i) { a[i] = w * v0[i]; b[i] = w * v1[i]; }
        store8bf(y, a); store8bf(y + 128, b);
    }
};
struct EpiBf16Plain { static constexpr bool FENCE = false;
    bf16* o;
    __device__ __forceinline__ void store(const Unit& u, int r, int cit, const float* v0, const float* v1) const {
        bf16* p = o + (size_t)(u.arow0 + r) * D + u.pn * 256 + cit; store8bf(p, v0); store8bf(p + 128, v1);
    }
};
struct EpiPle { static constexpr bool FENCE = false;
    const bf16* pp; float* h;
    __device__ __forceinline__ void store(const Unit& u, int r, int cit, const float* v0, const float* v1) const {
        const size_t off = (size_t)(u.arow0 + r) * D + u.pn * 256 + cit; float p0[8], p1[8]; load8bf(pp + off, p0); load8bf(pp + off + 128, p1);
#pragma unroll
        for (int q = 0; q < 2; ++q) { const f32x4 a = *(const f32x4*)(h + off + 4 * q), b = *(const f32x4*)(h + off + 128 + 4 * q); f32x4 oa, ob;
#pragma unroll
            for (int i = 0; i < 4; ++i) { oa[i] = a[i] + sigmoidf_(v0[4 * q + i]) * p0[4 * q + i]; ob[i] = b[i] + sigmoidf_(v1[4 * q + i]) * p1[4 * q + i]; }
            *(f32x4*)(h + off + 4 * q) = oa; *(f32x4*)(h + off + 128 + 4 * q) = ob; }
    }
};

__device__ __forceinline__ void transpose_item(const float* W, int ldw, int K, int k0, int c0, int nvalid, bf16* WT, int r0, LAS float* scr, int lane) {
    (void)scr;
    const int kb = lane >> 3, nb = lane & 7; const bool ok = 4 * nb < nvalid;
    const float* src = W + (size_t)(k0 + 8 * kb) * ldw + c0 + 4 * nb;
    f32x4 v[8];
#pragma unroll
    for (int i = 0; i < 8; ++i) v[i] = ok ? *(const f32x4*)(src + (size_t)i * ldw) : (f32x4){0.f, 0.f, 0.f, 0.f};
    bf16* dst = WT + (size_t)(r0 + 4 * nb) * K + k0 + 8 * kb;
#pragma unroll
    for (int e = 0; e < 4; ++e) { v4u o; o.x = pk2(v[0][e], v[1][e]); o.y = pk2(v[2][e], v[3][e]); o.z = pk2(v[4][e], v[5][e]); o.w = pk2(v[6][e], v[7][e]); *(v4u*)(dst + (size_t)e * K) = o; }
}
__device__ __forceinline__ void transpose_job(const float* W, int K, int N, bf16* WT, LAS float* scr, int gw, int NGW, int lane) {
    const int nblk = N / 32, items = (K / 64) * nblk;
    for (int it = gw; it < items; it += NGW) { const int kb = it / nblk, nb = it % nblk; transpose_item(W, N, K, 64 * kb, 32 * nb, 32, WT, 32 * nb, scr, lane); }
}
__device__ __forceinline__ void rms_row_bf16(const float* xrow, const float* gain, bf16* orow, int lane) {
    const f32x4* xr = (const f32x4*)xrow + lane; const f32x4* gr = (const f32x4*)gain + lane;
    f32x4 v[8]; float s = 0.f;
#pragma unroll
    for (int j = 0; j < 8; ++j) { v[j] = xr[64 * j]; s += (v[j].x * v[j].x + v[j].y * v[j].y) + (v[j].z * v[j].z + v[j].w * v[j].w); }
    const float rstd = 1.0f / sqrtf(wave_sum(s) * (1.f / D) + EPS);
    v2u* o8 = (v2u*)orow + lane;
#pragma unroll
    for (int j = 0; j < 8; ++j) { const f32x4 g = gr[64 * j]; v2u o; o.x = pk2(v[j].x * rstd * g.x, v[j].y * rstd * g.y); o.y = pk2(v[j].z * rstd * g.z, v[j].w * rstd * g.w); o8[64 * j] = o; }
}


__device__ __forceinline__ void route_row(Frame& F, const LAS float* lgp, float rs, int t, LAS unsigned* lcnt, LAS int* ent, int ei) {
    float gl[4];
#pragma unroll
    for (int o = 0; o < 4; ++o) gl[o] = lgp[o] * rs + F.in[I_B_RG][o];
    int gi = 0; float gm = gl[0];
#pragma unroll
    for (int o = 1; o < 4; ++o) if (gl[o] > gm) { gm = gl[o]; gi = o; }
    float den = 0.f;
#pragma unroll
    for (int o = 0; o < 4; ++o) den += __expf(gl[o] - gm);
    const float psel = 1.0f / den;
    float le[8];
#pragma unroll
    for (int q = 0; q < 8; ++q) le[q] = lgp[4 + 8 * gi + q] * rs + F.in[I_B_RE][gi * 8 + q];
    int i0 = 0; float v0 = le[0];
#pragma unroll
    for (int q = 1; q < 8; ++q) if (le[q] > v0) { v0 = le[q]; i0 = q; }
    int i1 = -1; float v1 = -3.0e38f;
#pragma unroll
    for (int q = 0; q < 8; ++q) if (q != i0 && le[q] > v1) { v1 = le[q]; i1 = q; }
    const float e1 = __expf(v1 - v0); const float w0 = psel / (1.0f + e1), w1 = psel * e1 / (1.0f + e1);
    const int ea = gi * 8 + i0, ebx = gi * 8 + i1;
    const unsigned sa = atomicAdd((unsigned*)(lcnt + ea), 1u), sb = atomicAdd((unsigned*)(lcnt + ebx), 1u);
    ent[4 * ei + 0] = (ea << 16) | (int)sa; ent[4 * ei + 1] = 2 * t; ent[4 * ei + 2] = __float_as_int(w0); ent[4 * ei + 3] = 0;
    ent[4 * (ei + 1) + 0] = (ebx << 16) | (int)sb; ent[4 * (ei + 1) + 1] = 2 * t + 1; ent[4 * (ei + 1) + 2] = __float_as_int(w1); ent[4 * (ei + 1) + 3] = 0;
}

enum { PH_PRO = 0, PH_INPROJ, PH_TOKLOC, PH_DNA, PH_DN, PH_YDN, PH_MERGE, PH_OUT, PH_ROUTE, PH_MOE1, PH_MOE2, PH_N3, PH_PP, PH_PLE, PH_FINAL, NPHASE };
struct Args { const float* in[25]; float* out; unsigned char* ws; int ph_lo, ph_hi, flags, pad; };
__global__ void __launch_bounds__(NTHR, 2) fwd(Args args) {
    extern __shared__ __attribute__((aligned(16))) unsigned char lds_raw[];
    Frame F;
    F.lds = (LAS unsigned char*)lds_raw; F.MISC = (volatile LAS unsigned*)(F.lds + MISC_OFF);
    F.tid = threadIdx.x; F.lane = F.tid & 63; F.wave = __builtin_amdgcn_readfirstlane(F.tid >> 6);
    F.G = gridDim.x; { const int bx = blockIdx.x; F.vcu = (F.G % 8 == 0) ? (bx % 8) * (F.G / 8) + bx / 8 : bx; }
    F.ws = args.ws; F.ctl = (unsigned*)(args.ws + WS_CTL); F.out = args.out;
#pragma unroll
    for (int i = 0; i < 25; ++i) F.in[i] = args.in[i];
    for (int u = F.tid; u < MISC_WORDS; u += NTHR) F.MISC[u] = 0u;
    __syncthreads();
    XcdBarrier bar; bar.bar = F.ctl + CW_BAR; bar.x = 0; bar.st = nullptr;
    if (MK_N_LAUNCHES == 1) bar = xcd_barrier_post(F.ctl + CW_BAR, F.MISC + 8);
    const int lo = args.ph_lo, hi = args.ph_hi;
#define IN(k) (lo <= (k) && (k) < hi)
#define SEAM(k) do { if (MK_N_LAUNCHES == 1 && IN(k) && IN((k) + 1)) xcd_barrier(bar); } while (0)
    unsigned char* ws = F.ws;
    bf16* WIN = (bf16*)(ws + WS_WIN); bf16* WCOMB = (bf16*)(ws + WS_WCOMB); bf16* WUPDN = (bf16*)(ws + WS_WUPDN); bf16* WOUT = (bf16*)(ws + WS_WOUT);
    bf16* WPLEG = (bf16*)(ws + WS_WPLEG); bf16* WPLEP = (bf16*)(ws + WS_WPLEP); bf16* WGU = (bf16*)(ws + WS_WGU); bf16* WDN = (bf16*)(ws + WS_WDN);
    float* BA = (float*)(ws + WS_BA); float* GG = (float*)(ws + WS_G); float* BETA = (float*)(ws + WS_BETA);
    int* LTK = (int*)(ws + WS_LTK); float* LW = (float*)(ws + WS_LW); bf16* PBF = (bf16*)(ws + WS_PBF);
    bf16* WRH = (bf16*)(ws + WS_WRT); bf16* WRL = WRH + 48 * D;
    unsigned char* PKG = ws + WS_PKG; bf16* UT = (bf16*)(ws + WS_UT); bf16* OB = (bf16*)(ws + WS_OB);
    bf16* N1 = (bf16*)(ws + WS_N1); bf16* QKV = (bf16*)(ws + WS_QKV); float* OBUF = (float*)(ws + WS_QKV); bf16* PP = (bf16*)(ws + WS_QKV);
    bf16* MP = (bf16*)((unsigned char*)F.out + OUT_QKV2); bf16* MERGED = (bf16*)(ws + WS_QKV);     bf16* UPOOL = (bf16*)(ws + WS_UPOOL); bf16* ZS = (bf16*)(ws + WS_Z); bf16* HMID = (bf16*)(ws + WS_Z);
    bf16* GP = (bf16*)(ws + WS_GP); bf16* GD = (bf16*)(ws + WS_GD); bf16* Y0 = GP; bf16* Y1 = GD;
    bf16* DBUF = (bf16*)((unsigned char*)F.out + OUT_D); bf16* QKV2 = (bf16*)((unsigned char*)F.out + OUT_QKV2); float* H = F.out;
    const int gw = F.vcu * NWAVES + F.wave, NGW = F.G * NWAVES, lane = F.lane;

    if (IN(PH_PRO)) {
        LAS float* scr = (LAS float*)(F.lds + RING_OFF + F.wave * 16384);
        {
            const int nblk = N_IN_PAD / 32, items = (D / 64) * nblk;
            for (int it = gw; it < items; it += NGW) { const int kb = it / nblk, nb = it % nblk, r0 = 32 * nb; int c0, nv;
                if (r0 < 5120) { c0 = r0; nv = 32; } else { c0 = r0 + 16; nv = 32; }
                transpose_item(F.in[I_W_IN], D_IN, D, 64 * kb, c0, nv, WIN, r0, scr, lane); }
        }
        transpose_job(F.in[I_W_UP_DN], D_Z, D, WUPDN, scr, gw, NGW, lane);
        transpose_job(F.in[I_W_OUT], D, D, WOUT, scr, gw, NGW, lane);
        transpose_job(F.in[I_W_PLE_GATE], D, D, WPLEG, scr, gw, NGW, lane);
        transpose_job(F.in[I_W_PLE_PROJ], D_PLE, D, WPLEP, scr, gw, NGW, lane);
        {
            const float* pw = F.in[I_POOL_W]; const float* ps = F.in[I_POOL_SCALE]; const float* wu = F.in[I_W_UP_POOL];
            const int items = (D_POOL / 8) * (D / 64);
            for (int it = gw; it < items; it += NGW) { const int kg = it / (D / 64), nb = it % (D / 64), k0 = 8 * kg, g = k0 >> 8, kk0 = k0 & 255, n = 64 * nb + lane;
                float acc[8];
#pragma unroll
                for (int i = 0; i < 8; ++i) acc[i] = 0.f;
                for (int j = 0; j < POOL_GW; ++j) { const float wv = wu[(size_t)(256 * g + j) * D + n] * ps[256 * g + j];
#pragma unroll
                    for (int i = 0; i < 8; ++i) acc[i] += pw[(size_t)g * POOL_GW * POOL_GW + (size_t)(kk0 + i) * POOL_GW + j] * wv; }
                store8bf(WCOMB + (size_t)n * D_POOL + k0, acc); }
        }
        {
            const float* gm = F.in[I_NORM_MOE]; const float* wrg = F.in[I_W_RG]; const float* wre = F.in[I_W_RE];
            for (int idx = gw * 64 + lane; idx < 48 * D; idx += NGW * 64) { const int n = idx / D, k = idx % D;
                const float v = n < 4 ? gm[k] * wrg[(size_t)k * NGRP + n] : (n < 36 ? gm[k] * wre[(size_t)k * NE + (n - 4)] : 0.f);
                const unsigned hi = f2bf(v); WRH[idx] = (bf16)hi; WRL[idx] = (bf16)f2bf(v - __uint_as_float(hi << 16)); }
        }
        {
            const float* gain = F.in[I_NORM_MIX]; const float* win = F.in[I_W_IN];
            __syncthreads();
            LAS float* LGp = (LAS float*)(F.lds + RING_OFF);
            LAS float* SSp = LGp + 8 * 256;
            LAS float* RS = SSp + 128;
            const int row = lane & 15, g = lane >> 4, wv = F.wave;
            bf16x8 wbh[8], wbl[8];
#pragma unroll
            for (int J = 0; J < 8; ++J) { unsigned hh[4], ll[4];
#pragma unroll
                for (int q = 0; q < 4; ++q) { const int k = 256 * wv + 32 * J + 8 * g + 2 * q; const float v0 = gain[k] * win[(size_t)k * D_IN + 5120 + row], v1 = gain[k + 1] * win[(size_t)(k + 1) * D_IN + 5120 + row];
                    hh[q] = pk2(v0, v1); ll[q] = pk2(v0 - bflo(hh[q]), v1 - bfhi(hh[q])); }
                wbh[J] = __builtin_bit_cast(bf16x8, (v4u){hh[0], hh[1], hh[2], hh[3]}); wbl[J] = __builtin_bit_cast(bf16x8, (v4u){ll[0], ll[1], ll[2], ll[3]}); }
            for (int task = F.vcu; task < T / 16; task += F.G) {
                const int r0 = task * 16; const float* hp_ = F.in[I_X] + (size_t)(r0 + row) * D + 256 * wv + 8 * g;
                f32x4 a[8][2];
#pragma unroll
                for (int J = 0; J < 8; ++J) { a[J][0] = *(const f32x4*)(hp_ + 32 * J); a[J][1] = *(const f32x4*)(hp_ + 32 * J + 4); }
                f32x4 acc = (f32x4){0.f, 0.f, 0.f, 0.f}; float ss = 0.f;
#pragma unroll
                for (int J = 0; J < 8; ++J) { const f32x4 x0 = a[J][0], x1 = a[J][1];
                    ss += ((x0.x * x0.x + x0.y * x0.y) + (x0.z * x0.z + x0.w * x0.w)) + ((x1.x * x1.x + x1.y * x1.y) + (x1.z * x1.z + x1.w * x1.w));
                    const unsigned h0 = pk2(x0.x, x0.y), h1 = pk2(x0.z, x0.w), h2_ = pk2(x1.x, x1.y), h3 = pk2(x1.z, x1.w);
                    const unsigned l0 = pk2(x0.x - bflo(h0), x0.y - bfhi(h0)), l1 = pk2(x0.z - bflo(h1), x0.w - bfhi(h1)), l2 = pk2(x1.x - bflo(h2_), x1.y - bfhi(h2_)), l3 = pk2(x1.z - bflo(h3), x1.w - bfhi(h3));
                    const bf16x8 ah = __builtin_bit_cast(bf16x8, (v4u){h0, h1, h2_, h3}), al = __builtin_bit_cast(bf16x8, (v4u){l0, l1, l2, l3});
                    acc = __builtin_amdgcn_mfma_f32_16x16x32_bf16(ah, wbh[J], acc, 0, 0, 0); acc = __builtin_amdgcn_mfma_f32_16x16x32_bf16(al, wbh[J], acc, 0, 0, 0); acc = __builtin_amdgcn_mfma_f32_16x16x32_bf16(ah, wbl[J], acc, 0, 0, 0); }
                ss += __shfl_xor(ss, 16); ss += __shfl_xor(ss, 32);
                LDS_BARRIER();
#pragma unroll
                for (int reg = 0; reg < 4; ++reg) LGp[wv * 256 + (4 * g + reg) * 16 + row] = acc[reg];
                if (g == 0) SSp[wv * 16 + row] = ss;
                LDS_BARRIER();
                if (F.tid < 16) { float s8 = 0.f;
#pragma unroll
                    for (int w8 = 0; w8 < 8; ++w8) s8 += SSp[w8 * 16 + F.tid];
                    RS[F.tid] = 1.0f / sqrtf(s8 * (1.f / D) + EPS); }
                LDS_BARRIER();
                if (F.tid < 256) { float s8 = 0.f;
#pragma unroll
                    for (int w8 = 0; w8 < 8; ++w8) s8 += LGp[w8 * 256 + F.tid];
                    BA[(size_t)(r0 + (F.tid >> 4)) * 16 + (F.tid & 15)] = s8 * RS[F.tid >> 4]; }
                {   const float rs = RS[row]; bf16* op = N1 + (size_t)(r0 + row) * D + 256 * wv + 8 * g; const float* gp = gain + 256 * wv + 8 * g;
#pragma unroll
                    for (int J = 0; J < 8; ++J) { const f32x4 g0 = *(const f32x4*)(gp + 32 * J), g1 = *(const f32x4*)(gp + 32 * J + 4); const f32x4 x0 = a[J][0], x1 = a[J][1];
                        v4u o; o.x = pk2(x0.x * rs * g0.x, x0.y * rs * g0.y); o.y = pk2(x0.z * rs * g0.z, x0.w * rs * g0.w); o.z = pk2(x1.x * rs * g1.x, x1.y * rs * g1.y); o.w = pk2(x1.z * rs * g1.z, x1.w * rs * g1.w);
                        *(v4u*)(op + 32 * J) = o; }
                }
            }
            __syncthreads();
        }
        for (int m = gw; m < T; m += NGW) { const f32x4 v = *((const f32x4*)(F.in[I_P] + (size_t)m * D_PLE) + lane); v2u o; o.x = pk2(v.x, v.y); o.y = pk2(v.z, v.w); *((v2u*)(PBF + (size_t)m * D_PLE) + lane) = o; }
    }
    SEAM(PH_PRO);
    if (IN(PH_INPROJ)) {
        pg8::DenseOrder S; S.init(T, N_IN_PAD, D, F.G, (int)blockIdx.x);
        EpiInProj E{UPOOL, QKV, ZS, GP, GD, BA};
        pg8::gemm_phase<EpiInProj, pg8::DenseOrder, false>(F.lds + RING_OFF, N1, WIN, D, S, E);
    }
    SEAM(PH_INPROJ);
    if (IN(PH_TOKLOC)) {
        const float* cw = F.in[I_CONV_W];
        LAS float* red = (LAS float*)(F.lds + RING_OFF + F.wave * 4608);
        LAS float* SC = red + 1024;
        for (int item = gw; item < 2048 * 12; item += NGW) {
            const int run = item / 12, blk = item % 12, t0 = run * 16, s0 = t0 % SEQ, c = blk * 256 + 4 * lane;
            v2u u[19];
#pragma unroll
            for (int i = 0; i < 19; ++i) { u[i] = (s0 - 3 + i >= 0) ? *(const v2u*)(QKV + (size_t)(t0 - 3 + i) * D_QKV + c) : (v2u){0u, 0u}; }
            f32x4 w[4];
#pragma unroll
            for (int kk = 0; kk < 4; ++kk) w[kk] = *(const f32x4*)(cw + kk * D_QKV + c);
            f32x4 y[16];
#pragma unroll
            for (int tt = 0; tt < 16; ++tt) { f32x4 a = (f32x4){0.f, 0.f, 0.f, 0.f};
#pragma unroll
                for (int kk = 0; kk < 4; ++kk) { const v2u x = u[tt + kk]; a.x += bflo(x.x) * w[kk].x; a.y += bfhi(x.x) * w[kk].y; a.z += bflo(x.y) * w[kk].z; a.w += bfhi(x.y) * w[kk].w; }
                a.x = siluf_(a.x); a.y = siluf_(a.y); a.z = siluf_(a.z); a.w = siluf_(a.w); y[tt] = a; }
            if (blk < 8) {
#pragma unroll
                for (int tt = 0; tt < 16; ++tt) red[tt * 64 + lane] = (y[tt].x * y[tt].x + y[tt].y * y[tt].y) + (y[tt].z * y[tt].z + y[tt].w * y[tt].w);
                asm volatile("s_waitcnt lgkmcnt(0)" ::: "memory");
                {   const int tt = lane & 15, hd = (lane >> 4) & 1, part = lane >> 5; float sm = 0.f;
#pragma unroll
                    for (int i = 0; i < 16; ++i) sm += red[tt * 64 + hd * 32 + part * 16 + ((i + lane) & 15)];
                    sm += __shfl_xor(sm, 32);
                    float rr = 1.0f / sqrtf(sm + EPS); if (blk < 4) rr *= 0.08838834764831845f;
                    if (part == 0) SC[hd * 16 + tt] = rr; }
                asm volatile("s_waitcnt lgkmcnt(0)" ::: "memory");
#pragma unroll
                for (int q4 = 0; q4 < 4; ++q4) { const f32x4 sc = *(const LAS f32x4*)(SC + (lane >> 5) * 16 + 4 * q4);
#pragma unroll
                    for (int i = 0; i < 4; ++i) y[4 * q4 + i] = y[4 * q4 + i] * sc[i]; }
                asm volatile("s_waitcnt lgkmcnt(0)" ::: "memory");
            }
#pragma unroll
            for (int tt = 0; tt < 16; ++tt) { v2u o; o.x = pk2(y[tt].x, y[tt].y); o.y = pk2(y[tt].z, y[tt].w); *(v2u*)(QKV2 + (size_t)(t0 + tt) * D_QKV + c) = o; }
        }
        for (int item = gw; item < 1024 * 4; item += NGW) {
            const int run = item >> 2, gi = item & 3, t0 = run * 32, s0 = t0 % SEQ, c = gi * 256 + 4 * lane;
#define POOL_BODY(W) { v2u u[31 + W]; \
                _Pragma("unroll") for (int i = 0; i < 31 + W; ++i) u[i] = (s0 - (W - 1) + i >= 0) ? *(const v2u*)(UPOOL + (size_t)(t0 - (W - 1) + i) * D_POOL + c) : (v2u){0u, 0u}; \
                _Pragma("unroll") for (int tt = 0; tt < 32; ++tt) { f32x4 sm = (f32x4){0.f, 0.f, 0.f, 0.f}; \
                    _Pragma("unroll") for (int j = 0; j < W; ++j) { const v2u x = u[tt + j]; sm.x += bflo(x.x); sm.y += bfhi(x.x); sm.z += bflo(x.y); sm.w += bfhi(x.y); } \
                    const v2u xc = u[tt + W - 1]; const float inv = 1.0f / (float)((s0 + tt + 1) < W ? (s0 + tt + 1) : W); \
                    v2u o; o.x = pk2(sm.x * inv - bflo(xc.x), sm.y * inv - bfhi(xc.x)); o.y = pk2(sm.z * inv - bflo(xc.y), sm.w * inv - bfhi(xc.y)); \
                    *(v2u*)(DBUF + (size_t)(t0 + tt) * D_POOL + c) = o; } }
            if (gi == 0) POOL_BODY(2) else if (gi == 1) POOL_BODY(4) else if (gi == 2) POOL_BODY(8) else POOL_BODY(16)
#undef POOL_BODY
        }
        for (int idx = gw * 64 + lane; idx < T * NH; idx += NGW * 64) { const int t = idx >> 3, hh = idx & 7; const float bl = BA[(size_t)t * 16 + hh], al = BA[(size_t)t * 16 + 8 + hh]; const float xx = al + F.in[I_DT_BIAS][hh];
            const float sp = xx > 20.f ? xx : log1pf(__expf(xx)); GG[idx] = -__expf(F.in[I_A_LOG][hh]) * sp; BETA[idx] = sigmoidf_(bl); }
    }
    SEAM(PH_TOKLOC);
    if (IN(PH_DNA)) {
        const int hb = F.tid >> 8, t4 = F.tid & 255, wq = t4 >> 6;
        LAS unsigned char* hl = F.lds + RING_OFF + hb * 62464;
        LAS bf16* Ks = (LAS bf16*)hl;
        LAS bf16* Qs = Ks + 64 * 136;
        LAS float* Ls = (LAS float*)(hl + 2 * 17408);
        LAS float* gs = (LAS float*)(hl + 3 * 17408);
        LAS bf16* IMG = (LAS bf16*)(hl + 3 * 17408 + 2048);
        LAS bf16* UWI = Qs;
        for (int up = F.vcu; up < DN_UNITS / 2; up += F.G) {
            const int unit = up * 2 + hb, bh = unit >> 7, cch = unit & 127, b = bh >> 3, h = bh & 7; const size_t tok0 = (size_t)b * SEQ + (size_t)cch * 64;
            unsigned char* pk = PKG + (size_t)unit * PKG_BYTES; bf16* pW = (bf16*)pk; bf16* pQ = (bf16*)(pk + 16384); bf16* pA = (bf16*)(pk + 32768); bf16* pKT = (bf16*)(pk + 40960); float* pS = (float*)(pk + 57344);
            bf16* pU = UT + (size_t)unit * 8192;
            float x[64];
            if (t4 < 128) {
#pragma unroll
                for (int i = 0; i < 64; ++i) x[i] = bf2f(QKV2[(tok0 + i) * D_QKV + 2048 + h * 128 + t4]);
            }
            LDS_BARRIER();
            if (t4 < 64) { gs[t4] = GG[(tok0 + t4) * NH + h]; gs[64 + t4] = BETA[(tok0 + t4) * NH + h]; }
#pragma unroll
            for (int i = 0; i < 4; ++i) { const int idx = t4 + 256 * i, row = idx >> 4, ch = idx & 15;
                *(LAS v4u*)(Ks + row * 136 + ch * 8) = *(const v4u*)(QKV2 + (tok0 + row) * D_QKV + 1024 + h * 128 + ch * 8);
                *(LAS v4u*)(Qs + row * 136 + ch * 8) = *(const v4u*)(QKV2 + (tok0 + row) * D_QKV + h * 128 + ch * 8); }
            LDS_BARRIER();
            if (t4 < 64) {
                float a = gs[t4];
#pragma unroll
                for (int o = 1; o < 64; o <<= 1) { const float tv = __shfl_up(a, o); if (lane >= o) a += tv; }
                gs[128 + t4] = a; }
            LDS_BARRIER();
            if (t4 < 64) { const float gl = gs[128 + 63], gc = gs[128 + t4]; gs[192 + t4] = __expf(gc); gs[256 + t4] = __expf(gl - gc); }
            {
                const int c = lane & 15, gq = lane >> 4;
                f32x4 kk[4], qk[4];
#pragma unroll
                for (int jb = 0; jb < 4; ++jb) { kk[jb] = (f32x4){0.f, 0.f, 0.f, 0.f}; qk[jb] = (f32x4){0.f, 0.f, 0.f, 0.f}; }
#pragma unroll
                for (int ks = 0; ks < 4; ++ks) {
                    const bf16x8 aK = *(const LAS bf16x8*)(Ks + (16 * wq + c) * 136 + 32 * ks + 8 * gq), aQ = *(const LAS bf16x8*)(Qs + (16 * wq + c) * 136 + 32 * ks + 8 * gq);
#pragma unroll
                    for (int jb = 0; jb < 4; ++jb) { const bf16x8 bK = *(const LAS bf16x8*)(Ks + (16 * jb + c) * 136 + 32 * ks + 8 * gq);
                        kk[jb] = __builtin_amdgcn_mfma_f32_16x16x32_bf16(aK, bK, kk[jb], 0, 0, 0); qk[jb] = __builtin_amdgcn_mfma_f32_16x16x32_bf16(aQ, bK, qk[jb], 0, 0, 0); }
                }
#pragma unroll
                for (int reg = 0; reg < 4; ++reg) { const int row = 16 * wq + 4 * gq + reg; const float gi = gs[128 + row], bi = gs[64 + row];
#pragma unroll
                    for (int jb = 0; jb < 4; ++jb) { const int col = 16 * jb + c; const float dec = (row >= col) ? __expf(gi - gs[128 + col]) : 0.f;
                        Ls[row * 68 + col] = (row > col) ? -(bi * kk[jb][reg] * dec) : 0.f;
                        IMG[tix(row, col, 4)] = (bf16)f2bf(qk[jb][reg] * dec); } }
            }
#pragma unroll 1
            for (int it = 0; it < 4; ++it) { const int sl = t4 + 256 * it, fr_ = sl >> 6, lp = sl & 63, hh = lp >> 5, r = lp & 31;
                {   const int rt = fr_ >> 3, s = fr_ & 7, row = 32 * rt + r, k0 = 16 * s + 4 * hh; const float eg = __expf(gs[128 + row]);
                    const v2u q0 = *(const LAS v2u*)(Qs + row * 136 + k0), q1 = *(const LAS v2u*)(Qs + row * 136 + k0 + 8);
                    v4u o; o.x = pk2(bflo(q0.x) * eg, bfhi(q0.x) * eg); o.y = pk2(bflo(q0.y) * eg, bfhi(q0.y) * eg); o.z = pk2(bflo(q1.x) * eg, bfhi(q1.x) * eg); o.w = pk2(bflo(q1.y) * eg, bfhi(q1.y) * eg);
                    *(v4u*)(pQ + sl * 8) = o; }
                {   const int rt = fr_ >> 2, s = fr_ & 3, dk = 32 * rt + r, i0 = 16 * s + 4 * hh; float kv[8]; const float gl_ = gs[128 + 63];
#pragma unroll
                    for (int e = 0; e < 4; ++e) { kv[e] = bf2f(Ks[(i0 + e) * 136 + dk]) * __expf(gl_ - gs[128 + i0 + e]); kv[4 + e] = bf2f(Ks[(i0 + 8 + e) * 136 + dk]) * __expf(gl_ - gs[128 + i0 + 8 + e]); }
                    v4u o; o.x = pk2(kv[0], kv[1]); o.y = pk2(kv[2], kv[3]); o.z = pk2(kv[4], kv[5]); o.w = pk2(kv[6], kv[7]);
                    *(v4u*)(pKT + sl * 8) = o; } }
            if (t4 == 0) pS[128] = __expf(gs[128 + 63]);
            LDS_BARRIER();
#pragma unroll
            for (int i = 0; i < 2; ++i) { const int idx = t4 + 256 * i; *(v4u*)(pA + idx * 8) = *(const LAS v4u*)(IMG + idx * 8); }
            {
                if (t4 < 128) {
#pragma unroll
                    for (int i = 0; i < 64; ++i) x[i] *= gs[64 + i];
                } else {
#pragma unroll
                    for (int i = 0; i < 64; ++i) x[i] = gs[64 + i] * bf2f(Ks[i * 136 + (t4 - 128)]) * gs[192 + i];
                }
                SolveRows<60>::run(x, Ls, lane & 15);
            }
            LDS_BARRIER();
            if (t4 < 128) { const int w = t4 >> 5, c = t4 & 31;
#pragma unroll
                for (int i = 0; i < 64; ++i) { const int rt = i >> 5, i32 = i & 31, hh = (i32 >> 2) & 1, reg = (i32 & 3) + 4 * (i32 >> 3); UWI[(((w * 2 + rt) * 64 + hh * 32 + c) << 4) + reg] = (bf16)f2bf(x[i]); }
            } else { const int dk = t4 - 128;
#pragma unroll
                for (int i = 0; i < 64; ++i) UWI[8192 + tix(i, dk, 8)] = (bf16)f2bf(-x[i]);
            }
            LDS_BARRIER();
#pragma unroll
            for (int i = 0; i < 4; ++i) { const int idx = t4 + 256 * i; *(v4u*)(pU + idx * 8) = *(const LAS v4u*)(UWI + idx * 8); *(v4u*)(pW + idx * 8) = *(const LAS v4u*)(UWI + 8192 + idx * 8); }
        }
        __syncthreads();
    }
    SEAM(PH_DNA);
    if (IN(PH_DN)) {
        if ((int)blockIdx.x < NB * NH) { if (!(args.flags & 1)) {
            const int bh = (int)blockIdx.x, b = bh >> 3, hh = bh & 7; const size_t tokb = (size_t)b * SEQ;
            const unsigned char* pkg0 = PKG + (size_t)bh * 128 * PKG_BYTES; const bf16* ut0 = UT + (size_t)bh * 128 * 8192;
            const bool loader = F.wave >= 4; const int lt = F.tid - 256;
            if (loader) {
                v4u la[19], lb[19];
                constexpr int NCH = STG_BYTES / 16, NPK = PKG_BYTES / 16;
#define DN_LD(dst, pn) do { const int pn_ = (pn) < 127 ? (pn) : 127; const unsigned char* src_ = pkg0 + (size_t)pn_ * PKG_BYTES; const unsigned char* usrc_ = (const unsigned char*)(ut0 + (size_t)pn_ * 8192); _Pragma("unroll") for (int i = 0; i < 19; ++i) { int idx = lt + 256 * i; idx = idx < NCH ? idx : NCH - 1; \
        dst[i] = __builtin_nontemporal_load((const v4u*)((idx < NPK) ? (src_ + (size_t)idx * 16) : (usrc_ + (size_t)(idx - NPK) * 16))); } } while (0)
#define DN_ST(srcr, stg) do { _Pragma("unroll") for (int i = 0; i < 19; ++i) { const int idx = lt + 256 * i; if (idx < NCH) *(LAS v4u*)(F.lds + RING_OFF + (stg) * STG_BYTES + idx * 16) = srcr[i]; } } while (0)
                DN_LD(la, 0); DN_ST(la, 0); DN_LD(la, 1); DN_LD(lb, 2);
                for (int n = 0; n < 128; n += 2) {
                    LDS_BARRIER();
                    DN_ST(la, 1); DN_LD(la, n + 3);
                    LDS_BARRIER();
                    DN_ST(lb, 0); DN_LD(lb, n + 4);
                }
#undef DN_LD
#undef DN_ST
            } else {
            const int w = F.wave & 3, r = lane & 31, h2 = lane >> 5;
            f32x16 S[4]; bf16x8 Sb[8];
#pragma unroll
            for (int d = 0; d < 4; ++d)
#pragma unroll
                for (int i = 0; i < 16; ++i) S[d][i] = 0.f;
#pragma unroll
            for (int s = 0; s < 8; ++s)
#pragma unroll
                for (int i = 0; i < 8; ++i) Sb[s][i] = 0;
            for (int n = 0; n < 128; ++n) {
                LDS_BARRIER();
                {
                    LAS unsigned char* st = F.lds + RING_OFF + (n & 1) * STG_BYTES;
                    const LAS float* sc = (const LAS float*)(st + 57344);
#define FRAG(off, f) (*(const LAS bf16x8*)(st + (off) + (f) * 1024 + lane * 16))
#define MF(a, b, c) __builtin_amdgcn_mfma_f32_32x32x16_bf16((a), (b), (c), 0, 0, 0)
#define SB() __builtin_amdgcn_sched_barrier(0)
                    f32x16 vn[2], qs[2];
#pragma unroll
                    for (int rt = 0; rt < 2; ++rt) {
#pragma unroll
                        for (int q = 0; q < 2; ++q) { const v4u u4 = *(const LAS v4u*)(st + PKG_BYTES + (((w * 2 + rt) * 64 + lane) << 5) + q * 16);
                            vn[rt][8 * q + 0] = bflo(u4.x); vn[rt][8 * q + 1] = bfhi(u4.x); vn[rt][8 * q + 2] = bflo(u4.y); vn[rt][8 * q + 3] = bfhi(u4.y);
                            vn[rt][8 * q + 4] = bflo(u4.z); vn[rt][8 * q + 5] = bfhi(u4.z); vn[rt][8 * q + 6] = bflo(u4.w); vn[rt][8 * q + 7] = bfhi(u4.w); }
#pragma unroll
                        for (int i = 0; i < 16; ++i) qs[rt][i] = 0.f; }
                    bf16x8 fa[4], fb[4];
                    fa[0] = FRAG(0, 0); fa[1] = FRAG(0, 8); fa[2] = FRAG(16384, 0); fa[3] = FRAG(16384, 8);
                    fb[0] = FRAG(0, 1); fb[1] = FRAG(0, 9); fb[2] = FRAG(16384, 1); fb[3] = FRAG(16384, 9);
                    SB();
#pragma unroll
                    for (int s = 0; s < 8; s += 2) {
                        vn[0] = MF(fa[0], Sb[s], vn[0]); vn[1] = MF(fa[1], Sb[s], vn[1]); qs[0] = MF(fa[2], Sb[s], qs[0]); qs[1] = MF(fa[3], Sb[s], qs[1]);
                        SB();
                        if (s + 2 < 8) { fa[0] = FRAG(0, s + 2); fa[1] = FRAG(0, 8 + s + 2); fa[2] = FRAG(16384, s + 2); fa[3] = FRAG(16384, 8 + s + 2); }
                        SB();
                        vn[0] = MF(fb[0], Sb[s + 1], vn[0]); vn[1] = MF(fb[1], Sb[s + 1], vn[1]); qs[0] = MF(fb[2], Sb[s + 1], qs[0]); qs[1] = MF(fb[3], Sb[s + 1], qs[1]);
                        SB();
                        if (s + 3 < 8) { fb[0] = FRAG(0, s + 3); fb[1] = FRAG(0, 8 + s + 3); fb[2] = FRAG(16384, s + 3); fb[3] = FRAG(16384, 8 + s + 3); }
                        SB();
                    }
                    bf16x8 ga[6], gb[6];
#define LD6(dst, sp) do { dst[0] = FRAG(32768, sp); dst[1] = FRAG(32768, 4 + (sp)); dst[2] = FRAG(40960, sp); dst[3] = FRAG(40960, 4 + (sp)); dst[4] = FRAG(40960, 8 + (sp)); dst[5] = FRAG(40960, 12 + (sp)); } while (0)
                    LD6(ga, 0); LD6(gb, 1);
                    const float egl = sc[128];
                    SB();
                    bf16x8 vb[4];
#pragma unroll
                    for (int sp = 0; sp < 4; ++sp) { const int rt = sp >> 1, base = 8 * (sp & 1); unsigned pv[4];
#pragma unroll
                        for (int jj = 0; jj < 4; ++jj) pv[jj] = pk2(vn[rt][base + 2 * jj], vn[rt][base + 2 * jj + 1]);
                        vb[sp] = __builtin_bit_cast(bf16x8, (v4u){pv[0], pv[1], pv[2], pv[3]}); }
#pragma unroll
                    for (int d = 0; d < 4; ++d)
#pragma unroll
                        for (int i = 0; i < 16; ++i) S[d][i] *= egl;
                    SB();
#pragma unroll
                    for (int sp = 0; sp < 4; sp += 2) {
                        qs[0] = MF(ga[0], vb[sp], qs[0]); qs[1] = MF(ga[1], vb[sp], qs[1]); S[0] = MF(ga[2], vb[sp], S[0]); S[1] = MF(ga[3], vb[sp], S[1]); S[2] = MF(ga[4], vb[sp], S[2]); S[3] = MF(ga[5], vb[sp], S[3]);
                        SB();
                        if (sp + 2 < 4) LD6(ga, sp + 2);
                        SB();
                        qs[0] = MF(gb[0], vb[sp + 1], qs[0]); qs[1] = MF(gb[1], vb[sp + 1], qs[1]); S[0] = MF(gb[2], vb[sp + 1], S[0]); S[1] = MF(gb[3], vb[sp + 1], S[1]); S[2] = MF(gb[4], vb[sp + 1], S[2]); S[3] = MF(gb[5], vb[sp + 1], S[3]);
                        SB();
                        if (sp + 3 < 4) LD6(gb, sp + 3);
                        SB();
                    }
#undef LD6
#undef FRAG
#undef MF
#undef SB
#pragma unroll
                    for (int s = 0; s < 8; ++s) { const int d = s >> 1, base = 8 * (s & 1); unsigned pv[4];
#pragma unroll
                        for (int jj = 0; jj < 4; ++jj) pv[jj] = pk2(S[d][base + 2 * jj], S[d][base + 2 * jj + 1]);
                        Sb[s] = __builtin_bit_cast(bf16x8, (v4u){pv[0], pv[1], pv[2], pv[3]}); }
                    {
                        LAS bf16* ot = (LAS bf16*)(F.lds + OT_OFF + w * 2048);
                        bf16* ob = OB + (tokb + (size_t)n * 64 + (lane >> 1)) * D_Z + hh * 128 + 32 * w + 16 * (lane & 1);
#pragma unroll
                        for (int rt = 0; rt < 2; ++rt) {
#pragma unroll
                            for (int rp = 0; rp < 8; ++rp) { const int reg = 2 * rp, row = (reg & 3) + 8 * (reg >> 2) + 4 * h2; const unsigned pv = pk2(qs[rt][reg], qs[rt][reg + 1]);
                                ot[row * 32 + r] = (bf16)(pv & 0xffffu); ot[(row + 1) * 32 + r] = (bf16)(pv >> 16); }
                            asm volatile("s_waitcnt lgkmcnt(0)" ::: "memory");
                            const v4u o0 = *(const LAS v4u*)(ot + (lane >> 1) * 32 + 16 * (lane & 1)), o1 = *(const LAS v4u*)(ot + (lane >> 1) * 32 + 16 * (lane & 1) + 8);
                            asm volatile("s_waitcnt lgkmcnt(0)" ::: "memory");
                            *(v4u*)(ob + (size_t)(32 * rt) * D_Z) = o0; *(v4u*)(ob + (size_t)(32 * rt) * D_Z + 8) = o1; } }
                }
            }
            }
        } } else if (!(args.flags & 2)) {
            pg8::DenseOrder S; S.init(T, D, D_POOL, F.G - NB * NH, (int)blockIdx.x - NB * NH); EpiPool E{GP, MP};
            pg8::gemm_phase<EpiPool, pg8::DenseOrder, false>(F.lds + RING_OFF, DBUF, WCOMB, D_POOL, S, E);
            __syncthreads();
            LAS float* scr = (LAS float*)(F.lds + RING_OFF + F.wave * 16384);
            const int gw2 = ((int)blockIdx.x - NB * NH) * NWAVES + F.wave, NGW2 = (F.G - NB * NH) * NWAVES;
        {
            const int items = NE * (D / 64) * 32;
            for (int it = gw2; it < items; it += NGW2) { const int e = it / (32 * 32), rem = it % (32 * 32), kb = rem / 32, nb = rem % 32;
                const int r0 = 32 * nb, pn = r0 >> 8, rin = r0 & 255; const bool up = rin >= 128; const int c0 = pn * 128 + (rin & 127);
                transpose_item((up ? F.in[I_W_UP] : F.in[I_W_GATE]) + (size_t)e * D * DE, DE, D, 64 * kb, c0, 32, WGU + (size_t)e * 1024 * D, r0, scr, lane); }
        }
        {
            const int per = (DE / 64) * (D / 32), items = NE * per;
            for (int it = gw2; it < items; it += NGW2) { const int e = it / per, rem = it % per, kb = rem / (D / 32), nb = rem % (D / 32);
                transpose_item(F.in[I_W_DOWN] + (size_t)e * DE * D, D, DE, 64 * kb, 32 * nb, 32, WDN + (size_t)e * D * DE, 32 * nb, scr, lane); }
        }
        }
        __syncthreads();
    }
    SEAM(PH_DN);
    if (IN(PH_YDN)) {
        bf16* YDN = N1; const float* dn = F.in[I_DN_NORM];
        for (int it = gw; it < T * NH; it += NGW) { const int t = it / NH, h = it % NH; const size_t off = (size_t)t * D_Z + h * 128 + 2 * lane;
            const unsigned ou = *(const unsigned*)(OB + off); const float o0 = bflo(ou), o1 = bfhi(ou); const float r = 1.0f / sqrtf(wave_sum(o0 * o0 + o1 * o1) * (1.f / 128.f) + EPS);
            const unsigned zu = *(const unsigned*)(ZS + off); *(unsigned*)(YDN + off) = pk2(o0 * r * dn[2 * lane] * bflo(zu), o1 * r * dn[2 * lane + 1] * bfhi(zu)); }
    }
    SEAM(PH_YDN);
    if (IN(PH_MERGE)) { pg8::DenseOrder S; S.init(T, D, D_Z, F.G, (int)blockIdx.x); EpiMerge E{GD, MP, MERGED}; pg8::gemm_phase<EpiMerge, pg8::DenseOrder, false>(F.lds + RING_OFF, N1, WUPDN, D_Z, S, E); }
    SEAM(PH_MERGE);
    if (IN(PH_OUT)) { pg8::DenseOrder S; S.init(T, D, D, F.G, (int)blockIdx.x); EpiResid E{F.in[I_X], H}; pg8::gemm_phase<EpiResid, pg8::DenseOrder, false>(F.lds + RING_OFF, MERGED, WOUT, D, S, E); }
    SEAM(PH_OUT);
    if (IN(PH_ROUTE)) {
        const float* gain = F.in[I_NORM_MOE];
        LAS float* LGp = (LAS float*)(F.lds + RING_OFF);
        LAS float* LGs = LGp + 8 * 768;
        LAS float* SSp = LGs + 768;
        LAS float* RS = SSp + 128;
        LAS unsigned* LCNT = (LAS unsigned*)(RS + 16);
        LAS int* ENT = (LAS int*)(LCNT + 64);
        if (F.tid < 64) LCNT[F.tid] = 0u;
        int ntok = 0;
        __syncthreads();
        const int row = lane & 15, g = lane >> 4, wv = F.wave;
        const bf16* wph = WRH + (size_t)row * D + 256 * wv + 8 * g;
#define RT_LOAD(dst, tsk) do { const float* hp_ = H + (size_t)((tsk) * 16 + row) * D + 256 * wv + 8 * g; _Pragma("unroll") for (int J = 0; J < 8; ++J) { dst[J][0] = *(const f32x4*)(hp_ + 32 * J); dst[J][1] = *(const f32x4*)(hp_ + 32 * J + 4); } } while (0)
#define RT_BODY(a, an, task, ntask) do { \
            const int r0 = (task) * 16; \
            f32x4 acc0 = (f32x4){0.f, 0.f, 0.f, 0.f}, acc1 = acc0, acc2 = acc0; float ss = 0.f; \
            _Pragma("unroll") for (int J = 0; J < 8; ++J) { \
                const f32x4 x0 = a[J][0], x1 = a[J][1]; \
                ss += ((x0.x * x0.x + x0.y * x0.y) + (x0.z * x0.z + x0.w * x0.w)) + ((x1.x * x1.x + x1.y * x1.y) + (x1.z * x1.z + x1.w * x1.w)); \
                const unsigned h0 = pk2(x0.x, x0.y), h1 = pk2(x0.z, x0.w), h2_ = pk2(x1.x, x1.y), h3 = pk2(x1.z, x1.w); \
                const unsigned l0 = pk2(x0.x - bflo(h0), x0.y - bfhi(h0)), l1 = pk2(x0.z - bflo(h1), x0.w - bfhi(h1)), l2 = pk2(x1.x - bflo(h2_), x1.y - bfhi(h2_)), l3 = pk2(x1.z - bflo(h3), x1.w - bfhi(h3)); \
                const bf16x8 ah = __builtin_bit_cast(bf16x8, (v4u){h0, h1, h2_, h3}), al = __builtin_bit_cast(bf16x8, (v4u){l0, l1, l2, l3}); \
                acc0 = __builtin_amdgcn_mfma_f32_16x16x32_bf16(ah, wb[J][0], acc0, 0, 0, 0); acc1 = __builtin_amdgcn_mfma_f32_16x16x32_bf16(ah, wb[J][1], acc1, 0, 0, 0); acc2 = __builtin_amdgcn_mfma_f32_16x16x32_bf16(ah, wb[J][2], acc2, 0, 0, 0); \
                acc0 = __builtin_amdgcn_mfma_f32_16x16x32_bf16(al, wb[J][0], acc0, 0, 0, 0); acc1 = __builtin_amdgcn_mfma_f32_16x16x32_bf16(al, wb[J][1], acc1, 0, 0, 0); acc2 = __builtin_amdgcn_mfma_f32_16x16x32_bf16(al, wb[J][2], acc2, 0, 0, 0); } \
            ss += __shfl_xor(ss, 16); ss += __shfl_xor(ss, 32); \
            LDS_BARRIER(); \
            _Pragma("unroll") for (int reg = 0; reg < 4; ++reg) { LAS float* q = LGp + wv * 768 + (4 * g + reg) * 48 + row; q[0] = acc0[reg]; q[16] = acc1[reg]; q[32] = acc2[reg]; } \
            if (g == 0) SSp[wv * 16 + row] = ss; \
            LDS_BARRIER(); \
            for (int e = F.tid; e < 768; e += NTHR) { float s8 = 0.f; _Pragma("unroll") for (int w8 = 0; w8 < 8; ++w8) s8 += LGp[w8 * 768 + e]; LGs[e] = s8; } \
            if (F.tid < 16) { float s8 = 0.f; _Pragma("unroll") for (int w8 = 0; w8 < 8; ++w8) s8 += SSp[w8 * 16 + F.tid]; RS[F.tid] = 1.0f / sqrtf(s8 * (1.f / D) + EPS); } \
            LDS_BARRIER(); \
            if (F.tid < 16) route_row(F, LGs + F.tid * 48, RS[F.tid], r0 + F.tid, LCNT, ENT, 2 * (ntok + F.tid)); ntok += 16; \
            { const float rs = RS[row]; bf16* op = N1 + (size_t)(r0 + row) * D + 256 * wv + 8 * g; const float* gp = gain + 256 * wv + 8 * g; \
              _Pragma("unroll") for (int J = 0; J < 8; ++J) { const f32x4 g0 = *(const f32x4*)(gp + 32 * J), g1 = *(const f32x4*)(gp + 32 * J + 4); const f32x4 x0 = a[J][0], x1 = a[J][1]; \
                v4u o; o.x = pk2(x0.x * rs * g0.x, x0.y * rs * g0.y); o.y = pk2(x0.z * rs * g0.z, x0.w * rs * g0.w); o.z = pk2(x1.x * rs * g1.x, x1.y * rs * g1.y); o.w = pk2(x1.z * rs * g1.z, x1.w * rs * g1.w); \
                *(v4u*)(op + 32 * J) = o; } } } while (0)
        f32x4 ra[8][2];
        bf16x8 wb[8][3];
#pragma unroll
        for (int J = 0; J < 8; ++J)
#pragma unroll
            for (int t3 = 0; t3 < 3; ++t3) wb[J][t3] = *(const bf16x8*)(wph + 16 * t3 * D + 32 * J);
        for (int task = F.vcu; task < T / 16; task += F.G) { RT_LOAD(ra, task); RT_BODY(ra, ra, task, 0); }
#undef RT_LOAD
#undef RT_BODY
        __syncthreads();
        if (F.tid < NE) LCNT[32 + F.tid] = atomicAdd(&F.ctl[CW_CNT + 64 * F.tid], LCNT[F.tid]);
        __syncthreads();
        for (int i = F.tid; i < 2 * ntok; i += NTHR) { const int es = ENT[4 * i], e = es >> 16, slot = (int)LCNT[32 + e] + (es & 0xffff); LTK[(size_t)e * T + slot] = ENT[4 * i + 1]; LW[(size_t)e * T + slot] = __int_as_float(ENT[4 * i + 2]); }
        __syncthreads();
    }
    SEAM(PH_ROUTE);
    if (IN(PH_MOE1)) {
        LAS int* pre = (LAS int*)(F.lds + MISC_OFF + 256); LAS int* base = pre + 40;
        moe_tables<256>(F, pre, base);
        MoeSched<256, true> S{pre, base, LTK, 4, F.G, F.vcu, D, 1024};
        EpiMoe1 E{HMID}; pg8::gemm_phase<EpiMoe1, MoeSched<256, true>, true>(F.lds + RING_OFF, N1, WGU, D, S, E);
    }
    SEAM(PH_MOE1);
    if (IN(PH_MOE2)) {
        LAS int* pre = (LAS int*)(F.lds + MISC_OFF + 256); LAS int* base = pre + 40;
        moe_tables<256>(F, pre, base);
        MoeSched<256, false> S{pre, base, LTK, 8, F.G, F.vcu, DE, D};
        EpiMoe2 E{LTK, LW, Y0, Y1}; pg8::gemm_phase<EpiMoe2, MoeSched<256, false>, false>(F.lds + RING_OFF, HMID, WDN, DE, S, E);
    }
    SEAM(PH_MOE2);
    if (IN(PH_N3)) {
        const float* gain = F.in[I_NORM_PLE];
        for (int t = gw; t < T; t += NGW) {
            f32x4* hr = (f32x4*)(H + (size_t)t * D) + lane; const f32x4* gr = (const f32x4*)gain + lane;
            const v2u* y0r = (const v2u*)(Y0 + (size_t)t * D) + lane; const v2u* y1r = (const v2u*)(Y1 + (size_t)t * D) + lane;
            f32x4 v[8]; float s = 0.f;
#pragma unroll
            for (int j = 0; j < 8; ++j) { const v2u a = y0r[64 * j], b = y1r[64 * j]; f32x4 x = hr[64 * j];
                x.x += bflo(a.x) + bflo(b.x); x.y += bfhi(a.x) + bfhi(b.x); x.z += bflo(a.y) + bflo(b.y); x.w += bfhi(a.y) + bfhi(b.y);
                v[j] = x; hr[64 * j] = x; s += (x.x * x.x + x.y * x.y) + (x.z * x.z + x.w * x.w); }
            const float rstd = 1.0f / sqrtf(wave_sum(s) * (1.f / D) + EPS);
            v2u* o8 = (v2u*)(N1 + (size_t)t * D) + lane;
#pragma unroll
            for (int j = 0; j < 8; ++j) { const f32x4 g = gr[64 * j]; v2u o; o.x = pk2(v[j].x * rstd * g.x, v[j].y * rstd * g.y); o.y = pk2(v[j].z * rstd * g.z, v[j].w * rstd * g.w); o8[64 * j] = o; }
        }
    }
    SEAM(PH_N3);
    if (IN(PH_PP)) { pg8::DenseOrder S; S.init(T, D, D_PLE, F.G, (int)blockIdx.x); EpiBf16Plain E{PP}; pg8::gemm_phase<EpiBf16Plain, pg8::DenseOrder, false>(F.lds + RING_OFF, PBF, WPLEP, D_PLE, S, E); }
    SEAM(PH_PP);
    if (IN(PH_PLE)) { pg8::DenseOrder S; S.init(T, D, D, F.G, (int)blockIdx.x); EpiPle E{PP, H}; pg8::gemm_phase<EpiPle, pg8::DenseOrder, false>(F.lds + RING_OFF, N1, WPLEG, D, S, E); }
    SEAM(PH_PLE);
    if (IN(PH_FINAL)) {
        const float* gain = F.in[I_NORM_FINAL];
        for (int t = gw; t < T; t += NGW) {
            f32x4* hr = (f32x4*)(H + (size_t)t * D) + lane; const f32x4* gr = (const f32x4*)gain + lane;
            f32x4 v[8]; float s = 0.f;
#pragma unroll
            for (int j = 0; j < 8; ++j) { v[j] = hr[64 * j]; s += (v[j].x * v[j].x + v[j].y * v[j].y) + (v[j].z * v[j].z + v[j].w * v[j].w); }
            const float rstd = 1.0f / sqrtf(wave_sum(s) * (1.f / D) + EPS);
#pragma unroll
            for (int j = 0; j < 8; ++j) { const f32x4 g = gr[64 * j]; hr[64 * j] = v[j] * rstd * g; }
        }
    }
#undef IN
#undef SEAM
}

extern "C" void kernel_launch(void* const* d_in, const int* in_sizes, int n_in, void* d_out, int out_size, void* d_ws, size_t ws_size, hipStream_t stream) {
    static int grid = 0;
    if (grid == 0) {
        if (n_in != 25 || in_sizes[0] != T * D || out_size != T * D || ws_size < WS_END) { fprintf(stderr, "kernel_launch: unexpected shapes (n_in %d, in0 %d, out %d, ws %zu); nothing launched\n", n_in, n_in > 0 ? in_sizes[0] : -1, out_size, ws_size); grid = -1; return; }
        int dev = 0, cus = 0, per_cu = 0;
        if (hipGetDevice(&dev) != hipSuccess || hipDeviceGetAttribute(&cus, hipDeviceAttributeMultiprocessorCount, dev) != hipSuccess) { grid = -1; return; }
        if (hipFuncSetAttribute((const void*)fwd, hipFuncAttributeMaxDynamicSharedMemorySize, LDS_BYTES) != hipSuccess) { fprintf(stderr, "kernel_launch: hipFuncSetAttribute failed\n"); grid = -1; return; }
        if (hipOccupancyMaxActiveBlocksPerMultiprocessor(&per_cu, (const void*)fwd, NTHR, LDS_BYTES) != hipSuccess || per_cu < 1) fprintf(stderr, "kernel_launch: occupancy query reports %d\n", per_cu);
        (void)hipGetLastError();
        grid = cus;
    }
    if (grid < 0) return;
    (void)hipMemsetAsync((char*)d_ws + WS_CTL, 0, CTL_ZERO_BYTES, stream);
    Args a{};
    for (int i = 0; i < 25; ++i) a.in[i] = (const float*)d_in[i];
    a.out = (float*)d_out; a.ws = (unsigned char*)d_ws;
    if (MK_N_LAUNCHES == 1) { a.ph_lo = 0; a.ph_hi = NPHASE; hipLaunchKernelGGL(fwd, dim3(grid), dim3(NTHR), LDS_BYTES, stream, a); }
    else for (int k = 0; k < NPHASE; ++k) { a.ph_lo = k; a.ph_hi = k + 1; hipLaunchKernelGGL(fwd, dim3(grid), dim3(NTHR), LDS_BYTES, stream, a); }
}
```

```cpp
#include <hip/hip_runtime.h>
#include <cstdio>
#include <cstdint>

#ifndef MK_N_LAUNCHES
#define MK_N_LAUNCHES 1
#endif

#define GAS __attribute__((address_space(1)))
#define LAS __attribute__((address_space(3)))
typedef unsigned short bf16;
typedef unsigned v4u __attribute__((ext_vector_type(4)));
typedef unsigned v2u __attribute__((ext_vector_type(2)));
typedef float f32x4 __attribute__((ext_vector_type(4)));
typedef float f32x16 __attribute__((ext_vector_type(16)));
typedef short bf16x8 __attribute__((ext_vector_type(8)));

constexpr int NB = 4, SEQ = 8192, T = NB * SEQ, D = 2048;
constexpr int D_PLE = 256, D_POOL = 1024, POOL_GW = 256, NH = 8, DK = 128, D_QKV = 3072, D_Z = 1024;
constexpr int D_IN = 9232, N_IN_PAD = 9216;
constexpr int NE = 32, EPG = 8, NGRP = 4, DE = 512;
constexpr float EPS = 1e-6f;
constexpr int NWAVES = 8, NTHR = 512;
constexpr int DN_UNITS = NB * NH * (SEQ / 64);
constexpr int STG_BYTES = 58368 + 16384;
constexpr int PKG_BYTES = 58368;

constexpr size_t MiB = 1u << 20;
constexpr size_t WS_CTL = 0, CTL_ZERO_BYTES = 65536;
constexpr size_t WS_WRT = 512 * 1024;
constexpr size_t WS_WIN = 1 * MiB;
constexpr size_t WS_WCOMB = 38 * MiB;
constexpr size_t WS_WUPDN = 42 * MiB;
constexpr size_t WS_WOUT = 46 * MiB;
constexpr size_t WS_WPLEG = 54 * MiB;
constexpr size_t WS_WPLEP = 62 * MiB;
constexpr size_t WS_WGU = 63 * MiB;
constexpr size_t WS_WDN = 191 * MiB;
constexpr size_t WS_BA = 255 * MiB;
constexpr size_t WS_G = 257 * MiB;
constexpr size_t WS_BETA = 258 * MiB;
constexpr size_t WS_LTK = 259 * MiB;
constexpr size_t WS_LW = 263 * MiB;
constexpr size_t WS_PBF = 267 * MiB;
constexpr size_t WS_N1 = 283 * MiB;
constexpr size_t WS_PKG = 283 * MiB;
constexpr size_t WS_UT = 511 * MiB;
constexpr size_t WS_OB = 575 * MiB;
constexpr size_t WS_QKV = 411 * MiB;
constexpr size_t WS_MP = 539 * MiB;
constexpr size_t WS_UPOOL = 603 * MiB;
constexpr size_t WS_Z = 667 * MiB;
constexpr size_t WS_GP = 731 * MiB;
constexpr size_t WS_GD = 859 * MiB;
constexpr size_t WS_END = 987 * MiB;
constexpr size_t OUT_D = 0, OUT_QKV2 = 64 * MiB;
constexpr int CW_CNT = 1024;
constexpr int CW_BAR = 4096;

constexpr int RING_OFF = 0, RING_BYTES = 153600;
constexpr int MISC_OFF = RING_BYTES;
constexpr int MISC_WORDS = 256;
constexpr int OT_OFF = 154624;
constexpr int LDS_BYTES = 162816;

#define LDS_WAIT() asm volatile("s_waitcnt lgkmcnt(0)" ::: "memory")
#define VM_WAIT() asm volatile("s_waitcnt vmcnt(0)" ::: "memory")
#define LDS_BARRIER() do { asm volatile("s_waitcnt lgkmcnt(0)" ::: "memory"); __builtin_amdgcn_s_barrier(); asm volatile("" ::: "memory"); } while (0)
__device__ __forceinline__ float bflo(unsigned u) { return __uint_as_float(u << 16); }
__device__ __forceinline__ float bfhi(unsigned u) { return __uint_as_float(u & 0xffff0000u); }
__device__ __forceinline__ float bf2f(bf16 b) { return __uint_as_float((unsigned)b << 16); }
__device__ __forceinline__ unsigned f2bf(float f) { unsigned u = __float_as_uint(f); return (u + 0x7fffu + ((u >> 16) & 1u)) >> 16; }
typedef __bf16 bf16x2_t __attribute__((ext_vector_type(2)));
typedef float f32x2_t __attribute__((ext_vector_type(2)));
__device__ __forceinline__ unsigned pk2(float lo, float hi) { const f32x2_t v = {lo, hi}; const bf16x2_t b = __builtin_convertvector(v, bf16x2_t); return __builtin_bit_cast(unsigned, b); }
__device__ __forceinline__ float wave_sum(float v) {
#pragma unroll
    for (int o = 1; o < 64; o <<= 1) v += __shfl_xor(v, o);
    return v;
}
__device__ __forceinline__ float sigmoidf_(float x) { return __builtin_amdgcn_rcpf(1.0f + __builtin_amdgcn_exp2f(-1.4426950408889634f * x)); }
__device__ __forceinline__ float siluf_(float x) { return x * __builtin_amdgcn_rcpf(1.0f + __builtin_amdgcn_exp2f(-1.4426950408889634f * x)); }
__device__ __forceinline__ void store8bf(bf16* p, const float* v) {
    v4u o; o.x = pk2(v[0], v[1]); o.y = pk2(v[2], v[3]); o.z = pk2(v[4], v[5]); o.w = pk2(v[6], v[7]); *(v4u*)p = o;
}
__device__ __forceinline__ void load8bf(const bf16* p, float* v) {
    const v4u o = *(const v4u*)p; v[0] = bflo(o.x); v[1] = bfhi(o.x); v[2] = bflo(o.y); v[3] = bfhi(o.y); v[4] = bflo(o.z); v[5] = bfhi(o.z); v[6] = bflo(o.w); v[7] = bfhi(o.w);
}

__device__ __forceinline__ int tix(int row, int k, int kd16) { const int k16 = k & 15; return ((((row >> 5) * kd16 + (k >> 4)) * 64 + ((k16 >> 2) & 1) * 32 + (row & 31)) << 3) + (k16 & 3) + ((k16 >> 3) << 2); }


template <int J> __device__ __forceinline__ void fmac_bcast(float& acc, float l, float x) {
    asm volatile("v_fmac_f32_dpp %0, %1, %2 row_newbcast:%3 row_mask:0xf bank_mask:0xf" : "+v"(acc) : "v"(l), "v"(x), "n"(J));
}
template <int N> struct FmacChunk;
template <> struct FmacChunk<1> {
    static __device__ __forceinline__ void run(float& acc, float l, float x0) {
        asm volatile("v_fmac_f32_dpp %0, %1, %2 row_newbcast:0 row_mask:0xf bank_mask:0xf\n\t" : "+v"(acc) : "v"(l), "v"(x0));
    }
};
template <> struct FmacChunk<2> {
    static __device__ __forceinline__ void run(float& acc, float l, float x0, float x1) {
        asm volatile("v_fmac_f32_dpp %0, %1, %2 row_newbcast:0 row_mask:0xf bank_mask:0xf\n\t" "v_fmac_f32_dpp %0, %1, %3 row_newbcast:1 row_mask:0xf bank_mask:0xf\n\t" : "+v"(acc) : "v"(l), "v"(x0), "v"(x1));
    }
};
template <> struct FmacChunk<3> {
    static __device__ __forceinline__ void run(float& acc, float l, float x0, float x1, float x2) {
        asm volatile("v_fmac_f32_dpp %0, %1, %2 row_newbcast:0 row_mask:0xf bank_mask:0xf\n\t" "v_fmac_f32_dpp %0, %1, %3 row_newbcast:1 row_mask:0xf bank_mask:0xf\n\t" "v_fmac_f32_dpp %0, %1, %4 row_newbcast:2 row_mask:0xf bank_mask:0xf\n\t" : "+v"(acc) : "v"(l), "v"(x0), "v"(x1), "v"(x2));
    }
};
template <> struct FmacChunk<4> {
    static __device__ __forceinline__ void run(float& acc, float l, float x0, float x1, float x2, float x3) {
        asm volatile("v_fmac_f32_dpp %0, %1, %2 row_newbcast:0 row_mask:0xf bank_mask:0xf\n\t" "v_fmac_f32_dpp %0, %1, %3 row_newbcast:1 row_mask:0xf bank_mask:0xf\n\t" "v_fmac_f32_dpp %0, %1, %4 row_newbcast:2 row_mask:0xf bank_mask:0xf\n\t" "v_fmac_f32_dpp %0, %1, %5 row_newbcast:3 row_mask:0xf bank_mask:0xf\n\t" : "+v"(acc) : "v"(l), "v"(x0), "v"(x1), "v"(x2), "v"(x3));
    }
};
template <> struct FmacChunk<5> {
    static __device__ __forceinline__ void run(float& acc, float l, float x0, float x1, float x2, float x3, float x4) {
        asm volatile("v_fmac_f32_dpp %0, %1, %2 row_newbcast:0 row_mask:0xf bank_mask:0xf\n\t" "v_fmac_f32_dpp %0, %1, %3 row_newbcast:1 row_mask:0xf bank_mask:0xf\n\t" "v_fmac_f32_dpp %0, %1, %4 row_newbcast:2 row_mask:0xf bank_mask:0xf\n\t" "v_fmac_f32_dpp %0, %1, %5 row_newbcast:3 row_mask:0xf bank_mask:0xf\n\t" "v_fmac_f32_dpp %0, %1, %6 row_newbcast:4 row_mask:0xf bank_mask:0xf\n\t" : "+v"(acc) : "v"(l), "v"(x0), "v"(x1), "v"(x2), "v"(x3), "v"(x4));
    }
};
template <> struct FmacChunk<6> {
    static __device__ __forceinline__ void run(float& acc, float l, float x0, float x1, float x2, float x3, float x4, float x5) {
        asm volatile("v_fmac_f32_dpp %0, %1, %2 row_newbcast:0 row_mask:0xf bank_mask:0xf\n\t" "v_fmac_f32_dpp %0, %1, %3 row_newbcast:1 row_mask:0xf bank_mask:0xf\n\t" "v_fmac_f32_dpp %0, %1, %4 row_newbcast:2 row_mask:0xf bank_mask:0xf\n\t" "v_fmac_f32_dpp %0, %1, %5 row_newbcast:3 row_mask:0xf bank_mask:0xf\n\t" "v_fmac_f32_dpp %0, %1, %6 row_newbcast:4 row_mask:0xf bank_mask:0xf\n\t" "v_fmac_f32_dpp %0, %1, %7 row_newbcast:5 row_mask:0xf bank_mask:0xf\n\t" : "+v"(acc) : "v"(l), "v"(x0), "v"(x1), "v"(x2), "v"(x3), "v"(x4), "v"(x5));
    }
};
template <> struct FmacChunk<7> {
    static __device__ __forceinline__ void run(float& acc, float l, float x0, float x1, float x2, float x3, float x4, float x5, float x6) {
        asm volatile("v_fmac_f32_dpp %0, %1, %2 row_newbcast:0 row_mask:0xf bank_mask:0xf\n\t" "v_fmac_f32_dpp %0, %1, %3 row_newbcast:1 row_mask:0xf bank_mask:0xf\n\t" "v_fmac_f32_dpp %0, %1, %4 row_newbcast:2 row_mask:0xf bank_mask:0xf\n\t" "v_fmac_f32_dpp %0, %1, %5 row_newbcast:3 row_mask:0xf bank_mask:0xf\n\t" "v_fmac_f32_dpp %0, %1, %6 row_newbcast:4 row_mask:0xf bank_mask:0xf\n\t" "v_fmac_f32_dpp %0, %1, %7 row_newbcast:5 row_mask:0xf bank_mask:0xf\n\t" "v_fmac_f32_dpp %0, %1, %8 row_newbcast:6 row_mask:0xf bank_mask:0xf\n\t" : "+v"(acc) : "v"(l), "v"(x0), "v"(x1), "v"(x2), "v"(x3), "v"(x4), "v"(x5), "v"(x6));
    }
};
template <> struct FmacChunk<8> {
    static __device__ __forceinline__ void run(float& acc, float l, float x0, float x1, float x2, float x3, float x4, float x5, float x6, float x7) {
        asm volatile("v_fmac_f32_dpp %0, %1, %2 row_newbcast:0 row_mask:0xf bank_mask:0xf\n\t" "v_fmac_f32_dpp %0, %1, %3 row_newbcast:1 row_mask:0xf bank_mask:0xf\n\t" "v_fmac_f32_dpp %0, %1, %4 row_newbcast:2 row_mask:0xf bank_mask:0xf\n\t" "v_fmac_f32_dpp %0, %1, %5 row_newbcast:3 row_mask:0xf bank_mask:0xf\n\t" "v_fmac_f32_dpp %0, %1, %6 row_newbcast:4 row_mask:0xf bank_mask:0xf\n\t" "v_fmac_f32_dpp %0, %1, %7 row_newbcast:5 row_mask:0xf bank_mask:0xf\n\t" "v_fmac_f32_dpp %0, %1, %8 row_newbcast:6 row_mask:0xf bank_mask:0xf\n\t" "v_fmac_f32_dpp %0, %1, %9 row_newbcast:7 row_mask:0xf bank_mask:0xf\n\t" : "+v"(acc) : "v"(l), "v"(x0), "v"(x1), "v"(x2), "v"(x3), "v"(x4), "v"(x5), "v"(x6), "v"(x7));
    }
};
template <> struct FmacChunk<9> {
    static __device__ __forceinline__ void run(float& acc, float l, float x0, float x1, float x2, float x3, float x4, float x5, float x6, float x7, float x8) {
        asm volatile("v_fmac_f32_dpp %0, %1, %2 row_newbcast:0 row_mask:0xf bank_mask:0xf\n\t" "v_fmac_f32_dpp %0, %1, %3 row_newbcast:1 row_mask:0xf bank_mask:0xf\n\t" "v_fmac_f32_dpp %0, %1, %4 row_newbcast:2 row_mask:0xf bank_mask:0xf\n\t" "v_fmac_f32_dpp %0, %1, %5 row_newbcast:3 row_mask:0xf bank_mask:0xf\n\t" "v_fmac_f32_dpp %0, %1, %6 row_newbcast:4 row_mask:0xf bank_mask:0xf\n\t" "v_fmac_f32_dpp %0, %1, %7 row_newbcast:5 row_mask:0xf bank_mask:0xf\n\t" "v_fmac_f32_dpp %0, %1, %8 row_newbcast:6 row_mask:0xf bank_mask:0xf\n\t" "v_fmac_f32_dpp %0, %1, %9 row_newbcast:7 row_mask:0xf bank_mask:0xf\n\t" "v_fmac_f32_dpp %0, %1, %10 row_newbcast:8 row_mask:0xf bank_mask:0xf\n\t" : "+v"(acc) : "v"(l), "v"(x0), "v"(x1), "v"(x2), "v"(x3), "v"(x4), "v"(x5), "v"(x6), "v"(x7), "v"(x8));
    }
};
template <> struct FmacChunk<10> {
    static __device__ __forceinline__ void run(float& acc, float l, float x0, float x1, float x2, float x3, float x4, float x5, float x6, float x7, float x8, float x9) {
        asm volatile("v_fmac_f32_dpp %0, %1, %2 row_newbcast:0 row_mask:0xf bank_mask:0xf\n\t" "v_fmac_f32_dpp %0, %1, %3 row_newbcast:1 row_mask:0xf bank_mask:0xf\n\t" "v_fmac_f32_dpp %0, %1, %4 row_newbcast:2 row_mask:0xf bank_mask:0xf\n\t" "v_fmac_f32_dpp %0, %1, %5 row_newbcast:3 row_mask:0xf bank_mask:0xf\n\t" "v_fmac_f32_dpp %0, %1, %6 row_newbcast:4 row_mask:0xf bank_mask:0xf\n\t" "v_fmac_f32_dpp %0, %1, %7 row_newbcast:5 row_mask:0xf bank_mask:0xf\n\t" "v_fmac_f32_dpp %0, %1, %8 row_newbcast:6 row_mask:0xf bank_mask:0xf\n\t" "v_fmac_f32_dpp %0, %1, %9 row_newbcast:7 row_mask:0xf bank_mask:0xf\n\t" "v_fmac_f32_dpp %0, %1, %10 row_newbcast:8 row_mask:0xf bank_mask:0xf\n\t" "v_fmac_f32_dpp %0, %1, %11 row_newbcast:9 row_mask:0xf bank_mask:0xf\n\t" : "+v"(acc) : "v"(l), "v"(x0), "v"(x1), "v"(x2), "v"(x3), "v"(x4), "v"(x5), "v"(x6), "v"(x7), "v"(x8), "v"(x9));
    }
};
template <> struct FmacChunk<11> {
    static __device__ __forceinline__ void run(float& acc, float l, float x0, float x1, float x2, float x3, float x4, float x5, float x6, float x7, float x8, float x9, float x10) {
        asm volatile("v_fmac_f32_dpp %0, %1, %2 row_newbcast:0 row_mask:0xf bank_mask:0xf\n\t" "v_fmac_f32_dpp %0, %1, %3 row_newbcast:1 row_mask:0xf bank_mask:0xf\n\t" "v_fmac_f32_dpp %0, %1, %4 row_newbcast:2 row_mask:0xf bank_mask:0xf\n\t" "v_fmac_f32_dpp %0, %1, %5 row_newbcast:3 row_mask:0xf bank_mask:0xf\n\t" "v_fmac_f32_dpp %0, %1, %6 row_newbcast:4 row_mask:0xf bank_mask:0xf\n\t" "v_fmac_f32_dpp %0, %1, %7 row_newbcast:5 row_mask:0xf bank_mask:0xf\n\t" "v_fmac_f32_dpp %0, %1, %8 row_newbcast:6 row_mask:0xf bank_mask:0xf\n\t" "v_fmac_f32_dpp %0, %1, %9 row_newbcast:7 row_mask:0xf bank_mask:0xf\n\t" "v_fmac_f32_dpp %0, %1, %10 row_newbcast:8 row_mask:0xf bank_mask:0xf\n\t" "v_fmac_f32_dpp %0, %1, %11 row_newbcast:9 row_mask:0xf bank_mask:0xf\n\t" "v_fmac_f32_dpp %0, %1, %12 row_newbcast:10 row_mask:0xf bank_mask:0xf\n\t" : "+v"(acc) : "v"(l), "v"(x0), "v"(x1), "v"(x2), "v"(x3), "v"(x4), "v"(x5), "v"(x6), "v"(x7), "v"(x8), "v"(x9), "v"(x10));
    }
};
template <> struct FmacChunk<12> {
    static __device__ __forceinline__ void run(float& acc, float l, float x0, float x1, float x2, float x3, float x4, float x5, float x6, float x7, float x8, float x9, float x10, float x11) {
        asm volatile("v_fmac_f32_dpp %0, %1, %2 row_newbcast:0 row_mask:0xf bank_mask:0xf\n\t" "v_fmac_f32_dpp %0, %1, %3 row_newbcast:1 row_mask:0xf bank_mask:0xf\n\t" "v_fmac_f32_dpp %0, %1, %4 row_newbcast:2 row_mask:0xf bank_mask:0xf\n\t" "v_fmac_f32_dpp %0, %1, %5 row_newbcast:3 row_mask:0xf bank_mask:0xf\n\t" "v_fmac_f32_dpp %0, %1, %6 row_newbcast:4 row_mask:0xf bank_mask:0xf\n\t" "v_fmac_f32_dpp %0, %1, %7 row_newbcast:5 row_mask:0xf bank_mask:0xf\n\t" "v_fmac_f32_dpp %0, %1, %8 row_newbcast:6 row_mask:0xf bank_mask:0xf\n\t" "v_fmac_f32_dpp %0, %1, %9 row_newbcast:7 row_mask:0xf bank_mask:0xf\n\t" "v_fmac_f32_dpp %0, %1, %10 row_newbcast:8 row_mask:0xf bank_mask:0xf\n\t" "v_fmac_f32_dpp %0, %1, %11 row_newbcast:9 row_mask:0xf bank_mask:0xf\n\t" "v_fmac_f32_dpp %0, %1, %12 row_newbcast:10 row_mask:0xf bank_mask:0xf\n\t" "v_fmac_f32_dpp %0, %1, %13 row_newbcast:11 row_mask:0xf bank_mask:0xf\n\t" : "+v"(acc) : "v"(l), "v"(x0), "v"(x1), "v"(x2), "v"(x3), "v"(x4), "v"(x5), "v"(x6), "v"(x7), "v"(x8), "v"(x9), "v"(x10), "v"(x11));
    }
};
template <> struct FmacChunk<13> {
    static __device__ __forceinline__ void run(float& acc, float l, float x0, float x1, float x2, float x3, float x4, float x5, float x6, float x7, float x8, float x9, float x10, float x11, float x12) {
        asm volatile("v_fmac_f32_dpp %0, %1, %2 row_newbcast:0 row_mask:0xf bank_mask:0xf\n\t" "v_fmac_f32_dpp %0, %1, %3 row_newbcast:1 row_mask:0xf bank_mask:0xf\n\t" "v_fmac_f32_dpp %0, %1, %4 row_newbcast:2 row_mask:0xf bank_mask:0xf\n\t" "v_fmac_f32_dpp %0, %1, %5 row_newbcast:3 row_mask:0xf bank_mask:0xf\n\t" "v_fmac_f32_dpp %0, %1, %6 row_newbcast:4 row_mask:0xf bank_mask:0xf\n\t" "v_fmac_f32_dpp %0, %1, %7 row_newbcast:5 row_mask:0xf bank_mask:0xf\n\t" "v_fmac_f32_dpp %0, %1, %8 row_newbcast:6 row_mask:0xf bank_mask:0xf\n\t" "v_fmac_f32_dpp %0, %1, %9 row_newbcast:7 row_mask:0xf bank_mask:0xf\n\t" "v_fmac_f32_dpp %0, %1, %10 row_newbcast:8 row_mask:0xf bank_mask:0xf\n\t" "v_fmac_f32_dpp %0, %1, %11 row_newbcast:9 row_mask:0xf bank_mask:0xf\n\t" "v_fmac_f32_dpp %0, %1, %12 row_newbcast:10 row_mask:0xf bank_mask:0xf\n\t" "v_fmac_f32_dpp %0, %1, %13 row_newbcast:11 row_mask:0xf bank_mask:0xf\n\t" "v_fmac_f32_dpp %0, %1, %14 row_newbcast:12 row_mask:0xf bank_mask:0xf\n\t" : "+v"(acc) : "v"(l), "v"(x0), "v"(x1), "v"(x2), "v"(x3), "v"(x4), "v"(x5), "v"(x6), "v"(x7), "v"(x8), "v"(x9), "v"(x10), "v"(x11), "v"(x12));
    }
};
template <> struct FmacChunk<14> {
    static __device__ __forceinline__ void run(float& acc, float l, float x0, float x1, float x2, float x3, float x4, float x5, float x6, float x7, float x8, float x9, float x10, float x11, float x12, float x13) {
        asm volatile("v_fmac_f32_dpp %0, %1, %2 row_newbcast:0 row_mask:0xf bank_mask:0xf\n\t" "v_fmac_f32_dpp %0, %1, %3 row_newbcast:1 row_mask:0xf bank_mask:0xf\n\t" "v_fmac_f32_dpp %0, %1, %4 row_newbcast:2 row_mask:0xf bank_mask:0xf\n\t" "v_fmac_f32_dpp %0, %1, %5 row_newbcast:3 row_mask:0xf bank_mask:0xf\n\t" "v_fmac_f32_dpp %0, %1, %6 row_newbcast:4 row_mask:0xf bank_mask:0xf\n\t" "v_fmac_f32_dpp %0, %1, %7 row_newbcast:5 row_mask:0xf bank_mask:0xf\n\t" "v_fmac_f32_dpp %0, %1, %8 row_newbcast:6 row_mask:0xf bank_mask:0xf\n\t" "v_fmac_f32_dpp %0, %1, %9 row_newbcast:7 row_mask:0xf bank_mask:0xf\n\t" "v_fmac_f32_dpp %0, %1, %10 row_newbcast:8 row_mask:0xf bank_mask:0xf\n\t" "v_fmac_f32_dpp %0, %1, %11 row_newbcast:9 row_mask:0xf bank_mask:0xf\n\t" "v_fmac_f32_dpp %0, %1, %12 row_newbcast:10 row_mask:0xf bank_mask:0xf\n\t" "v_fmac_f32_dpp %0, %1, %13 row_newbcast:11 row_mask:0xf bank_mask:0xf\n\t" "v_fmac_f32_dpp %0, %1, %14 row_newbcast:12 row_mask:0xf bank_mask:0xf\n\t" "v_fmac_f32_dpp %0, %1, %15 row_newbcast:13 row_mask:0xf bank_mask:0xf\n\t" : "+v"(acc) : "v"(l), "v"(x0), "v"(x1), "v"(x2), "v"(x3), "v"(x4), "v"(x5), "v"(x6), "v"(x7), "v"(x8), "v"(x9), "v"(x10), "v"(x11), "v"(x12), "v"(x13));
    }
};
template <> struct FmacChunk<15> {
    static __device__ __forceinline__ void run(float& acc, float l, float x0, float x1, float x2, float x3, float x4, float x5, float x6, float x7, float x8, float x9, float x10, float x11, float x12, float x13, float x14) {
        asm volatile("v_fmac_f32_dpp %0, %1, %2 row_newbcast:0 row_mask:0xf bank_mask:0xf\n\t" "v_fmac_f32_dpp %0, %1, %3 row_newbcast:1 row_mask:0xf bank_mask:0xf\n\t" "v_fmac_f32_dpp %0, %1, %4 row_newbcast:2 row_mask:0xf bank_mask:0xf\n\t" "v_fmac_f32_dpp %0, %1, %5 row_newbcast:3 row_mask:0xf bank_mask:0xf\n\t" "v_fmac_f32_dpp %0, %1, %6 row_newbcast:4 row_mask:0xf bank_mask:0xf\n\t" "v_fmac_f32_dpp %0, %1, %7 row_newbcast:5 row_mask:0xf bank_mask:0xf\n\t" "v_fmac_f32_dpp %0, %1, %8 row_newbcast:6 row_mask:0xf bank_mask:0xf\n\t" "v_fmac_f32_dpp %0, %1, %9 row_newbcast:7 row_mask:0xf bank_mask:0xf\n\t" "v_fmac_f32_dpp %0, %1, %10 row_newbcast:8 row_mask:0xf bank_mask:0xf\n\t" "v_fmac_f32_dpp %0, %1, %11 row_newbcast:9 row_mask:0xf bank_mask:0xf\n\t" "v_fmac_f32_dpp %0, %1, %12 row_newbcast:10 row_mask:0xf bank_mask:0xf\n\t" "v_fmac_f32_dpp %0, %1, %13 row_newbcast:11 row_mask:0xf bank_mask:0xf\n\t" "v_fmac_f32_dpp %0, %1, %14 row_newbcast:12 row_mask:0xf bank_mask:0xf\n\t" "v_fmac_f32_dpp %0, %1, %15 row_newbcast:13 row_mask:0xf bank_mask:0xf\n\t" "v_fmac_f32_dpp %0, %1, %16 row_newbcast:14 row_mask:0xf bank_mask:0xf\n\t" : "+v"(acc) : "v"(l), "v"(x0), "v"(x1), "v"(x2), "v"(x3), "v"(x4), "v"(x5), "v"(x6), "v"(x7), "v"(x8), "v"(x9), "v"(x10), "v"(x11), "v"(x12), "v"(x13), "v"(x14));
    }
};
template <> struct FmacChunk<16> {
    static __device__ __forceinline__ void run(float& acc, float l, float x0, float x1, float x2, float x3, float x4, float x5, float x6, float x7, float x8, float x9, float x10, float x11, float x12, float x13, float x14, float x15) {
        asm volatile("v_fmac_f32_dpp %0, %1, %2 row_newbcast:0 row_mask:0xf bank_mask:0xf\n\t" "v_fmac_f32_dpp %0, %1, %3 row_newbcast:1 row_mask:0xf bank_mask:0xf\n\t" "v_fmac_f32_dpp %0, %1, %4 row_newbcast:2 row_mask:0xf bank_mask:0xf\n\t" "v_fmac_f32_dpp %0, %1, %5 row_newbcast:3 row_mask:0xf bank_mask:0xf\n\t" "v_fmac_f32_dpp %0, %1, %6 row_newbcast:4 row_mask:0xf bank_mask:0xf\n\t" "v_fmac_f32_dpp %0, %1, %7 row_newbcast:5 row_mask:0xf bank_mask:0xf\n\t" "v_fmac_f32_dpp %0, %1, %8 row_newbcast:6 row_mask:0xf bank_mask:0xf\n\t" "v_fmac_f32_dpp %0, %1, %9 row_newbcast:7 row_mask:0xf bank_mask:0xf\n\t" "v_fmac_f32_dpp %0, %1, %10 row_newbcast:8 row_mask:0xf bank_mask:0xf\n\t" "v_fmac_f32_dpp %0, %1, %11 row_newbcast:9 row_mask:0xf bank_mask:0xf\n\t" "v_fmac_f32_dpp %0, %1, %12 row_newbcast:10 row_mask:0xf bank_mask:0xf\n\t" "v_fmac_f32_dpp %0, %1, %13 row_newbcast:11 row_mask:0xf bank_mask:0xf\n\t" "v_fmac_f32_dpp %0, %1, %14 row_newbcast:12 row_mask:0xf bank_mask:0xf\n\t" "v_fmac_f32_dpp %0, %1, %15 row_newbcast:13 row_mask:0xf bank_mask:0xf\n\t" "v_fmac_f32_dpp %0, %1, %16 row_newbcast:14 row_mask:0xf bank_mask:0xf\n\t" "v_fmac_f32_dpp %0, %1, %17 row_newbcast:15 row_mask:0xf bank_mask:0xf\n\t" : "+v"(acc) : "v"(l), "v"(x0), "v"(x1), "v"(x2), "v"(x3), "v"(x4), "v"(x5), "v"(x6), "v"(x7), "v"(x8), "v"(x9), "v"(x10), "v"(x11), "v"(x12), "v"(x13), "v"(x14), "v"(x15));
    }
};
template <int N, int B> struct ChunkCall;
#define CC_ARGS1(B) x[B]
#define CC_ARGS2(B) CC_ARGS1(B), x[B + 1]
#define CC_ARGS3(B) CC_ARGS2(B), x[B + 2]
#define CC_ARGS4(B) CC_ARGS3(B), x[B + 3]
#define CC_ARGS5(B) CC_ARGS4(B), x[B + 4]
#define CC_ARGS6(B) CC_ARGS5(B), x[B + 5]
#define CC_ARGS7(B) CC_ARGS6(B), x[B + 6]
#define CC_ARGS8(B) CC_ARGS7(B), x[B + 7]
#define CC_ARGS9(B) CC_ARGS8(B), x[B + 8]
#define CC_ARGS10(B) CC_ARGS9(B), x[B + 9]
#define CC_ARGS11(B) CC_ARGS10(B), x[B + 10]
#define CC_ARGS12(B) CC_ARGS11(B), x[B + 11]
#define CC_ARGS13(B) CC_ARGS12(B), x[B + 12]
#define CC_ARGS14(B) CC_ARGS13(B), x[B + 13]
#define CC_ARGS15(B) CC_ARGS14(B), x[B + 14]
#define CC_ARGS16(B) CC_ARGS15(B), x[B + 15]
#define CC_DEF(N) template <int B> struct ChunkCall<N, B> { static __device__ __forceinline__ void run(float (&x)[64], float& acc, float l) { FmacChunk<N>::run(acc, l, CC_ARGS##N(B)); } };
CC_DEF(1) CC_DEF(2) CC_DEF(3) CC_DEF(4) CC_DEF(5) CC_DEF(6) CC_DEF(7) CC_DEF(8) CC_DEF(9) CC_DEF(10) CC_DEF(11) CC_DEF(12) CC_DEF(13) CC_DEF(14) CC_DEF(15) CC_DEF(16)
#undef CC_DEF
template <int N> struct QuadChunk;
template <> struct QuadChunk<1> {
    static __device__ __forceinline__ void run(float& a0, float& a1, float& a2, float& a3, float l0, float l1, float l2, float l3, float x0) {
        asm volatile("v_fmac_f32_dpp %0, %4, %8 row_newbcast:0 row_mask:0xf bank_mask:0xf\n\t" "v_fmac_f32_dpp %1, %5, %8 row_newbcast:0 row_mask:0xf bank_mask:0xf\n\t" "v_fmac_f32_dpp %2, %6, %8 row_newbcast:0 row_mask:0xf bank_mask:0xf\n\t" "v_fmac_f32_dpp %3, %7, %8 row_newbcast:0 row_mask:0xf bank_mask:0xf\n\t" : "+v"(a0), "+v"(a1), "+v"(a2), "+v"(a3) : "v"(l0), "v"(l1), "v"(l2), "v"(l3), "v"(x0));
    }
};
template <> struct QuadChunk<2> {
    static __device__ __forceinline__ void run(float& a0, float& a1, float& a2, float& a3, float l0, float l1, float l2, float l3, float x0, float x1) {
        asm volatile("v_fmac_f32_dpp %0, %4, %8 row_newbcast:0 row_mask:0xf bank_mask:0xf\n\t" "v_fmac_f32_dpp %1, %5, %8 row_newbcast:0 row_mask:0xf bank_mask:0xf\n\t" "v_fmac_f32_dpp %2, %6, %8 row_newbcast:0 row_mask:0xf bank_mask:0xf\n\t" "v_fmac_f32_dpp %3, %7, %8 row_newbcast:0 row_mask:0xf bank_mask:0xf\n\t" "v_fmac_f32_dpp %0, %4, %9 row_newbcast:1 row_mask:0xf bank_mask:0xf\n\t" "v_fmac_f32_dpp %1, %5, %9 row_newbcast:1 row_mask:0xf bank_mask:0xf\n\t" "v_fmac_f32_dpp %2, %6, %9 row_newbcast:1 row_mask:0xf bank_mask:0xf\n\t" "v_fmac_f32_dpp %3, %7, %9 row_newbcast:1 row_mask:0xf bank_mask:0xf\n\t" : "+v"(a0), "+v"(a1), "+v"(a2), "+v"(a3) : "v"(l0), "v"(l1), "v"(l2), "v"(l3), "v"(x0), "v"(x1));
    }
};
template <> struct QuadChunk<3> {
    static __device__ __forceinline__ void run(float& a0, float& a1, float& a2, float& a3, float l0, float l1, float l2, float l3, float x0, float x1, float x2) {
        asm volatile("v_fmac_f32_dpp %0, %4, %8 row_newbcast:0 row_mask:0xf bank_mask:0xf\n\t" "v_fmac_f32_dpp %1, %5, %8 row_newbcast:0 row_mask:0xf bank_mask:0xf\n\t" "v_fmac_f32_dpp %2, %6, %8 row_newbcast:0 row_mask:0xf bank_mask:0xf\n\t" "v_fmac_f32_dpp %3, %7, %8 row_newbcast:0 row_mask:0xf bank_mask:0xf\n\t" "v_fmac_f32_dpp %0, %4, %9 row_newbcast:1 row_mask:0xf bank_mask:0xf\n\t" "v_fmac_f32_dpp %1, %5, %9 row_newbcast:1 row_mask:0xf bank_mask:0xf\n\t" "v_fmac_f32_dpp %2, %6, %9 row_newbcast:1 row_mask:0xf bank_mask:0xf\n\t" "v_fmac_f32_dpp %3, %7, %9 row_newbcast:1 row_mask:0xf bank_mask:0xf\n\t" "v_fmac_f32_dpp %0, %4, %10 row_newbcast:2 row_mask:0xf bank_mask:0xf\n\t" "v_fmac_f32_dpp %1, %5, %10 row_newbcast:2 row_mask:0xf bank_mask:0xf\n\t" "v_fmac_f32_dpp %2, %6, %10 row_newbcast:2 row_mask:0xf bank_mask:0xf\n\t" "v_fmac_f32_dpp %3, %7, %10 row_newbcast:2 row_mask:0xf bank_mask:0xf\n\t" : "+v"(a0), "+v"(a1), "+v"(a2), "+v"(a3) : "v"(l0), "v"(l1), "v"(l2), "v"(l3), "v"(x0), "v"(x1), "v"(x2));
    }
};
template <> struct QuadChunk<4> {
    static __device__ __forceinline__ void run(float& a0, float& a1, float& a2, float& a3, float l0, float l1, float l2, float l3, float x0, float x1, float x2, float x3) {
        asm volatile("v_fmac_f32_dpp %0, %4, %8 row_newbcast:0 row_mask:0xf bank_mask:0xf\n\t" "v_fmac_f32_dpp %1, %5, %8 row_newbcast:0 row_mask:0xf bank_mask:0xf\n\t" "v_fmac_f32_dpp %2, %6, %8 row_newbcast:0 row_mask:0xf bank_mask:0xf\n\t" "v_fmac_f32_dpp %3, %7, %8 row_newbcast:0 row_mask:0xf bank_mask:0xf\n\t" "v_fmac_f32_dpp %0, %4, %9 row_newbcast:1 row_mask:0xf bank_mask:0xf\n\t" "v_fmac_f32_dpp %1, %5, %9 row_newbcast:1 row_mask:0xf bank_mask:0xf\n\t" "v_fmac_f32_dpp %2, %6, %9 row_newbcast:1 row_mask:0xf bank_mask:0xf\n\t" "v_fmac_f32_dpp %3, %7, %9 row_newbcast:1 row_mask:0xf bank_mask:0xf\n\t" "v_fmac_f32_dpp %0, %4, %10 row_newbcast:2 row_mask:0xf bank_mask:0xf\n\t" "v_fmac_f32_dpp %1, %5, %10 row_newbcast:2 row_mask:0xf bank_mask:0xf\n\t" "v_fmac_f32_dpp %2, %6, %10 row_newbcast:2 row_mask:0xf bank_mask:0xf\n\t" "v_fmac_f32_dpp %3, %7, %10 row_newbcast:2 row_mask:0xf bank_mask:0xf\n\t" "v_fmac_f32_dpp %0, %4, %11 row_newbcast:3 row_mask:0xf bank_mask:0xf\n\t" "v_fmac_f32_dpp %1, %5, %11 row_newbcast:3 row_mask:0xf bank_mask:0xf\n\t" "v_fmac_f32_dpp %2, %6, %11 row_newbcast:3 row_mask:0xf bank_mask:0xf\n\t" "v_fmac_f32_dpp %3, %7, %11 row_newbcast:3 row_mask:0xf bank_mask:0xf\n\t" : "+v"(a0), "+v"(a1), "+v"(a2), "+v"(a3) : "v"(l0), "v"(l1), "v"(l2), "v"(l3), "v"(x0), "v"(x1), "v"(x2), "v"(x3));
    }
};
template <> struct QuadChunk<5> {
    static __device__ __forceinline__ void run(float& a0, float& a1, float& a2, float& a3, float l0, float l1, float l2, float l3, float x0, float x1, float x2, float x3, float x4) {
        asm volatile("v_fmac_f32_dpp %0, %4, %8 row_newbcast:0 row_mask:0xf bank_mask:0xf\n\t" "v_fmac_f32_dpp %1, %5, %8 row_newbcast:0 row_mask:0xf bank_mask:0xf\n\t" "v_fmac_f32_dpp %2, %6, %8 row_newbcast:0 row_mask:0xf bank_mask:0xf\n\t" "v_fmac_f32_dpp %3, %7, %8 row_newbcast:0 row_mask:0xf bank_mask:0xf\n\t" "v_fmac_f32_dpp %0, %4, %9 row_newbcast:1 row_mask:0xf bank_mask:0xf\n\t" "v_fmac_f32_dpp %1, %5, %9 row_newbcast:1 row_mask:0xf bank_mask:0xf\n\t" "v_fmac_f32_dpp %2, %6, %9 row_newbcast:1 row_mask:0xf bank_mask:0xf\n\t" "v_fmac_f32_dpp %3, %7, %9 row_newbcast:1 row_mask:0xf bank_mask:0xf\n\t" "v_fmac_f32_dpp %0, %4, %10 row_newbcast:2 row_mask:0xf bank_mask:0xf\n\t" "v_fmac_f32_dpp %1, %5, %10 row_newbcast:2 row_mask:0xf bank_mask:0xf\n\t" "v_fmac_f32_dpp %2, %6, %10 row_newbcast:2 row_mask:0xf bank_mask:0xf\n\t" "v_fmac_f32_dpp %3, %7, %10 row_newbcast:2 row_mask:0xf bank_mask:0xf\n\t" "v_fmac_f32_dpp %0, %4, %11 row_newbcast:3 row_mask:0xf bank_mask:0xf\n\t" "v_fmac_f32_dpp %1, %5, %11 row_newbcast:3 row_mask:0xf bank_mask:0xf\n\t" "v_fmac_f32_dpp %2, %6, %11 row_newbcast:3 row_mask:0xf bank_mask:0xf\n\t" "v_fmac_f32_dpp %3, %7, %11 row_newbcast:3 row_mask:0xf bank_mask:0xf\n\t" "v_fmac_f32_dpp %0, %4, %12 row_newbcast:4 row_mask:0xf bank_mask:0xf\n\t" "v_fmac_f32_dpp %1, %5, %12 row_newbcast:4 row_mask:0xf bank_mask:0xf\n\t" "v_fmac_f32_dpp %2, %6, %12 row_newbcast:4 row_mask:0xf bank_mask:0xf\n\t" "v_fmac_f32_dpp %3, %7, %12 row_newbcast:4 row_mask:0xf bank_mask:0xf\n\t" : "+v"(a0), "+v"(a1), "+v"(a2), "+v"(a3) : "v"(l0), "v"(l1), "v"(l2), "v"(l3), "v"(x0), "v"(x1), "v"(x2), "v"(x3), "v"(x4));
    }
};
template <> struct QuadChunk<6> {
    static __device__ __forceinline__ void run(float& a0, float& a1, float& a2, float& a3, float l0, float l1, float l2, float l3, float x0, float x1, float x2, float x3, float x4, float x5) {
        asm volatile("v_fmac_f32_dpp %0, %4, %8 row_newbcast:0 row_mask:0xf bank_mask:0xf\n\t" "v_fmac_f32_dpp %1, %5, %8 row_newbcast:0 row_mask:0xf bank_mask:0xf\n\t" "v_fmac_f32_dpp %2, %6, %8 row_newbcast:0 row_mask:0xf bank_mask:0xf\n\t" "v_fmac_f32_dpp %3, %7, %8 row_newbcast:0 row_mask:0xf bank_mask:0xf\n\t" "v_fmac_f32_dpp %0, %4, %9 row_newbcast:1 row_mask:0xf bank_mask:0xf\n\t" "v_fmac_f32_dpp %1, %5, %9 row_newbcast:1 row_mask:0xf bank_mask:0xf\n\t" "v_fmac_f32_dpp %2, %6, %9 row_newbcast:1 row_mask:0xf bank_mask:0xf\n\t" "v_fmac_f32_dpp %3, %7, %9 row_newbcast:1 row_mask:0xf bank_mask:0xf\n\t" "v_fmac_f32_dpp %0, %4, %10 row_newbcast:2 row_mask:0xf bank_mask:0xf\n\t" "v_fmac_f32_dpp %1, %5, %10 row_newbcast:2 row_mask:0xf bank_mask:0xf\n\t" "v_fmac_f32_dpp %2, %6, %10 row_newbcast:2 row_mask:0xf bank_mask:0xf\n\t" "v_fmac_f32_dpp %3, %7, %10 row_newbcast:2 row_mask:0xf bank_mask:0xf\n\t" "v_fmac_f32_dpp %0, %4, %11 row_newbcast:3 row_mask:0xf bank_mask:0xf\n\t" "v_fmac_f32_dpp %1, %5, %11 row_newbcast:3 row_mask:0xf bank_mask:0xf\n\t" "v_fmac_f32_dpp %2, %6, %11 row_newbcast:3 row_mask:0xf bank_mask:0xf\n\t" "v_fmac_f32_dpp %3, %7, %11 row_newbcast:3 row_mask:0xf bank_mask:0xf\n\t" "v_fmac_f32_dpp %0, %4, %12 row_newbcast:4 row_mask:0xf bank_mask:0xf\n\t" "v_fmac_f32_dpp %1, %5, %12 row_newbcast:4 row_mask:0xf bank_mask:0xf\n\t" "v_fmac_f32_dpp %2, %6, %12 row_newbcast:4 row_mask:0xf bank_mask:0xf\n\t" "v_fmac_f32_dpp %3, %7, %12 row_newbcast:4 row_mask:0xf bank_mask:0xf\n\t" "v_fmac_f32_dpp %0, %4, %13 row_newbcast:5 row_mask:0xf bank_mask:0xf\n\t" "v_fmac_f32_dpp %1, %5, %13 row_newbcast:5 row_mask:0xf bank_mask:0xf\n\t" "v_fmac_f32_dpp %2, %6, %13 row_newbcast:5 row_mask:0xf bank_mask:0xf\n\t" "v_fmac_f32_dpp %3, %7, %13 row_newbcast:5 row_mask:0xf bank_mask:0xf\n\t" : "+v"(a0), "+v"(a1), "+v"(a2), "+v"(a3) : "v"(l0), "v"(l1), "v"(l2), "v"(l3), "v"(x0), "v"(x1), "v"(x2), "v"(x3), "v"(x4), "v"(x5));
    }
};
template <> struct QuadChunk<7> {
    static __device__ __forceinline__ void run(float& a0, float& a1, float& a2, float& a3, float l0, float l1, float l2, float l3, float x0, float x1, float x2, float x3, float x4, float x5, float x6) {
        asm volatile("v_fmac_f32_dpp %0, %4, %8 row_newbcast:0 row_mask:0xf bank_mask:0xf\n\t" "v_fmac_f32_dpp %1, %5, %8 row_newbcast:0 row_mask:0xf bank_mask:0xf\n\t" "v_fmac_f32_dpp %2, %6, %8 row_newbcast:0 row_mask:0xf bank_mask:0xf\n\t" "v_fmac_f32_dpp %3, %7, %8 row_newbcast:0 row_mask:0xf bank_mask:0xf\n\t" "v_fmac_f32_dpp %0, %4, %9 row_newbcast:1 row_mask:0xf bank_mask:0xf\n\t" "v_fmac_f32_dpp %1, %5, %9 row_newbcast:1 row_mask:0xf bank_mask:0xf\n\t" "v_fmac_f32_dpp %2, %6, %9 row_newbcast:1 row_mask:0xf bank_mask:0xf\n\t" "v_fmac_f32_dpp %3, %7, %9 row_newbcast:1 row_mask:0xf bank_mask:0xf\n\t" "v_fmac_f32_dpp %0, %4, %10 row_newbcast:2 row_mask:0xf bank_mask:0xf\n\t" "v_fmac_f32_dpp %1, %5, %10 row_newbcast:2 row_mask:0xf bank_mask:0xf\n\t" "v_fmac_f32_dpp %2, %6, %10 row_newbcast:2 row_mask:0xf bank_mask:0xf\n\t" "v_fmac_f32_dpp %3, %7, %10 row_newbcast:2 row_mask:0xf bank_mask:0xf\n\t" "v_fmac_f32_dpp %0, %4, %11 row_newbcast:3 row_mask:0xf bank_mask:0xf\n\t" "v_fmac_f32_dpp %1, %5, %11 row_newbcast:3 row_mask:0xf bank_mask:0xf\n\t" "v_fmac_f32_dpp %2, %6, %11 row_newbcast:3 row_mask:0xf bank_mask:0xf\n\t" "v_fmac_f32_dpp %3, %7, %11 row_newbcast:3 row_mask:0xf bank_mask:0xf\n\t" "v_fmac_f32_dpp %0, %4, %12 row_newbcast:4 row_mask:0xf bank_mask:0xf\n\t" "v_fmac_f32_dpp %1, %5, %12 row_newbcast:4 row_mask:0xf bank_mask:0xf\n\t" "v_fmac_f32_dpp %2, %6, %12 row_newbcast:4 row_mask:0xf bank_mask:0xf\n\t" "v_fmac_f32_dpp %3, %7, %12 row_newbcast:4 row_mask:0xf bank_mask:0xf\n\t" "v_fmac_f32_dpp %0, %4, %13 row_newbcast:5 row_mask:0xf bank_mask:0xf\n\t" "v_fmac_f32_dpp %1, %5, %13 row_newbcast:5 row_mask:0xf bank_mask:0xf\n\t" "v_fmac_f32_dpp %2, %6, %13 row_newbcast:5 row_mask:0xf bank_mask:0xf\n\t" "v_fmac_f32_dpp %3, %7, %13 row_newbcast:5 row_mask:0xf bank_mask:0xf\n\t" "v_fmac_f32_dpp %0, %4, %14 row_newbcast:6 row_mask:0xf bank_mask:0xf\n\t" "v_fmac_f32_dpp %1, %5, %14 row_newbcast:6 row_mask:0xf bank_mask:0xf\n\t" "v_fmac_f32_dpp %2, %6, %14 row_newbcast:6 row_mask:0xf bank_mask:0xf\n\t" "v_fmac_f32_dpp %3, %7, %14 row_newbcast:6 row_mask:0xf bank_mask:0xf\n\t" : "+v"(a0), "+v"(a1), "+v"(a2), "+v"(a3) : "v"(l0), "v"(l1), "v"(l2), "v"(l3), "v"(x0), "v"(x1), "v"(x2), "v"(x3), "v"(x4), "v"(x5), "v"(x6));
    }
};
template <> struct QuadChunk<8> {
    static __device__ __forceinline__ void run(float& a0, float& a1, float& a2, float& a3, float l0, float l1, float l2, float l3, float x0, float x1, float x2, float x3, float x4, float x5, float x6, float x7) {
        asm volatile("v_fmac_f32_dpp %0, %4, %8 row_newbcast:0 row_mask:0xf bank_mask:0xf\n\t" "v_fmac_f32_dpp %1, %5, %8 row_newbcast:0 row_mask:0xf bank_mask:0xf\n\t" "v_fmac_f32_dpp %2, %6, %8 row_newbcast:0 row_mask:0xf bank_mask:0xf\n\t" "v_fmac_f32_dpp %3, %7, %8 row_newbcast:0 row_mask:0xf bank_mask:0xf\n\t" "v_fmac_f32_dpp %0, %4, %9 row_newbcast:1 row_mask:0xf bank_mask:0xf\n\t" "v_fmac_f32_dpp %1, %5, %9 row_newbcast:1 row_mask:0xf bank_mask:0xf\n\t" "v_fmac_f32_dpp %2, %6, %9 row_newbcast:1 row_mask:0xf bank_mask:0xf\n\t" "v_fmac_f32_dpp %3, %7, %9 row_newbcast:1 row_mask:0xf bank_mask:0xf\n\t" "v_fmac_f32_dpp %0, %4, %10 row_newbcast:2 row_mask:0xf bank_mask:0xf\n\t" "v_fmac_f32_dpp %1, %5, %10 row_newbcast:2 row_mask:0xf bank_mask:0xf\n\t" "v_fmac_f32_dpp %2, %6, %10 row_newbcast:2 row_mask:0xf bank_mask:0xf\n\t" "v_fmac_f32_dpp %3, %7, %10 row_newbcast:2 row_mask:0xf bank_mask:0xf\n\t" "v_fmac_f32_dpp %0, %4, %11 row_newbcast:3 row_mask:0xf bank_mask:0xf\n\t" "v_fmac_f32_dpp %1, %5, %11 row_newbcast:3 row_mask:0xf bank_mask:0xf\n\t" "v_fmac_f32_dpp %2, %6, %11 row_newbcast:3 row_mask:0xf bank_mask:0xf\n\t" "v_fmac_f32_dpp %3, %7, %11 row_newbcast:3 row_mask:0xf bank_mask:0xf\n\t" "v_fmac_f32_dpp %0, %4, %12 row_newbcast:4 row_mask:0xf bank_mask:0xf\n\t" "v_fmac_f32_dpp %1, %5, %12 row_newbcast:4 row_mask:0xf bank_mask:0xf\n\t" "v_fmac_f32_dpp %2, %6, %12 row_newbcast:4 row_mask:0xf bank_mask:0xf\n\t" "v_fmac_f32_dpp %3, %7, %12 row_newbcast:4 row_mask:0xf bank_mask:0xf\n\t" "v_fmac_f32_dpp %0, %4, %13 row_newbcast:5 row_mask:0xf bank_mask:0xf\n\t" "v_fmac_f32_dpp %1, %5, %13 row_newbcast:5 row_mask:0xf bank_mask:0xf\n\t" "v_fmac_f32_dpp %2, %6, %13 row_newbcast:5 row_mask:0xf bank_mask:0xf\n\t" "v_fmac_f32_dpp %3, %7, %13 row_newbcast:5 row_mask:0xf bank_mask:0xf\n\t" "v_fmac_f32_dpp %0, %4, %14 row_newbcast:6 row_mask:0xf bank_mask:0xf\n\t" "v_fmac_f32_dpp %1, %5, %14 row_newbcast:6 row_mask:0xf bank_mask:0xf\n\t" "v_fmac_f32_dpp %2, %6, %14 row_newbcast:6 row_mask:0xf bank_mask:0xf\n\t" "v_fmac_f32_dpp %3, %7, %14 row_newbcast:6 row_mask:0xf bank_mask:0xf\n\t" "v_fmac_f32_dpp %0, %4, %15 row_newbcast:7 row_mask:0xf bank_mask:0xf\n\t" "v_fmac_f32_dpp %1, %5, %15 row_newbcast:7 row_mask:0xf bank_mask:0xf\n\t" "v_fmac_f32_dpp %2, %6, %15 row_newbcast:7 row_mask:0xf bank_mask:0xf\n\t" "v_fmac_f32_dpp %3, %7, %15 row_newbcast:7 row_mask:0xf bank_mask:0xf\n\t" : "+v"(a0), "+v"(a1), "+v"(a2), "+v"(a3) : "v"(l0), "v"(l1), "v"(l2), "v"(l3), "v"(x0), "v"(x1), "v"(x2), "v"(x3), "v"(x4), "v"(x5), "v"(x6), "v"(x7));
    }
};
template <> struct QuadChunk<9> {
    static __device__ __forceinline__ void run(float& a0, float& a1, float& a2, float& a3, float l0, float l1, float l2, float l3, float x0, float x1, float x2, float x3, float x4, float x5, float x6, float x7, float x8) {
        asm volatile("v_fmac_f32_dpp %0, %4, %8 row_newbcast:0 row_mask:0xf bank_mask:0xf\n\t" "v_fmac_f32_dpp %1, %5, %8 row_newbcast:0 row_mask:0xf bank_mask:0xf\n\t" "v_fmac_f32_dpp %2, %6, %8 row_newbcast:0 row_mask:0xf bank_mask:0xf\n\t" "v_fmac_f32_dpp %3, %7, %8 row_newbcast:0 row_mask:0xf bank_mask:0xf\n\t" "v_fmac_f32_dpp %0, %4, %9 row_newbcast:1 row_mask:0xf bank_mask:0xf\n\t" "v_fmac_f32_dpp %1, %5, %9 row_newbcast:1 row_mask:0xf bank_mask:0xf\n\t" "v_fmac_f32_dpp %2, %6, %9 row_newbcast:1 row_mask:0xf bank_mask:0xf\n\t" "v_fmac_f32_dpp %3, %7, %9 row_newbcast:1 row_mask:0xf bank_mask:0xf\n\t" "v_fmac_f32_dpp %0, %4, %10 row_newbcast:2 row_mask:0xf bank_mask:0xf\n\t" "v_fmac_f32_dpp %1, %5, %10 row_newbcast:2 row_mask:0xf bank_mask:0xf\n\t" "v_fmac_f32_dpp %2, %6, %10 row_newbcast:2 row_mask:0xf bank_mask:0xf\n\t" "v_fmac_f32_dpp %3, %7, %10 row_newbcast:2 row_mask:0xf bank_mask:0xf\n\t" "v_fmac_f32_dpp %0, %4, %11 row_newbcast:3 row_mask:0xf bank_mask:0xf\n\t" "v_fmac_f32_dpp %1, %5, %11 row_newbcast:3 row_mask:0xf bank_mask:0xf\n\t" "v_fmac_f32_dpp %2, %6, %11 row_newbcast:3 row_mask:0xf bank_mask:0xf\n\t" "v_fmac_f32_dpp %3, %7, %11 row_newbcast:3 row_mask:0xf bank_mask:0xf\n\t" "v_fmac_f32_dpp %0, %4, %12 row_newbcast:4 row_mask:0xf bank_mask:0xf\n\t" "v_fmac_f32_dpp %1, %5, %12 row_newbcast:4 row_mask:0xf bank_mask:0xf\n\t" "v_fmac_f32_dpp %2, %6, %12 row_newbcast:4 row_mask:0xf bank_mask:0xf\n\t" "v_fmac_f32_dpp %3, %7, %12 row_newbcast:4 row_mask:0xf bank_mask:0xf\n\t" "v_fmac_f32_dpp %0, %4, %13 row_newbcast:5 row_mask:0xf bank_mask:0xf\n\t" "v_fmac_f32_dpp %1, %5, %13 row_newbcast:5 row_mask:0xf bank_mask:0xf\n\t" "v_fmac_f32_dpp %2, %6, %13 row_newbcast:5 row_mask:0xf bank_mask:0xf\n\t" "v_fmac_f32_dpp %3, %7, %13 row_newbcast:5 row_mask:0xf bank_mask:0xf\n\t" "v_fmac_f32_dpp %0, %4, %14 row_newbcast:6 row_mask:0xf bank_mask:0xf\n\t" "v_fmac_f32_dpp %1, %5, %14 row_newbcast:6 row_mask:0xf bank_mask:0xf\n\t" "v_fmac_f32_dpp %2, %6, %14 row_newbcast:6 row_mask:0xf bank_mask:0xf\n\t" "v_fmac_f32_dpp %3, %7, %14 row_newbcast:6 row_mask:0xf bank_mask:0xf\n\t" "v_fmac_f32_dpp %0, %4, %15 row_newbcast:7 row_mask:0xf bank_mask:0xf\n\t" "v_fmac_f32_dpp %1, %5, %15 row_newbcast:7 row_mask:0xf bank_mask:0xf\n\t" "v_fmac_f32_dpp %2, %6, %15 row_newbcast:7 row_mask:0xf bank_mask:0xf\n\t" "v_fmac_f32_dpp %3, %7, %15 row_newbcast:7 row_mask:0xf bank_mask:0xf\n\t" "v_fmac_f32_dpp %0, %4, %16 row_newbcast:8 row_mask:0xf bank_mask:0xf\n\t" "v_fmac_f32_dpp %1, %5, %16 row_newbcast:8 row_mask:0xf bank_mask:0xf\n\t" "v_fmac_f32_dpp %2, %6, %16 row_newbcast:8 row_mask:0xf bank_mask:0xf\n\t" "v_fmac_f32_dpp %3, %7, %16 row_newbcast:8 row_mask:0xf bank_mask:0xf\n\t" : "+v"(a0), "+v"(a1), "+v"(a2), "+v"(a3) : "v"(l0), "v"(l1), "v"(l2), "v"(l3), "v"(x0), "v"(x1), "v"(x2), "v"(x3), "v"(x4), "v"(x5), "v"(x6), "v"(x7), "v"(x8));
    }
};
template <> struct QuadChunk<10> {
    static __device__ __forceinline__ void run(float& a0, float& a1, float& a2, float& a3, float l0, float l1, float l2, float l3, float x0, float x1, float x2, float x3, float x4, float x5, float x6, float x7, float x8, float x9) {
        asm volatile("v_fmac_f32_dpp %0, %4, %8 row_newbcast:0 row_mask:0xf bank_mask:0xf\n\t" "v_fmac_f32_dpp %1, %5, %8 row_newbcast:0 row_mask:0xf bank_mask:0xf\n\t" "v_fmac_f32_dpp %2, %6, %8 row_newbcast:0 row_mask:0xf bank_mask:0xf\n\t" "v_fmac_f32_dpp %3, %7, %8 row_newbcast:0 row_mask:0xf bank_mask:0xf\n\t" "v_fmac_f32_dpp %0, %4, %9 row_newbcast:1 row_mask:0xf bank_mask:0xf\n\t" "v_fmac_f32_dpp %1, %5, %9 row_newbcast:1 row_mask:0xf bank_mask:0xf\n\t" "v_fmac_f32_dpp %2, %6, %9 row_newbcast:1 row_mask:0xf bank_mask:0xf\n\t" "v_fmac_f32_dpp %3, %7, %9 row_newbcast:1 row_mask:0xf bank_mask:0xf\n\t" "v_fmac_f32_dpp %0, %4, %10 row_newbcast:2 row_mask:0xf bank_mask:0xf\n\t" "v_fmac_f32_dpp %1, %5, %10 row_newbcast:2 row_mask:0xf bank_mask:0xf\n\t" "v_fmac_f32_dpp %2, %6, %10 row_newbcast:2 row_mask:0xf bank_mask:0xf\n\t" "v_fmac_f32_dpp %3, %7, %10 row_newbcast:2 row_mask:0xf bank_mask:0xf\n\t" "v_fmac_f32_dpp %0, %4, %11 row_newbcast:3 row_mask:0xf bank_mask:0xf\n\t" "v_fmac_f32_dpp %1, %5, %11 row_newbcast:3 row_mask:0xf bank_mask:0xf\n\t" "v_fmac_f32_dpp %2, %6, %11 row_newbcast:3 row_mask:0xf bank_mask:0xf\n\t" "v_fmac_f32_dpp %3, %7, %11 row_newbcast:3 row_mask:0xf bank_mask:0xf\n\t" "v_fmac_f32_dpp %0, %4, %12 row_newbcast:4 row_mask:0xf bank_mask:0xf\n\t" "v_fmac_f32_dpp %1, %5, %12 row_newbcast:4 row_mask:0xf bank_mask:0xf\n\t" "v_fmac_f32_dpp %2, %6, %12 row_newbcast:4 row_mask:0xf bank_mask:0xf\n\t" "v_fmac_f32_dpp %3, %7, %12 row_newbcast:4 row_mask:0xf bank_mask:0xf\n\t" "v_fmac_f32_dpp %0, %4, %13 row_newbcast:5 row_mask:0xf bank_mask:0xf\n\t" "v_fmac_f32_dpp %1, %5, %13 row_newbcast:5 row_mask:0xf bank_mask:0xf\n\t" "v_fmac_f32_dpp %2, %6, %13 row_newbcast:5 row_mask:0xf bank_mask:0xf\n\t" "v_fmac_f32_dpp %3, %7, %13 row_newbcast:5 row_mask:0xf bank_mask:0xf\n\t" "v_fmac_f32_dpp %0, %4, %14 row_newbcast:6 row_mask:0xf bank_mask:0xf\n\t" "v_fmac_f32_dpp %1, %5, %14 row_newbcast:6 row_mask:0xf bank_mask:0xf\n\t" "v_fmac_f32_dpp %2, %6, %14 row_newbcast:6 row_mask:0xf bank_mask:0xf\n\t" "v_fmac_f32_dpp %3, %7, %14 row_newbcast:6 row_mask:0xf bank_mask:0xf\n\t" "v_fmac_f32_dpp %0, %4, %15 row_newbcast:7 row_mask:0xf bank_mask:0xf\n\t" "v_fmac_f32_dpp %1, %5, %15 row_newbcast:7 row_mask:0xf bank_mask:0xf\n\t" "v_fmac_f32_dpp %2, %6, %15 row_newbcast:7 row_mask:0xf bank_mask:0xf\n\t" "v_fmac_f32_dpp %3, %7, %15 row_newbcast:7 row_mask:0xf bank_mask:0xf\n\t" "v_fmac_f32_dpp %0, %4, %16 row_newbcast:8 row_mask:0xf bank_mask:0xf\n\t" "v_fmac_f32_dpp %1, %5, %16 row_newbcast:8 row_mask:0xf bank_mask:0xf\n\t" "v_fmac_f32_dpp %2, %6, %16 row_newbcast:8 row_mask:0xf bank_mask:0xf\n\t" "v_fmac_f32_dpp %3, %7, %16 row_newbcast:8 row_mask:0xf bank_mask:0xf\n\t" "v_fmac_f32_dpp %0, %4, %17 row_newbcast:9 row_mask:0xf bank_mask:0xf\n\t" "v_fmac_f32_dpp %1, %5, %17 row_newbcast:9 row_mask:0xf bank_mask:0xf\n\t" "v_fmac_f32_dpp %2, %6, %17 row_newbcast:9 row_mask:0xf bank_mask:0xf\n\t" "v_fmac_f32_dpp %3, %7, %17 row_newbcast:9 row_mask:0xf bank_mask:0xf\n\t" : "+v"(a0), "+v"(a1), "+v"(a2), "+v"(a3) : "v"(l0), "v"(l1), "v"(l2), "v"(l3), "v"(x0), "v"(x1), "v"(x2), "v"(x3), "v"(x4), "v"(x5), "v"(x6), "v"(x7), "v"(x8), "v"(x9));
    }
};
template <> struct QuadChunk<11> {
    static __device__ __forceinline__ void run(float& a0, float& a1, float& a2, float& a3, float l0, float l1, float l2, float l3, float x0, float x1, float x2, float x3, float x4, float x5, float x6, float x7, float x8, float x9, float x10) {
        asm volatile("v_fmac_f32_dpp %0, %4, %8 row_newbcast:0 row_mask:0xf bank_mask:0xf\n\t" "v_fmac_f32_dpp %1, %5, %8 row_newbcast:0 row_mask:0xf bank_mask:0xf\n\t" "v_fmac_f32_dpp %2, %6, %8 row_newbcast:0 row_mask:0xf bank_mask:0xf\n\t" "v_fmac_f32_dpp %3, %7, %8 row_newbcast:0 row_mask:0xf bank_mask:0xf\n\t" "v_fmac_f32_dpp %0, %4, %9 row_newbcast:1 row_mask:0xf bank_mask:0xf\n\t" "v_fmac_f32_dpp %1, %5, %9 row_newbcast:1 row_mask:0xf bank_mask:0xf\n\t" "v_fmac_f32_dpp %2, %6, %9 row_newbcast:1 row_mask:0xf bank_mask:0xf\n\t" "v_fmac_f32_dpp %3, %7, %9 row_newbcast:1 row_mask:0xf bank_mask:0xf\n\t" "v_fmac_f32_dpp %0, %4, %10 row_newbcast:2 row_mask:0xf bank_mask:0xf\n\t" "v_fmac_f32_dpp %1, %5, %10 row_newbcast:2 row_mask:0xf bank_mask:0xf\n\t" "v_fmac_f32_dpp %2, %6, %10 row_newbcast:2 row_mask:0xf bank_mask:0xf\n\t" "v_fmac_f32_dpp %3, %7, %10 row_newbcast:2 row_mask:0xf bank_mask:0xf\n\t" "v_fmac_f32_dpp %0, %4, %11 row_newbcast:3 row_mask:0xf bank_mask:0xf\n\t" "v_fmac_f32_dpp %1, %5, %11 row_newbcast:3 row_mask:0xf bank_mask:0xf\n\t" "v_fmac_f32_dpp %2, %6, %11 row_newbcast:3 row_mask:0xf bank_mask:0xf\n\t" "v_fmac_f32_dpp %3, %7, %11 row_newbcast:3 row_mask:0xf bank_mask:0xf\n\t" "v_fmac_f32_dpp %0, %4, %12 row_newbcast:4 row_mask:0xf bank_mask:0xf\n\t" "v_fmac_f32_dpp %1, %5, %12 row_newbcast:4 row_mask:0xf bank_mask:0xf\n\t" "v_fmac_f32_dpp %2, %6, %12 row_newbcast:4 row_mask:0xf bank_mask:0xf\n\t" "v_fmac_f32_dpp %3, %7, %12 row_newbcast:4 row_mask:0xf bank_mask:0xf\n\t" "v_fmac_f32_dpp %0, %4, %13 row_newbcast:5 row_mask:0xf bank_mask:0xf\n\t" "v_fmac_f32_dpp %1, %5, %13 row_newbcast:5 row_mask:0xf bank_mask:0xf\n\t" "v_fmac_f32_dpp %2, %6, %13 row_newbcast:5 row_mask:0xf bank_mask:0xf\n\t" "v_fmac_f32_dpp %3, %7, %13 row_newbcast:5 row_mask:0xf bank_mask:0xf\n\t" "v_fmac_f32_dpp %0, %4, %14 row_newbcast:6 row_mask:0xf bank_mask:0xf\n\t" "v_fmac_f32_dpp %1, %5, %14 row_newbcast:6 row_mask:0xf bank_mask:0xf\n\t" "v_fmac_f32_dpp %2, %6, %14 row_newbcast:6 row_mask:0xf bank_mask:0xf\n\t" "v_fmac_f32_dpp %3, %7, %14 row_newbcast:6 row_mask:0xf bank_mask:0xf\n\t" "v_fmac_f32_dpp %0, %4, %15 row_newbcast:7 row_mask:0xf bank_mask:0xf\n\t" "v_fmac_f32_dpp %1, %5, %15 row_newbcast:7 row_mask:0xf bank_mask:0xf\n\t" "v_fmac_f32_dpp %2, %6, %15 row_newbcast:7 row_mask:0xf bank_mask:0xf\n\t" "v_fmac_f32_dpp %3, %7, %15 row_newbcast:7 row_mask:0xf bank_mask:0xf\n\t" "v_fmac_f32_dpp %0, %4, %16 row_newbcast:8 row_mask:0xf bank_mask:0xf\n\t" "v_fmac_f32_dpp %1, %5, %16 row_newbcast:8 row_mask:0xf bank_mask:0xf\n\t" "v_fmac_f32_dpp %2, %6, %16 row_newbcast:8 row_mask:0xf bank_mask:0xf\n\t" "v_fmac_f32_dpp %3, %7, %16 row_newbcast:8 row_mask:0xf bank_mask:0xf\n\t" "v_fmac_f32_dpp %0, %4, %17 row_newbcast:9 row_mask:0xf bank_mask:0xf\n\t" "v_fmac_f32_dpp %1, %5, %17 row_newbcast:9 row_mask:0xf bank_mask:0xf\n\t" "v_fmac_f32_dpp %2, %6, %17 row_newbcast:9 row_mask:0xf bank_mask:0xf\n\t" "v_fmac_f32_dpp %3, %7, %17 row_newbcast:9 row_mask:0xf bank_mask:0xf\n\t" "v_fmac_f32_dpp %0, %4, %18 row_newbcast:10 row_mask:0xf bank_mask:0xf\n\t" "v_fmac_f32_dpp %1, %5, %18 row_newbcast:10 row_mask:0xf bank_mask:0xf\n\t" "v_fmac_f32_dpp %2, %6, %18 row_newbcast:10 row_mask:0xf bank_mask:0xf\n\t" "v_fmac_f32_dpp %3, %7, %18 row_newbcast:10 row_mask:0xf bank_mask:0xf\n\t" : "+v"(a0), "+v"(a1), "+v"(a2), "+v"(a3) : "v"(l0), "v"(l1), "v"(l2), "v"(l3), "v"(x0), "v"(x1), "v"(x2), "v"(x3), "v"(x4), "v"(x5), "v"(x6), "v"(x7), "v"(x8), "v"(x9), "v"(x10));
    }
};
template <> struct QuadChunk<12> {
    static __device__ __forceinline__ void run(float& a0, float& a1, float& a2, float& a3, float l0, float l1, float l2, float l3, float x0, float x1, float x2, float x3, float x4, float x5, float x6, float x7, float x8, float x9, float x10, float x11) {
        asm volatile("v_fmac_f32_dpp %0, %4, %8 row_newbcast:0 row_mask:0xf bank_mask:0xf\n\t" "v_fmac_f32_dpp %1, %5, %8 row_newbcast:0 row_mask:0xf bank_mask:0xf\n\t" "v_fmac_f32_dpp %2, %6, %8 row_newbcast:0 row_mask:0xf bank_mask:0xf\n\t" "v_fmac_f32_dpp %3, %7, %8 row_newbcast:0 row_mask:0xf bank_mask:0xf\n\t" "v_fmac_f32_dpp %0, %4, %9 row_newbcast:1 row_mask:0xf bank_mask:0xf\n\t" "v_fmac_f32_dpp %1, %5, %9 row_newbcast:1 row_mask:0xf bank_mask:0xf\n\t" "v_fmac_f32_dpp %2, %6, %9 row_newbcast:1 row_mask:0xf bank_mask:0xf\n\t" "v_fmac_f32_dpp %3, %7, %9 row_newbcast:1 row_mask:0xf bank_mask:0xf\n\t" "v_fmac_f32_dpp %0, %4, %10 row_newbcast:2 row_mask:0xf bank_mask:0xf\n\t" "v_fmac_f32_dpp %1, %5, %10 row_newbcast:2 row_mask:0xf bank_mask:0xf\n\t" "v_fmac_f32_dpp %2, %6, %10 row_newbcast:2 row_mask:0xf bank_mask:0xf\n\t" "v_fmac_f32_dpp %3, %7, %10 row_newbcast:2 row_mask:0xf bank_mask:0xf\n\t" "v_fmac_f32_dpp %0, %4, %11 row_newbcast:3 row_mask:0xf bank_mask:0xf\n\t" "v_fmac_f32_dpp %1, %5, %11 row_newbcast:3 row_mask:0xf bank_mask:0xf\n\t" "v_fmac_f32_dpp %2, %6, %11 row_newbcast:3 row_mask:0xf bank_mask:0xf\n\t" "v_fmac_f32_dpp %3, %7, %11 row_newbcast:3 row_mask:0xf bank_mask:0xf\n\t" "v_fmac_f32_dpp %0, %4, %12 row_newbcast:4 row_mask:0xf bank_mask:0xf\n\t" "v_fmac_f32_dpp %1, %5, %12 row_newbcast:4 row_mask:0xf bank_mask:0xf\n\t" "v_fmac_f32_dpp %2, %6, %12 row_newbcast:4 row_mask:0xf bank_mask:0xf\n\t" "v_fmac_f32_dpp %3, %7, %12 row_newbcast:4 row_mask:0xf bank_mask:0xf\n\t" "v_fmac_f32_dpp %0, %4, %13 row_newbcast:5 row_mask:0xf bank_mask:0xf\n\t" "v_fmac_f32_dpp %1, %5, %13 row_newbcast:5 row_mask:0xf bank_mask:0xf\n\t" "v_fmac_f32_dpp %2, %6, %13 row_newbcast:5 row_mask:0xf bank_mask:0xf\n\t" "v_fmac_f32_dpp %3, %7, %13 row_newbcast:5 row_mask:0xf bank_mask:0xf\n\t" "v_fmac_f32_dpp %0, %4, %14 row_newbcast:6 row_mask:0xf bank_mask:0xf\n\t" "v_fmac_f32_dpp %1, %5, %14 row_newbcast:6 row_mask:0xf bank_mask:0xf\n\t" "v_fmac_f32_dpp %2, %6, %14 row_newbcast:6 row_mask:0xf bank_mask:0xf\n\t" "v_fmac_f32_dpp %3, %7, %14 row_newbcast:6 row_mask:0xf bank_mask:0xf\n\t" "v_fmac_f32_dpp %0, %4, %15 row_newbcast:7 row_mask:0xf bank_mask:0xf\n\t" "v_fmac_f32_dpp %1, %5, %15 row_newbcast:7 row_mask:0xf bank_mask:0xf\n\t" "v_fmac_f32_dpp %2, %6, %15 row_newbcast:7 row_mask:0xf bank_mask:0xf\n\t" "v_fmac_f32_dpp %3, %7, %15 row_newbcast:7 row_mask:0xf bank_mask:0xf\n\t" "v_fmac_f32_dpp %0, %4, %16 row_newbcast:8 row_mask:0xf bank_mask:0xf\n\t" "v_fmac_f32_dpp %1, %5, %16 row_newbcast:8 row_mask:0xf bank_mask:0xf\n\t" "v_fmac_f32_dpp %2, %6, %16 row_newbcast:8 row_mask:0xf bank_mask:0xf\n\t" "v_fmac_f32_dpp %3, %7, %16 row_newbcast:8 row_mask:0xf bank_mask:0xf\n\t" "v_fmac_f32_dpp %0, %4, %17 row_newbcast:9 row_mask:0xf bank_mask:0xf\n\t" "v_fmac_f32_dpp %1, %5, %17 row_newbcast:9 row_mask:0xf bank_mask:0xf\n\t" "v_fmac_f32_dpp %2, %6, %17 row_newbcast:9 row_mask:0xf bank_mask:0xf\n\t" "v_fmac_f32_dpp %3, %7, %17 row_newbcast:9 row_mask:0xf bank_mask:0xf\n\t" "v_fmac_f32_dpp %0, %4, %18 row_newbcast:10 row_mask:0xf bank_mask:0xf\n\t" "v_fmac_f32_dpp %1, %5, %18 row_newbcast:10 row_mask:0xf bank_mask:0xf\n\t" "v_fmac_f32_dpp %2, %6, %18 row_newbcast:10 row_mask:0xf bank_mask:0xf\n\t" "v_fmac_f32_dpp %3, %7, %18 row_newbcast:10 row_mask:0xf bank_mask:0xf\n\t" "v_fmac_f32_dpp %0, %4, %19 row_newbcast:11 row_mask:0xf bank_mask:0xf\n\t" "v_fmac_f32_dpp %1, %5, %19 row_newbcast:11 row_mask:0xf bank_mask:0xf\n\t" "v_fmac_f32_dpp %2, %6, %19 row_newbcast:11 row_mask:0xf bank_mask:0xf\n\t" "v_fmac_f32_dpp %3, %7, %19 row_newbcast:11 row_mask:0xf bank_mask:0xf\n\t" : "+v"(a0), "+v"(a1), "+v"(a2), "+v"(a3) : "v"(l0), "v"(l1), "v"(l2), "v"(l3), "v"(x0), "v"(x1), "v"(x2), "v"(x3), "v"(x4), "v"(x5), "v"(x6), "v"(x7), "v"(x8), "v"(x9), "v"(x10), "v"(x11));
    }
};
template <> struct QuadChunk<13> {
    static __device__ __forceinline__ void run(float& a0, float& a1, float& a2, float& a3, float l0, float l1, float l2, float l3, float x0, float x1, float x2, float x3, float x4, float x5, float x6, float x7, float x8, float x9, float x10, float x11, float x12) {
        asm volatile("v_fmac_f32_dpp %0, %4, %8 row_newbcast:0 row_mask:0xf bank_mask:0xf\n\t" "v_fmac_f32_dpp %1, %5, %8 row_newbcast:0 row_mask:0xf bank_mask:0xf\n\t" "v_fmac_f32_dpp %2, %6, %8 row_newbcast:0 row_mask:0xf bank_mask:0xf\n\t" "v_fmac_f32_dpp %3, %7, %8 row_newbcast:0 row_mask:0xf bank_mask:0xf\n\t" "v_fmac_f32_dpp %0, %4, %9 row_newbcast:1 row_mask:0xf bank_mask:0xf\n\t" "v_fmac_f32_dpp %1, %5, %9 row_newbcast:1 row_mask:0xf bank_mask:0xf\n\t" "v_fmac_f32_dpp %2, %6, %9 row_newbcast:1 row_mask:0xf bank_mask:0xf\n\t" "v_fmac_f32_dpp %3, %7, %9 row_newbcast:1 row_mask:0xf bank_mask:0xf\n\t" "v_fmac_f32_dpp %0, %4, %10 row_newbcast:2 row_mask:0xf bank_mask:0xf\n\t" "v_fmac_f32_dpp %1, %5, %10 row_newbcast:2 row_mask:0xf bank_mask:0xf\n\t" "v_fmac_f32_dpp %2, %6, %10 row_newbcast:2 row_mask:0xf bank_mask:0xf\n\t" "v_fmac_f32_dpp %3, %7, %10 row_newbcast:2 row_mask:0xf bank_mask:0xf\n\t" "v_fmac_f32_dpp %0, %4, %11 row_newbcast:3 row_mask:0xf bank_mask:0xf\n\t" "v_fmac_f32_dpp %1, %5, %11 row_newbcast:3 row_mask:0xf bank_mask:0xf\n\t" "v_fmac_f32_dpp %2, %6, %11 row_newbcast:3 row_mask:0xf bank_mask:0xf\n\t" "v_fmac_f32_dpp %3, %7, %11 row_newbcast:3 row_mask:0xf bank_mask:0xf\n\t" "v_fmac_f32_dpp %0, %4, %12 row_newbcast:4 row_mask:0xf bank_mask:0xf\n\t" "v_fmac_f32_dpp %1, %5, %12 row_newbcast:4 row_mask:0xf bank_mask:0xf\n\t" "v_fmac_f32_dpp %2, %6, %12 row_newbcast:4 row_mask:0xf bank_mask:0xf\n\t" "v_fmac_f32_dpp %3, %7, %12 row_newbcast:4 row_mask:0xf bank_mask:0xf\n\t" "v_fmac_f32_dpp %0, %4, %13 row_newbcast:5 row_mask:0xf bank_mask:0xf\n\t" "v_fmac_f32_dpp %1, %5, %13 row_newbcast:5 row_mask:0xf bank_mask:0xf\n\t" "v_fmac_f32_dpp %2, %6, %13 row_newbcast:5 row_mask:0xf bank_mask:0xf\n\t" "v_fmac_f32_dpp %3, %7, %13 row_newbcast:5 row_mask:0xf bank_mask:0xf\n\t" "v_fmac_f32_dpp %0, %4, %14 row_newbcast:6 row_mask:0xf bank_mask:0xf\n\t" "v_fmac_f32_dpp %1, %5, %14 row_newbcast:6 row_mask:0xf bank_mask:0xf\n\t" "v_fmac_f32_dpp %2, %6, %14 row_newbcast:6 row_mask:0xf bank_mask:0xf\n\t" "v_fmac_f32_dpp %3, %7, %14 row_newbcast:6 row_mask:0xf bank_mask:0xf\n\t" "v_fmac_f32_dpp %0, %4, %15 row_newbcast:7 row_mask:0xf bank_mask:0xf\n\t" "v_fmac_f32_dpp %1, %5, %15 row_newbcast:7 row_mask:0xf bank_mask:0xf\n\t" "v_fmac_f32_dpp %2, %6, %15 row_newbcast:7 row_mask:0xf bank_mask:0xf\n\t" "v_fmac_f32_dpp %3, %7, %15 row_newbcast:7 row_mask:0xf bank_mask:0xf\n\t" "v_fmac_f32_dpp %0, %4, %16 row_newbcast:8 row_mask:0xf bank_mask:0xf\n\t" "v_fmac_f32_dpp %1, %5, %16 row_newbcast:8 row_mask:0xf bank_mask:0xf\n\t" "v_fmac_f32_dpp %2, %6, %16 row_newbcast:8 row_mask:0xf bank_mask:0xf\n\t" "v_fmac_f32_dpp %3, %7, %16 row_newbcast:8 row_mask:0xf bank_mask:0xf\n\t" "v_fmac_f32_dpp %0, %4, %17 row_newbcast:9 row_mask:0xf bank_mask:0xf\n\t" "v_fmac_f32_dpp %1, %5, %17 row_newbcast:9 row_mask:0xf bank_mask:0xf\n\t" "v_fmac_f32_dpp %2, %6, %17 row_newbcast:9 row_mask:0xf bank_mask:0xf\n\t" "v_fmac_f32_dpp %3, %7, %17 row_newbcast:9 row_mask:0xf bank_mask:0xf\n\t" "v_fmac_f32_dpp %0, %4, %18 row_newbcast:10 row_mask:0xf bank_mask:0xf\n\t" "v_fmac_f32_dpp %1, %5, %18 row_newbcast:10 row_mask:0xf bank_mask:0xf\n\t" "v_fmac_f32_dpp %2, %6, %18 row_newbcast:10 row_mask:0xf bank_mask:0xf\n\t" "v_fmac_f32_dpp %3, %7, %18 row_newbcast:10 row_mask:0xf bank_mask:0xf\n\t" "v_fmac_f32_dpp %0, %4, %19 row_newbcast:11 row_mask:0xf bank_mask:0xf\n\t" "v_fmac_f32_dpp %1, %5, %19 row_newbcast:11 row_mask:0xf bank_mask:0xf\n\t" "v_fmac_f32_dpp %2, %6, %19 row_newbcast:11 row_mask:0xf bank_mask:0xf\n\t" "v_fmac_f32_dpp %3, %7, %19 row_newbcast:11 row_mask:0xf bank_mask:0xf\n\t" "v_fmac_f32_dpp %0, %4, %20 row_newbcast:12 row_mask:0xf bank_mask:0xf\n\t" "v_fmac_f32_dpp %1, %5, %20 row_newbcast:12 row_mask:0xf bank_mask:0xf\n\t" "v_fmac_f32_dpp %2, %6, %20 row_newbcast:12 row_mask:0xf bank_mask:0xf\n\t" "v_fmac_f32_dpp %3, %7, %20 row_newbcast:12 row_mask:0xf bank_mask:0xf\n\t" : "+v"(a0), "+v"(a1), "+v"(a2), "+v"(a3) : "v"(l0), "v"(l1), "v"(l2), "v"(l3), "v"(x0), "v"(x1), "v"(x2), "v"(x3), "v"(x4), "v"(x5), "v"(x6), "v"(x7), "v"(x8), "v"(x9), "v"(x10), "v"(x11), "v"(x12));
    }
};
template <> struct QuadChunk<14> {
    static __device__ __forceinline__ void run(float& a0, float& a1, float& a2, float& a3, float l0, float l1, float l2, float l3, float x0, float x1, float x2, float x3, float x4, float x5, float x6, float x7, float x8, float x9, float x10, float x11, float x12, float x13) {
        asm volatile("v_fmac_f32_dpp %0, %4, %8 row_newbcast:0 row_mask:0xf bank_mask:0xf\n\t" "v_fmac_f32_dpp %1, %5, %8 row_newbcast:0 row_mask:0xf bank_mask:0xf\n\t" "v_fmac_f32_dpp %2, %6, %8 row_newbcast:0 row_mask:0xf bank_mask:0xf\n\t" "v_fmac_f32_dpp %3, %7, %8 row_newbcast:0 row_mask:0xf bank_mask:0xf\n\t" "v_fmac_f32_dpp %0, %4, %9 row_newbcast:1 row_mask:0xf bank_mask:0xf\n\t" "v_fmac_f32_dpp %1, %5, %9 row_newbcast:1 row_mask:0xf bank_mask:0xf\n\t" "v_fmac_f32_dpp %2, %6, %9 row_newbcast:1 row_mask:0xf bank_mask:0xf\n\t" "v_fmac_f32_dpp %3, %7, %9 row_newbcast:1 row_mask:0xf bank_mask:0xf\n\t" "v_fmac_f32_dpp %0, %4, %10 row_newbcast:2 row_mask:0xf bank_mask:0xf\n\t" "v_fmac_f32_dpp %1, %5, %10 row_newbcast:2 row_mask:0xf bank_mask:0xf\n\t" "v_fmac_f32_dpp %2, %6, %10 row_newbcast:2 row_mask:0xf bank_mask:0xf\n\t" "v_fmac_f32_dpp %3, %7, %10 row_newbcast:2 row_mask:0xf bank_mask:0xf\n\t" "v_fmac_f32_dpp %0, %4, %11 row_newbcast:3 row_mask:0xf bank_mask:0xf\n\t" "v_fmac_f32_dpp %1, %5, %11 row_newbcast:3 row_mask:0xf bank_mask:0xf\n\t" "v_fmac_f32_dpp %2, %6, %11 row_newbcast:3 row_mask:0xf bank_mask:0xf\n\t" "v_fmac_f32_dpp %3, %7, %11 row_newbcast:3 row_mask:0xf bank_mask:0xf\n\t" "v_fmac_f32_dpp %0, %4, %12 row_newbcast:4 row_mask:0xf bank_mask:0xf\n\t" "v_fmac_f32_dpp %1, %5, %12 row_newbcast:4 row_mask:0xf bank_mask:0xf\n\t" "v_fmac_f32_dpp %2, %6, %12 row_newbcast:4 row_mask:0xf bank_mask:0xf\n\t" "v_fmac_f32_dpp %3, %7, %12 row_newbcast:4 row_mask:0xf bank_mask:0xf\n\t" "v_fmac_f32_dpp %0, %4, %13 row_newbcast:5 row_mask:0xf bank_mask:0xf\n\t" "v_fmac_f32_dpp %1, %5, %13 row_newbcast:5 row_mask:0xf bank_mask:0xf\n\t" "v_fmac_f32_dpp %2, %6, %13 row_newbcast:5 row_mask:0xf bank_mask:0xf\n\t" "v_fmac_f32_dpp %3, %7, %13 row_newbcast:5 row_mask:0xf bank_mask:0xf\n\t" "v_fmac_f32_dpp %0, %4, %14 row_newbcast:6 row_mask:0xf bank_mask:0xf\n\t" "v_fmac_f32_dpp %1, %5, %14 row_newbcast:6 row_mask:0xf bank_mask:0xf\n\t" "v_fmac_f32_dpp %2, %6, %14 row_newbcast:6 row_mask:0xf bank_mask:0xf\n\t" "v_fmac_f32_dpp %3, %7, %14 row_newbcast:6 row_mask:0xf bank_mask:0xf\n\t" "v_fmac_f32_dpp %0, %4, %15 row_newbcast:7 row_mask:0xf bank_mask:0xf\n\t" "v_fmac_f32_dpp %1, %5, %15 row_newbcast:7 row_mask:0xf bank_mask:0xf\n\t" "v_fmac_f32_dpp %2, %6, %15 row_newbcast:7 row_mask:0xf bank_mask:0xf\n\t" "v_fmac_f32_dpp %3, %7, %15 row_newbcast:7 row_mask:0xf bank_mask:0xf\n\t" "v_fmac_f32_dpp %0, %4, %16 row_newbcast:8 row_mask:0xf bank_mask:0xf\n\t" "v_fmac_f32_dpp %1, %5, %16 row_newbcast:8 row_mask:0xf bank_mask:0xf\n\t" "v_fmac_f32_dpp %2, %6, %16 row_newbcast:8 row_mask:0xf bank_mask:0xf\n\t" "v_fmac_f32_dpp %3, %7, %16 row_newbcast:8 row_mask:0xf bank_mask:0xf\n\t" "v_fmac_f32_dpp %0, %4, %17 row_newbcast:9 row_mask:0xf bank_mask:0xf\n\t" "v_fmac_f32_dpp %1, %5, %17 row_newbcast:9 row_mask:0xf bank_mask:0xf\n\t" "v_fmac_f32_dpp %2, %6, %17 row_newbcast:9 row_mask:0xf bank_mask:0xf\n\t" "v_fmac_f32_dpp %3, %7, %17 row_newbcast:9 row_mask:0xf bank_mask:0xf\n\t" "v_fmac_f32_dpp %0, %4, %18 row_newbcast:10 row_mask:0xf bank_mask:0xf\n\t" "v_fmac_f32_dpp %1, %5, %18 row_newbcast:10 row_mask:0xf bank_mask:0xf\n\t" "v_fmac_f32_dpp %2, %6, %18 row_newbcast:10 row_mask:0xf bank_mask:0xf\n\t" "v_fmac_f32_dpp %3, %7, %18 row_newbcast:10 row_mask:0xf bank_mask:0xf\n\t" "v_fmac_f32_dpp %0, %4, %19 row_newbcast:11 row_mask:0xf bank_mask:0xf\n\t" "v_fmac_f32_dpp %1, %5, %19 row_newbcast:11 row_mask:0xf bank_mask:0xf\n\t" "v_fmac_f32_dpp %2, %6, %19 row_newbcast:11 row_mask:0xf bank_mask:0xf\n\t" "v_fmac_f32_dpp %3, %7, %19 row_newbcast:11 row_mask:0xf bank_mask:0xf\n\t" "v_fmac_f32_dpp %0, %4, %20 row_newbcast:12 row_mask:0xf bank_mask:0xf\n\t" "v_fmac_f32_dpp %1, %5, %20 row_newbcast:12 row_mask:0xf bank_mask:0xf\n\t" "v_fmac_f32_dpp %2, %6, %20 row_newbcast:12 row_mask:0xf bank_mask:0xf\n\t" "v_fmac_f32_dpp %3, %7, %20 row_newbcast:12 row_mask:0xf bank_mask:0xf\n\t" "v_fmac_f32_dpp %0, %4, %21 row_newbcast:13 row_mask:0xf bank_mask:0xf\n\t" "v_fmac_f32_dpp %1, %5, %21 row_newbcast:13 row_mask:0xf bank_mask:0xf\n\t" "v_fmac_f32_dpp %2, %6, %21 row_newbcast:13 row_mask:0xf bank_mask:0xf\n\t" "v_fmac_f32_dpp %3, %7, %21 row_newbcast:13 row_mask:0xf bank_mask:0xf\n\t" : "+v"(a0), "+v"(a1), "+v"(a2), "+v"(a3) : "v"(l0), "v"(l1), "v"(l2), "v"(l3), "v"(x0), "v"(x1), "v"(x2), "v"(x3), "v"(x4), "v"(x5), "v"(x6), "v"(x7), "v"(x8), "v"(x9), "v"(x10), "v"(x11), "v"(x12), "v"(x13));
    }
};
template <> struct QuadChunk<15> {
    static __device__ __forceinline__ void run(float& a0, float& a1, float& a2, float& a3, float l0, float l1, float l2, float l3, float x0, float x1, float x2, float x3, float x4, float x5, float x6, float x7, float x8, float x9, float x10, float x11, float x12, float x13, float x14) {
        asm volatile("v_fmac_f32_dpp %0, %4, %8 row_newbcast:0 row_mask:0xf bank_mask:0xf\n\t" "v_fmac_f32_dpp %1, %5, %8 row_newbcast:0 row_mask:0xf bank_mask:0xf\n\t" "v_fmac_f32_dpp %2, %6, %8 row_newbcast:0 row_mask:0xf bank_mask:0xf\n\t" "v_fmac_f32_dpp %3, %7, %8 row_newbcast:0 row_mask:0xf bank_mask:0xf\n\t" "v_fmac_f32_dpp %0, %4, %9 row_newbcast:1 row_mask:0xf bank_mask:0xf\n\t" "v_fmac_f32_dpp %1, %5, %9 row_newbcast:1 row_mask:0xf bank_mask:0xf\n\t" "v_fmac_f32_dpp %2, %6, %9 row_newbcast:1 row_mask:0xf bank_mask:0xf\n\t" "v_fmac_f32_dpp %3, %7, %9 row_newbcast:1 row_mask:0xf bank_mask:0xf\n\t" "v_fmac_f32_dpp %0, %4, %10 row_newbcast:2 row_mask:0xf bank_mask:0xf\n\t" "v_fmac_f32_dpp %1, %5, %10 row_newbcast:2 row_mask:0xf bank_mask:0xf\n\t" "v_fmac_f32_dpp %2, %6, %10 row_newbcast:2 row_mask:0xf bank_mask:0xf\n\t" "v_fmac_f32_dpp %3, %7, %10 row_newbcast:2 row_mask:0xf bank_mask:0xf\n\t" "v_fmac_f32_dpp %0, %4, %11 row_newbcast:3 row_mask:0xf bank_mask:0xf\n\t" "v_fmac_f32_dpp %1, %5, %11 row_newbcast:3 row_mask:0xf bank_mask:0xf\n\t" "v_fmac_f32_dpp %2, %6, %11 row_newbcast:3 row_mask:0xf bank_mask:0xf\n\t" "v_fmac_f32_dpp %3, %7, %11 row_newbcast:3 row_mask:0xf bank_mask:0xf\n\t" "v_fmac_f32_dpp %0, %4, %12 row_newbcast:4 row_mask:0xf bank_mask:0xf\n\t" "v_fmac_f32_dpp %1, %5, %12 row_newbcast:4 row_mask:0xf bank_mask:0xf\n\t" "v_fmac_f32_dpp %2, %6, %12 row_newbcast:4 row_mask:0xf bank_mask:0xf\n\t" "v_fmac_f32_dpp %3, %7, %12 row_newbcast:4 row_mask:0xf bank_mask:0xf\n\t" "v_fmac_f32_dpp %0, %4, %13 row_newbcast:5 row_mask:0xf bank_mask:0xf\n\t" "v_fmac_f32_dpp %1, %5, %13 row_newbcast:5 row_mask:0xf bank_mask:0xf\n\t" "v_fmac_f32_dpp %2, %6, %13 row_newbcast:5 row_mask:0xf bank_mask:0xf\n\t" "v_fmac_f32_dpp %3, %7, %13 row_newbcast:5 row_mask:0xf bank_mask:0xf\n\t" "v_fmac_f32_dpp %0, %4, %14 row_newbcast:6 row_mask:0xf bank_mask:0xf\n\t" "v_fmac_f32_dpp %1, %5, %14 row_newbcast:6 row_mask:0xf bank_mask:0xf\n\t" "v_fmac_f32_dpp %2, %6, %14 row_newbcast:6 row_mask:0xf bank_mask:0xf\n\t" "v_fmac_f32_dpp %3, %7, %14 row_newbcast:6 row_mask:0xf bank_mask:0xf\n\t" "v_fmac_f32_dpp %0, %4, %15 row_newbcast:7 row_mask:0xf bank_mask:0xf\n\t" "v_fmac_f32_dpp %1, %5, %15 row_newbcast:7 row_mask:0xf bank_mask:0xf\n\t" "v_fmac_f32_dpp %2, %6, %15 row_newbcast:7 row_mask:0xf bank_mask:0xf\n\t" "v_fmac_f32_dpp %3, %7, %15 row_newbcast:7 row_mask:0xf bank_mask:0xf\n\t" "v_fmac_f32_dpp %0, %4, %16 row_newbcast:8 row_mask:0xf bank_mask:0xf\n\t" "v_fmac_f32_dpp %1, %5, %16 row_newbcast:8 row_mask:0xf bank_mask:0xf\n\t" "v_fmac_f32_dpp %2, %6, %16 row_newbcast:8 row_mask:0xf bank_mask:0xf\n\t" "v_fmac_f32_dpp %3, %7, %16 row_newbcast:8 row_mask:0xf bank_mask:0xf\n\t" "v_fmac_f32_dpp %0, %4, %17 row_newbcast:9 row_mask:0xf bank_mask:0xf\n\t" "v_fmac_f32_dpp %1, %5, %17 row_newbcast:9 row_mask:0xf bank_mask:0xf\n\t" "v_fmac_f32_dpp %2, %6, %17 row_newbcast:9 row_mask:0xf bank_mask:0xf\n\t" "v_fmac_f32_dpp %3, %7, %17 row_newbcast:9 row_mask:0xf bank_mask:0xf\n\t" "v_fmac_f32_dpp %0, %4, %18 row_newbcast:10 row_mask:0xf bank_mask:0xf\n\t" "v_fmac_f32_dpp %1, %5, %18 row_newbcast:10 row_mask:0xf bank_mask:0xf\n\t" "v_fmac_f32_dpp %2, %6, %18 row_newbcast:10 row_mask:0xf bank_mask:0xf\n\t" "v_fmac_f32_dpp %3, %7, %18 row_newbcast:10 row_mask:0xf bank_mask:0xf\n\t" "v_fmac_f32_dpp %0, %4, %19 row_newbcast:11 row_mask:0xf bank_mask:0xf\n\t" "v_fmac_f32_dpp %1, %5, %19 row_newbcast:11 row_mask:0xf bank_mask:0xf\n\t" "v_fmac_f32_dpp %2, %6, %19 row_newbcast:11 row_mask:0xf bank_mask:0xf\n\t" "v_fmac_f32_dpp %3, %7, %19 row_newbcast:11 row_mask:0xf bank_mask:0xf\n\t" "v_fmac_f32_dpp %0, %4, %20 row_newbcast:12 row_mask:0xf bank_mask:0xf\n\t" "v_fmac_f32_dpp %1, %5, %20 row_newbcast:12 row_mask:0xf bank_mask:0xf\n\t" "v_fmac_f32_dpp %2, %6, %20 row_newbcast:12 row_mask:0xf bank_mask:0xf\n\t" "v_fmac_f32_dpp %3, %7, %20 row_newbcast:12 row_mask:0xf bank_mask:0xf\n\t" "v_fmac_f32_dpp %0, %4, %21 row_newbcast:13 row_mask:0xf bank_mask:0xf\n\t" "v_fmac_f32_dpp %1, %5, %21 row_newbcast:13 row_mask:0xf bank_mask:0xf\n\t" "v_fmac_f32_dpp %2, %6, %21 row_newbcast:13 row_mask:0xf bank_mask:0xf\n\t" "v_fmac_f32_dpp %3, %7, %21 row_newbcast:13 row_mask:0xf bank_mask:0xf\n\t" "v_fmac_f32_dpp %0, %4, %22 row_newbcast:14 row_mask:0xf bank_mask:0xf\n\t" "v_fmac_f32_dpp %1, %5, %22 row_newbcast:14 row_mask:0xf bank_mask:0xf\n\t" "v_fmac_f32_dpp %2, %6, %22 row_newbcast:14 row_mask:0xf bank_mask:0xf\n\t" "v_fmac_f32_dpp %3, %7, %22 row_newbcast:14 row_mask:0xf bank_mask:0xf\n\t" : "+v"(a0), "+v"(a1), "+v"(a2), "+v"(a3) : "v"(l0), "v"(l1), "v"(l2), "v"(l3), "v"(x0), "v"(x1), "v"(x2), "v"(x3), "v"(x4), "v"(x5), "v"(x6), "v"(x7), "v"(x8), "v"(x9), "v"(x10), "v"(x11), "v"(x12), "v"(x13), "v"(x14));
    }
};
template <> struct QuadChunk<16> {
    static __device__ __forceinline__ void run(float& a0, float& a1, float& a2, float& a3, float l0, float l1, float l2, float l3, float x0, float x1, float x2, float x3, float x4, float x5, float x6, float x7, float x8, float x9, float x10, float x11, float x12, float x13, float x14, float x15) {
        asm volatile("v_fmac_f32_dpp %0, %4, %8 row_newbcast:0 row_mask:0xf bank_mask:0xf\n\t" "v_fmac_f32_dpp %1, %5, %8 row_newbcast:0 row_mask:0xf bank_mask:0xf\n\t" "v_fmac_f32_dpp %2, %6, %8 row_newbcast:0 row_mask:0xf bank_mask:0xf\n\t" "v_fmac_f32_dpp %3, %7, %8 row_newbcast:0 row_mask:0xf bank_mask:0xf\n\t" "v_fmac_f32_dpp %0, %4, %9 row_newbcast:1 row_mask:0xf bank_mask:0xf\n\t" "v_fmac_f32_dpp %1, %5, %9 row_newbcast:1 row_mask:0xf bank_mask:0xf\n\t" "v_fmac_f32_dpp %2, %6, %9 row_newbcast:1 row_mask:0xf bank_mask:0xf\n\t" "v_fmac_f32_dpp %3, %7, %9 row_newbcast:1 row_mask:0xf bank_mask:0xf\n\t" "v_fmac_f32_dpp %0, %4, %10 row_newbcast:2 row_mask:0xf bank_mask:0xf\n\t" "v_fmac_f32_dpp %1, %5, %10 row_newbcast:2 row_mask:0xf bank_mask:0xf\n\t" "v_fmac_f32_dpp %2, %6, %10 row_newbcast:2 row_mask:0xf bank_mask:0xf\n\t" "v_fmac_f32_dpp %3, %7, %10 row_newbcast:2 row_mask:0xf bank_mask:0xf\n\t" "v_fmac_f32_dpp %0, %4, %11 row_newbcast:3 row_mask:0xf bank_mask:0xf\n\t" "v_fmac_f32_dpp %1, %5, %11 row_newbcast:3 row_mask:0xf bank_mask:0xf\n\t" "v_fmac_f32_dpp %2, %6, %11 row_newbcast:3 row_mask:0xf bank_mask:0xf\n\t" "v_fmac_f32_dpp %3, %7, %11 row_newbcast:3 row_mask:0xf bank_mask:0xf\n\t" "v_fmac_f32_dpp %0, %4, %12 row_newbcast:4 row_mask:0xf bank_mask:0xf\n\t" "v_fmac_f32_dpp %1, %5, %12 row_newbcast:4 row_mask:0xf bank_mask:0xf\n\t" "v_fmac_f32_dpp %2, %6, %12 row_newbcast:4 row_mask:0xf bank_mask:0xf\n\t" "v_fmac_f32_dpp %3, %7, %12 row_newbcast:4 row_mask:0xf bank_mask:0xf\n\t" "v_fmac_f32_dpp %0, %4, %13 row_newbcast:5 row_mask:0xf bank_mask:0xf\n\t" "v_fmac_f32_dpp %1, %5, %13 row_newbcast:5 row_mask:0xf bank_mask:0xf\n\t" "v_fmac_f32_dpp %2, %6, %13 row_newbcast:5 row_mask:0xf bank_mask:0xf\n\t" "v_fmac_f32_dpp %3, %7, %13 row_newbcast:5 row_mask:0xf bank_mask:0xf\n\t" "v_fmac_f32_dpp %0, %4, %14 row_newbcast:6 row_mask:0xf bank_mask:0xf\n\t" "v_fmac_f32_dpp %1, %5, %14 row_newbcast:6 row_mask:0xf bank_mask:0xf\n\t" "v_fmac_f32_dpp %2, %6, %14 row_newbcast:6 row_mask:0xf bank_mask:0xf\n\t" "v_fmac_f32_dpp %3, %7, %14 row_newbcast:6 row_mask:0xf bank_mask:0xf\n\t" "v_fmac_f32_dpp %0, %4, %15 row_newbcast:7 row_mask:0xf bank_mask:0xf\n\t" "v_fmac_f32_dpp %1, %5, %15 row_newbcast:7 row_mask:0xf bank_mask:0xf\n\t" "v_fmac_f32_dpp %2, %6, %15 row_newbcast:7 row_mask:0xf bank_mask:0xf\n\t" "v_fmac_f32_dpp %3, %7, %15 row_newbcast:7 row_mask:0xf bank_mask:0xf\n\t" "v_fmac_f32_dpp %0, %4, %16 row_newbcast:8 row_mask:0xf bank_mask:0xf\n\t" "v_fmac_f32_dpp %1, %5, %16 row_newbcast:8 row_mask:0xf bank_mask:0xf\n\t" "v_fmac_f32_dpp %2, %6, %16 row_newbcast:8 row_mask:0xf bank_mask:0xf\n\t" "v_fmac_f32_dpp %3, %7, %16 row_newbcast:8 row_mask:0xf bank_mask:0xf\n\t" "v_fmac_f32_dpp %0, %4, %17 row_newbcast:9 row_mask:0xf bank_mask:0xf\n\t" "v_fmac_f32_dpp %1, %5, %17 row_newbcast:9 row_mask:0xf bank_mask:0xf\n\t" "v_fmac_f32_dpp %2, %6, %17 row_newbcast:9 row_mask:0xf bank_mask:0xf\n\t" "v_fmac_f32_dpp %3, %7, %17 row_newbcast:9 row_mask:0xf bank_mask:0xf\n\t" "v_fmac_f32_dpp %0, %4, %18 row_newbcast:10 row_mask:0xf bank_mask:0xf\n\t" "v_fmac_f32_dpp %1, %5, %18 row_newbcast:10 row_mask:0xf bank_mask:0xf\n\t" "v_fmac_f32_dpp %2, %6, %18 row_newbcast:10 row_mask:0xf bank_mask:0xf\n\t" "v_fmac_f32_dpp %3, %7, %18 row_newbcast:10 row_mask:0xf bank_mask:0xf\n\t" "v_fmac_f32_dpp %0, %4, %19 row_newbcast:11 row_mask:0xf bank_mask:0xf\n\t" "v_fmac_f32_dpp %1, %5, %19 row_newbcast:11 row_mask:0xf bank_mask:0xf\n\t" "v_fmac_f32_dpp %2, %6, %19 row_newbcast:11 row_mask:0xf bank_mask:0xf\n\t" "v_fmac_f32_dpp %3, %7, %19 row_newbcast:11 row_mask:0xf bank_mask:0xf\n\t" "v_fmac_f32_dpp %0, %4, %20 row_newbcast:12 row_mask:0xf bank_mask:0xf\n\t" "v_fmac_f32_dpp %1, %5, %20 row_newbcast:12 row_mask:0xf bank_mask:0xf\n\t" "v_fmac_f32_dpp %2, %6, %20 row_newbcast:12 row_mask:0xf bank_mask:0xf\n\t" "v_fmac_f32_dpp %3, %7, %20 row_newbcast:12 row_mask:0xf bank_mask:0xf\n\t" "v_fmac_f32_dpp %0, %4, %21 row_newbcast:13 row_mask:0xf bank_mask:0xf\n\t" "v_fmac_f32_dpp %1, %5, %21 row_newbcast:13 row_mask:0xf bank_mask:0xf\n\t" "v_fmac_f32_dpp %2, %6, %21 row_newbcast:13 row_mask:0xf bank_mask:0xf\n\t" "v_fmac_f32_dpp %3, %7, %21 row_newbcast:13 row_mask:0xf bank_mask:0xf\n\t" "v_fmac_f32_dpp %0, %4, %22 row_newbcast:14 row_mask:0xf bank_mask:0xf\n\t" "v_fmac_f32_dpp %1, %5, %22 row_newbcast:14 row_mask:0xf bank_mask:0xf\n\t" "v_fmac_f32_dpp %2, %6, %22 row_newbcast:14 row_mask:0xf bank_mask:0xf\n\t" "v_fmac_f32_dpp %3, %7, %22 row_newbcast:14 row_mask:0xf bank_mask:0xf\n\t" "v_fmac_f32_dpp %0, %4, %23 row_newbcast:15 row_mask:0xf bank_mask:0xf\n\t" "v_fmac_f32_dpp %1, %5, %23 row_newbcast:15 row_mask:0xf bank_mask:0xf\n\t" "v_fmac_f32_dpp %2, %6, %23 row_newbcast:15 row_mask:0xf bank_mask:0xf\n\t" "v_fmac_f32_dpp %3, %7, %23 row_newbcast:15 row_mask:0xf bank_mask:0xf\n\t" : "+v"(a0), "+v"(a1), "+v"(a2), "+v"(a3) : "v"(l0), "v"(l1), "v"(l2), "v"(l3), "v"(x0), "v"(x1), "v"(x2), "v"(x3), "v"(x4), "v"(x5), "v"(x6), "v"(x7), "v"(x8), "v"(x9), "v"(x10), "v"(x11), "v"(x12), "v"(x13), "v"(x14), "v"(x15));
    }
};
template <int N, int B> struct QuadCall;
#define QC_DEF(N) template <int B> struct QuadCall<N, B> { static __device__ __forceinline__ void run(float (&x)[64], int I, float (&l)[4][4], int Q); };
#undef QC_DEF
#define QC_DEF(N) template <int B> struct QuadCallI { };
#undef QC_DEF
template <int N, int B, int I, int Q> struct QuadDo;
#define QD_DEF(N) template <int B, int I, int Q> struct QuadDo<N, B, I, Q> { static __device__ __forceinline__ void run(float (&x)[64], const float (&l)[4][4]) { QuadChunk<N>::run(x[I], x[I + 1], x[I + 2], x[I + 3], l[0][Q], l[1][Q], l[2][Q], l[3][Q], CC_ARGS##N(B)); } };
QD_DEF(1) QD_DEF(2) QD_DEF(3) QD_DEF(4) QD_DEF(5) QD_DEF(6) QD_DEF(7) QD_DEF(8) QD_DEF(9) QD_DEF(10) QD_DEF(11) QD_DEF(12) QD_DEF(13) QD_DEF(14) QD_DEF(15) QD_DEF(16)
#undef QD_DEF
template <int I, int Q> struct SolveQuadBlocks {
    static __device__ __forceinline__ void run(float (&x)[64], const float (&l)[4][4]) {
        if constexpr (Q > 0) SolveQuadBlocks<I, Q - 1>::run(x, l);
        constexpr int n = (I - 16 * Q) < 16 ? (I - 16 * Q) : 16;
        QuadDo<n, 16 * Q, I, Q>::run(x, l);
    }
};
template <int I> struct SolveRows {
    static __device__ __forceinline__ void run(float (&x)[64], const LAS float* Ls, int l15) {
        if constexpr (I > 0) SolveRows<I - 4>::run(x, Ls, l15);
        float l[4][4];
#pragma unroll
        for (int r = 0; r < 4; ++r)
#pragma unroll
            for (int q = 0; q < 4; ++q) l[r][q] = (16 * q < I + 3) ? Ls[(I + r) * 68 + 16 * q + l15] : 0.f;
        if constexpr (I > 0) SolveQuadBlocks<I, (I - 1) / 16>::run(x, l);
        constexpr int QB = I >> 4, L0 = I & 15;
        fmac_bcast<L0>(x[I + 1], l[1][QB], x[I]);
        fmac_bcast<L0>(x[I + 2], l[2][QB], x[I]); fmac_bcast<L0>(x[I + 3], l[3][QB], x[I]);
        fmac_bcast<L0 + 1>(x[I + 2], l[2][QB], x[I + 1]); fmac_bcast<L0 + 1>(x[I + 3], l[3][QB], x[I + 1]);
        fmac_bcast<L0 + 2>(x[I + 3], l[3][QB], x[I + 2]);
        if ((I & 7) == 4) asm volatile("" ::: "memory");
    }
};

#define XB_TMO      128
#define XB_XCNT(j)  (256  + 64 * (j))
#define XB_XSUB(j)  (1280 + 64 * (j))
#define XB_XGEN(j)  (2304 + 64 * (j))
#define XB_TOP      3328
#define XB_TOPGEN   3392
#define XCD_BAR_WORDS 3456
#define XB_SPIN_CAP (1u << 18)
__device__ __forceinline__ unsigned xb_ld(unsigned* p)              { return __hip_atomic_load(p, __ATOMIC_RELAXED, __HIP_MEMORY_SCOPE_AGENT); }
__device__ __forceinline__ unsigned xb_add(unsigned* p, unsigned v) { return __hip_atomic_fetch_add(p, v, __ATOMIC_RELAXED, __HIP_MEMORY_SCOPE_AGENT); }
__device__ __forceinline__ unsigned xb_xcc_id() { return (unsigned)__builtin_amdgcn_s_getreg((3 << 11) | 20) & 0xFu; }
#define XB_SPIN(cond, bar) do { unsigned _sp = 0; while (cond) { __builtin_amdgcn_s_sleep(1); \
    if ((++_sp & 255u) == 0u) { if (xb_ld(&(bar)[XB_TMO])) break; if (_sp > XB_SPIN_CAP) { atomicAdd(&(bar)[XB_TMO], 1u); break; } } } } while (0)
struct XcdBarrier { unsigned* bar; unsigned x; volatile LAS unsigned* st; };
__device__ __forceinline__ XcdBarrier xcd_barrier_post(unsigned* bar, volatile LAS unsigned* st) {
    XcdBarrier b; b.bar = bar; b.x = xb_xcc_id(); b.st = st;
    if (threadIdx.x == 0) (void)xb_add(&bar[XB_XCNT(b.x)], 1u);
    return b;
}
__device__ __forceinline__ void xcd_barrier_complete(unsigned* bar, unsigned x, unsigned& nloc, unsigned& nx) {
    const unsigned G = gridDim.x * gridDim.y * gridDim.z;
    unsigned sum, cnt, mine, sp = 0u;
    for (;;) {
        sum = 0u; cnt = 0u; mine = 0u;
#pragma unroll
        for (unsigned j = 0; j < 16; ++j) { const unsigned c = xb_ld(&bar[XB_XCNT(j)]); sum += c; cnt += (c > 0u) ? 1u : 0u; mine = (j == x) ? c : mine; }
        if (sum == G) break;
        __builtin_amdgcn_s_sleep(1);
        if ((++sp & 255u) == 0u) { if (xb_ld(&bar[XB_TMO])) break; if (sp > XB_SPIN_CAP) { atomicAdd(&bar[XB_TMO], 1u); break; } }
    }
    nloc = mine > 0u ? mine : 1u; nx = cnt > 0u ? cnt : 1u;
}
__device__ __forceinline__ void xcd_barrier(const XcdBarrier& b) {
    asm volatile("s_waitcnt vmcnt(0)" ::: "memory");
    __syncthreads();
    if (threadIdx.x == 0) {
        unsigned* bar = b.bar;
        __builtin_amdgcn_s_waitcnt(0);
        unsigned nloc = b.st[0], nx = b.st[1];
        if (nloc == 0u) { xcd_barrier_complete(bar, b.x, nloc, nx); b.st[0] = nloc; b.st[1] = nx; }
        const unsigned old = xb_add(&bar[XB_XSUB(b.x)], 1u);
        const unsigned gen = old / nloc;
        if (old + 1u == (gen + 1u) * nloc) {
            __builtin_amdgcn_fence(__ATOMIC_RELEASE, "agent");
            asm volatile("s_waitcnt vmcnt(0)" ::: "memory");
            const unsigned og = xb_add(&bar[XB_TOP], 1u);
            const unsigned tg = og / nx;
            if (og + 1u == (tg + 1u) * nx) xb_add(&bar[XB_TOPGEN], 1u);
            else XB_SPIN(xb_ld(&bar[XB_TOPGEN]) == tg, bar);
            __builtin_amdgcn_fence(__ATOMIC_ACQUIRE, "agent");
            xb_add(&bar[XB_XGEN(b.x)], 1u);
            asm volatile("s_waitcnt vmcnt(0)" ::: "memory");
        } else {
            XB_SPIN(xb_ld(&bar[XB_XGEN(b.x)]) == gen, bar);
            __builtin_amdgcn_fence(__ATOMIC_ACQUIRE, "agent");
            asm volatile("s_waitcnt vmcnt(0)" ::: "memory");
        }
    }
    __syncthreads();
}

struct Frame {
    LAS unsigned char* lds;
    volatile LAS unsigned* MISC;
    unsigned* ctl;
    int tid, lane, wave, vcu, G;
    const float* in[25]; float* out; unsigned char* ws;
};
enum { I_X = 0, I_P, I_NORM_MIX, I_W_IN, I_POOL_W, I_POOL_SCALE, I_CONV_W, I_A_LOG, I_DT_BIAS, I_DN_NORM, I_W_UP_POOL, I_W_UP_DN, I_W_OUT, I_NORM_MOE,
       I_W_RG, I_B_RG, I_W_RE, I_B_RE, I_W_GATE, I_W_UP, I_W_DOWN, I_NORM_PLE, I_W_PLE_GATE, I_W_PLE_PROJ, I_NORM_FINAL };

struct Unit { int pn, e, arow0, nrows, lrow0; };
template <int RB> struct DenseSched {
    int nM, nN, G, c, K;
    __device__ __forceinline__ void init(int M, int N, int K_, int G_, int c_) { nM = M / RB; nN = N / 256; G = G_; c = c_; K = K_; }
    __device__ __forceinline__ bool next(int i, Unit& u) const {
        const long L = (long)i * G + c; if (L >= (long)nM * nN) return false;
        const int pm = (int)(L / nN); u.pn = (int)(L % nN); u.e = 0; u.arow0 = pm * RB; u.nrows = RB; u.lrow0 = 0; return true;
    }
    __device__ __forceinline__ int arow(const Unit& u, int r) const { return u.arow0 + r; }
    __device__ __forceinline__ size_t boff(const Unit& u) const { return (size_t)u.pn * 256 * K; }
};
template <int RB, bool GATHER> struct MoeSched {
    const LAS int* pre; const LAS int* base; const int* ltk; int nN, G, c, K, Nfull;
    __device__ __forceinline__ bool next(int i, Unit& u) const {
        const long L = (long)i * G + c; if (L >= (long)pre[NE] * nN) return false;
        const int blk = (int)(L / nN); u.pn = (int)(L % nN);
        int e = 0;
        for (int j = 1; j < NE; ++j) if (pre[j] <= blk) e = j;
        const int rb = blk - pre[e]; const int cnt = base[e + 1] - base[e];
        const int nr = (cnt - rb * RB) < RB ? (cnt - rb * RB) : RB;
        u.e = __builtin_amdgcn_readfirstlane(e); u.lrow0 = __builtin_amdgcn_readfirstlane(rb * RB); u.arow0 = __builtin_amdgcn_readfirstlane(base[e] + rb * RB); u.nrows = __builtin_amdgcn_readfirstlane(nr);
        u.pn = __builtin_amdgcn_readfirstlane(u.pn); return true;
    }
    __device__ __forceinline__ int arow(const Unit& u, int r) const {
        const int rr = r < u.nrows ? r : u.nrows - 1;
        if (GATHER) return ltk[(size_t)u.e * T + u.lrow0 + rr] >> 1;
        return u.arow0 + rr;
    }
    __device__ __forceinline__ size_t boff(const Unit& u) const { return ((size_t)u.e * Nfull + (size_t)u.pn * 256) * K; }
};
template <int RB> __device__ __forceinline__ void moe_tables(Frame& F, LAS int* pre, LAS int* base) {
    __syncthreads();
    if (F.tid == 0) { int p = 0, b = 0; for (int e = 0; e < NE; ++e) { const int c = (int)F.ctl[CW_CNT + 64 * e]; pre[e] = p; base[e] = b; p += (c + RB - 1) / RB; b += c; } pre[NE] = p; base[NE] = b; }
    __syncthreads();
}

constexpr int SG_RB = 64, SG_BK = 32, SG_ALD = 68, SG_BLD = 260;
template <class Epi, class Sched>
__device__ __forceinline__ void sgemm_phase(Frame& F, const bf16* A, const bf16* Bt, int K, const Sched& S, const Epi& E) {
    LAS float* As = (LAS float*)(F.lds + RING_OFF);
    LAS float* Bs = As + SG_BK * SG_ALD;
    const int tid = F.tid, rg = tid >> 4, cg = tid & 15;
    const int la = tid >> 3, kq = (tid & 7) * 4;
    const int nb = tid >> 1, kh = (tid & 1) * 16;
    for (int i = 0;; ++i) {
        Unit u; if (!S.next(i, u)) break;
        const bf16* ap = A + (size_t)S.arow(u, la) * K + kq;
        const bf16* bp = Bt + S.boff(u) + (size_t)nb * K + kh;
        float acc[2][16];
#pragma unroll
        for (int a = 0; a < 2; ++a)
#pragma unroll
            for (int b = 0; b < 16; ++b) acc[a][b] = 0.f;
        for (int k0 = 0; k0 < K; k0 += SG_BK) {
            const v2u av = *(const v2u*)(ap + k0);
            const v4u b0 = *(const v4u*)(bp + k0), b1 = *(const v4u*)(bp + k0 + 8);
            __syncthreads();
            As[(kq + 0) * SG_ALD + la] = bflo(av.x); As[(kq + 1) * SG_ALD + la] = bfhi(av.x); As[(kq + 2) * SG_ALD + la] = bflo(av.y); As[(kq + 3) * SG_ALD + la] = bfhi(av.y);
            Bs[(kh + 0) * SG_BLD + nb] = bflo(b0.x); Bs[(kh + 1) * SG_BLD + nb] = bfhi(b0.x); Bs[(kh + 2) * SG_BLD + nb] = bflo(b0.y); Bs[(kh + 3) * SG_BLD + nb] = bfhi(b0.y);
            Bs[(kh + 4) * SG_BLD + nb] = bflo(b0.z); Bs[(kh + 5) * SG_BLD + nb] = bfhi(b0.z); Bs[(kh + 6) * SG_BLD + nb] = bflo(b0.w); Bs[(kh + 7) * SG_BLD + nb] = bfhi(b0.w);
            Bs[(kh + 8) * SG_BLD + nb] = bflo(b1.x); Bs[(kh + 9) * SG_BLD + nb] = bfhi(b1.x); Bs[(kh + 10) * SG_BLD + nb] = bflo(b1.y); Bs[(kh + 11) * SG_BLD + nb] = bfhi(b1.y);
            Bs[(kh + 12) * SG_BLD + nb] = bflo(b1.z); Bs[(kh + 13) * SG_BLD + nb] = bfhi(b1.z); Bs[(kh + 14) * SG_BLD + nb] = bflo(b1.w); Bs[(kh + 15) * SG_BLD + nb] = bfhi(b1.w);
            __syncthreads();
#pragma unroll 8
            for (int kk = 0; kk < SG_BK; ++kk) {
                const float a0 = As[kk * SG_ALD + rg], a1 = As[kk * SG_ALD + rg + 32];
                const f32x4 p0 = *(const LAS f32x4*)(Bs + kk * SG_BLD + 8 * cg), p1 = *(const LAS f32x4*)(Bs + kk * SG_BLD + 8 * cg + 4);
                const f32x4 p2 = *(const LAS f32x4*)(Bs + kk * SG_BLD + 128 + 8 * cg), p3 = *(const LAS f32x4*)(Bs + kk * SG_BLD + 128 + 8 * cg + 4);
#pragma unroll
                for (int j = 0; j < 4; ++j) {
                    acc[0][j] += a0 * p0[j]; acc[0][4 + j] += a0 * p1[j]; acc[0][8 + j] += a0 * p2[j]; acc[0][12 + j] += a0 * p3[j];
                    acc[1][j] += a1 * p0[j]; acc[1][4 + j] += a1 * p1[j]; acc[1][8 + j] += a1 * p2[j]; acc[1][12 + j] += a1 * p3[j];
                }
            }
        }
#pragma unroll
        for (int a = 0; a < 2; ++a) { const int r = rg + 32 * a; if (r < u.nrows) E.store(u, r, 8 * cg, &acc[a][0], &acc[a][8]); }
    }
    __syncthreads();
}


namespace pg8 {
constexpr int BM = 256, BK = 64, HALF = 128, HTB = HALF * BK * 2, STAGE_BYTES = 8 * HTB, NXCD = 8, WGM = 8;
__host__ __device__ __forceinline__ int lds_byte(int r, int c) { const int st = (r >> 4) * 2 + (c >> 5), rr = r & 15, cc = c & 31, ob = rr * 64 + cc * 2; return st * 1024 + (ob ^ (((ob >> 9) & 1) << 5)); }
__host__ __device__ __forceinline__ void stage_rc(int b, int& R, int& C) { const int st = b / 1024, sb = b % 1024, swz = sb ^ (((sb >> 9) & 1) << 5); R = (st >> 1) * 16 + swz / 64; C = (st & 1) * 32 + (swz % 64) / 2; }
__host__ __device__ __forceinline__ int perm32(int rho) { const int n = rho >> 4, i = rho & 15; return 8 * (i >> 2) + 4 * n + (i & 3); }

struct DenseOrder {
    int nM, nN, nwg, G, c, K;
    __device__ __forceinline__ void init(int M, int N, int K_, int G_, int c_) { nM = M / BM; nN = N / BM; nwg = nM * nN; G = G_; c = c_; K = K_; }
    __device__ __forceinline__ bool next(int i, Unit& u) const {
        const long L = (long)i * G + c; if (L >= nwg) return false;
        int wgid = (int)L; { const int q = nwg / NXCD, r = nwg % NXCD, xcd = wgid % NXCD, off = wgid / NXCD; wgid = (xcd < r ? xcd * (q + 1) : r * (q + 1) + (xcd - r) * q) + off; }
        const int nig = WGM * nN, gid = wgid / nig, fm = gid * WGM, gsz = (nM - fm) < WGM ? (nM - fm) : WGM;
        u.pn = (wgid % nig) / gsz; u.e = 0; u.arow0 = (fm + ((wgid % nig) % gsz)) * BM; u.nrows = BM; u.lrow0 = 0; return true;
    }
    __device__ __forceinline__ int arow(const Unit& u, int r) const { return u.arow0 + r; }
    __device__ __forceinline__ size_t boff(const Unit& u) const { return (size_t)u.pn * 256 * K; }
};

template <class Epi, class Sched, bool GATHER, bool ALIGN_EPI = true, bool SP2 = true>
__device__ __forceinline__ void gemm_phase(LAS unsigned char* lds, const bf16* Ag, const bf16* Btg, const int K, const Sched& S, const Epi& E) {
    const int tid = threadIdx.x, wid = __builtin_amdgcn_readfirstlane(tid >> 6), lane = tid & 63, wr = wid >> 2, wc = wid & 3, fr = lane & 15, fq = lane >> 4;
    const int nt = K / BK;
    unsigned voffA[2], voffB[2]; int RA[2], CA[2];
#pragma unroll
    for (int i = 0; i < 2; ++i) { int R, C; stage_rc(tid * 16 + i * 8192, R, C); const int Rb = (R & ~31) + perm32(R & 31);
        voffA[i] = (unsigned)(R * K + C) * 2u; voffB[i] = (unsigned)(Rb * K + C) * 2u; RA[i] = R; CA[i] = C; }
    const size_t kstep = (size_t)(BK * 2);
    const size_t hstep = (size_t)HALF * K * 2;
    const unsigned ldsw = (unsigned)wid * 1024u;
    const int aoff = lds_byte(wr * 64 + fr, fq * 8), boff = lds_byte(wc * 32 + fr, fq * 8);
#define PG8_SA(b, h) (((b) * 2 + (h)) * HTB)
#define PG8_SB(b, h) ((4 + (b) * 2 + (h)) * HTB)
#define PG8_STAGE(bufoff, gbase, voff) do { _Pragma("unroll") for (int _i = 0; _i < 2; ++_i) \
        __builtin_amdgcn_global_load_lds((const unsigned*)((const char*)(gbase) + (voff)[_i]), (LAS unsigned*)(lds + (bufoff) + ldsw + _i * 8192), 16, 0, 0); } while (0)
#define PG8_STAGE_A(bufoff, base, vg, h, ko) do { if (GATHER) { PG8_STAGE(bufoff, (const char*)Ag + (ko), vg[h]); } else { PG8_STAGE(bufoff, (base) + (h) * hstep + (ko), voffA); } } while (0)
#define PG8_LDA(dst, b, h) do { _Pragma("unroll") for (int m = 0; m < 4; ++m) _Pragma("unroll") for (int k = 0; k < 2; ++k) dst[m][k] = *(const LAS bf16x8*)(lds + PG8_SA(b, h) + aoff + m * 2048 + k * 1024); } while (0)
#define PG8_LDB(dst, b, h) do { _Pragma("unroll") for (int n = 0; n < 2; ++n) _Pragma("unroll") for (int k = 0; k < 2; ++k) dst[n][k] = *(const LAS bf16x8*)(lds + PG8_SB(b, h) + boff + n * 2048 + k * 1024); } while (0)
#define PG8_MMA(ai, bj, At, Bt) do { __builtin_amdgcn_s_setprio(1); _Pragma("unroll") for (int m = 0; m < 4; ++m) _Pragma("unroll") for (int n = 0; n < 2; ++n) _Pragma("unroll") for (int k = 0; k < 2; ++k) \
        acc[ai][bj][m][n] = __builtin_amdgcn_mfma_f32_16x16x32_bf16(Bt[n][k], At[m][k], acc[ai][bj][m][n], 0, 0, 0); __builtin_amdgcn_s_setprio(0); } while (0)
#define PG8_WAIT_V(n) asm volatile("s_waitcnt vmcnt(" #n ")" ::: "memory")
#define PG8_WAIT_L(n) asm volatile("s_waitcnt lgkmcnt(" #n ")" ::: "memory")
#define PG8_BAR __builtin_amdgcn_s_barrier()
#define PG8_SCHED __builtin_amdgcn_sched_barrier(0)
#define PG8_ROWOFFS(dst, un) do { _Pragma("unroll") for (int _h = 0; _h < 2; ++_h) _Pragma("unroll") for (int _i = 0; _i < 2; ++_i) \
        dst[_h][_i] = ((unsigned)S.arow(un, _h * HALF + RA[_i]) * (unsigned)K + (unsigned)CA[_i]) * 2u; } while (0)
    Unit cur, nxt; int ui = 0;
    if (!S.next(0, cur)) return;
    f32x4 acc[2][2][4][2];
#pragma unroll
    for (int a = 0; a < 2; ++a)
#pragma unroll
        for (int b = 0; b < 2; ++b)
#pragma unroll
            for (int m = 0; m < 4; ++m)
#pragma unroll
                for (int n = 0; n < 2; ++n) acc[a][b][m][n] = (f32x4){0.f, 0.f, 0.f, 0.f};
    bf16x8 At[4][2], B0[2][2], B1[2][2];
    unsigned vc[2][2], vn[2][2];
    if (GATHER) { PG8_ROWOFFS(vc, cur); }
    const char* cA = GATHER ? (const char*)Ag : (const char*)Ag + (size_t)cur.arow0 * K * 2; const char* cB = (const char*)Btg + S.boff(cur) * 2;
    if constexpr (SP2) {
        PG8_STAGE(PG8_SB(0, 0), cB, voffB); PG8_STAGE(PG8_SB(0, 1), cB + hstep, voffB); PG8_STAGE_A(PG8_SA(0, 0), cA, vc, 0, 0); PG8_STAGE_A(PG8_SA(0, 1), cA, vc, 1, 0);
        if (wr == 1) PG8_BAR;
        PG8_WAIT_V(2); PG8_BAR;
        PG8_STAGE(PG8_SB(1, 0), cB + kstep, voffB); PG8_STAGE_A(PG8_SA(1, 0), cA, vc, 0, kstep); PG8_STAGE(PG8_SB(1, 1), cB + hstep + kstep, voffB);
        PG8_WAIT_V(6); PG8_BAR;
    } else {
        PG8_STAGE(PG8_SB(0, 0), cB, voffB); PG8_STAGE_A(PG8_SA(0, 0), cA, vc, 0, 0); PG8_STAGE(PG8_SB(0, 1), cB + hstep, voffB); PG8_STAGE_A(PG8_SA(0, 1), cA, vc, 1, 0);
        if (wr == 1) PG8_BAR;
        PG8_WAIT_V(4); PG8_BAR;
        PG8_STAGE(PG8_SB(1, 0), cB + kstep, voffB); PG8_STAGE_A(PG8_SA(1, 0), cA, vc, 0, kstep); PG8_STAGE(PG8_SB(1, 1), cB + hstep + kstep, voffB);
        PG8_WAIT_V(6); PG8_BAR;
    }
    for (;;) {
        const bool has_next = S.next(ui + 1, nxt);
        const char* nA = GATHER ? cA : (has_next ? (const char*)Ag + (size_t)nxt.arow0 * K * 2 : cA); const char* nB = has_next ? (const char*)Btg + S.boff(nxt) * 2 : cB;
        if (GATHER) { if (has_next) { PG8_ROWOFFS(vn, nxt); } else {
#pragma unroll
            for (int _h = 0; _h < 2; ++_h)
#pragma unroll
                for (int _i = 0; _i < 2; ++_i) vn[_h][_i] = vc[_h][_i]; } }
#pragma unroll 1
        for (int t = 0; t < nt; t += 2) {
            const bool last = (t == nt - 2);
            const size_t k1 = (size_t)(t + 1) * kstep;
            const size_t k2 = last ? 0 : (size_t)(t + 2) * kstep, k3 = k2 + kstep;
            const char* a2 = last ? nA : cA; const char* b2 = (last ? nB : cB) + k2; const char* b3 = b2 + kstep;
            unsigned v2[2][2];
#pragma unroll
            for (int _h = 0; _h < 2; ++_h)
#pragma unroll
                for (int _i = 0; _i < 2; ++_i) v2[_h][_i] = last ? vn[_h][_i] : vc[_h][_i];
            if constexpr (SP2) {
            PG8_LDB(B0, 0, 0); PG8_LDB(B1, 0, 1); PG8_SCHED; PG8_LDA(At, 0, 0); PG8_STAGE_A(PG8_SA(1, 1), cA, vc, 1, k1);
            PG8_WAIT_V(8); PG8_WAIT_L(0); PG8_BAR; PG8_MMA(0, 0, At, B0); PG8_MMA(0, 1, At, B1); PG8_BAR; PG8_SCHED;
            PG8_LDA(At, 0, 1); PG8_STAGE(PG8_SB(0, 0), b2, voffB); PG8_STAGE(PG8_SB(0, 1), b2 + hstep, voffB); PG8_STAGE_A(PG8_SA(0, 0), a2, v2, 0, k2);
            PG8_WAIT_V(8); PG8_WAIT_L(0); PG8_BAR; PG8_MMA(1, 0, At, B0); PG8_MMA(1, 1, At, B1); PG8_BAR; PG8_SCHED;
            PG8_LDB(B0, 1, 0); PG8_LDB(B1, 1, 1); PG8_SCHED; PG8_LDA(At, 1, 0); PG8_STAGE_A(PG8_SA(0, 1), a2, v2, 1, k2);
            PG8_WAIT_V(8); PG8_WAIT_L(0); PG8_BAR; PG8_MMA(0, 0, At, B0); PG8_MMA(0, 1, At, B1); PG8_BAR; PG8_SCHED;
            PG8_LDA(At, 1, 1); PG8_STAGE(PG8_SB(1, 0), b3, voffB); PG8_STAGE(PG8_SB(1, 1), b3 + hstep, voffB); PG8_STAGE_A(PG8_SA(1, 0), a2, v2, 0, k3);
            PG8_WAIT_V(8); PG8_WAIT_L(0); PG8_BAR; PG8_MMA(1, 0, At, B0); PG8_MMA(1, 1, At, B1); PG8_BAR; PG8_SCHED;
            } else {
            PG8_LDB(B0, 0, 0); PG8_SCHED; PG8_LDA(At, 0, 0); PG8_STAGE_A(PG8_SA(1, 1), cA, vc, 1, k1);
            PG8_WAIT_L(8); PG8_BAR; PG8_WAIT_L(0); PG8_MMA(0, 0, At, B0); PG8_BAR; PG8_SCHED;
            PG8_LDB(B1, 0, 1); PG8_STAGE(PG8_SB(0, 0), b2, voffB);
            PG8_BAR; PG8_WAIT_L(0); PG8_MMA(0, 1, At, B1); PG8_BAR;
            PG8_LDA(At, 0, 1); PG8_STAGE_A(PG8_SA(0, 0), a2, v2, 0, k2);
            PG8_BAR; PG8_WAIT_L(0); PG8_MMA(1, 0, At, B0); PG8_BAR; PG8_SCHED;
            PG8_STAGE(PG8_SB(0, 1), b2 + hstep, voffB);
            PG8_WAIT_V(6); PG8_BAR; PG8_MMA(1, 1, At, B1); PG8_BAR;
            PG8_LDB(B0, 1, 0); PG8_SCHED; PG8_LDA(At, 1, 0); PG8_STAGE_A(PG8_SA(0, 1), a2, v2, 1, k2);
            PG8_WAIT_L(8); PG8_BAR; PG8_WAIT_L(0); PG8_MMA(0, 0, At, B0); PG8_BAR; PG8_SCHED;
            PG8_LDB(B1, 1, 1); PG8_STAGE(PG8_SB(1, 0), b3, voffB);
            PG8_BAR; PG8_WAIT_L(0); PG8_MMA(0, 1, At, B1); PG8_BAR;
            PG8_LDA(At, 1, 1); PG8_STAGE_A(PG8_SA(1, 0), a2, v2, 0, k3);
            PG8_BAR; PG8_WAIT_L(0); PG8_MMA(1, 0, At, B0); PG8_BAR; PG8_SCHED;
            PG8_STAGE(PG8_SB(1, 1), b3 + hstep, voffB);
            PG8_WAIT_V(6); PG8_BAR; PG8_MMA(1, 1, At, B1); PG8_BAR;
            }
        }
        if constexpr (ALIGN_EPI) { if (wr == 0) PG8_BAR; }
        {
            typename Epi::Pre pq[2]; const int cit = wc * 32 + 8 * fq;
            { const int r0_ = wr * 64 + fr; pq[0] = E.pre(cur, r0_ < cur.nrows ? r0_ : cur.nrows - 1, cit); }
#pragma unroll
            for (int gq = 0; gq < 8; ++gq) { const int ai = gq >> 2, m = gq & 3, r = ai * HALF + wr * 64 + m * 16 + fr;
                if (gq + 1 < 8) { const int rn = ((gq + 1) >> 2) * HALF + wr * 64 + ((gq + 1) & 3) * 16 + fr; pq[(gq + 1) & 1] = E.pre(cur, rn < cur.nrows ? rn : cur.nrows - 1, cit); }
                __builtin_amdgcn_sched_barrier(0);
                if (r < cur.nrows) { float v0[8], v1[8];
#pragma unroll
                    for (int i = 0; i < 4; ++i) { v0[i] = acc[ai][0][m][0][i]; v0[4 + i] = acc[ai][0][m][1][i]; v1[i] = acc[ai][1][m][0][i]; v1[4 + i] = acc[ai][1][m][1][i]; }
                    E.post(cur, r, cit, v0, v1, pq[gq & 1]); }
                __builtin_amdgcn_sched_barrier(0); }
        }
        if (!has_next) break;
#pragma unroll
        for (int a = 0; a < 2; ++a)
#pragma unroll
            for (int b = 0; b < 2; ++b)
#pragma unroll
                for (int m = 0; m < 4; ++m)
#pragma unroll
                    for (int n = 0; n < 2; ++n) acc[a][b][m][n] = (f32x4){0.f, 0.f, 0.f, 0.f};
        cur = nxt; cA = nA; cB = nB; ++ui;
        if (GATHER) {
#pragma unroll
            for (int _h = 0; _h < 2; ++_h)
#pragma unroll
                for (int _i = 0; _i < 2; ++_i) vc[_h][_i] = vn[_h][_i]; }
        if constexpr (ALIGN_EPI) { if (wr == 1) PG8_BAR; }
    }
    PG8_WAIT_V(0);
    if constexpr (!ALIGN_EPI) { if (wr == 0) PG8_BAR; }
    PG8_BAR;
#undef PG8_SA
#undef PG8_SB
#undef PG8_STAGE
#undef PG8_STAGE_A
#undef PG8_LDA
#undef PG8_LDB
#undef PG8_MMA
#undef PG8_WAIT_V
#undef PG8_WAIT_L
#undef PG8_BAR
#undef PG8_SCHED
#undef PG8_ROWOFFS
}
}

struct NoPre {};
struct EpiInProj { typedef NoPre Pre;
    bf16 *upool, *qkv, *z, *gp, *gd;
    __device__ __forceinline__ Pre pre(const Unit&, int, int) const { return Pre{}; }
    __device__ __forceinline__ void post(const Unit& u, int r, int cit, const float* v0, const float* v1, const Pre&) const {
        const size_t row = (size_t)(u.arow0 + r); const int pn = u.pn;
        if (pn < 4) { bf16* p = upool + row * D_POOL + pn * 256 + cit; store8bf(p, v0); store8bf(p + 128, v1); }
        else if (pn < 16) { bf16* p = qkv + row * D_QKV + (pn - 4) * 256 + cit; store8bf(p, v0); store8bf(p + 128, v1); }
        else if (pn < 20) { float a[8], b[8];
#pragma unroll
            for (int i = 0; i < 8; ++i) { a[i] = siluf_(v0[i]); b[i] = siluf_(v1[i]); }
            bf16* p = z + row * D_Z + (pn - 16) * 256 + cit; store8bf(p, a); store8bf(p + 128, b); }
        else { float a[8], b[8];
#pragma unroll
            for (int i = 0; i < 8; ++i) { a[i] = sigmoidf_(v0[i]); b[i] = sigmoidf_(v1[i]); }
            bf16* p = (pn < 28 ? gp + row * D + (pn - 20) * 256 : gd + row * D + (pn - 28) * 256) + cit; store8bf(p, a); store8bf(p + 128, b); }
    }
};
__device__ __forceinline__ void unpack8bf(const v4u o, float* v) { v[0] = bflo(o.x); v[1] = bfhi(o.x); v[2] = bflo(o.y); v[3] = bfhi(o.y); v[4] = bflo(o.z); v[5] = bfhi(o.z); v[6] = bflo(o.w); v[7] = bfhi(o.w); }
struct EpiPool {
    struct Pre { v4u g0, g1; };
    const bf16* gp; bf16* mp;
    __device__ __forceinline__ Pre pre(const Unit& u, int r, int cit) const { const size_t off = (size_t)(u.arow0 + r) * D + u.pn * 256 + cit; return Pre{*(const v4u*)(gp + off), *(const v4u*)(gp + off + 128)}; }
    __device__ __forceinline__ void post(const Unit& u, int r, int cit, const float* v0, const float* v1, const Pre& p) const {
        const size_t off = (size_t)(u.arow0 + r) * D + u.pn * 256 + cit; float g0[8], g1[8], a[8], b[8]; unpack8bf(p.g0, g0); unpack8bf(p.g1, g1);
#pragma unroll
        for (int i = 0; i < 8; ++i) { a[i] = g0[i] * v0[i]; b[i] = g1[i] * v1[i]; }
        store8bf(mp + off, a); store8bf(mp + off + 128, b);
    }
};
struct EpiMerge {
    struct Pre { v4u g0, g1, m0, m1; };
    const bf16* gd; const bf16* mp; bf16* mg;
    __device__ __forceinline__ Pre pre(const Unit& u, int r, int cit) const { const size_t off = (size_t)(u.arow0 + r) * D + u.pn * 256 + cit; return Pre{*(const v4u*)(gd + off), *(const v4u*)(gd + off + 128), *(const v4u*)(mp + off), *(const v4u*)(mp + off + 128)}; }
    __device__ __forceinline__ void post(const Unit& u, int r, int cit, const float* v0, const float* v1, const Pre& p) const {
        const size_t off = (size_t)(u.arow0 + r) * D + u.pn * 256 + cit; float g0[8], g1[8], m0[8], m1[8]; unpack8bf(p.g0, g0); unpack8bf(p.g1, g1); unpack8bf(p.m0, m0); unpack8bf(p.m1, m1);
#pragma unroll
        for (int i = 0; i < 8; ++i) { m0[i] += g0[i] * v0[i]; m1[i] += g1[i] * v1[i]; }
        store8bf(mg + off, m0); store8bf(mg + off + 128, m1);
    }
};
struct EpiResid {
    struct Pre { f32x4 a0, a1, b0, b1; };
    const float* x; float* h;
    __device__ __forceinline__ Pre pre(const Unit& u, int r, int cit) const { const size_t off = (size_t)(u.arow0 + r) * D + u.pn * 256 + cit; return Pre{*(const f32x4*)(x + off), *(const f32x4*)(x + off + 4), *(const f32x4*)(x + off + 128), *(const f32x4*)(x + off + 132)}; }
    __device__ __forceinline__ void post(const Unit& u, int r, int cit, const float* v0, const float* v1, const Pre& p) const {
        const size_t off = (size_t)(u.arow0 + r) * D + u.pn * 256 + cit;
        *(f32x4*)(h + off) = (f32x4){p.a0[0] + v0[0], p.a0[1] + v0[1], p.a0[2] + v0[2], p.a0[3] + v0[3]}; *(f32x4*)(h + off + 4) = (f32x4){p.a1[0] + v0[4], p.a1[1] + v0[5], p.a1[2] + v0[6], p.a1[3] + v0[7]};
        *(f32x4*)(h + off + 128) = (f32x4){p.b0[0] + v1[0], p.b0[1] + v1[1], p.b0[2] + v1[2], p.b0[3] + v1[3]}; *(f32x4*)(h + off + 132) = (f32x4){p.b1[0] + v1[4], p.b1[1] + v1[5], p.b1[2] + v1[6], p.b1[3] + v1[7]};
    }
};
struct EpiMoe1 { typedef NoPre Pre;
    bf16* hmid;
    __device__ __forceinline__ Pre pre(const Unit&, int, int) const { return Pre{}; }
    __device__ __forceinline__ void post(const Unit& u, int r, int cit, const float* v0, const float* v1, const Pre&) const {
        float a[8];
#pragma unroll
        for (int i = 0; i < 8; ++i) a[i] = siluf_(v0[i]) * v1[i];
        store8bf(hmid + (size_t)(u.arow0 + r) * DE + u.pn * 128 + cit, a);
    }
};
struct EpiMoe2 {
    struct Pre { int tk; float w; };
    const int* ltk; const float* lw; bf16 *y0, *y1;
    __device__ __forceinline__ Pre pre(const Unit& u, int r, int) const { const size_t li = (size_t)u.e * T + u.lrow0 + r; return Pre{ltk[li], lw[li]}; }
    __device__ __forceinline__ void post(const Unit& u, int, int cit, const float* v0, const float* v1, const Pre& p) const {
        bf16* y = ((p.tk & 1) ? y1 : y0) + (size_t)(p.tk >> 1) * D + u.pn * 256 + cit; float a[8], b[8];
#pragma unroll
        for (int i = 0; i < 8; ++i) { a[i] = p.w * v0[i]; b[i] = p.w * v1[i]; }
        store8bf(y, a); store8bf(y + 128, b);
    }
};
struct EpiBf16Plain { typedef NoPre Pre;
    bf16* o;
    __device__ __forceinline__ Pre pre(const Unit&, int, int) const { return Pre{}; }
    __device__ __forceinline__ void post(const Unit& u, int r, int cit, const float* v0, const float* v1, const Pre&) const {
        bf16* p = o + (size_t)(u.arow0 + r) * D + u.pn * 256 + cit; store8bf(p, v0); store8bf(p + 128, v1);
    }
};
struct EpiPle {
    struct Pre { v4u p0, p1; f32x4 a0, a1, b0, b1; };
    const bf16* pp; float* h;
    __device__ __forceinline__ Pre pre(const Unit& u, int r, int cit) const { const size_t off = (size_t)(u.arow0 + r) * D + u.pn * 256 + cit;
        return Pre{*(const v4u*)(pp + off), *(const v4u*)(pp + off + 128), *(const f32x4*)(h + off), *(const f32x4*)(h + off + 4), *(const f32x4*)(h + off + 128), *(const f32x4*)(h + off + 132)}; }
    __device__ __forceinline__ void post(const Unit& u, int r, int cit, const float* v0, const float* v1, const Pre& p) const {
        const size_t off = (size_t)(u.arow0 + r) * D + u.pn * 256 + cit; float p0[8], p1[8]; unpack8bf(p.p0, p0); unpack8bf(p.p1, p1);
        f32x4 oa0, oa1, ob0, ob1;
#pragma unroll
        for (int i = 0; i < 4; ++i) { oa0[i] = p.a0[i] + sigmoidf_(v0[i]) * p0[i]; oa1[i] = p.a1[i] + sigmoidf_(v0[4 + i]) * p0[4 + i]; ob0[i] = p.b0[i] + sigmoidf_(v1[i]) * p1[i]; ob1[i] = p.b1[i] + sigmoidf_(v1[4 + i]) * p1[4 + i]; }
        *(f32x4*)(h + off) = oa0; *(f32x4*)(h + off + 4) = oa1; *(f32x4*)(h + off + 128) = ob0; *(f32x4*)(h + off + 132) = ob1;
    }
};

__device__ __forceinline__ void transpose_item(const float* W, int ldw, int K, int k0, int c0, int nvalid, bf16* WT, int r0, LAS float* scr, int lane) {
    (void)scr;
    const int kb = lane >> 3, nb = lane & 7; const bool ok = 4 * nb < nvalid;
    const float* src = W + (size_t)(k0 + 8 * kb) * ldw + c0 + 4 * nb;
    f32x4 v[8];
#pragma unroll
    for (int i = 0; i < 8; ++i) v[i] = ok ? *(const f32x4*)(src + (size_t)i * ldw) : (f32x4){0.f, 0.f, 0.f, 0.f};
    bf16* dst = WT + (size_t)(r0 + 4 * nb) * K + k0 + 8 * kb;
#pragma unroll
    for (int e = 0; e < 4; ++e) { v4u o; o.x = pk2(v[0][e], v[1][e]); o.y = pk2(v[2][e], v[3][e]); o.z = pk2(v[4][e], v[5][e]); o.w = pk2(v[6][e], v[7][e]); *(v4u*)(dst + (size_t)e * K) = o; }
}
__device__ __forceinline__ void transpose_job(const float* W, int K, int N, bf16* WT, LAS float* scr, int gw, int NGW, int lane) {
    const int nblk = N / 32, items = (K / 64) * nblk;
    for (int it = gw; it < items; it += NGW) { const int kb = it / nblk, nb = it % nblk; transpose_item(W, N, K, 64 * kb, 32 * nb, 32, WT, 32 * nb, scr, lane); }
}
__device__ __forceinline__ void rms_row_bf16(const float* xrow, const float* gain, bf16* orow, int lane) {
    const f32x4* xr = (const f32x4*)xrow + lane; const f32x4* gr = (const f32x4*)gain + lane;
    f32x4 v[8]; float s = 0.f;
#pragma unroll
    for (int j = 0; j < 8; ++j) { v[j] = xr[64 * j]; s += (v[j].x * v[j].x + v[j].y * v[j].y) + (v[j].z * v[j].z + v[j].w * v[j].w); }
    const float rstd = 1.0f / sqrtf(wave_sum(s) * (1.f / D) + EPS);
    v2u* o8 = (v2u*)orow + lane;
#pragma unroll
    for (int j = 0; j < 8; ++j) { const f32x4 g = gr[64 * j]; v2u o; o.x = pk2(v[j].x * rstd * g.x, v[j].y * rstd * g.y); o.y = pk2(v[j].z * rstd * g.z, v[j].w * rstd * g.w); o8[64 * j] = o; }
}


__device__ __forceinline__ void route_row(Frame& F, const LAS float* lgp, float rs, int t, LAS unsigned* lcnt, LAS int* ent, int ei) {
    float gl[4];
#pragma unroll
    for (int o = 0; o < 4; ++o) gl[o] = lgp[o] * rs + F.in[I_B_RG][o];
    int gi = 0; float gm = gl[0];
#pragma unroll
    for (int o = 1; o < 4; ++o) if (gl[o] > gm) { gm = gl[o]; gi = o; }
    float den = 0.f;
#pragma unroll
    for (int o = 0; o < 4; ++o) den += __expf(gl[o] - gm);
    const float psel = 1.0f / den;
    float le[8];
#pragma unroll
    for (int q = 0; q < 8; ++q) le[q] = lgp[4 + 8 * gi + q] * rs + F.in[I_B_RE][gi * 8 + q];
    int i0 = 0; float v0 = le[0];
#pragma unroll
    for (int q = 1; q < 8; ++q) if (le[q] > v0) { v0 = le[q]; i0 = q; }
    int i1 = -1; float v1 = -3.0e38f;
#pragma unroll
    for (int q = 0; q < 8; ++q) if (q != i0 && le[q] > v1) { v1 = le[q]; i1 = q; }
    const float e1 = __expf(v1 - v0); const float w0 = psel / (1.0f + e1), w1 = psel * e1 / (1.0f + e1);
    const int ea = gi * 8 + i0, ebx = gi * 8 + i1;
    const unsigned sa = atomicAdd((unsigned*)(lcnt + ea), 1u), sb = atomicAdd((unsigned*)(lcnt + ebx), 1u);
    ent[4 * ei + 0] = (ea << 16) | (int)sa; ent[4 * ei + 1] = 2 * t; ent[4 * ei + 2] = __float_as_int(w0); ent[4 * ei + 3] = 0;
    ent[4 * (ei + 1) + 0] = (ebx << 16) | (int)sb; ent[4 * (ei + 1) + 1] = 2 * t + 1; ent[4 * (ei + 1) + 2] = __float_as_int(w1); ent[4 * (ei + 1) + 3] = 0;
}

enum { PH_PRO = 0, PH_INPROJ, PH_TOKLOC, PH_DNA, PH_DN, PH_YDN, PH_MERGE, PH_OUT, PH_ROUTE, PH_MOE1, PH_MOE2, PH_N3, PH_PP, PH_PLE, PH_FINAL, NPHASE };
struct Args { const float* in[25]; float* out; unsigned char* ws; int ph_lo, ph_hi, flags, pad; };
__global__ void __launch_bounds__(NTHR, 2) fwd(Args args) {
    extern __shared__ __attribute__((aligned(16))) unsigned char lds_raw[];
    Frame F;
    F.lds = (LAS unsigned char*)lds_raw; F.MISC = (volatile LAS unsigned*)(F.lds + MISC_OFF);
    F.tid = threadIdx.x; F.lane = F.tid & 63; F.wave = __builtin_amdgcn_readfirstlane(F.tid >> 6);
    F.G = gridDim.x; { const int bx = blockIdx.x; F.vcu = (F.G % 8 == 0) ? (bx % 8) * (F.G / 8) + bx / 8 : bx; }
    F.ws = args.ws; F.ctl = (unsigned*)(args.ws + WS_CTL); F.out = args.out;
#pragma unroll
    for (int i = 0; i < 25; ++i) F.in[i] = args.in[i];
    for (int u = F.tid; u < MISC_WORDS; u += NTHR) F.MISC[u] = 0u;
    __syncthreads();
    XcdBarrier bar; bar.bar = F.ctl + CW_BAR; bar.x = 0; bar.st = nullptr;
    if (MK_N_LAUNCHES == 1) bar = xcd_barrier_post(F.ctl + CW_BAR, F.MISC + 8);
    const int lo = args.ph_lo, hi = args.ph_hi;
#define IN(k) (lo <= (k) && (k) < hi)
#define SEAM(k) do { if (MK_N_LAUNCHES == 1 && IN(k) && IN((k) + 1)) xcd_barrier(bar); } while (0)
    unsigned char* ws = F.ws;
    bf16* WIN = (bf16*)(ws + WS_WIN); bf16* WCOMB = (bf16*)(ws + WS_WCOMB); bf16* WUPDN = (bf16*)(ws + WS_WUPDN); bf16* WOUT = (bf16*)(ws + WS_WOUT);
    bf16* WPLEG = (bf16*)(ws + WS_WPLEG); bf16* WPLEP = (bf16*)(ws + WS_WPLEP); bf16* WGU = (bf16*)(ws + WS_WGU); bf16* WDN = (bf16*)(ws + WS_WDN);
    float* BA = (float*)(ws + WS_BA); float* GG = (float*)(ws + WS_G); float* BETA = (float*)(ws + WS_BETA);
    int* LTK = (int*)(ws + WS_LTK); float* LW = (float*)(ws + WS_LW); bf16* PBF = (bf16*)(ws + WS_PBF);
    bf16* WRH = (bf16*)(ws + WS_WRT); bf16* WRL = WRH + 48 * D;
    unsigned char* PKG = ws + WS_PKG; bf16* UT = (bf16*)(ws + WS_UT); bf16* OB = (bf16*)(ws + WS_OB);
    bf16* N1 = (bf16*)(ws + WS_N1); bf16* QKV = (bf16*)(ws + WS_QKV); float* OBUF = (float*)(ws + WS_QKV); bf16* PP = (bf16*)(ws + WS_QKV);
    bf16* MP = (bf16*)((unsigned char*)F.out + OUT_QKV2); bf16* MERGED = (bf16*)(ws + WS_QKV);     bf16* UPOOL = (bf16*)(ws + WS_UPOOL); bf16* ZS = (bf16*)(ws + WS_Z); bf16* HMID = (bf16*)(ws + WS_Z);
    bf16* GP = (bf16*)(ws + WS_GP); bf16* GD = (bf16*)(ws + WS_GD); bf16* Y0 = GP; bf16* Y1 = GD;
    bf16* DBUF = (bf16*)((unsigned char*)F.out + OUT_D); bf16* QKV2 = (bf16*)((unsigned char*)F.out + OUT_QKV2); float* H = F.out;
    const int gw = F.vcu * NWAVES + F.wave, NGW = F.G * NWAVES, lane = F.lane;

    if (IN(PH_PRO)) {
        LAS float* scr = (LAS float*)(F.lds + RING_OFF + F.wave * 16384);
        {
            const int nblk = N_IN_PAD / 32, items = (D / 64) * nblk;
            for (int it = gw; it < items; it += NGW) { const int kb = it / nblk, nb = it % nblk, r0 = 32 * nb; int c0, nv;
                if (r0 < 5120) { c0 = r0; nv = 32; } else { c0 = r0 + 16; nv = 32; }
                transpose_item(F.in[I_W_IN], D_IN, D, 64 * kb, c0, nv, WIN, r0, scr, lane); }
        }
        transpose_job(F.in[I_W_UP_DN], D_Z, D, WUPDN, scr, gw, NGW, lane);
        transpose_job(F.in[I_W_OUT], D, D, WOUT, scr, gw, NGW, lane);
        transpose_job(F.in[I_W_PLE_GATE], D, D, WPLEG, scr, gw, NGW, lane);
        transpose_job(F.in[I_W_PLE_PROJ], D_PLE, D, WPLEP, scr, gw, NGW, lane);
        {
            const float* pw = F.in[I_POOL_W]; const float* ps = F.in[I_POOL_SCALE]; const float* wu = F.in[I_W_UP_POOL];
            const int items = (D_POOL / 8) * (D / 64);
            for (int it = gw; it < items; it += NGW) { const int kg = it / (D / 64), nb = it % (D / 64), k0 = 8 * kg, g = k0 >> 8, kk0 = k0 & 255, n = 64 * nb + lane;
                float acc[8];
#pragma unroll
                for (int i = 0; i < 8; ++i) acc[i] = 0.f;
                for (int j = 0; j < POOL_GW; ++j) { const float wv = wu[(size_t)(256 * g + j) * D + n] * ps[256 * g + j];
#pragma unroll
                    for (int i = 0; i < 8; ++i) acc[i] += pw[(size_t)g * POOL_GW * POOL_GW + (size_t)(kk0 + i) * POOL_GW + j] * wv; }
                store8bf(WCOMB + (size_t)n * D_POOL + k0, acc); }
        }
        {
            const float* gm = F.in[I_NORM_MOE]; const float* wrg = F.in[I_W_RG]; const float* wre = F.in[I_W_RE];
            for (int idx = gw * 64 + lane; idx < 48 * D; idx += NGW * 64) { const int n = idx / D, k = idx % D;
                const float v = n < 4 ? gm[k] * wrg[(size_t)k * NGRP + n] : (n < 36 ? gm[k] * wre[(size_t)k * NE + (n - 4)] : 0.f);
                const unsigned hi = f2bf(v); WRH[idx] = (bf16)hi; WRL[idx] = (bf16)f2bf(v - __uint_as_float(hi << 16)); }
        }
        {
            const float* gain = F.in[I_NORM_MIX]; const float* win = F.in[I_W_IN];
            __syncthreads();
            LAS float* LGp = (LAS float*)(F.lds + RING_OFF);
            LAS float* SSp = LGp + 8 * 256;
            LAS float* RS = SSp + 128;
            const int row = lane & 15, g = lane >> 4, wv = F.wave;
            bf16x8 wbh[8], wbl[8];
#pragma unroll
            for (int J = 0; J < 8; ++J) { unsigned hh[4], ll[4];
#pragma unroll
                for (int q = 0; q < 4; ++q) { const int k = 256 * wv + 32 * J + 8 * g + 2 * q; const float v0 = gain[k] * win[(size_t)k * D_IN + 5120 + row], v1 = gain[k + 1] * win[(size_t)(k + 1) * D_IN + 5120 + row];
                    hh[q] = pk2(v0, v1); ll[q] = pk2(v0 - bflo(hh[q]), v1 - bfhi(hh[q])); }
                wbh[J] = __builtin_bit_cast(bf16x8, (v4u){hh[0], hh[1], hh[2], hh[3]}); wbl[J] = __builtin_bit_cast(bf16x8, (v4u){ll[0], ll[1], ll[2], ll[3]}); }
            for (int task = F.vcu; task < T / 16; task += F.G) {
                const int r0 = task * 16; const float* hp_ = F.in[I_X] + (size_t)(r0 + row) * D + 256 * wv + 8 * g;
                f32x4 a[8][2];
#pragma unroll
                for (int J = 0; J < 8; ++J) { a[J][0] = *(const f32x4*)(hp_ + 32 * J); a[J][1] = *(const f32x4*)(hp_ + 32 * J + 4); }
                f32x4 acc = (f32x4){0.f, 0.f, 0.f, 0.f}; float ss = 0.f;
#pragma unroll
                for (int J = 0; J < 8; ++J) { const f32x4 x0 = a[J][0], x1 = a[J][1];
                    ss += ((x0.x * x0.x + x0.y * x0.y) + (x0.z * x0.z + x0.w * x0.w)) + ((x1.x * x1.x + x1.y * x1.y) + (x1.z * x1.z + x1.w * x1.w));
                    const unsigned h0 = pk2(x0.x, x0.y), h1 = pk2(x0.z, x0.w), h2_ = pk2(x1.x, x1.y), h3 = pk2(x1.z, x1.w);
                    const unsigned l0 = pk2(x0.x - bflo(h0), x0.y - bfhi(h0)), l1 = pk2(x0.z - bflo(h1), x0.w - bfhi(h1)), l2 = pk2(x1.x - bflo(h2_), x1.y - bfhi(h2_)), l3 = pk2(x1.z - bflo(h3), x1.w - bfhi(h3));
                    const bf16x8 ah = __builtin_bit_cast(bf16x8, (v4u){h0, h1, h2_, h3}), al = __builtin_bit_cast(bf16x8, (v4u){l0, l1, l2, l3});
                    acc = __builtin_amdgcn_mfma_f32_16x16x32_bf16(ah, wbh[J], acc, 0, 0, 0); acc = __builtin_amdgcn_mfma_f32_16x16x32_bf16(al, wbh[J], acc, 0, 0, 0); acc = __builtin_amdgcn_mfma_f32_16x16x32_bf16(ah, wbl[J], acc, 0, 0, 0); }
                ss += __shfl_xor(ss, 16); ss += __shfl_xor(ss, 32);
                LDS_BARRIER();
#pragma unroll
                for (int reg = 0; reg < 4; ++reg) LGp[wv * 256 + (4 * g + reg) * 16 + row] = acc[reg];
                if (g == 0) SSp[wv * 16 + row] = ss;
                LDS_BARRIER();
                if (F.tid < 16) { float s8 = 0.f;
#pragma unroll
                    for (int w8 = 0; w8 < 8; ++w8) s8 += SSp[w8 * 16 + F.tid];
                    RS[F.tid] = 1.0f / sqrtf(s8 * (1.f / D) + EPS); }
                LDS_BARRIER();
                if (F.tid < 256) { float s8 = 0.f;
#pragma unroll
                    for (int w8 = 0; w8 < 8; ++w8) s8 += LGp[w8 * 256 + F.tid];
                    BA[(size_t)(r0 + (F.tid >> 4)) * 16 + (F.tid & 15)] = s8 * RS[F.tid >> 4]; }
                {   const float rs = RS[row]; bf16* op = N1 + (size_t)(r0 + row) * D + 256 * wv + 8 * g; const float* gp = gain + 256 * wv + 8 * g;
#pragma unroll
                    for (int J = 0; J < 8; ++J) { const f32x4 g0 = *(const f32x4*)(gp + 32 * J), g1 = *(const f32x4*)(gp + 32 * J + 4); const f32x4 x0 = a[J][0], x1 = a[J][1];
                        v4u o; o.x = pk2(x0.x * rs * g0.x, x0.y * rs * g0.y); o.y = pk2(x0.z * rs * g0.z, x0.w * rs * g0.w); o.z = pk2(x1.x * rs * g1.x, x1.y * rs * g1.y); o.w = pk2(x1.z * rs * g1.z, x1.w * rs * g1.w);
                        *(v4u*)(op + 32 * J) = o; }
                }
            }
            __syncthreads();
        }
        for (int m = gw; m < T; m += NGW) { const f32x4 v = *((const f32x4*)(F.in[I_P] + (size_t)m * D_PLE) + lane); v2u o; o.x = pk2(v.x, v.y); o.y = pk2(v.z, v.w); *((v2u*)(PBF + (size_t)m * D_PLE) + lane) = o; }
    }
    SEAM(PH_PRO);
    if (IN(PH_INPROJ)) {
        pg8::DenseOrder S; S.init(T, N_IN_PAD, D, F.G, (int)blockIdx.x);
        EpiInProj E{UPOOL, QKV, ZS, GP, GD};
        pg8::gemm_phase<EpiInProj, pg8::DenseOrder, false>(F.lds + RING_OFF, N1, WIN, D, S, E);
    }
    SEAM(PH_INPROJ);
    if (IN(PH_TOKLOC)) {
        const float* cw = F.in[I_CONV_W];
        LAS float* red = (LAS float*)(F.lds + RING_OFF + F.wave * 4608);
        LAS float* SC = red + 1024;
        for (int item = gw; item < 2048 * 12; item += NGW) {
            const int run = item / 12, blk = item % 12, t0 = run * 16, s0 = t0 % SEQ, c = blk * 256 + 4 * lane;
            v2u u[19];
#pragma unroll
            for (int i = 0; i < 19; ++i) { u[i] = (s0 - 3 + i >= 0) ? *(const v2u*)(QKV + (size_t)(t0 - 3 + i) * D_QKV + c) : (v2u){0u, 0u}; }
            f32x4 w[4];
#pragma unroll
            for (int kk = 0; kk < 4; ++kk) w[kk] = *(const f32x4*)(cw + kk * D_QKV + c);
            f32x4 y[16];
#pragma unroll
            for (int tt = 0; tt < 16; ++tt) { f32x4 a = (f32x4){0.f, 0.f, 0.f, 0.f};
#pragma unroll
                for (int kk = 0; kk < 4; ++kk) { const v2u x = u[tt + kk]; a.x += bflo(x.x) * w[kk].x; a.y += bfhi(x.x) * w[kk].y; a.z += bflo(x.y) * w[kk].z; a.w += bfhi(x.y) * w[kk].w; }
                a.x = siluf_(a.x); a.y = siluf_(a.y); a.z = siluf_(a.z); a.w = siluf_(a.w); y[tt] = a; }
            if (blk < 8) {
#pragma unroll
                for (int tt = 0; tt < 16; ++tt) red[tt * 64 + lane] = (y[tt].x * y[tt].x + y[tt].y * y[tt].y) + (y[tt].z * y[tt].z + y[tt].w * y[tt].w);
                asm volatile("s_waitcnt lgkmcnt(0)" ::: "memory");
                {   const int tt = lane & 15, hd = (lane >> 4) & 1, part = lane >> 5; float sm = 0.f;
#pragma unroll
                    for (int i = 0; i < 16; ++i) sm += red[tt * 64 + hd * 32 + part * 16 + ((i + lane) & 15)];
                    sm += __shfl_xor(sm, 32);
                    float rr = 1.0f / sqrtf(sm + EPS); if (blk < 4) rr *= 0.08838834764831845f;
                    if (part == 0) SC[hd * 16 + tt] = rr; }
                asm volatile("s_waitcnt lgkmcnt(0)" ::: "memory");
#pragma unroll
                for (int q4 = 0; q4 < 4; ++q4) { const f32x4 sc = *(const LAS f32x4*)(SC + (lane >> 5) * 16 + 4 * q4);
#pragma unroll
                    for (int i = 0; i < 4; ++i) y[4 * q4 + i] = y[4 * q4 + i] * sc[i]; }
                asm volatile("s_waitcnt lgkmcnt(0)" ::: "memory");
            }
#pragma unroll
            for (int tt = 0; tt < 16; ++tt) { v2u o; o.x = pk2(y[tt].x, y[tt].y); o.y = pk2(y[tt].z, y[tt].w); *(v2u*)(QKV2 + (size_t)(t0 + tt) * D_QKV + c) = o; }
        }
        for (int item = gw; item < 1024 * 4; item += NGW) {
            const int run = item >> 2, gi = item & 3, t0 = run * 32, s0 = t0 % SEQ, c = gi * 256 + 4 * lane;
#define POOL_BODY(W) { v2u u[31 + W]; \
                _Pragma("unroll") for (int i = 0; i < 31 + W; ++i) u[i] = (s0 - (W - 1) + i >= 0) ? *(const v2u*)(UPOOL + (size_t)(t0 - (W - 1) + i) * D_POOL + c) : (v2u){0u, 0u}; \
                _Pragma("unroll") for (int tt = 0; tt < 32; ++tt) { f32x4 sm = (f32x4){0.f, 0.f, 0.f, 0.f}; \
                    _Pragma("unroll") for (int j = 0; j < W; ++j) { const v2u x = u[tt + j]; sm.x += bflo(x.x); sm.y += bfhi(x.x); sm.z += bflo(x.y); sm.w += bfhi(x.y); } \
                    const v2u xc = u[tt + W - 1]; const float inv = 1.0f / (float)((s0 + tt + 1) < W ? (s0 + tt + 1) : W); \
                    v2u o; o.x = pk2(sm.x * inv - bflo(xc.x), sm.y * inv - bfhi(xc.x)); o.y = pk2(sm.z * inv - bflo(xc.y), sm.w * inv - bfhi(xc.y)); \
                    *(v2u*)(DBUF + (size_t)(t0 + tt) * D_POOL + c) = o; } }
            if (gi == 0) POOL_BODY(2) else if (gi == 1) POOL_BODY(4) else if (gi == 2) POOL_BODY(8) else POOL_BODY(16)
#undef POOL_BODY
        }
        for (int idx = gw * 64 + lane; idx < T * NH; idx += NGW * 64) { const int t = idx >> 3, hh = idx & 7; const float bl = BA[(size_t)t * 16 + hh], al = BA[(size_t)t * 16 + 8 + hh]; const float xx = al + F.in[I_DT_BIAS][hh];
            const float sp = xx > 20.f ? xx : log1pf(__expf(xx)); GG[idx] = -__expf(F.in[I_A_LOG][hh]) * sp; BETA[idx] = sigmoidf_(bl); }
    }
    SEAM(PH_TOKLOC);
    if (IN(PH_DNA)) {
        const int hb = F.tid >> 8, t4 = F.tid & 255, wq = t4 >> 6;
        LAS unsigned char* hl = F.lds + RING_OFF + hb * 62464;
        LAS bf16* Ks = (LAS bf16*)hl;
        LAS bf16* Qs = Ks + 64 * 136;
        LAS float* Ls = (LAS float*)(hl + 2 * 17408);
        LAS float* gs = (LAS float*)(hl + 3 * 17408);
        LAS bf16* IMG = (LAS bf16*)(hl + 3 * 17408 + 2048);
        LAS bf16* UWI = Qs;
        for (int up = F.vcu; up < DN_UNITS / 2; up += F.G) {
            const int unit = up * 2 + hb, bh = unit >> 7, cch = unit & 127, b = bh >> 3, h = bh & 7; const size_t tok0 = (size_t)b * SEQ + (size_t)cch * 64;
            unsigned char* pk = PKG + (size_t)unit * PKG_BYTES; bf16* pW = (bf16*)pk; bf16* pQ = (bf16*)(pk + 16384); bf16* pA = (bf16*)(pk + 32768); bf16* pKT = (bf16*)(pk + 40960); float* pS = (float*)(pk + 57344);
            bf16* pU = UT + (size_t)unit * 8192;
            float x[64];
            if (t4 < 128) {
#pragma unroll
                for (int i = 0; i < 64; ++i) x[i] = bf2f(QKV2[(tok0 + i) * D_QKV + 2048 + h * 128 + t4]);
            }
            LDS_BARRIER();
            if (t4 < 64) { gs[t4] = GG[(tok0 + t4) * NH + h]; gs[64 + t4] = BETA[(tok0 + t4) * NH + h]; }
#pragma unroll
            for (int i = 0; i < 4; ++i) { const int idx = t4 + 256 * i, row = idx >> 4, ch = idx & 15;
                *(LAS v4u*)(Ks + row * 136 + ch * 8) = *(const v4u*)(QKV2 + (tok0 + row) * D_QKV + 1024 + h * 128 + ch * 8);
                *(LAS v4u*)(Qs + row * 136 + ch * 8) = *(const v4u*)(QKV2 + (tok0 + row) * D_QKV + h * 128 + ch * 8); }
            LDS_BARRIER();
            if (t4 < 64) {
                float a = gs[t4];
#pragma unroll
                for (int o = 1; o < 64; o <<= 1) { const float tv = __shfl_up(a, o); if (lane >= o) a += tv; }
                gs[128 + t4] = a; }
            LDS_BARRIER();
            if (t4 < 64) { const float gl = gs[128 + 63], gc = gs[128 + t4]; gs[192 + t4] = __expf(gc); gs[256 + t4] = __expf(gl - gc); }
            {
                const int c = lane & 15, gq = lane >> 4;
                f32x4 kk[4], qk[4];
#pragma unroll
                for (int jb = 0; jb < 4; ++jb) { kk[jb] = (f32x4){0.f, 0.f, 0.f, 0.f}; qk[jb] = (f32x4){0.f, 0.f, 0.f, 0.f}; }
#pragma unroll
                for (int ks = 0; ks < 4; ++ks) {
                    const bf16x8 aK = *(const LAS bf16x8*)(Ks + (16 * wq + c) * 136 + 32 * ks + 8 * gq), aQ = *(const LAS bf16x8*)(Qs + (16 * wq + c) * 136 + 32 * ks + 8 * gq);
#pragma unroll
                    for (int jb = 0; jb < 4; ++jb) { const bf16x8 bK = *(const LAS bf16x8*)(Ks + (16 * jb + c) * 136 + 32 * ks + 8 * gq);
                        kk[jb] = __builtin_amdgcn_mfma_f32_16x16x32_bf16(aK, bK, kk[jb], 0, 0, 0); qk[jb] = __builtin_amdgcn_mfma_f32_16x16x32_bf16(aQ, bK, qk[jb], 0, 0, 0); }
                }
#pragma unroll
                for (int reg = 0; reg < 4; ++reg) { const int row = 16 * wq + 4 * gq + reg; const float gi = gs[128 + row], bi = gs[64 + row];
#pragma unroll
                    for (int jb = 0; jb < 4; ++jb) { const int col = 16 * jb + c; const float dec = (row >= col) ? __expf(gi - gs[128 + col]) : 0.f;
                        Ls[row * 68 + col] = (row > col) ? -(bi * kk[jb][reg] * dec) : 0.f;
                        IMG[tix(row, col, 4)] = (bf16)f2bf(qk[jb][reg] * dec); } }
            }
#pragma unroll 1
            for (int it = 0; it < 4; ++it) { const int sl = t4 + 256 * it, fr_ = sl >> 6, lp = sl & 63, hh = lp >> 5, r = lp & 31;
                {   const int rt = fr_ >> 3, s = fr_ & 7, row = 32 * rt + r, k0 = 16 * s + 4 * hh; const float eg = __expf(gs[128 + row]);
                    const v2u q0 = *(const LAS v2u*)(Qs + row * 136 + k0), q1 = *(const LAS v2u*)(Qs + row * 136 + k0 + 8);
                    v4u o; o.x = pk2(bflo(q0.x) * eg, bfhi(q0.x) * eg); o.y = pk2(bflo(q0.y) * eg, bfhi(q0.y) * eg); o.z = pk2(bflo(q1.x) * eg, bfhi(q1.x) * eg); o.w = pk2(bflo(q1.y) * eg, bfhi(q1.y) * eg);
                    *(v4u*)(pQ + sl * 8) = o; }
                {   const int rt = fr_ >> 2, s = fr_ & 3, dk = 32 * rt + r, i0 = 16 * s + 4 * hh; float kv[8]; const float gl_ = gs[128 + 63];
#pragma unroll
                    for (int e = 0; e < 4; ++e) { kv[e] = bf2f(Ks[(i0 + e) * 136 + dk]) * __expf(gl_ - gs[128 + i0 + e]); kv[4 + e] = bf2f(Ks[(i0 + 8 + e) * 136 + dk]) * __expf(gl_ - gs[128 + i0 + 8 + e]); }
                    v4u o; o.x = pk2(kv[0], kv[1]); o.y = pk2(kv[2], kv[3]); o.z = pk2(kv[4], kv[5]); o.w = pk2(kv[6], kv[7]);
                    *(v4u*)(pKT + sl * 8) = o; } }
            if (t4 == 0) pS[128] = __expf(gs[128 + 63]);
            LDS_BARRIER();
#pragma unroll
            for (int i = 0; i < 2; ++i) { const int idx = t4 + 256 * i; *(v4u*)(pA + idx * 8) = *(const LAS v4u*)(IMG + idx * 8); }
            {
                if (t4 < 128) {
#pragma unroll
                    for (int i = 0; i < 64; ++i) x[i] *= gs[64 + i];
                } else {
#pragma unroll
                    for (int i = 0; i < 64; ++i) x[i] = gs[64 + i] * bf2f(Ks[i * 136 + (t4 - 128)]) * gs[192 + i];
                }
                SolveRows<60>::run(x, Ls, lane & 15);
            }
            LDS_BARRIER();
            if (t4 < 128) { const int w = t4 >> 5, c = t4 & 31;
#pragma unroll
                for (int i = 0; i < 64; ++i) { const int rt = i >> 5, i32 = i & 31, hh = (i32 >> 2) & 1, reg = (i32 & 3) + 4 * (i32 >> 3); UWI[(((w * 2 + rt) * 64 + hh * 32 + c) << 4) + reg] = (bf16)f2bf(x[i]); }
            } else { const int dk = t4 - 128;
#pragma unroll
                for (int i = 0; i < 64; ++i) UWI[8192 + tix(i, dk, 8)] = (bf16)f2bf(-x[i]);
            }
            LDS_BARRIER();
#pragma unroll
            for (int i = 0; i < 4; ++i) { const int idx = t4 + 256 * i; *(v4u*)(pU + idx * 8) = *(const LAS v4u*)(UWI + idx * 8); *(v4u*)(pW + idx * 8) = *(const LAS v4u*)(UWI + 8192 + idx * 8); }
        }
        __syncthreads();
    }
    SEAM(PH_DNA);
    if (IN(PH_DN)) {
        if ((int)blockIdx.x < NB * NH) { if (!(args.flags & 1)) {
            const int bh = (int)blockIdx.x, b = bh >> 3, hh = bh & 7; const size_t tokb = (size_t)b * SEQ;
            const unsigned char* pkg0 = PKG + (size_t)bh * 128 * PKG_BYTES; const bf16* ut0 = UT + (size_t)bh * 128 * 8192;
            const bool loader = F.wave >= 4; const int lt = F.tid - 256;
            if (loader) {
                v4u la[19], lb[19];
                constexpr int NCH = STG_BYTES / 16, NPK = PKG_BYTES / 16;
#define DN_LD(dst, pn) do { const int pn_ = (pn) < 127 ? (pn) : 127; const unsigned char* src_ = pkg0 + (size_t)pn_ * PKG_BYTES; const unsigned char* usrc_ = (const unsigned char*)(ut0 + (size_t)pn_ * 8192); _Pragma("unroll") for (int i = 0; i < 19; ++i) { int idx = lt + 256 * i; idx = idx < NCH ? idx : NCH - 1; \
        dst[i] = __builtin_nontemporal_load((const v4u*)((idx < NPK) ? (src_ + (size_t)idx * 16) : (usrc_ + (size_t)(idx - NPK) * 16))); } } while (0)
#define DN_ST(srcr, stg) do { _Pragma("unroll") for (int i = 0; i < 19; ++i) { const int idx = lt + 256 * i; if (idx < NCH) *(LAS v4u*)(F.lds + RING_OFF + (stg) * STG_BYTES + idx * 16) = srcr[i]; } } while (0)
                DN_LD(la, 0); DN_ST(la, 0); DN_LD(la, 1); DN_LD(lb, 2);
                for (int n = 0; n < 128; n += 2) {
                    LDS_BARRIER();
                    DN_ST(la, 1); DN_LD(la, n + 3);
                    LDS_BARRIER();
                    DN_ST(lb, 0); DN_LD(lb, n + 4);
                }
#undef DN_LD
#undef DN_ST
            } else {
            const int w = F.wave & 3, r = lane & 31, h2 = lane >> 5;
            f32x16 S[4]; bf16x8 Sb[8];
#pragma unroll
            for (int d = 0; d < 4; ++d)
#pragma unroll
                for (int i = 0; i < 16; ++i) S[d][i] = 0.f;
#pragma unroll
            for (int s = 0; s < 8; ++s)
#pragma unroll
                for (int i = 0; i < 8; ++i) Sb[s][i] = 0;
            for (int n = 0; n < 128; ++n) {
                LDS_BARRIER();
                {
                    LAS unsigned char* st = F.lds + RING_OFF + (n & 1) * STG_BYTES;
                    const LAS float* sc = (const LAS float*)(st + 57344);
#define FRAG(off, f) (*(const LAS bf16x8*)(st + (off) + (f) * 1024 + lane * 16))
#define MF(a, b, c) __builtin_amdgcn_mfma_f32_32x32x16_bf16((a), (b), (c), 0, 0, 0)
#define SB() __builtin_amdgcn_sched_barrier(0)
                    f32x16 vn[2], qs[2];
#pragma unroll
                    for (int rt = 0; rt < 2; ++rt) {
#pragma unroll
                        for (int q = 0; q < 2; ++q) { const v4u u4 = *(const LAS v4u*)(st + PKG_BYTES + (((w * 2 + rt) * 64 + lane) << 5) + q * 16);
                            vn[rt][8 * q + 0] = bflo(u4.x); vn[rt][8 * q + 1] = bfhi(u4.x); vn[rt][8 * q + 2] = bflo(u4.y); vn[rt][8 * q + 3] = bfhi(u4.y);
                            vn[rt][8 * q + 4] = bflo(u4.z); vn[rt][8 * q + 5] = bfhi(u4.z); vn[rt][8 * q + 6] = bflo(u4.w); vn[rt][8 * q + 7] = bfhi(u4.w); }
#pragma unroll
                        for (int i = 0; i < 16; ++i) qs[rt][i] = 0.f; }
                    bf16x8 fa[4], fb[4];
                    fa[0] = FRAG(0, 0); fa[1] = FRAG(0, 8); fa[2] = FRAG(16384, 0); fa[3] = FRAG(16384, 8);
                    fb[0] = FRAG(0, 1); fb[1] = FRAG(0, 9); fb[2] = FRAG(16384, 1); fb[3] = FRAG(16384, 9);
                    SB();
#pragma unroll
                    for (int s = 0; s < 8; s += 2) {
                        vn[0] = MF(fa[0], Sb[s], vn[0]); vn[1] = MF(fa[1], Sb[s], vn[1]); qs[0] = MF(fa[2], Sb[s], qs[0]); qs[1] = MF(fa[3], Sb[s], qs[1]);
                        SB();
                        if (s + 2 < 8) { fa[0] = FRAG(0, s + 2); fa[1] = FRAG(0, 8 + s + 2); fa[2] = FRAG(16384, s + 2); fa[3] = FRAG(16384, 8 + s + 2); }
                        SB();
                        vn[0] = MF(fb[0], Sb[s + 1], vn[0]); vn[1] = MF(fb[1], Sb[s + 1], vn[1]); qs[0] = MF(fb[2], Sb[s + 1], qs[0]); qs[1] = MF(fb[3], Sb[s + 1], qs[1]);
                        SB();
                        if (s + 3 < 8) { fb[0] = FRAG(0, s + 3); fb[1] = FRAG(0, 8 + s + 3); fb[2] = FRAG(16384, s + 3); fb[3] = FRAG(16384, 8 + s + 3); }
                        SB();
                    }
                    bf16x8 ga[6], gb[6];
#define LD6(dst, sp) do { dst[0] = FRAG(32768, sp); dst[1] = FRAG(32768, 4 + (sp)); dst[2] = FRAG(40960, sp); dst[3] = FRAG(40960, 4 + (sp)); dst[4] = FRAG(40960, 8 + (sp)); dst[5] = FRAG(40960, 12 + (sp)); } while (0)
                    LD6(ga, 0); LD6(gb, 1);
                    const float egl = sc[128];
                    SB();
                    bf16x8 vb[4];
#pragma unroll
                    for (int sp = 0; sp < 4; ++sp) { const int rt = sp >> 1, base = 8 * (sp & 1); unsigned pv[4];
#pragma unroll
                        for (int jj = 0; jj < 4; ++jj) pv[jj] = pk2(vn[rt][base + 2 * jj], vn[rt][base + 2 * jj + 1]);
                        vb[sp] = __builtin_bit_cast(bf16x8, (v4u){pv[0], pv[1], pv[2], pv[3]}); }
#pragma unroll
                    for (int d = 0; d < 4; ++d)
#pragma unroll
                        for (int i = 0; i < 16; ++i) S[d][i] *= egl;
                    SB();
#pragma unroll
                    for (int sp = 0; sp < 4; sp += 2) {
                        qs[0] = MF(ga[0], vb[sp], qs[0]); qs[1] = MF(ga[1], vb[sp], qs[1]); S[0] = MF(ga[2], vb[sp], S[0]); S[1] = MF(ga[3], vb[sp], S[1]); S[2] = MF(ga[4], vb[sp], S[2]); S[3] = MF(ga[5], vb[sp], S[3]);
                        SB();
                        if (sp + 2 < 4) LD6(ga, sp + 2);
                        SB();
                        qs[0] = MF(gb[0], vb[sp + 1], qs[0]); qs[1] = MF(gb[1], vb[sp + 1], qs[1]); S[0] = MF(gb[2], vb[sp + 1], S[0]); S[1] = MF(gb[3], vb[sp + 1], S[1]); S[2] = MF(gb[4], vb[sp + 1], S[2]); S[3] = MF(gb[5], vb[sp + 1], S[3]);
                        SB();
                        if (sp + 3 < 4) LD6(gb, sp + 3);
                        SB();
                    }
#undef LD6
#undef FRAG
#undef MF
#undef SB
#pragma unroll
                    for (int s = 0; s < 8; ++s) { const int d = s >> 1, base = 8 * (s & 1); unsigned pv[4];
#pragma unroll
                        for (int jj = 0; jj < 4; ++jj) pv[jj] = pk2(S[d][base + 2 * jj], S[d][base + 2 * jj + 1]);
                        Sb[s] = __builtin_bit_cast(bf16x8, (v4u){pv[0], pv[1], pv[2], pv[3]}); }
                    {
                        LAS bf16* ot = (LAS bf16*)(F.lds + OT_OFF + w * 2048);
                        bf16* ob = OB + (tokb + (size_t)n * 64 + (lane >> 1)) * D_Z + hh * 128 + 32 * w + 16 * (lane & 1);
#pragma unroll
                        for (int rt = 0; rt < 2; ++rt) {
#pragma unroll
                            for (int rp = 0; rp < 8; ++rp) { const int reg = 2 * rp, row = (reg & 3) + 8 * (reg >> 2) + 4 * h2; const unsigned pv = pk2(qs[rt][reg], qs[rt][reg + 1]);
                                ot[row * 32 + r] = (bf16)(pv & 0xffffu); ot[(row + 1) * 32 + r] = (bf16)(pv >> 16); }
                            asm volatile("s_waitcnt lgkmcnt(0)" ::: "memory");
                            const v4u o0 = *(const LAS v4u*)(ot + (lane >> 1) * 32 + 16 * (lane & 1)), o1 = *(const LAS v4u*)(ot + (lane >> 1) * 32 + 16 * (lane & 1) + 8);
                            asm volatile("s_waitcnt lgkmcnt(0)" ::: "memory");
                            *(v4u*)(ob + (size_t)(32 * rt) * D_Z) = o0; *(v4u*)(ob + (size_t)(32 * rt) * D_Z + 8) = o1; } }
                }
            }
            }
        } } else if (!(args.flags & 2)) {
            pg8::DenseOrder S; S.init(T, D, D_POOL, F.G - NB * NH, (int)blockIdx.x - NB * NH); EpiPool E{GP, MP};
            pg8::gemm_phase<EpiPool, pg8::DenseOrder, false>(F.lds + RING_OFF, DBUF, WCOMB, D_POOL, S, E);
            __syncthreads();
            LAS float* scr = (LAS float*)(F.lds + RING_OFF + F.wave * 16384);
            const int gw2 = ((int)blockIdx.x - NB * NH) * NWAVES + F.wave, NGW2 = (F.G - NB * NH) * NWAVES;
        {
            const int items = NE * (D / 64) * 32;
            for (int it = gw2; it < items; it += NGW2) { const int e = it / (32 * 32), rem = it % (32 * 32), kb = rem / 32, nb = rem % 32;
                const int r0 = 32 * nb, pn = r0 >> 8, rin = r0 & 255; const bool up = rin >= 128; const int c0 = pn * 128 + (rin & 127);
                transpose_item((up ? F.in[I_W_UP] : F.in[I_W_GATE]) + (size_t)e * D * DE, DE, D, 64 * kb, c0, 32, WGU + (size_t)e * 1024 * D, r0, scr, lane); }
        }
        {
            const int per = (DE / 64) * (D / 32), items = NE * per;
            for (int it = gw2; it < items; it += NGW2) { const int e = it / per, rem = it % per, kb = rem / (D / 32), nb = rem % (D / 32);
                transpose_item(F.in[I_W_DOWN] + (size_t)e * DE * D, D, DE, 64 * kb, 32 * nb, 32, WDN + (size_t)e * D * DE, 32 * nb, scr, lane); }
        }
        }
        __syncthreads();
    }
    SEAM(PH_DN);
    if (IN(PH_YDN)) {
        bf16* YDN = N1; const float* dn = F.in[I_DN_NORM];
        for (int it = gw; it < T * NH; it += NGW) { const int t = it / NH, h = it % NH; const size_t off = (size_t)t * D_Z + h * 128 + 2 * lane;
            const unsigned ou = *(const unsigned*)(OB + off); const float o0 = bflo(ou), o1 = bfhi(ou); const float r = 1.0f / sqrtf(wave_sum(o0 * o0 + o1 * o1) * (1.f / 128.f) + EPS);
            const unsigned zu = *(const unsigned*)(ZS + off); *(unsigned*)(YDN + off) = pk2(o0 * r * dn[2 * lane] * bflo(zu), o1 * r * dn[2 * lane + 1] * bfhi(zu)); }
    }
    SEAM(PH_YDN);
    if (IN(PH_MERGE)) { pg8::DenseOrder S; S.init(T, D, D_Z, F.G, (int)blockIdx.x); EpiMerge E{GD, MP, MERGED}; pg8::gemm_phase<EpiMerge, pg8::DenseOrder, false>(F.lds + RING_OFF, N1, WUPDN, D_Z, S, E); }
    SEAM(PH_MERGE);
    if (IN(PH_OUT)) { pg8::DenseOrder S; S.init(T, D, D, F.G, (int)blockIdx.x); EpiResid E{F.in[I_X], H}; pg8::gemm_phase<EpiResid, pg8::DenseOrder, false>(F.lds + RING_OFF, MERGED, WOUT, D, S, E); }
    SEAM(PH_OUT);
    if (IN(PH_ROUTE)) {
        const float* gain = F.in[I_NORM_MOE];
        LAS float* LGp = (LAS float*)(F.lds + RING_OFF);
        LAS float* LGs = LGp + 8 * 768;
        LAS float* SSp = LGs + 768;
        LAS float* RS = SSp + 128;
        LAS unsigned* LCNT = (LAS unsigned*)(RS + 16);
        LAS int* ENT = (LAS int*)(LCNT + 64);
        if (F.tid < 64) LCNT[F.tid] = 0u;
        int ntok = 0;
        __syncthreads();
        const int row = lane & 15, g = lane >> 4, wv = F.wave;
        const bf16* wph = WRH + (size_t)row * D + 256 * wv + 8 * g;
#define RT_LOAD(dst, tsk) do { const float* hp_ = H + (size_t)((tsk) * 16 + row) * D + 256 * wv + 8 * g; _Pragma("unroll") for (int J = 0; J < 8; ++J) { dst[J][0] = *(const f32x4*)(hp_ + 32 * J); dst[J][1] = *(const f32x4*)(hp_ + 32 * J + 4); } } while (0)
#define RT_BODY(a, an, task, ntask) do { \
            const int r0 = (task) * 16; \
            f32x4 acc0 = (f32x4){0.f, 0.f, 0.f, 0.f}, acc1 = acc0, acc2 = acc0; float ss = 0.f; \
            _Pragma("unroll") for (int J = 0; J < 8; ++J) { \
                const f32x4 x0 = a[J][0], x1 = a[J][1]; \
                ss += ((x0.x * x0.x + x0.y * x0.y) + (x0.z * x0.z + x0.w * x0.w)) + ((x1.x * x1.x + x1.y * x1.y) + (x1.z * x1.z + x1.w * x1.w)); \
                const unsigned h0 = pk2(x0.x, x0.y), h1 = pk2(x0.z, x0.w), h2_ = pk2(x1.x, x1.y), h3 = pk2(x1.z, x1.w); \
                const unsigned l0 = pk2(x0.x - bflo(h0), x0.y - bfhi(h0)), l1 = pk2(x0.z - bflo(h1), x0.w - bfhi(h1)), l2 = pk2(x1.x - bflo(h2_), x1.y - bfhi(h2_)), l3 = pk2(x1.z - bflo(h3), x1.w - bfhi(h3)); \
                const bf16x8 ah = __builtin_bit_cast(bf16x8, (v4u){h0, h1, h2_, h3}), al = __builtin_bit_cast(bf16x8, (v4u){l0, l1, l2, l3}); \
                acc0 = __builtin_amdgcn_mfma_f32_16x16x32_bf16(ah, wb[J][0], acc0, 0, 0, 0); acc1 = __builtin_amdgcn_mfma_f32_16x16x32_bf16(ah, wb[J][1], acc1, 0, 0, 0); acc2 = __builtin_amdgcn_mfma_f32_16x16x32_bf16(ah, wb[J][2], acc2, 0, 0, 0); \
                acc0 = __builtin_amdgcn_mfma_f32_16x16x32_bf16(al, wb[J][0], acc0, 0, 0, 0); acc1 = __builtin_amdgcn_mfma_f32_16x16x32_bf16(al, wb[J][1], acc1, 0, 0, 0); acc2 = __builtin_amdgcn_mfma_f32_16x16x32_bf16(al, wb[J][2], acc2, 0, 0, 0); } \
            ss += __shfl_xor(ss, 16); ss += __shfl_xor(ss, 32); \
            LDS_BARRIER(); \
            _Pragma("unroll") for (int reg = 0; reg < 4; ++reg) { LAS float* q = LGp + wv * 768 + (4 * g + reg) * 48 + row; q[0] = acc0[reg]; q[16] = acc1[reg]; q[32] = acc2[reg]; } \
            if (g == 0) SSp[wv * 16 + row] = ss; \
            LDS_BARRIER(); \
            for (int e = F.tid; e < 768; e += NTHR) { float s8 = 0.f; _Pragma("unroll") for (int w8 = 0; w8 < 8; ++w8) s8 += LGp[w8 * 768 + e]; LGs[e] = s8; } \
            if (F.tid < 16) { float s8 = 0.f; _Pragma("unroll") for (int w8 = 0; w8 < 8; ++w8) s8 += SSp[w8 * 16 + F.tid]; RS[F.tid] = 1.0f / sqrtf(s8 * (1.f / D) + EPS); } \
            LDS_BARRIER(); \
            if (F.tid < 16) route_row(F, LGs + F.tid * 48, RS[F.tid], r0 + F.tid, LCNT, ENT, 2 * (ntok + F.tid)); ntok += 16; \
            { const float rs = RS[row]; bf16* op = N1 + (size_t)(r0 + row) * D + 256 * wv + 8 * g; const float* gp = gain + 256 * wv + 8 * g; \
              _Pragma("unroll") for (int J = 0; J < 8; ++J) { const f32x4 g0 = *(const f32x4*)(gp + 32 * J), g1 = *(const f32x4*)(gp + 32 * J + 4); const f32x4 x0 = a[J][0], x1 = a[J][1]; \
                v4u o; o.x = pk2(x0.x * rs * g0.x, x0.y * rs * g0.y); o.y = pk2(x0.z * rs * g0.z, x0.w * rs * g0.w); o.z = pk2(x1.x * rs * g1.x, x1.y * rs * g1.y); o.w = pk2(x1.z * rs * g1.z, x1.w * rs * g1.w); \
                *(v4u*)(op + 32 * J) = o; } } } while (0)
        f32x4 ra[8][2];
        bf16x8 wb[8][3];
#pragma unroll
        for (int J = 0; J < 8; ++J)
#pragma unroll
            for (int t3 = 0; t3 < 3; ++t3) wb[J][t3] = *(const bf16x8*)(wph + 16 * t3 * D + 32 * J);
        for (int task = F.vcu; task < T / 16; task += F.G) { RT_LOAD(ra, task); RT_BODY(ra, ra, task, 0); }
#undef RT_LOAD
#undef RT_BODY
        __syncthreads();
        if (F.tid < NE) LCNT[32 + F.tid] = atomicAdd(&F.ctl[CW_CNT + 64 * F.tid], LCNT[F.tid]);
        __syncthreads();
        for (int i = F.tid; i < 2 * ntok; i += NTHR) { const int es = ENT[4 * i], e = es >> 16, slot = (int)LCNT[32 + e] + (es & 0xffff); LTK[(size_t)e * T + slot] = ENT[4 * i + 1]; LW[(size_t)e * T + slot] = __int_as_float(ENT[4 * i + 2]); }
        __syncthreads();
    }
    SEAM(PH_ROUTE);
    if (IN(PH_MOE1)) {
        LAS int* pre = (LAS int*)(F.lds + MISC_OFF + 256); LAS int* base = pre + 40;
        moe_tables<256>(F, pre, base);
        MoeSched<256, true> S{pre, base, LTK, 4, F.G, F.vcu, D, 1024};
        EpiMoe1 E{HMID}; pg8::gemm_phase<EpiMoe1, MoeSched<256, true>, true>(F.lds + RING_OFF, N1, WGU, D, S, E);
    }
    SEAM(PH_MOE1);
    if (IN(PH_MOE2)) {
        LAS int* pre = (LAS int*)(F.lds + MISC_OFF + 256); LAS int* base = pre + 40;
        moe_tables<256>(F, pre, base);
        MoeSched<256, false> S{pre, base, LTK, 8, F.G, F.vcu, DE, D};
        EpiMoe2 E{LTK, LW, Y0, Y1}; pg8::gemm_phase<EpiMoe2, MoeSched<256, false>, false>(F.lds + RING_OFF, HMID, WDN, DE, S, E);
    }
    SEAM(PH_MOE2);
    if (IN(PH_N3)) {
        const float* gain = F.in[I_NORM_PLE];
        for (int t = gw; t < T; t += NGW) {
            f32x4* hr = (f32x4*)(H + (size_t)t * D) + lane; const f32x4* gr = (const f32x4*)gain + lane;
            const v2u* y0r = (const v2u*)(Y0 + (size_t)t * D) + lane; const v2u* y1r = (const v2u*)(Y1 + (size_t)t * D) + lane;
            f32x4 v[8]; float s = 0.f;
#pragma unroll
            for (int j = 0; j < 8; ++j) { const v2u a = y0r[64 * j], b = y1r[64 * j]; f32x4 x = hr[64 * j];
                x.x += bflo(a.x) + bflo(b.x); x.y += bfhi(a.x) + bfhi(b.x); x.z += bflo(a.y) + bflo(b.y); x.w += bfhi(a.y) + bfhi(b.y);
                v[j] = x; hr[64 * j] = x; s += (x.x * x.x + x.y * x.y) + (x.z * x.z + x.w * x.w); }
            const float rstd = 1.0f / sqrtf(wave_sum(s) * (1.f / D) + EPS);
            v2u* o8 = (v2u*)(N1 + (size_t)t * D) + lane;
#pragma unroll
            for (int j = 0; j < 8; ++j) { const f32x4 g = gr[64 * j]; v2u o; o.x = pk2(v[j].x * rstd * g.x, v[j].y * rstd * g.y); o.y = pk2(v[j].z * rstd * g.z, v[j].w * rstd * g.w); o8[64 * j] = o; }
        }
    }
    SEAM(PH_N3);
    if (IN(PH_PP)) { pg8::DenseOrder S; S.init(T, D, D_PLE, F.G, (int)blockIdx.x); EpiBf16Plain E{PP}; pg8::gemm_phase<EpiBf16Plain, pg8::DenseOrder, false>(F.lds + RING_OFF, PBF, WPLEP, D_PLE, S, E); }
    SEAM(PH_PP);
    if (IN(PH_PLE)) { pg8::DenseOrder S; S.init(T, D, D, F.G, (int)blockIdx.x); EpiPle E{PP, H}; pg8::gemm_phase<EpiPle, pg8::DenseOrder, false>(F.lds + RING_OFF, N1, WPLEG, D, S, E); }
    SEAM(PH_PLE);
    if (IN(PH_FINAL)) {
        const float* gain = F.in[I_NORM_FINAL];
        for (int t = gw; t < T; t += NGW) {
            f32x4* hr = (f32x4*)(H + (size_t)t * D) + lane; const f32x4* gr = (const f32x4*)gain + lane;
            f32x4 v[8]; float s = 0.f;
#pragma unroll
            for (int j = 0; j < 8; ++j) { v[j] = hr[64 * j]; s += (v[j].x * v[j].x + v[j].y * v[j].y) + (v[j].z * v[j].z + v[j].w * v[j].w); }
            const float rstd = 1.0f / sqrtf(wave_sum(s) * (1.f / D) + EPS);
#pragma unroll
            for (int j = 0; j < 8; ++j) { const f32x4 g = gr[64 * j]; hr[64 * j] = v[j] * rstd * g; }
        }
    }
#undef IN
#undef SEAM
}

extern "C" void kernel_launch(void* const* d_in, const int* in_sizes, int n_in, void* d_out, int out_size, void* d_ws, size_t ws_size, hipStream_t stream) {
    static int grid = 0;
    if (grid == 0) {
        if (n_in != 25 || in_sizes[0] != T * D || out_size != T * D || ws_size < WS_END) { fprintf(stderr, "kernel_launch: unexpected shapes (n_in %d, in0 %d, out %d, ws %zu); nothing launched\n", n_in, n_in > 0 ? in_sizes[0] : -1, out_size, ws_size); grid = -1; return; }
        int dev = 0, cus = 0, per_cu = 0;
        if (hipGetDevice(&dev) != hipSuccess || hipDeviceGetAttribute(&cus, hipDeviceAttributeMultiprocessorCount, dev) != hipSuccess) { grid = -1; return; }
        if (hipFuncSetAttribute((const void*)fwd, hipFuncAttributeMaxDynamicSharedMemorySize, LDS_BYTES) != hipSuccess) { fprintf(stderr, "kernel_launch: hipFuncSetAttribute failed\n"); grid = -1; return; }
        if (hipOccupancyMaxActiveBlocksPerMultiprocessor(&per_cu, (const void*)fwd, NTHR, LDS_BYTES) != hipSuccess || per_cu < 1) fprintf(stderr, "kernel_launch: occupancy query reports %d\n", per_cu);
        (void)hipGetLastError();
        grid = cus;
    }
    if (grid < 0) return;
    (void)hipMemsetAsync((char*)d_ws + WS_CTL, 0, CTL_ZERO_BYTES, stream);
    Args a{};
    for (int i = 0; i < 25; ++i) a.in[i] = (const float*)d_in[i];
    a.out = (float*)d_out; a.ws = (unsigned char*)d_ws;
    if (MK_N_LAUNCHES == 1) { a.ph_lo = 0; a.ph_hi = NPHASE; hipLaunchKernelGGL(fwd, dim3(grid), dim3(NTHR), LDS_BYTES, stream, a); }
    else for (int k = 0; k < NPHASE; ++k) { a.ph_lo = k; a.ph_hi = k + 1; hipLaunchKernelGGL(fwd, dim3(grid), dim3(NTHR), LDS_BYTES, stream, a); }
}
```

```cpp
#include <hip/hip_runtime.h>
#include <cstdio>
#include <cstdint>

#ifndef MK_N_LAUNCHES
#define MK_N_LAUNCHES 1
#endif

#define GAS __attribute__((address_space(1)))
#define LAS __attribute__((address_space(3)))
typedef unsigned short bf16;
typedef unsigned v4u __attribute__((ext_vector_type(4)));
typedef unsigned v2u __attribute__((ext_vector_type(2)));
typedef float f32x4 __attribute__((ext_vector_type(4)));
typedef float f32x16 __attribute__((ext_vector_type(16)));
typedef short bf16x8 __attribute__((ext_vector_type(8)));

constexpr int NB = 4, SEQ = 8192, T = NB * SEQ, D = 2048;
constexpr int D_PLE = 256, D_POOL = 1024, POOL_GW = 256, NH = 8, DK = 128, D_QKV = 3072, D_Z = 1024;
constexpr int D_IN = 9232, N_IN_PAD = 9216;
constexpr int NE = 32, EPG = 8, NGRP = 4, DE = 512;
constexpr float EPS = 1e-6f;
constexpr int NWAVES = 8, NTHR = 512;
constexpr int DN_UNITS = NB * NH * (SEQ / 64);
constexpr int STG_BYTES = 58368 + 16384;
constexpr int PKG_BYTES = 58368;

constexpr size_t MiB = 1u << 20;
constexpr size_t WS_CTL = 0, CTL_ZERO_BYTES = 65536;
constexpr size_t WS_WRT = 512 * 1024;
constexpr size_t WS_WIN = 1 * MiB;
constexpr size_t WS_WCOMB = 38 * MiB;
constexpr size_t WS_WUPDN = 42 * MiB;
constexpr size_t WS_WOUT = 46 * MiB;
constexpr size_t WS_WPLEG = 54 * MiB;
constexpr size_t WS_WPLEP = 62 * MiB;
constexpr size_t WS_WGU = 63 * MiB;
constexpr size_t WS_WDN = 191 * MiB;
constexpr size_t WS_BA = 255 * MiB;
constexpr size_t WS_G = 257 * MiB;
constexpr size_t WS_BETA = 258 * MiB;
constexpr size_t WS_LTK = 259 * MiB;
constexpr size_t WS_LW = 263 * MiB;
constexpr size_t WS_PBF = 267 * MiB;
constexpr size_t WS_N1 = 283 * MiB;
constexpr size_t WS_PKG = 283 * MiB;
constexpr size_t WS_UT = 511 * MiB;
constexpr size_t WS_OB = 575 * MiB;
constexpr size_t WS_QKV = 411 * MiB;
constexpr size_t WS_MP = 539 * MiB;
constexpr size_t WS_UPOOL = 603 * MiB;
constexpr size_t WS_Z = 667 * MiB;
constexpr size_t WS_GP = 731 * MiB;
constexpr size_t WS_GD = 859 * MiB;
constexpr size_t WS_END = 987 * MiB;
constexpr size_t OUT_D = 0, OUT_QKV2 = 64 * MiB;
constexpr int CW_CNT = 1024;
constexpr int CW_BAR = 4096;

constexpr int RING_OFF = 0, RING_BYTES = 153600;
constexpr int MISC_OFF = RING_BYTES;
constexpr int MISC_WORDS = 256;
constexpr int OT_OFF = 154624;
constexpr int LDS_BYTES = 162816;

#define LDS_WAIT() asm volatile("s_waitcnt lgkmcnt(0)" ::: "memory")
#define VM_WAIT() asm volatile("s_waitcnt vmcnt(0)" ::: "memory")
#define LDS_BARRIER() do { asm volatile("s_waitcnt lgkmcnt(0)" ::: "memory"); __builtin_amdgcn_s_barrier(); asm volatile("" ::: "memory"); } while (0)
__device__ __forceinline__ float bflo(unsigned u) { return __uint_as_float(u << 16); }
__device__ __forceinline__ float bfhi(unsigned u) { return __uint_as_float(u & 0xffff0000u); }
__device__ __forceinline__ float bf2f(bf16 b) { return __uint_as_float((unsigned)b << 16); }
__device__ __forceinline__ unsigned f2bf(float f) { unsigned u = __float_as_uint(f); return (u + 0x7fffu + ((u >> 16) & 1u)) >> 16; }
typedef __bf16 bf16x2_t __attribute__((ext_vector_type(2)));
typedef float f32x2_t __attribute__((ext_vector_type(2)));
__device__ __forceinline__ unsigned pk2(float lo, float hi) { const f32x2_t v = {lo, hi}; const bf16x2_t b = __builtin_convertvector(v, bf16x2_t); return __builtin_bit_cast(unsigned, b); }
__device__ __forceinline__ float wave_sum(float v) {
#pragma unroll
    for (int o = 1; o < 64; o <<= 1) v += __shfl_xor(v, o);
    return v;
}
__device__ __forceinline__ float sigmoidf_(float x) { return __builtin_amdgcn_rcpf(1.0f + __builtin_amdgcn_exp2f(-1.4426950408889634f * x)); }
__device__ __forceinline__ float siluf_(float x) { return x * __builtin_amdgcn_rcpf(1.0f + __builtin_amdgcn_exp2f(-1.4426950408889634f * x)); }
__device__ __forceinline__ void store8bf(bf16* p, const float* v) {
    v4u o; o.x = pk2(v[0], v[1]); o.y = pk2(v[2], v[3]); o.z = pk2(v[4], v[5]); o.w = pk2(v[6], v[7]); *(v4u*)p = o;
}
__device__ __forceinline__ void load8bf(const bf16* p, float* v) {
    const v4u o = *(const v4u*)p; v[0] = bflo(o.x); v[1] = bfhi(o.x); v[2] = bflo(o.y); v[3] = bfhi(o.y); v[4] = bflo(o.z); v[5] = bfhi(o.z); v[6] = bflo(o.w); v[7] = bfhi(o.w);
}

__device__ __forceinline__ int tix(int row, int k, int kd16) { const int k16 = k & 15; return ((((row >> 5) * kd16 + (k >> 4)) * 64 + ((k16 >> 2) & 1) * 32 + (row & 31)) << 3) + (k16 & 3) + ((k16 >> 3) << 2); }


template <int J> __device__ __forceinline__ void fmac_bcast(float& acc, float l, float x) {
    asm volatile("v_fmac_f32_dpp %0, %1, %2 row_newbcast:%3 row_mask:0xf bank_mask:0xf" : "+v"(acc) : "v"(l), "v"(x), "n"(J));
}
template <int N> struct FmacChunk;
template <> struct FmacChunk<1> {
    static __device__ __forceinline__ void run(float& acc, float l, float x0) {
        asm volatile("v_fmac_f32_dpp %0, %1, %2 row_newbcast:0 row_mask:0xf bank_mask:0xf\n\t" : "+v"(acc) : "v"(l), "v"(x0));
    }
};
template <> struct FmacChunk<2> {
    static __device__ __forceinline__ void run(float& acc, float l, float x0, float x1) {
        asm volatile("v_fmac_f32_dpp %0, %1, %2 row_newbcast:0 row_mask:0xf bank_mask:0xf\n\t" "v_fmac_f32_dpp %0, %1, %3 row_newbcast:1 row_mask:0xf bank_mask:0xf\n\t" : "+v"(acc) : "v"(l), "v"(x0), "v"(x1));
    }
};
template <> struct FmacChunk<3> {
    static __device__ __forceinline__ void run(float& acc, float l, float x0, float x1, float x2) {
        asm volatile("v_fmac_f32_dpp %0, %1, %2 row_newbcast:0 row_mask:0xf bank_mask:0xf\n\t" "v_fmac_f32_dpp %0, %1, %3 row_newbcast:1 row_mask:0xf bank_mask:0xf\n\t" "v_fmac_f32_dpp %0, %1, %4 row_newbcast:2 row_mask:0xf bank_mask:0xf\n\t" : "+v"(acc) : "v"(l), "v"(x0), "v"(x1), "v"(x2));
    }
};
template <> struct FmacChunk<4> {
    static __device__ __forceinline__ void run(float& acc, float l, float x0, float x1, float x2, float x3) {
        asm volatile("v_fmac_f32_dpp %0, %1, %2 row_newbcast:0 row_mask:0xf bank_mask:0xf\n\t" "v_fmac_f32_dpp %0, %1, %3 row_newbcast:1 row_mask:0xf bank_mask:0xf\n\t" "v_fmac_f32_dpp %0, %1, %4 row_newbcast:2 row_mask:0xf bank_mask:0xf\n\t" "v_fmac_f32_dpp %0, %1, %5 row_newbcast:3 row_mask:0xf bank_mask:0xf\n\t" : "+v"(acc) : "v"(l), "v"(x0), "v"(x1), "v"(x2), "v"(x3));
    }
};
template <> struct FmacChunk<5> {
    static __device__ __forceinline__ void run(float& acc, float l, float x0, float x1, float x2, float x3, float x4) {
        asm volatile("v_fmac_f32_dpp %0, %1, %2 row_newbcast:0 row_mask:0xf bank_mask:0xf\n\t" "v_fmac_f32_dpp %0, %1, %3 row_newbcast:1 row_mask:0xf bank_mask:0xf\n\t" "v_fmac_f32_dpp %0, %1, %4 row_newbcast:2 row_mask:0xf bank_mask:0xf\n\t" "v_fmac_f32_dpp %0, %1, %5 row_newbcast:3 row_mask:0xf bank_mask:0xf\n\t" "v_fmac_f32_dpp %0, %1, %6 row_newbcast:4 row_mask:0xf bank_mask:0xf\n\t" : "+v"(acc) : "v"(l), "v"(x0), "v"(x1), "v"(x2), "v"(x3), "v"(x4));
    }
};
template <> struct FmacChunk<6> {
    static __device__ __forceinline__ void run(float& acc, float l, float x0, float x1, float x2, float x3, float x4, float x5) {
        asm volatile("v_fmac_f32_dpp %0, %1, %2 row_newbcast:0 row_mask:0xf bank_mask:0xf\n\t" "v_fmac_f32_dpp %0, %1, %3 row_newbcast:1 row_mask:0xf bank_mask:0xf\n\t" "v_fmac_f32_dpp %0, %1, %4 row_newbcast:2 row_mask:0xf bank_mask:0xf\n\t" "v_fmac_f32_dpp %0, %1, %5 row_newbcast:3 row_mask:0xf bank_mask:0xf\n\t" "v_fmac_f32_dpp %0, %1, %6 row_newbcast:4 row_mask:0xf bank_mask:0xf\n\t" "v_fmac_f32_dpp %0, %1, %7 row_newbcast:5 row_mask:0xf bank_mask:0xf\n\t" : "+v"(acc) : "v"(l), "v"(x0), "v"(x1), "v"(x2), "v"(x3), "v"(x4), "v"(x5));
    }
};
template <> struct FmacChunk<7> {
    static __device__ __forceinline__ void run(float& acc, float l, float x0, float x1, float x2, float x3, float x4, float x5, float x6) {
        asm volatile("v_fmac_f32_dpp %0, %1, %2 row_newbcast:0 row_mask:0xf bank_mask:0xf\n\t" "v_fmac_f32_dpp %0, %1, %3 row_newbcast:1 row_mask:0xf bank_mask:0xf\n\t" "v_fmac_f32_dpp %0, %1, %4 row_newbcast:2 row_mask:0xf bank_mask:0xf\n\t" "v_fmac_f32_dpp %0, %1, %5 row_newbcast:3 row_mask:0xf bank_mask:0xf\n\t" "v_fmac_f32_dpp %0, %1, %6 row_newbcast:4 row_mask:0xf bank_mask:0xf\n\t" "v_fmac_f32_dpp %0, %1, %7 row_newbcast:5 row_mask:0xf bank_mask:0xf\n\t" "v_fmac_f32_dpp %0, %1, %8 row_newbcast:6 row_mask:0xf bank_mask:0xf\n\t" : "+v"(acc) : "v"(l), "v"(x0), "v"(x1), "v"(x2), "v"(x3), "v"(x4), "v"(x5), "v"(x6));
    }
};
template <> struct FmacChunk<8> {
    static __device__ __forceinline__ void run(float& acc, float l, float x0, float x1, float x2, float x3, float x4, float x5, float x6, float x7) {
        asm volatile("v_fmac_f32_dpp %0, %1, %2 row_newbcast:0 row_mask:0xf bank_mask:0xf\n\t" "v_fmac_f32_dpp %0, %1, %3 row_newbcast:1 row_mask:0xf bank_mask:0xf\n\t" "v_fmac_f32_dpp %0, %1, %4 row_newbcast:2 row_mask:0xf bank_mask:0xf\n\t" "v_fmac_f32_dpp %0, %1, %5 row_newbcast:3 row_mask:0xf bank_mask:0xf\n\t" "v_fmac_f32_dpp %0, %1, %6 row_newbcast:4 row_mask:0xf bank_mask:0xf\n\t" "v_fmac_f32_dpp %0, %1, %7 row_newbcast:5 row_mask:0xf bank_mask:0xf\n\t" "v_fmac_f32_dpp %0, %1, %8 row_newbcast:6 row_mask:0xf bank_mask:0xf\n\t" "v_fmac_f32_dpp %0, %1, %9 row_newbcast:7 row_mask:0xf bank_mask:0xf\n\t" : "+v"(acc) : "v"(l), "v"(x0), "v"(x1), "v"(x2), "v"(x3), "v"(x4), "v"(x5), "v"(x6), "v"(x7));
    }
};
template <> struct FmacChunk<9> {
    static __device__ __forceinline__ void run(float& acc, float l, float x0, float x1, float x2, float x3, float x4, float x5, float x6, float x7, float x8) {
        asm volatile("v_fmac_f32_dpp %0, %1, %2 row_newbcast:0 row_mask:0xf bank_mask:0xf\n\t" "v_fmac_f32_dpp %0, %1, %3 row_newbcast:1 row_mask:0xf bank_mask:0xf\n\t" "v_fmac_f32_dpp %0, %1, %4 row_newbcast:2 row_mask:0xf bank_mask:0xf\n\t" "v_fmac_f32_dpp %0, %1, %5 row_newbcast:3 row_mask:0xf bank_mask:0xf\n\t" "v_fmac_f32_dpp %0, %1, %6 row_newbcast:4 row_mask:0xf bank_mask:0xf\n\t" "v_fmac_f32_dpp %0, %1, %7 row_newbcast:5 row_mask:0xf bank_mask:0xf\n\t" "v_fmac_f32_dpp %0, %1, %8 row_newbcast:6 row_mask:0xf bank_mask:0xf\n\t" "v_fmac_f32_dpp %0, %1, %9 row_newbcast:7 row_mask:0xf bank_mask:0xf\n\t" "v_fmac_f32_dpp %0, %1, %10 row_newbcast:8 row_mask:0xf bank_mask:0xf\n\t" : "+v"(acc) : "v"(l), "v"(x0), "v"(x1), "v"(x2), "v"(x3), "v"(x4), "v"(x5), "v"(x6), "v"(x7), "v"(x8));
    }
};
template <> struct FmacChunk<10> {
    static __device__ __forceinline__ void run(float& acc, float l, float x0, float x1, float x2, float x3, float x4, float x5, float x6, float x7, float x8, float x9) {
        asm volatile("v_fmac_f32_dpp %0, %1, %2 row_newbcast:0 row_mask:0xf bank_mask:0xf\n\t" "v_fmac_f32_dpp %0, %1, %3 row_newbcast:1 row_mask:0xf bank_mask:0xf\n\t" "v_fmac_f32_dpp %0, %1, %4 row_newbcast:2 row_mask:0xf bank_mask:0xf\n\t" "v_fmac_f32_dpp %0, %1, %5 row_newbcast:3 row_mask:0xf bank_mask:0xf\n\t" "v_fmac_f32_dpp %0, %1, %6 row_newbcast:4 row_mask:0xf bank_mask:0xf\n\t" "v_fmac_f32_dpp %0, %1, %7 row_newbcast:5 row_mask:0xf bank_mask:0xf\n\t" "v_fmac_f32_dpp %0, %1, %8 row_newbcast:6 row_mask:0xf bank_mask:0xf\n\t" "v_fmac_f32_dpp %0, %1, %9 row_newbcast:7 row_mask:0xf bank_mask:0xf\n\t" "v_fmac_f32_dpp %0, %1, %10 row_newbcast:8 row_mask:0xf bank_mask:0xf\n\t" "v_fmac_f32_dpp %0, %1, %11 row_newbcast:9 row_mask:0xf bank_mask:0xf\n\t" : "+v"(acc) : "v"(l), "v"(x0), "v"(x1), "v"(x2), "v"(x3), "v"(x4), "v"(x5), "v"(x6), "v"(x7), "v"(x8), "v"(x9));
    }
};
template <> struct FmacChunk<11> {
    static __device__ __forceinline__ void run(float& acc, float l, float x0, float x1, float x2, float x3, float x4, float x5, float x6, float x7, float x8, float x9, float x10) {
        asm volatile("v_fmac_f32_dpp %0, %1, %2 row_newbcast:0 row_mask:0xf bank_mask:0xf\n\t" "v_fmac_f32_dpp %0, %1, %3 row_newbcast:1 row_mask:0xf bank_mask:0xf\n\t" "v_fmac_f32_dpp %0, %1, %4 row_newbcast:2 row_mask:0xf bank_mask:0xf\n\t" "v_fmac_f32_dpp %0, %1, %5 row_newbcast:3 row_mask:0xf bank_mask:0xf\n\t" "v_fmac_f32_dpp %0, %1, %6 row_newbcast:4 row_mask:0xf bank_mask:0xf\n\t" "v_fmac_f32_dpp %0, %1, %7 row_newbcast:5 row_mask:0xf bank_mask:0xf\n\t" "v_fmac_f32_dpp %0, %1, %8 row_newbcast:6 row_mask:0xf bank_mask:0xf\n\t" "v_fmac_f32_dpp %0, %1, %9 row_newbcast:7 row_mask:0xf bank_mask:0xf\n\t" "v_fmac_f32_dpp %0, %1, %10 row_newbcast:8 row_mask:0xf bank_mask:0xf\n\t" "v_fmac_f32_dpp %0, %1, %11 row_newbcast:9 row_mask:0xf bank_mask:0xf\n\t" "v_fmac_f32_dpp %0, %1, %12 row_newbcast:10 row_mask:0xf bank_mask:0xf\n\t" : "+v"(acc) : "v"(l), "v"(x0), "v"(x1), "v"(x2), "v"(x3), "v"(x4), "v"(x5), "v"(x6), "v"(x7), "v"(x8), "v"(x9), "v"(x10));
    }
};
template <> struct FmacChunk<12> {
    static __device__ __forceinline__ void run(float& acc, float l, float x0, float x1, float x2, float x3, float x4, float x5, float x6, float x7, float x8, float x9, float x10, float x11) {
        asm volatile("v_fmac_f32_dpp %0, %1, %2 row_newbcast:0 row_mask:0xf bank_mask:0xf\n\t" "v_fmac_f32_dpp %0, %1, %3 row_newbcast:1 row_mask:0xf bank_mask:0xf\n\t" "v_fmac_f32_dpp %0, %1, %4 row_newbcast:2 row_mask:0xf bank_mask:0xf\n\t" "v_fmac_f32_dpp %0, %1, %5 row_newbcast:3 row_mask:0xf bank_mask:0xf\n\t" "v_fmac_f32_dpp %0, %1, %6 row_newbcast:4 row_mask:0xf bank_mask:0xf\n\t" "v_fmac_f32_dpp %0, %1, %7 row_newbcast:5 row_mask:0xf bank_mask:0xf\n\t" "v_fmac_f32_dpp %0, %1, %8 row_newbcast:6 row_mask:0xf bank_mask:0xf\n\t" "v_fmac_f32_dpp %0, %1, %9 row_newbcast:7 row_mask:0xf bank_mask:0xf\n\t" "v_fmac_f32_dpp %0, %1, %10 row_newbcast:8 row_mask:0xf bank_mask:0xf\n\t" "v_fmac_f32_dpp %0, %1, %11 row_newbcast:9 row_mask:0xf bank_mask:0xf\n\t" "v_fmac_f32_dpp %0, %1, %12 row_newbcast:10 row_mask:0xf bank_mask:0xf\n\t" "v_fmac_f32_dpp %0, %1, %13 row_newbcast:11 row_mask:0xf bank_mask:0xf\n\t" : "+v"(acc) : "v"(l), "v"(x0), "v"(x1), "v"(x2), "v"(x3), "v"(x4), "v"(x5), "v"(x6), "v"(x7), "v"(x8), "v"(x9), "v"(x10), "v"(x11));
    }
};
template <> struct FmacChunk<13> {
    static __device__ __forceinline__ void run(float& acc, float l, float x0, float x1, float x2, float x3, float x4, float x5, float x6, float x7, float x8, float x9, float x10, float x11, float x12) {
        asm volatile("v_fmac_f32_dpp %0, %1, %2 row_newbcast:0 row_mask:0xf bank_mask:0xf\n\t" "v_fmac_f32_dpp %0, %1, %3 row_newbcast:1 row_mask:0xf bank_mask:0xf\n\t" "v_fmac_f32_dpp %0, %1, %4 row_newbcast:2 row_mask:0xf bank_mask:0xf\n\t" "v_fmac_f32_dpp %0, %1, %5 row_newbcast:3 row_mask:0xf bank_mask:0xf\n\t" "v_fmac_f32_dpp %0, %1, %6 row_newbcast:4 row_mask:0xf bank_mask:0xf\n\t" "v_fmac_f32_dpp %0, %1, %7 row_newbcast:5 row_mask:0xf bank_mask:0xf\n\t" "v_fmac_f32_dpp %0, %1, %8 row_newbcast:6 row_mask:0xf bank_mask:0xf\n\t" "v_fmac_f32_dpp %0, %1, %9 row_newbcast:7 row_mask:0xf bank_mask:0xf\n\t" "v_fmac_f32_dpp %0, %1, %10 row_newbcast:8 row_mask:0xf bank_mask:0xf\n\t" "v_fmac_f32_dpp %0, %1, %11 row_newbcast:9 row_mask:0xf bank_mask:0xf\n\t" "v_fmac_f32_dpp %0, %1, %12 row_newbcast:10 row_mask:0xf bank_mask:0xf\n\t" "v_fmac_f32_dpp %0, %1, %13 row_newbcast:11 row_mask:0xf bank_mask:0xf\n\t" "v_fmac_f32_dpp %0, %1, %14 row_newbcast:12 row_mask:0xf bank_mask:0xf\n\t" : "+v"(acc) : "v"(l), "v"(x0), "v"(x1), "v"(x2), "v"(x3), "v"(x4), "v"(x5), "v"(x6), "v"(x7), "v"(x8), "v"(x9), "v"(x10), "v"(x11), "v"(x12));
    }
};
template <> struct FmacChunk<14> {
    static __device__ __forceinline__ void run(float& acc, float l, float x0, float x1, float x2, float x3, float x4, float x5, float x6, float x7, float x8, float x9, float x10, float x11, float x12, float x13) {
        asm volatile("v_fmac_f32_dpp %0, %1, %2 row_newbcast:0 row_mask:0xf bank_mask:0xf\n\t" "v_fmac_f32_dpp %0, %1, %3 row_newbcast:1 row_mask:0xf bank_mask:0xf\n\t" "v_fmac_f32_dpp %0, %1, %4 row_newbcast:2 row_mask:0xf bank_mask:0xf\n\t" "v_fmac_f32_dpp %0, %1, %5 row_newbcast:3 row_mask:0xf bank_mask:0xf\n\t" "v_fmac_f32_dpp %0, %1, %6 row_newbcast:4 row_mask:0xf bank_mask:0xf\n\t" "v_fmac_f32_dpp %0, %1, %7 row_newbcast:5 row_mask:0xf bank_mask:0xf\n\t" "v_fmac_f32_dpp %0, %1, %8 row_newbcast:6 row_mask:0xf bank_mask:0xf\n\t" "v_fmac_f32_dpp %0, %1, %9 row_newbcast:7 row_mask:0xf bank_mask:0xf\n\t" "v_fmac_f32_dpp %0, %1, %10 row_newbcast:8 row_mask:0xf bank_mask:0xf\n\t" "v_fmac_f32_dpp %0, %1, %11 row_newbcast:9 row_mask:0xf bank_mask:0xf\n\t" "v_fmac_f32_dpp %0, %1, %12 row_newbcast:10 row_mask:0xf bank_mask:0xf\n\t" "v_fmac_f32_dpp %0, %1, %13 row_newbcast:11 row_mask:0xf bank_mask:0xf\n\t" "v_fmac_f32_dpp %0, %1, %14 row_newbcast:12 row_mask:0xf bank_mask:0xf\n\t" "v_fmac_f32_dpp %0, %1, %15 row_newbcast:13 row_mask:0xf bank_mask:0xf\n\t" : "+v"(acc) : "v"(l), "v"(x0), "v"(x1), "v"(x2), "v"(x3), "v"(x4), "v"(x5), "v"(x6), "v"(x7), "v"(x8), "v"(x9), "v"(x10), "v"(x11), "v"(x12), "v"(x13));
    }
};
template <> struct FmacChunk<15> {
    static __device__ __forceinline__ void run(float& acc, float l, float x0, float x1, float x2, float x3, float x4, float x5, float x6, float x7, float x8, float x9, float x10, float x11, float x12, float x13, float x14) {
        asm volatile("v_fmac_f32_dpp %0, %1, %2 row_newbcast:0 row_mask:0xf bank_mask:0xf\n\t" "v_fmac_f32_dpp %0, %1, %3 row_newbcast:1 row_mask:0xf bank_mask:0xf\n\t" "v_fmac_f32_dpp %0, %1, %4 row_newbcast:2 row_mask:0xf bank_mask:0xf\n\t" "v_fmac_f32_dpp %0, %1, %5 row_newbcast:3 row_mask:0xf bank_mask:0xf\n\t" "v_fmac_f32_dpp %0, %1, %6 row_newbcast:4 row_mask:0xf bank_mask:0xf\n\t" "v_fmac_f32_dpp %0, %1, %7 row_newbcast:5 row_mask:0xf bank_mask:0xf\n\t" "v_fmac_f32_dpp %0, %1, %8 row_newbcast:6 row_mask:0xf bank_mask:0xf\n\t" "v_fmac_f32_dpp %0, %1, %9 row_newbcast:7 row_mask:0xf bank_mask:0xf\n\t" "v_fmac_f32_dpp %0, %1, %10 row_newbcast:8 row_mask:0xf bank_mask:0xf\n\t" "v_fmac_f32_dpp %0, %1, %11 row_newbcast:9 row_mask:0xf bank_mask:0xf\n\t" "v_fmac_f32_dpp %0, %1, %12 row_newbcast:10 row_mask:0xf bank_mask:0xf\n\t" "v_fmac_f32_dpp %0, %1, %13 row_newbcast:11 row_mask:0xf bank_mask:0xf\n\t" "v_fmac_f32_dpp %0, %1, %14 row_newbcast:12 row_mask:0xf bank_mask:0xf\n\t" "v_fmac_f32_dpp %0, %1, %15 row_newbcast:13 row_mask:0xf bank_mask:0xf\n\t" "v_fmac_f32_dpp %0, %1, %16 row_newbcast:14 row_mask:0xf bank_mask:0xf\n\t" : "+v"(acc) : "v"(l), "v"(x0), "v"(x1), "v"(x2), "v"(x3), "v"(x4), "v"(x5), "v"(x6), "v"(x7), "v"(x8), "v"(x9), "v"(x10), "v"(x11), "v"(x12), "v"(x13), "v"(x14));
    }
};
template <> struct FmacChunk<16> {
    static __device__ __forceinline__ void run(float& acc, float l, float x0, float x1, float x2, float x3, float x4, float x5, float x6, float x7, float x8, float x9, float x10, float x11, float x12, float x13, float x14, float x15) {
        asm volatile("v_fmac_f32_dpp %0, %1, %2 row_newbcast:0 row_mask:0xf bank_mask:0xf\n\t" "v_fmac_f32_dpp %0, %1, %3 row_newbcast:1 row_mask:0xf bank_mask:0xf\n\t" "v_fmac_f32_dpp %0, %1, %4 row_newbcast:2 row_mask:0xf bank_mask:0xf\n\t" "v_fmac_f32_dpp %0, %1, %5 row_newbcast:3 row_mask:0xf bank_mask:0xf\n\t" "v_fmac_f32_dpp %0, %1, %6 row_newbcast:4 row_mask:0xf bank_mask:0xf\n\t" "v_fmac_f32_dpp %0, %1, %7 row_newbcast:5 row_mask:0xf bank_mask:0xf\n\t" "v_fmac_f32_dpp %0, %1, %8 row_newbcast:6 row_mask:0xf bank_mask:0xf\n\t" "v_fmac_f32_dpp %0, %1, %9 row_newbcast:7 row_mask:0xf bank_mask:0xf\n\t" "v_fmac_f32_dpp %0, %1, %10 row_newbcast:8 row_mask:0xf bank_mask:0xf\n\t" "v_fmac_f32_dpp %0, %1, %11 row_newbcast:9 row_mask:0xf bank_mask:0xf\n\t" "v_fmac_f32_dpp %0, %1, %12 row_newbcast:10 row_mask:0xf bank_mask:0xf\n\t" "v_fmac_f32_dpp %0, %1, %13 row_newbcast:11 row_mask:0xf bank_mask:0xf\n\t" "v_fmac_f32_dpp %0, %1, %14 row_newbcast:12 row_mask:0xf bank_mask:0xf\n\t" "v_fmac_f32_dpp %0, %1, %15 row_newbcast:13 row_mask:0xf bank_mask:0xf\n\t" "v_fmac_f32_dpp %0, %1, %16 row_newbcast:14 row_mask:0xf bank_mask:0xf\n\t" "v_fmac_f32_dpp %0, %1, %17 row_newbcast:15 row_mask:0xf bank_mask:0xf\n\t" : "+v"(acc) : "v"(l), "v"(x0), "v"(x1), "v"(x2), "v"(x3), "v"(x4), "v"(x5), "v"(x6), "v"(x7), "v"(x8), "v"(x9), "v"(x10), "v"(x11), "v"(x12), "v"(x13), "v"(x14), "v"(x15));
    }
};
template <int N, int B> struct ChunkCall;
#define CC_ARGS1(B) x[B]
#define CC_ARGS2(B) CC_ARGS1(B), x[B + 1]
#define CC_ARGS3(B) CC_ARGS2(B), x[B + 2]
#define CC_ARGS4(B) CC_ARGS3(B), x[B + 3]
#define CC_ARGS5(B) CC_ARGS4(B), x[B + 4]
#define CC_ARGS6(B) CC_ARGS5(B), x[B + 5]
#define CC_ARGS7(B) CC_ARGS6(B), x[B + 6]
#define CC_ARGS8(B) CC_ARGS7(B), x[B + 7]
#define CC_ARGS9(B) CC_ARGS8(B), x[B + 8]
#define CC_ARGS10(B) CC_ARGS9(B), x[B + 9]
#define CC_ARGS11(B) CC_ARGS10(B), x[B + 10]
#define CC_ARGS12(B) CC_ARGS11(B), x[B + 11]
#define CC_ARGS13(B) CC_ARGS12(B), x[B + 12]
#define CC_ARGS14(B) CC_ARGS13(B), x[B + 13]
#define CC_ARGS15(B) CC_ARGS14(B), x[B + 14]
#define CC_ARGS16(B) CC_ARGS15(B), x[B + 15]
#define CC_DEF(N) template <int B> struct ChunkCall<N, B> { static __device__ __forceinline__ void run(float (&x)[64], float& acc, float l) { FmacChunk<N>::run(acc, l, CC_ARGS##N(B)); } };
CC_DEF(1) CC_DEF(2) CC_DEF(3) CC_DEF(4) CC_DEF(5) CC_DEF(6) CC_DEF(7) CC_DEF(8) CC_DEF(9) CC_DEF(10) CC_DEF(11) CC_DEF(12) CC_DEF(13) CC_DEF(14) CC_DEF(15) CC_DEF(16)
#undef CC_DEF
template <int N> struct QuadChunk;
template <> struct QuadChunk<1> {
    static __device__ __forceinline__ void run(float& a0, float& a1, float& a2, float& a3, float l0, float l1, float l2, float l3, float x0) {
        asm volatile("v_fmac_f32_dpp %0, %4, %8 row_newbcast:0 row_mask:0xf bank_mask:0xf\n\t" "v_fmac_f32_dpp %1, %5, %8 row_newbcast:0 row_mask:0xf bank_mask:0xf\n\t" "v_fmac_f32_dpp %2, %6, %8 row_newbcast:0 row_mask:0xf bank_mask:0xf\n\t" "v_fmac_f32_dpp %3, %7, %8 row_newbcast:0 row_mask:0xf bank_mask:0xf\n\t" : "+v"(a0), "+v"(a1), "+v"(a2), "+v"(a3) : "v"(l0), "v"(l1), "v"(l2), "v"(l3), "v"(x0));
    }
};
template <> struct QuadChunk<2> {
    static __device__ __forceinline__ void run(float& a0, float& a1, float& a2, float& a3, float l0, float l1, float l2, float l3, float x0, float x1) {
        asm volatile("v_fmac_f32_dpp %0, %4, %8 row_newbcast:0 row_mask:0xf bank_mask:0xf\n\t" "v_fmac_f32_dpp %1, %5, %8 row_newbcast:0 row_mask:0xf bank_mask:0xf\n\t" "v_fmac_f32_dpp %2, %6, %8 row_newbcast:0 row_mask:0xf bank_mask:0xf\n\t" "v_fmac_f32_dpp %3, %7, %8 row_newbcast:0 row_mask:0xf bank_mask:0xf\n\t" "v_fmac_f32_dpp %0, %4, %9 row_newbcast:1 row_mask:0xf bank_mask:0xf\n\t" "v_fmac_f32_dpp %1, %5, %9 row_newbcast:1 row_mask:0xf bank_mask:0xf\n\t" "v_fmac_f32_dpp %2, %6, %9 row_newbcast:1 row_mask:0xf bank_mask:0xf\n\t" "v_fmac_f32_dpp %3, %7, %9 row_newbcast:1 row_mask:0xf bank_mask:0xf\n\t" : "+v"(a0), "+v"(a1), "+v"(a2), "+v"(a3) : "v"(l0), "v"(l1), "v"(l2), "v"(l3), "v"(x0), "v"(x1));
    }
};
template <> struct QuadChunk<3> {
    static __device__ __forceinline__ void run(float& a0, float& a1, float& a2, float& a3, float l0, float l1, float l2, float l3, float x0, float x1, float x2) {
        asm volatile("v_fmac_f32_dpp %0, %4, %8 row_newbcast:0 row_mask:0xf bank_mask:0xf\n\t" "v_fmac_f32_dpp %1, %5, %8 row_newbcast:0 row_mask:0xf bank_mask:0xf\n\t" "v_fmac_f32_dpp %2, %6, %8 row_newbcast:0 row_mask:0xf bank_mask:0xf\n\t" "v_fmac_f32_dpp %3, %7, %8 row_newbcast:0 row_mask:0xf bank_mask:0xf\n\t" "v_fmac_f32_dpp %0, %4, %9 row_newbcast:1 row_mask:0xf bank_mask:0xf\n\t" "v_fmac_f32_dpp %1, %5, %9 row_newbcast:1 row_mask:0xf bank_mask:0xf\n\t" "v_fmac_f32_dpp %2, %6, %9 row_newbcast:1 row_mask:0xf bank_mask:0xf\n\t" "v_fmac_f32_dpp %3, %7, %9 row_newbcast:1 row_mask:0xf bank_mask:0xf\n\t" "v_fmac_f32_dpp %0, %4, %10 row_newbcast:2 row_mask:0xf bank_mask:0xf\n\t" "v_fmac_f32_dpp %1, %5, %10 row_newbcast:2 row_mask:0xf bank_mask:0xf\n\t" "v_fmac_f32_dpp %2, %6, %10 row_newbcast:2 row_mask:0xf bank_mask:0xf\n\t" "v_fmac_f32_dpp %3, %7, %10 row_newbcast:2 row_mask:0xf bank_mask:0xf\n\t" : "+v"(a0), "+v"(a1), "+v"(a2), "+v"(a3) : "v"(l0), "v"(l1), "v"(l2), "v"(l3), "v"(x0), "v"(x1), "v"(x2));
    }
};
template <> struct QuadChunk<4> {
    static __device__ __forceinline__ void run(float& a0, float& a1, float& a2, float& a3, float l0, float l1, float l2, float l3, float x0, float x1, float x2, float x3) {
        asm volatile("v_fmac_f32_dpp %0, %4, %8 row_newbcast:0 row_mask:0xf bank_mask:0xf\n\t" "v_fmac_f32_dpp %1, %5, %8 row_newbcast:0 row_mask:0xf bank_mask:0xf\n\t" "v_fmac_f32_dpp %2, %6, %8 row_newbcast:0 row_mask:0xf bank_mask:0xf\n\t" "v_fmac_f32_dpp %3, %7, %8 row_newbcast:0 row_mask:0xf bank_mask:0xf\n\t" "v_fmac_f32_dpp %0, %4, %9 row_newbcast:1 row_mask:0xf bank_mask:0xf\n\t" "v_fmac_f32_dpp %1, %5, %9 row_newbcast:1 row_mask:0xf bank_mask:0xf\n\t" "v_fmac_f32_dpp %2, %6, %9 row_newbcast:1 row_mask:0xf bank_mask:0xf\n\t" "v_fmac_f32_dpp %3, %7, %9 row_newbcast:1 row_mask:0xf bank_mask:0xf\n\t" "v_fmac_f32_dpp %0, %4, %10 row_newbcast:2 row_mask:0xf bank_mask:0xf\n\t" "v_fmac_f32_dpp %1, %5, %10 row_newbcast:2 row_mask:0xf bank_mask:0xf\n\t" "v_fmac_f32_dpp %2, %6, %10 row_newbcast:2 row_mask:0xf bank_mask:0xf\n\t" "v_fmac_f32_dpp %3, %7, %10 row_newbcast:2 row_mask:0xf bank_mask:0xf\n\t" "v_fmac_f32_dpp %0, %4, %11 row_newbcast:3 row_mask:0xf bank_mask:0xf\n\t" "v_fmac_f32_dpp %1, %5, %11 row_newbcast:3 row_mask:0xf bank_mask:0xf\n\t" "v_fmac_f32_dpp %2, %6, %11 row_newbcast:3 row_mask:0xf bank_mask:0xf\n\t" "v_fmac_f32_dpp %3, %7, %11 row_newbcast:3 row_mask:0xf bank_mask:0xf\n\t" : "+v"(a0), "+v"(a1), "+v"(a2), "+v"(a3) : "v"(l0), "v"(l1), "v"(l2), "v"(l3), "v"(x0), "v"(x1), "v"(x2), "v"(x3));
    }
};
template <> struct QuadChunk<5> {
    static __device__ __forceinline__ void run(float& a0, float& a1, float& a2, float& a3, float l0, float l1, float l2, float l3, float x0, float x1, float x2, float x3, float x4) {
        asm volatile("v_fmac_f32_dpp %0, %4, %8 row_newbcast:0 row_mask:0xf bank_mask:0xf\n\t" "v_fmac_f32_dpp %1, %5, %8 row_newbcast:0 row_mask:0xf bank_mask:0xf\n\t" "v_fmac_f32_dpp %2, %6, %8 row_newbcast:0 row_mask:0xf bank_mask:0xf\n\t" "v_fmac_f32_dpp %3, %7, %8 row_newbcast:0 row_mask:0xf bank_mask:0xf\n\t" "v_fmac_f32_dpp %0, %4, %9 row_newbcast:1 row_mask:0xf bank_mask:0xf\n\t" "v_fmac_f32_dpp %1, %5, %9 row_newbcast:1 row_mask:0xf bank_mask:0xf\n\t" "v_fmac_f32_dpp %2, %6, %9 row_newbcast:1 row_mask:0xf bank_mask:0xf\n\t" "v_fmac_f32_dpp %3, %7, %9 row_newbcast:1 row_mask:0xf bank_mask:0xf\n\t" "v_fmac_f32_dpp %0, %4, %10 row_newbcast:2 row_mask:0xf bank_mask:0xf\n\t" "v_fmac_f32_dpp %1, %5, %10 row_newbcast:2 row_mask:0xf bank_mask:0xf\n\t" "v_fmac_f32_dpp %2, %6, %10 row_newbcast:2 row_mask:0xf bank_mask:0xf\n\t" "v_fmac_f32_dpp %3, %7, %10 row_newbcast:2 row_mask:0xf bank_mask:0xf\n\t" "v_fmac_f32_dpp %0, %4, %11 row_newbcast:3 row_mask:0xf bank_mask:0xf\n\t" "v_fmac_f32_dpp %1, %5, %11 row_newbcast:3 row_mask:0xf bank_mask:0xf\n\t" "v_fmac_f32_dpp %2, %6, %11 row_newbcast:3 row_mask:0xf bank_mask:0xf\n\t" "v_fmac_f32_dpp %3, %7, %11 row_newbcast:3 row_mask:0xf bank_mask:0xf\n\t" "v_fmac_f32_dpp %0, %4, %12 row_newbcast:4 row_mask:0xf bank_mask:0xf\n\t" "v_fmac_f32_dpp %1, %5, %12 row_newbcast:4 row_mask:0xf bank_mask:0xf\n\t" "v_fmac_f32_dpp %2, %6, %12 row_newbcast:4 row_mask:0xf bank_mask:0xf\n\t" "v_fmac_f32_dpp %3, %7, %12 row_newbcast:4 row_mask:0xf bank_mask:0xf\n\t" : "+v"(a0), "+v"(a1), "+v"(a2), "+v"(a3) : "v"(l0), "v"(l1), "v"(l2), "v"(l3), "v"(x0), "v"(x1), "v"(x2), "v"(x3), "v"(x4));
    }
};
template <> struct QuadChunk<6> {
    static __device__ __forceinline__ void run(float& a0, float& a1, float& a2, float& a3, float l0, float l1, float l2, float l3, float x0, float x1, float x2, float x3, float x4, float x5) {
        asm volatile("v_fmac_f32_dpp %0, %4, %8 row_newbcast:0 row_mask:0xf bank_mask:0xf\n\t" "v_fmac_f32_dpp %1, %5, %8 row_newbcast:0 row_mask:0xf bank_mask:0xf\n\t" "v_fmac_f32_dpp %2, %6, %8 row_newbcast:0 row_mask:0xf bank_mask:0xf\n\t" "v_fmac_f32_dpp %3, %7, %8 row_newbcast:0 row_mask:0xf bank_mask:0xf\n\t" "v_fmac_f32_dpp %0, %4, %9 row_newbcast:1 row_mask:0xf bank_mask:0xf\n\t" "v_fmac_f32_dpp %1, %5, %9 row_newbcast:1 row_mask:0xf bank_mask:0xf\n\t" "v_fmac_f32_dpp %2, %6, %9 row_newbcast:1 row_mask:0xf bank_mask:0xf\n\t" "v_fmac_f32_dpp %3, %7, %9 row_newbcast:1 row_mask:0xf bank_mask:0xf\n\t" "v_fmac_f32_dpp %0, %4, %10 row_newbcast:2 row_mask:0xf bank_mask:0xf\n\t" "v_fmac_f32_dpp %1, %5, %10 row_newbcast:2 row_mask:0xf bank_mask:0xf\n\t" "v_fmac_f32_dpp %2, %6, %10 row_newbcast:2 row_mask:0xf bank_mask:0xf\n\t" "v_fmac_f32_dpp %3, %7, %10 row_newbcast:2 row_mask:0xf bank_mask:0xf\n\t" "v_fmac_f32_dpp %0, %4, %11 row_newbcast:3 row_mask:0xf bank_mask:0xf\n\t" "v_fmac_f32_dpp %1, %5, %11 row_newbcast:3 row_mask:0xf bank_mask:0xf\n\t" "v_fmac_f32_dpp %2, %6, %11 row_newbcast:3 row_mask:0xf bank_mask:0xf\n\t" "v_fmac_f32_dpp %3, %7, %11 row_newbcast:3 row_mask:0xf bank_mask:0xf\n\t" "v_fmac_f32_dpp %0, %4, %12 row_newbcast:4 row_mask:0xf bank_mask:0xf\n\t" "v_fmac_f32_dpp %1, %5, %12 row_newbcast:4 row_mask:0xf bank_mask:0xf\n\t" "v_fmac_f32_dpp %2, %6, %12 row_newbcast:4 row_mask:0xf bank_mask:0xf\n\t" "v_fmac_f32_dpp %3, %7, %12 row_newbcast:4 row_mask:0xf bank_mask:0xf\n\t" "v_fmac_f32_dpp %0, %4, %13 row_newbcast:5 row_mask:0xf bank_mask:0xf\n\t" "v_fmac_f32_dpp %1, %5, %13 row_newbcast:5 row_mask:0xf bank_mask:0xf\n\t" "v_fmac_f32_dpp %2, %6, %13 row_newbcast:5 row_mask:0xf bank_mask:0xf\n\t" "v_fmac_f32_dpp %3, %7, %13 row_newbcast:5 row_mask:0xf bank_mask:0xf\n\t" : "+v"(a0), "+v"(a1), "+v"(a2), "+v"(a3) : "v"(l0), "v"(l1), "v"(l2), "v"(l3), "v"(x0), "v"(x1), "v"(x2), "v"(x3), "v"(x4), "v"(x5));
    }
};
template <> struct QuadChunk<7> {
    static __device__ __forceinline__ void run(float& a0, float& a1, float& a2, float& a3, float l0, float l1, float l2, float l3, float x0, float x1, float x2, float x3, float x4, float x5, float x6) {
        asm volatile("v_fmac_f32_dpp %0, %4, %8 row_newbcast:0 row_mask:0xf bank_mask:0xf\n\t" "v_fmac_f32_dpp %1, %5, %8 row_newbcast:0 row_mask:0xf bank_mask:0xf\n\t" "v_fmac_f32_dpp %2, %6, %8 row_newbcast:0 row_mask:0xf bank_mask:0xf\n\t" "v_fmac_f32_dpp %3, %7, %8 row_newbcast:0 row_mask:0xf bank_mask:0xf\n\t" "v_fmac_f32_dpp %0, %4, %9 row_newbcast:1 row_mask:0xf bank_mask:0xf\n\t" "v_fmac_f32_dpp %1, %5, %9 row_newbcast:1 row_mask:0xf bank_mask:0xf\n\t" "v_fmac_f32_dpp %2, %6, %9 row_newbcast:1 row_mask:0xf bank_mask:0xf\n\t" "v_fmac_f32_dpp %3, %7, %9 row_newbcast:1 row_mask:0xf bank_mask:0xf\n\t" "v_fmac_f32_dpp %0, %4, %10 row_newbcast:2 row_mask:0xf bank_mask:0xf\n\t" "v_fmac_f32_dpp %1, %5, %10 row_newbcast:2 row_mask:0xf bank_mask:0xf\n\t" "v_fmac_f32_dpp %2, %6, %10 row_newbcast:2 row_mask:0xf bank_mask:0xf\n\t" "v_fmac_f32_dpp %3, %7, %10 row_newbcast:2 row_mask:0xf bank_mask:0xf\n\t" "v_fmac_f32_dpp %0, %4, %11 row_newbcast:3 row_mask:0xf bank_mask:0xf\n\t" "v_fmac_f32_dpp %1, %5, %11 row_newbcast:3 row_mask:0xf bank_mask:0xf\n\t" "v_fmac_f32_dpp %2, %6, %11 row_newbcast:3 row_mask:0xf bank_mask:0xf\n\t" "v_fmac_f32_dpp %3, %7, %11 row_newbcast:3 row_mask:0xf bank_mask:0xf\n\t" "v_fmac_f32_dpp %0, %4, %12 row_newbcast:4 row_mask:0xf bank_mask:0xf\n\t" "v_fmac_f32_dpp %1, %5, %12 row_newbcast:4 row_mask:0xf bank_mask:0xf\n\t" "v_fmac_f32_dpp %2, %6, %12 row_newbcast:4 row_mask:0xf bank_mask:0xf\n\t" "v_fmac_f32_dpp %3, %7, %12 row_newbcast:4 row_mask:0xf bank_mask:0xf\n\t" "v_fmac_f32_dpp %0, %4, %13 row_newbcast:5 row_mask:0xf bank_mask:0xf\n\t" "v_fmac_f32_dpp %1, %5, %13 row_newbcast:5 row_mask:0xf bank_mask:0xf\n\t" "v_fmac_f32_dpp %2, %6, %13 row_newbcast:5 row_mask:0xf bank_mask:0xf\n\t" "v_fmac_f32_dpp %3, %7, %13 row_newbcast:5 row_mask:0xf bank_mask:0xf\n\t" "v_fmac_f32_dpp %0, %4, %14 row_newbcast:6 row_mask:0xf bank_mask:0xf\n\t" "v_fmac_f32_dpp %1, %5, %14 row_newbcast:6 row_mask:0xf bank_mask:0xf\n\t" "v_fmac_f32_dpp %2, %6, %14 row_newbcast:6 row_mask:0xf bank_mask:0xf\n\t" "v_fmac_f32_dpp %3, %7, %14 row_newbcast:6 row_mask:0xf bank_mask:0xf\n\t" : "+v"(a0), "+v"(a1), "+v"(a2), "+v"(a3) : "v"(l0), "v"(l1), "v"(l2), "v"(l3), "v"(x0), "v"(x1), "v"(x2), "v"(x3), "v"(x4), "v"(x5), "v"(x6));
    }
};
template <> struct QuadChunk<8> {
    static __device__ __forceinline__ void run(float& a0, float& a1, float& a2, float& a3, float l0, float l1, float l2, float l3, float x0, float x1, float x2, float x3, float x4, float x5, float x6, float x7) {
        asm volatile("v_fmac_f32_dpp %0, %4, %8 row_newbcast:0 row_mask:0xf bank_mask:0xf\n\t" "v_fmac_f32_dpp %1, %5, %8 row_newbcast:0 row_mask:0xf bank_mask:0xf\n\t" "v_fmac_f32_dpp %2, %6, %8 row_newbcast:0 row_mask:0xf bank_mask:0xf\n\t" "v_fmac_f32_dpp %3, %7, %8 row_newbcast:0 row_mask:0xf bank_mask:0xf\n\t" "v_fmac_f32_dpp %0, %4, %9 row_newbcast:1 row_mask:0xf bank_mask:0xf\n\t" "v_fmac_f32_dpp %1, %5, %9 row_newbcast:1 row_mask:0xf bank_mask:0xf\n\t" "v_fmac_f32_dpp %2, %6, %9 row_newbcast:1 row_mask:0xf bank_mask:0xf\n\t" "v_fmac_f32_dpp %3, %7, %9 row_newbcast:1 row_mask:0xf bank_mask:0xf\n\t" "v_fmac_f32_dpp %0, %4, %10 row_newbcast:2 row_mask:0xf bank_mask:0xf\n\t" "v_fmac_f32_dpp %1, %5, %10 row_newbcast:2 row_mask:0xf bank_mask:0xf\n\t" "v_fmac_f32_dpp %2, %6, %10 row_newbcast:2 row_mask:0xf bank_mask:0xf\n\t" "v_fmac_f32_dpp %3, %7, %10 row_newbcast:2 row_mask:0xf bank_mask:0xf\n\t" "v_fmac_f32_dpp %0, %4, %11 row_newbcast:3 row_mask:0xf bank_mask:0xf\n\t" "v_fmac_f32_dpp %1, %5, %11 row_newbcast:3 row_mask:0xf bank_mask:0xf\n\t" "v_fmac_f32_dpp %2, %6, %11 row_newbcast:3 row_mask:0xf bank_mask:0xf\n\t" "v_fmac_f32_dpp %3, %7, %11 row_newbcast:3 row_mask:0xf bank_mask:0xf\n\t" "v_fmac_f32_dpp %0, %4, %12 row_newbcast:4 row_mask:0xf bank_mask:0xf\n\t" "v_fmac_f32_dpp %1, %5, %12 row_newbcast:4 row_mask:0xf bank_mask:0xf\n\t" "v_fmac_f32_dpp %2, %6, %12 row_newbcast:4 row_mask:0xf bank_mask:0xf\n\t" "v_fmac_f32_dpp %3, %7, %12 row_newbcast:4 row_mask:0xf bank_mask:0xf\n\t" "v_fmac_f32_dpp %0, %4, %13 row_newbcast:5 row_mask:0xf bank_mask:0xf\n\t" "v_fmac_f32_dpp %1, %5, %13 row_newbcast:5 row_mask:0xf bank_mask:0xf\n\t" "v_fmac_f32_dpp %2, %6, %13 row_newbcast:5 row_mask:0xf bank_mask:0xf\n\t" "v_fmac_f32_dpp %3, %7, %13 row_newbcast:5 row_mask:0xf bank_mask:0xf\n\t" "v_fmac_f32_dpp %0, %4, %14 row_newbcast:6 row_mask:0xf bank_mask:0xf\n\t" "v_fmac_f32_dpp %1, %5, %14 row_newbcast:6 row_mask:0xf bank_mask:0xf\n\t" "v_fmac_f32_dpp %2, %6, %14 row_newbcast:6 row_mask:0xf bank_mask:0xf\n\t" "v_fmac_f32_dpp %3, %7, %14 row_newbcast:6 row_mask:0xf bank_mask:0xf\n\t" "v_fmac_f32_dpp %0, %4, %15 row_newbcast:7 row_mask:0xf bank_mask:0xf\n\t" "v_fmac_f32_dpp %1, %5, %15 row_newbcast:7 row_mask:0xf bank_mask:0xf\n\t" "v_fmac_f32_dpp %2, %6, %15 row_newbcast:7 row_mask:0xf bank_mask:0xf\n\t" "v_fmac_f32_dpp %3, %7, %15 row_newbcast:7 row_mask:0xf bank_mask:0xf\n\t" : "+v"(a0), "+v"(a1), "+v"(a2), "+v"(a3) : "v"(l0), "v"(l1), "v"(l2), "v"(l3), "v"(x0), "v"(x1), "v"(x2), "v"(x3), "v"(x4), "v"(x5), "v"(x6), "v"(x7));
    }
};
template <> struct QuadChunk<9> {
    static __device__ __forceinline__ void run(float& a0, float& a1, float& a2, float& a3, float l0, float l1, float l2, float l3, float x0, float x1, float x2, float x3, float x4, float x5, float x6, float x7, float x8) {
        asm volatile("v_fmac_f32_dpp %0, %4, %8 row_newbcast:0 row_mask:0xf bank_mask:0xf\n\t" "v_fmac_f32_dpp %1, %5, %8 row_newbcast:0 row_mask:0xf bank_mask:0xf\n\t" "v_fmac_f32_dpp %2, %6, %8 row_newbcast:0 row_mask:0xf bank_mask:0xf\n\t" "v_fmac_f32_dpp %3, %7, %8 row_newbcast:0 row_mask:0xf bank_mask:0xf\n\t" "v_fmac_f32_dpp %0, %4, %9 row_newbcast:1 row_mask:0xf bank_mask:0xf\n\t" "v_fmac_f32_dpp %1, %5, %9 row_newbcast:1 row_mask:0xf bank_mask:0xf\n\t" "v_fmac_f32_dpp %2, %6, %9 row_newbcast:1 row_mask:0xf bank_mask:0xf\n\t" "v_fmac_f32_dpp %3, %7, %9 row_newbcast:1 row_mask:0xf bank_mask:0xf\n\t" "v_fmac_f32_dpp %0, %4, %10 row_newbcast:2 row_mask:0xf bank_mask:0xf\n\t" "v_fmac_f32_dpp %1, %5, %10 row_newbcast:2 row_mask:0xf bank_mask:0xf\n\t" "v_fmac_f32_dpp %2, %6, %10 row_newbcast:2 row_mask:0xf bank_mask:0xf\n\t" "v_fmac_f32_dpp %3, %7, %10 row_newbcast:2 row_mask:0xf bank_mask:0xf\n\t" "v_fmac_f32_dpp %0, %4, %11 row_newbcast:3 row_mask:0xf bank_mask:0xf\n\t" "v_fmac_f32_dpp %1, %5, %11 row_newbcast:3 row_mask:0xf bank_mask:0xf\n\t" "v_fmac_f32_dpp %2, %6, %11 row_newbcast:3 row_mask:0xf bank_mask:0xf\n\t" "v_fmac_f32_dpp %3, %7, %11 row_newbcast:3 row_mask:0xf bank_mask:0xf\n\t" "v_fmac_f32_dpp %0, %4, %12 row_newbcast:4 row_mask:0xf bank_mask:0xf\n\t" "v_fmac_f32_dpp %1, %5, %12 row_newbcast:4 row_mask:0xf bank_mask:0xf\n\t" "v_fmac_f32_dpp %2, %6, %12 row_newbcast:4 row_mask:0xf bank_mask:0xf\n\t" "v_fmac_f32_dpp %3, %7, %12 row_newbcast:4 row_mask:0xf bank_mask:0xf\n\t" "v_fmac_f32_dpp %0, %4, %13 row_newbcast:5 row_mask:0xf bank_mask:0xf\n\t" "v_fmac_f32_dpp %1, %5, %13 row_newbcast:5 row_mask:0xf bank_mask:0xf\n\t" "v_fmac_f32_dpp %2, %6, %13 row_newbcast:5 row_mask:0xf bank_mask:0xf\n\t" "v_fmac_f32_dpp %3, %7, %13 row_newbcast:5 row_mask:0xf bank_mask:0xf\n\t" "v_fmac_f32_dpp %0, %4, %14 row_newbcast:6 row_mask:0xf bank_mask:0xf\n\t" "v_fmac_f32_dpp %1, %5, %14 row_newbcast:6 row_mask:0xf bank_mask:0xf\n\t" "v_fmac_f32_dpp %2, %6, %14 row_newbcast:6 row_mask:0xf bank_mask:0xf\n\t" "v_fmac_f32_dpp %3, %7, %14 row_newbcast:6 row_mask:0xf bank_mask:0xf\n\t" "v_fmac_f32_dpp %0, %4, %15 row_newbcast:7 row_mask:0xf bank_mask:0xf\n\t" "v_fmac_f32_dpp %1, %5, %15 row_newbcast:7 row_mask:0xf bank_mask:0xf\n\t" "v_fmac_f32_dpp %2, %6, %15 row_newbcast:7 row_mask:0xf bank_mask:0xf\n\t" "v_fmac_f32_dpp %3, %7, %15 row_newbcast:7 row_mask:0xf bank_mask:0xf\n\t" "v_fmac_f32_dpp %0, %4, %16 row_newbcast:8 row_mask:0xf bank_mask:0xf\n\t" "v_fmac_f32_dpp %1, %5, %16 row_newbcast:8 row_mask:0xf bank_mask:0xf\n\t" "v_fmac_f32_dpp %2, %6, %16 row_newbcast:8 row_mask:0xf bank_mask:0xf\n\t" "v_fmac_f32_dpp %3, %7, %16 row_newbcast:8 row_mask:0xf bank_mask:0xf\n\t" : "+v"(a0), "+v"(a1), "+v"(a2), "+v"(a3) : "v"(l0), "v"(l1), "v"(l2), "v"(l3), "v"(x0), "v"(x1), "v"(x2), "v"(x3), "v"(x4), "v"(x5), "v"(x6), "v"(x7), "v"(x8));
    }
};
template <> struct QuadChunk<10> {
    static __device__ __forceinline__ void run(float& a0, float& a1, float& a2, float& a3, float l0, float l1, float l2, float l3, float x0, float x1, float x2, float x3, float x4, float x5, float x6, float x7, float x8, float x9) {
        asm volatile("v_fmac_f32_dpp %0, %4, %8 row_newbcast:0 row_mask:0xf bank_mask:0xf\n\t" "v_fmac_f32_dpp %1, %5, %8 row_newbcast:0 row_mask:0xf bank_mask:0xf\n\t" "v_fmac_f32_dpp %2, %6, %8 row_newbcast:0 row_mask:0xf bank_mask:0xf\n\t" "v_fmac_f32_dpp %3, %7, %8 row_newbcast:0 row_mask:0xf bank_mask:0xf\n\t" "v_fmac_f32_dpp %0, %4, %9 row_newbcast:1 row_mask:0xf bank_mask:0xf\n\t" "v_fmac_f32_dpp %1, %5, %9 row_newbcast:1 row_mask:0xf bank_mask:0xf\n\t" "v_fmac_f32_dpp %2, %6, %9 row_newbcast:1 row_mask:0xf bank_mask:0xf\n\t" "v_fmac_f32_dpp %3, %7, %9 row_newbcast:1 row_mask:0xf bank_mask:0xf\n\t" "v_fmac_f32_dpp %0, %4, %10 row_newbcast:2 row_mask:0xf bank_mask:0xf\n\t" "v_fmac_f32_dpp %1, %5, %10 row_newbcast:2 row_mask:0xf bank_mask:0xf\n\t" "v_fmac_f32_dpp %2, %6, %10 row_newbcast:2 row_mask:0xf bank_mask:0xf\n\t" "v_fmac_f32_dpp %3, %7, %10 row_newbcast:2 row_mask:0xf bank_mask:0xf\n\t" "v_fmac_f32_dpp %0, %4, %11 row_newbcast:3 row_mask:0xf bank_mask:0xf\n\t" "v_fmac_f32_dpp %1, %5, %11 row_newbcast:3 row_mask:0xf bank_mask:0xf\n\t" "v_fmac_f32_dpp %2, %6, %11 row_newbcast:3 row_mask:0xf bank_mask:0xf\n\t" "v_fmac_f32_dpp %3, %7, %11 row_newbcast:3 row_mask:0xf bank_mask:0xf\n\t" "v_fmac_f32_dpp %0, %4, %12 row_newbcast:4 row_mask:0xf bank_mask:0xf\n\t" "v_fmac_f32_dpp %1, %5, %12 row_newbcast:4 row_mask:0xf bank_mask:0xf\n\t" "v_fmac_f32_dpp %2, %6, %12 row_newbcast:4 row_mask:0xf bank_mask:0xf\n\t" "v_fmac_f32_dpp %3, %7, %12 row_newbcast:4 row_mask:0xf bank_mask:0xf\n\t" "v_fmac_f32_dpp %0, %4, %13 row_newbcast:5 row_mask:0xf bank_mask:0xf\n\t" "v_fmac_f32_dpp %1, %5, %13 row_newbcast:5 row_mask:0xf bank_mask:0xf\n\t" "v_fmac_f32_dpp %2, %6, %13 row_newbcast:5 row_mask:0xf bank_mask:0xf\n\t" "v_fmac_f32_dpp %3, %7, %13 row_newbcast:5 row_mask:0xf bank_mask:0xf\n\t" "v_fmac_f32_dpp %0, %4, %14 row_newbcast:6 row_mask:0xf bank_mask:0xf\n\t" "v_fmac_f32_dpp %1, %5, %14 row_newbcast:6 row_mask:0xf bank_mask:0xf\n\t" "v_fmac_f32_dpp %2, %6, %14 row_newbcast:6 row_mask:0xf bank_mask:0xf\n\t" "v_fmac_f32_dpp %3, %7, %14 row_newbcast:6 row_mask:0xf bank_mask:0xf\n\t" "v_fmac_f32_dpp %0, %4, %15 row_newbcast:7 row_mask:0xf bank_mask:0xf\n\t" "v_fmac_f32_dpp %1, %5, %15 row_newbcast:7 row_mask:0xf bank_mask:0xf\n\t" "v_fmac_f32_dpp %2, %6, %15 row_newbcast:7 row_mask:0xf bank_mask:0xf\n\t" "v_fmac_f32_dpp %3, %7, %15 row_newbcast:7 row_mask:0xf bank_mask:0xf\n\t" "v_fmac_f32_dpp %0, %4, %16 row_newbcast:8 row_mask:0xf bank_mask:0xf\n\t" "v_fmac_f32_dpp %1, %5, %16 row_newbcast:8 row_mask:0xf bank_mask:0xf\n\t" "v_fmac_f32_dpp %2, %6, %16 row_newbcast:8 row_mask:0xf bank_mask:0xf\n\t" "v_fmac_f32_dpp %3, %7, %16 row_newbcast:8 row_mask:0xf bank_mask:0xf\n\t" "v_fmac_f32_dpp %0, %4, %17 row_newbcast:9 row_mask:0xf bank_mask:0xf\n\t" "v_fmac_f32_dpp %1, %5, %17 row_newbcast:9 row_mask:0xf bank_mask:0xf\n\t" "v_fmac_f32_dpp %2, %6, %17 row_newbcast:9 row_mask:0xf bank_mask:0xf\n\t" "v_fmac_f32_dpp %3, %7, %17 row_newbcast:9 row_mask:0xf bank_mask:0xf\n\t" : "+v"(a0), "+v"(a1), "+v"(a2), "+v"(a3) : "v"(l0), "v"(l1), "v"(l2), "v"(l3), "v"(x0), "v"(x1), "v"(x2), "v"(x3), "v"(x4), "v"(x5), "v"(x6), "v"(x7), "v"(x8), "v"(x9));
    }
};
template <> struct QuadChunk<11> {
    static __device__ __forceinline__ void run(float& a0, float& a1, float& a2, float& a3, float l0, float l1, float l2, float l3, float x0, float x1, float x2, float x3, float x4, float x5, float x6, float x7, float x8, float x9, float x10) {
        asm volatile("v_fmac_f32_dpp %0, %4, %8 row_newbcast:0 row_mask:0xf bank_mask:0xf\n\t" "v_fmac_f32_dpp %1, %5, %8 row_newbcast:0 row_mask:0xf bank_mask:0xf\n\t" "v_fmac_f32_dpp %2, %6, %8 row_newbcast:0 row_mask:0xf bank_mask:0xf\n\t" "v_fmac_f32_dpp %3, %7, %8 row_newbcast:0 row_mask:0xf bank_mask:0xf\n\t" "v_fmac_f32_dpp %0, %4, %9 row_newbcast:1 row_mask:0xf bank_mask:0xf\n\t" "v_fmac_f32_dpp %1, %5, %9 row_newbcast:1 row_mask:0xf bank_mask:0xf\n\t" "v_fmac_f32_dpp %2, %6, %9 row_newbcast:1 row_mask:0xf bank_mask:0xf\n\t" "v_fmac_f32_dpp %3, %7, %9 row_newbcast:1 row_mask:0xf bank_mask:0xf\n\t" "v_fmac_f32_dpp %0, %4, %10 row_newbcast:2 row_mask:0xf bank_mask:0xf\n\t" "v_fmac_f32_dpp %1, %5, %10 row_newbcast:2 row_mask:0xf bank_mask:0xf\n\t" "v_fmac_f32_dpp %2, %6, %10 row_newbcast:2 row_mask:0xf bank_mask:0xf\n\t" "v_fmac_f32_dpp %3, %7, %10 row_newbcast:2 row_mask:0xf bank_mask:0xf\n\t" "v_fmac_f32_dpp %0, %4, %11 row_newbcast:3 row_mask:0xf bank_mask:0xf\n\t" "v_fmac_f32_dpp %1, %5, %11 row_newbcast:3 row_mask:0xf bank_mask:0xf\n\t" "v_fmac_f32_dpp %2, %6, %11 row_newbcast:3 row_mask:0xf bank_mask:0xf\n\t" "v_fmac_f32_dpp %3, %7, %11 row_newbcast:3 row_mask:0xf bank_mask:0xf\n\t" "v_fmac_f32_dpp %0, %4, %12 row_newbcast:4 row_mask:0xf bank_mask:0xf\n\t" "v_fmac_f32_dpp %1, %5, %12 row_newbcast:4 row_mask:0xf bank_mask:0xf\n\t" "v_fmac_f32_dpp %2, %6, %12 row_newbcast:4 row_mask:0xf bank_mask:0xf\n\t" "v_fmac_f32_dpp %3, %7, %12 row_newbcast:4 row_mask:0xf bank_mask:0xf\n\t" "v_fmac_f32_dpp %0, %4, %13 row_newbcast:5 row_mask:0xf bank_mask:0xf\n\t" "v_fmac_f32_dpp %1, %5, %13 row_newbcast:5 row_mask:0xf bank_mask:0xf\n\t" "v_fmac_f32_dpp %2, %6, %13 row_newbcast:5 row_mask:0xf bank_mask:0xf\n\t" "v_fmac_f32_dpp %3, %7, %13 row_newbcast:5 row_mask:0xf bank_mask:0xf\n\t" "v_fmac_f32_dpp %0, %4, %14 row_newbcast:6 row_mask:0xf bank_mask:0xf\n\t" "v_fmac_f32_dpp %1, %5, %14 row_newbcast:6 row_mask:0xf bank_mask:0xf\n\t" "v_fmac_f32_dpp %2, %6, %14 row_newbcast:6 row_mask:0xf bank_mask:0xf\n\t" "v_fmac_f32_dpp %3, %7, %14 row_newbcast:6 row_mask:0xf bank_mask:0xf\n\t" "v_fmac_f32_dpp %0, %4, %15 row_newbcast:7 row_mask:0xf bank_mask:0xf\n\t" "v_fmac_f32_dpp %1, %5, %15 row_newbcast:7 row_mask:0xf bank_mask:0xf\n\t" "v_fmac_f32_dpp %2, %6, %15 row_newbcast:7 row_mask:0xf bank_mask:0xf\n\t" "v_fmac_f32_dpp %3, %7, %15 row_newbcast:7 row_mask:0xf bank_mask:0xf\n\t" "v_fmac_f32_dpp %0, %4, %16 row_newbcast:8 row_mask:0xf bank_mask:0xf\n\t" "v_fmac_f32_dpp %1, %5, %16 row_newbcast:8 row_mask:0xf bank_mask:0xf\n\t" "v_fmac_f32_dpp %2, %6, %16 row_newbcast:8 row_mask:0xf bank_mask:0xf\n\t" "v_fmac_f32_dpp %3, %7, %16 row_newbcast:8 row_mask:0xf bank_mask:0xf\n\t" "v_fmac_f32_dpp %0, %4, %17 row_newbcast:9 row_mask:0xf bank_mask:0xf\n\t" "v_fmac_f32_dpp %1, %5, %17 row_newbcast:9 row_mask:0xf bank_mask:0xf\n\t" "v_fmac_f32_dpp %2, %6, %17 row_newbcast:9 row_mask:0xf bank_mask:0xf\n\t" "v_fmac_f32_dpp %3, %7, %17 row_newbcast:9 row_mask:0xf bank_mask:0xf\n\t" "v_fmac_f32_dpp %0, %4, %18 row_newbcast:10 row_mask:0xf bank_mask:0xf\n\t" "v_fmac_f32_dpp %1, %5, %18 row_newbcast:10 row_mask:0xf bank_mask:0xf\n\t" "v_fmac_f32_dpp %2, %6, %18 row_newbcast:10 row_mask:0xf bank_mask:0xf\n\t" "v_fmac_f32_dpp %3, %7, %18 row_newbcast:10 row_mask:0xf bank_mask:0xf\n\t" : "+v"(a0), "+v"(a1), "+v"(a2), "+v"(a3) : "v"(l0), "v"(l1), "v"(l2), "v"(l3), "v"(x0), "v"(x1), "v"(x2), "v"(x3), "v"(x4), "v"(x5), "v"(x6), "v"(x7), "v"(x8), "v"(x9), "v"(x10));
    }
};
template <> struct QuadChunk<12> {
    static __device__ __forceinline__ void run(float& a0, float& a1, float& a2, float& a3, float l0, float l1, float l2, float l3, float x0, float x1, float x2, float x3, float x4, float x5, float x6, float x7, float x8, float x9, float x10, float x11) {
        asm volatile("v_fmac_f32_dpp %0, %4, %8 row_newbcast:0 row_mask:0xf bank_mask:0xf\n\t" "v_fmac_f32_dpp %1, %5, %8 row_newbcast:0 row_mask:0xf bank_mask:0xf\n\t" "v_fmac_f32_dpp %2, %6, %8 row_newbcast:0 row_mask:0xf bank_mask:0xf\n\t" "v_fmac_f32_dpp %3, %7, %8 row_newbcast:0 row_mask:0xf bank_mask:0xf\n\t" "v_fmac_f32_dpp %0, %4, %9 row_newbcast:1 row_mask:0xf bank_mask:0xf\n\t" "v_fmac_f32_dpp %1, %5, %9 row_newbcast:1 row_mask:0xf bank_mask:0xf\n\t" "v_fmac_f32_dpp %2, %6, %9 row_newbcast:1 row_mask:0xf bank_mask:0xf\n\t" "v_fmac_f32_dpp %3, %7, %9 row_newbcast:1 row_mask:0xf bank_mask:0xf\n\t" "v_fmac_f32_dpp %0, %4, %10 row_newbcast:2 row_mask:0xf bank_mask:0xf\n\t" "v_fmac_f32_dpp %1, %5, %10 row_newbcast:2 row_mask:0xf bank_mask:0xf\n\t" "v_fmac_f32_dpp %2, %6, %10 row_newbcast:2 row_mask:0xf bank_mask:0xf\n\t" "v_fmac_f32_dpp %3, %7, %10 row_newbcast:2 row_mask:0xf bank_mask:0xf\n\t" "v_fmac_f32_dpp %0, %4, %11 row_newbcast:3 row_mask:0xf bank_mask:0xf\n\t" "v_fmac_f32_dpp %1, %5, %11 row_newbcast:3 row_mask:0xf bank_mask:0xf\n\t" "v_fmac_f32_dpp %2, %6, %11 row_newbcast:3 row_mask:0xf bank_mask:0xf\n\t" "v_fmac_f32_dpp %3, %7, %11 row_newbcast:3 row_mask:0xf bank_mask:0xf\n\t" "v_fmac_f32_dpp %0, %4, %12 row_newbcast:4 row_mask:0xf bank_mask:0xf\n\t" "v_fmac_f32_dpp %1, %5, %12 row_newbcast:4 row_mask:0xf bank_mask:0xf\n\t" "v_fmac_f32_dpp %2, %6, %12 row_newbcast:4 row_mask:0xf bank_mask:0xf\n\t" "v_fmac_f32_dpp %3, %7, %12 row_newbcast:4 row_mask:0xf bank_mask:0xf\n\t" "v_fmac_f32_dpp %0, %4, %13 row_newbcast:5 row_mask:0xf bank_mask:0xf\n\t" "v_fmac_f32_dpp %1, %5, %13 row_newbcast:5 row_mask:0xf bank_mask:0xf\n\t" "v_fmac_f32_dpp %2, %6, %13 row_newbcast:5 row_mask:0xf bank_mask:0xf\n\t" "v_fmac_f32_dpp %3, %7, %13 row_newbcast:5 row_mask:0xf bank_mask:0xf\n\t" "v_fmac_f32_dpp %0, %4, %14 row_newbcast:6 row_mask:0xf bank_mask:0xf\n\t" "v_fmac_f32_dpp %1, %5, %14 row_newbcast:6 row_mask:0xf bank_mask:0xf\n\t" "v_fmac_f32_dpp %2, %6, %14 row_newbcast:6 row_mask:0xf bank_mask:0xf\n\t" "v_fmac_f32_dpp %3, %7, %14 row_newbcast:6 row_mask:0xf bank_mask:0xf\n\t" "v_fmac_f32_dpp %0, %4, %15 row_newbcast:7 row_mask:0xf bank_mask:0xf\n\t" "v_fmac_f32_dpp %1, %5, %15 row_newbcast:7 row_mask:0xf bank_mask:0xf\n\t" "v_fmac_f32_dpp %2, %6, %15 row_newbcast:7 row_mask:0xf bank_mask:0xf\n\t" "v_fmac_f32_dpp %3, %7, %15 row_newbcast:7 row_mask:0xf bank_mask:0xf\n\t" "v_fmac_f32_dpp %0, %4, %16 row_newbcast:8 row_mask:0xf bank_mask:0xf\n\t" "v_fmac_f32_dpp %1, %5, %16 row_newbcast:8 row_mask:0xf bank_mask:0xf\n\t" "v_fmac_f32_dpp %2, %6, %16 row_newbcast:8 row_mask:0xf bank_mask:0xf\n\t" "v_fmac_f32_dpp %3, %7, %16 row_newbcast:8 row_mask:0xf bank_mask:0xf\n\t" "v_fmac_f32_dpp %0, %4, %17 row_newbcast:9 row_mask:0xf bank_mask:0xf\n\t" "v_fmac_f32_dpp %1, %5, %17 row_newbcast:9 row_mask:0xf bank_mask:0xf\n\t" "v_fmac_f32_dpp %2, %6, %17 row_newbcast:9 row_mask:0xf bank_mask:0xf\n\t" "v_fmac_f32_dpp %3, %7, %17 row_newbcast:9 row_mask:0xf bank_mask:0xf\n\t" "v_fmac_f32_dpp %0, %4, %18 row_newbcast:10 row_mask:0xf bank_mask:0xf\n\t" "v_fmac_f32_dpp %1, %5, %18 row_newbcast:10 row_mask:0xf bank_mask:0xf\n\t" "v_fmac_f32_dpp %2, %6, %18 row_newbcast:10 row_mask:0xf bank_mask:0xf\n\t" "v_fmac_f32_dpp %3, %7, %18 row_newbcast:10 row_mask:0xf bank_mask:0xf\n\t" "v_fmac_f32_dpp %0, %4, %19 row_newbcast:11 row_mask:0xf bank_mask:0xf\n\t" "v_fmac_f32_dpp %1, %5, %19 row_newbcast:11 row_mask:0xf bank_mask:0xf\n\t" "v_fmac_f32_dpp %2, %6, %19 row_newbcast:11 row_mask:0xf bank_mask:0xf\n\t" "v_fmac_f32_dpp %3, %7, %19 row_newbcast:11 row_mask:0xf bank_mask:0xf\n\t" : "+v"(a0), "+v"(a1), "+v"(a2), "+v"(a3) : "v"(l0), "v"(l1), "v"(l2), "v"(l3), "v"(x0), "v"(x1), "v"(x2), "v"(x3), "v"(x4), "v"(x5), "v"(x6), "v"(x7), "v"(x8), "v"(x9), "v"(x10), "v"(x11));
    }
};
template <> struct QuadChunk<13> {
    static __device__ __forceinline__ void run(float& a0, float& a1, float& a2, float& a3, float l0, float l1, float l2, float l3, float x0, float x1, float x2, float x3, float x4, float x5, float x6, float x7, float x8, float x9, float x10, float x11, float x12) {
        asm volatile("v_fmac_f32_dpp %0, %4, %8 row_newbcast:0 row_mask:0xf bank_mask:0xf\n\t" "v_fmac_f32_dpp %1, %5, %8 row_newbcast:0 row_mask:0xf bank_mask:0xf\n\t" "v_fmac_f32_dpp %2, %6, %8 row_newbcast:0 row_mask:0xf bank_mask:0xf\n\t" "v_fmac_f32_dpp %3, %7, %8 row_newbcast:0 row_mask:0xf bank_mask:0xf\n\t" "v_fmac_f32_dpp %0, %4, %9 row_newbcast:1 row_mask:0xf bank_mask:0xf\n\t" "v_fmac_f32_dpp %1, %5, %9 row_newbcast:1 row_mask:0xf bank_mask:0xf\n\t" "v_fmac_f32_dpp %2, %6, %9 row_newbcast:1 row_mask:0xf bank_mask:0xf\n\t" "v_fmac_f32_dpp %3, %7, %9 row_newbcast:1 row_mask:0xf bank_mask:0xf\n\t" "v_fmac_f32_dpp %0, %4, %10 row_newbcast:2 row_mask:0xf bank_mask:0xf\n\t" "v_fmac_f32_dpp %1, %5, %10 row_newbcast:2 row_mask:0xf bank_mask:0xf\n\t" "v_fmac_f32_dpp %2, %6, %10 row_newbcast:2 row_mask:0xf bank_mask:0xf\n\t" "v_fmac_f32_dpp %3, %7, %10 row_newbcast:2 row_mask:0xf bank_mask:0xf\n\t" "v_fmac_f32_dpp %0, %4, %11 row_newbcast:3 row_mask:0xf bank_mask:0xf\n\t" "v_fmac_f32_dpp %1, %5, %11 row_newbcast:3 row_mask:0xf bank_mask:0xf\n\t" "v_fmac_f32_dpp %2, %6, %11 row_newbcast:3 row_mask:0xf bank_mask:0xf\n\t" "v_fmac_f32_dpp %3, %7, %11 row_newbcast:3 row_mask:0xf bank_mask:0xf\n\t" "v_fmac_f32_dpp %0, %4, %12 row_newbcast:4 row_mask:0xf bank_mask:0xf\n\t" "v_fmac_f32_dpp %1, %5, %12 row_newbcast:4 row_mask:0xf bank_mask:0xf\n\t" "v_fmac_f32_dpp %2, %6, %12 row_newbcast:4 row_mask:0xf bank_mask:0xf\n\t" "v_fmac_f32_dpp %3, %7, %12 row_newbcast:4 row_mask:0xf bank_mask:0xf\n\t" "v_fmac_f32_dpp %0, %4, %13 row_newbcast:5 row_mask:0xf bank_mask:0xf\n\t" "v_fmac_f32_dpp %1, %5, %13 row_newbcast:5 row_mask:0xf bank_mask:0xf\n\t" "v_fmac_f32_dpp %2, %6, %13 row_newbcast:5 row_mask:0xf bank_mask:0xf\n\t" "v_fmac_f32_dpp %3, %7, %13 row_newbcast:5 row_mask:0xf bank_mask:0xf\n\t" "v_fmac_f32_dpp %0, %4, %14 row_newbcast:6 row_mask:0xf bank_mask:0xf\n\t" "v_fmac_f32_dpp %1, %5, %14 row_newbcast:6 row_mask:0xf bank_mask:0xf\n\t" "v_fmac_f32_dpp %2, %6, %14 row_newbcast:6 row_mask:0xf bank_mask:0xf\n\t" "v_fmac_f32_dpp %3, %7, %14 row_newbcast:6 row_mask:0xf bank_mask:0xf\n\t" "v_fmac_f32_dpp %0, %4, %15 row_newbcast:7 row_mask:0xf bank_mask:0xf\n\t" "v_fmac_f32_dpp %1, %5, %15 row_newbcast:7 row_mask:0xf bank_mask:0xf\n\t" "v_fmac_f32_dpp %2, %6, %15 row_newbcast:7 row_mask:0xf bank_mask:0xf\n\t" "v_fmac_f32_dpp %3, %7, %15 row_newbcast:7 row_mask:0xf bank_mask:0xf\n\t" "v_fmac_f32_dpp %0, %4, %16 row_newbcast:8 row_mask:0xf bank_mask:0xf\n\t" "v_fmac_f32_dpp %1, %5, %16 row_newbcast:8 row_mask:0xf bank_mask:0xf\n\t" "v_fmac_f32_dpp %2, %6, %16 row_newbcast:8 row_mask:0xf bank_mask:0xf\n\t" "v_fmac_f32_dpp %3, %7, %16 row_newbcast:8 row_mask:0xf bank_mask:0xf\n\t" "v_fmac_f32_dpp %0, %4, %17 row_newbcast:9 row_mask:0xf bank_mask:0xf\n\t" "v_fmac_f32_dpp %1, %5, %17 row_newbcast:9 row_mask:0xf bank_mask:0xf\n\t" "v_fmac_f32_dpp %2, %6, %17 row_newbcast:9 row_mask:0xf bank_mask:0xf\n\t" "v_fmac_f32_dpp %3, %7, %17 row_newbcast:9 row_mask:0xf bank_mask:0xf\n\t" "v_fmac_f32_dpp %0, %4, %18 row_newbcast:10 row_mask:0xf bank_mask:0xf\n\t" "v_fmac_f32_dpp %1, %5, %18 row_newbcast:10 row_mask:0xf bank_mask:0xf\n\t" "v_fmac_f32_dpp %2, %6, %18 row_newbcast:10 row_mask:0xf bank_mask:0xf\n\t" "v_fmac_f32_dpp %3, %7, %18 row_newbcast:10 row_mask:0xf bank_mask:0xf\n\t" "v_fmac_f32_dpp %0, %4, %19 row_newbcast:11 row_mask:0xf bank_mask:0xf\n\t" "v_fmac_f32_dpp %1, %5, %19 row_newbcast:11 row_mask:0xf bank_mask:0xf\n\t" "v_fmac_f32_dpp %2, %6, %19 row_newbcast:11 row_mask:0xf bank_mask:0xf\n\t" "v_fmac_f32_dpp %3, %7, %19 row_newbcast:11 row_mask:0xf bank_mask:0xf\n\t" "v_fmac_f32_dpp %0, %4, %20 row_newbcast:12 row_mask:0xf bank_mask:0xf\n\t" "v_fmac_f32_dpp %1, %5, %20 row_newbcast:12 row_mask:0xf bank_mask:0xf\n\t" "v_fmac_f32_dpp %2, %6, %20 row_newbcast:12 row_mask:0xf bank_mask:0xf\n\t" "v_fmac_f32_dpp %3, %7, %20 row_newbcast:12 row_mask:0xf bank_mask:0xf\n\t" : "+v"(a0), "+v"(a1), "+v"(a2), "+v"(a3) : "v"(l0), "v"(l1), "v"(l2), "v"(l3), "v"(x0), "v"(x1), "v"(x2), "v"(x3), "v"(x4), "v"(x5), "v"(x6), "v"(x7), "v"(x8), "v"(x9), "v"(x10), "v"(x11), "v"(x12));
    }
};
template <> struct QuadChunk<14> {
    static __device__ __forceinline__ void run(float& a0, float& a1, float& a2, float& a3, float l0, float l1, float l2, float l3, float x0, float x1, float x2, float x3, float x4, float x5, float x6, float x7, float x8, float x9, float x10, float x11, float x12, float x13) {
        asm volatile("v_fmac_f32_dpp %0, %4, %8 row_newbcast:0 row_mask:0xf bank_mask:0xf\n\t" "v_fmac_f32_dpp %1, %5, %8 row_newbcast:0 row_mask:0xf bank_mask:0xf\n\t" "v_fmac_f32_dpp %2, %6, %8 row_newbcast:0 row_mask:0xf bank_mask:0xf\n\t" "v_fmac_f32_dpp %3, %7, %8 row_newbcast:0 row_mask:0xf bank_mask:0xf\n\t" "v_fmac_f32_dpp %0, %4, %9 row_newbcast:1 row_mask:0xf bank_mask:0xf\n\t" "v_fmac_f32_dpp %1, %5, %9 row_newbcast:1 row_mask:0xf bank_mask:0xf\n\t" "v_fmac_f32_dpp %2, %6, %9 row_newbcast:1 row_mask:0xf bank_mask:0xf\n\t" "v_fmac_f32_dpp %3, %7, %9 row_newbcast:1 row_mask:0xf bank_mask:0xf\n\t" "v_fmac_f32_dpp %0, %4, %10 row_newbcast:2 row_mask:0xf bank_mask:0xf\n\t" "v_fmac_f32_dpp %1, %5, %10 row_newbcast:2 row_mask:0xf bank_mask:0xf\n\t" "v_fmac_f32_dpp %2, %6, %10 row_newbcast:2 row_mask:0xf bank_mask:0xf\n\t" "v_fmac_f32_dpp %3, %7, %10 row_newbcast:2 row_mask:0xf bank_mask:0xf\n\t" "v_fmac_f32_dpp %0, %4, %11 row_newbcast:3 row_mask:0xf bank_mask:0xf\n\t" "v_fmac_f32_dpp %1, %5, %11 row_newbcast:3 row_mask:0xf bank_mask:0xf\n\t" "v_fmac_f32_dpp %2, %6, %11 row_newbcast:3 row_mask:0xf bank_mask:0xf\n\t" "v_fmac_f32_dpp %3, %7, %11 row_newbcast:3 row_mask:0xf bank_mask:0xf\n\t" "v_fmac_f32_dpp %0, %4, %12 row_newbcast:4 row_mask:0xf bank_mask:0xf\n\t" "v_fmac_f32_dpp %1, %5, %12 row_newbcast:4 row_mask:0xf bank_mask:0xf\n\t" "v_fmac_f32_dpp %2, %6, %12 row_newbcast:4 row_mask:0xf bank_mask:0xf\n\t" "v_fmac_f32_dpp %3, %7, %12 row_newbcast:4 row_mask:0xf bank_mask:0xf\n\t" "v_fmac_f32_dpp %0, %4, %13 row_newbcast:5 row_mask:0xf bank_mask:0xf\n\t" "v_fmac_f32_dpp %1, %5, %13 row_newbcast:5 row_mask:0xf bank_mask:0xf\n\t" "v_fmac_f32_dpp %2, %6, %13 row_newbcast:5 row_mask:0xf bank_mask:0xf\n\t" "v_fmac_f32_dpp %3, %7, %13 row_newbcast:5 row_mask:0xf bank_mask:0xf\n\t" "v_fmac_f32_dpp %0, %4, %14 row_newbcast:6 row_mask:0xf bank_mask:0xf\n\t" "v_fmac_f32_dpp %1, %5, %14 row_newbcast:6 row_mask:0xf bank_mask:0xf\n\t" "v_fmac_f32_dpp %2, %6, %14 row_newbcast:6 row_mask:0xf bank_mask:0xf\n\t" "v_fmac_f32_dpp %3, %7, %14 row_newbcast:6 row_mask:0xf bank_mask:0xf\n\t" "v_fmac_f32_dpp %0, %4, %15 row_newbcast:7 row_mask:0xf bank_mask:0xf\n\t" "v_fmac_f32_dpp %1, %5, %15 row_newbcast:7 row_mask:0xf bank_mask:0xf\n\t" "v_fmac_f32_dpp %2, %6, %15 row_newbcast:7 row_mask:0xf bank_mask:0xf\n\t" "v_fmac_f32_dpp %3, %7, %15 row_newbcast:7 row_mask:0xf bank_mask:0xf\n\t" "v_fmac_f32_dpp %0, %4, %16 row_newbcast:8 row_mask:0xf bank_mask:0xf\n\t" "v_fmac_f32_dpp %1, %5, %16 row_newbcast:8 row_mask:0xf bank_mask:0xf\n\t" "v_fmac_f32_dpp %2, %6, %16 row_newbcast:8 row_mask:0xf bank_mask:0xf\n\t" "v_fmac_f32_dpp %3, %7, %16 row_newbcast:8 row_mask:0xf bank_mask:0xf\n\t" "v_fmac_f32_dpp %0, %4, %17 row_newbcast:9 row_mask:0xf bank_mask:0xf\n\t" "v_fmac_f32_dpp %1, %5, %17 row_newbcast:9 row_mask:0xf bank_mask:0xf\n\t" "v_fmac_f32_dpp %2, %6, %17 row_newbcast:9 row_mask:0xf bank_mask:0xf\n\t" "v_fmac_f32_dpp %3, %7, %17 row_newbcast:9 row_mask:0xf bank_mask:0xf\n\t" "v_fmac_f32_dpp %0, %4, %18 row_newbcast:10 row_mask:0xf bank_mask:0xf\n\t" "v_fmac_f32_dpp %1, %5, %18 row_newbcast:10 row_mask:0xf bank_mask:0xf\n\t" "v_fmac_f32_dpp %2, %6, %18 row_newbcast:10 row_mask:0xf bank_mask:0xf\n\t" "v_fmac_f32_dpp %3, %7, %18 row_newbcast:10 row_mask:0xf bank_mask:0xf\n\t" "v_fmac_f32_dpp %0, %4, %19 row_newbcast:11 row_mask:0xf bank_mask:0xf\n\t" "v_fmac_f32_dpp %1, %5, %19 row_newbcast:11 row_mask:0xf bank_mask:0xf\n\t" "v_fmac_f32_dpp %2, %6, %19 row_newbcast:11 row_mask:0xf bank_mask:0xf\n\t" "v_fmac_f32_dpp %3, %7, %19 row_newbcast:11 row_mask:0xf bank_mask:0xf\n\t" "v_fmac_f32_dpp %0, %4, %20 row_newbcast:12 row_mask:0xf bank_mask:0xf\n\t" "v_fmac_f32_dpp %1, %5, %20 row_newbcast:12 row_mask:0xf bank_mask:0xf\n\t" "v_fmac_f32_dpp %2, %6, %20 row_newbcast:12 row_mask:0xf bank_mask:0xf\n\t" "v_fmac_f32_dpp %3, %7, %20 row_newbcast:12 row_mask:0xf bank_mask:0xf\n\t" "v_fmac_f32_dpp %0, %4, %21 row_newbcast:13 row_mask:0xf bank_mask:0xf\n\t" "v_fmac_f32_dpp %1, %5, %21 row_newbcast:13 row_mask:0xf bank_mask:0xf\n\t" "v_fmac_f32_dpp %2, %6, %21 row_newbcast:13 row_mask:0xf bank_mask:0xf\n\t" "v_fmac_f32_dpp %3, %7, %21 row_newbcast:13 row_mask:0xf bank_mask:0xf\n\t" : "+v"(a0), "+v"(a1), "+v"(a2), "+v"(a3) : "v"(l0), "v"(l1), "v"(l2), "v"(l3), "v"(x0), "v"(x1), "v"(x2), "v"(x3), "v"(x4), "v"(x5), "v"(x6), "v"(x7), "v"(x8), "v"(x9), "v"(x10), "v"(x11), "v"(x12), "v"(x13));
    }
};
template <> struct QuadChunk<15> {
    static __device__ __forceinline__ void run(float& a0, float& a1, float& a2, float& a3, float l0, float l1, float l2, float l3, float x0, float x1, float x2, float x3, float x4, float x5, float x6, float x7, float x8, float x9, float x10, float x11, float x12, float x13, float x14) {
        asm volatile("v_fmac_f32_dpp %0, %4, %8 row_newbcast:0 row_mask:0xf bank_mask:0xf\n\t" "v_fmac_f32_dpp %1, %5, %8 row_newbcast:0 row_mask:0xf bank_mask:0xf\n\t" "v_fmac_f32_dpp %2, %6, %8 row_newbcast:0 row_mask:0xf bank_mask:0xf\n\t" "v_fmac_f32_dpp %3, %7, %8 row_newbcast:0 row_mask:0xf bank_mask:0xf\n\t" "v_fmac_f32_dpp %0, %4, %9 row_newbcast:1 row_mask:0xf bank_mask:0xf\n\t" "v_fmac_f32_dpp %1, %5, %9 row_newbcast:1 row_mask:0xf bank_mask:0xf\n\t" "v_fmac_f32_dpp %2, %6, %9 row_newbcast:1 row_mask:0xf bank_mask:0xf\n\t" "v_fmac_f32_dpp %3, %7, %9 row_newbcast:1 row_mask:0xf bank_mask:0xf\n\t" "v_fmac_f32_dpp %0, %4, %10 row_newbcast:2 row_mask:0xf bank_mask:0xf\n\t" "v_fmac_f32_dpp %1, %5, %10 row_newbcast:2 row_mask:0xf bank_mask:0xf\n\t" "v_fmac_f32_dpp %2, %6, %10 row_newbcast:2 row_mask:0xf bank_mask:0xf\n\t" "v_fmac_f32_dpp %3, %7, %10 row_newbcast:2 row_mask:0xf bank_mask:0xf\n\t" "v_fmac_f32_dpp %0, %4, %11 row_newbcast:3 row_mask:0xf bank_mask:0xf\n\t" "v_fmac_f32_dpp %1, %5, %11 row_newbcast:3 row_mask:0xf bank_mask:0xf\n\t" "v_fmac_f32_dpp %2, %6, %11 row_newbcast:3 row_mask:0xf bank_mask:0xf\n\t" "v_fmac_f32_dpp %3, %7, %11 row_newbcast:3 row_mask:0xf bank_mask:0xf\n\t" "v_fmac_f32_dpp %0, %4, %12 row_newbcast:4 row_mask:0xf bank_mask:0xf\n\t" "v_fmac_f32_dpp %1, %5, %12 row_newbcast:4 row_mask:0xf bank_mask:0xf\n\t" "v_fmac_f32_dpp %2, %6, %12 row_newbcast:4 row_mask:0xf bank_mask:0xf\n\t" "v_fmac_f32_dpp %3, %7, %12 row_newbcast:4 row_mask:0xf bank_mask:0xf\n\t" "v_fmac_f32_dpp %0, %4, %13 row_newbcast:5 row_mask:0xf bank_mask:0xf\n\t" "v_fmac_f32_dpp %1, %5, %13 row_newbcast:5 row_mask:0xf bank_mask:0xf\n\t" "v_fmac_f32_dpp %2, %6, %13 row_newbcast:5 row_mask:0xf bank_mask:0xf\n\t" "v_fmac_f32_dpp %3, %7, %13 row_newbcast:5 row_mask:0xf bank_mask:0xf\n\t" "v_fmac_f32_dpp %0, %4, %14 row_newbcast:6 row_mask:0xf bank_mask:0xf\n\t" "v_fmac_f32_dpp %1, %5, %14 row_newbcast:6 row_mask:0xf bank_mask:0xf\n\t" "v_fmac_f32_dpp %2, %6, %14 row_newbcast:6 row_mask:0xf bank_mask:0xf\n\t" "v_fmac_f32_dpp %3, %7, %14 row_newbcast:6 row_mask:0xf bank_mask:0xf\n\t" "v_fmac_f32_dpp %0, %4, %15 row_newbcast:7 row_mask:0xf bank_mask:0xf\n\t" "v_fmac_f32_dpp %1, %5, %15 row_newbcast:7 row_mask:0xf bank_mask:0xf\n\t" "v_fmac_f32_dpp %2, %6, %15 row_newbcast:7 row_mask:0xf bank_mask:0xf\n\t" "v_fmac_f32_dpp %3, %7, %15 row_newbcast:7 row_mask:0xf bank_mask:0xf\n\t" "v_fmac_f32_dpp %0, %4, %16 row_newbcast:8 row_mask:0xf bank_mask:0xf\n\t" "v_fmac_f32_dpp %1, %5, %16 row_newbcast:8 row_mask:0xf bank_mask:0xf\n\t" "v_fmac_f32_dpp %2, %6, %16 row_newbcast:8 row_mask:0xf bank_mask:0xf\n\t" "v_fmac_f32_dpp %3, %7, %16 row_newbcast:8 row_mask:0xf bank_mask:0xf\n\t" "v_fmac_f32_dpp %0, %4, %17 row_newbcast:9 row_mask:0xf bank_mask:0xf\n\t" "v_fmac_f32_dpp %1, %5, %17 row_newbcast:9 row_mask:0xf bank_mask:0xf\n\t" "v_fmac_f32_dpp %2, %6, %17 row_newbcast:9 row_mask:0xf bank_mask:0xf\n\t" "v_fmac_f32_dpp %3, %7, %17 row_newbcast:9 row_mask:0xf bank_mask:0xf\n\t" "v_fmac_f32_dpp %0, %4, %18 row_newbcast:10 row_mask:0xf bank_mask:0xf\n\t" "v_fmac_f32_dpp %1, %5, %18 row_newbcast:10 row_mask:0xf bank_mask:0xf\n\t" "v_fmac_f32_dpp %2, %6, %18 row_newbcast:10 row_mask:0xf bank_mask:0xf\n\t" "v_fmac_f32_dpp %3, %7, %18 row_newbcast:10 row_mask:0xf bank_mask:0xf\n\t" "v_fmac_f32_dpp %0, %4, %19 row_newbcast:11 row_mask:0xf bank_mask:0xf\n\t" "v_fmac_f32_dpp %1, %5, %19 row_newbcast:11 row_mask:0xf bank_mask:0xf\n\t" "v_fmac_f32_dpp %2, %6, %19 row_newbcast:11 row_mask:0xf bank_mask:0xf\n\t" "v_fmac_f32_dpp %3, %7, %19 row_newbcast:11 row_mask:0xf bank_mask:0xf\n\t" "v_fmac_f32_dpp %0, %4, %20 row_newbcast:12 row_mask:0xf bank_mask:0xf\n\t" "v_fmac_f32_dpp %1, %5, %20 row_newbcast:12 row_mask:0xf bank_mask:0xf\n\t" "v_fmac_f32_dpp %2, %6, %20 row_newbcast:12 row_mask:0xf bank_mask:0xf\n\t" "v_fmac_f32_dpp %3, %7, %20 row_newbcast:12 row_mask:0xf bank_mask:0xf\n\t" "v_fmac_f32_dpp %0, %4, %21 row_newbcast:13 row_mask:0xf bank_mask:0xf\n\t" "v_fmac_f32_dpp %1, %5, %21 row_newbcast:13 row_mask:0xf bank_mask:0xf\n\t" "v_fmac_f32_dpp %2, %6, %21 row_newbcast:13 row_mask:0xf bank_mask:0xf\n\t" "v_fmac_f32_dpp %3, %7, %21 row_newbcast:13 row_mask:0xf bank_mask:0xf\n\t" "v_fmac_f32_dpp %0, %4, %22 row_newbcast:14 row_mask:0xf bank_mask:0xf\n\t" "v_fmac_f32_dpp %1, %5, %22 row_newbcast:14 row_mask:0xf bank_mask:0xf\n\t" "v_fmac_f32_dpp %2, %6, %22 row_newbcast:14 row_mask:0xf bank_mask:0xf\n\t" "v_fmac_f32_dpp %3, %7, %22 row_newbcast:14 row_mask:0xf bank_mask:0xf\n\t" : "+v"(a0), "+v"(a1), "+v"(a2), "+v"(a3) : "v"(l0), "v"(l1), "v"(l2), "v"(l3), "v"(x0), "v"(x1), "v"(x2), "v"(x3), "v"(x4), "v"(x5), "v"(x6), "v"(x7), "v"(x8), "v"(x9), "v"(x10), "v"(x11), "v"(x12), "v"(x13), "v"(x14));
    }
};
template <> struct QuadChunk<16> {
    static __device__ __forceinline__ void run(float& a0, float& a1, float& a2, float& a3, float l0, float l1, float l2, float l3, float x0, float x1, float x2, float x3, float x4, float x5, float x6, float x7, float x8, float x9, float x10, float x11, float x12, float x13, float x14, float x15) {
        asm volatile("v_fmac_f32_dpp %0, %4, %8 row_newbcast:0 row_mask:0xf bank_mask:0xf\n\t" "v_fmac_f32_dpp %1, %5, %8 row_newbcast:0 row_mask:0xf bank_mask:0xf\n\t" "v_fmac_f32_dpp %2, %6, %8 row_newbcast:0 row_mask:0xf bank_mask:0xf\n\t" "v_fmac_f32_dpp %3, %7, %8 row_newbcast:0 row_mask:0xf bank_mask:0xf\n\t" "v_fmac_f32_dpp %0, %4, %9 row_newbcast:1 row_mask:0xf bank_mask:0xf\n\t" "v_fmac_f32_dpp %1, %5, %9 row_newbcast:1 row_mask:0xf bank_mask:0xf\n\t" "v_fmac_f32_dpp %2, %6, %9 row_newbcast:1 row_mask:0xf bank_mask:0xf\n\t" "v_fmac_f32_dpp %3, %7, %9 row_newbcast:1 row_mask:0xf bank_mask:0xf\n\t" "v_fmac_f32_dpp %0, %4, %10 row_newbcast:2 row_mask:0xf bank_mask:0xf\n\t" "v_fmac_f32_dpp %1, %5, %10 row_newbcast:2 row_mask:0xf bank_mask:0xf\n\t" "v_fmac_f32_dpp %2, %6, %10 row_newbcast:2 row_mask:0xf bank_mask:0xf\n\t" "v_fmac_f32_dpp %3, %7, %10 row_newbcast:2 row_mask:0xf bank_mask:0xf\n\t" "v_fmac_f32_dpp %0, %4, %11 row_newbcast:3 row_mask:0xf bank_mask:0xf\n\t" "v_fmac_f32_dpp %1, %5, %11 row_newbcast:3 row_mask:0xf bank_mask:0xf\n\t" "v_fmac_f32_dpp %2, %6, %11 row_newbcast:3 row_mask:0xf bank_mask:0xf\n\t" "v_fmac_f32_dpp %3, %7, %11 row_newbcast:3 row_mask:0xf bank_mask:0xf\n\t" "v_fmac_f32_dpp %0, %4, %12 row_newbcast:4 row_mask:0xf bank_mask:0xf\n\t" "v_fmac_f32_dpp %1, %5, %12 row_newbcast:4 row_mask:0xf bank_mask:0xf\n\t" "v_fmac_f32_dpp %2, %6, %12 row_newbcast:4 row_mask:0xf bank_mask:0xf\n\t" "v_fmac_f32_dpp %3, %7, %12 row_newbcast:4 row_mask:0xf bank_mask:0xf\n\t" "v_fmac_f32_dpp %0, %4, %13 row_newbcast:5 row_mask:0xf bank_mask:0xf\n\t" "v_fmac_f32_dpp %1, %5, %13 row_newbcast:5 row_mask:0xf bank_mask:0xf\n\t" "v_fmac_f32_dpp %2, %6, %13 row_newbcast:5 row_mask:0xf bank_mask:0xf\n\t" "v_fmac_f32_dpp %3, %7, %13 row_newbcast:5 row_mask:0xf bank_mask:0xf\n\t" "v_fmac_f32_dpp %0, %4, %14 row_newbcast:6 row_mask:0xf bank_mask:0xf\n\t" "v_fmac_f32_dpp %1, %5, %14 row_newbcast:6 row_mask:0xf bank_mask:0xf\n\t" "v_fmac_f32_dpp %2, %6, %14 row_newbcast:6 row_mask:0xf bank_mask:0xf\n\t" "v_fmac_f32_dpp %3, %7, %14 row_newbcast:6 row_mask:0xf bank_mask:0xf\n\t" "v_fmac_f32_dpp %0, %4, %15 row_newbcast:7 row_mask:0xf bank_mask:0xf\n\t" "v_fmac_f32_dpp %1, %5, %15 row_newbcast:7 row_mask:0xf bank_mask:0xf\n\t" "v_fmac_f32_dpp %2, %6, %15 row_newbcast:7 row_mask:0xf bank_mask:0xf\n\t" "v_fmac_f32_dpp %3, %7, %15 row_newbcast:7 row_mask:0xf bank_mask:0xf\n\t" "v_fmac_f32_dpp %0, %4, %16 row_newbcast:8 row_mask:0xf bank_mask:0xf\n\t" "v_fmac_f32_dpp %1, %5, %16 row_newbcast:8 row_mask:0xf bank_mask:0xf\n\t" "v_fmac_f32_dpp %2, %6, %16 row_newbcast:8 row_mask:0xf bank_mask:0xf\n\t" "v_fmac_f32_dpp %3, %7, %16 row_newbcast:8 row_mask:0xf bank_mask:0xf\n\t" "v_fmac_f32_dpp %0, %4, %17 row_newbcast:9 row_mask:0xf bank_mask:0xf\n\t" "v_fmac_f32_dpp %1, %5, %17 row_newbcast:9 row_mask:0xf bank_mask:0xf\n\t" "v_fmac_f32_dpp %2, %6, %17 row_newbcast:9 row_mask:0xf bank_mask:0xf\n\t" "v_fmac_f32_dpp %3, %7, %17 row_newbcast:9 row_mask:0xf bank_mask:0xf\n\t" "v_fmac_f32_dpp %0, %4, %18 row_newbcast:10 row_mask:0xf bank_mask:0xf\n\t" "v_fmac_f32_dpp %1, %5, %18 row_newbcast:10 row_mask:0xf bank_mask:0xf\n\t" "v_fmac_f32_dpp %2, %6, %18 row_newbcast:10 row_mask:0xf bank_mask:0xf\n\t" "v_fmac_f32_dpp %3, %7, %18 row_newbcast:10 row_mask:0xf bank_mask:0xf\n\t" "v_fmac_f32_dpp %0, %4, %19 row_newbcast:11 row_mask:0xf bank_mask:0xf\n\t" "v_fmac_f32_dpp %1, %5, %19 row_newbcast:11 row_mask:0xf bank_mask:0xf\n\t" "v_fmac_f32_dpp %2, %6, %19 row_newbcast:11 row_mask:0xf bank_mask:0xf\n\t" "v_fmac_f32_dpp %3, %7, %19 row_newbcast:11 row_mask:0xf bank_mask:0xf\n\t" "v_fmac_f32_dpp %0, %4, %20 row_newbcast:12 row_mask:0xf bank_mask:0xf\n\t" "v_fmac_f32_dpp %1, %5, %20 row_newbcast:12 row_mask:0xf bank_mask:0xf\n\t" "v_fmac_f32_dpp %2, %6, %20 row_newbcast:12 row_mask:0xf bank_mask:0xf\n\t" "v_fmac_f32_dpp %3, %7, %20 row_newbcast:12 row_mask:0xf bank_mask:0xf\n\t" "v_fmac_f32_dpp %0, %4, %21 row_newbcast:13 row_mask:0xf bank_mask:0xf\n\t" "v_fmac_f32_dpp %1, %5, %21 row_newbcast:13 row_mask:0xf bank_mask:0xf\n\t" "v_fmac_f32_dpp %2, %6, %21 row_newbcast:13 row_mask:0xf bank_mask:0xf\n\t" "v_fmac_f32_dpp %3, %7, %21 row_newbcast:13 row_mask:0xf bank_mask:0xf\n\t" "v_fmac_f32_dpp %0, %4, %22 row_newbcast:14 row_mask:0xf bank_mask:0xf\n\t" "v_fmac_f32_dpp %1, %5, %22 row_newbcast:14 row_mask:0xf bank_mask:0xf\n\t" "v_fmac_f32_dpp %2, %6, %22 row_newbcast:14 row_mask:0xf bank_mask:0xf\n\t" "v_fmac_f32_dpp %3, %7, %22 row_newbcast:14 row_mask:0xf bank_mask:0xf\n\t" "v_fmac_f32_dpp %0, %4, %23 row_newbcast:15 row_mask:0xf bank_mask:0xf\n\t" "v_fmac_f32_dpp %1, %5, %23 row_newbcast:15 row_mask:0xf bank_mask:0xf\n\t" "v_fmac_f32_dpp %2, %6, %23 row_newbcast:15 row_mask:0xf bank_mask:0xf\n\t" "v_fmac_f32_dpp %3, %7, %23 row_newbcast:15 row_mask:0xf bank_mask:0xf\n\t" : "+v"(a0), "+v"(a1), "+v"(a2), "+v"(a3) : "v"(l0), "v"(l1), "v"(l2), "v"(l3), "v"(x0), "v"(x1), "v"(x2), "v"(x3), "v"(x4), "v"(x5), "v"(x6), "v"(x7), "v"(x8), "v"(x9), "v"(x10), "v"(x11), "v"(x12), "v"(x13), "v"(x14), "v"(x15));
    }
};
template <int N, int B> struct QuadCall;
#define QC_DEF(N) template <int B> struct QuadCall<N, B> { static __device__ __forceinline__ void run(float (&x)[64], int I, float (&l)[4][4], int Q); };
#undef QC_DEF
#define QC_DEF(N) template <int B> struct QuadCallI { };
#undef QC_DEF
template <int N, int B, int I, int Q> struct QuadDo;
#define QD_DEF(N) template <int B, int I, int Q> struct QuadDo<N, B, I, Q> { static __device__ __forceinline__ void run(float (&x)[64], const float (&l)[4][4]) { QuadChunk<N>::run(x[I], x[I + 1], x[I + 2], x[I + 3], l[0][Q], l[1][Q], l[2][Q], l[3][Q], CC_ARGS##N(B)); } };
QD_DEF(1) QD_DEF(2) QD_DEF(3) QD_DEF(4) QD_DEF(5) QD_DEF(6) QD_DEF(7) QD_DEF(8) QD_DEF(9) QD_DEF(10) QD_DEF(11) QD_DEF(12) QD_DEF(13) QD_DEF(14) QD_DEF(15) QD_DEF(16)
#undef QD_DEF
template <int I, int Q> struct SolveQuadBlocks {
    static __device__ __forceinline__ void run(float (&x)[64], const float (&l)[4][4]) {
        if constexpr (Q > 0) SolveQuadBlocks<I, Q - 1>::run(x, l);
        constexpr int n = (I - 16 * Q) < 16 ? (I - 16 * Q) : 16;
        QuadDo<n, 16 * Q, I, Q>::run(x, l);
    }
};
template <int I> struct SolveRows {
    static __device__ __forceinline__ void run(float (&x)[64], const LAS float* Ls, int l15) {
        if constexpr (I > 0) SolveRows<I - 4>::run(x, Ls, l15);
        float l[4][4];
#pragma unroll
        for (int r = 0; r < 4; ++r)
#pragma unroll
            for (int q = 0; q < 4; ++q) l[r][q] = (16 * q < I + 3) ? Ls[(I + r) * 68 + 16 * q + l15] : 0.f;
        if constexpr (I > 0) SolveQuadBlocks<I, (I - 1) / 16>::run(x, l);
        constexpr int QB = I >> 4, L0 = I & 15;
        fmac_bcast<L0>(x[I + 1], l[1][QB], x[I]);
        fmac_bcast<L0>(x[I + 2], l[2][QB], x[I]); fmac_bcast<L0>(x[I + 3], l[3][QB], x[I]);
        fmac_bcast<L0 + 1>(x[I + 2], l[2][QB], x[I + 1]); fmac_bcast<L0 + 1>(x[I + 3], l[3][QB], x[I + 1]);
        fmac_bcast<L0 + 2>(x[I + 3], l[3][QB], x[I + 2]);
        if ((I & 7) == 4) asm volatile("" ::: "memory");
    }
};

#define XB_TMO      128
#define XB_XCNT(j)  (256  + 64 * (j))
#define XB_XSUB(j)  (1280 + 64 * (j))
#define XB_XGEN(j)  (2304 + 64 * (j))
#define XB_TOP      3328
#define XB_TOPGEN   3392
#define XCD_BAR_WORDS 3456
#define XB_SPIN_CAP (1u << 18)
__device__ __forceinline__ unsigned xb_ld(unsigned* p)              { return __hip_atomic_load(p, __ATOMIC_RELAXED, __HIP_MEMORY_SCOPE_AGENT); }
__device__ __forceinline__ unsigned xb_add(unsigned* p, unsigned v) { return __hip_atomic_fetch_add(p, v, __ATOMIC_RELAXED, __HIP_MEMORY_SCOPE_AGENT); }
__device__ __forceinline__ unsigned xb_xcc_id() { return (unsigned)__builtin_amdgcn_s_getreg((3 << 11) | 20) & 0xFu; }
#define XB_SPIN(cond, bar) do { unsigned _sp = 0; while (cond) { __builtin_amdgcn_s_sleep(1); \
    if ((++_sp & 255u) == 0u) { if (xb_ld(&(bar)[XB_TMO])) break; if (_sp > XB_SPIN_CAP) { atomicAdd(&(bar)[XB_TMO], 1u); break; } } } } while (0)
struct XcdBarrier { unsigned* bar; unsigned x; volatile LAS unsigned* st; };
__device__ __forceinline__ XcdBarrier xcd_barrier_post(unsigned* bar, volatile LAS unsigned* st) {
    XcdBarrier b; b.bar = bar; b.x = xb_xcc_id(); b.st = st;
    if (threadIdx.x == 0) (void)xb_add(&bar[XB_XCNT(b.x)], 1u);
    return b;
}
__device__ __forceinline__ void xcd_barrier_complete(unsigned* bar, unsigned x, unsigned& nloc, unsigned& nx) {
    const unsigned G = gridDim.x * gridDim.y * gridDim.z;
    unsigned sum, cnt, mine, sp = 0u;
    for (;;) {
        sum = 0u; cnt = 0u; mine = 0u;
#pragma unroll
        for (unsigned j = 0; j < 16; ++j) { const unsigned c = xb_ld(&bar[XB_XCNT(j)]); sum += c; cnt += (c > 0u) ? 1u : 0u; mine = (j == x) ? c : mine; }
        if (sum == G) break;
        __builtin_amdgcn_s_sleep(1);
        if ((++sp & 255u) == 0u) { if (xb_ld(&bar[XB_TMO])) break; if (sp > XB_SPIN_CAP) { atomicAdd(&bar[XB_TMO], 1u); break; } }
    }
    nloc = mine > 0u ? mine : 1u; nx = cnt > 0u ? cnt : 1u;
}
__device__ __forceinline__ void xcd_barrier(const XcdBarrier& b) {
    asm volatile("s_waitcnt vmcnt(0)" ::: "memory");
    __syncthreads();
    if (threadIdx.x == 0) {
        unsigned* bar = b.bar;
        __builtin_amdgcn_s_waitcnt(0);
        unsigned nloc = b.st[0], nx = b.st[1];
        if (nloc == 0u) { xcd_barrier_complete(bar, b.x, nloc, nx); b.st[0] = nloc; b.st[1] = nx; }
        const unsigned old = xb_add(&bar[XB_XSUB(b.x)], 1u);
        const unsigned gen = old / nloc;
        if (old + 1u == (gen + 1u) * nloc) {
            __builtin_amdgcn_fence(__ATOMIC_RELEASE, "agent");
            asm volatile("s_waitcnt vmcnt(0)" ::: "memory");
            const unsigned og = xb_add(&bar[XB_TOP], 1u);
            const unsigned tg = og / nx;
            if (og + 1u == (tg + 1u) * nx) xb_add(&bar[XB_TOPGEN], 1u);
            else XB_SPIN(xb_ld(&bar[XB_TOPGEN]) == tg, bar);
            __builtin_amdgcn_fence(__ATOMIC_ACQUIRE, "agent");
            xb_add(&bar[XB_XGEN(b.x)], 1u);
            asm volatile("s_waitcnt vmcnt(0)" ::: "memory");
        } else {
            XB_SPIN(xb_ld(&bar[XB_XGEN(b.x)]) == gen, bar);
            __builtin_amdgcn_fence(__ATOMIC_ACQUIRE, "agent");
            asm volatile("s_waitcnt vmcnt(0)" ::: "memory");
        }
    }
    __syncthreads();
}

struct Frame {
    LAS unsigned char* lds;
    volatile LAS unsigned* MISC;
    unsigned* ctl;
    int tid, lane, wave, vcu, G;
    const float* in[25]; float* out; unsigned char* ws;
};
enum { I_X = 0, I_P, I_NORM_MIX, I_W_IN, I_POOL_W, I_POOL_SCALE, I_CONV_W, I_A_LOG, I_DT_BIAS, I_DN_NORM, I_W_UP_POOL, I_W_UP_DN, I_W_OUT, I_NORM_MOE,
       I_W_RG, I_B_RG, I_W_RE, I_B_RE, I_W_GATE, I_W_UP, I_W_DOWN, I_NORM_PLE, I_W_PLE_GATE, I_W_PLE_PROJ, I_NORM_FINAL };

struct Unit { int pn, e, arow0, nrows, lrow0; };
template <int RB> struct DenseSched {
    int nM, nN, G, c, K;
    __device__ __forceinline__ void init(int M, int N, int K_, int G_, int c_) { nM = M / RB; nN = N / 256; G = G_; c = c_; K = K_; }
    __device__ __forceinline__ bool next(int i, Unit& u) const {
        const long L = (long)i * G + c; if (L >= (long)nM * nN) return false;
        const int pm = (int)(L / nN); u.pn = (int)(L % nN); u.e = 0; u.arow0 = pm * RB; u.nrows = RB; u.lrow0 = 0; return true;
    }
    __device__ __forceinline__ int arow(const Unit& u, int r) const { return u.arow0 + r; }
    __device__ __forceinline__ size_t boff(const Unit& u) const { return (size_t)u.pn * 256 * K; }
};
template <int RB, bool GATHER> struct MoeSched {
    const LAS int* pre; const LAS int* base; const int* ltk; int nN, G, c, K, Nfull;
    __device__ __forceinline__ bool next(int i, Unit& u) const {
        const long L = (long)i * G + c; if (L >= (long)pre[NE] * nN) return false;
        const int blk = (int)(L / nN); u.pn = (int)(L % nN);
        int e = 0;
        for (int j = 1; j < NE; ++j) if (pre[j] <= blk) e = j;
        const int rb = blk - pre[e]; const int cnt = base[e + 1] - base[e];
        const int nr = (cnt - rb * RB) < RB ? (cnt - rb * RB) : RB;
        u.e = __builtin_amdgcn_readfirstlane(e); u.lrow0 = __builtin_amdgcn_readfirstlane(rb * RB); u.arow0 = __builtin_amdgcn_readfirstlane(base[e] + rb * RB); u.nrows = __builtin_amdgcn_readfirstlane(nr);
        u.pn = __builtin_amdgcn_readfirstlane(u.pn); return true;
    }
    __device__ __forceinline__ int arow(const Unit& u, int r) const {
        const int rr = r < u.nrows ? r : u.nrows - 1;
        if (GATHER) return ltk[(size_t)u.e * T + u.lrow0 + rr] >> 1;
        return u.arow0 + rr;
    }
    __device__ __forceinline__ size_t boff(const Unit& u) const { return ((size_t)u.e * Nfull + (size_t)u.pn * 256) * K; }
};
template <int RB> __device__ __forceinline__ void moe_tables(Frame& F, LAS int* pre, LAS int* base) {
    __syncthreads();
    if (F.tid == 0) { int p = 0, b = 0; for (int e = 0; e < NE; ++e) { const int c = (int)F.ctl[CW_CNT + 64 * e]; pre[e] = p; base[e] = b; p += (c + RB - 1) / RB; b += c; } pre[NE] = p; base[NE] = b; }
    __syncthreads();
}

constexpr int SG_RB = 64, SG_BK = 32, SG_ALD = 68, SG_BLD = 260;
template <class Epi, class Sched>
__device__ __forceinline__ void sgemm_phase(Frame& F, const bf16* A, const bf16* Bt, int K, const Sched& S, const Epi& E) {
    LAS float* As = (LAS float*)(F.lds + RING_OFF);
    LAS float* Bs = As + SG_BK * SG_ALD;
    const int tid = F.tid, rg = tid >> 4, cg = tid & 15;
    const int la = tid >> 3, kq = (tid & 7) * 4;
    const int nb = tid >> 1, kh = (tid & 1) * 16;
    for (int i = 0;; ++i) {
        Unit u; if (!S.next(i, u)) break;
        const bf16* ap = A + (size_t)S.arow(u, la) * K + kq;
        const bf16* bp = Bt + S.boff(u) + (size_t)nb * K + kh;
        float acc[2][16];
#pragma unroll
        for (int a = 0; a < 2; ++a)
#pragma unroll
            for (int b = 0; b < 16; ++b) acc[a][b] = 0.f;
        for (int k0 = 0; k0 < K; k0 += SG_BK) {
            const v2u av = *(const v2u*)(ap + k0);
            const v4u b0 = *(const v4u*)(bp + k0), b1 = *(const v4u*)(bp + k0 + 8);
            __syncthreads();
            As[(kq + 0) * SG_ALD + la] = bflo(av.x); As[(kq + 1) * SG_ALD + la] = bfhi(av.x); As[(kq + 2) * SG_ALD + la] = bflo(av.y); As[(kq + 3) * SG_ALD + la] = bfhi(av.y);
            Bs[(kh + 0) * SG_BLD + nb] = bflo(b0.x); Bs[(kh + 1) * SG_BLD + nb] = bfhi(b0.x); Bs[(kh + 2) * SG_BLD + nb] = bflo(b0.y); Bs[(kh + 3) * SG_BLD + nb] = bfhi(b0.y);
            Bs[(kh + 4) * SG_BLD + nb] = bflo(b0.z); Bs[(kh + 5) * SG_BLD + nb] = bfhi(b0.z); Bs[(kh + 6) * SG_BLD + nb] = bflo(b0.w); Bs[(kh + 7) * SG_BLD + nb] = bfhi(b0.w);
            Bs[(kh + 8) * SG_BLD + nb] = bflo(b1.x); Bs[(kh + 9) * SG_BLD + nb] = bfhi(b1.x); Bs[(kh + 10) * SG_BLD + nb] = bflo(b1.y); Bs[(kh + 11) * SG_BLD + nb] = bfhi(b1.y);
            Bs[(kh + 12) * SG_BLD + nb] = bflo(b1.z); Bs[(kh + 13) * SG_BLD + nb] = bfhi(b1.z); Bs[(kh + 14) * SG_BLD + nb] = bflo(b1.w); Bs[(kh + 15) * SG_BLD + nb] = bfhi(b1.w);
            __syncthreads();
#pragma unroll 8
            for (int kk = 0; kk < SG_BK; ++kk) {
                const float a0 = As[kk * SG_ALD + rg], a1 = As[kk * SG_ALD + rg + 32];
                const f32x4 p0 = *(const LAS f32x4*)(Bs + kk * SG_BLD + 8 * cg), p1 = *(const LAS f32x4*)(Bs + kk * SG_BLD + 8 * cg + 4);
                const f32x4 p2 = *(const LAS f32x4*)(Bs + kk * SG_BLD + 128 + 8 * cg), p3 = *(const LAS f32x4*)(Bs + kk * SG_BLD + 128 + 8 * cg + 4);
#pragma unroll
                for (int j = 0; j < 4; ++j) {
                    acc[0][j] += a0 * p0[j]; acc[0][4 + j] += a0 * p1[j]; acc[0][8 + j] += a0 * p2[j]; acc[0][12 + j] += a0 * p3[j];
                    acc[1][j] += a1 * p0[j]; acc[1][4 + j] += a1 * p1[j]; acc[1][8 + j] += a1 * p2[j]; acc[1][12 + j] += a1 * p3[j];
                }
            }
        }
#pragma unroll
        for (int a = 0; a < 2; ++a) { const int r = rg + 32 * a; if (r < u.nrows) E.store(u, r, 8 * cg, &acc[a][0], &acc[a][8]); }
    }
    __syncthreads();
}


namespace pg8 {
constexpr int BM = 256, BK = 64, HALF = 128, HTB = HALF * BK * 2, STAGE_BYTES = 8 * HTB, NXCD = 8, WGM = 8;
__host__ __device__ __forceinline__ int lds_byte(int r, int c) { const int st = (r >> 4) * 2 + (c >> 5), rr = r & 15, cc = c & 31, ob = rr * 64 + cc * 2; return st * 1024 + (ob ^ (((ob >> 9) & 1) << 5)); }
__host__ __device__ __forceinline__ void stage_rc(int b, int& R, int& C) { const int st = b / 1024, sb = b % 1024, swz = sb ^ (((sb >> 9) & 1) << 5); R = (st >> 1) * 16 + swz / 64; C = (st & 1) * 32 + (swz % 64) / 2; }
__host__ __device__ __forceinline__ int perm32(int rho) { const int n = rho >> 4, i = rho & 15; return 8 * (i >> 2) + 4 * n + (i & 3); }

struct DenseOrder {
    int nM, nN, nwg, G, c, K;
    __device__ __forceinline__ void init(int M, int N, int K_, int G_, int c_) { nM = M / BM; nN = N / BM; nwg = nM * nN; G = G_; c = c_; K = K_; }
    __device__ __forceinline__ bool next(int i, Unit& u) const {
        const long L = (long)i * G + c; if (L >= nwg) return false;
        int wgid = (int)L; { const int q = nwg / NXCD, r = nwg % NXCD, xcd = wgid % NXCD, off = wgid / NXCD; wgid = (xcd < r ? xcd * (q + 1) : r * (q + 1) + (xcd - r) * q) + off; }
        const int nig = WGM * nN, gid = wgid / nig, fm = gid * WGM, gsz = (nM - fm) < WGM ? (nM - fm) : WGM;
        u.pn = (wgid % nig) / gsz; u.e = 0; u.arow0 = (fm + ((wgid % nig) % gsz)) * BM; u.nrows = BM; u.lrow0 = 0; return true;
    }
    __device__ __forceinline__ int arow(const Unit& u, int r) const { return u.arow0 + r; }
    __device__ __forceinline__ size_t boff(const Unit& u) const { return (size_t)u.pn * 256 * K; }
};

template <class Epi, class Sched, bool GATHER, bool ALIGN_EPI = true, bool SP2 = true>
__device__ __forceinline__ void gemm_phase(LAS unsigned char* lds, const bf16* Ag, const bf16* Btg, const int K, const Sched& S, const Epi& E) {
    const int tid = threadIdx.x, wid = __builtin_amdgcn_readfirstlane(tid >> 6), lane = tid & 63, wr = wid >> 2, wc = wid & 3, fr = lane & 15, fq = lane >> 4;
    const int nt = K / BK;
    unsigned voffA[2], voffB[2]; int RA[2], CA[2];
#pragma unroll
    for (int i = 0; i < 2; ++i) { int R, C; stage_rc(tid * 16 + i * 8192, R, C); const int Rb = (R & ~31) + perm32(R & 31);
        voffA[i] = (unsigned)(R * K + C) * 2u; voffB[i] = (unsigned)(Rb * K + C) * 2u; RA[i] = R; CA[i] = C; }
    const size_t kstep = (size_t)(BK * 2);
    const size_t hstep = (size_t)HALF * K * 2;
    const unsigned ldsw = (unsigned)wid * 1024u;
    const int aoff = lds_byte(wr * 64 + fr, fq * 8), boff = lds_byte(wc * 32 + fr, fq * 8);
#define PG8_SA(b, h) (((b) * 2 + (h)) * HTB)
#define PG8_SB(b, h) ((4 + (b) * 2 + (h)) * HTB)
#define PG8_STAGE(bufoff, gbase, voff) do { _Pragma("unroll") for (int _i = 0; _i < 2; ++_i) \
        __builtin_amdgcn_global_load_lds((const unsigned*)((const char*)(gbase) + (voff)[_i]), (LAS unsigned*)(lds + (bufoff) + ldsw + _i * 8192), 16, 0, 0); } while (0)
#define PG8_STAGE_A(bufoff, base, vg, h, ko) do { if (GATHER) { PG8_STAGE(bufoff, (const char*)Ag + (ko), vg[h]); } else { PG8_STAGE(bufoff, (base) + (h) * hstep + (ko), voffA); } } while (0)
#define PG8_LDA(dst, b, h) do { _Pragma("unroll") for (int m = 0; m < 4; ++m) _Pragma("unroll") for (int k = 0; k < 2; ++k) dst[m][k] = *(const LAS bf16x8*)(lds + PG8_SA(b, h) + aoff + m * 2048 + k * 1024); } while (0)
#define PG8_LDB(dst, b, h) do { _Pragma("unroll") for (int n = 0; n < 2; ++n) _Pragma("unroll") for (int k = 0; k < 2; ++k) dst[n][k] = *(const LAS bf16x8*)(lds + PG8_SB(b, h) + boff + n * 2048 + k * 1024); } while (0)
#define PG8_MMA(ai, bj, At, Bt) do { __builtin_amdgcn_s_setprio(1); _Pragma("unroll") for (int m = 0; m < 4; ++m) _Pragma("unroll") for (int n = 0; n < 2; ++n) _Pragma("unroll") for (int k = 0; k < 2; ++k) \
        acc[ai][bj][m][n] = __builtin_amdgcn_mfma_f32_16x16x32_bf16(Bt[n][k], At[m][k], acc[ai][bj][m][n], 0, 0, 0); __builtin_amdgcn_s_setprio(0); } while (0)
#define PG8_WAIT_V(n) asm volatile("s_waitcnt vmcnt(" #n ")" ::: "memory")
#define PG8_WAIT_L(n) asm volatile("s_waitcnt lgkmcnt(" #n ")" ::: "memory")
#define PG8_BAR __builtin_amdgcn_s_barrier()
#define PG8_SCHED __builtin_amdgcn_sched_barrier(0)
#define PG8_ROWOFFS(dst, un) do { _Pragma("unroll") for (int _h = 0; _h < 2; ++_h) _Pragma("unroll") for (int _i = 0; _i < 2; ++_i) \
        dst[_h][_i] = ((unsigned)S.arow(un, _h * HALF + RA[_i]) * (unsigned)K + (unsigned)CA[_i]) * 2u; } while (0)
    Unit cur, nxt; int ui = 0;
    if (!S.next(0, cur)) return;
    f32x4 acc[2][2][4][2];
#pragma unroll
    for (int a = 0; a < 2; ++a)
#pragma unroll
        for (int b = 0; b < 2; ++b)
#pragma unroll
            for (int m = 0; m < 4; ++m)
#pragma unroll
                for (int n = 0; n < 2; ++n) acc[a][b][m][n] = (f32x4){0.f, 0.f, 0.f, 0.f};
    bf16x8 At[4][2], B0[2][2], B1[2][2];
    unsigned vc[2][2], vn[2][2];
    if (GATHER) { PG8_ROWOFFS(vc, cur); }
    const char* cA = GATHER ? (const char*)Ag : (const char*)Ag + (size_t)cur.arow0 * K * 2; const char* cB = (const char*)Btg + S.boff(cur) * 2;
    if constexpr (SP2) {
        PG8_STAGE(PG8_SB(0, 0), cB, voffB); PG8_STAGE(PG8_SB(0, 1), cB + hstep, voffB); PG8_STAGE_A(PG8_SA(0, 0), cA, vc, 0, 0); PG8_STAGE_A(PG8_SA(0, 1), cA, vc, 1, 0);
        if (wr == 1) PG8_BAR;
        PG8_WAIT_V(2); PG8_BAR;
        PG8_STAGE(PG8_SB(1, 0), cB + kstep, voffB); PG8_STAGE_A(PG8_SA(1, 0), cA, vc, 0, kstep); PG8_STAGE(PG8_SB(1, 1), cB + hstep + kstep, voffB);
        PG8_WAIT_V(6); PG8_BAR;
    } else {
        PG8_STAGE(PG8_SB(0, 0), cB, voffB); PG8_STAGE_A(PG8_SA(0, 0), cA, vc, 0, 0); PG8_STAGE(PG8_SB(0, 1), cB + hstep, voffB); PG8_STAGE_A(PG8_SA(0, 1), cA, vc, 1, 0);
        if (wr == 1) PG8_BAR;
        PG8_WAIT_V(4); PG8_BAR;
        PG8_STAGE(PG8_SB(1, 0), cB + kstep, voffB); PG8_STAGE_A(PG8_SA(1, 0), cA, vc, 0, kstep); PG8_STAGE(PG8_SB(1, 1), cB + hstep + kstep, voffB);
        PG8_WAIT_V(6); PG8_BAR;
    }
    for (;;) {
        const bool has_next = S.next(ui + 1, nxt);
        const char* nA = GATHER ? cA : (has_next ? (const char*)Ag + (size_t)nxt.arow0 * K * 2 : cA); const char* nB = has_next ? (const char*)Btg + S.boff(nxt) * 2 : cB;
        if (GATHER) { if (has_next) { PG8_ROWOFFS(vn, nxt); } else {
#pragma unroll
            for (int _h = 0; _h < 2; ++_h)
#pragma unroll
                for (int _i = 0; _i < 2; ++_i) vn[_h][_i] = vc[_h][_i]; } }
#pragma unroll 1
        for (int t = 0; t < nt; t += 2) {
            const bool last = (t == nt - 2);
            const size_t k1 = (size_t)(t + 1) * kstep;
            const size_t k2 = last ? 0 : (size_t)(t + 2) * kstep, k3 = k2 + kstep;
            const char* a2 = last ? nA : cA; const char* b2 = (last ? nB : cB) + k2; const char* b3 = b2 + kstep;
            unsigned v2[2][2];
#pragma unroll
            for (int _h = 0; _h < 2; ++_h)
#pragma unroll
                for (int _i = 0; _i < 2; ++_i) v2[_h][_i] = last ? vn[_h][_i] : vc[_h][_i];
            if constexpr (SP2) {
            PG8_LDB(B0, 0, 0); PG8_LDB(B1, 0, 1); PG8_SCHED; PG8_LDA(At, 0, 0); PG8_STAGE_A(PG8_SA(1, 1), cA, vc, 1, k1);
            PG8_WAIT_V(8); PG8_WAIT_L(0); PG8_BAR; PG8_MMA(0, 0, At, B0); PG8_MMA(0, 1, At, B1); PG8_BAR; PG8_SCHED;
            PG8_LDA(At, 0, 1); PG8_STAGE(PG8_SB(0, 0), b2, voffB); PG8_STAGE(PG8_SB(0, 1), b2 + hstep, voffB); PG8_STAGE_A(PG8_SA(0, 0), a2, v2, 0, k2);
            PG8_WAIT_V(8); PG8_WAIT_L(0); PG8_BAR; PG8_MMA(1, 0, At, B0); PG8_MMA(1, 1, At, B1); PG8_BAR; PG8_SCHED;
            PG8_LDB(B0, 1, 0); PG8_LDB(B1, 1, 1); PG8_SCHED; PG8_LDA(At, 1, 0); PG8_STAGE_A(PG8_SA(0, 1), a2, v2, 1, k2);
            PG8_WAIT_V(8); PG8_WAIT_L(0); PG8_BAR; PG8_MMA(0, 0, At, B0); PG8_MMA(0, 1, At, B1); PG8_BAR; PG8_SCHED;
            PG8_LDA(At, 1, 1); PG8_STAGE(PG8_SB(1, 0), b3, voffB); PG8_STAGE(PG8_SB(1, 1), b3 + hstep, voffB); PG8_STAGE_A(PG8_SA(1, 0), a2, v2, 0, k3);
            PG8_WAIT_V(8); PG8_WAIT_L(0); PG8_BAR; PG8_MMA(1, 0, At, B0); PG8_MMA(1, 1, At, B1); PG8_BAR; PG8_SCHED;
            } else {
            PG8_LDB(B0, 0, 0); PG8_SCHED; PG8_LDA(At, 0, 0); PG8_STAGE_A(PG8_SA(1, 1), cA, vc, 1, k1);
            PG8_WAIT_L(8); PG8_BAR; PG8_WAIT_L(0); PG8_MMA(0, 0, At, B0); PG8_BAR; PG8_SCHED;
            PG8_LDB(B1, 0, 1); PG8_STAGE(PG8_SB(0, 0), b2, voffB);
            PG8_BAR; PG8_WAIT_L(0); PG8_MMA(0, 1, At, B1); PG8_BAR;
            PG8_LDA(At, 0, 1); PG8_STAGE_A(PG8_SA(0, 0), a2, v2, 0, k2);
            PG8_BAR; PG8_WAIT_L(0); PG8_MMA(1, 0, At, B0); PG8_BAR; PG8_SCHED;
            PG8_STAGE(PG8_SB(0, 1), b2 + hstep, voffB);
            PG8_WAIT_V(6); PG8_BAR; PG8_MMA(1, 1, At, B1); PG8_BAR;
            PG8_LDB(B0, 1, 0); PG8_SCHED; PG8_LDA(At, 1, 0); PG8_STAGE_A(PG8_SA(0, 1), a2, v2, 1, k2);
            PG8_WAIT_L(8); PG8_BAR; PG8_WAIT_L(0); PG8_MMA(0, 0, At, B0); PG8_BAR; PG8_SCHED;
            PG8_LDB(B1, 1, 1); PG8_STAGE(PG8_SB(1, 0), b3, voffB);
            PG8_BAR; PG8_WAIT_L(0); PG8_MMA(0, 1, At, B1); PG8_BAR;
            PG8_LDA(At, 1, 1); PG8_STAGE_A(PG8_SA(1, 0), a2, v2, 0, k3);
            PG8_BAR; PG8_WAIT_L(0); PG8_MMA(1, 0, At, B0); PG8_BAR; PG8_SCHED;
            PG8_STAGE(PG8_SB(1, 1), b3 + hstep, voffB);
            PG8_WAIT_V(6); PG8_BAR; PG8_MMA(1, 1, At, B1); PG8_BAR;
            }
        }
        if constexpr (ALIGN_EPI) { if (wr == 0) PG8_BAR; }
        {
            const int cit = wc * 32 + 8 * fq;
            if constexpr (Epi::PRE_ALL) {
                typename Epi::Pre pa[8];
#pragma unroll
                for (int gq = 0; gq < 8; ++gq) { const int rn = (gq >> 2) * HALF + wr * 64 + (gq & 3) * 16 + fr; pa[gq] = E.pre(cur, rn < cur.nrows ? rn : cur.nrows - 1, cit); }
#pragma unroll
                for (int gq = 0; gq < 8; ++gq) { const int ai = gq >> 2, m = gq & 3, r = ai * HALF + wr * 64 + m * 16 + fr;
                    if (r < cur.nrows) { float v0[8], v1[8];
#pragma unroll
                        for (int i = 0; i < 4; ++i) { v0[i] = acc[ai][0][m][0][i]; v0[4 + i] = acc[ai][0][m][1][i]; v1[i] = acc[ai][1][m][0][i]; v1[4 + i] = acc[ai][1][m][1][i]; }
                        E.post(cur, r, cit, v0, v1, pa[gq]); } }
            } else {
            typename Epi::Pre pq[2];
            { const int r0_ = wr * 64 + fr; pq[0] = E.pre(cur, r0_ < cur.nrows ? r0_ : cur.nrows - 1, cit); }
#pragma unroll
            for (int gq = 0; gq < 8; ++gq) { const int ai = gq >> 2, m = gq & 3, r = ai * HALF + wr * 64 + m * 16 + fr;
                if (gq + 1 < 8) { const int rn = ((gq + 1) >> 2) * HALF + wr * 64 + ((gq + 1) & 3) * 16 + fr; pq[(gq + 1) & 1] = E.pre(cur, rn < cur.nrows ? rn : cur.nrows - 1, cit); }
                __builtin_amdgcn_sched_barrier(0);
                if (r < cur.nrows) { float v0[8], v1[8];
#pragma unroll
                    for (int i = 0; i < 4; ++i) { v0[i] = acc[ai][0][m][0][i]; v0[4 + i] = acc[ai][0][m][1][i]; v1[i] = acc[ai][1][m][0][i]; v1[4 + i] = acc[ai][1][m][1][i]; }
                    E.post(cur, r, cit, v0, v1, pq[gq & 1]); }
                __builtin_amdgcn_sched_barrier(0); }
            }
        }
        if (!has_next) break;
#pragma unroll
        for (int a = 0; a < 2; ++a)
#pragma unroll
            for (int b = 0; b < 2; ++b)
#pragma unroll
                for (int m = 0; m < 4; ++m)
#pragma unroll
                    for (int n = 0; n < 2; ++n) acc[a][b][m][n] = (f32x4){0.f, 0.f, 0.f, 0.f};
        cur = nxt; cA = nA; cB = nB; ++ui;
        if (GATHER) {
#pragma unroll
            for (int _h = 0; _h < 2; ++_h)
#pragma unroll
                for (int _i = 0; _i < 2; ++_i) vc[_h][_i] = vn[_h][_i]; }
        if constexpr (ALIGN_EPI) { if (wr == 1) PG8_BAR; }
    }
    PG8_WAIT_V(0);
    if constexpr (!ALIGN_EPI) { if (wr == 0) PG8_BAR; }
    PG8_BAR;
#undef PG8_SA
#undef PG8_SB
#undef PG8_STAGE
#undef PG8_STAGE_A
#undef PG8_LDA
#undef PG8_LDB
#undef PG8_MMA
#undef PG8_WAIT_V
#undef PG8_WAIT_L
#undef PG8_BAR
#undef PG8_SCHED
#undef PG8_ROWOFFS
}
}

struct NoPre {};
struct EpiInProj { typedef NoPre Pre; static constexpr bool PRE_ALL = false;
    bf16 *upool, *qkv, *z, *gp, *gd;
    __device__ __forceinline__ Pre pre(const Unit&, int, int) const { return Pre{}; }
    __device__ __forceinline__ void post(const Unit& u, int r, int cit, const float* v0, const float* v1, const Pre&) const {
        const size_t row = (size_t)(u.arow0 + r); const int pn = u.pn;
        if (pn < 4) { bf16* p = upool + row * D_POOL + pn * 256 + cit; store8bf(p, v0); store8bf(p + 128, v1); }
        else if (pn < 16) { bf16* p = qkv + row * D_QKV + (pn - 4) * 256 + cit; store8bf(p, v0); store8bf(p + 128, v1); }
        else if (pn < 20) { float a[8], b[8];
#pragma unroll
            for (int i = 0; i < 8; ++i) { a[i] = siluf_(v0[i]); b[i] = siluf_(v1[i]); }
            bf16* p = z + row * D_Z + (pn - 16) * 256 + cit; store8bf(p, a); store8bf(p + 128, b); }
        else { float a[8], b[8];
#pragma unroll
            for (int i = 0; i < 8; ++i) { a[i] = sigmoidf_(v0[i]); b[i] = sigmoidf_(v1[i]); }
            bf16* p = (pn < 28 ? gp + row * D + (pn - 20) * 256 : gd + row * D + (pn - 28) * 256) + cit; store8bf(p, a); store8bf(p + 128, b); }
    }
};
__device__ __forceinline__ void unpack8bf(const v4u o, float* v) { v[0] = bflo(o.x); v[1] = bfhi(o.x); v[2] = bflo(o.y); v[3] = bfhi(o.y); v[4] = bflo(o.z); v[5] = bfhi(o.z); v[6] = bflo(o.w); v[7] = bfhi(o.w); }
struct EpiPool {
    static constexpr bool PRE_ALL = false;
    struct Pre { v4u g0, g1; };
    const bf16* gp; bf16* mp;
    __device__ __forceinline__ Pre pre(const Unit& u, int r, int cit) const { const size_t off = (size_t)(u.arow0 + r) * D + u.pn * 256 + cit; return Pre{*(const v4u*)(gp + off), *(const v4u*)(gp + off + 128)}; }
    __device__ __forceinline__ void post(const Unit& u, int r, int cit, const float* v0, const float* v1, const Pre& p) const {
        const size_t off = (size_t)(u.arow0 + r) * D + u.pn * 256 + cit; float g0[8], g1[8], a[8], b[8]; unpack8bf(p.g0, g0); unpack8bf(p.g1, g1);
#pragma unroll
        for (int i = 0; i < 8; ++i) { a[i] = g0[i] * v0[i]; b[i] = g1[i] * v1[i]; }
        store8bf(mp + off, a); store8bf(mp + off + 128, b);
    }
};
struct EpiMerge {
    static constexpr bool PRE_ALL = false;
    struct Pre { v4u g0, g1, m0, m1; };
    const bf16* gd; const bf16* mp; bf16* mg;
    __device__ __forceinline__ Pre pre(const Unit& u, int r, int cit) const { const size_t off = (size_t)(u.arow0 + r) * D + u.pn * 256 + cit; return Pre{*(const v4u*)(gd + off), *(const v4u*)(gd + off + 128), *(const v4u*)(mp + off), *(const v4u*)(mp + off + 128)}; }
    __device__ __forceinline__ void post(const Unit& u, int r, int cit, const float* v0, const float* v1, const Pre& p) const {
        const size_t off = (size_t)(u.arow0 + r) * D + u.pn * 256 + cit; float g0[8], g1[8], m0[8], m1[8]; unpack8bf(p.g0, g0); unpack8bf(p.g1, g1); unpack8bf(p.m0, m0); unpack8bf(p.m1, m1);
#pragma unroll
        for (int i = 0; i < 8; ++i) { m0[i] += g0[i] * v0[i]; m1[i] += g1[i] * v1[i]; }
        store8bf(mg + off, m0); store8bf(mg + off + 128, m1);
    }
};
struct EpiResid {
    static constexpr bool PRE_ALL = false;
    struct Pre { f32x4 a0, a1, b0, b1; };
    const float* x; float* h;
    __device__ __forceinline__ Pre pre(const Unit& u, int r, int cit) const { const size_t off = (size_t)(u.arow0 + r) * D + u.pn * 256 + cit; return Pre{*(const f32x4*)(x + off), *(const f32x4*)(x + off + 4), *(const f32x4*)(x + off + 128), *(const f32x4*)(x + off + 132)}; }
    __device__ __forceinline__ void post(const Unit& u, int r, int cit, const float* v0, const float* v1, const Pre& p) const {
        const size_t off = (size_t)(u.arow0 + r) * D + u.pn * 256 + cit;
        *(f32x4*)(h + off) = (f32x4){p.a0[0] + v0[0], p.a0[1] + v0[1], p.a0[2] + v0[2], p.a0[3] + v0[3]}; *(f32x4*)(h + off + 4) = (f32x4){p.a1[0] + v0[4], p.a1[1] + v0[5], p.a1[2] + v0[6], p.a1[3] + v0[7]};
        *(f32x4*)(h + off + 128) = (f32x4){p.b0[0] + v1[0], p.b0[1] + v1[1], p.b0[2] + v1[2], p.b0[3] + v1[3]}; *(f32x4*)(h + off + 132) = (f32x4){p.b1[0] + v1[4], p.b1[1] + v1[5], p.b1[2] + v1[6], p.b1[3] + v1[7]};
    }
};
struct EpiMoe1 { typedef NoPre Pre; static constexpr bool PRE_ALL = false;
    bf16* hmid;
    __device__ __forceinline__ Pre pre(const Unit&, int, int) const { return Pre{}; }
    __device__ __forceinline__ void post(const Unit& u, int r, int cit, const float* v0, const float* v1, const Pre&) const {
        float a[8];
#pragma unroll
        for (int i = 0; i < 8; ++i) a[i] = siluf_(v0[i]) * v1[i];
        store8bf(hmid + (size_t)(u.arow0 + r) * DE + u.pn * 128 + cit, a);
    }
};
struct EpiMoe2 {
    static constexpr bool PRE_ALL = true;
    struct Pre { int tk; float w; };
    const int* ltk; const float* lw; bf16 *y0, *y1;
    __device__ __forceinline__ Pre pre(const Unit& u, int r, int) const { const size_t li = (size_t)u.e * T + u.lrow0 + r; return Pre{ltk[li], lw[li]}; }
    __device__ __forceinline__ void post(const Unit& u, int, int cit, const float* v0, const float* v1, const Pre& p) const {
        bf16* y = ((p.tk & 1) ? y1 : y0) + (size_t)(p.tk >> 1) * D + u.pn * 256 + cit; float a[8], b[8];
#pragma unroll
        for (int i = 0; i < 8; ++i) { a[i] = p.w * v0[i]; b[i] = p.w * v1[i]; }
        store8bf(y, a); store8bf(y + 128, b);
    }
};
struct EpiBf16Plain { typedef NoPre Pre; static constexpr bool PRE_ALL = false;
    bf16* o;
    __device__ __forceinline__ Pre pre(const Unit&, int, int) const { return Pre{}; }
    __device__ __forceinline__ void post(const Unit& u, int r, int cit, const float* v0, const float* v1, const Pre&) const {
        bf16* p = o + (size_t)(u.arow0 + r) * D + u.pn * 256 + cit; store8bf(p, v0); store8bf(p + 128, v1);
    }
};
struct EpiPle {
    static constexpr bool PRE_ALL = false;
    struct Pre { v4u p0, p1; f32x4 a0, a1, b0, b1; };
    const bf16* pp; float* h;
    __device__ __forceinline__ Pre pre(const Unit& u, int r, int cit) const { const size_t off = (size_t)(u.arow0 + r) * D + u.pn * 256 + cit;
        return Pre{*(const v4u*)(pp + off), *(const v4u*)(pp + off + 128), *(const f32x4*)(h + off), *(const f32x4*)(h + off + 4), *(const f32x4*)(h + off + 128), *(const f32x4*)(h + off + 132)}; }
    __device__ __forceinline__ void post(const Unit& u, int r, int cit, const float* v0, const float* v1, const Pre& p) const {
        const size_t off = (size_t)(u.arow0 + r) * D + u.pn * 256 + cit; float p0[8], p1[8]; unpack8bf(p.p0, p0); unpack8bf(p.p1, p1);
        f32x4 oa0, oa1, ob0, ob1;
#pragma unroll
        for (int i = 0; i < 4; ++i) { oa0[i] = p.a0[i] + sigmoidf_(v0[i]) * p0[i]; oa1[i] = p.a1[i] + sigmoidf_(v0[4 + i]) * p0[4 + i]; ob0[i] = p.b0[i] + sigmoidf_(v1[i]) * p1[i]; ob1[i] = p.b1[i] + sigmoidf_(v1[4 + i]) * p1[4 + i]; }
        *(f32x4*)(h + off) = oa0; *(f32x4*)(h + off + 4) = oa1; *(f32x4*)(h + off + 128) = ob0; *(f32x4*)(h + off + 132) = ob1;
    }
};

__device__ __forceinline__ void transpose_item(const float* W, int ldw, int K, int k0, int c0, int nvalid, bf16* WT, int r0, LAS float* scr, int lane) {
    (void)scr;
    const int kb = lane >> 3, nb = lane & 7; const bool ok = 4 * nb < nvalid;
    const float* src = W + (size_t)(k0 + 8 * kb) * ldw + c0 + 4 * nb;
    f32x4 v[8];
#pragma unroll
    for (int i = 0; i < 8; ++i) v[i] = ok ? *(const f32x4*)(src + (size_t)i * ldw) : (f32x4){0.f, 0.f, 0.f, 0.f};
    bf16* dst = WT + (size_t)(r0 + 4 * nb) * K + k0 + 8 * kb;
#pragma unroll
    for (int e = 0; e < 4; ++e) { v4u o; o.x = pk2(v[0][e], v[1][e]); o.y = pk2(v[2][e], v[3][e]); o.z = pk2(v[4][e], v[5][e]); o.w = pk2(v[6][e], v[7][e]); *(v4u*)(dst + (size_t)e * K) = o; }
}
__device__ __forceinline__ void transpose_job(const float* W, int K, int N, bf16* WT, LAS float* scr, int gw, int NGW, int lane) {
    const int nblk = N / 32, items = (K / 64) * nblk;
    for (int it = gw; it < items; it += NGW) { const int kb = it / nblk, nb = it % nblk; transpose_item(W, N, K, 64 * kb, 32 * nb, 32, WT, 32 * nb, scr, lane); }
}
__device__ __forceinline__ void rms_row_bf16(const float* xrow, const float* gain, bf16* orow, int lane) {
    const f32x4* xr = (const f32x4*)xrow + lane; const f32x4* gr = (const f32x4*)gain + lane;
    f32x4 v[8]; float s = 0.f;
#pragma unroll
    for (int j = 0; j < 8; ++j) { v[j] = xr[64 * j]; s += (v[j].x * v[j].x + v[j].y * v[j].y) + (v[j].z * v[j].z + v[j].w * v[j].w); }
    const float rstd = 1.0f / sqrtf(wave_sum(s) * (1.f / D) + EPS);
    v2u* o8 = (v2u*)orow + lane;
#pragma unroll
    for (int j = 0; j < 8; ++j) { const f32x4 g = gr[64 * j]; v2u o; o.x = pk2(v[j].x * rstd * g.x, v[j].y * rstd * g.y); o.y = pk2(v[j].z * rstd * g.z, v[j].w * rstd * g.w); o8[64 * j] = o; }
}


__device__ __forceinline__ void route_row(Frame& F, const LAS float* lgp, float rs, int t, LAS unsigned* lcnt, LAS int* ent, int ei) {
    float gl[4];
#pragma unroll
    for (int o = 0; o < 4; ++o) gl[o] = lgp[o] * rs + F.in[I_B_RG][o];
    int gi = 0; float gm = gl[0];
#pragma unroll
    for (int o = 1; o < 4; ++o) if (gl[o] > gm) { gm = gl[o]; gi = o; }
    float den = 0.f;
#pragma unroll
    for (int o = 0; o < 4; ++o) den += __expf(gl[o] - gm);
    const float psel = 1.0f / den;
    float le[8];
#pragma unroll
    for (int q = 0; q < 8; ++q) le[q] = lgp[4 + 8 * gi + q] * rs + F.in[I_B_RE][gi * 8 + q];
    int i0 = 0; float v0 = le[0];
#pragma unroll
    for (int q = 1; q < 8; ++q) if (le[q] > v0) { v0 = le[q]; i0 = q; }
    int i1 = -1; float v1 = -3.0e38f;
#pragma unroll
    for (int q = 0; q < 8; ++q) if (q != i0 && le[q] > v1) { v1 = le[q]; i1 = q; }
    const float e1 = __expf(v1 - v0); const float w0 = psel / (1.0f + e1), w1 = psel * e1 / (1.0f + e1);
    const int ea = gi * 8 + i0, ebx = gi * 8 + i1;
    const unsigned sa = atomicAdd((unsigned*)(lcnt + ea), 1u), sb = atomicAdd((unsigned*)(lcnt + ebx), 1u);
    ent[4 * ei + 0] = (ea << 16) | (int)sa; ent[4 * ei + 1] = 2 * t; ent[4 * ei + 2] = __float_as_int(w0); ent[4 * ei + 3] = 0;
    ent[4 * (ei + 1) + 0] = (ebx << 16) | (int)sb; ent[4 * (ei + 1) + 1] = 2 * t + 1; ent[4 * (ei + 1) + 2] = __float_as_int(w1); ent[4 * (ei + 1) + 3] = 0;
}

enum { PH_PRO = 0, PH_INPROJ, PH_TOKLOC, PH_DNA, PH_DN, PH_YDN, PH_MERGE, PH_OUT, PH_ROUTE, PH_MOE1, PH_MOE2, PH_N3, PH_PP, PH_PLE, PH_FINAL, NPHASE };
struct Args { const float* in[25]; float* out; unsigned char* ws; int ph_lo, ph_hi, flags, pad; };
__global__ void __launch_bounds__(NTHR, 2) fwd(Args args) {
    extern __shared__ __attribute__((aligned(16))) unsigned char lds_raw[];
    Frame F;
    F.lds = (LAS unsigned char*)lds_raw; F.MISC = (volatile LAS unsigned*)(F.lds + MISC_OFF);
    F.tid = threadIdx.x; F.lane = F.tid & 63; F.wave = __builtin_amdgcn_readfirstlane(F.tid >> 6);
    F.G = gridDim.x; { const int bx = blockIdx.x; F.vcu = (F.G % 8 == 0) ? (bx % 8) * (F.G / 8) + bx / 8 : bx; }
    F.ws = args.ws; F.ctl = (unsigned*)(args.ws + WS_CTL); F.out = args.out;
#pragma unroll
    for (int i = 0; i < 25; ++i) F.in[i] = args.in[i];
    for (int u = F.tid; u < MISC_WORDS; u += NTHR) F.MISC[u] = 0u;
    __syncthreads();
    XcdBarrier bar; bar.bar = F.ctl + CW_BAR; bar.x = 0; bar.st = nullptr;
    if (MK_N_LAUNCHES == 1) bar = xcd_barrier_post(F.ctl + CW_BAR, F.MISC + 8);
    const int lo = args.ph_lo, hi = args.ph_hi;
#define IN(k) (lo <= (k) && (k) < hi)
#define SEAM(k) do { if (MK_N_LAUNCHES == 1 && IN(k) && IN((k) + 1)) xcd_barrier(bar); } while (0)
    unsigned char* ws = F.ws;
    bf16* WIN = (bf16*)(ws + WS_WIN); bf16* WCOMB = (bf16*)(ws + WS_WCOMB); bf16* WUPDN = (bf16*)(ws + WS_WUPDN); bf16* WOUT = (bf16*)(ws + WS_WOUT);
    bf16* WPLEG = (bf16*)(ws + WS_WPLEG); bf16* WPLEP = (bf16*)(ws + WS_WPLEP); bf16* WGU = (bf16*)(ws + WS_WGU); bf16* WDN = (bf16*)(ws + WS_WDN);
    float* BA = (float*)(ws + WS_BA); float* GG = (float*)(ws + WS_G); float* BETA = (float*)(ws + WS_BETA);
    int* LTK = (int*)(ws + WS_LTK); float* LW = (float*)(ws + WS_LW); bf16* PBF = (bf16*)(ws + WS_PBF);
    bf16* WRH = (bf16*)(ws + WS_WRT); bf16* WRL = WRH + 48 * D;
    unsigned char* PKG = ws + WS_PKG; bf16* UT = (bf16*)(ws + WS_UT); bf16* OB = (bf16*)(ws + WS_OB);
    bf16* N1 = (bf16*)(ws + WS_N1); bf16* QKV = (bf16*)(ws + WS_QKV); float* OBUF = (float*)(ws + WS_QKV); bf16* PP = (bf16*)(ws + WS_QKV);
    bf16* MP = (bf16*)((unsigned char*)F.out + OUT_QKV2); bf16* MERGED = (bf16*)(ws + WS_QKV);     bf16* UPOOL = (bf16*)(ws + WS_UPOOL); bf16* ZS = (bf16*)(ws + WS_Z); bf16* HMID = (bf16*)(ws + WS_Z);
    bf16* GP = (bf16*)(ws + WS_GP); bf16* GD = (bf16*)(ws + WS_GD); bf16* Y0 = GP; bf16* Y1 = GD;
    bf16* DBUF = (bf16*)((unsigned char*)F.out + OUT_D); bf16* QKV2 = (bf16*)((unsigned char*)F.out + OUT_QKV2); float* H = F.out;
    const int gw = F.vcu * NWAVES + F.wave, NGW = F.G * NWAVES, lane = F.lane;

    if (IN(PH_PRO)) {
        LAS float* scr = (LAS float*)(F.lds + RING_OFF + F.wave * 16384);
        {
            const int nblk = N_IN_PAD / 32, items = (D / 64) * nblk;
            for (int it = gw; it < items; it += NGW) { const int kb = it / nblk, nb = it % nblk, r0 = 32 * nb; int c0, nv;
                if (r0 < 5120) { c0 = r0; nv = 32; } else { c0 = r0 + 16; nv = 32; }
                transpose_item(F.in[I_W_IN], D_IN, D, 64 * kb, c0, nv, WIN, r0, scr, lane); }
        }
        transpose_job(F.in[I_W_UP_DN], D_Z, D, WUPDN, scr, gw, NGW, lane);
        transpose_job(F.in[I_W_OUT], D, D, WOUT, scr, gw, NGW, lane);
        transpose_job(F.in[I_W_PLE_GATE], D, D, WPLEG, scr, gw, NGW, lane);
        transpose_job(F.in[I_W_PLE_PROJ], D_PLE, D, WPLEP, scr, gw, NGW, lane);
        {
            const float* pw = F.in[I_POOL_W]; const float* ps = F.in[I_POOL_SCALE]; const float* wu = F.in[I_W_UP_POOL];
            const int items = (D_POOL / 8) * (D / 64);
            for (int it = gw; it < items; it += NGW) { const int kg = it / (D / 64), nb = it % (D / 64), k0 = 8 * kg, g = k0 >> 8, kk0 = k0 & 255, n = 64 * nb + lane;
                float acc[8];
#pragma unroll
                for (int i = 0; i < 8; ++i) acc[i] = 0.f;
                for (int j = 0; j < POOL_GW; ++j) { const float wv = wu[(size_t)(256 * g + j) * D + n] * ps[256 * g + j];
#pragma unroll
                    for (int i = 0; i < 8; ++i) acc[i] += pw[(size_t)g * POOL_GW * POOL_GW + (size_t)(kk0 + i) * POOL_GW + j] * wv; }
                store8bf(WCOMB + (size_t)n * D_POOL + k0, acc); }
        }
        {
            const float* gm = F.in[I_NORM_MOE]; const float* wrg = F.in[I_W_RG]; const float* wre = F.in[I_W_RE];
            for (int idx = gw * 64 + lane; idx < 48 * D; idx += NGW * 64) { const int n = idx / D, k = idx % D;
                const float v = n < 4 ? gm[k] * wrg[(size_t)k * NGRP + n] : (n < 36 ? gm[k] * wre[(size_t)k * NE + (n - 4)] : 0.f);
                const unsigned hi = f2bf(v); WRH[idx] = (bf16)hi; WRL[idx] = (bf16)f2bf(v - __uint_as_float(hi << 16)); }
        }
        {
            const float* gain = F.in[I_NORM_MIX]; const float* win = F.in[I_W_IN];
            __syncthreads();
            LAS float* LGp = (LAS float*)(F.lds + RING_OFF);
            LAS float* SSp = LGp + 8 * 256;
            LAS float* RS = SSp + 128;
            const int row = lane & 15, g = lane >> 4, wv = F.wave;
            bf16x8 wbh[8], wbl[8];
#pragma unroll
            for (int J = 0; J < 8; ++J) { unsigned hh[4], ll[4];
#pragma unroll
                for (int q = 0; q < 4; ++q) { const int k = 256 * wv + 32 * J + 8 * g + 2 * q; const float v0 = gain[k] * win[(size_t)k * D_IN + 5120 + row], v1 = gain[k + 1] * win[(size_t)(k + 1) * D_IN + 5120 + row];
                    hh[q] = pk2(v0, v1); ll[q] = pk2(v0 - bflo(hh[q]), v1 - bfhi(hh[q])); }
                wbh[J] = __builtin_bit_cast(bf16x8, (v4u){hh[0], hh[1], hh[2], hh[3]}); wbl[J] = __builtin_bit_cast(bf16x8, (v4u){ll[0], ll[1], ll[2], ll[3]}); }
            for (int task = F.vcu; task < T / 16; task += F.G) {
                const int r0 = task * 16; const float* hp_ = F.in[I_X] + (size_t)(r0 + row) * D + 256 * wv + 8 * g;
                f32x4 a[8][2];
#pragma unroll
                for (int J = 0; J < 8; ++J) { a[J][0] = *(const f32x4*)(hp_ + 32 * J); a[J][1] = *(const f32x4*)(hp_ + 32 * J + 4); }
                f32x4 acc = (f32x4){0.f, 0.f, 0.f, 0.f}; float ss = 0.f;
#pragma unroll
                for (int J = 0; J < 8; ++J) { const f32x4 x0 = a[J][0], x1 = a[J][1];
                    ss += ((x0.x * x0.x + x0.y * x0.y) + (x0.z * x0.z + x0.w * x0.w)) + ((x1.x * x1.x + x1.y * x1.y) + (x1.z * x1.z + x1.w * x1.w));
                    const unsigned h0 = pk2(x0.x, x0.y), h1 = pk2(x0.z, x0.w), h2_ = pk2(x1.x, x1.y), h3 = pk2(x1.z, x1.w);
                    const unsigned l0 = pk2(x0.x - bflo(h0), x0.y - bfhi(h0)), l1 = pk2(x0.z - bflo(h1), x0.w - bfhi(h1)), l2 = pk2(x1.x - bflo(h2_), x1.y - bfhi(h2_)), l3 = pk2(x1.z - bflo(h3), x1.w - bfhi(h3));
                    const bf16x8 ah = __builtin_bit_cast(bf16x8, (v4u){h0, h1, h2_, h3}), al = __builtin_bit_cast(bf16x8, (v4u){l0, l1, l2, l3});
                    acc = __builtin_amdgcn_mfma_f32_16x16x32_bf16(ah, wbh[J], acc, 0, 0, 0); acc = __builtin_amdgcn_mfma_f32_16x16x32_bf16(al, wbh[J], acc, 0, 0, 0); acc = __builtin_amdgcn_mfma_f32_16x16x32_bf16(ah, wbl[J], acc, 0, 0, 0); }
                ss += __shfl_xor(ss, 16); ss += __shfl_xor(ss, 32);
                LDS_BARRIER();
#pragma unroll
                for (int reg = 0; reg < 4; ++reg) LGp[wv * 256 + (4 * g + reg) * 16 + row] = acc[reg];
                if (g == 0) SSp[wv * 16 + row] = ss;
                LDS_BARRIER();
                if (F.tid < 16) { float s8 = 0.f;
#pragma unroll
                    for (int w8 = 0; w8 < 8; ++w8) s8 += SSp[w8 * 16 + F.tid];
                    RS[F.tid] = 1.0f / sqrtf(s8 * (1.f / D) + EPS); }
                LDS_BARRIER();
                if (F.tid < 256) { float s8 = 0.f;
#pragma unroll
                    for (int w8 = 0; w8 < 8; ++w8) s8 += LGp[w8 * 256 + F.tid];
                    BA[(size_t)(r0 + (F.tid >> 4)) * 16 + (F.tid & 15)] = s8 * RS[F.tid >> 4]; }
                {   const float rs = RS[row]; bf16* op = N1 + (size_t)(r0 + row) * D + 256 * wv + 8 * g; const float* gp = gain + 256 * wv + 8 * g;
#pragma unroll
                    for (int J = 0; J < 8; ++J) { const f32x4 g0 = *(const f32x4*)(gp + 32 * J), g1 = *(const f32x4*)(gp + 32 * J + 4); const f32x4 x0 = a[J][0], x1 = a[J][1];
                        v4u o; o.x = pk2(x0.x * rs * g0.x, x0.y * rs * g0.y); o.y = pk2(x0.z * rs * g0.z, x0.w * rs * g0.w); o.z = pk2(x1.x * rs * g1.x, x1.y * rs * g1.y); o.w = pk2(x1.z * rs * g1.z, x1.w * rs * g1.w);
                        *(v4u*)(op + 32 * J) = o; }
                }
            }
            __syncthreads();
        }
        for (int m = gw; m < T; m += NGW) { const f32x4 v = *((const f32x4*)(F.in[I_P] + (size_t)m * D_PLE) + lane); v2u o; o.x = pk2(v.x, v.y); o.y = pk2(v.z, v.w); *((v2u*)(PBF + (size_t)m * D_PLE) + lane) = o; }
    }
    SEAM(PH_PRO);
    if (IN(PH_INPROJ)) {
        pg8::DenseOrder S; S.init(T, N_IN_PAD, D, F.G, (int)blockIdx.x);
        EpiInProj E{UPOOL, QKV, ZS, GP, GD};
        pg8::gemm_phase<EpiInProj, pg8::DenseOrder, false>(F.lds + RING_OFF, N1, WIN, D, S, E);
    }
    SEAM(PH_INPROJ);
    if (IN(PH_TOKLOC)) {
        const float* cw = F.in[I_CONV_W];
        LAS float* red = (LAS float*)(F.lds + RING_OFF + F.wave * 4608);
        LAS float* SC = red + 1024;
        for (int item = gw; item < 2048 * 12; item += NGW) {
            const int run = item / 12, blk = item % 12, t0 = run * 16, s0 = t0 % SEQ, c = blk * 256 + 4 * lane;
            v2u u[19];
#pragma unroll
            for (int i = 0; i < 19; ++i) { u[i] = (s0 - 3 + i >= 0) ? *(const v2u*)(QKV + (size_t)(t0 - 3 + i) * D_QKV + c) : (v2u){0u, 0u}; }
            f32x4 w[4];
#pragma unroll
            for (int kk = 0; kk < 4; ++kk) w[kk] = *(const f32x4*)(cw + kk * D_QKV + c);
            f32x4 y[16];
#pragma unroll
            for (int tt = 0; tt < 16; ++tt) { f32x4 a = (f32x4){0.f, 0.f, 0.f, 0.f};
#pragma unroll
                for (int kk = 0; kk < 4; ++kk) { const v2u x = u[tt + kk]; a.x += bflo(x.x) * w[kk].x; a.y += bfhi(x.x) * w[kk].y; a.z += bflo(x.y) * w[kk].z; a.w += bfhi(x.y) * w[kk].w; }
                a.x = siluf_(a.x); a.y = siluf_(a.y); a.z = siluf_(a.z); a.w = siluf_(a.w); y[tt] = a; }
            if (blk < 8) {
#pragma unroll
                for (int tt = 0; tt < 16; ++tt) red[tt * 64 + lane] = (y[tt].x * y[tt].x + y[tt].y * y[tt].y) + (y[tt].z * y[tt].z + y[tt].w * y[tt].w);
                asm volatile("s_waitcnt lgkmcnt(0)" ::: "memory");
                {   const int tt = lane & 15, hd = (lane >> 4) & 1, part = lane >> 5; float sm = 0.f;
#pragma unroll
                    for (int i = 0; i < 16; ++i) sm += red[tt * 64 + hd * 32 + part * 16 + ((i + lane) & 15)];
                    sm += __shfl_xor(sm, 32);
                    float rr = 1.0f / sqrtf(sm + EPS); if (blk < 4) rr *= 0.08838834764831845f;
                    if (part == 0) SC[hd * 16 + tt] = rr; }
                asm volatile("s_waitcnt lgkmcnt(0)" ::: "memory");
#pragma unroll
                for (int q4 = 0; q4 < 4; ++q4) { const f32x4 sc = *(const LAS f32x4*)(SC + (lane >> 5) * 16 + 4 * q4);
#pragma unroll
                    for (int i = 0; i < 4; ++i) y[4 * q4 + i] = y[4 * q4 + i] * sc[i]; }
                asm volatile("s_waitcnt lgkmcnt(0)" ::: "memory");
            }
#pragma unroll
            for (int tt = 0; tt < 16; ++tt) { v2u o; o.x = pk2(y[tt].x, y[tt].y); o.y = pk2(y[tt].z, y[tt].w); *(v2u*)(QKV2 + (size_t)(t0 + tt) * D_QKV + c) = o; }
        }
        for (int item = gw; item < 1024 * 4; item += NGW) {
            const int run = item >> 2, gi = item & 3, t0 = run * 32, s0 = t0 % SEQ, c = gi * 256 + 4 * lane;
#define POOL_BODY(W) { v2u u[31 + W]; \
                _Pragma("unroll") for (int i = 0; i < 31 + W; ++i) u[i] = (s0 - (W - 1) + i >= 0) ? *(const v2u*)(UPOOL + (size_t)(t0 - (W - 1) + i) * D_POOL + c) : (v2u){0u, 0u}; \
                _Pragma("unroll") for (int tt = 0; tt < 32; ++tt) { f32x4 sm = (f32x4){0.f, 0.f, 0.f, 0.f}; \
                    _Pragma("unroll") for (int j = 0; j < W; ++j) { const v2u x = u[tt + j]; sm.x += bflo(x.x); sm.y += bfhi(x.x); sm.z += bflo(x.y); sm.w += bfhi(x.y); } \
                    const v2u xc = u[tt + W - 1]; const float inv = 1.0f / (float)((s0 + tt + 1) < W ? (s0 + tt + 1) : W); \
                    v2u o; o.x = pk2(sm.x * inv - bflo(xc.x), sm.y * inv - bfhi(xc.x)); o.y = pk2(sm.z * inv - bflo(xc.y), sm.w * inv - bfhi(xc.y)); \
                    *(v2u*)(DBUF + (size_t)(t0 + tt) * D_POOL + c) = o; } }
            if (gi == 0) POOL_BODY(2) else if (gi == 1) POOL_BODY(4) else if (gi == 2) POOL_BODY(8) else POOL_BODY(16)
#undef POOL_BODY
        }
        for (int idx = gw * 64 + lane; idx < T * NH; idx += NGW * 64) { const int t = idx >> 3, hh = idx & 7; const float bl = BA[(size_t)t * 16 + hh], al = BA[(size_t)t * 16 + 8 + hh]; const float xx = al + F.in[I_DT_BIAS][hh];
            const float sp = xx > 20.f ? xx : log1pf(__expf(xx)); GG[idx] = -__expf(F.in[I_A_LOG][hh]) * sp; BETA[idx] = sigmoidf_(bl); }
    }
    SEAM(PH_TOKLOC);
    if (IN(PH_DNA)) {
        const int hb = F.tid >> 8, t4 = F.tid & 255, wq = t4 >> 6;
        LAS unsigned char* hl = F.lds + RING_OFF + hb * 62464;
        LAS bf16* Ks = (LAS bf16*)hl;
        LAS bf16* Qs = Ks + 64 * 136;
        LAS float* Ls = (LAS float*)(hl + 2 * 17408);
        LAS float* gs = (LAS float*)(hl + 3 * 17408);
        LAS bf16* IMG = (LAS bf16*)(hl + 3 * 17408 + 2048);
        LAS bf16* UWI = Qs;
        for (int up = F.vcu; up < DN_UNITS / 2; up += F.G) {
            const int unit = up * 2 + hb, bh = unit >> 7, cch = unit & 127, b = bh >> 3, h = bh & 7; const size_t tok0 = (size_t)b * SEQ + (size_t)cch * 64;
            unsigned char* pk = PKG + (size_t)unit * PKG_BYTES; bf16* pW = (bf16*)pk; bf16* pQ = (bf16*)(pk + 16384); bf16* pA = (bf16*)(pk + 32768); bf16* pKT = (bf16*)(pk + 40960); float* pS = (float*)(pk + 57344);
            bf16* pU = UT + (size_t)unit * 8192;
            float x[64];
            if (t4 < 128) {
#pragma unroll
                for (int i = 0; i < 64; ++i) x[i] = bf2f(QKV2[(tok0 + i) * D_QKV + 2048 + h * 128 + t4]);
            }
            LDS_BARRIER();
            if (t4 < 64) { gs[t4] = GG[(tok0 + t4) * NH + h]; gs[64 + t4] = BETA[(tok0 + t4) * NH + h]; }
#pragma unroll
            for (int i = 0; i < 4; ++i) { const int idx = t4 + 256 * i, row = idx >> 4, ch = idx & 15;
                *(LAS v4u*)(Ks + row * 136 + ch * 8) = *(const v4u*)(QKV2 + (tok0 + row) * D_QKV + 1024 + h * 128 + ch * 8);
                *(LAS v4u*)(Qs + row * 136 + ch * 8) = *(const v4u*)(QKV2 + (tok0 + row) * D_QKV + h * 128 + ch * 8); }
            LDS_BARRIER();
            if (t4 < 64) {
                float a = gs[t4];
#pragma unroll
                for (int o = 1; o < 64; o <<= 1) { const float tv = __shfl_up(a, o); if (lane >= o) a += tv; }
                gs[128 + t4] = a; }
            LDS_BARRIER();
            if (t4 < 64) { const float gl = gs[128 + 63], gc = gs[128 + t4]; gs[192 + t4] = __expf(gc); gs[256 + t4] = __expf(gl - gc); }
            {
                const int c = lane & 15, gq = lane >> 4;
                f32x4 kk[4], qk[4];
#pragma unroll
                for (int jb = 0; jb < 4; ++jb) { kk[jb] = (f32x4){0.f, 0.f, 0.f, 0.f}; qk[jb] = (f32x4){0.f, 0.f, 0.f, 0.f}; }
#pragma unroll
                for (int ks = 0; ks < 4; ++ks) {
                    const bf16x8 aK = *(const LAS bf16x8*)(Ks + (16 * wq + c) * 136 + 32 * ks + 8 * gq), aQ = *(const LAS bf16x8*)(Qs + (16 * wq + c) * 136 + 32 * ks + 8 * gq);
#pragma unroll
                    for (int jb = 0; jb < 4; ++jb) { const bf16x8 bK = *(const LAS bf16x8*)(Ks + (16 * jb + c) * 136 + 32 * ks + 8 * gq);
                        kk[jb] = __builtin_amdgcn_mfma_f32_16x16x32_bf16(aK, bK, kk[jb], 0, 0, 0); qk[jb] = __builtin_amdgcn_mfma_f32_16x16x32_bf16(aQ, bK, qk[jb], 0, 0, 0); }
                }
#pragma unroll
                for (int reg = 0; reg < 4; ++reg) { const int row = 16 * wq + 4 * gq + reg; const float gi = gs[128 + row], bi = gs[64 + row];
#pragma unroll
                    for (int jb = 0; jb < 4; ++jb) { const int col = 16 * jb + c; const float dec = (row >= col) ? __expf(gi - gs[128 + col]) : 0.f;
                        Ls[row * 68 + col] = (row > col) ? -(bi * kk[jb][reg] * dec) : 0.f;
                        IMG[tix(row, col, 4)] = (bf16)f2bf(qk[jb][reg] * dec); } }
            }
#pragma unroll 1
            for (int it = 0; it < 4; ++it) { const int sl = t4 + 256 * it, fr_ = sl >> 6, lp = sl & 63, hh = lp >> 5, r = lp & 31;
                {   const int rt = fr_ >> 3, s = fr_ & 7, row = 32 * rt + r, k0 = 16 * s + 4 * hh; const float eg = __expf(gs[128 + row]);
                    const v2u q0 = *(const LAS v2u*)(Qs + row * 136 + k0), q1 = *(const LAS v2u*)(Qs + row * 136 + k0 + 8);
                    v4u o; o.x = pk2(bflo(q0.x) * eg, bfhi(q0.x) * eg); o.y = pk2(bflo(q0.y) * eg, bfhi(q0.y) * eg); o.z = pk2(bflo(q1.x) * eg, bfhi(q1.x) * eg); o.w = pk2(bflo(q1.y) * eg, bfhi(q1.y) * eg);
                    *(v4u*)(pQ + sl * 8) = o; }
                {   const int rt = fr_ >> 2, s = fr_ & 3, dk = 32 * rt + r, i0 = 16 * s + 4 * hh; float kv[8]; const float gl_ = gs[128 + 63];
#pragma unroll
                    for (int e = 0; e < 4; ++e) { kv[e] = bf2f(Ks[(i0 + e) * 136 + dk]) * __expf(gl_ - gs[128 + i0 + e]); kv[4 + e] = bf2f(Ks[(i0 + 8 + e) * 136 + dk]) * __expf(gl_ - gs[128 + i0 + 8 + e]); }
                    v4u o; o.x = pk2(kv[0], kv[1]); o.y = pk2(kv[2], kv[3]); o.z = pk2(kv[4], kv[5]); o.w = pk2(kv[6], kv[7]);
                    *(v4u*)(pKT + sl * 8) = o; } }
            if (t4 == 0) pS[128] = __expf(gs[128 + 63]);
            LDS_BARRIER();
#pragma unroll
            for (int i = 0; i < 2; ++i) { const int idx = t4 + 256 * i; *(v4u*)(pA + idx * 8) = *(const LAS v4u*)(IMG + idx * 8); }
            {
                if (t4 < 128) {
#pragma unroll
                    for (int i = 0; i < 64; ++i) x[i] *= gs[64 + i];
                } else {
#pragma unroll
                    for (int i = 0; i < 64; ++i) x[i] = gs[64 + i] * bf2f(Ks[i * 136 + (t4 - 128)]) * gs[192 + i];
                }
                SolveRows<60>::run(x, Ls, lane & 15);
            }
            LDS_BARRIER();
            if (t4 < 128) { const int w = t4 >> 5, c = t4 & 31;
#pragma unroll
                for (int i = 0; i < 64; ++i) { const int rt = i >> 5, i32 = i & 31, hh = (i32 >> 2) & 1, reg = (i32 & 3) + 4 * (i32 >> 3); UWI[(((w * 2 + rt) * 64 + hh * 32 + c) << 4) + reg] = (bf16)f2bf(x[i]); }
            } else { const int dk = t4 - 128;
#pragma unroll
                for (int i = 0; i < 64; ++i) UWI[8192 + tix(i, dk, 8)] = (bf16)f2bf(-x[i]);
            }
            LDS_BARRIER();
#pragma unroll
            for (int i = 0; i < 4; ++i) { const int idx = t4 + 256 * i; *(v4u*)(pU + idx * 8) = *(const LAS v4u*)(UWI + idx * 8); *(v4u*)(pW + idx * 8) = *(const LAS v4u*)(UWI + 8192 + idx * 8); }
        }
        __syncthreads();
    }
    SEAM(PH_DNA);
    if (IN(PH_DN)) {
        if ((int)blockIdx.x < NB * NH) { if (!(args.flags & 1)) {
            const int bh = (int)blockIdx.x, b = bh >> 3, hh = bh & 7; const size_t tokb = (size_t)b * SEQ;
            const unsigned char* pkg0 = PKG + (size_t)bh * 128 * PKG_BYTES; const bf16* ut0 = UT + (size_t)bh * 128 * 8192;
            const bool loader = F.wave >= 4; const int lt = F.tid - 256;
            if (loader) {
                v4u la[19], lb[19];
                constexpr int NCH = STG_BYTES / 16, NPK = PKG_BYTES / 16;
#define DN_LD(dst, pn) do { const int pn_ = (pn) < 127 ? (pn) : 127; const unsigned char* src_ = pkg0 + (size_t)pn_ * PKG_BYTES; const unsigned char* usrc_ = (const unsigned char*)(ut0 + (size_t)pn_ * 8192); _Pragma("unroll") for (int i = 0; i < 19; ++i) { int idx = lt + 256 * i; idx = idx < NCH ? idx : NCH - 1; \
        dst[i] = __builtin_nontemporal_load((const v4u*)((idx < NPK) ? (src_ + (size_t)idx * 16) : (usrc_ + (size_t)(idx - NPK) * 16))); } } while (0)
#define DN_ST(srcr, stg) do { _Pragma("unroll") for (int i = 0; i < 19; ++i) { const int idx = lt + 256 * i; if (idx < NCH) *(LAS v4u*)(F.lds + RING_OFF + (stg) * STG_BYTES + idx * 16) = srcr[i]; } } while (0)
                DN_LD(la, 0); DN_ST(la, 0); DN_LD(la, 1); DN_LD(lb, 2);
                for (int n = 0; n < 128; n += 2) {
                    LDS_BARRIER();
                    DN_ST(la, 1); DN_LD(la, n + 3);
                    LDS_BARRIER();
                    DN_ST(lb, 0); DN_LD(lb, n + 4);
                }
#undef DN_LD
#undef DN_ST
            } else {
            const int w = F.wave & 3, r = lane & 31, h2 = lane >> 5;
            f32x16 S[4]; bf16x8 Sb[8];
#pragma unroll
            for (int d = 0; d < 4; ++d)
#pragma unroll
                for (int i = 0; i < 16; ++i) S[d][i] = 0.f;
#pragma unroll
            for (int s = 0; s < 8; ++s)
#pragma unroll
                for (int i = 0; i < 8; ++i) Sb[s][i] = 0;
            for (int n = 0; n < 128; ++n) {
                LDS_BARRIER();
                {
                    LAS unsigned char* st = F.lds + RING_OFF + (n & 1) * STG_BYTES;
                    const LAS float* sc = (const LAS float*)(st + 57344);
#define FRAG(off, f) (*(const LAS bf16x8*)(st + (off) + (f) * 1024 + lane * 16))
#define MF(a, b, c) __builtin_amdgcn_mfma_f32_32x32x16_bf16((a), (b), (c), 0, 0, 0)
#define SB() __builtin_amdgcn_sched_barrier(0)
                    f32x16 vn[2], qs[2];
#pragma unroll
                    for (int rt = 0; rt < 2; ++rt) {
#pragma unroll
                        for (int q = 0; q < 2; ++q) { const v4u u4 = *(const LAS v4u*)(st + PKG_BYTES + (((w * 2 + rt) * 64 + lane) << 5) + q * 16);
                            vn[rt][8 * q + 0] = bflo(u4.x); vn[rt][8 * q + 1] = bfhi(u4.x); vn[rt][8 * q + 2] = bflo(u4.y); vn[rt][8 * q + 3] = bfhi(u4.y);
                            vn[rt][8 * q + 4] = bflo(u4.z); vn[rt][8 * q + 5] = bfhi(u4.z); vn[rt][8 * q + 6] = bflo(u4.w); vn[rt][8 * q + 7] = bfhi(u4.w); }
#pragma unroll
                        for (int i = 0; i < 16; ++i) qs[rt][i] = 0.f; }
                    bf16x8 fa[4], fb[4];
                    fa[0] = FRAG(0, 0); fa[1] = FRAG(0, 8); fa[2] = FRAG(16384, 0); fa[3] = FRAG(16384, 8);
                    fb[0] = FRAG(0, 1); fb[1] = FRAG(0, 9); fb[2] = FRAG(16384, 1); fb[3] = FRAG(16384, 9);
                    SB();
#pragma unroll
                    for (int s = 0; s < 8; s += 2) {
                        vn[0] = MF(fa[0], Sb[s], vn[0]); vn[1] = MF(fa[1], Sb[s], vn[1]); qs[0] = MF(fa[2], Sb[s], qs[0]); qs[1] = MF(fa[3], Sb[s], qs[1]);
                        SB();
                        if (s + 2 < 8) { fa[0] = FRAG(0, s + 2); fa[1] = FRAG(0, 8 + s + 2); fa[2] = FRAG(16384, s + 2); fa[3] = FRAG(16384, 8 + s + 2); }
                        SB();
                        vn[0] = MF(fb[0], Sb[s + 1], vn[0]); vn[1] = MF(fb[1], Sb[s + 1], vn[1]); qs[0] = MF(fb[2], Sb[s + 1], qs[0]); qs[1] = MF(fb[3], Sb[s + 1], qs[1]);
                        SB();
                        if (s + 3 < 8) { fb[0] = FRAG(0, s + 3); fb[1] = FRAG(0, 8 + s + 3); fb[2] = FRAG(16384, s + 3); fb[3] = FRAG(16384, 8 + s + 3); }
                        SB();
                    }
                    bf16x8 ga[6], gb[6];
#define LD6(dst, sp) do { dst[0] = FRAG(32768, sp); dst[1] = FRAG(32768, 4 + (sp)); dst[2] = FRAG(40960, sp); dst[3] = FRAG(40960, 4 + (sp)); dst[4] = FRAG(40960, 8 + (sp)); dst[5] = FRAG(40960, 12 + (sp)); } while (0)
                    LD6(ga, 0); LD6(gb, 1);
                    const float egl = sc[128];
                    SB();
                    bf16x8 vb[4];
#pragma unroll
                    for (int sp = 0; sp < 4; ++sp) { const int rt = sp >> 1, base = 8 * (sp & 1); unsigned pv[4];
#pragma unroll
                        for (int jj = 0; jj < 4; ++jj) pv[jj] = pk2(vn[rt][base + 2 * jj], vn[rt][base + 2 * jj + 1]);
                        vb[sp] = __builtin_bit_cast(bf16x8, (v4u){pv[0], pv[1], pv[2], pv[3]}); }
#pragma unroll
                    for (int d = 0; d < 4; ++d)
#pragma unroll
                        for (int i = 0; i < 16; ++i) S[d][i] *= egl;
                    SB();
#pragma unroll
                    for (int sp = 0; sp < 4; sp += 2) {
                        qs[0] = MF(ga[0], vb[sp], qs[0]); qs[1] = MF(ga[1], vb[sp], qs[1]); S[0] = MF(ga[2], vb[sp], S[0]); S[1] = MF(ga[3], vb[sp], S[1]); S[2] = MF(ga[4], vb[sp], S[2]); S[3] = MF(ga[5], vb[sp], S[3]);
                        SB();
                        if (sp + 2 < 4) LD6(ga, sp + 2);
                        SB();
                        qs[0] = MF(gb[0], vb[sp + 1], qs[0]); qs[1] = MF(gb[1], vb[sp + 1], qs[1]); S[0] = MF(gb[2], vb[sp + 1], S[0]); S[1] = MF(gb[3], vb[sp + 1], S[1]); S[2] = MF(gb[4], vb[sp + 1], S[2]); S[3] = MF(gb[5], vb[sp + 1], S[3]);
                        SB();
                        if (sp + 3 < 4) LD6(gb, sp + 3);
                        SB();
                    }
#undef LD6
#undef FRAG
#undef MF
#undef SB
#pragma unroll
                    for (int s = 0; s < 8; ++s) { const int d = s >> 1, base = 8 * (s & 1); unsigned pv[4];
#pragma unroll
                        for (int jj = 0; jj < 4; ++jj) pv[jj] = pk2(S[d][base + 2 * jj], S[d][base + 2 * jj + 1]);
                        Sb[s] = __builtin_bit_cast(bf16x8, (v4u){pv[0], pv[1], pv[2], pv[3]}); }
                    {
                        LAS bf16* ot = (LAS bf16*)(F.lds + OT_OFF + w * 2048);
                        bf16* ob = OB + (tokb + (size_t)n * 64 + (lane >> 1)) * D_Z + hh * 128 + 32 * w + 16 * (lane & 1);
#pragma unroll
                        for (int rt = 0; rt < 2; ++rt) {
#pragma unroll
                            for (int rp = 0; rp < 8; ++rp) { const int reg = 2 * rp, row = (reg & 3) + 8 * (reg >> 2) + 4 * h2; const unsigned pv = pk2(qs[rt][reg], qs[rt][reg + 1]);
                                ot[row * 32 + r] = (bf16)(pv & 0xffffu); ot[(row + 1) * 32 + r] = (bf16)(pv >> 16); }
                            asm volatile("s_waitcnt lgkmcnt(0)" ::: "memory");
                            const v4u o0 = *(const LAS v4u*)(ot + (lane >> 1) * 32 + 16 * (lane & 1)), o1 = *(const LAS v4u*)(ot + (lane >> 1) * 32 + 16 * (lane & 1) + 8);
                            asm volatile("s_waitcnt lgkmcnt(0)" ::: "memory");
                            *(v4u*)(ob + (size_t)(32 * rt) * D_Z) = o0; *(v4u*)(ob + (size_t)(32 * rt) * D_Z + 8) = o1; } }
                }
            }
            }
        } } else if (!(args.flags & 2)) {
            pg8::DenseOrder S; S.init(T, D, D_POOL, F.G - NB * NH, (int)blockIdx.x - NB * NH); EpiPool E{GP, MP};
            pg8::gemm_phase<EpiPool, pg8::DenseOrder, false>(F.lds + RING_OFF, DBUF, WCOMB, D_POOL, S, E);
            __syncthreads();
            LAS float* scr = (LAS float*)(F.lds + RING_OFF + F.wave * 16384);
            const int gw2 = ((int)blockIdx.x - NB * NH) * NWAVES + F.wave, NGW2 = (F.G - NB * NH) * NWAVES;
        {
            const int items = NE * (D / 64) * 32;
            for (int it = gw2; it < items; it += NGW2) { const int e = it / (32 * 32), rem = it % (32 * 32), kb = rem / 32, nb = rem % 32;
                const int r0 = 32 * nb, pn = r0 >> 8, rin = r0 & 255; const bool up = rin >= 128; const int c0 = pn * 128 + (rin & 127);
                transpose_item((up ? F.in[I_W_UP] : F.in[I_W_GATE]) + (size_t)e * D * DE, DE, D, 64 * kb, c0, 32, WGU + (size_t)e * 1024 * D, r0, scr, lane); }
        }
        {
            const int per = (DE / 64) * (D / 32), items = NE * per;
            for (int it = gw2; it < items; it += NGW2) { const int e = it / per, rem = it % per, kb = rem / (D / 32), nb = rem % (D / 32);
                transpose_item(F.in[I_W_DOWN] + (size_t)e * DE * D, D, DE, 64 * kb, 32 * nb, 32, WDN + (size_t)e * D * DE, 32 * nb, scr, lane); }
        }
        }
        __syncthreads();
    }
    SEAM(PH_DN);
    if (IN(PH_YDN)) {
        bf16* YDN = N1; const float* dn = F.in[I_DN_NORM];
        for (int it = gw; it < T * NH; it += NGW) { const int t = it / NH, h = it % NH; const size_t off = (size_t)t * D_Z + h * 128 + 2 * lane;
            const unsigned ou = *(const unsigned*)(OB + off); const float o0 = bflo(ou), o1 = bfhi(ou); const float r = 1.0f / sqrtf(wave_sum(o0 * o0 + o1 * o1) * (1.f / 128.f) + EPS);
            const unsigned zu = *(const unsigned*)(ZS + off); *(unsigned*)(YDN + off) = pk2(o0 * r * dn[2 * lane] * bflo(zu), o1 * r * dn[2 * lane + 1] * bfhi(zu)); }
    }
    SEAM(PH_YDN);
    if (IN(PH_MERGE)) { pg8::DenseOrder S; S.init(T, D, D_Z, F.G, (int)blockIdx.x); EpiMerge E{GD, MP, MERGED}; pg8::gemm_phase<EpiMerge, pg8::DenseOrder, false>(F.lds + RING_OFF, N1, WUPDN, D_Z, S, E); }
    SEAM(PH_MERGE);
    if (IN(PH_OUT)) { pg8::DenseOrder S; S.init(T, D, D, F.G, (int)blockIdx.x); EpiResid E{F.in[I_X], H}; pg8::gemm_phase<EpiResid, pg8::DenseOrder, false>(F.lds + RING_OFF, MERGED, WOUT, D, S, E); }
    SEAM(PH_OUT);
    if (IN(PH_ROUTE)) {
        const float* gain = F.in[I_NORM_MOE];
        LAS float* LGp = (LAS float*)(F.lds + RING_OFF);
        LAS float* LGs = LGp + 8 * 768;
        LAS float* SSp = LGs + 768;
        LAS float* RS = SSp + 128;
        LAS unsigned* LCNT = (LAS unsigned*)(RS + 16);
        LAS int* ENT = (LAS int*)(LCNT + 64);
        if (F.tid < 64) LCNT[F.tid] = 0u;
        int ntok = 0;
        __syncthreads();
        const int row = lane & 15, g = lane >> 4, wv = F.wave;
        const bf16* wph = WRH + (size_t)row * D + 256 * wv + 8 * g;
#define RT_LOAD(dst, tsk) do { const float* hp_ = H + (size_t)((tsk) * 16 + row) * D + 256 * wv + 8 * g; _Pragma("unroll") for (int J = 0; J < 8; ++J) { dst[J][0] = *(const f32x4*)(hp_ + 32 * J); dst[J][1] = *(const f32x4*)(hp_ + 32 * J + 4); } } while (0)
#define RT_BODY(a, an, task, ntask) do { \
            const int r0 = (task) * 16; \
            f32x4 acc0 = (f32x4){0.f, 0.f, 0.f, 0.f}, acc1 = acc0, acc2 = acc0; float ss = 0.f; \
            _Pragma("unroll") for (int J = 0; J < 8; ++J) { \
                const f32x4 x0 = a[J][0], x1 = a[J][1]; \
                ss += ((x0.x * x0.x + x0.y * x0.y) + (x0.z * x0.z + x0.w * x0.w)) + ((x1.x * x1.x + x1.y * x1.y) + (x1.z * x1.z + x1.w * x1.w)); \
                const unsigned h0 = pk2(x0.x, x0.y), h1 = pk2(x0.z, x0.w), h2_ = pk2(x1.x, x1.y), h3 = pk2(x1.z, x1.w); \
                const unsigned l0 = pk2(x0.x - bflo(h0), x0.y - bfhi(h0)), l1 = pk2(x0.z - bflo(h1), x0.w - bfhi(h1)), l2 = pk2(x1.x - bflo(h2_), x1.y - bfhi(h2_)), l3 = pk2(x1.z - bflo(h3), x1.w - bfhi(h3)); \
                const bf16x8 ah = __builtin_bit_cast(bf16x8, (v4u){h0, h1, h2_, h3}), al = __builtin_bit_cast(bf16x8, (v4u){l0, l1, l2, l3}); \
                acc0 = __builtin_amdgcn_mfma_f32_16x16x32_bf16(ah, wb[J][0], acc0, 0, 0, 0); acc1 = __builtin_amdgcn_mfma_f32_16x16x32_bf16(ah, wb[J][1], acc1, 0, 0, 0); acc2 = __builtin_amdgcn_mfma_f32_16x16x32_bf16(ah, wb[J][2], acc2, 0, 0, 0); \
                acc0 = __builtin_amdgcn_mfma_f32_16x16x32_bf16(al, wb[J][0], acc0, 0, 0, 0); acc1 = __builtin_amdgcn_mfma_f32_16x16x32_bf16(al, wb[J][1], acc1, 0, 0, 0); acc2 = __builtin_amdgcn_mfma_f32_16x16x32_bf16(al, wb[J][2], acc2, 0, 0, 0); } \
            ss += __shfl_xor(ss, 16); ss += __shfl_xor(ss, 32); \
            LDS_BARRIER(); \
            _Pragma("unroll") for (int reg = 0; reg < 4; ++reg) { LAS float* q = LGp + wv * 768 + (4 * g + reg) * 48 + row; q[0] = acc0[reg]; q[16] = acc1[reg]; q[32] = acc2[reg]; } \
            if (g == 0) SSp[wv * 16 + row] = ss; \
            LDS_BARRIER(); \
            for (int e = F.tid; e < 768; e += NTHR) { float s8 = 0.f; _Pragma("unroll") for (int w8 = 0; w8 < 8; ++w8) s8 += LGp[w8 * 768 + e]; LGs[e] = s8; } \
            if (F.tid < 16) { float s8 = 0.f; _Pragma("unroll") for (int w8 = 0; w8 < 8; ++w8) s8 += SSp[w8 * 16 + F.tid]; RS[F.tid] = 1.0f / sqrtf(s8 * (1.f / D) + EPS); } \
            LDS_BARRIER(); \
            if (F.tid < 16) route_row(F, LGs + F.tid * 48, RS[F.tid], r0 + F.tid, LCNT, ENT, 2 * (ntok + F.tid)); ntok += 16; \
            { const float rs = RS[row]; bf16* op = N1 + (size_t)(r0 + row) * D + 256 * wv + 8 * g; const float* gp = gain + 256 * wv + 8 * g; \
              _Pragma("unroll") for (int J = 0; J < 8; ++J) { const f32x4 g0 = *(const f32x4*)(gp + 32 * J), g1 = *(const f32x4*)(gp + 32 * J + 4); const f32x4 x0 = a[J][0], x1 = a[J][1]; \
                v4u o; o.x = pk2(x0.x * rs * g0.x, x0.y * rs * g0.y); o.y = pk2(x0.z * rs * g0.z, x0.w * rs * g0.w); o.z = pk2(x1.x * rs * g1.x, x1.y * rs * g1.y); o.w = pk2(x1.z * rs * g1.z, x1.w * rs * g1.w); \
                *(v4u*)(op + 32 * J) = o; } } } while (0)
        f32x4 ra[8][2];
        bf16x8 wb[8][3];
#pragma unroll
        for (int J = 0; J < 8; ++J)
#pragma unroll
            for (int t3 = 0; t3 < 3; ++t3) wb[J][t3] = *(const bf16x8*)(wph + 16 * t3 * D + 32 * J);
        for (int task = F.vcu; task < T / 16; task += F.G) { RT_LOAD(ra, task); RT_BODY(ra, ra, task, 0); }
#undef RT_LOAD
#undef RT_BODY
        __syncthreads();
        if (F.tid < NE) LCNT[32 + F.tid] = atomicAdd(&F.ctl[CW_CNT + 64 * F.tid], LCNT[F.tid]);
        __syncthreads();
        for (int i = F.tid; i < 2 * ntok; i += NTHR) { const int es = ENT[4 * i], e = es >> 16, slot = (int)LCNT[32 + e] + (es & 0xffff); LTK[(size_t)e * T + slot] = ENT[4 * i + 1]; LW[(size_t)e * T + slot] = __int_as_float(ENT[4 * i + 2]); }
        __syncthreads();
    }
    SEAM(PH_ROUTE);
    if (IN(PH_MOE1)) {
        LAS int* pre = (LAS int*)(F.lds + MISC_OFF + 256); LAS int* base = pre + 40;
        moe_tables<256>(F, pre, base);
        MoeSched<256, true> S{pre, base, LTK, 4, F.G, F.vcu, D, 1024};
        EpiMoe1 E{HMID}; pg8::gemm_phase<EpiMoe1, MoeSched<256, true>, true>(F.lds + RING_OFF, N1, WGU, D, S, E);
    }
    SEAM(PH_MOE1);
    if (IN(PH_MOE2)) {
        LAS int* pre = (LAS int*)(F.lds + MISC_OFF + 256); LAS int* base = pre + 40;
        moe_tables<256>(F, pre, base);
        MoeSched<256, false> S{pre, base, LTK, 8, F.G, F.vcu, DE, D};
        EpiMoe2 E{LTK, LW, Y0, Y1}; pg8::gemm_phase<EpiMoe2, MoeSched<256, false>, false>(F.lds + RING_OFF, HMID, WDN, DE, S, E);
    }
    SEAM(PH_MOE2);
    if (IN(PH_N3)) {
        const float* gain = F.in[I_NORM_PLE];
        for (int t = gw; t < T; t += NGW) {
            f32x4* hr = (f32x4*)(H + (size_t)t * D) + lane; const f32x4* gr = (const f32x4*)gain + lane;
            const v2u* y0r = (const v2u*)(Y0 + (size_t)t * D) + lane; const v2u* y1r = (const v2u*)(Y1 + (size_t)t * D) + lane;
            f32x4 v[8]; float s = 0.f;
#pragma unroll
            for (int j = 0; j < 8; ++j) { const v2u a = y0r[64 * j], b = y1r[64 * j]; f32x4 x = hr[64 * j];
                x.x += bflo(a.x) + bflo(b.x); x.y += bfhi(a.x) + bfhi(b.x); x.z += bflo(a.y) + bflo(b.y); x.w += bfhi(a.y) + bfhi(b.y);
                v[j] = x; hr[64 * j] = x; s += (x.x * x.x + x.y * x.y) + (x.z * x.z + x.w * x.w); }
            const float rstd = 1.0f / sqrtf(wave_sum(s) * (1.f / D) + EPS);
            v2u* o8 = (v2u*)(N1 + (size_t)t * D) + lane;
#pragma unroll
            for (int j = 0; j < 8; ++j) { const f32x4 g = gr[64 * j]; v2u o; o.x = pk2(v[j].x * rstd * g.x, v[j].y * rstd * g.y); o.y = pk2(v[j].z * rstd * g.z, v[j].w * rstd * g.w); o8[64 * j] = o; }
        }
    }
    SEAM(PH_N3);
    if (IN(PH_PP)) { pg8::DenseOrder S; S.init(T, D, D_PLE, F.G, (int)blockIdx.x); EpiBf16Plain E{PP}; pg8::gemm_phase<EpiBf16Plain, pg8::DenseOrder, false>(F.lds + RING_OFF, PBF, WPLEP, D_PLE, S, E); }
    SEAM(PH_PP);
    if (IN(PH_PLE)) { pg8::DenseOrder S; S.init(T, D, D, F.G, (int)blockIdx.x); EpiPle E{PP, H}; pg8::gemm_phase<EpiPle, pg8::DenseOrder, false>(F.lds + RING_OFF, N1, WPLEG, D, S, E); }
    SEAM(PH_PLE);
    if (IN(PH_FINAL)) {
        const float* gain = F.in[I_NORM_FINAL];
        for (int t = gw; t < T; t += NGW) {
            f32x4* hr = (f32x4*)(H + (size_t)t * D) + lane; const f32x4* gr = (const f32x4*)gain + lane;
            f32x4 v[8]; float s = 0.f;
#pragma unroll
            for (int j = 0; j < 8; ++j) { v[j] = hr[64 * j]; s += (v[j].x * v[j].x + v[j].y * v[j].y) + (v[j].z * v[j].z + v[j].w * v[j].w); }
            const float rstd = 1.0f / sqrtf(wave_sum(s) * (1.f / D) + EPS);
#pragma unroll
            for (int j = 0; j < 8; ++j) { const f32x4 g = gr[64 * j]; hr[64 * j] = v[j] * rstd * g; }
        }
    }
#undef IN
#undef SEAM
}

extern "C" void kernel_launch(void* const* d_in, const int* in_sizes, int n_in, void* d_out, int out_size, void* d_ws, size_t ws_size, hipStream_t stream) {
    static int grid = 0;
    if (grid == 0) {
        if (n_in != 25 || in_sizes[0] != T * D || out_size != T * D || ws_size < WS_END) { fprintf(stderr, "kernel_launch: unexpected shapes (n_in %d, in0 %d, out %d, ws %zu); nothing launched\n", n_in, n_in > 0 ? in_sizes[0] : -1, out_size, ws_size); grid = -1; return; }
        int dev = 0, cus = 0, per_cu = 0;
        if (hipGetDevice(&dev) != hipSuccess || hipDeviceGetAttribute(&cus, hipDeviceAttributeMultiprocessorCount, dev) != hipSuccess) { grid = -1; return; }
        if (hipFuncSetAttribute((const void*)fwd, hipFuncAttributeMaxDynamicSharedMemorySize, LDS_BYTES) != hipSuccess) { fprintf(stderr, "kernel_launch: hipFuncSetAttribute failed\n"); grid = -1; return; }
        if (hipOccupancyMaxActiveBlocksPerMultiprocessor(&per_cu, (const void*)fwd, NTHR, LDS_BYTES) != hipSuccess || per_cu < 1) fprintf(stderr, "kernel_launch: occupancy query reports %d\n", per_cu);
        (void)hipGetLastError();
        grid = cus;
    }
    if (grid < 0) return;
    (void)hipMemsetAsync((char*)d_ws + WS_CTL, 0, CTL_ZERO_BYTES, stream);
    Args a{};
    for (int i = 0; i < 25; ++i) a.in[i] = (const float*)d_in[i];
    a.out = (float*)d_out; a.ws = (unsigned char*)d_ws;
    if (MK_N_LAUNCHES == 1) { a.ph_lo = 0; a.ph_hi = NPHASE; hipLaunchKernelGGL(fwd, dim3(grid), dim3(NTHR), LDS_BYTES, stream, a); }
    else for (int k = 0; k < NPHASE; ++k) { a.ph_lo = k; a.ph_hi = k + 1; hipLaunchKernelGGL(fwd, dim3(grid), dim3(NTHR), LDS_BYTES, stream, a); }
}
```

```cpp
#include <hip/hip_runtime.h>
#include <cstdio>
#include <cstdint>

#ifndef MK_N_LAUNCHES
#define MK_N_LAUNCHES 1
#endif

#define GAS __attribute__((address_space(1)))
#define LAS __attribute__((address_space(3)))
typedef unsigned short bf16;
typedef unsigned v4u __attribute__((ext_vector_type(4)));
typedef unsigned v2u __attribute__((ext_vector_type(2)));
typedef float f32x4 __attribute__((ext_vector_type(4)));
typedef float f32x16 __attribute__((ext_vector_type(16)));
typedef short bf16x8 __attribute__((ext_vector_type(8)));

constexpr int NB = 4, SEQ = 8192, T = NB * SEQ, D = 2048;
constexpr int D_PLE = 256, D_POOL = 1024, POOL_GW = 256, NH = 8, DK = 128, D_QKV = 3072, D_Z = 1024;
constexpr int D_IN = 9232, N_IN_PAD = 9216;
constexpr int NE = 32, EPG = 8, NGRP = 4, DE = 512;
constexpr float EPS = 1e-6f;
constexpr int NWAVES = 8, NTHR = 512;
constexpr int DN_UNITS = NB * NH * (SEQ / 64);
constexpr int STG_BYTES = 50176;
constexpr int SL_KT = 16384, SL_SC = 32768, SL_U = 33792;
constexpr int PKG_BYTES = 58368;

constexpr size_t MiB = 1u << 20;
constexpr size_t WS_CTL = 0, CTL_ZERO_BYTES = 65536;
constexpr size_t WS_WRT = 512 * 1024;
constexpr size_t WS_WIN = 1 * MiB;
constexpr size_t WS_WCOMB = 38 * MiB;
constexpr size_t WS_WUPDN = 42 * MiB;
constexpr size_t WS_WOUT = 46 * MiB;
constexpr size_t WS_WPLEG = 54 * MiB;
constexpr size_t WS_WPLEP = 62 * MiB;
constexpr size_t WS_WGU = 63 * MiB;
constexpr size_t WS_WDN = 191 * MiB;
constexpr size_t WS_BA = 255 * MiB;
constexpr size_t WS_G = 257 * MiB;
constexpr size_t WS_BETA = 258 * MiB;
constexpr size_t WS_LTK = 259 * MiB;
constexpr size_t WS_LW = 263 * MiB;
constexpr size_t WS_PBF = 267 * MiB;
constexpr size_t WS_N1 = 283 * MiB;
constexpr size_t WS_PKG = 283 * MiB;
constexpr size_t WS_UT = 511 * MiB;
constexpr size_t WS_SSTB = 575 * MiB;
constexpr size_t WS_QKV = 411 * MiB;
constexpr size_t WS_MP = 539 * MiB;
constexpr size_t WS_H16 = 539 * MiB;
constexpr size_t WS_UPOOL = 603 * MiB;
constexpr size_t WS_Z = 667 * MiB;
constexpr size_t WS_GP = 731 * MiB;
constexpr size_t WS_GD = 859 * MiB;
constexpr size_t WS_END = 987 * MiB;
constexpr size_t OUT_D = 0, OUT_QKV2 = 64 * MiB;
constexpr int CW_CNT = 1024;
constexpr int CW_TR = 3584;
constexpr int CW_BAR = 4096;

constexpr int RING_OFF = 0, RING_BYTES = 153600;
constexpr int MISC_OFF = RING_BYTES;
constexpr int MISC_WORDS = 256;
constexpr int OT_OFF = 154624;
constexpr int LDS_BYTES = 162816;

#define LDS_WAIT() asm volatile("s_waitcnt lgkmcnt(0)" ::: "memory")
#define VM_WAIT() asm volatile("s_waitcnt vmcnt(0)" ::: "memory")
#define LDS_BARRIER() do { asm volatile("s_waitcnt lgkmcnt(0)" ::: "memory"); __builtin_amdgcn_s_barrier(); asm volatile("" ::: "memory"); } while (0)
__device__ __forceinline__ float bflo(unsigned u) { return __uint_as_float(u << 16); }
__device__ __forceinline__ float bfhi(unsigned u) { return __uint_as_float(u & 0xffff0000u); }
__device__ __forceinline__ float bf2f(bf16 b) { return __uint_as_float((unsigned)b << 16); }
__device__ __forceinline__ unsigned f2bf(float f) { unsigned u = __float_as_uint(f); return (u + 0x7fffu + ((u >> 16) & 1u)) >> 16; }
typedef __bf16 bf16x2_t __attribute__((ext_vector_type(2)));
typedef float f32x2_t __attribute__((ext_vector_type(2)));
__device__ __forceinline__ unsigned pk2(float lo, float hi) { const f32x2_t v = {lo, hi}; const bf16x2_t b = __builtin_convertvector(v, bf16x2_t); return __builtin_bit_cast(unsigned, b); }
__device__ __forceinline__ float wave_sum(float v) {
#pragma unroll
    for (int o = 1; o < 64; o <<= 1) v += __shfl_xor(v, o);
    return v;
}
__device__ __forceinline__ float sigmoidf_(float x) { return __builtin_amdgcn_rcpf(1.0f + __builtin_amdgcn_exp2f(-1.4426950408889634f * x)); }
__device__ __forceinline__ float siluf_(float x) { return x * __builtin_amdgcn_rcpf(1.0f + __builtin_amdgcn_exp2f(-1.4426950408889634f * x)); }
__device__ __forceinline__ void store8bf(bf16* p, const float* v) {
    v4u o; o.x = pk2(v[0], v[1]); o.y = pk2(v[2], v[3]); o.z = pk2(v[4], v[5]); o.w = pk2(v[6], v[7]); *(v4u*)p = o;
}
__device__ __forceinline__ void load8bf(const bf16* p, float* v) {
    const v4u o = *(const v4u*)p; v[0] = bflo(o.x); v[1] = bfhi(o.x); v[2] = bflo(o.y); v[3] = bfhi(o.y); v[4] = bflo(o.z); v[5] = bfhi(o.z); v[6] = bflo(o.w); v[7] = bfhi(o.w);
}

__device__ __forceinline__ int tix(int row, int k, int kd16) { const int k16 = k & 15; return ((((row >> 5) * kd16 + (k >> 4)) * 64 + ((k16 >> 2) & 1) * 32 + (row & 31)) << 3) + (k16 & 3) + ((k16 >> 3) << 2); }


template <int J> __device__ __forceinline__ void fmac_bcast(float& acc, float l, float x) {
    asm volatile("v_fmac_f32_dpp %0, %1, %2 row_newbcast:%3 row_mask:0xf bank_mask:0xf" : "+v"(acc) : "v"(l), "v"(x), "n"(J));
}
template <int N> struct FmacChunk;
template <> struct FmacChunk<1> {
    static __device__ __forceinline__ void run(float& acc, float l, float x0) {
        asm volatile("v_fmac_f32_dpp %0, %1, %2 row_newbcast:0 row_mask:0xf bank_mask:0xf\n\t" : "+v"(acc) : "v"(l), "v"(x0));
    }
};
template <> struct FmacChunk<2> {
    static __device__ __forceinline__ void run(float& acc, float l, float x0, float x1) {
        asm volatile("v_fmac_f32_dpp %0, %1, %2 row_newbcast:0 row_mask:0xf bank_mask:0xf\n\t" "v_fmac_f32_dpp %0, %1, %3 row_newbcast:1 row_mask:0xf bank_mask:0xf\n\t" : "+v"(acc) : "v"(l), "v"(x0), "v"(x1));
    }
};
template <> struct FmacChunk<3> {
    static __device__ __forceinline__ void run(float& acc, float l, float x0, float x1, float x2) {
        asm volatile("v_fmac_f32_dpp %0, %1, %2 row_newbcast:0 row_mask:0xf bank_mask:0xf\n\t" "v_fmac_f32_dpp %0, %1, %3 row_newbcast:1 row_mask:0xf bank_mask:0xf\n\t" "v_fmac_f32_dpp %0, %1, %4 row_newbcast:2 row_mask:0xf bank_mask:0xf\n\t" : "+v"(acc) : "v"(l), "v"(x0), "v"(x1), "v"(x2));
    }
};
template <> struct FmacChunk<4> {
    static __device__ __forceinline__ void run(float& acc, float l, float x0, float x1, float x2, float x3) {
        asm volatile("v_fmac_f32_dpp %0, %1, %2 row_newbcast:0 row_mask:0xf bank_mask:0xf\n\t" "v_fmac_f32_dpp %0, %1, %3 row_newbcast:1 row_mask:0xf bank_mask:0xf\n\t" "v_fmac_f32_dpp %0, %1, %4 row_newbcast:2 row_mask:0xf bank_mask:0xf\n\t" "v_fmac_f32_dpp %0, %1, %5 row_newbcast:3 row_mask:0xf bank_mask:0xf\n\t" : "+v"(acc) : "v"(l), "v"(x0), "v"(x1), "v"(x2), "v"(x3));
    }
};
template <> struct FmacChunk<5> {
    static __device__ __forceinline__ void run(float& acc, float l, float x0, float x1, float x2, float x3, float x4) {
        asm volatile("v_fmac_f32_dpp %0, %1, %2 row_newbcast:0 row_mask:0xf bank_mask:0xf\n\t" "v_fmac_f32_dpp %0, %1, %3 row_newbcast:1 row_mask:0xf bank_mask:0xf\n\t" "v_fmac_f32_dpp %0, %1, %4 row_newbcast:2 row_mask:0xf bank_mask:0xf\n\t" "v_fmac_f32_dpp %0, %1, %5 row_newbcast:3 row_mask:0xf bank_mask:0xf\n\t" "v_fmac_f32_dpp %0, %1, %6 row_newbcast:4 row_mask:0xf bank_mask:0xf\n\t" : "+v"(acc) : "v"(l), "v"(x0), "v"(x1), "v"(x2), "v"(x3), "v"(x4));
    }
};
template <> struct FmacChunk<6> {
    static __device__ __forceinline__ void run(float& acc, float l, float x0, float x1, float x2, float x3, float x4, float x5) {
        asm volatile("v_fmac_f32_dpp %0, %1, %2 row_newbcast:0 row_mask:0xf bank_mask:0xf\n\t" "v_fmac_f32_dpp %0, %1, %3 row_newbcast:1 row_mask:0xf bank_mask:0xf\n\t" "v_fmac_f32_dpp %0, %1, %4 row_newbcast:2 row_mask:0xf bank_mask:0xf\n\t" "v_fmac_f32_dpp %0, %1, %5 row_newbcast:3 row_mask:0xf bank_mask:0xf\n\t" "v_fmac_f32_dpp %0, %1, %6 row_newbcast:4 row_mask:0xf bank_mask:0xf\n\t" "v_fmac_f32_dpp %0, %1, %7 row_newbcast:5 row_mask:0xf bank_mask:0xf\n\t" : "+v"(acc) : "v"(l), "v"(x0), "v"(x1), "v"(x2), "v"(x3), "v"(x4), "v"(x5));
    }
};
template <> struct FmacChunk<7> {
    static __device__ __forceinline__ void run(float& acc, float l, float x0, float x1, float x2, float x3, float x4, float x5, float x6) {
        asm volatile("v_fmac_f32_dpp %0, %1, %2 row_newbcast:0 row_mask:0xf bank_mask:0xf\n\t" "v_fmac_f32_dpp %0, %1, %3 row_newbcast:1 row_mask:0xf bank_mask:0xf\n\t" "v_fmac_f32_dpp %0, %1, %4 row_newbcast:2 row_mask:0xf bank_mask:0xf\n\t" "v_fmac_f32_dpp %0, %1, %5 row_newbcast:3 row_mask:0xf bank_mask:0xf\n\t" "v_fmac_f32_dpp %0, %1, %6 row_newbcast:4 row_mask:0xf bank_mask:0xf\n\t" "v_fmac_f32_dpp %0, %1, %7 row_newbcast:5 row_mask:0xf bank_mask:0xf\n\t" "v_fmac_f32_dpp %0, %1, %8 row_newbcast:6 row_mask:0xf bank_mask:0xf\n\t" : "+v"(acc) : "v"(l), "v"(x0), "v"(x1), "v"(x2), "v"(x3), "v"(x4), "v"(x5), "v"(x6));
    }
};
template <> struct FmacChunk<8> {
    static __device__ __forceinline__ void run(float& acc, float l, float x0, float x1, float x2, float x3, float x4, float x5, float x6, float x7) {
        asm volatile("v_fmac_f32_dpp %0, %1, %2 row_newbcast:0 row_mask:0xf bank_mask:0xf\n\t" "v_fmac_f32_dpp %0, %1, %3 row_newbcast:1 row_mask:0xf bank_mask:0xf\n\t" "v_fmac_f32_dpp %0, %1, %4 row_newbcast:2 row_mask:0xf bank_mask:0xf\n\t" "v_fmac_f32_dpp %0, %1, %5 row_newbcast:3 row_mask:0xf bank_mask:0xf\n\t" "v_fmac_f32_dpp %0, %1, %6 row_newbcast:4 row_mask:0xf bank_mask:0xf\n\t" "v_fmac_f32_dpp %0, %1, %7 row_newbcast:5 row_mask:0xf bank_mask:0xf\n\t" "v_fmac_f32_dpp %0, %1, %8 row_newbcast:6 row_mask:0xf bank_mask:0xf\n\t" "v_fmac_f32_dpp %0, %1, %9 row_newbcast:7 row_mask:0xf bank_mask:0xf\n\t" : "+v"(acc) : "v"(l), "v"(x0), "v"(x1), "v"(x2), "v"(x3), "v"(x4), "v"(x5), "v"(x6), "v"(x7));
    }
};
template <> struct FmacChunk<9> {
    static __device__ __forceinline__ void run(float& acc, float l, float x0, float x1, float x2, float x3, float x4, float x5, float x6, float x7, float x8) {
        asm volatile("v_fmac_f32_dpp %0, %1, %2 row_newbcast:0 row_mask:0xf bank_mask:0xf\n\t" "v_fmac_f32_dpp %0, %1, %3 row_newbcast:1 row_mask:0xf bank_mask:0xf\n\t" "v_fmac_f32_dpp %0, %1, %4 row_newbcast:2 row_mask:0xf bank_mask:0xf\n\t" "v_fmac_f32_dpp %0, %1, %5 row_newbcast:3 row_mask:0xf bank_mask:0xf\n\t" "v_fmac_f32_dpp %0, %1, %6 row_newbcast:4 row_mask:0xf bank_mask:0xf\n\t" "v_fmac_f32_dpp %0, %1, %7 row_newbcast:5 row_mask:0xf bank_mask:0xf\n\t" "v_fmac_f32_dpp %0, %1, %8 row_newbcast:6 row_mask:0xf bank_mask:0xf\n\t" "v_fmac_f32_dpp %0, %1, %9 row_newbcast:7 row_mask:0xf bank_mask:0xf\n\t" "v_fmac_f32_dpp %0, %1, %10 row_newbcast:8 row_mask:0xf bank_mask:0xf\n\t" : "+v"(acc) : "v"(l), "v"(x0), "v"(x1), "v"(x2), "v"(x3), "v"(x4), "v"(x5), "v"(x6), "v"(x7), "v"(x8));
    }
};
template <> struct FmacChunk<10> {
    static __device__ __forceinline__ void run(float& acc, float l, float x0, float x1, float x2, float x3, float x4, float x5, float x6, float x7, float x8, float x9) {
        asm volatile("v_fmac_f32_dpp %0, %1, %2 row_newbcast:0 row_mask:0xf bank_mask:0xf\n\t" "v_fmac_f32_dpp %0, %1, %3 row_newbcast:1 row_mask:0xf bank_mask:0xf\n\t" "v_fmac_f32_dpp %0, %1, %4 row_newbcast:2 row_mask:0xf bank_mask:0xf\n\t" "v_fmac_f32_dpp %0, %1, %5 row_newbcast:3 row_mask:0xf bank_mask:0xf\n\t" "v_fmac_f32_dpp %0, %1, %6 row_newbcast:4 row_mask:0xf bank_mask:0xf\n\t" "v_fmac_f32_dpp %0, %1, %7 row_newbcast:5 row_mask:0xf bank_mask:0xf\n\t" "v_fmac_f32_dpp %0, %1, %8 row_newbcast:6 row_mask:0xf bank_mask:0xf\n\t" "v_fmac_f32_dpp %0, %1, %9 row_newbcast:7 row_mask:0xf bank_mask:0xf\n\t" "v_fmac_f32_dpp %0, %1, %10 row_newbcast:8 row_mask:0xf bank_mask:0xf\n\t" "v_fmac_f32_dpp %0, %1, %11 row_newbcast:9 row_mask:0xf bank_mask:0xf\n\t" : "+v"(acc) : "v"(l), "v"(x0), "v"(x1), "v"(x2), "v"(x3), "v"(x4), "v"(x5), "v"(x6), "v"(x7), "v"(x8), "v"(x9));
    }
};
template <> struct FmacChunk<11> {
    static __device__ __forceinline__ void run(float& acc, float l, float x0, float x1, float x2, float x3, float x4, float x5, float x6, float x7, float x8, float x9, float x10) {
        asm volatile("v_fmac_f32_dpp %0, %1, %2 row_newbcast:0 row_mask:0xf bank_mask:0xf\n\t" "v_fmac_f32_dpp %0, %1, %3 row_newbcast:1 row_mask:0xf bank_mask:0xf\n\t" "v_fmac_f32_dpp %0, %1, %4 row_newbcast:2 row_mask:0xf bank_mask:0xf\n\t" "v_fmac_f32_dpp %0, %1, %5 row_newbcast:3 row_mask:0xf bank_mask:0xf\n\t" "v_fmac_f32_dpp %0, %1, %6 row_newbcast:4 row_mask:0xf bank_mask:0xf\n\t" "v_fmac_f32_dpp %0, %1, %7 row_newbcast:5 row_mask:0xf bank_mask:0xf\n\t" "v_fmac_f32_dpp %0, %1, %8 row_newbcast:6 row_mask:0xf bank_mask:0xf\n\t" "v_fmac_f32_dpp %0, %1, %9 row_newbcast:7 row_mask:0xf bank_mask:0xf\n\t" "v_fmac_f32_dpp %0, %1, %10 row_newbcast:8 row_mask:0xf bank_mask:0xf\n\t" "v_fmac_f32_dpp %0, %1, %11 row_newbcast:9 row_mask:0xf bank_mask:0xf\n\t" "v_fmac_f32_dpp %0, %1, %12 row_newbcast:10 row_mask:0xf bank_mask:0xf\n\t" : "+v"(acc) : "v"(l), "v"(x0), "v"(x1), "v"(x2), "v"(x3), "v"(x4), "v"(x5), "v"(x6), "v"(x7), "v"(x8), "v"(x9), "v"(x10));
    }
};
template <> struct FmacChunk<12> {
    static __device__ __forceinline__ void run(float& acc, float l, float x0, float x1, float x2, float x3, float x4, float x5, float x6, float x7, float x8, float x9, float x10, float x11) {
        asm volatile("v_fmac_f32_dpp %0, %1, %2 row_newbcast:0 row_mask:0xf bank_mask:0xf\n\t" "v_fmac_f32_dpp %0, %1, %3 row_newbcast:1 row_mask:0xf bank_mask:0xf\n\t" "v_fmac_f32_dpp %0, %1, %4 row_newbcast:2 row_mask:0xf bank_mask:0xf\n\t" "v_fmac_f32_dpp %0, %1, %5 row_newbcast:3 row_mask:0xf bank_mask:0xf\n\t" "v_fmac_f32_dpp %0, %1, %6 row_newbcast:4 row_mask:0xf bank_mask:0xf\n\t" "v_fmac_f32_dpp %0, %1, %7 row_newbcast:5 row_mask:0xf bank_mask:0xf\n\t" "v_fmac_f32_dpp %0, %1, %8 row_newbcast:6 row_mask:0xf bank_mask:0xf\n\t" "v_fmac_f32_dpp %0, %1, %9 row_newbcast:7 row_mask:0xf bank_mask:0xf\n\t" "v_fmac_f32_dpp %0, %1, %10 row_newbcast:8 row_mask:0xf bank_mask:0xf\n\t" "v_fmac_f32_dpp %0, %1, %11 row_newbcast:9 row_mask:0xf bank_mask:0xf\n\t" "v_fmac_f32_dpp %0, %1, %12 row_newbcast:10 row_mask:0xf bank_mask:0xf\n\t" "v_fmac_f32_dpp %0, %1, %13 row_newbcast:11 row_mask:0xf bank_mask:0xf\n\t" : "+v"(acc) : "v"(l), "v"(x0), "v"(x1), "v"(x2), "v"(x3), "v"(x4), "v"(x5), "v"(x6), "v"(x7), "v"(x8), "v"(x9), "v"(x10), "v"(x11));
    }
};
template <> struct FmacChunk<13> {
    static __device__ __forceinline__ void run(float& acc, float l, float x0, float x1, float x2, float x3, float x4, float x5, float x6, float x7, float x8, float x9, float x10, float x11, float x12) {
        asm volatile("v_fmac_f32_dpp %0, %1, %2 row_newbcast:0 row_mask:0xf bank_mask:0xf\n\t" "v_fmac_f32_dpp %0, %1, %3 row_newbcast:1 row_mask:0xf bank_mask:0xf\n\t" "v_fmac_f32_dpp %0, %1, %4 row_newbcast:2 row_mask:0xf bank_mask:0xf\n\t" "v_fmac_f32_dpp %0, %1, %5 row_newbcast:3 row_mask:0xf bank_mask:0xf\n\t" "v_fmac_f32_dpp %0, %1, %6 row_newbcast:4 row_mask:0xf bank_mask:0xf\n\t" "v_fmac_f32_dpp %0, %1, %7 row_newbcast:5 row_mask:0xf bank_mask:0xf\n\t" "v_fmac_f32_dpp %0, %1, %8 row_newbcast:6 row_mask:0xf bank_mask:0xf\n\t" "v_fmac_f32_dpp %0, %1, %9 row_newbcast:7 row_mask:0xf bank_mask:0xf\n\t" "v_fmac_f32_dpp %0, %1, %10 row_newbcast:8 row_mask:0xf bank_mask:0xf\n\t" "v_fmac_f32_dpp %0, %1, %11 row_newbcast:9 row_mask:0xf bank_mask:0xf\n\t" "v_fmac_f32_dpp %0, %1, %12 row_newbcast:10 row_mask:0xf bank_mask:0xf\n\t" "v_fmac_f32_dpp %0, %1, %13 row_newbcast:11 row_mask:0xf bank_mask:0xf\n\t" "v_fmac_f32_dpp %0, %1, %14 row_newbcast:12 row_mask:0xf bank_mask:0xf\n\t" : "+v"(acc) : "v"(l), "v"(x0), "v"(x1), "v"(x2), "v"(x3), "v"(x4), "v"(x5), "v"(x6), "v"(x7), "v"(x8), "v"(x9), "v"(x10), "v"(x11), "v"(x12));
    }
};
template <> struct FmacChunk<14> {
    static __device__ __forceinline__ void run(float& acc, float l, float x0, float x1, float x2, float x3, float x4, float x5, float x6, float x7, float x8, float x9, float x10, float x11, float x12, float x13) {
        asm volatile("v_fmac_f32_dpp %0, %1, %2 row_newbcast:0 row_mask:0xf bank_mask:0xf\n\t" "v_fmac_f32_dpp %0, %1, %3 row_newbcast:1 row_mask:0xf bank_mask:0xf\n\t" "v_fmac_f32_dpp %0, %1, %4 row_newbcast:2 row_mask:0xf bank_mask:0xf\n\t" "v_fmac_f32_dpp %0, %1, %5 row_newbcast:3 row_mask:0xf bank_mask:0xf\n\t" "v_fmac_f32_dpp %0, %1, %6 row_newbcast:4 row_mask:0xf bank_mask:0xf\n\t" "v_fmac_f32_dpp %0, %1, %7 row_newbcast:5 row_mask:0xf bank_mask:0xf\n\t" "v_fmac_f32_dpp %0, %1, %8 row_newbcast:6 row_mask:0xf bank_mask:0xf\n\t" "v_fmac_f32_dpp %0, %1, %9 row_newbcast:7 row_mask:0xf bank_mask:0xf\n\t" "v_fmac_f32_dpp %0, %1, %10 row_newbcast:8 row_mask:0xf bank_mask:0xf\n\t" "v_fmac_f32_dpp %0, %1, %11 row_newbcast:9 row_mask:0xf bank_mask:0xf\n\t" "v_fmac_f32_dpp %0, %1, %12 row_newbcast:10 row_mask:0xf bank_mask:0xf\n\t" "v_fmac_f32_dpp %0, %1, %13 row_newbcast:11 row_mask:0xf bank_mask:0xf\n\t" "v_fmac_f32_dpp %0, %1, %14 row_newbcast:12 row_mask:0xf bank_mask:0xf\n\t" "v_fmac_f32_dpp %0, %1, %15 row_newbcast:13 row_mask:0xf bank_mask:0xf\n\t" : "+v"(acc) : "v"(l), "v"(x0), "v"(x1), "v"(x2), "v"(x3), "v"(x4), "v"(x5), "v"(x6), "v"(x7), "v"(x8), "v"(x9), "v"(x10), "v"(x11), "v"(x12), "v"(x13));
    }
};
template <> struct FmacChunk<15> {
    static __device__ __forceinline__ void run(float& acc, float l, float x0, float x1, float x2, float x3, float x4, float x5, float x6, float x7, float x8, float x9, float x10, float x11, float x12, float x13, float x14) {
        asm volatile("v_fmac_f32_dpp %0, %1, %2 row_newbcast:0 row_mask:0xf bank_mask:0xf\n\t" "v_fmac_f32_dpp %0, %1, %3 row_newbcast:1 row_mask:0xf bank_mask:0xf\n\t" "v_fmac_f32_dpp %0, %1, %4 row_newbcast:2 row_mask:0xf bank_mask:0xf\n\t" "v_fmac_f32_dpp %0, %1, %5 row_newbcast:3 row_mask:0xf bank_mask:0xf\n\t" "v_fmac_f32_dpp %0, %1, %6 row_newbcast:4 row_mask:0xf bank_mask:0xf\n\t" "v_fmac_f32_dpp %0, %1, %7 row_newbcast:5 row_mask:0xf bank_mask:0xf\n\t" "v_fmac_f32_dpp %0, %1, %8 row_newbcast:6 row_mask:0xf bank_mask:0xf\n\t" "v_fmac_f32_dpp %0, %1, %9 row_newbcast:7 row_mask:0xf bank_mask:0xf\n\t" "v_fmac_f32_dpp %0, %1, %10 row_newbcast:8 row_mask:0xf bank_mask:0xf\n\t" "v_fmac_f32_dpp %0, %1, %11 row_newbcast:9 row_mask:0xf bank_mask:0xf\n\t" "v_fmac_f32_dpp %0, %1, %12 row_newbcast:10 row_mask:0xf bank_mask:0xf\n\t" "v_fmac_f32_dpp %0, %1, %13 row_newbcast:11 row_mask:0xf bank_mask:0xf\n\t" "v_fmac_f32_dpp %0, %1, %14 row_newbcast:12 row_mask:0xf bank_mask:0xf\n\t" "v_fmac_f32_dpp %0, %1, %15 row_newbcast:13 row_mask:0xf bank_mask:0xf\n\t" "v_fmac_f32_dpp %0, %1, %16 row_newbcast:14 row_mask:0xf bank_mask:0xf\n\t" : "+v"(acc) : "v"(l), "v"(x0), "v"(x1), "v"(x2), "v"(x3), "v"(x4), "v"(x5), "v"(x6), "v"(x7), "v"(x8), "v"(x9), "v"(x10), "v"(x11), "v"(x12), "v"(x13), "v"(x14));
    }
};
template <> struct FmacChunk<16> {
    static __device__ __forceinline__ void run(float& acc, float l, float x0, float x1, float x2, float x3, float x4, float x5, float x6, float x7, float x8, float x9, float x10, float x11, float x12, float x13, float x14, float x15) {
        asm volatile("v_fmac_f32_dpp %0, %1, %2 row_newbcast:0 row_mask:0xf bank_mask:0xf\n\t" "v_fmac_f32_dpp %0, %1, %3 row_newbcast:1 row_mask:0xf bank_mask:0xf\n\t" "v_fmac_f32_dpp %0, %1, %4 row_newbcast:2 row_mask:0xf bank_mask:0xf\n\t" "v_fmac_f32_dpp %0, %1, %5 row_newbcast:3 row_mask:0xf bank_mask:0xf\n\t" "v_fmac_f32_dpp %0, %1, %6 row_newbcast:4 row_mask:0xf bank_mask:0xf\n\t" "v_fmac_f32_dpp %0, %1, %7 row_newbcast:5 row_mask:0xf bank_mask:0xf\n\t" "v_fmac_f32_dpp %0, %1, %8 row_newbcast:6 row_mask:0xf bank_mask:0xf\n\t" "v_fmac_f32_dpp %0, %1, %9 row_newbcast:7 row_mask:0xf bank_mask:0xf\n\t" "v_fmac_f32_dpp %0, %1, %10 row_newbcast:8 row_mask:0xf bank_mask:0xf\n\t" "v_fmac_f32_dpp %0, %1, %11 row_newbcast:9 row_mask:0xf bank_mask:0xf\n\t" "v_fmac_f32_dpp %0, %1, %12 row_newbcast:10 row_mask:0xf bank_mask:0xf\n\t" "v_fmac_f32_dpp %0, %1, %13 row_newbcast:11 row_mask:0xf bank_mask:0xf\n\t" "v_fmac_f32_dpp %0, %1, %14 row_newbcast:12 row_mask:0xf bank_mask:0xf\n\t" "v_fmac_f32_dpp %0, %1, %15 row_newbcast:13 row_mask:0xf bank_mask:0xf\n\t" "v_fmac_f32_dpp %0, %1, %16 row_newbcast:14 row_mask:0xf bank_mask:0xf\n\t" "v_fmac_f32_dpp %0, %1, %17 row_newbcast:15 row_mask:0xf bank_mask:0xf\n\t" : "+v"(acc) : "v"(l), "v"(x0), "v"(x1), "v"(x2), "v"(x3), "v"(x4), "v"(x5), "v"(x6), "v"(x7), "v"(x8), "v"(x9), "v"(x10), "v"(x11), "v"(x12), "v"(x13), "v"(x14), "v"(x15));
    }
};
template <int N, int B> struct ChunkCall;
#define CC_ARGS1(B) x[B]
#define CC_ARGS2(B) CC_ARGS1(B), x[B + 1]
#define CC_ARGS3(B) CC_ARGS2(B), x[B + 2]
#define CC_ARGS4(B) CC_ARGS3(B), x[B + 3]
#define CC_ARGS5(B) CC_ARGS4(B), x[B + 4]
#define CC_ARGS6(B) CC_ARGS5(B), x[B + 5]
#define CC_ARGS7(B) CC_ARGS6(B), x[B + 6]
#define CC_ARGS8(B) CC_ARGS7(B), x[B + 7]
#define CC_ARGS9(B) CC_ARGS8(B), x[B + 8]
#define CC_ARGS10(B) CC_ARGS9(B), x[B + 9]
#define CC_ARGS11(B) CC_ARGS10(B), x[B + 10]
#define CC_ARGS12(B) CC_ARGS11(B), x[B + 11]
#define CC_ARGS13(B) CC_ARGS12(B), x[B + 12]
#define CC_ARGS14(B) CC_ARGS13(B), x[B + 13]
#define CC_ARGS15(B) CC_ARGS14(B), x[B + 14]
#define CC_ARGS16(B) CC_ARGS15(B), x[B + 15]
#define CC_DEF(N) template <int B> struct ChunkCall<N, B> { static __device__ __forceinline__ void run(float (&x)[64], float& acc, float l) { FmacChunk<N>::run(acc, l, CC_ARGS##N(B)); } };
CC_DEF(1) CC_DEF(2) CC_DEF(3) CC_DEF(4) CC_DEF(5) CC_DEF(6) CC_DEF(7) CC_DEF(8) CC_DEF(9) CC_DEF(10) CC_DEF(11) CC_DEF(12) CC_DEF(13) CC_DEF(14) CC_DEF(15) CC_DEF(16)
#undef CC_DEF
template <int N> struct QuadChunk;
template <> struct QuadChunk<1> {
    static __device__ __forceinline__ void run(float& a0, float& a1, float& a2, float& a3, float l0, float l1, float l2, float l3, float x0) {
        asm volatile("v_fmac_f32_dpp %0, %4, %8 row_newbcast:0 row_mask:0xf bank_mask:0xf\n\t" "v_fmac_f32_dpp %1, %5, %8 row_newbcast:0 row_mask:0xf bank_mask:0xf\n\t" "v_fmac_f32_dpp %2, %6, %8 row_newbcast:0 row_mask:0xf bank_mask:0xf\n\t" "v_fmac_f32_dpp %3, %7, %8 row_newbcast:0 row_mask:0xf bank_mask:0xf\n\t" : "+v"(a0), "+v"(a1), "+v"(a2), "+v"(a3) : "v"(l0), "v"(l1), "v"(l2), "v"(l3), "v"(x0));
    }
};
template <> struct QuadChunk<2> {
    static __device__ __forceinline__ void run(float& a0, float& a1, float& a2, float& a3, float l0, float l1, float l2, float l3, float x0, float x1) {
        asm volatile("v_fmac_f32_dpp %0, %4, %8 row_newbcast:0 row_mask:0xf bank_mask:0xf\n\t" "v_fmac_f32_dpp %1, %5, %8 row_newbcast:0 row_mask:0xf bank_mask:0xf\n\t" "v_fmac_f32_dpp %2, %6, %8 row_newbcast:0 row_mask:0xf bank_mask:0xf\n\t" "v_fmac_f32_dpp %3, %7, %8 row_newbcast:0 row_mask:0xf bank_mask:0xf\n\t" "v_fmac_f32_dpp %0, %4, %9 row_newbcast:1 row_mask:0xf bank_mask:0xf\n\t" "v_fmac_f32_dpp %1, %5, %9 row_newbcast:1 row_mask:0xf bank_mask:0xf\n\t" "v_fmac_f32_dpp %2, %6, %9 row_newbcast:1 row_mask:0xf bank_mask:0xf\n\t" "v_fmac_f32_dpp %3, %7, %9 row_newbcast:1 row_mask:0xf bank_mask:0xf\n\t" : "+v"(a0), "+v"(a1), "+v"(a2), "+v"(a3) : "v"(l0), "v"(l1), "v"(l2), "v"(l3), "v"(x0), "v"(x1));
    }
};
template <> struct QuadChunk<3> {
    static __device__ __forceinline__ void run(float& a0, float& a1, float& a2, float& a3, float l0, float l1, float l2, float l3, float x0, float x1, float x2) {
        asm volatile("v_fmac_f32_dpp %0, %4, %8 row_newbcast:0 row_mask:0xf bank_mask:0xf\n\t" "v_fmac_f32_dpp %1, %5, %8 row_newbcast:0 row_mask:0xf bank_mask:0xf\n\t" "v_fmac_f32_dpp %2, %6, %8 row_newbcast:0 row_mask:0xf bank_mask:0xf\n\t" "v_fmac_f32_dpp %3, %7, %8 row_newbcast:0 row_mask:0xf bank_mask:0xf\n\t" "v_fmac_f32_dpp %0, %4, %9 row_newbcast:1 row_mask:0xf bank_mask:0xf\n\t" "v_fmac_f32_dpp %1, %5, %9 row_newbcast:1 row_mask:0xf bank_mask:0xf\n\t" "v_fmac_f32_dpp %2, %6, %9 row_newbcast:1 row_mask:0xf bank_mask:0xf\n\t" "v_fmac_f32_dpp %3, %7, %9 row_newbcast:1 row_mask:0xf bank_mask:0xf\n\t" "v_fmac_f32_dpp %0, %4, %10 row_newbcast:2 row_mask:0xf bank_mask:0xf\n\t" "v_fmac_f32_dpp %1, %5, %10 row_newbcast:2 row_mask:0xf bank_mask:0xf\n\t" "v_fmac_f32_dpp %2, %6, %10 row_newbcast:2 row_mask:0xf bank_mask:0xf\n\t" "v_fmac_f32_dpp %3, %7, %10 row_newbcast:2 row_mask:0xf bank_mask:0xf\n\t" : "+v"(a0), "+v"(a1), "+v"(a2), "+v"(a3) : "v"(l0), "v"(l1), "v"(l2), "v"(l3), "v"(x0), "v"(x1), "v"(x2));
    }
};
template <> struct QuadChunk<4> {
    static __device__ __forceinline__ void run(float& a0, float& a1, float& a2, float& a3, float l0, float l1, float l2, float l3, float x0, float x1, float x2, float x3) {
        asm volatile("v_fmac_f32_dpp %0, %4, %8 row_newbcast:0 row_mask:0xf bank_mask:0xf\n\t" "v_fmac_f32_dpp %1, %5, %8 row_newbcast:0 row_mask:0xf bank_mask:0xf\n\t" "v_fmac_f32_dpp %2, %6, %8 row_newbcast:0 row_mask:0xf bank_mask:0xf\n\t" "v_fmac_f32_dpp %3, %7, %8 row_newbcast:0 row_mask:0xf bank_mask:0xf\n\t" "v_fmac_f32_dpp %0, %4, %9 row_newbcast:1 row_mask:0xf bank_mask:0xf\n\t" "v_fmac_f32_dpp %1, %5, %9 row_newbcast:1 row_mask:0xf bank_mask:0xf\n\t" "v_fmac_f32_dpp %2, %6, %9 row_newbcast:1 row_mask:0xf bank_mask:0xf\n\t" "v_fmac_f32_dpp %3, %7, %9 row_newbcast:1 row_mask:0xf bank_mask:0xf\n\t" "v_fmac_f32_dpp %0, %4, %10 row_newbcast:2 row_mask:0xf bank_mask:0xf\n\t" "v_fmac_f32_dpp %1, %5, %10 row_newbcast:2 row_mask:0xf bank_mask:0xf\n\t" "v_fmac_f32_dpp %2, %6, %10 row_newbcast:2 row_mask:0xf bank_mask:0xf\n\t" "v_fmac_f32_dpp %3, %7, %10 row_newbcast:2 row_mask:0xf bank_mask:0xf\n\t" "v_fmac_f32_dpp %0, %4, %11 row_newbcast:3 row_mask:0xf bank_mask:0xf\n\t" "v_fmac_f32_dpp %1, %5, %11 row_newbcast:3 row_mask:0xf bank_mask:0xf\n\t" "v_fmac_f32_dpp %2, %6, %11 row_newbcast:3 row_mask:0xf bank_mask:0xf\n\t" "v_fmac_f32_dpp %3, %7, %11 row_newbcast:3 row_mask:0xf bank_mask:0xf\n\t" : "+v"(a0), "+v"(a1), "+v"(a2), "+v"(a3) : "v"(l0), "v"(l1), "v"(l2), "v"(l3), "v"(x0), "v"(x1), "v"(x2), "v"(x3));
    }
};
template <> struct QuadChunk<5> {
    static __device__ __forceinline__ void run(float& a0, float& a1, float& a2, float& a3, float l0, float l1, float l2, float l3, float x0, float x1, float x2, float x3, float x4) {
        asm volatile("v_fmac_f32_dpp %0, %4, %8 row_newbcast:0 row_mask:0xf bank_mask:0xf\n\t" "v_fmac_f32_dpp %1, %5, %8 row_newbcast:0 row_mask:0xf bank_mask:0xf\n\t" "v_fmac_f32_dpp %2, %6, %8 row_newbcast:0 row_mask:0xf bank_mask:0xf\n\t" "v_fmac_f32_dpp %3, %7, %8 row_newbcast:0 row_mask:0xf bank_mask:0xf\n\t" "v_fmac_f32_dpp %0, %4, %9 row_newbcast:1 row_mask:0xf bank_mask:0xf\n\t" "v_fmac_f32_dpp %1, %5, %9 row_newbcast:1 row_mask:0xf bank_mask:0xf\n\t" "v_fmac_f32_dpp %2, %6, %9 row_newbcast:1 row_mask:0xf bank_mask:0xf\n\t" "v_fmac_f32_dpp %3, %7, %9 row_newbcast:1 row_mask:0xf bank_mask:0xf\n\t" "v_fmac_f32_dpp %0, %4, %10 row_newbcast:2 row_mask:0xf bank_mask:0xf\n\t" "v_fmac_f32_dpp %1, %5, %10 row_newbcast:2 row_mask:0xf bank_mask:0xf\n\t" "v_fmac_f32_dpp %2, %6, %10 row_newbcast:2 row_mask:0xf bank_mask:0xf\n\t" "v_fmac_f32_dpp %3, %7, %10 row_newbcast:2 row_mask:0xf bank_mask:0xf\n\t" "v_fmac_f32_dpp %0, %4, %11 row_newbcast:3 row_mask:0xf bank_mask:0xf\n\t" "v_fmac_f32_dpp %1, %5, %11 row_newbcast:3 row_mask:0xf bank_mask:0xf\n\t" "v_fmac_f32_dpp %2, %6, %11 row_newbcast:3 row_mask:0xf bank_mask:0xf\n\t" "v_fmac_f32_dpp %3, %7, %11 row_newbcast:3 row_mask:0xf bank_mask:0xf\n\t" "v_fmac_f32_dpp %0, %4, %12 row_newbcast:4 row_mask:0xf bank_mask:0xf\n\t" "v_fmac_f32_dpp %1, %5, %12 row_newbcast:4 row_mask:0xf bank_mask:0xf\n\t" "v_fmac_f32_dpp %2, %6, %12 row_newbcast:4 row_mask:0xf bank_mask:0xf\n\t" "v_fmac_f32_dpp %3, %7, %12 row_newbcast:4 row_mask:0xf bank_mask:0xf\n\t" : "+v"(a0), "+v"(a1), "+v"(a2), "+v"(a3) : "v"(l0), "v"(l1), "v"(l2), "v"(l3), "v"(x0), "v"(x1), "v"(x2), "v"(x3), "v"(x4));
    }
};
template <> struct QuadChunk<6> {
    static __device__ __forceinline__ void run(float& a0, float& a1, float& a2, float& a3, float l0, float l1, float l2, float l3, float x0, float x1, float x2, float x3, float x4, float x5) {
        asm volatile("v_fmac_f32_dpp %0, %4, %8 row_newbcast:0 row_mask:0xf bank_mask:0xf\n\t" "v_fmac_f32_dpp %1, %5, %8 row_newbcast:0 row_mask:0xf bank_mask:0xf\n\t" "v_fmac_f32_dpp %2, %6, %8 row_newbcast:0 row_mask:0xf bank_mask:0xf\n\t" "v_fmac_f32_dpp %3, %7, %8 row_newbcast:0 row_mask:0xf bank_mask:0xf\n\t" "v_fmac_f32_dpp %0, %4, %9 row_newbcast:1 row_mask:0xf bank_mask:0xf\n\t" "v_fmac_f32_dpp %1, %5, %9 row_newbcast:1 row_mask:0xf bank_mask:0xf\n\t" "v_fmac_f32_dpp %2, %6, %9 row_newbcast:1 row_mask:0xf bank_mask:0xf\n\t" "v_fmac_f32_dpp %3, %7, %9 row_newbcast:1 row_mask:0xf bank_mask:0xf\n\t" "v_fmac_f32_dpp %0, %4, %10 row_newbcast:2 row_mask:0xf bank_mask:0xf\n\t" "v_fmac_f32_dpp %1, %5, %10 row_newbcast:2 row_mask:0xf bank_mask:0xf\n\t" "v_fmac_f32_dpp %2, %6, %10 row_newbcast:2 row_mask:0xf bank_mask:0xf\n\t" "v_fmac_f32_dpp %3, %7, %10 row_newbcast:2 row_mask:0xf bank_mask:0xf\n\t" "v_fmac_f32_dpp %0, %4, %11 row_newbcast:3 row_mask:0xf bank_mask:0xf\n\t" "v_fmac_f32_dpp %1, %5, %11 row_newbcast:3 row_mask:0xf bank_mask:0xf\n\t" "v_fmac_f32_dpp %2, %6, %11 row_newbcast:3 row_mask:0xf bank_mask:0xf\n\t" "v_fmac_f32_dpp %3, %7, %11 row_newbcast:3 row_mask:0xf bank_mask:0xf\n\t" "v_fmac_f32_dpp %0, %4, %12 row_newbcast:4 row_mask:0xf bank_mask:0xf\n\t" "v_fmac_f32_dpp %1, %5, %12 row_newbcast:4 row_mask:0xf bank_mask:0xf\n\t" "v_fmac_f32_dpp %2, %6, %12 row_newbcast:4 row_mask:0xf bank_mask:0xf\n\t" "v_fmac_f32_dpp %3, %7, %12 row_newbcast:4 row_mask:0xf bank_mask:0xf\n\t" "v_fmac_f32_dpp %0, %4, %13 row_newbcast:5 row_mask:0xf bank_mask:0xf\n\t" "v_fmac_f32_dpp %1, %5, %13 row_newbcast:5 row_mask:0xf bank_mask:0xf\n\t" "v_fmac_f32_dpp %2, %6, %13 row_newbcast:5 row_mask:0xf bank_mask:0xf\n\t" "v_fmac_f32_dpp %3, %7, %13 row_newbcast:5 row_mask:0xf bank_mask:0xf\n\t" : "+v"(a0), "+v"(a1), "+v"(a2), "+v"(a3) : "v"(l0), "v"(l1), "v"(l2), "v"(l3), "v"(x0), "v"(x1), "v"(x2), "v"(x3), "v"(x4), "v"(x5));
    }
};
template <> struct QuadChunk<7> {
    static __device__ __forceinline__ void run(float& a0, float& a1, float& a2, float& a3, float l0, float l1, float l2, float l3, float x0, float x1, float x2, float x3, float x4, float x5, float x6) {
        asm volatile("v_fmac_f32_dpp %0, %4, %8 row_newbcast:0 row_mask:0xf bank_mask:0xf\n\t" "v_fmac_f32_dpp %1, %5, %8 row_newbcast:0 row_mask:0xf bank_mask:0xf\n\t" "v_fmac_f32_dpp %2, %6, %8 row_newbcast:0 row_mask:0xf bank_mask:0xf\n\t" "v_fmac_f32_dpp %3, %7, %8 row_newbcast:0 row_mask:0xf bank_mask:0xf\n\t" "v_fmac_f32_dpp %0, %4, %9 row_newbcast:1 row_mask:0xf bank_mask:0xf\n\t" "v_fmac_f32_dpp %1, %5, %9 row_newbcast:1 row_mask:0xf bank_mask:0xf\n\t" "v_fmac_f32_dpp %2, %6, %9 row_newbcast:1 row_mask:0xf bank_mask:0xf\n\t" "v_fmac_f32_dpp %3, %7, %9 row_newbcast:1 row_mask:0xf bank_mask:0xf\n\t" "v_fmac_f32_dpp %0, %4, %10 row_newbcast:2 row_mask:0xf bank_mask:0xf\n\t" "v_fmac_f32_dpp %1, %5, %10 row_newbcast:2 row_mask:0xf bank_mask:0xf\n\t" "v_fmac_f32_dpp %2, %6, %10 row_newbcast:2 row_mask:0xf bank_mask:0xf\n\t" "v_fmac_f32_dpp %3, %7, %10 row_newbcast:2 row_mask:0xf bank_mask:0xf\n\t" "v_fmac_f32_dpp %0, %4, %11 row_newbcast:3 row_mask:0xf bank_mask:0xf\n\t" "v_fmac_f32_dpp %1, %5, %11 row_newbcast:3 row_mask:0xf bank_mask:0xf\n\t" "v_fmac_f32_dpp %2, %6, %11 row_newbcast:3 row_mask:0xf bank_mask:0xf\n\t" "v_fmac_f32_dpp %3, %7, %11 row_newbcast:3 row_mask:0xf bank_mask:0xf\n\t" "v_fmac_f32_dpp %0, %4, %12 row_newbcast:4 row_mask:0xf bank_mask:0xf\n\t" "v_fmac_f32_dpp %1, %5, %12 row_newbcast:4 row_mask:0xf bank_mask:0xf\n\t" "v_fmac_f32_dpp %2, %6, %12 row_newbcast:4 row_mask:0xf bank_mask:0xf\n\t" "v_fmac_f32_dpp %3, %7, %12 row_newbcast:4 row_mask:0xf bank_mask:0xf\n\t" "v_fmac_f32_dpp %0, %4, %13 row_newbcast:5 row_mask:0xf bank_mask:0xf\n\t" "v_fmac_f32_dpp %1, %5, %13 row_newbcast:5 row_mask:0xf bank_mask:0xf\n\t" "v_fmac_f32_dpp %2, %6, %13 row_newbcast:5 row_mask:0xf bank_mask:0xf\n\t" "v_fmac_f32_dpp %3, %7, %13 row_newbcast:5 row_mask:0xf bank_mask:0xf\n\t" "v_fmac_f32_dpp %0, %4, %14 row_newbcast:6 row_mask:0xf bank_mask:0xf\n\t" "v_fmac_f32_dpp %1, %5, %14 row_newbcast:6 row_mask:0xf bank_mask:0xf\n\t" "v_fmac_f32_dpp %2, %6, %14 row_newbcast:6 row_mask:0xf bank_mask:0xf\n\t" "v_fmac_f32_dpp %3, %7, %14 row_newbcast:6 row_mask:0xf bank_mask:0xf\n\t" : "+v"(a0), "+v"(a1), "+v"(a2), "+v"(a3) : "v"(l0), "v"(l1), "v"(l2), "v"(l3), "v"(x0), "v"(x1), "v"(x2), "v"(x3), "v"(x4), "v"(x5), "v"(x6));
    }
};
template <> struct QuadChunk<8> {
    static __device__ __forceinline__ void run(float& a0, float& a1, float& a2, float& a3, float l0, float l1, float l2, float l3, float x0, float x1, float x2, float x3, float x4, float x5, float x6, float x7) {
        asm volatile("v_fmac_f32_dpp %0, %4, %8 row_newbcast:0 row_mask:0xf bank_mask:0xf\n\t" "v_fmac_f32_dpp %1, %5, %8 row_newbcast:0 row_mask:0xf bank_mask:0xf\n\t" "v_fmac_f32_dpp %2, %6, %8 row_newbcast:0 row_mask:0xf bank_mask:0xf\n\t" "v_fmac_f32_dpp %3, %7, %8 row_newbcast:0 row_mask:0xf bank_mask:0xf\n\t" "v_fmac_f32_dpp %0, %4, %9 row_newbcast:1 row_mask:0xf bank_mask:0xf\n\t" "v_fmac_f32_dpp %1, %5, %9 row_newbcast:1 row_mask:0xf bank_mask:0xf\n\t" "v_fmac_f32_dpp %2, %6, %9 row_newbcast:1 row_mask:0xf bank_mask:0xf\n\t" "v_fmac_f32_dpp %3, %7, %9 row_newbcast:1 row_mask:0xf bank_mask:0xf\n\t" "v_fmac_f32_dpp %0, %4, %10 row_newbcast:2 row_mask:0xf bank_mask:0xf\n\t" "v_fmac_f32_dpp %1, %5, %10 row_newbcast:2 row_mask:0xf bank_mask:0xf\n\t" "v_fmac_f32_dpp %2, %6, %10 row_newbcast:2 row_mask:0xf bank_mask:0xf\n\t" "v_fmac_f32_dpp %3, %7, %10 row_newbcast:2 row_mask:0xf bank_mask:0xf\n\t" "v_fmac_f32_dpp %0, %4, %11 row_newbcast:3 row_mask:0xf bank_mask:0xf\n\t" "v_fmac_f32_dpp %1, %5, %11 row_newbcast:3 row_mask:0xf bank_mask:0xf\n\t" "v_fmac_f32_dpp %2, %6, %11 row_newbcast:3 row_mask:0xf bank_mask:0xf\n\t" "v_fmac_f32_dpp %3, %7, %11 row_newbcast:3 row_mask:0xf bank_mask:0xf\n\t" "v_fmac_f32_dpp %0, %4, %12 row_newbcast:4 row_mask:0xf bank_mask:0xf\n\t" "v_fmac_f32_dpp %1, %5, %12 row_newbcast:4 row_mask:0xf bank_mask:0xf\n\t" "v_fmac_f32_dpp %2, %6, %12 row_newbcast:4 row_mask:0xf bank_mask:0xf\n\t" "v_fmac_f32_dpp %3, %7, %12 row_newbcast:4 row_mask:0xf bank_mask:0xf\n\t" "v_fmac_f32_dpp %0, %4, %13 row_newbcast:5 row_mask:0xf bank_mask:0xf\n\t" "v_fmac_f32_dpp %1, %5, %13 row_newbcast:5 row_mask:0xf bank_mask:0xf\n\t" "v_fmac_f32_dpp %2, %6, %13 row_newbcast:5 row_mask:0xf bank_mask:0xf\n\t" "v_fmac_f32_dpp %3, %7, %13 row_newbcast:5 row_mask:0xf bank_mask:0xf\n\t" "v_fmac_f32_dpp %0, %4, %14 row_newbcast:6 row_mask:0xf bank_mask:0xf\n\t" "v_fmac_f32_dpp %1, %5, %14 row_newbcast:6 row_mask:0xf bank_mask:0xf\n\t" "v_fmac_f32_dpp %2, %6, %14 row_newbcast:6 row_mask:0xf bank_mask:0xf\n\t" "v_fmac_f32_dpp %3, %7, %14 row_newbcast:6 row_mask:0xf bank_mask:0xf\n\t" "v_fmac_f32_dpp %0, %4, %15 row_newbcast:7 row_mask:0xf bank_mask:0xf\n\t" "v_fmac_f32_dpp %1, %5, %15 row_newbcast:7 row_mask:0xf bank_mask:0xf\n\t" "v_fmac_f32_dpp %2, %6, %15 row_newbcast:7 row_mask:0xf bank_mask:0xf\n\t" "v_fmac_f32_dpp %3, %7, %15 row_newbcast:7 row_mask:0xf bank_mask:0xf\n\t" : "+v"(a0), "+v"(a1), "+v"(a2), "+v"(a3) : "v"(l0), "v"(l1), "v"(l2), "v"(l3), "v"(x0), "v"(x1), "v"(x2), "v"(x3), "v"(x4), "v"(x5), "v"(x6), "v"(x7));
    }
};
template <> struct QuadChunk<9> {
    static __device__ __forceinline__ void run(float& a0, float& a1, float& a2, float& a3, float l0, float l1, float l2, float l3, float x0, float x1, float x2, float x3, float x4, float x5, float x6, float x7, float x8) {
        asm volatile("v_fmac_f32_dpp %0, %4, %8 row_newbcast:0 row_mask:0xf bank_mask:0xf\n\t" "v_fmac_f32_dpp %1, %5, %8 row_newbcast:0 row_mask:0xf bank_mask:0xf\n\t" "v_fmac_f32_dpp %2, %6, %8 row_newbcast:0 row_mask:0xf bank_mask:0xf\n\t" "v_fmac_f32_dpp %3, %7, %8 row_newbcast:0 row_mask:0xf bank_mask:0xf\n\t" "v_fmac_f32_dpp %0, %4, %9 row_newbcast:1 row_mask:0xf bank_mask:0xf\n\t" "v_fmac_f32_dpp %1, %5, %9 row_newbcast:1 row_mask:0xf bank_mask:0xf\n\t" "v_fmac_f32_dpp %2, %6, %9 row_newbcast:1 row_mask:0xf bank_mask:0xf\n\t" "v_fmac_f32_dpp %3, %7, %9 row_newbcast:1 row_mask:0xf bank_mask:0xf\n\t" "v_fmac_f32_dpp %0, %4, %10 row_newbcast:2 row_mask:0xf bank_mask:0xf\n\t" "v_fmac_f32_dpp %1, %5, %10 row_newbcast:2 row_mask:0xf bank_mask:0xf\n\t" "v_fmac_f32_dpp %2, %6, %10 row_newbcast:2 row_mask:0xf bank_mask:0xf\n\t" "v_fmac_f32_dpp %3, %7, %10 row_newbcast:2 row_mask:0xf bank_mask:0xf\n\t" "v_fmac_f32_dpp %0, %4, %11 row_newbcast:3 row_mask:0xf bank_mask:0xf\n\t" "v_fmac_f32_dpp %1, %5, %11 row_newbcast:3 row_mask:0xf bank_mask:0xf\n\t" "v_fmac_f32_dpp %2, %6, %11 row_newbcast:3 row_mask:0xf bank_mask:0xf\n\t" "v_fmac_f32_dpp %3, %7, %11 row_newbcast:3 row_mask:0xf bank_mask:0xf\n\t" "v_fmac_f32_dpp %0, %4, %12 row_newbcast:4 row_mask:0xf bank_mask:0xf\n\t" "v_fmac_f32_dpp %1, %5, %12 row_newbcast:4 row_mask:0xf bank_mask:0xf\n\t" "v_fmac_f32_dpp %2, %6, %12 row_newbcast:4 row_mask:0xf bank_mask:0xf\n\t" "v_fmac_f32_dpp %3, %7, %12 row_newbcast:4 row_mask:0xf bank_mask:0xf\n\t" "v_fmac_f32_dpp %0, %4, %13 row_newbcast:5 row_mask:0xf bank_mask:0xf\n\t" "v_fmac_f32_dpp %1, %5, %13 row_newbcast:5 row_mask:0xf bank_mask:0xf\n\t" "v_fmac_f32_dpp %2, %6, %13 row_newbcast:5 row_mask:0xf bank_mask:0xf\n\t" "v_fmac_f32_dpp %3, %7, %13 row_newbcast:5 row_mask:0xf bank_mask:0xf\n\t" "v_fmac_f32_dpp %0, %4, %14 row_newbcast:6 row_mask:0xf bank_mask:0xf\n\t" "v_fmac_f32_dpp %1, %5, %14 row_newbcast:6 row_mask:0xf bank_mask:0xf\n\t" "v_fmac_f32_dpp %2, %6, %14 row_newbcast:6 row_mask:0xf bank_mask:0xf\n\t" "v_fmac_f32_dpp %3, %7, %14 row_newbcast:6 row_mask:0xf bank_mask:0xf\n\t" "v_fmac_f32_dpp %0, %4, %15 row_newbcast:7 row_mask:0xf bank_mask:0xf\n\t" "v_fmac_f32_dpp %1, %5, %15 row_newbcast:7 row_mask:0xf bank_mask:0xf\n\t" "v_fmac_f32_dpp %2, %6, %15 row_newbcast:7 row_mask:0xf bank_mask:0xf\n\t" "v_fmac_f32_dpp %3, %7, %15 row_newbcast:7 row_mask:0xf bank_mask:0xf\n\t" "v_fmac_f32_dpp %0, %4, %16 row_newbcast:8 row_mask:0xf bank_mask:0xf\n\t" "v_fmac_f32_dpp %1, %5, %16 row_newbcast:8 row_mask:0xf bank_mask:0xf\n\t" "v_fmac_f32_dpp %2, %6, %16 row_newbcast:8 row_mask:0xf bank_mask:0xf\n\t" "v_fmac_f32_dpp %3, %7, %16 row_newbcast:8 row_mask:0xf bank_mask:0xf\n\t" : "+v"(a0), "+v"(a1), "+v"(a2), "+v"(a3) : "v"(l0), "v"(l1), "v"(l2), "v"(l3), "v"(x0), "v"(x1), "v"(x2), "v"(x3), "v"(x4), "v"(x5), "v"(x6), "v"(x7), "v"(x8));
    }
};
template <> struct QuadChunk<10> {
    static __device__ __forceinline__ void run(float& a0, float& a1, float& a2, float& a3, float l0, float l1, float l2, float l3, float x0, float x1, float x2, float x3, float x4, float x5, float x6, float x7, float x8, float x9) {
        asm volatile("v_fmac_f32_dpp %0, %4, %8 row_newbcast:0 row_mask:0xf bank_mask:0xf\n\t" "v_fmac_f32_dpp %1, %5, %8 row_newbcast:0 row_mask:0xf bank_mask:0xf\n\t" "v_fmac_f32_dpp %2, %6, %8 row_newbcast:0 row_mask:0xf bank_mask:0xf\n\t" "v_fmac_f32_dpp %3, %7, %8 row_newbcast:0 row_mask:0xf bank_mask:0xf\n\t" "v_fmac_f32_dpp %0, %4, %9 row_newbcast:1 row_mask:0xf bank_mask:0xf\n\t" "v_fmac_f32_dpp %1, %5, %9 row_newbcast:1 row_mask:0xf bank_mask:0xf\n\t" "v_fmac_f32_dpp %2, %6, %9 row_newbcast:1 row_mask:0xf bank_mask:0xf\n\t" "v_fmac_f32_dpp %3, %7, %9 row_newbcast:1 row_mask:0xf bank_mask:0xf\n\t" "v_fmac_f32_dpp %0, %4, %10 row_newbcast:2 row_mask:0xf bank_mask:0xf\n\t" "v_fmac_f32_dpp %1, %5, %10 row_newbcast:2 row_mask:0xf bank_mask:0xf\n\t" "v_fmac_f32_dpp %2, %6, %10 row_newbcast:2 row_mask:0xf bank_mask:0xf\n\t" "v_fmac_f32_dpp %3, %7, %10 row_newbcast:2 row_mask:0xf bank_mask:0xf\n\t" "v_fmac_f32_dpp %0, %4, %11 row_newbcast:3 row_mask:0xf bank_mask:0xf\n\t" "v_fmac_f32_dpp %1, %5, %11 row_newbcast:3 row_mask:0xf bank_mask:0xf\n\t" "v_fmac_f32_dpp %2, %6, %11 row_newbcast:3 row_mask:0xf bank_mask:0xf\n\t" "v_fmac_f32_dpp %3, %7, %11 row_newbcast:3 row_mask:0xf bank_mask:0xf\n\t" "v_fmac_f32_dpp %0, %4, %12 row_newbcast:4 row_mask:0xf bank_mask:0xf\n\t" "v_fmac_f32_dpp %1, %5, %12 row_newbcast:4 row_mask:0xf bank_mask:0xf\n\t" "v_fmac_f32_dpp %2, %6, %12 row_newbcast:4 row_mask:0xf bank_mask:0xf\n\t" "v_fmac_f32_dpp %3, %7, %12 row_newbcast:4 row_mask:0xf bank_mask:0xf\n\t" "v_fmac_f32_dpp %0, %4, %13 row_newbcast:5 row_mask:0xf bank_mask:0xf\n\t" "v_fmac_f32_dpp %1, %5, %13 row_newbcast:5 row_mask:0xf bank_mask:0xf\n\t" "v_fmac_f32_dpp %2, %6, %13 row_newbcast:5 row_mask:0xf bank_mask:0xf\n\t" "v_fmac_f32_dpp %3, %7, %13 row_newbcast:5 row_mask:0xf bank_mask:0xf\n\t" "v_fmac_f32_dpp %0, %4, %14 row_newbcast:6 row_mask:0xf bank_mask:0xf\n\t" "v_fmac_f32_dpp %1, %5, %14 row_newbcast:6 row_mask:0xf bank_mask:0xf\n\t" "v_fmac_f32_dpp %2, %6, %14 row_newbcast:6 row_mask:0xf bank_mask:0xf\n\t" "v_fmac_f32_dpp %3, %7, %14 row_newbcast:6 row_mask:0xf bank_mask:0xf\n\t" "v_fmac_f32_dpp %0, %4, %15 row_newbcast:7 row_mask:0xf bank_mask:0xf\n\t" "v_fmac_f32_dpp %1, %5, %15 row_newbcast:7 row_mask:0xf bank_mask:0xf\n\t" "v_fmac_f32_dpp %2, %6, %15 row_newbcast:7 row_mask:0xf bank_mask:0xf\n\t" "v_fmac_f32_dpp %3, %7, %15 row_newbcast:7 row_mask:0xf bank_mask:0xf\n\t" "v_fmac_f32_dpp %0, %4, %16 row_newbcast:8 row_mask:0xf bank_mask:0xf\n\t" "v_fmac_f32_dpp %1, %5, %16 row_newbcast:8 row_mask:0xf bank_mask:0xf\n\t" "v_fmac_f32_dpp %2, %6, %16 row_newbcast:8 row_mask:0xf bank_mask:0xf\n\t" "v_fmac_f32_dpp %3, %7, %16 row_newbcast:8 row_mask:0xf bank_mask:0xf\n\t" "v_fmac_f32_dpp %0, %4, %17 row_newbcast:9 row_mask:0xf bank_mask:0xf\n\t" "v_fmac_f32_dpp %1, %5, %17 row_newbcast:9 row_mask:0xf bank_mask:0xf\n\t" "v_fmac_f32_dpp %2, %6, %17 row_newbcast:9 row_mask:0xf bank_mask:0xf\n\t" "v_fmac_f32_dpp %3, %7, %17 row_newbcast:9 row_mask:0xf bank_mask:0xf\n\t" : "+v"(a0), "+v"(a1), "+v"(a2), "+v"(a3) : "v"(l0), "v"(l1), "v"(l2), "v"(l3), "v"(x0), "v"(x1), "v"(x2), "v"(x3), "v"(x4), "v"(x5), "v"(x6), "v"(x7), "v"(x8), "v"(x9));
    }
};
template <> struct QuadChunk<11> {
    static __device__ __forceinline__ void run(float& a0, float& a1, float& a2, float& a3, float l0, float l1, float l2, float l3, float x0, float x1, float x2, float x3, float x4, float x5, float x6, float x7, float x8, float x9, float x10) {
        asm volatile("v_fmac_f32_dpp %0, %4, %8 row_newbcast:0 row_mask:0xf bank_mask:0xf\n\t" "v_fmac_f32_dpp %1, %5, %8 row_newbcast:0 row_mask:0xf bank_mask:0xf\n\t" "v_fmac_f32_dpp %2, %6, %8 row_newbcast:0 row_mask:0xf bank_mask:0xf\n\t" "v_fmac_f32_dpp %3, %7, %8 row_newbcast:0 row_mask:0xf bank_mask:0xf\n\t" "v_fmac_f32_dpp %0, %4, %9 row_newbcast:1 row_mask:0xf bank_mask:0xf\n\t" "v_fmac_f32_dpp %1, %5, %9 row_newbcast:1 row_mask:0xf bank_mask:0xf\n\t" "v_fmac_f32_dpp %2, %6, %9 row_newbcast:1 row_mask:0xf bank_mask:0xf\n\t" "v_fmac_f32_dpp %3, %7, %9 row_newbcast:1 row_mask:0xf bank_mask:0xf\n\t" "v_fmac_f32_dpp %0, %4, %10 row_newbcast:2 row_mask:0xf bank_mask:0xf\n\t" "v_fmac_f32_dpp %1, %5, %10 row_newbcast:2 row_mask:0xf bank_mask:0xf\n\t" "v_fmac_f32_dpp %2, %6, %10 row_newbcast:2 row_mask:0xf bank_mask:0xf\n\t" "v_fmac_f32_dpp %3, %7, %10 row_newbcast:2 row_mask:0xf bank_mask:0xf\n\t" "v_fmac_f32_dpp %0, %4, %11 row_newbcast:3 row_mask:0xf bank_mask:0xf\n\t" "v_fmac_f32_dpp %1, %5, %11 row_newbcast:3 row_mask:0xf bank_mask:0xf\n\t" "v_fmac_f32_dpp %2, %6, %11 row_newbcast:3 row_mask:0xf bank_mask:0xf\n\t" "v_fmac_f32_dpp %3, %7, %11 row_newbcast:3 row_mask:0xf bank_mask:0xf\n\t" "v_fmac_f32_dpp %0, %4, %12 row_newbcast:4 row_mask:0xf bank_mask:0xf\n\t" "v_fmac_f32_dpp %1, %5, %12 row_newbcast:4 row_mask:0xf bank_mask:0xf\n\t" "v_fmac_f32_dpp %2, %6, %12 row_newbcast:4 row_mask:0xf bank_mask:0xf\n\t" "v_fmac_f32_dpp %3, %7, %12 row_newbcast:4 row_mask:0xf bank_mask:0xf\n\t" "v_fmac_f32_dpp %0, %4, %13 row_newbcast:5 row_mask:0xf bank_mask:0xf\n\t" "v_fmac_f32_dpp %1, %5, %13 row_newbcast:5 row_mask:0xf bank_mask:0xf\n\t" "v_fmac_f32_dpp %2, %6, %13 row_newbcast:5 row_mask:0xf bank_mask:0xf\n\t" "v_fmac_f32_dpp %3, %7, %13 row_newbcast:5 row_mask:0xf bank_mask:0xf\n\t" "v_fmac_f32_dpp %0, %4, %14 row_newbcast:6 row_mask:0xf bank_mask:0xf\n\t" "v_fmac_f32_dpp %1, %5, %14 row_newbcast:6 row_mask:0xf bank_mask:0xf\n\t" "v_fmac_f32_dpp %2, %6, %14 row_newbcast:6 row_mask:0xf bank_mask:0xf\n\t" "v_fmac_f32_dpp %3, %7, %14 row_newbcast:6 row_mask:0xf bank_mask:0xf\n\t" "v_fmac_f32_dpp %0, %4, %15 row_newbcast:7 row_mask:0xf bank_mask:0xf\n\t" "v_fmac_f32_dpp %1, %5, %15 row_newbcast:7 row_mask:0xf bank_mask:0xf\n\t" "v_fmac_f32_dpp %2, %6, %15 row_newbcast:7 row_mask:0xf bank_mask:0xf\n\t" "v_fmac_f32_dpp %3, %7, %15 row_newbcast:7 row_mask:0xf bank_mask:0xf\n\t" "v_fmac_f32_dpp %0, %4, %16 row_newbcast:8 row_mask:0xf bank_mask:0xf\n\t" "v_fmac_f32_dpp %1, %5, %16 row_newbcast:8 row_mask:0xf bank_mask:0xf\n\t" "v_fmac_f32_dpp %2, %6, %16 row_newbcast:8 row_mask:0xf bank_mask:0xf\n\t" "v_fmac_f32_dpp %3, %7, %16 row_newbcast:8 row_mask:0xf bank_mask:0xf\n\t" "v_fmac_f32_dpp %0, %4, %17 row_newbcast:9 row_mask:0xf bank_mask:0xf\n\t" "v_fmac_f32_dpp %1, %5, %17 row_newbcast:9 row_mask:0xf bank_mask:0xf\n\t" "v_fmac_f32_dpp %2, %6, %17 row_newbcast:9 row_mask:0xf bank_mask:0xf\n\t" "v_fmac_f32_dpp %3, %7, %17 row_newbcast:9 row_mask:0xf bank_mask:0xf\n\t" "v_fmac_f32_dpp %0, %4, %18 row_newbcast:10 row_mask:0xf bank_mask:0xf\n\t" "v_fmac_f32_dpp %1, %5, %18 row_newbcast:10 row_mask:0xf bank_mask:0xf\n\t" "v_fmac_f32_dpp %2, %6, %18 row_newbcast:10 row_mask:0xf bank_mask:0xf\n\t" "v_fmac_f32_dpp %3, %7, %18 row_newbcast:10 row_mask:0xf bank_mask:0xf\n\t" : "+v"(a0), "+v"(a1), "+v"(a2), "+v"(a3) : "v"(l0), "v"(l1), "v"(l2), "v"(l3), "v"(x0), "v"(x1), "v"(x2), "v"(x3), "v"(x4), "v"(x5), "v"(x6), "v"(x7), "v"(x8), "v"(x9), "v"(x10));
    }
};
template <> struct QuadChunk<12> {
    static __device__ __forceinline__ void run(float& a0, float& a1, float& a2, float& a3, float l0, float l1, float l2, float l3, float x0, float x1, float x2, float x3, float x4, float x5, float x6, float x7, float x8, float x9, float x10, float x11) {
        asm volatile("v_fmac_f32_dpp %0, %4, %8 row_newbcast:0 row_mask:0xf bank_mask:0xf\n\t" "v_fmac_f32_dpp %1, %5, %8 row_newbcast:0 row_mask:0xf bank_mask:0xf\n\t" "v_fmac_f32_dpp %2, %6, %8 row_newbcast:0 row_mask:0xf bank_mask:0xf\n\t" "v_fmac_f32_dpp %3, %7, %8 row_newbcast:0 row_mask:0xf bank_mask:0xf\n\t" "v_fmac_f32_dpp %0, %4, %9 row_newbcast:1 row_mask:0xf bank_mask:0xf\n\t" "v_fmac_f32_dpp %1, %5, %9 row_newbcast:1 row_mask:0xf bank_mask:0xf\n\t" "v_fmac_f32_dpp %2, %6, %9 row_newbcast:1 row_mask:0xf bank_mask:0xf\n\t" "v_fmac_f32_dpp %3, %7, %9 row_newbcast:1 row_mask:0xf bank_mask:0xf\n\t" "v_fmac_f32_dpp %0, %4, %10 row_newbcast:2 row_mask:0xf bank_mask:0xf\n\t" "v_fmac_f32_dpp %1, %5, %10 row_newbcast:2 row_mask:0xf bank_mask:0xf\n\t" "v_fmac_f32_dpp %2, %6, %10 row_newbcast:2 row_mask:0xf bank_mask:0xf\n\t" "v_fmac_f32_dpp %3, %7, %10 row_newbcast:2 row_mask:0xf bank_mask:0xf\n\t" "v_fmac_f32_dpp %0, %4, %11 row_newbcast:3 row_mask:0xf bank_mask:0xf\n\t" "v_fmac_f32_dpp %1, %5, %11 row_newbcast:3 row_mask:0xf bank_mask:0xf\n\t" "v_fmac_f32_dpp %2, %6, %11 row_newbcast:3 row_mask:0xf bank_mask:0xf\n\t" "v_fmac_f32_dpp %3, %7, %11 row_newbcast:3 row_mask:0xf bank_mask:0xf\n\t" "v_fmac_f32_dpp %0, %4, %12 row_newbcast:4 row_mask:0xf bank_mask:0xf\n\t" "v_fmac_f32_dpp %1, %5, %12 row_newbcast:4 row_mask:0xf bank_mask:0xf\n\t" "v_fmac_f32_dpp %2, %6, %12 row_newbcast:4 row_mask:0xf bank_mask:0xf\n\t" "v_fmac_f32_dpp %3, %7, %12 row_newbcast:4 row_mask:0xf bank_mask:0xf\n\t" "v_fmac_f32_dpp %0, %4, %13 row_newbcast:5 row_mask:0xf bank_mask:0xf\n\t" "v_fmac_f32_dpp %1, %5, %13 row_newbcast:5 row_mask:0xf bank_mask:0xf\n\t" "v_fmac_f32_dpp %2, %6, %13 row_newbcast:5 row_mask:0xf bank_mask:0xf\n\t" "v_fmac_f32_dpp %3, %7, %13 row_newbcast:5 row_mask:0xf bank_mask:0xf\n\t" "v_fmac_f32_dpp %0, %4, %14 row_newbcast:6 row_mask:0xf bank_mask:0xf\n\t" "v_fmac_f32_dpp %1, %5, %14 row_newbcast:6 row_mask:0xf bank_mask:0xf\n\t" "v_fmac_f32_dpp %2, %6, %14 row_newbcast:6 row_mask:0xf bank_mask:0xf\n\t" "v_fmac_f32_dpp %3, %7, %14 row_newbcast:6 row_mask:0xf bank_mask:0xf\n\t" "v_fmac_f32_dpp %0, %4, %15 row_newbcast:7 row_mask:0xf bank_mask:0xf\n\t" "v_fmac_f32_dpp %1, %5, %15 row_newbcast:7 row_mask:0xf bank_mask:0xf\n\t" "v_fmac_f32_dpp %2, %6, %15 row_newbcast:7 row_mask:0xf bank_mask:0xf\n\t" "v_fmac_f32_dpp %3, %7, %15 row_newbcast:7 row_mask:0xf bank_mask:0xf\n\t" "v_fmac_f32_dpp %0, %4, %16 row_newbcast:8 row_mask:0xf bank_mask:0xf\n\t" "v_fmac_f32_dpp %1, %5, %16 row_newbcast:8 row_mask:0xf bank_mask:0xf\n\t" "v_fmac_f32_dpp %2, %6, %16 row_newbcast:8 row_mask:0xf bank_mask:0xf\n\t" "v_fmac_f32_dpp %3, %7, %16 row_newbcast:8 row_mask:0xf bank_mask:0xf\n\t" "v_fmac_f32_dpp %0, %4, %17 row_newbcast:9 row_mask:0xf bank_mask:0xf\n\t" "v_fmac_f32_dpp %1, %5, %17 row_newbcast:9 row_mask:0xf bank_mask:0xf\n\t" "v_fmac_f32_dpp %2, %6, %17 row_newbcast:9 row_mask:0xf bank_mask:0xf\n\t" "v_fmac_f32_dpp %3, %7, %17 row_newbcast:9 row_mask:0xf bank_mask:0xf\n\t" "v_fmac_f32_dpp %0, %4, %18 row_newbcast:10 row_mask:0xf bank_mask:0xf\n\t" "v_fmac_f32_dpp %1, %5, %18 row_newbcast:10 row_mask:0xf bank_mask:0xf\n\t" "v_fmac_f32_dpp %2, %6, %18 row_newbcast:10 row_mask:0xf bank_mask:0xf\n\t" "v_fmac_f32_dpp %3, %7, %18 row_newbcast:10 row_mask:0xf bank_mask:0xf\n\t" "v_fmac_f32_dpp %0, %4, %19 row_newbcast:11 row_mask:0xf bank_mask:0xf\n\t" "v_fmac_f32_dpp %1, %5, %19 row_newbcast:11 row_mask:0xf bank_mask:0xf\n\t" "v_fmac_f32_dpp %2, %6, %19 row_newbcast:11 row_mask:0xf bank_mask:0xf\n\t" "v_fmac_f32_dpp %3, %7, %19 row_newbcast:11 row_mask:0xf bank_mask:0xf\n\t" : "+v"(a0), "+v"(a1), "+v"(a2), "+v"(a3) : "v"(l0), "v"(l1), "v"(l2), "v"(l3), "v"(x0), "v"(x1), "v"(x2), "v"(x3), "v"(x4), "v"(x5), "v"(x6), "v"(x7), "v"(x8), "v"(x9), "v"(x10), "v"(x11));
    }
};
template <> struct QuadChunk<13> {
    static __device__ __forceinline__ void run(float& a0, float& a1, float& a2, float& a3, float l0, float l1, float l2, float l3, float x0, float x1, float x2, float x3, float x4, float x5, float x6, float x7, float x8, float x9, float x10, float x11, float x12) {
        asm volatile("v_fmac_f32_dpp %0, %4, %8 row_newbcast:0 row_mask:0xf bank_mask:0xf\n\t" "v_fmac_f32_dpp %1, %5, %8 row_newbcast:0 row_mask:0xf bank_mask:0xf\n\t" "v_fmac_f32_dpp %2, %6, %8 row_newbcast:0 row_mask:0xf bank_mask:0xf\n\t" "v_fmac_f32_dpp %3, %7, %8 row_newbcast:0 row_mask:0xf bank_mask:0xf\n\t" "v_fmac_f32_dpp %0, %4, %9 row_newbcast:1 row_mask:0xf bank_mask:0xf\n\t" "v_fmac_f32_dpp %1, %5, %9 row_newbcast:1 row_mask:0xf bank_mask:0xf\n\t" "v_fmac_f32_dpp %2, %6, %9 row_newbcast:1 row_mask:0xf bank_mask:0xf\n\t" "v_fmac_f32_dpp %3, %7, %9 row_newbcast:1 row_mask:0xf bank_mask:0xf\n\t" "v_fmac_f32_dpp %0, %4, %10 row_newbcast:2 row_mask:0xf bank_mask:0xf\n\t" "v_fmac_f32_dpp %1, %5, %10 row_newbcast:2 row_mask:0xf bank_mask:0xf\n\t" "v_fmac_f32_dpp %2, %6, %10 row_newbcast:2 row_mask:0xf bank_mask:0xf\n\t" "v_fmac_f32_dpp %3, %7, %10 row_newbcast:2 row_mask:0xf bank_mask:0xf\n\t" "v_fmac_f32_dpp %0, %4, %11 row_newbcast:3 row_mask:0xf bank_mask:0xf\n\t" "v_fmac_f32_dpp %1, %5, %11 row_newbcast:3 row_mask:0xf bank_mask:0xf\n\t" "v_fmac_f32_dpp %2, %6, %11 row_newbcast:3 row_mask:0xf bank_mask:0xf\n\t" "v_fmac_f32_dpp %3, %7, %11 row_newbcast:3 row_mask:0xf bank_mask:0xf\n\t" "v_fmac_f32_dpp %0, %4, %12 row_newbcast:4 row_mask:0xf bank_mask:0xf\n\t" "v_fmac_f32_dpp %1, %5, %12 row_newbcast:4 row_mask:0xf bank_mask:0xf\n\t" "v_fmac_f32_dpp %2, %6, %12 row_newbcast:4 row_mask:0xf bank_mask:0xf\n\t" "v_fmac_f32_dpp %3, %7, %12 row_newbcast:4 row_mask:0xf bank_mask:0xf\n\t" "v_fmac_f32_dpp %0, %4, %13 row_newbcast:5 row_mask:0xf bank_mask:0xf\n\t" "v_fmac_f32_dpp %1, %5, %13 row_newbcast:5 row_mask:0xf bank_mask:0xf\n\t" "v_fmac_f32_dpp %2, %6, %13 row_newbcast:5 row_mask:0xf bank_mask:0xf\n\t" "v_fmac_f32_dpp %3, %7, %13 row_newbcast:5 row_mask:0xf bank_mask:0xf\n\t" "v_fmac_f32_dpp %0, %4, %14 row_newbcast:6 row_mask:0xf bank_mask:0xf\n\t" "v_fmac_f32_dpp %1, %5, %14 row_newbcast:6 row_mask:0xf bank_mask:0xf\n\t" "v_fmac_f32_dpp %2, %6, %14 row_newbcast:6 row_mask:0xf bank_mask:0xf\n\t" "v_fmac_f32_dpp %3, %7, %14 row_newbcast:6 row_mask:0xf bank_mask:0xf\n\t" "v_fmac_f32_dpp %0, %4, %15 row_newbcast:7 row_mask:0xf bank_mask:0xf\n\t" "v_fmac_f32_dpp %1, %5, %15 row_newbcast:7 row_mask:0xf bank_mask:0xf\n\t" "v_fmac_f32_dpp %2, %6, %15 row_newbcast:7 row_mask:0xf bank_mask:0xf\n\t" "v_fmac_f32_dpp %3, %7, %15 row_newbcast:7 row_mask:0xf bank_mask:0xf\n\t" "v_fmac_f32_dpp %0, %4, %16 row_newbcast:8 row_mask:0xf bank_mask:0xf\n\t" "v_fmac_f32_dpp %1, %5, %16 row_newbcast:8 row_mask:0xf bank_mask:0xf\n\t" "v_fmac_f32_dpp %2, %6, %16 row_newbcast:8 row_mask:0xf bank_mask:0xf\n\t" "v_fmac_f32_dpp %3, %7, %16 row_newbcast:8 row_mask:0xf bank_mask:0xf\n\t" "v_fmac_f32_dpp %0, %4, %17 row_newbcast:9 row_mask:0xf bank_mask:0xf\n\t" "v_fmac_f32_dpp %1, %5, %17 row_newbcast:9 row_mask:0xf bank_mask:0xf\n\t" "v_fmac_f32_dpp %2, %6, %17 row_newbcast:9 row_mask:0xf bank_mask:0xf\n\t" "v_fmac_f32_dpp %3, %7, %17 row_newbcast:9 row_mask:0xf bank_mask:0xf\n\t" "v_fmac_f32_dpp %0, %4, %18 row_newbcast:10 row_mask:0xf bank_mask:0xf\n\t" "v_fmac_f32_dpp %1, %5, %18 row_newbcast:10 row_mask:0xf bank_mask:0xf\n\t" "v_fmac_f32_dpp %2, %6, %18 row_newbcast:10 row_mask:0xf bank_mask:0xf\n\t" "v_fmac_f32_dpp %3, %7, %18 row_newbcast:10 row_mask:0xf bank_mask:0xf\n\t" "v_fmac_f32_dpp %0, %4, %19 row_newbcast:11 row_mask:0xf bank_mask:0xf\n\t" "v_fmac_f32_dpp %1, %5, %19 row_newbcast:11 row_mask:0xf bank_mask:0xf\n\t" "v_fmac_f32_dpp %2, %6, %19 row_newbcast:11 row_mask:0xf bank_mask:0xf\n\t" "v_fmac_f32_dpp %3, %7, %19 row_newbcast:11 row_mask:0xf bank_mask:0xf\n\t" "v_fmac_f32_dpp %0, %4, %20 row_newbcast:12 row_mask:0xf bank_mask:0xf\n\t" "v_fmac_f32_dpp %1, %5, %20 row_newbcast:12 row_mask:0xf bank_mask:0xf\n\t" "v_fmac_f32_dpp %2, %6, %20 row_newbcast:12 row_mask:0xf bank_mask:0xf\n\t" "v_fmac_f32_dpp %3, %7, %20 row_newbcast:12 row_mask:0xf bank_mask:0xf\n\t" : "+v"(a0), "+v"(a1), "+v"(a2), "+v"(a3) : "v"(l0), "v"(l1), "v"(l2), "v"(l3), "v"(x0), "v"(x1), "v"(x2), "v"(x3), "v"(x4), "v"(x5), "v"(x6), "v"(x7), "v"(x8), "v"(x9), "v"(x10), "v"(x11), "v"(x12));
    }
};
template <> struct QuadChunk<14> {
    static __device__ __forceinline__ void run(float& a0, float& a1, float& a2, float& a3, float l0, float l1, float l2, float l3, float x0, float x1, float x2, float x3, float x4, float x5, float x6, float x7, float x8, float x9, float x10, float x11, float x12, float x13) {
        asm volatile("v_fmac_f32_dpp %0, %4, %8 row_newbcast:0 row_mask:0xf bank_mask:0xf\n\t" "v_fmac_f32_dpp %1, %5, %8 row_newbcast:0 row_mask:0xf bank_mask:0xf\n\t" "v_fmac_f32_dpp %2, %6, %8 row_newbcast:0 row_mask:0xf bank_mask:0xf\n\t" "v_fmac_f32_dpp %3, %7, %8 row_newbcast:0 row_mask:0xf bank_mask:0xf\n\t" "v_fmac_f32_dpp %0, %4, %9 row_newbcast:1 row_mask:0xf bank_mask:0xf\n\t" "v_fmac_f32_dpp %1, %5, %9 row_newbcast:1 row_mask:0xf bank_mask:0xf\n\t" "v_fmac_f32_dpp %2, %6, %9 row_newbcast:1 row_mask:0xf bank_mask:0xf\n\t" "v_fmac_f32_dpp %3, %7, %9 row_newbcast:1 row_mask:0xf bank_mask:0xf\n\t" "v_fmac_f32_dpp %0, %4, %10 row_newbcast:2 row_mask:0xf bank_mask:0xf\n\t" "v_fmac_f32_dpp %1, %5, %10 row_newbcast:2 row_mask:0xf bank_mask:0xf\n\t" "v_fmac_f32_dpp %2, %6, %10 row_newbcast:2 row_mask:0xf bank_mask:0xf\n\t" "v_fmac_f32_dpp %3, %7, %10 row_newbcast:2 row_mask:0xf bank_mask:0xf\n\t" "v_fmac_f32_dpp %0, %4, %11 row_newbcast:3 row_mask:0xf bank_mask:0xf\n\t" "v_fmac_f32_dpp %1, %5, %11 row_newbcast:3 row_mask:0xf bank_mask:0xf\n\t" "v_fmac_f32_dpp %2, %6, %11 row_newbcast:3 row_mask:0xf bank_mask:0xf\n\t" "v_fmac_f32_dpp %3, %7, %11 row_newbcast:3 row_mask:0xf bank_mask:0xf\n\t" "v_fmac_f32_dpp %0, %4, %12 row_newbcast:4 row_mask:0xf bank_mask:0xf\n\t" "v_fmac_f32_dpp %1, %5, %12 row_newbcast:4 row_mask:0xf bank_mask:0xf\n\t" "v_fmac_f32_dpp %2, %6, %12 row_newbcast:4 row_mask:0xf bank_mask:0xf\n\t" "v_fmac_f32_dpp %3, %7, %12 row_newbcast:4 row_mask:0xf bank_mask:0xf\n\t" "v_fmac_f32_dpp %0, %4, %13 row_newbcast:5 row_mask:0xf bank_mask:0xf\n\t" "v_fmac_f32_dpp %1, %5, %13 row_newbcast:5 row_mask:0xf bank_mask:0xf\n\t" "v_fmac_f32_dpp %2, %6, %13 row_newbcast:5 row_mask:0xf bank_mask:0xf\n\t" "v_fmac_f32_dpp %3, %7, %13 row_newbcast:5 row_mask:0xf bank_mask:0xf\n\t" "v_fmac_f32_dpp %0, %4, %14 row_newbcast:6 row_mask:0xf bank_mask:0xf\n\t" "v_fmac_f32_dpp %1, %5, %14 row_newbcast:6 row_mask:0xf bank_mask:0xf\n\t" "v_fmac_f32_dpp %2, %6, %14 row_newbcast:6 row_mask:0xf bank_mask:0xf\n\t" "v_fmac_f32_dpp %3, %7, %14 row_newbcast:6 row_mask:0xf bank_mask:0xf\n\t" "v_fmac_f32_dpp %0, %4, %15 row_newbcast:7 row_mask:0xf bank_mask:0xf\n\t" "v_fmac_f32_dpp %1, %5, %15 row_newbcast:7 row_mask:0xf bank_mask:0xf\n\t" "v_fmac_f32_dpp %2, %6, %15 row_newbcast:7 row_mask:0xf bank_mask:0xf\n\t" "v_fmac_f32_dpp %3, %7, %15 row_newbcast:7 row_mask:0xf bank_mask:0xf\n\t" "v_fmac_f32_dpp %0, %4, %16 row_newbcast:8 row_mask:0xf bank_mask:0xf\n\t" "v_fmac_f32_dpp %1, %5, %16 row_newbcast:8 row_mask:0xf bank_mask:0xf\n\t" "v_fmac_f32_dpp %2, %6, %16 row_newbcast:8 row_mask:0xf bank_mask:0xf\n\t" "v_fmac_f32_dpp %3, %7, %16 row_newbcast:8 row_mask:0xf bank_mask:0xf\n\t" "v_fmac_f32_dpp %0, %4, %17 row_newbcast:9 row_mask:0xf bank_mask:0xf\n\t" "v_fmac_f32_dpp %1, %5, %17 row_newbcast:9 row_mask:0xf bank_mask:0xf\n\t" "v_fmac_f32_dpp %2, %6, %17 row_newbcast:9 row_mask:0xf bank_mask:0xf\n\t" "v_fmac_f32_dpp %3, %7, %17 row_newbcast:9 row_mask:0xf bank_mask:0xf\n\t" "v_fmac_f32_dpp %0, %4, %18 row_newbcast:10 row_mask:0xf bank_mask:0xf\n\t" "v_fmac_f32_dpp %1, %5, %18 row_newbcast:10 row_mask:0xf bank_mask:0xf\n\t" "v_fmac_f32_dpp %2, %6, %18 row_newbcast:10 row_mask:0xf bank_mask:0xf\n\t" "v_fmac_f32_dpp %3, %7, %18 row_newbcast:10 row_mask:0xf bank_mask:0xf\n\t" "v_fmac_f32_dpp %0, %4, %19 row_newbcast:11 row_mask:0xf bank_mask:0xf\n\t" "v_fmac_f32_dpp %1, %5, %19 row_newbcast:11 row_mask:0xf bank_mask:0xf\n\t" "v_fmac_f32_dpp %2, %6, %19 row_newbcast:11 row_mask:0xf bank_mask:0xf\n\t" "v_fmac_f32_dpp %3, %7, %19 row_newbcast:11 row_mask:0xf bank_mask:0xf\n\t" "v_fmac_f32_dpp %0, %4, %20 row_newbcast:12 row_mask:0xf bank_mask:0xf\n\t" "v_fmac_f32_dpp %1, %5, %20 row_newbcast:12 row_mask:0xf bank_mask:0xf\n\t" "v_fmac_f32_dpp %2, %6, %20 row_newbcast:12 row_mask:0xf bank_mask:0xf\n\t" "v_fmac_f32_dpp %3, %7, %20 row_newbcast:12 row_mask:0xf bank_mask:0xf\n\t" "v_fmac_f32_dpp %0, %4, %21 row_newbcast:13 row_mask:0xf bank_mask:0xf\n\t" "v_fmac_f32_dpp %1, %5, %21 row_newbcast:13 row_mask:0xf bank_mask:0xf\n\t" "v_fmac_f32_dpp %2, %6, %21 row_newbcast:13 row_mask:0xf bank_mask:0xf\n\t" "v_fmac_f32_dpp %3, %7, %21 row_newbcast:13 row_mask:0xf bank_mask:0xf\n\t" : "+v"(a0), "+v"(a1), "+v"(a2), "+v"(a3) : "v"(l0), "v"(l1), "v"(l2), "v"(l3), "v"(x0), "v"(x1), "v"(x2), "v"(x3), "v"(x4), "v"(x5), "v"(x6), "v"(x7), "v"(x8), "v"(x9), "v"(x10), "v"(x11), "v"(x12), "v"(x13));
    }
};
template <> struct QuadChunk<15> {
    static __device__ __forceinline__ void run(float& a0, float& a1, float& a2, float& a3, float l0, float l1, float l2, float l3, float x0, float x1, float x2, float x3, float x4, float x5, float x6, float x7, float x8, float x9, float x10, float x11, float x12, float x13, float x14) {
        asm volatile("v_fmac_f32_dpp %0, %4, %8 row_newbcast:0 row_mask:0xf bank_mask:0xf\n\t" "v_fmac_f32_dpp %1, %5, %8 row_newbcast:0 row_mask:0xf bank_mask:0xf\n\t" "v_fmac_f32_dpp %2, %6, %8 row_newbcast:0 row_mask:0xf bank_mask:0xf\n\t" "v_fmac_f32_dpp %3, %7, %8 row_newbcast:0 row_mask:0xf bank_mask:0xf\n\t" "v_fmac_f32_dpp %0, %4, %9 row_newbcast:1 row_mask:0xf bank_mask:0xf\n\t" "v_fmac_f32_dpp %1, %5, %9 row_newbcast:1 row_mask:0xf bank_mask:0xf\n\t" "v_fmac_f32_dpp %2, %6, %9 row_newbcast:1 row_mask:0xf bank_mask:0xf\n\t" "v_fmac_f32_dpp %3, %7, %9 row_newbcast:1 row_mask:0xf bank_mask:0xf\n\t" "v_fmac_f32_dpp %0, %4, %10 row_newbcast:2 row_mask:0xf bank_mask:0xf\n\t" "v_fmac_f32_dpp %1, %5, %10 row_newbcast:2 row_mask:0xf bank_mask:0xf\n\t" "v_fmac_f32_dpp %2, %6, %10 row_newbcast:2 row_mask:0xf bank_mask:0xf\n\t" "v_fmac_f32_dpp %3, %7, %10 row_newbcast:2 row_mask:0xf bank_mask:0xf\n\t" "v_fmac_f32_dpp %0, %4, %11 row_newbcast:3 row_mask:0xf bank_mask:0xf\n\t" "v_fmac_f32_dpp %1, %5, %11 row_newbcast:3 row_mask:0xf bank_mask:0xf\n\t" "v_fmac_f32_dpp %2, %6, %11 row_newbcast:3 row_mask:0xf bank_mask:0xf\n\t" "v_fmac_f32_dpp %3, %7, %11 row_newbcast:3 row_mask:0xf bank_mask:0xf\n\t" "v_fmac_f32_dpp %0, %4, %12 row_newbcast:4 row_mask:0xf bank_mask:0xf\n\t" "v_fmac_f32_dpp %1, %5, %12 row_newbcast:4 row_mask:0xf bank_mask:0xf\n\t" "v_fmac_f32_dpp %2, %6, %12 row_newbcast:4 row_mask:0xf bank_mask:0xf\n\t" "v_fmac_f32_dpp %3, %7, %12 row_newbcast:4 row_mask:0xf bank_mask:0xf\n\t" "v_fmac_f32_dpp %0, %4, %13 row_newbcast:5 row_mask:0xf bank_mask:0xf\n\t" "v_fmac_f32_dpp %1, %5, %13 row_newbcast:5 row_mask:0xf bank_mask:0xf\n\t" "v_fmac_f32_dpp %2, %6, %13 row_newbcast:5 row_mask:0xf bank_mask:0xf\n\t" "v_fmac_f32_dpp %3, %7, %13 row_newbcast:5 row_mask:0xf bank_mask:0xf\n\t" "v_fmac_f32_dpp %0, %4, %14 row_newbcast:6 row_mask:0xf bank_mask:0xf\n\t" "v_fmac_f32_dpp %1, %5, %14 row_newbcast:6 row_mask:0xf bank_mask:0xf\n\t" "v_fmac_f32_dpp %2, %6, %14 row_newbcast:6 row_mask:0xf bank_mask:0xf\n\t" "v_fmac_f32_dpp %3, %7, %14 row_newbcast:6 row_mask:0xf bank_mask:0xf\n\t" "v_fmac_f32_dpp %0, %4, %15 row_newbcast:7 row_mask:0xf bank_mask:0xf\n\t" "v_fmac_f32_dpp %1, %5, %15 row_newbcast:7 row_mask:0xf bank_mask:0xf\n\t" "v_fmac_f32_dpp %2, %6, %15 row_newbcast:7 row_mask:0xf bank_mask:0xf\n\t" "v_fmac_f32_dpp %3, %7, %15 row_newbcast:7 row_mask:0xf bank_mask:0xf\n\t" "v_fmac_f32_dpp %0, %4, %16 row_newbcast:8 row_mask:0xf bank_mask:0xf\n\t" "v_fmac_f32_dpp %1, %5, %16 row_newbcast:8 row_mask:0xf bank_mask:0xf\n\t" "v_fmac_f32_dpp %2, %6, %16 row_newbcast:8 row_mask:0xf bank_mask:0xf\n\t" "v_fmac_f32_dpp %3, %7, %16 row_newbcast:8 row_mask:0xf bank_mask:0xf\n\t" "v_fmac_f32_dpp %0, %4, %17 row_newbcast:9 row_mask:0xf bank_mask:0xf\n\t" "v_fmac_f32_dpp %1, %5, %17 row_newbcast:9 row_mask:0xf bank_mask:0xf\n\t" "v_fmac_f32_dpp %2, %6, %17 row_newbcast:9 row_mask:0xf bank_mask:0xf\n\t" "v_fmac_f32_dpp %3, %7, %17 row_newbcast:9 row_mask:0xf bank_mask:0xf\n\t" "v_fmac_f32_dpp %0, %4, %18 row_newbcast:10 row_mask:0xf bank_mask:0xf\n\t" "v_fmac_f32_dpp %1, %5, %18 row_newbcast:10 row_mask:0xf bank_mask:0xf\n\t" "v_fmac_f32_dpp %2, %6, %18 row_newbcast:10 row_mask:0xf bank_mask:0xf\n\t" "v_fmac_f32_dpp %3, %7, %18 row_newbcast:10 row_mask:0xf bank_mask:0xf\n\t" "v_fmac_f32_dpp %0, %4, %19 row_newbcast:11 row_mask:0xf bank_mask:0xf\n\t" "v_fmac_f32_dpp %1, %5, %19 row_newbcast:11 row_mask:0xf bank_mask:0xf\n\t" "v_fmac_f32_dpp %2, %6, %19 row_newbcast:11 row_mask:0xf bank_mask:0xf\n\t" "v_fmac_f32_dpp %3, %7, %19 row_newbcast:11 row_mask:0xf bank_mask:0xf\n\t" "v_fmac_f32_dpp %0, %4, %20 row_newbcast:12 row_mask:0xf bank_mask:0xf\n\t" "v_fmac_f32_dpp %1, %5, %20 row_newbcast:12 row_mask:0xf bank_mask:0xf\n\t" "v_fmac_f32_dpp %2, %6, %20 row_newbcast:12 row_mask:0xf bank_mask:0xf\n\t" "v_fmac_f32_dpp %3, %7, %20 row_newbcast:12 row_mask:0xf bank_mask:0xf\n\t" "v_fmac_f32_dpp %0, %4, %21 row_newbcast:13 row_mask:0xf bank_mask:0xf\n\t" "v_fmac_f32_dpp %1, %5, %21 row_newbcast:13 row_mask:0xf bank_mask:0xf\n\t" "v_fmac_f32_dpp %2, %6, %21 row_newbcast:13 row_mask:0xf bank_mask:0xf\n\t" "v_fmac_f32_dpp %3, %7, %21 row_newbcast:13 row_mask:0xf bank_mask:0xf\n\t" "v_fmac_f32_dpp %0, %4, %22 row_newbcast:14 row_mask:0xf bank_mask:0xf\n\t" "v_fmac_f32_dpp %1, %5, %22 row_newbcast:14 row_mask:0xf bank_mask:0xf\n\t" "v_fmac_f32_dpp %2, %6, %22 row_newbcast:14 row_mask:0xf bank_mask:0xf\n\t" "v_fmac_f32_dpp %3, %7, %22 row_newbcast:14 row_mask:0xf bank_mask:0xf\n\t" : "+v"(a0), "+v"(a1), "+v"(a2), "+v"(a3) : "v"(l0), "v"(l1), "v"(l2), "v"(l3), "v"(x0), "v"(x1), "v"(x2), "v"(x3), "v"(x4), "v"(x5), "v"(x6), "v"(x7), "v"(x8), "v"(x9), "v"(x10), "v"(x11), "v"(x12), "v"(x13), "v"(x14));
    }
};
template <> struct QuadChunk<16> {
    static __device__ __forceinline__ void run(float& a0, float& a1, float& a2, float& a3, float l0, float l1, float l2, float l3, float x0, float x1, float x2, float x3, float x4, float x5, float x6, float x7, float x8, float x9, float x10, float x11, float x12, float x13, float x14, float x15) {
        asm volatile("v_fmac_f32_dpp %0, %4, %8 row_newbcast:0 row_mask:0xf bank_mask:0xf\n\t" "v_fmac_f32_dpp %1, %5, %8 row_newbcast:0 row_mask:0xf bank_mask:0xf\n\t" "v_fmac_f32_dpp %2, %6, %8 row_newbcast:0 row_mask:0xf bank_mask:0xf\n\t" "v_fmac_f32_dpp %3, %7, %8 row_newbcast:0 row_mask:0xf bank_mask:0xf\n\t" "v_fmac_f32_dpp %0, %4, %9 row_newbcast:1 row_mask:0xf bank_mask:0xf\n\t" "v_fmac_f32_dpp %1, %5, %9 row_newbcast:1 row_mask:0xf bank_mask:0xf\n\t" "v_fmac_f32_dpp %2, %6, %9 row_newbcast:1 row_mask:0xf bank_mask:0xf\n\t" "v_fmac_f32_dpp %3, %7, %9 row_newbcast:1 row_mask:0xf bank_mask:0xf\n\t" "v_fmac_f32_dpp %0, %4, %10 row_newbcast:2 row_mask:0xf bank_mask:0xf\n\t" "v_fmac_f32_dpp %1, %5, %10 row_newbcast:2 row_mask:0xf bank_mask:0xf\n\t" "v_fmac_f32_dpp %2, %6, %10 row_newbcast:2 row_mask:0xf bank_mask:0xf\n\t" "v_fmac_f32_dpp %3, %7, %10 row_newbcast:2 row_mask:0xf bank_mask:0xf\n\t" "v_fmac_f32_dpp %0, %4, %11 row_newbcast:3 row_mask:0xf bank_mask:0xf\n\t" "v_fmac_f32_dpp %1, %5, %11 row_newbcast:3 row_mask:0xf bank_mask:0xf\n\t" "v_fmac_f32_dpp %2, %6, %11 row_newbcast:3 row_mask:0xf bank_mask:0xf\n\t" "v_fmac_f32_dpp %3, %7, %11 row_newbcast:3 row_mask:0xf bank_mask:0xf\n\t" "v_fmac_f32_dpp %0, %4, %12 row_newbcast:4 row_mask:0xf bank_mask:0xf\n\t" "v_fmac_f32_dpp %1, %5, %12 row_newbcast:4 row_mask:0xf bank_mask:0xf\n\t" "v_fmac_f32_dpp %2, %6, %12 row_newbcast:4 row_mask:0xf bank_mask:0xf\n\t" "v_fmac_f32_dpp %3, %7, %12 row_newbcast:4 row_mask:0xf bank_mask:0xf\n\t" "v_fmac_f32_dpp %0, %4, %13 row_newbcast:5 row_mask:0xf bank_mask:0xf\n\t" "v_fmac_f32_dpp %1, %5, %13 row_newbcast:5 row_mask:0xf bank_mask:0xf\n\t" "v_fmac_f32_dpp %2, %6, %13 row_newbcast:5 row_mask:0xf bank_mask:0xf\n\t" "v_fmac_f32_dpp %3, %7, %13 row_newbcast:5 row_mask:0xf bank_mask:0xf\n\t" "v_fmac_f32_dpp %0, %4, %14 row_newbcast:6 row_mask:0xf bank_mask:0xf\n\t" "v_fmac_f32_dpp %1, %5, %14 row_newbcast:6 row_mask:0xf bank_mask:0xf\n\t" "v_fmac_f32_dpp %2, %6, %14 row_newbcast:6 row_mask:0xf bank_mask:0xf\n\t" "v_fmac_f32_dpp %3, %7, %14 row_newbcast:6 row_mask:0xf bank_mask:0xf\n\t" "v_fmac_f32_dpp %0, %4, %15 row_newbcast:7 row_mask:0xf bank_mask:0xf\n\t" "v_fmac_f32_dpp %1, %5, %15 row_newbcast:7 row_mask:0xf bank_mask:0xf\n\t" "v_fmac_f32_dpp %2, %6, %15 row_newbcast:7 row_mask:0xf bank_mask:0xf\n\t" "v_fmac_f32_dpp %3, %7, %15 row_newbcast:7 row_mask:0xf bank_mask:0xf\n\t" "v_fmac_f32_dpp %0, %4, %16 row_newbcast:8 row_mask:0xf bank_mask:0xf\n\t" "v_fmac_f32_dpp %1, %5, %16 row_newbcast:8 row_mask:0xf bank_mask:0xf\n\t" "v_fmac_f32_dpp %2, %6, %16 row_newbcast:8 row_mask:0xf bank_mask:0xf\n\t" "v_fmac_f32_dpp %3, %7, %16 row_newbcast:8 row_mask:0xf bank_mask:0xf\n\t" "v_fmac_f32_dpp %0, %4, %17 row_newbcast:9 row_mask:0xf bank_mask:0xf\n\t" "v_fmac_f32_dpp %1, %5, %17 row_newbcast:9 row_mask:0xf bank_mask:0xf\n\t" "v_fmac_f32_dpp %2, %6, %17 row_newbcast:9 row_mask:0xf bank_mask:0xf\n\t" "v_fmac_f32_dpp %3, %7, %17 row_newbcast:9 row_mask:0xf bank_mask:0xf\n\t" "v_fmac_f32_dpp %0, %4, %18 row_newbcast:10 row_mask:0xf bank_mask:0xf\n\t" "v_fmac_f32_dpp %1, %5, %18 row_newbcast:10 row_mask:0xf bank_mask:0xf\n\t" "v_fmac_f32_dpp %2, %6, %18 row_newbcast:10 row_mask:0xf bank_mask:0xf\n\t" "v_fmac_f32_dpp %3, %7, %18 row_newbcast:10 row_mask:0xf bank_mask:0xf\n\t" "v_fmac_f32_dpp %0, %4, %19 row_newbcast:11 row_mask:0xf bank_mask:0xf\n\t" "v_fmac_f32_dpp %1, %5, %19 row_newbcast:11 row_mask:0xf bank_mask:0xf\n\t" "v_fmac_f32_dpp %2, %6, %19 row_newbcast:11 row_mask:0xf bank_mask:0xf\n\t" "v_fmac_f32_dpp %3, %7, %19 row_newbcast:11 row_mask:0xf bank_mask:0xf\n\t" "v_fmac_f32_dpp %0, %4, %20 row_newbcast:12 row_mask:0xf bank_mask:0xf\n\t" "v_fmac_f32_dpp %1, %5, %20 row_newbcast:12 row_mask:0xf bank_mask:0xf\n\t" "v_fmac_f32_dpp %2, %6, %20 row_newbcast:12 row_mask:0xf bank_mask:0xf\n\t" "v_fmac_f32_dpp %3, %7, %20 row_newbcast:12 row_mask:0xf bank_mask:0xf\n\t" "v_fmac_f32_dpp %0, %4, %21 row_newbcast:13 row_mask:0xf bank_mask:0xf\n\t" "v_fmac_f32_dpp %1, %5, %21 row_newbcast:13 row_mask:0xf bank_mask:0xf\n\t" "v_fmac_f32_dpp %2, %6, %21 row_newbcast:13 row_mask:0xf bank_mask:0xf\n\t" "v_fmac_f32_dpp %3, %7, %21 row_newbcast:13 row_mask:0xf bank_mask:0xf\n\t" "v_fmac_f32_dpp %0, %4, %22 row_newbcast:14 row_mask:0xf bank_mask:0xf\n\t" "v_fmac_f32_dpp %1, %5, %22 row_newbcast:14 row_mask:0xf bank_mask:0xf\n\t" "v_fmac_f32_dpp %2, %6, %22 row_newbcast:14 row_mask:0xf bank_mask:0xf\n\t" "v_fmac_f32_dpp %3, %7, %22 row_newbcast:14 row_mask:0xf bank_mask:0xf\n\t" "v_fmac_f32_dpp %0, %4, %23 row_newbcast:15 row_mask:0xf bank_mask:0xf\n\t" "v_fmac_f32_dpp %1, %5, %23 row_newbcast:15 row_mask:0xf bank_mask:0xf\n\t" "v_fmac_f32_dpp %2, %6, %23 row_newbcast:15 row_mask:0xf bank_mask:0xf\n\t" "v_fmac_f32_dpp %3, %7, %23 row_newbcast:15 row_mask:0xf bank_mask:0xf\n\t" : "+v"(a0), "+v"(a1), "+v"(a2), "+v"(a3) : "v"(l0), "v"(l1), "v"(l2), "v"(l3), "v"(x0), "v"(x1), "v"(x2), "v"(x3), "v"(x4), "v"(x5), "v"(x6), "v"(x7), "v"(x8), "v"(x9), "v"(x10), "v"(x11), "v"(x12), "v"(x13), "v"(x14), "v"(x15));
    }
};
template <int N, int B> struct QuadCall;
#define QC_DEF(N) template <int B> struct QuadCall<N, B> { static __device__ __forceinline__ void run(float (&x)[64], int I, float (&l)[4][4], int Q); };
#undef QC_DEF
#define QC_DEF(N) template <int B> struct QuadCallI { };
#undef QC_DEF
template <int N, int B, int I, int Q> struct QuadDo;
#define QD_DEF(N) template <int B, int I, int Q> struct QuadDo<N, B, I, Q> { static __device__ __forceinline__ void run(float (&x)[64], const float (&l)[4][4]) { QuadChunk<N>::run(x[I], x[I + 1], x[I + 2], x[I + 3], l[0][Q], l[1][Q], l[2][Q], l[3][Q], CC_ARGS##N(B)); } };
QD_DEF(1) QD_DEF(2) QD_DEF(3) QD_DEF(4) QD_DEF(5) QD_DEF(6) QD_DEF(7) QD_DEF(8) QD_DEF(9) QD_DEF(10) QD_DEF(11) QD_DEF(12) QD_DEF(13) QD_DEF(14) QD_DEF(15) QD_DEF(16)
#undef QD_DEF
template <int I, int Q> struct SolveQuadBlocks {
    static __device__ __forceinline__ void run(float (&x)[64], const float (&l)[4][4]) {
        if constexpr (Q > 0) SolveQuadBlocks<I, Q - 1>::run(x, l);
        constexpr int n = (I - 16 * Q) < 16 ? (I - 16 * Q) : 16;
        QuadDo<n, 16 * Q, I, Q>::run(x, l);
    }
};
template <int I> struct SolveRows {
    static __device__ __forceinline__ void run(float (&x)[64], const LAS float* Ls, int l15) {
        if constexpr (I > 0) SolveRows<I - 4>::run(x, Ls, l15);
        float l[4][4];
#pragma unroll
        for (int r = 0; r < 4; ++r)
#pragma unroll
            for (int q = 0; q < 4; ++q) l[r][q] = (16 * q < I + 3) ? Ls[(I + r) * 68 + 16 * q + l15] : 0.f;
        if constexpr (I > 0) SolveQuadBlocks<I, (I - 1) / 16>::run(x, l);
        constexpr int QB = I >> 4, L0 = I & 15;
        fmac_bcast<L0>(x[I + 1], l[1][QB], x[I]);
        fmac_bcast<L0>(x[I + 2], l[2][QB], x[I]); fmac_bcast<L0>(x[I + 3], l[3][QB], x[I]);
        fmac_bcast<L0 + 1>(x[I + 2], l[2][QB], x[I + 1]); fmac_bcast<L0 + 1>(x[I + 3], l[3][QB], x[I + 1]);
        fmac_bcast<L0 + 2>(x[I + 3], l[3][QB], x[I + 2]);
        if ((I & 7) == 4) asm volatile("" ::: "memory");
    }
};

#define XB_TMO      128
#define XB_XCNT(j)  (256  + 64 * (j))
#define XB_XSUB(j)  (1280 + 64 * (j))
#define XB_XGEN(j)  (2304 + 64 * (j))
#define XB_TOP      3328
#define XB_TOPGEN   3392
#define XCD_BAR_WORDS 3456
#define XB_SPIN_CAP (1u << 18)
__device__ __forceinline__ unsigned xb_ld(unsigned* p)              { return __hip_atomic_load(p, __ATOMIC_RELAXED, __HIP_MEMORY_SCOPE_AGENT); }
__device__ __forceinline__ unsigned xb_add(unsigned* p, unsigned v) { return __hip_atomic_fetch_add(p, v, __ATOMIC_RELAXED, __HIP_MEMORY_SCOPE_AGENT); }
__device__ __forceinline__ unsigned xb_xcc_id() { return (unsigned)__builtin_amdgcn_s_getreg((3 << 11) | 20) & 0xFu; }
#define XB_SPIN(cond, bar) do { unsigned _sp = 0; while (cond) { __builtin_amdgcn_s_sleep(1); \
    if ((++_sp & 255u) == 0u) { if (xb_ld(&(bar)[XB_TMO])) break; if (_sp > XB_SPIN_CAP) { atomicAdd(&(bar)[XB_TMO], 1u); break; } } } } while (0)
struct XcdBarrier { unsigned* bar; unsigned x; volatile LAS unsigned* st; };
__device__ __forceinline__ XcdBarrier xcd_barrier_post(unsigned* bar, volatile LAS unsigned* st) {
    XcdBarrier b; b.bar = bar; b.x = xb_xcc_id(); b.st = st;
    if (threadIdx.x == 0) (void)xb_add(&bar[XB_XCNT(b.x)], 1u);
    return b;
}
__device__ __forceinline__ void xcd_barrier_complete(unsigned* bar, unsigned x, unsigned& nloc, unsigned& nx) {
    const unsigned G = gridDim.x * gridDim.y * gridDim.z;
    unsigned sum, cnt, mine, sp = 0u;
    for (;;) {
        sum = 0u; cnt = 0u; mine = 0u;
#pragma unroll
        for (unsigned j = 0; j < 16; ++j) { const unsigned c = xb_ld(&bar[XB_XCNT(j)]); sum += c; cnt += (c > 0u) ? 1u : 0u; mine = (j == x) ? c : mine; }
        if (sum == G) break;
        __builtin_amdgcn_s_sleep(1);
        if ((++sp & 255u) == 0u) { if (xb_ld(&bar[XB_TMO])) break; if (sp > XB_SPIN_CAP) { atomicAdd(&bar[XB_TMO], 1u); break; } }
    }
    nloc = mine > 0u ? mine : 1u; nx = cnt > 0u ? cnt : 1u;
}
__device__ __forceinline__ void xcd_barrier(const XcdBarrier& b) {
    asm volatile("s_waitcnt vmcnt(0)" ::: "memory");
    __syncthreads();
    if (threadIdx.x == 0) {
        unsigned* bar = b.bar;
        __builtin_amdgcn_s_waitcnt(0);
        unsigned nloc = b.st[0], nx = b.st[1];
        if (nloc == 0u) { xcd_barrier_complete(bar, b.x, nloc, nx); b.st[0] = nloc; b.st[1] = nx; }
        const unsigned old = xb_add(&bar[XB_XSUB(b.x)], 1u);
        const unsigned gen = old / nloc;
        if (old + 1u == (gen + 1u) * nloc) {
            __builtin_amdgcn_fence(__ATOMIC_RELEASE, "agent");
            asm volatile("s_waitcnt vmcnt(0)" ::: "memory");
            const unsigned og = xb_add(&bar[XB_TOP], 1u);
            const unsigned tg = og / nx;
            if (og + 1u == (tg + 1u) * nx) xb_add(&bar[XB_TOPGEN], 1u);
            else XB_SPIN(xb_ld(&bar[XB_TOPGEN]) == tg, bar);
            __builtin_amdgcn_fence(__ATOMIC_ACQUIRE, "agent");
            xb_add(&bar[XB_XGEN(b.x)], 1u);
            asm volatile("s_waitcnt vmcnt(0)" ::: "memory");
        } else {
            XB_SPIN(xb_ld(&bar[XB_XGEN(b.x)]) == gen, bar);
            __builtin_amdgcn_fence(__ATOMIC_ACQUIRE, "agent");
            asm volatile("s_waitcnt vmcnt(0)" ::: "memory");
        }
    }
    __syncthreads();
}

struct Frame {
    LAS unsigned char* lds;
    volatile LAS unsigned* MISC;
    unsigned* ctl;
    int tid, lane, wave, vcu, G;
    const float* in[25]; float* out; unsigned char* ws;
};
enum { I_X = 0, I_P, I_NORM_MIX, I_W_IN, I_POOL_W, I_POOL_SCALE, I_CONV_W, I_A_LOG, I_DT_BIAS, I_DN_NORM, I_W_UP_POOL, I_W_UP_DN, I_W_OUT, I_NORM_MOE,
       I_W_RG, I_B_RG, I_W_RE, I_B_RE, I_W_GATE, I_W_UP, I_W_DOWN, I_NORM_PLE, I_W_PLE_GATE, I_W_PLE_PROJ, I_NORM_FINAL };

struct Unit { int pn, e, arow0, nrows, lrow0; };
template <int RB> struct DenseSched {
    int nM, nN, G, c, K;
    __device__ __forceinline__ void init(int M, int N, int K_, int G_, int c_) { nM = M / RB; nN = N / 256; G = G_; c = c_; K = K_; }
    __device__ __forceinline__ bool next(int i, Unit& u) const {
        const long L = (long)i * G + c; if (L >= (long)nM * nN) return false;
        const int pm = (int)(L / nN); u.pn = (int)(L % nN); u.e = 0; u.arow0 = pm * RB; u.nrows = RB; u.lrow0 = 0; return true;
    }
    __device__ __forceinline__ int arow(const Unit& u, int r) const { return u.arow0 + r; }
    __device__ __forceinline__ size_t boff(const Unit& u) const { return (size_t)u.pn * 256 * K; }
};
template <int RB, bool GATHER> struct MoeSched {
    const LAS int* pre; const LAS int* base; const int* ltk; int nN, G, c, K, Nfull;
    __device__ __forceinline__ bool next(int i, Unit& u) const {
        const long L = (long)i * G + c; if (L >= (long)pre[NE] * nN) return false;
        const int blk = (int)(L / nN); u.pn = (int)(L % nN);
        int e = 0;
        for (int j = 1; j < NE; ++j) if (pre[j] <= blk) e = j;
        const int rb = blk - pre[e]; const int cnt = base[e + 1] - base[e];
        const int nr = (cnt - rb * RB) < RB ? (cnt - rb * RB) : RB;
        u.e = __builtin_amdgcn_readfirstlane(e); u.lrow0 = __builtin_amdgcn_readfirstlane(rb * RB); u.arow0 = __builtin_amdgcn_readfirstlane(base[e] + rb * RB); u.nrows = __builtin_amdgcn_readfirstlane(nr);
        u.pn = __builtin_amdgcn_readfirstlane(u.pn); return true;
    }
    __device__ __forceinline__ int arow(const Unit& u, int r) const {
        const int rr = r < u.nrows ? r : u.nrows - 1;
        if (GATHER) return ltk[(size_t)u.e * T + u.lrow0 + rr] >> 1;
        return u.arow0 + rr;
    }
    __device__ __forceinline__ size_t boff(const Unit& u) const { return ((size_t)u.e * Nfull + (size_t)u.pn * 256) * K; }
};
template <int RB> __device__ __forceinline__ void moe_tables(Frame& F, LAS int* pre, LAS int* base) {
    __syncthreads();
    if (F.tid == 0) { int p = 0, b = 0; for (int e = 0; e < NE; ++e) { const int c = (int)F.ctl[CW_CNT + 64 * e]; pre[e] = p; base[e] = b; p += (c + RB - 1) / RB; b += c; } pre[NE] = p; base[NE] = b; }
    __syncthreads();
}

constexpr int SG_RB = 64, SG_BK = 32, SG_ALD = 68, SG_BLD = 260;
template <class Epi, class Sched>
__device__ __forceinline__ void sgemm_phase(Frame& F, const bf16* A, const bf16* Bt, int K, const Sched& S, const Epi& E) {
    LAS float* As = (LAS float*)(F.lds + RING_OFF);
    LAS float* Bs = As + SG_BK * SG_ALD;
    const int tid = F.tid, rg = tid >> 4, cg = tid & 15;
    const int la = tid >> 3, kq = (tid & 7) * 4;
    const int nb = tid >> 1, kh = (tid & 1) * 16;
    for (int i = 0;; ++i) {
        Unit u; if (!S.next(i, u)) break;
        const bf16* ap = A + (size_t)S.arow(u, la) * K + kq;
        const bf16* bp = Bt + S.boff(u) + (size_t)nb * K + kh;
        float acc[2][16];
#pragma unroll
        for (int a = 0; a < 2; ++a)
#pragma unroll
            for (int b = 0; b < 16; ++b) acc[a][b] = 0.f;
        for (int k0 = 0; k0 < K; k0 += SG_BK) {
            const v2u av = *(const v2u*)(ap + k0);
            const v4u b0 = *(const v4u*)(bp + k0), b1 = *(const v4u*)(bp + k0 + 8);
            __syncthreads();
            As[(kq + 0) * SG_ALD + la] = bflo(av.x); As[(kq + 1) * SG_ALD + la] = bfhi(av.x); As[(kq + 2) * SG_ALD + la] = bflo(av.y); As[(kq + 3) * SG_ALD + la] = bfhi(av.y);
            Bs[(kh + 0) * SG_BLD + nb] = bflo(b0.x); Bs[(kh + 1) * SG_BLD + nb] = bfhi(b0.x); Bs[(kh + 2) * SG_BLD + nb] = bflo(b0.y); Bs[(kh + 3) * SG_BLD + nb] = bfhi(b0.y);
            Bs[(kh + 4) * SG_BLD + nb] = bflo(b0.z); Bs[(kh + 5) * SG_BLD + nb] = bfhi(b0.z); Bs[(kh + 6) * SG_BLD + nb] = bflo(b0.w); Bs[(kh + 7) * SG_BLD + nb] = bfhi(b0.w);
            Bs[(kh + 8) * SG_BLD + nb] = bflo(b1.x); Bs[(kh + 9) * SG_BLD + nb] = bfhi(b1.x); Bs[(kh + 10) * SG_BLD + nb] = bflo(b1.y); Bs[(kh + 11) * SG_BLD + nb] = bfhi(b1.y);
            Bs[(kh + 12) * SG_BLD + nb] = bflo(b1.z); Bs[(kh + 13) * SG_BLD + nb] = bfhi(b1.z); Bs[(kh + 14) * SG_BLD + nb] = bflo(b1.w); Bs[(kh + 15) * SG_BLD + nb] = bfhi(b1.w);
            __syncthreads();
#pragma unroll 8
            for (int kk = 0; kk < SG_BK; ++kk) {
                const float a0 = As[kk * SG_ALD + rg], a1 = As[kk * SG_ALD + rg + 32];
                const f32x4 p0 = *(const LAS f32x4*)(Bs + kk * SG_BLD + 8 * cg), p1 = *(const LAS f32x4*)(Bs + kk * SG_BLD + 8 * cg + 4);
                const f32x4 p2 = *(const LAS f32x4*)(Bs + kk * SG_BLD + 128 + 8 * cg), p3 = *(const LAS f32x4*)(Bs + kk * SG_BLD + 128 + 8 * cg + 4);
#pragma unroll
                for (int j = 0; j < 4; ++j) {
                    acc[0][j] += a0 * p0[j]; acc[0][4 + j] += a0 * p1[j]; acc[0][8 + j] += a0 * p2[j]; acc[0][12 + j] += a0 * p3[j];
                    acc[1][j] += a1 * p0[j]; acc[1][4 + j] += a1 * p1[j]; acc[1][8 + j] += a1 * p2[j]; acc[1][12 + j] += a1 * p3[j];
                }
            }
        }
#pragma unroll
        for (int a = 0; a < 2; ++a) { const int r = rg + 32 * a; if (r < u.nrows) E.store(u, r, 8 * cg, &acc[a][0], &acc[a][8]); }
    }
    __syncthreads();
}


namespace pg8 {
constexpr int BM = 256, BK = 64, HALF = 128, HTB = HALF * BK * 2, STAGE_BYTES = 8 * HTB, NXCD = 8, WGM = 8;
__host__ __device__ __forceinline__ int lds_byte(int r, int c) { const int st = (r >> 4) * 2 + (c >> 5), rr = r & 15, cc = c & 31, ob = rr * 64 + cc * 2; return st * 1024 + (ob ^ (((ob >> 9) & 1) << 5)); }
__host__ __device__ __forceinline__ void stage_rc(int b, int& R, int& C) { const int st = b / 1024, sb = b % 1024, swz = sb ^ (((sb >> 9) & 1) << 5); R = (st >> 1) * 16 + swz / 64; C = (st & 1) * 32 + (swz % 64) / 2; }
__host__ __device__ __forceinline__ int perm32(int rho) { const int n = rho >> 4, i = rho & 15; return 8 * (i >> 2) + 4 * n + (i & 3); }

struct DenseOrder {
    int nM, nN, nwg, G, c, K;
    __device__ __forceinline__ void init(int M, int N, int K_, int G_, int c_) { nM = M / BM; nN = N / BM; nwg = nM * nN; G = G_; c = c_; K = K_; }
    __device__ __forceinline__ void unit_of(int L, Unit& u) const {
        int wgid = L; { const int q = nwg / NXCD, r = nwg % NXCD, xcd = wgid % NXCD, off = wgid / NXCD; wgid = (xcd < r ? xcd * (q + 1) : r * (q + 1) + (xcd - r) * q) + off; }
        const int nig = WGM * nN, gid = wgid / nig, fm = gid * WGM, gsz = (nM - fm) < WGM ? (nM - fm) : WGM;
        u.pn = (wgid % nig) / gsz; u.e = 0; u.arow0 = (fm + ((wgid % nig) % gsz)) * BM; u.nrows = BM; u.lrow0 = 0;
    }
    __device__ __forceinline__ bool next(int i, Unit& u) const {
        const long L = (long)i * G + c; if (L >= nwg) return false;
        unit_of((int)L, u); return true;
    }
    __device__ __forceinline__ int arow(const Unit& u, int r) const { return u.arow0 + r; }
    __device__ __forceinline__ size_t boff(const Unit& u) const { return (size_t)u.pn * 256 * K; }
};
struct TwoTierOrder {
    DenseOrder Dn; int nidle, irank, n1, k1, G, c;
    __device__ __forceinline__ void init(int M, int N, int K_, int G_, int c_, int rem, int K1) {
        Dn.init(M, N, K_, 1, 0); G = G_; c = c_; nidle = rem ? G_ - rem : 0; irank = rem ? c_ - rem : -1;
        n1 = K1 * nidle < Dn.nwg ? K1 * nidle : Dn.nwg; k1 = (irank >= 0 && irank < n1) ? (n1 - irank + nidle - 1) / nidle : 0;
    }
    __device__ __forceinline__ bool next(int i, Unit& u) const {
        long L; if (i < k1) L = (long)i * nidle + irank; else { L = n1 + (long)(i - k1) * G + c; if (L >= Dn.nwg) return false; }
        Dn.unit_of((int)L, u); return true;
    }
    __device__ __forceinline__ int arow(const Unit& u, int r) const { return u.arow0 + r; }
    __device__ __forceinline__ size_t boff(const Unit& u) const { return Dn.boff(u); }
};

template <class Epi, class Sched, bool GATHER, bool ALIGN_EPI = true, bool SP2 = true, bool REMAP64 = false>
__device__ __forceinline__ void gemm_phase(LAS unsigned char* lds, const bf16* Ag, const bf16* Btg, const int K, const Sched& S, const Epi& E) {
    const int tid = threadIdx.x, wid = __builtin_amdgcn_readfirstlane(tid >> 6), lane = tid & 63, wr = wid >> 2, wc = wid & 3, fr = lane & 15, fq = lane >> 4;
    const int nt = K / BK;
    unsigned voffA[2], voffB[2]; int RA[2], CA[2];
#pragma unroll
    for (int i = 0; i < 2; ++i) { int R, C; stage_rc(tid * 16 + i * 8192, R, C); const int Rb = REMAP64 ? 64 * (R >> 5) + perm32(R & 31) : (R & ~31) + perm32(R & 31);
        voffA[i] = (unsigned)(R * K + C) * 2u; voffB[i] = (unsigned)(Rb * K + C) * 2u; RA[i] = R; CA[i] = C; }
    const size_t kstep = (size_t)(BK * 2);
    const size_t hstep = (size_t)HALF * K * 2;
    const size_t hstepB = REMAP64 ? (size_t)32 * K * 2 : hstep;
    const unsigned ldsw = (unsigned)wid * 1024u;
    const int aoff = lds_byte(wr * 64 + fr, fq * 8), boff = lds_byte(wc * 32 + fr, fq * 8);
#define PG8_SA(b, h) (((b) * 2 + (h)) * HTB)
#define PG8_SB(b, h) ((4 + (b) * 2 + (h)) * HTB)
#define PG8_STAGE(bufoff, gbase, voff) do { _Pragma("unroll") for (int _i = 0; _i < 2; ++_i) \
        __builtin_amdgcn_global_load_lds((const unsigned*)((const char*)(gbase) + (voff)[_i]), (LAS unsigned*)(lds + (bufoff) + ldsw + _i * 8192), 16, 0, 0); } while (0)
#define PG8_STAGE_A(bufoff, base, vg, h, ko) do { if (GATHER) { PG8_STAGE(bufoff, (const char*)Ag + (ko), vg[h]); } else { PG8_STAGE(bufoff, (base) + (h) * hstep + (ko), voffA); } } while (0)
#define PG8_LDA(dst, b, h) do { _Pragma("unroll") for (int m = 0; m < 4; ++m) _Pragma("unroll") for (int k = 0; k < 2; ++k) dst[m][k] = *(const LAS bf16x8*)(lds + PG8_SA(b, h) + aoff + m * 2048 + k * 1024); } while (0)
#define PG8_LDB(dst, b, h) do { _Pragma("unroll") for (int n = 0; n < 2; ++n) _Pragma("unroll") for (int k = 0; k < 2; ++k) dst[n][k] = *(const LAS bf16x8*)(lds + PG8_SB(b, h) + boff + n * 2048 + k * 1024); } while (0)
#define PG8_MMA(ai, bj, At, Bt) do { __builtin_amdgcn_s_setprio(1); _Pragma("unroll") for (int m = 0; m < 4; ++m) _Pragma("unroll") for (int n = 0; n < 2; ++n) _Pragma("unroll") for (int k = 0; k < 2; ++k) \
        acc[ai][bj][m][n] = __builtin_amdgcn_mfma_f32_16x16x32_bf16(Bt[n][k], At[m][k], acc[ai][bj][m][n], 0, 0, 0); __builtin_amdgcn_s_setprio(0); } while (0)
#define PG8_WAIT_V(n) asm volatile("s_waitcnt vmcnt(" #n ")" ::: "memory")
#define PG8_WAIT_L(n) asm volatile("s_waitcnt lgkmcnt(" #n ")" ::: "memory")
#define PG8_BAR __builtin_amdgcn_s_barrier()
#define PG8_SCHED __builtin_amdgcn_sched_barrier(0)
#define PG8_ROWOFFS(dst, un) do { int ar_[2][2]; _Pragma("unroll") for (int _h = 0; _h < 2; ++_h) _Pragma("unroll") for (int _i = 0; _i < 2; ++_i) ar_[_h][_i] = S.arow(un, _h * HALF + RA[_i]);     \
        _Pragma("unroll") for (int _h = 0; _h < 2; ++_h) _Pragma("unroll") for (int _i = 0; _i < 2; ++_i) dst[_h][_i] = ((unsigned)ar_[_h][_i] * (unsigned)K + (unsigned)CA[_i]) * 2u; } while (0)
    Unit cur, nxt; int ui = 0;
    if (!S.next(0, cur)) return;
    f32x4 acc[2][2][4][2];
#pragma unroll
    for (int a = 0; a < 2; ++a)
#pragma unroll
        for (int b = 0; b < 2; ++b)
#pragma unroll
            for (int m = 0; m < 4; ++m)
#pragma unroll
                for (int n = 0; n < 2; ++n) acc[a][b][m][n] = (f32x4){0.f, 0.f, 0.f, 0.f};
    bf16x8 At[4][2], B0[2][2], B1[2][2];
    unsigned vc[2][2], vn[2][2];
    if (GATHER) { PG8_ROWOFFS(vc, cur); }
    const char* cA = GATHER ? (const char*)Ag : (const char*)Ag + (size_t)cur.arow0 * K * 2; const char* cB = (const char*)Btg + S.boff(cur) * 2;
    if constexpr (SP2) {
        PG8_STAGE(PG8_SB(0, 0), cB, voffB); PG8_STAGE(PG8_SB(0, 1), cB + hstepB, voffB); PG8_STAGE_A(PG8_SA(0, 0), cA, vc, 0, 0); PG8_STAGE_A(PG8_SA(0, 1), cA, vc, 1, 0);
        if (wr == 1) PG8_BAR;
        PG8_WAIT_V(2); PG8_BAR;
        PG8_STAGE(PG8_SB(1, 0), cB + kstep, voffB); PG8_STAGE_A(PG8_SA(1, 0), cA, vc, 0, kstep); PG8_STAGE(PG8_SB(1, 1), cB + hstepB + kstep, voffB);
        PG8_WAIT_V(6); PG8_BAR;
    } else {
        PG8_STAGE(PG8_SB(0, 0), cB, voffB); PG8_STAGE_A(PG8_SA(0, 0), cA, vc, 0, 0); PG8_STAGE(PG8_SB(0, 1), cB + hstepB, voffB); PG8_STAGE_A(PG8_SA(0, 1), cA, vc, 1, 0);
        if (wr == 1) PG8_BAR;
        PG8_WAIT_V(4); PG8_BAR;
        PG8_STAGE(PG8_SB(1, 0), cB + kstep, voffB); PG8_STAGE_A(PG8_SA(1, 0), cA, vc, 0, kstep); PG8_STAGE(PG8_SB(1, 1), cB + hstepB + kstep, voffB);
        PG8_WAIT_V(6); PG8_BAR;
    }
    for (;;) {
        const bool has_next = S.next(ui + 1, nxt);
        const char* nA = GATHER ? cA : (has_next ? (const char*)Ag + (size_t)nxt.arow0 * K * 2 : cA); const char* nB = has_next ? (const char*)Btg + S.boff(nxt) * 2 : cB;
        if (GATHER) { if (has_next) { PG8_ROWOFFS(vn, nxt); } else {
#pragma unroll
            for (int _h = 0; _h < 2; ++_h)
#pragma unroll
                for (int _i = 0; _i < 2; ++_i) vn[_h][_i] = vc[_h][_i]; } }
#pragma unroll 1
        for (int t = 0; t < nt; t += 2) {
            const bool last = (t == nt - 2);
            const size_t k1 = (size_t)(t + 1) * kstep;
            const size_t k2 = last ? 0 : (size_t)(t + 2) * kstep, k3 = k2 + kstep;
            const char* a2 = last ? nA : cA; const char* b2 = (last ? nB : cB) + k2; const char* b3 = b2 + kstep;
            unsigned v2[2][2];
#pragma unroll
            for (int _h = 0; _h < 2; ++_h)
#pragma unroll
                for (int _i = 0; _i < 2; ++_i) v2[_h][_i] = last ? vn[_h][_i] : vc[_h][_i];
            if constexpr (SP2) {
            PG8_LDB(B0, 0, 0); PG8_LDB(B1, 0, 1); PG8_SCHED; PG8_LDA(At, 0, 0); PG8_STAGE_A(PG8_SA(1, 1), cA, vc, 1, k1);
            PG8_WAIT_V(8); PG8_WAIT_L(0); PG8_BAR; PG8_MMA(0, 0, At, B0); PG8_MMA(0, 1, At, B1); PG8_BAR; PG8_SCHED;
            PG8_LDA(At, 0, 1); PG8_STAGE(PG8_SB(0, 0), b2, voffB); PG8_STAGE(PG8_SB(0, 1), b2 + hstepB, voffB); PG8_STAGE_A(PG8_SA(0, 0), a2, v2, 0, k2);
            PG8_WAIT_V(8); PG8_WAIT_L(0); PG8_BAR; PG8_MMA(1, 0, At, B0); PG8_MMA(1, 1, At, B1); PG8_BAR; PG8_SCHED;
            PG8_LDB(B0, 1, 0); PG8_LDB(B1, 1, 1); PG8_SCHED; PG8_LDA(At, 1, 0); PG8_STAGE_A(PG8_SA(0, 1), a2, v2, 1, k2);
            PG8_WAIT_V(8); PG8_WAIT_L(0); PG8_BAR; PG8_MMA(0, 0, At, B0); PG8_MMA(0, 1, At, B1); PG8_BAR; PG8_SCHED;
            PG8_LDA(At, 1, 1); PG8_STAGE(PG8_SB(1, 0), b3, voffB); PG8_STAGE(PG8_SB(1, 1), b3 + hstepB, voffB); PG8_STAGE_A(PG8_SA(1, 0), a2, v2, 0, k3);
            PG8_WAIT_V(8); PG8_WAIT_L(0); PG8_BAR; PG8_MMA(1, 0, At, B0); PG8_MMA(1, 1, At, B1); PG8_BAR; PG8_SCHED;
            } else {
            PG8_LDB(B0, 0, 0); PG8_SCHED; PG8_LDA(At, 0, 0); PG8_STAGE_A(PG8_SA(1, 1), cA, vc, 1, k1);
            PG8_WAIT_L(8); PG8_BAR; PG8_WAIT_L(0); PG8_MMA(0, 0, At, B0); PG8_BAR; PG8_SCHED;
            PG8_LDB(B1, 0, 1); PG8_STAGE(PG8_SB(0, 0), b2, voffB);
            PG8_BAR; PG8_WAIT_L(0); PG8_MMA(0, 1, At, B1); PG8_BAR;
            PG8_LDA(At, 0, 1); PG8_STAGE_A(PG8_SA(0, 0), a2, v2, 0, k2);
            PG8_BAR; PG8_WAIT_L(0); PG8_MMA(1, 0, At, B0); PG8_BAR; PG8_SCHED;
            PG8_STAGE(PG8_SB(0, 1), b2 + hstepB, voffB);
            PG8_WAIT_V(6); PG8_BAR; PG8_MMA(1, 1, At, B1); PG8_BAR;
            PG8_LDB(B0, 1, 0); PG8_SCHED; PG8_LDA(At, 1, 0); PG8_STAGE_A(PG8_SA(0, 1), a2, v2, 1, k2);
            PG8_WAIT_L(8); PG8_BAR; PG8_WAIT_L(0); PG8_MMA(0, 0, At, B0); PG8_BAR; PG8_SCHED;
            PG8_LDB(B1, 1, 1); PG8_STAGE(PG8_SB(1, 0), b3, voffB);
            PG8_BAR; PG8_WAIT_L(0); PG8_MMA(0, 1, At, B1); PG8_BAR;
            PG8_LDA(At, 1, 1); PG8_STAGE_A(PG8_SA(1, 0), a2, v2, 0, k3);
            PG8_BAR; PG8_WAIT_L(0); PG8_MMA(1, 0, At, B0); PG8_BAR; PG8_SCHED;
            PG8_STAGE(PG8_SB(1, 1), b3 + hstepB, voffB);
            PG8_WAIT_V(6); PG8_BAR; PG8_MMA(1, 1, At, B1); PG8_BAR;
            }
        }
        if constexpr (ALIGN_EPI) { if (wr == 0) PG8_BAR; }
        {
            const int cit = REMAP64 ? wc * 64 + 8 * fq : wc * 32 + 8 * fq;
            if constexpr (Epi::PRE_ALL) {
                typename Epi::Pre pa[8];
#pragma unroll
                for (int gq = 0; gq < 8; ++gq) { const int rn = (gq >> 2) * HALF + wr * 64 + (gq & 3) * 16 + fr; pa[gq] = E.pre(cur, rn < cur.nrows ? rn : cur.nrows - 1, cit); }
#pragma unroll
                for (int gq = 0; gq < 8; ++gq) { const int ai = gq >> 2, m = gq & 3, r = ai * HALF + wr * 64 + m * 16 + fr;
                    if (r < cur.nrows) { float v0[8], v1[8];
#pragma unroll
                        for (int i = 0; i < 4; ++i) { v0[i] = acc[ai][0][m][0][i]; v0[4 + i] = acc[ai][0][m][1][i]; v1[i] = acc[ai][1][m][0][i]; v1[4 + i] = acc[ai][1][m][1][i]; }
                        E.post(cur, r, cit, v0, v1, pa[gq]); } }
            } else {
            constexpr bool RP = REMAP64 && Epi::ROWPAIR;
            const bool hi = RP && (fr >= 8); const int rsh = hi ? -8 : 0, citx = hi ? cit + 32 : cit;
            typename Epi::Pre pq[2];
            { const int r0_ = wr * 64 + fr; pq[0] = E.pre(cur, (r0_ < cur.nrows ? r0_ : cur.nrows - 1) + rsh, citx); }
#pragma unroll
            for (int gq = 0; gq < 8; ++gq) { const int ai = gq >> 2, m = gq & 3, r = ai * HALF + wr * 64 + m * 16 + fr;
                if (gq + 1 < 8) { const int rn = ((gq + 1) >> 2) * HALF + wr * 64 + ((gq + 1) & 3) * 16 + fr; pq[(gq + 1) & 1] = E.pre(cur, (rn < cur.nrows ? rn : cur.nrows - 1) + rsh, citx); }
                __builtin_amdgcn_sched_barrier(0);
                if (r < cur.nrows) { float v0[8], v1[8];
#pragma unroll
                    for (int i = 0; i < 4; ++i) { v0[i] = acc[ai][0][m][0][i]; v0[4 + i] = acc[ai][0][m][1][i]; v1[i] = acc[ai][1][m][0][i]; v1[4 + i] = acc[ai][1][m][1][i]; }
                    if constexpr (RP) {
#pragma unroll
                        for (int i = 0; i < 8; ++i) { const float snd = hi ? v0[i] : v1[i];
                            const float rcv = __builtin_bit_cast(float, __builtin_amdgcn_update_dpp(0, __builtin_bit_cast(int, snd), 0x128, 0xf, 0xf, false));
                            if (hi) v0[i] = rcv; else v1[i] = rcv; } }
                    E.post(cur, r + rsh, citx, v0, v1, pq[gq & 1]); }
                __builtin_amdgcn_sched_barrier(0); }
            }
        }
        if (!has_next) break;
#pragma unroll
        for (int a = 0; a < 2; ++a)
#pragma unroll
            for (int b = 0; b < 2; ++b)
#pragma unroll
                for (int m = 0; m < 4; ++m)
#pragma unroll
                    for (int n = 0; n < 2; ++n) acc[a][b][m][n] = (f32x4){0.f, 0.f, 0.f, 0.f};
        cur = nxt; cA = nA; cB = nB; ++ui;
        if (GATHER) {
#pragma unroll
            for (int _h = 0; _h < 2; ++_h)
#pragma unroll
                for (int _i = 0; _i < 2; ++_i) vc[_h][_i] = vn[_h][_i]; }
        if constexpr (ALIGN_EPI) { if (wr == 1) PG8_BAR; }
    }
    PG8_WAIT_V(0);
    if constexpr (!ALIGN_EPI) { if (wr == 0) PG8_BAR; }
    PG8_BAR;
#undef PG8_SA
#undef PG8_SB
#undef PG8_STAGE
#undef PG8_STAGE_A
#undef PG8_LDA
#undef PG8_LDB
#undef PG8_MMA
#undef PG8_WAIT_V
#undef PG8_WAIT_L
#undef PG8_BAR
#undef PG8_SCHED
#undef PG8_ROWOFFS
}
}

struct NoPre {};
struct EpiInProj { typedef NoPre Pre; static constexpr bool PRE_ALL = false; static constexpr bool ROWPAIR = false;
    bf16 *upool, *qkv, *z, *gp, *gd;
    __device__ __forceinline__ Pre pre(const Unit&, int, int) const { return Pre{}; }
    __device__ __forceinline__ void post(const Unit& u, int r, int cit, const float* v0, const float* v1, const Pre&) const {
        const int pn = u.pn; const bool hi = (threadIdx.x & 8) != 0;
        float fa[8], fb[8];
        if (pn < 16) {
#pragma unroll
            for (int i = 0; i < 8; ++i) { fa[i] = v0[i]; fb[i] = v1[i]; } }
        else if (pn < 20) {
#pragma unroll
            for (int i = 0; i < 8; ++i) { fa[i] = siluf_(v0[i]); fb[i] = siluf_(v1[i]); } }
        else {
#pragma unroll
            for (int i = 0; i < 8; ++i) { fa[i] = sigmoidf_(v0[i]); fb[i] = sigmoidf_(v1[i]); } }
        v4u a, b; a.x = pk2(fa[0], fa[1]); a.y = pk2(fa[2], fa[3]); a.z = pk2(fa[4], fa[5]); a.w = pk2(fa[6], fa[7]); b.x = pk2(fb[0], fb[1]); b.y = pk2(fb[2], fb[3]); b.z = pk2(fb[4], fb[5]); b.w = pk2(fb[6], fb[7]);
        const v4u snd = hi ? a : b; v4u rcv;
        rcv.x = (unsigned)__builtin_amdgcn_update_dpp(0, (int)snd.x, 0x128, 0xf, 0xf, false); rcv.y = (unsigned)__builtin_amdgcn_update_dpp(0, (int)snd.y, 0x128, 0xf, 0xf, false);
        rcv.z = (unsigned)__builtin_amdgcn_update_dpp(0, (int)snd.z, 0x128, 0xf, 0xf, false); rcv.w = (unsigned)__builtin_amdgcn_update_dpp(0, (int)snd.w, 0x128, 0xf, 0xf, false);
        const size_t row = (size_t)(u.arow0 + r - (hi ? 8 : 0)); const int col = cit + (hi ? 32 : 0);
        bf16* p; size_t ld;
        if (pn < 4) { p = upool + row * D_POOL + pn * 256 + col; ld = D_POOL; }
        else if (pn < 16) { p = qkv + row * D_QKV + (pn - 4) * 256 + col; ld = D_QKV; }
        else if (pn < 20) { p = z + row * D_Z + (pn - 16) * 256 + col; ld = D_Z; }
        else { p = (pn < 28 ? gp + row * D + (pn - 20) * 256 : gd + row * D + (pn - 28) * 256) + col; ld = D; }
        __builtin_nontemporal_store(hi ? rcv : a, (v4u*)p); __builtin_nontemporal_store(hi ? b : rcv, (v4u*)(p + 8 * ld));
    }
};
__device__ __forceinline__ void unpack8bf(const v4u o, float* v) { v[0] = bflo(o.x); v[1] = bfhi(o.x); v[2] = bflo(o.y); v[3] = bfhi(o.y); v[4] = bflo(o.z); v[5] = bfhi(o.z); v[6] = bflo(o.w); v[7] = bfhi(o.w); }
struct EpiPool {
    static constexpr bool PRE_ALL = false; static constexpr bool ROWPAIR = true;
    struct Pre { v4u g0, g1; };
    const bf16* gp; bf16* mp;
    __device__ __forceinline__ Pre pre(const Unit& u, int r, int cit) const { const size_t off = (size_t)(u.arow0 + r) * D + u.pn * 256 + cit; return Pre{__builtin_nontemporal_load((const v4u*)(gp + off)), __builtin_nontemporal_load((const v4u*)(gp + off + (size_t)8 * D))}; }
    __device__ __forceinline__ void post(const Unit& u, int r, int cit, const float* v0, const float* v1, const Pre& p) const {
        const size_t off = (size_t)(u.arow0 + r) * D + u.pn * 256 + cit; float g0[8], g1[8], a[8], b[8]; unpack8bf(p.g0, g0); unpack8bf(p.g1, g1);
#pragma unroll
        for (int i = 0; i < 8; ++i) { a[i] = g0[i] * v0[i]; b[i] = g1[i] * v1[i]; }
        store8bf(mp + off, a); store8bf(mp + off + (size_t)8 * D, b);
    }
};
struct EpiMerge {
    static constexpr bool PRE_ALL = false; static constexpr bool ROWPAIR = true;
    struct Pre { v4u g0, g1, m0, m1; };
    const bf16* gd; const bf16* mp; bf16* mg;
    __device__ __forceinline__ Pre pre(const Unit& u, int r, int cit) const { const size_t off = (size_t)(u.arow0 + r) * D + u.pn * 256 + cit; return Pre{__builtin_nontemporal_load((const v4u*)(gd + off)), __builtin_nontemporal_load((const v4u*)(gd + off + (size_t)8 * D)), __builtin_nontemporal_load((const v4u*)(mp + off)), __builtin_nontemporal_load((const v4u*)(mp + off + (size_t)8 * D))}; }
    __device__ __forceinline__ void post(const Unit& u, int r, int cit, const float* v0, const float* v1, const Pre& p) const {
        const size_t off = (size_t)(u.arow0 + r) * D + u.pn * 256 + cit; float g0[8], g1[8], m0[8], m1[8]; unpack8bf(p.g0, g0); unpack8bf(p.g1, g1); unpack8bf(p.m0, m0); unpack8bf(p.m1, m1);
#pragma unroll
        for (int i = 0; i < 8; ++i) { m0[i] += g0[i] * v0[i]; m1[i] += g1[i] * v1[i]; }
        store8bf(mg + off, m0); store8bf(mg + off + (size_t)8 * D, m1);
    }
};
struct EpiResid {
    static constexpr bool PRE_ALL = false; static constexpr bool ROWPAIR = true;
    struct Pre { f32x4 a0, a1, b0, b1; };
    const float* x; bf16* h;
    __device__ __forceinline__ Pre pre(const Unit& u, int r, int cit) const { const size_t off = (size_t)(u.arow0 + r) * D + u.pn * 256 + cit; return Pre{__builtin_nontemporal_load((const f32x4*)(x + off)), __builtin_nontemporal_load((const f32x4*)(x + off + 4)), __builtin_nontemporal_load((const f32x4*)(x + off + (size_t)8 * D)), __builtin_nontemporal_load((const f32x4*)(x + off + (size_t)8 * D + 4))}; }
    __device__ __forceinline__ void post(const Unit& u, int r, int cit, const float* v0, const float* v1, const Pre& p) const {
        const size_t off = (size_t)(u.arow0 + r) * D + u.pn * 256 + cit; float a[8], b[8];
#pragma unroll
        for (int i = 0; i < 4; ++i) { a[i] = p.a0[i] + v0[i]; a[4 + i] = p.a1[i] + v0[4 + i]; b[i] = p.b0[i] + v1[i]; b[4 + i] = p.b1[i] + v1[4 + i]; }
        store8bf(h + off, a); store8bf(h + off + (size_t)8 * D, b);
    }
};
struct EpiMoe1 { typedef NoPre Pre; static constexpr bool PRE_ALL = false; static constexpr bool ROWPAIR = false;
    bf16* hmid;
    __device__ __forceinline__ Pre pre(const Unit&, int, int) const { return Pre{}; }
    __device__ __forceinline__ void post(const Unit& u, int r, int cit, const float* v0, const float* v1, const Pre&) const {
        float a[8];
#pragma unroll
        for (int i = 0; i < 8; ++i) a[i] = siluf_(v0[i]) * v1[i];
        store8bf(hmid + (size_t)(u.arow0 + r) * DE + u.pn * 128 + cit, a);
    }
};
struct EpiMoe2 {
    static constexpr bool PRE_ALL = true; static constexpr bool ROWPAIR = false;
    struct Pre { int tk; float w; };
    const int* ltk; const float* lw; bf16 *y0, *y1;
    __device__ __forceinline__ Pre pre(const Unit& u, int r, int) const { const size_t li = (size_t)u.e * T + u.lrow0 + r; return Pre{ltk[li], lw[li]}; }
    __device__ __forceinline__ void post(const Unit& u, int, int cit, const float* v0, const float* v1, const Pre& p) const {
        bf16* y = ((p.tk & 1) ? y1 : y0) + (size_t)(p.tk >> 1) * D + u.pn * 256 + cit; float a[8], b[8];
#pragma unroll
        for (int i = 0; i < 8; ++i) { a[i] = p.w * v0[i]; b[i] = p.w * v1[i]; }
        store8bf(y, a); store8bf(y + 128, b);
    }
};
struct EpiBf16Plain { typedef NoPre Pre; static constexpr bool PRE_ALL = false; static constexpr bool ROWPAIR = false;
    bf16* o;
    __device__ __forceinline__ Pre pre(const Unit&, int, int) const { return Pre{}; }
    __device__ __forceinline__ void post(const Unit& u, int r, int cit, const float* v0, const float* v1, const Pre&) const {
        bf16* p = o + (size_t)(u.arow0 + r) * D + u.pn * 256 + cit; store8bf(p, v0); store8bf(p + 128, v1);
    }
};
struct EpiPle {
    static constexpr bool PRE_ALL = false; static constexpr bool ROWPAIR = true;
    struct Pre { v4u p0, p1, h0, h1; };
    const bf16* pp; bf16* h;
    __device__ __forceinline__ Pre pre(const Unit& u, int r, int cit) const { const size_t off = (size_t)(u.arow0 + r) * D + u.pn * 256 + cit;
        return Pre{__builtin_nontemporal_load((const v4u*)(pp + off)), __builtin_nontemporal_load((const v4u*)(pp + off + (size_t)8 * D)), *(const v4u*)(h + off), *(const v4u*)(h + off + (size_t)8 * D)}; }
    __device__ __forceinline__ void post(const Unit& u, int r, int cit, const float* v0, const float* v1, const Pre& p) const {
        const size_t off = (size_t)(u.arow0 + r) * D + u.pn * 256 + cit; float p0[8], p1[8], a[8], b[8]; unpack8bf(p.p0, p0); unpack8bf(p.p1, p1); unpack8bf(p.h0, a); unpack8bf(p.h1, b);
#pragma unroll
        for (int i = 0; i < 8; ++i) { a[i] += sigmoidf_(v0[i]) * p0[i]; b[i] += sigmoidf_(v1[i]) * p1[i]; }
        store8bf(h + off, a); store8bf(h + off + (size_t)8 * D, b);
    }
};

__device__ __forceinline__ void transpose_item(const float* W, int ldw, int K, int k0, int c0, int nvalid, bf16* WT, int r0, LAS float* scr, int lane) {
    (void)scr;
    const int kb = lane >> 3, nb = lane & 7; const bool ok = 4 * nb < nvalid;
    const float* src = W + (size_t)(k0 + 8 * kb) * ldw + c0 + 4 * nb;
    f32x4 v[2][8];
#pragma unroll
    for (int hf = 0; hf < 2; ++hf)
#pragma unroll
        for (int i = 0; i < 8; ++i) v[hf][i] = ok ? __builtin_nontemporal_load((const f32x4*)(src + (size_t)(64 * hf + i) * ldw)) : (f32x4){0.f, 0.f, 0.f, 0.f};
    bf16* dst = WT + (size_t)(r0 + 4 * nb) * K + k0 + 8 * kb;
#pragma unroll
    for (int hf = 0; hf < 2; ++hf)
#pragma unroll
        for (int e = 0; e < 4; ++e) { v4u o; o.x = pk2(v[hf][0][e], v[hf][1][e]); o.y = pk2(v[hf][2][e], v[hf][3][e]); o.z = pk2(v[hf][4][e], v[hf][5][e]); o.w = pk2(v[hf][6][e], v[hf][7][e]); *(v4u*)(dst + (size_t)e * K + 64 * hf) = o; }
}
__device__ __forceinline__ void transpose_job(const float* W, int K, int N, bf16* WT, LAS float* scr, int gw, int NGW, int lane) {
    const int nblk = N / 32, items = (K / 128) * nblk;
    for (int it = gw; it < items; it += NGW) { const int kb = it / nblk, nb = it % nblk; transpose_item(W, N, K, 128 * kb, 32 * nb, 32, WT, 32 * nb, scr, lane); }
}
__device__ __forceinline__ void rms_row_bf16(const float* xrow, const float* gain, bf16* orow, int lane) {
    const f32x4* xr = (const f32x4*)xrow + lane; const f32x4* gr = (const f32x4*)gain + lane;
    f32x4 v[8]; float s = 0.f;
#pragma unroll
    for (int j = 0; j < 8; ++j) { v[j] = xr[64 * j]; s += (v[j].x * v[j].x + v[j].y * v[j].y) + (v[j].z * v[j].z + v[j].w * v[j].w); }
    const float rstd = 1.0f / sqrtf(wave_sum(s) * (1.f / D) + EPS);
    v2u* o8 = (v2u*)orow + lane;
#pragma unroll
    for (int j = 0; j < 8; ++j) { const f32x4 g = gr[64 * j]; v2u o; o.x = pk2(v[j].x * rstd * g.x, v[j].y * rstd * g.y); o.y = pk2(v[j].z * rstd * g.z, v[j].w * rstd * g.w); o8[64 * j] = o; }
}


__device__ __forceinline__ void route_row(Frame& F, const LAS float* lgp, float rs, int t, LAS unsigned* lcnt, LAS int* ent, int ei) {
    float gl[4];
#pragma unroll
    for (int o = 0; o < 4; ++o) gl[o] = lgp[o] * rs + F.in[I_B_RG][o];
    int gi = 0; float gm = gl[0];
#pragma unroll
    for (int o = 1; o < 4; ++o) if (gl[o] > gm) { gm = gl[o]; gi = o; }
    float den = 0.f;
#pragma unroll
    for (int o = 0; o < 4; ++o) den += __expf(gl[o] - gm);
    const float psel = 1.0f / den;
    float le[8];
#pragma unroll
    for (int q = 0; q < 8; ++q) le[q] = lgp[4 + 8 * gi + q] * rs + F.in[I_B_RE][gi * 8 + q];
    int i0 = 0; float v0 = le[0];
#pragma unroll
    for (int q = 1; q < 8; ++q) if (le[q] > v0) { v0 = le[q]; i0 = q; }
    int i1 = -1; float v1 = -3.0e38f;
#pragma unroll
    for (int q = 0; q < 8; ++q) if (q != i0 && le[q] > v1) { v1 = le[q]; i1 = q; }
    const float e1 = __expf(v1 - v0); const float w0 = psel / (1.0f + e1), w1 = psel * e1 / (1.0f + e1);
    const int ea = gi * 8 + i0, ebx = gi * 8 + i1;
    const unsigned sa = atomicAdd((unsigned*)(lcnt + ea), 1u), sb = atomicAdd((unsigned*)(lcnt + ebx), 1u);
    ent[4 * ei + 0] = (ea << 16) | (int)sa; ent[4 * ei + 1] = 2 * t; ent[4 * ei + 2] = __float_as_int(w0); ent[4 * ei + 3] = 0;
    ent[4 * (ei + 1) + 0] = (ebx << 16) | (int)sb; ent[4 * (ei + 1) + 1] = 2 * t + 1; ent[4 * (ei + 1) + 2] = __float_as_int(w1); ent[4 * (ei + 1) + 3] = 0;
}


template <int WL> __device__ __forceinline__ void scan_loader(LAS unsigned char* ring, const unsigned char* pkg0, const unsigned char* ut0, int l16) {
    v4u la[13], lb[13];
#define DN_SRC(p_) ((p_) < 16 ? src_ + 1024 * (p_) : ((p_) < 32 ? src_ + 40960 + 1024 * ((p_) - 16) : ((p_) == 32 ? src_ + 57344 : usrc_ + 1024 * ((p_) - 33))))
#define DN_LD(dst, pn) do { const int pn_ = (pn) < 127 ? (pn) : 127; const unsigned char* src_ = pkg0 + (size_t)pn_ * PKG_BYTES; const unsigned char* usrc_ = ut0 + (size_t)pn_ * 16384; \
        _Pragma("unroll") for (int i = 0; i < 13; ++i) { if (4 * i + WL < 49) dst[i] = __builtin_nontemporal_load((const v4u*)(DN_SRC(4 * i + WL) + l16)); } } while (0)
#define DN_ST(srcr, stg) do { _Pragma("unroll") for (int i = 0; i < 13; ++i) { if (4 * i + WL < 49) *(LAS v4u*)(ring + (stg) * STG_BYTES + 1024 * (4 * i + WL) + l16) = srcr[i]; } } while (0)
#pragma unroll
    for (int i = 0; i < 13; ++i) { la[i] = (v4u){0u, 0u, 0u, 0u}; lb[i] = (v4u){0u, 0u, 0u, 0u}; }
    DN_LD(la, 0); DN_ST(la, 0); DN_LD(la, 1); DN_LD(lb, 2);
    for (int n = 0; n < 128; n += 2) {
        LDS_BARRIER();
        DN_ST(la, 1); DN_LD(la, n + 3);
        LDS_BARRIER();
        DN_ST(lb, 0); DN_LD(lb, n + 4);
    }
#undef DN_LD
#undef DN_ST
#undef DN_SRC
}

enum { PH_PRO = 0, PH_INPROJ, PH_TOKLOC, PH_DNA, PH_DN, PH_YDN, PH_MERGE, PH_OUT, PH_ROUTE, PH_MOE1, PH_MOE2, PH_N3, PH_PLE, PH_FINAL, NPHASE };
struct Args { const float* in[25]; float* out; unsigned char* ws; int ph_lo, ph_hi, flags, pad; };
__global__ void __launch_bounds__(NTHR, 2) fwd(Args args) {
    extern __shared__ __attribute__((aligned(16))) unsigned char lds_raw[];
    Frame F;
    F.lds = (LAS unsigned char*)lds_raw; F.MISC = (volatile LAS unsigned*)(F.lds + MISC_OFF);
    F.tid = threadIdx.x; F.lane = F.tid & 63; F.wave = __builtin_amdgcn_readfirstlane(F.tid >> 6);
    F.G = gridDim.x; { const int bx = blockIdx.x; F.vcu = (F.G % 8 == 0) ? (bx % 8) * (F.G / 8) + bx / 8 : bx; }
    F.ws = args.ws; F.ctl = (unsigned*)(args.ws + WS_CTL); F.out = args.out;
#pragma unroll
    for (int i = 0; i < 25; ++i) F.in[i] = args.in[i];
    for (int u = F.tid; u < MISC_WORDS; u += NTHR) F.MISC[u] = 0u;
    __syncthreads();
    XcdBarrier bar; bar.bar = F.ctl + CW_BAR; bar.x = 0; bar.st = nullptr;
    if (MK_N_LAUNCHES == 1) bar = xcd_barrier_post(F.ctl + CW_BAR, F.MISC + 8);
    const int lo = args.ph_lo, hi = args.ph_hi;
#define IN(k) (lo <= (k) && (k) < hi)
#define SEAM(k) do { if (MK_N_LAUNCHES == 1 && IN(k) && IN((k) + 1)) xcd_barrier(bar); } while (0)
    unsigned char* ws = F.ws;
    bf16* WIN = (bf16*)(ws + WS_WIN); bf16* WCOMB = (bf16*)(ws + WS_WCOMB); bf16* WUPDN = (bf16*)(ws + WS_WUPDN); bf16* WOUT = (bf16*)(ws + WS_WOUT);
    bf16* WPLEG = (bf16*)(ws + WS_WPLEG); bf16* WPLEP = (bf16*)(ws + WS_WPLEP); bf16* WGU = (bf16*)(ws + WS_WGU); bf16* WDN = (bf16*)(ws + WS_WDN);
    float* BA = (float*)(ws + WS_BA); float* GG = (float*)(ws + WS_G); float* BETA = (float*)(ws + WS_BETA);
    int* LTK = (int*)(ws + WS_LTK); float* LW = (float*)(ws + WS_LW); bf16* PBF = (bf16*)(ws + WS_PBF);
    bf16* WRH = (bf16*)(ws + WS_WRT); bf16* WRL = WRH + 48 * D;
    unsigned char* PKG = ws + WS_PKG; bf16* UT = (bf16*)(ws + WS_UT); unsigned char* SSTA = (unsigned char*)F.out + 192 * MiB; unsigned char* SSTB = ws + WS_SSTB;
#define SST_OF(unit) (((unit) < DN_UNITS / 2) ? SSTA + (size_t)(unit) * 32768 : SSTB + (size_t)((unit) - DN_UNITS / 2) * 32768)
    bf16* YDN = (bf16*)((unsigned char*)F.out + OUT_D);
    bf16* N1 = (bf16*)(ws + WS_N1); bf16* QKV = (bf16*)(ws + WS_QKV); float* OBUF = (float*)(ws + WS_QKV); bf16* PP = (bf16*)(ws + WS_QKV);
    bf16* MP = (bf16*)((unsigned char*)F.out + OUT_QKV2); bf16* MERGED = (bf16*)(ws + WS_QKV);     bf16* UPOOL = (bf16*)(ws + WS_UPOOL); bf16* ZS = (bf16*)(ws + WS_Z); bf16* HMID = (bf16*)(ws + WS_Z);
    bf16* GP = (bf16*)(ws + WS_GP); bf16* GD = (bf16*)(ws + WS_GD); bf16* Y0 = GP; bf16* Y1 = GD;
    bf16* DBUF = (bf16*)((unsigned char*)F.out + OUT_D); bf16* QKV2 = (bf16*)((unsigned char*)F.out + OUT_QKV2); bf16* H = (bf16*)(ws + WS_H16);
    const int gw = F.vcu * NWAVES + F.wave, NGW = F.G * NWAVES, lane = F.lane;

    if (IN(PH_PRO)) {
        LAS float* scr = (LAS float*)(F.lds + RING_OFF + F.wave * 16384);
        {
            constexpr int NB_IN = N_IN_PAD / 32, IT_IN = (D / 128) * NB_IN, IT_A = IT_IN + (D_Z / 128) * (D / 32), IT_B = IT_A + (D / 128) * (D / 32), IT_C = IT_B + (D / 128) * (D / 32), IT_D = IT_C + (D_PLE / 128) * (D / 32);
            for (int it = gw; it < IT_D; it += NGW) {
                if (it < IT_IN) { const int kb = it / NB_IN, nb = it % NB_IN, r0 = 32 * nb; const int c0 = (r0 < 5120) ? r0 : r0 + 16;
                    transpose_item(F.in[I_W_IN], D_IN, D, 128 * kb, c0, 32, WIN, r0, scr, lane); }
                else { const float* W; bf16* WT; int K_, j;
                    if (it < IT_A) { W = F.in[I_W_UP_DN]; WT = WUPDN; K_ = D_Z; j = it - IT_IN; }
                    else if (it < IT_B) { W = F.in[I_W_OUT]; WT = WOUT; K_ = D; j = it - IT_A; }
                    else if (it < IT_C) { W = F.in[I_W_PLE_GATE]; WT = WPLEG; K_ = D; j = it - IT_B; }
                    else { W = F.in[I_W_PLE_PROJ]; WT = WPLEP; K_ = D_PLE; j = it - IT_C; }
                    const int kb = j / (D / 32), nb = j % (D / 32);
                    transpose_item(W, D, K_, 128 * kb, 32 * nb, 32, WT, 32 * nb, scr, lane); }
            }
        }
        {
            const float* pw = F.in[I_POOL_W]; const float* ps = F.in[I_POOL_SCALE]; const float* wu = F.in[I_W_UP_POOL];
            const int c = lane & 15, kg = lane >> 4;
            for (int task = gw; task < 2048; task += NGW) {
                const int nt = task & 127, rem = task >> 7, g = rem >> 2, kk0 = 64 * (rem & 3), n0 = 16 * nt;
                f32x4 acc[4];
#pragma unroll
                for (int mt = 0; mt < 4; ++mt) acc[mt] = (f32x4){0.f, 0.f, 0.f, 0.f};
#pragma unroll 2
                for (int ks = 0; ks < 8; ++ks) { const int j0 = 32 * ks;
                    float bv[8];
#pragma unroll
                    for (int jj = 0; jj < 8; ++jj) { const int row = 256 * g + j0 + 8 * kg + jj; bv[jj] = wu[(size_t)row * D + n0 + c] * ps[row]; }
                    unsigned bhh[4], bll[4];
#pragma unroll
                    for (int q = 0; q < 4; ++q) { bhh[q] = pk2(bv[2 * q], bv[2 * q + 1]); bll[q] = pk2(bv[2 * q] - bflo(bhh[q]), bv[2 * q + 1] - bfhi(bhh[q])); }
                    const bf16x8 bh = __builtin_bit_cast(bf16x8, (v4u){bhh[0], bhh[1], bhh[2], bhh[3]}), bl = __builtin_bit_cast(bf16x8, (v4u){bll[0], bll[1], bll[2], bll[3]});
#pragma unroll
                    for (int mt = 0; mt < 4; ++mt) { const float* ap = pw + (size_t)g * POOL_GW * POOL_GW + (size_t)(kk0 + 16 * mt + c) * POOL_GW + j0 + 8 * kg;
                        const f32x4 a0 = *(const f32x4*)ap, a1 = *(const f32x4*)(ap + 4);
                        const unsigned h0 = pk2(a0.x, a0.y), h1 = pk2(a0.z, a0.w), h2_ = pk2(a1.x, a1.y), h3 = pk2(a1.z, a1.w);
                        const unsigned l0 = pk2(a0.x - bflo(h0), a0.y - bfhi(h0)), l1 = pk2(a0.z - bflo(h1), a0.w - bfhi(h1)), l2 = pk2(a1.x - bflo(h2_), a1.y - bfhi(h2_)), l3 = pk2(a1.z - bflo(h3), a1.w - bfhi(h3));
                        const bf16x8 ah = __builtin_bit_cast(bf16x8, (v4u){h0, h1, h2_, h3}), al = __builtin_bit_cast(bf16x8, (v4u){l0, l1, l2, l3});
                        acc[mt] = __builtin_amdgcn_mfma_f32_16x16x32_bf16(ah, bh, acc[mt], 0, 0, 0); acc[mt] = __builtin_amdgcn_mfma_f32_16x16x32_bf16(al, bh, acc[mt], 0, 0, 0); acc[mt] = __builtin_amdgcn_mfma_f32_16x16x32_bf16(ah, bl, acc[mt], 0, 0, 0); }
                }
#pragma unroll
                for (int mt = 0; mt < 4; ++mt) { v2u o; o.x = pk2(acc[mt][0], acc[mt][1]); o.y = pk2(acc[mt][2], acc[mt][3]); *(v2u*)(WCOMB + (size_t)(n0 + c) * D_POOL + 256 * g + kk0 + 16 * mt + 4 * kg) = o; }
            }
        }
        {
            const float* gm = F.in[I_NORM_MOE]; const float* wrg = F.in[I_W_RG]; const float* wre = F.in[I_W_RE];
            for (int idx = gw * 64 + lane; idx < 48 * D; idx += NGW * 64) { const int n = idx / D, k = idx % D;
                const float v = n < 4 ? gm[k] * wrg[(size_t)k * NGRP + n] : (n < 36 ? gm[k] * wre[(size_t)k * NE + (n - 4)] : 0.f);
                const unsigned hi = f2bf(v); WRH[idx] = (bf16)hi; WRL[idx] = (bf16)f2bf(v - __uint_as_float(hi << 16)); }
        }
        {
            const float* gain = F.in[I_NORM_MIX]; const float* win = F.in[I_W_IN];
            __syncthreads();
            LAS float* LGp = (LAS float*)(F.lds + RING_OFF);
            LAS float* SSp = LGp + 8 * 256;
            LAS float* RS = SSp + 128;
            const int row = lane & 15, g = lane >> 4, wv = F.wave;
            bf16x8 wbh[8], wbl[8];
#pragma unroll
            for (int J = 0; J < 8; ++J) { unsigned hh[4], ll[4];
#pragma unroll
                for (int q = 0; q < 4; ++q) { const int k = 256 * wv + 32 * J + 8 * g + 2 * q; const float v0 = gain[k] * win[(size_t)k * D_IN + 5120 + row], v1 = gain[k + 1] * win[(size_t)(k + 1) * D_IN + 5120 + row];
                    hh[q] = pk2(v0, v1); ll[q] = pk2(v0 - bflo(hh[q]), v1 - bfhi(hh[q])); }
                wbh[J] = __builtin_bit_cast(bf16x8, (v4u){hh[0], hh[1], hh[2], hh[3]}); wbl[J] = __builtin_bit_cast(bf16x8, (v4u){ll[0], ll[1], ll[2], ll[3]}); }
            for (int task = F.vcu; task < T / 16; task += F.G) {
                const int r0 = task * 16; const float* hp_ = F.in[I_X] + (size_t)(r0 + row) * D + 256 * wv + 8 * g;
                f32x4 a[8][2];
#pragma unroll
                for (int J = 0; J < 8; ++J) { a[J][0] = *(const f32x4*)(hp_ + 32 * J); a[J][1] = *(const f32x4*)(hp_ + 32 * J + 4); }
                f32x4 acc = (f32x4){0.f, 0.f, 0.f, 0.f}; float ss = 0.f;
#pragma unroll
                for (int J = 0; J < 8; ++J) { const f32x4 x0 = a[J][0], x1 = a[J][1];
                    ss += ((x0.x * x0.x + x0.y * x0.y) + (x0.z * x0.z + x0.w * x0.w)) + ((x1.x * x1.x + x1.y * x1.y) + (x1.z * x1.z + x1.w * x1.w));
                    const unsigned h0 = pk2(x0.x, x0.y), h1 = pk2(x0.z, x0.w), h2_ = pk2(x1.x, x1.y), h3 = pk2(x1.z, x1.w);
                    const unsigned l0 = pk2(x0.x - bflo(h0), x0.y - bfhi(h0)), l1 = pk2(x0.z - bflo(h1), x0.w - bfhi(h1)), l2 = pk2(x1.x - bflo(h2_), x1.y - bfhi(h2_)), l3 = pk2(x1.z - bflo(h3), x1.w - bfhi(h3));
                    const bf16x8 ah = __builtin_bit_cast(bf16x8, (v4u){h0, h1, h2_, h3}), al = __builtin_bit_cast(bf16x8, (v4u){l0, l1, l2, l3});
                    acc = __builtin_amdgcn_mfma_f32_16x16x32_bf16(ah, wbh[J], acc, 0, 0, 0); acc = __builtin_amdgcn_mfma_f32_16x16x32_bf16(al, wbh[J], acc, 0, 0, 0); acc = __builtin_amdgcn_mfma_f32_16x16x32_bf16(ah, wbl[J], acc, 0, 0, 0); }
                ss += __shfl_xor(ss, 16); ss += __shfl_xor(ss, 32);
                LDS_BARRIER();
#pragma unroll
                for (int reg = 0; reg < 4; ++reg) LGp[wv * 256 + (4 * g + reg) * 16 + row] = acc[reg];
                if (g == 0) SSp[wv * 16 + row] = ss;
                LDS_BARRIER();
                if (F.tid < 16) { float s8 = 0.f;
#pragma unroll
                    for (int w8 = 0; w8 < 8; ++w8) s8 += SSp[w8 * 16 + F.tid];
                    RS[F.tid] = 1.0f / sqrtf(s8 * (1.f / D) + EPS); }
                LDS_BARRIER();
                if (F.tid < 256) { float s8 = 0.f;
#pragma unroll
                    for (int w8 = 0; w8 < 8; ++w8) s8 += LGp[w8 * 256 + F.tid];
                    BA[(size_t)(r0 + (F.tid >> 4)) * 16 + (F.tid & 15)] = s8 * RS[F.tid >> 4]; }
                {   const float rs = RS[row]; bf16* op = N1 + (size_t)(r0 + row) * D + 256 * wv + 8 * g; const float* gp = gain + 256 * wv + 8 * g;
#pragma unroll
                    for (int J = 0; J < 8; ++J) { const f32x4 g0 = *(const f32x4*)(gp + 32 * J), g1 = *(const f32x4*)(gp + 32 * J + 4); const f32x4 x0 = a[J][0], x1 = a[J][1];
                        v4u o; o.x = pk2(x0.x * rs * g0.x, x0.y * rs * g0.y); o.y = pk2(x0.z * rs * g0.z, x0.w * rs * g0.w); o.z = pk2(x1.x * rs * g1.x, x1.y * rs * g1.y); o.w = pk2(x1.z * rs * g1.z, x1.w * rs * g1.w);
                        *(v4u*)(op + 32 * J) = o; }
                }
            }
            __syncthreads();
        }
        for (int m = gw; m < T; m += 4 * NGW) {
            f32x4 v[4];
#pragma unroll
            for (int q = 0; q < 4; ++q) v[q] = *((const f32x4*)(F.in[I_P] + (size_t)(m + q * NGW) * D_PLE) + lane);
#pragma unroll
            for (int q = 0; q < 4; ++q) { v2u o; o.x = pk2(v[q].x, v[q].y); o.y = pk2(v[q].z, v[q].w); *((v2u*)(PBF + (size_t)(m + q * NGW) * D_PLE) + lane) = o; } }
    }
    SEAM(PH_PRO);
    if (IN(PH_INPROJ)) {
        pg8::DenseOrder S; S.init(T, N_IN_PAD, D, F.G, (int)blockIdx.x);
        EpiInProj E{UPOOL, QKV, ZS, GP, GD};
        pg8::gemm_phase<EpiInProj, pg8::DenseOrder, false, true, true, true>(F.lds + RING_OFF, N1, WIN, D, S, E);
    }
    SEAM(PH_INPROJ);
    if (IN(PH_TOKLOC)) {
        const float* cw = F.in[I_CONV_W];
        LAS float* red = (LAS float*)(F.lds + RING_OFF + F.wave * 4608);
        LAS float* SC = red + 1024;
#define TL_LOAD(U, item_) do { const int run_ = (item_) / 12, blk_ = (item_) % 12, t0_ = run_ * 16, s0_ = t0_ % SEQ, c_ = blk_ * 256 + 4 * lane; \
            _Pragma("unroll") for (int i = 0; i < 19; ++i) { const bool ok_ = (i >= 3) || (s0_ > 0); const v2u v_ = __builtin_nontemporal_load((const v2u*)(QKV + (size_t)(t0_ - 3 + (ok_ ? i : 3)) * D_QKV + c_)); U[i] = ok_ ? v_ : (v2u){0u, 0u}; } } while (0)
#define TL_BODY(u, item_) do { const int run = (item_) / 12, blk = (item_) % 12, t0 = run * 16, c = blk * 256 + 4 * lane; \
            f32x4 w[4]; \
_Pragma("unroll") \
            for (int kk = 0; kk < 4; ++kk) w[kk] = *(const f32x4*)(cw + kk * D_QKV + c); \
            f32x4 y[16]; \
_Pragma("unroll") \
            for (int tt = 0; tt < 16; ++tt) { f32x4 a = (f32x4){0.f, 0.f, 0.f, 0.f}; \
_Pragma("unroll") \
                for (int kk = 0; kk < 4; ++kk) { const v2u x = u[tt + kk]; a.x += bflo(x.x) * w[kk].x; a.y += bfhi(x.x) * w[kk].y; a.z += bflo(x.y) * w[kk].z; a.w += bfhi(x.y) * w[kk].w; } \
                a.x = siluf_(a.x); a.y = siluf_(a.y); a.z = siluf_(a.z); a.w = siluf_(a.w); y[tt] = a; } \
            if (blk < 8) { \
_Pragma("unroll") \
                for (int tt = 0; tt < 16; ++tt) red[tt * 64 + lane] = (y[tt].x * y[tt].x + y[tt].y * y[tt].y) + (y[tt].z * y[tt].z + y[tt].w * y[tt].w); \
                asm volatile("s_waitcnt lgkmcnt(0)" ::: "memory"); \
                {   const int tt = lane & 15, hd = (lane >> 4) & 1, part = lane >> 5; float sm = 0.f; \
_Pragma("unroll") \
                    for (int i = 0; i < 16; ++i) sm += red[tt * 64 + hd * 32 + part * 16 + ((i + lane) & 15)]; \
                    sm += __shfl_xor(sm, 32); \
                    float rr = 1.0f / sqrtf(sm + EPS); if (blk < 4) rr *= 0.08838834764831845f; \
                    if (part == 0) SC[hd * 16 + tt] = rr; } \
                asm volatile("s_waitcnt lgkmcnt(0)" ::: "memory"); \
_Pragma("unroll") \
                for (int q4 = 0; q4 < 4; ++q4) { const f32x4 sc = *(const LAS f32x4*)(SC + (lane >> 5) * 16 + 4 * q4); \
_Pragma("unroll") \
                    for (int i = 0; i < 4; ++i) y[4 * q4 + i] = y[4 * q4 + i] * sc[i]; } \
                asm volatile("s_waitcnt lgkmcnt(0)" ::: "memory"); \
            } \
_Pragma("unroll") \
            for (int tt = 0; tt < 16; ++tt) { v2u o; o.x = pk2(y[tt].x, y[tt].y); o.y = pk2(y[tt].z, y[tt].w); __builtin_nontemporal_store(o, (v2u*)(QKV2 + (size_t)(t0 + tt) * D_QKV + c)); } \
 \
        } while (0)
        {
            v2u ua[19], ub[19]; const int NIT = 2048 * 12;
            int item = gw; if (item < NIT) TL_LOAD(ua, item);
            for (; item < NIT; item += 2 * NGW) {
                if (item + NGW < NIT) TL_LOAD(ub, item + NGW);
                TL_BODY(ua, item);
                if (item + 2 * NGW < NIT) TL_LOAD(ua, item + 2 * NGW);
                if (item + NGW < NIT) TL_BODY(ub, item + NGW);
            }
        }
#undef TL_LOAD
#undef TL_BODY
        for (int item = gw; item < 1024 * 4; item += NGW) {
            const int run = item >> 2, gi = item & 3, t0 = run * 32, s0 = t0 % SEQ, c = gi * 256 + 4 * lane;
#define POOL_BODY(W) { v2u u[31 + W]; \
                _Pragma("unroll") for (int i = 0; i < 31 + W; ++i) u[i] = (s0 - (W - 1) + i >= 0) ? *(const v2u*)(UPOOL + (size_t)(t0 - (W - 1) + i) * D_POOL + c) : (v2u){0u, 0u}; \
                _Pragma("unroll") for (int tt = 0; tt < 32; ++tt) { f32x4 sm = (f32x4){0.f, 0.f, 0.f, 0.f}; \
                    _Pragma("unroll") for (int j = 0; j < W; ++j) { const v2u x = u[tt + j]; sm.x += bflo(x.x); sm.y += bfhi(x.x); sm.z += bflo(x.y); sm.w += bfhi(x.y); } \
                    const v2u xc = u[tt + W - 1]; const float inv = 1.0f / (float)((s0 + tt + 1) < W ? (s0 + tt + 1) : W); \
                    v2u o; o.x = pk2(sm.x * inv - bflo(xc.x), sm.y * inv - bfhi(xc.x)); o.y = pk2(sm.z * inv - bflo(xc.y), sm.w * inv - bfhi(xc.y)); \
                    *(v2u*)(DBUF + (size_t)(t0 + tt) * D_POOL + c) = o; } }
            if (gi == 0) POOL_BODY(2) else if (gi == 1) POOL_BODY(4) else if (gi == 2) POOL_BODY(8) else POOL_BODY(16)
#undef POOL_BODY
        }
        for (int idx = gw * 64 + lane; idx < T * NH; idx += NGW * 64) { const int t = idx >> 3, hh = idx & 7; const float bl = BA[(size_t)t * 16 + hh], al = BA[(size_t)t * 16 + 8 + hh]; const float xx = al + F.in[I_DT_BIAS][hh];
            const float sp = xx > 20.f ? xx : log1pf(__expf(xx)); GG[idx] = -__expf(F.in[I_A_LOG][hh]) * sp; BETA[idx] = sigmoidf_(bl); }
    }
    SEAM(PH_TOKLOC);
    if (IN(PH_DNA)) {
        const int hb = F.tid >> 8, t4 = F.tid & 255, wq = t4 >> 6;
        LAS unsigned char* hl = F.lds + RING_OFF + hb * 62464;
        LAS bf16* Ks = (LAS bf16*)hl;
        LAS bf16* Qs = Ks + 64 * 136;
        LAS float* Ls = (LAS float*)(hl + 2 * 17408);
        LAS float* gs = (LAS float*)(hl + 3 * 17408);
        LAS bf16* IMG = (LAS bf16*)(hl + 3 * 17408 + 2048);
        LAS bf16* UWI = Qs;
        v4u kqn[8]; float gbn[2] = {0.f, 0.f};
#define DNA_PREF(up_) do { const int unit_ = (up_) * 2 + hb, bh_ = unit_ >> 7, h_ = bh_ & 7; const size_t tok_ = (size_t)(bh_ >> 3) * SEQ + (size_t)(unit_ & 127) * 64; \
            _Pragma("unroll") for (int i = 0; i < 4; ++i) { const int idx = t4 + 256 * i, row = idx >> 4, ch = idx & 15; \
                kqn[2 * i] = __builtin_nontemporal_load((const v4u*)(QKV2 + (tok_ + row) * D_QKV + 1024 + h_ * 128 + ch * 8)); kqn[2 * i + 1] = __builtin_nontemporal_load((const v4u*)(QKV2 + (tok_ + row) * D_QKV + h_ * 128 + ch * 8)); } \
            if (t4 < 64) { gbn[0] = GG[(tok_ + t4) * NH + h_]; gbn[1] = BETA[(tok_ + t4) * NH + h_]; } } while (0)
        if (F.vcu < DN_UNITS / 2) DNA_PREF(F.vcu);
        for (int up = F.vcu; up < DN_UNITS / 2; up += F.G) {
            const int unit = up * 2 + hb, bh = unit >> 7, cch = unit & 127, b = bh >> 3, h = bh & 7; const size_t tok0 = (size_t)b * SEQ + (size_t)cch * 64;
            unsigned char* pk = PKG + (size_t)unit * PKG_BYTES; bf16* pW = (bf16*)pk; bf16* pQ = (bf16*)(pk + 16384); bf16* pA = (bf16*)(pk + 32768); bf16* pKT = (bf16*)(pk + 40960); float* pS = (float*)(pk + 57344);
            bf16* pU = UT + (size_t)unit * 8192;
            float x[64];
            if (t4 < 128) {
#pragma unroll
                for (int i = 0; i < 64; ++i) x[i] = bf2f(__builtin_nontemporal_load(QKV2 + (tok0 + i) * D_QKV + 2048 + h * 128 + t4));
            }
            LDS_BARRIER();
            if (t4 < 64) { gs[t4] = gbn[0]; gs[64 + t4] = gbn[1]; }
#pragma unroll
            for (int i = 0; i < 4; ++i) { const int idx = t4 + 256 * i, row = idx >> 4, ch = idx & 15;
                *(LAS v4u*)(Ks + row * 136 + ch * 8) = kqn[2 * i]; *(LAS v4u*)(Qs + row * 136 + ch * 8) = kqn[2 * i + 1]; }
            if (up + F.G < DN_UNITS / 2) DNA_PREF(up + F.G);
            LDS_BARRIER();
            if (t4 < 64) {
                float a = gs[t4];
#pragma unroll
                for (int o = 1; o < 64; o <<= 1) { const float tv = __shfl_up(a, o); if (lane >= o) a += tv; }
                gs[128 + t4] = a; }
            LDS_BARRIER();
            if (t4 < 64) { const float gl = gs[128 + 63], gc = gs[128 + t4]; gs[192 + t4] = __expf(gc); gs[256 + t4] = __expf(gl - gc); }
            {
                const int c = lane & 15, gq = lane >> 4;
                f32x4 kk[4], qk[4];
#pragma unroll
                for (int jb = 0; jb < 4; ++jb) { kk[jb] = (f32x4){0.f, 0.f, 0.f, 0.f}; qk[jb] = (f32x4){0.f, 0.f, 0.f, 0.f}; }
#pragma unroll
                for (int ks = 0; ks < 4; ++ks) {
                    const bf16x8 aK = *(const LAS bf16x8*)(Ks + (16 * wq + c) * 136 + 32 * ks + 8 * gq), aQ = *(const LAS bf16x8*)(Qs + (16 * wq + c) * 136 + 32 * ks + 8 * gq);
#pragma unroll
                    for (int jb = 0; jb < 4; ++jb) { const bf16x8 bK = *(const LAS bf16x8*)(Ks + (16 * jb + c) * 136 + 32 * ks + 8 * gq);
                        kk[jb] = __builtin_amdgcn_mfma_f32_16x16x32_bf16(aK, bK, kk[jb], 0, 0, 0); qk[jb] = __builtin_amdgcn_mfma_f32_16x16x32_bf16(aQ, bK, qk[jb], 0, 0, 0); }
                }
#pragma unroll
                for (int reg = 0; reg < 4; ++reg) { const int row = 16 * wq + 4 * gq + reg; const float gi = gs[128 + row], bi = gs[64 + row];
#pragma unroll
                    for (int jb = 0; jb < 4; ++jb) { const int col = 16 * jb + c; const float dec = (row >= col) ? __expf(gi - gs[128 + col]) : 0.f;
                        Ls[row * 68 + col] = (row > col) ? -(bi * kk[jb][reg] * dec) : 0.f;
                        IMG[tix(row, col, 4)] = (bf16)f2bf(qk[jb][reg] * dec); } }
            }
#pragma unroll 1
            for (int it = 0; it < 4; ++it) { const int sl = t4 + 256 * it, fr_ = sl >> 6, lp = sl & 63, hh = lp >> 5, r = lp & 31;
                {   const int rt = fr_ >> 3, s = fr_ & 7, row = 32 * rt + r, k0 = 16 * s + 4 * hh; const float eg = __expf(gs[128 + row]);
                    const v2u q0 = *(const LAS v2u*)(Qs + row * 136 + k0), q1 = *(const LAS v2u*)(Qs + row * 136 + k0 + 8);
                    v4u o; o.x = pk2(bflo(q0.x) * eg, bfhi(q0.x) * eg); o.y = pk2(bflo(q0.y) * eg, bfhi(q0.y) * eg); o.z = pk2(bflo(q1.x) * eg, bfhi(q1.x) * eg); o.w = pk2(bflo(q1.y) * eg, bfhi(q1.y) * eg);
                    __builtin_nontemporal_store(o, (v4u*)(pQ + sl * 8)); }
                {   const int rt = fr_ >> 2, s = fr_ & 3, dk = 32 * rt + r, i0 = 16 * s + 4 * hh; float kv[8]; const float gl_ = gs[128 + 63];
#pragma unroll
                    for (int e = 0; e < 4; ++e) { kv[e] = bf2f(Ks[(i0 + e) * 136 + dk]) * __expf(gl_ - gs[128 + i0 + e]); kv[4 + e] = bf2f(Ks[(i0 + 8 + e) * 136 + dk]) * __expf(gl_ - gs[128 + i0 + 8 + e]); }
                    v4u o; o.x = pk2(kv[0], kv[1]); o.y = pk2(kv[2], kv[3]); o.z = pk2(kv[4], kv[5]); o.w = pk2(kv[6], kv[7]);
                    __builtin_nontemporal_store(o, (v4u*)(pKT + sl * 8)); } }
            if (t4 == 0) pS[128] = __expf(gs[128 + 63]);
            LDS_BARRIER();
#pragma unroll
            for (int i = 0; i < 2; ++i) { const int idx = t4 + 256 * i; __builtin_nontemporal_store(*(const LAS v4u*)(IMG + idx * 8), (v4u*)(pA + idx * 8)); }
            {
                if (t4 < 128) {
#pragma unroll
                    for (int i = 0; i < 64; ++i) x[i] *= gs[64 + i];
                } else {
#pragma unroll
                    for (int i = 0; i < 64; ++i) x[i] = gs[64 + i] * bf2f(Ks[i * 136 + (t4 - 128)]) * gs[192 + i];
                }
                SolveRows<60>::run(x, Ls, lane & 15);
            }
            LDS_BARRIER();
            if (t4 < 128) { const int w = t4 >> 5, c = t4 & 31;
#pragma unroll
                for (int i = 0; i < 64; ++i) { const int rt = i >> 5, i32 = i & 31, hh = (i32 >> 2) & 1, reg = (i32 & 3) + 4 * (i32 >> 3); UWI[(((w * 2 + rt) * 64 + hh * 32 + c) << 4) + reg] = (bf16)f2bf(x[i]); }
            } else { const int dk = t4 - 128;
#pragma unroll
                for (int i = 0; i < 64; ++i) UWI[8192 + tix(i, dk, 8)] = (bf16)f2bf(-x[i]);
            }
            LDS_BARRIER();
#pragma unroll
            for (int i = 0; i < 4; ++i) { const int idx = t4 + 256 * i; __builtin_nontemporal_store(*(const LAS v4u*)(UWI + idx * 8), (v4u*)(pU + idx * 8)); __builtin_nontemporal_store(*(const LAS v4u*)(UWI + 8192 + idx * 8), (v4u*)(pW + idx * 8)); }
        }
        __syncthreads();
#undef DNA_PREF
    }
    SEAM(PH_DNA);
    if (IN(PH_DN)) {
        if ((int)blockIdx.x < NB * NH) { if (!(args.flags & 1)) {
            const int bh = (int)blockIdx.x, b = bh >> 3, hh = bh & 7; const size_t tokb = (size_t)b * SEQ;
            const unsigned char* pkg0 = PKG + (size_t)bh * 128 * PKG_BYTES; const bf16* ut0 = UT + (size_t)bh * 128 * 8192;
            const bool loader = F.wave >= 4; const int lt = F.tid - 256;
            if (loader) {
                const int wl = __builtin_amdgcn_readfirstlane(lt >> 6);
                if (wl == 0) scan_loader<0>(F.lds + RING_OFF, pkg0, (const unsigned char*)ut0, (lt & 63) * 16);
                else if (wl == 1) scan_loader<1>(F.lds + RING_OFF, pkg0, (const unsigned char*)ut0, (lt & 63) * 16);
                else if (wl == 2) scan_loader<2>(F.lds + RING_OFF, pkg0, (const unsigned char*)ut0, (lt & 63) * 16);
                else scan_loader<3>(F.lds + RING_OFF, pkg0, (const unsigned char*)ut0, (lt & 63) * 16);
            } else {
            const int w = F.wave & 3, r = lane & 31, h2 = lane >> 5;
            f32x16 S[4]; bf16x8 Sb[8];
#pragma unroll
            for (int d = 0; d < 4; ++d)
#pragma unroll
                for (int i = 0; i < 16; ++i) S[d][i] = 0.f;
#pragma unroll
            for (int s = 0; s < 8; ++s)
#pragma unroll
                for (int i = 0; i < 8; ++i) Sb[s][i] = 0;
            unsigned char* sst0 = SST_OF(bh * 128);
            for (int n = 0; n < 128; ++n) {
                LDS_BARRIER();
                {
                    LAS unsigned char* st = F.lds + RING_OFF + (n & 1) * STG_BYTES;
#define FRAG(off, f) (*(const LAS bf16x8*)(st + (off) + (f) * 1024 + lane * 16))
#define MF(a, b, c) __builtin_amdgcn_mfma_f32_32x32x16_bf16((a), (b), (c), 0, 0, 0)
#define SB() __builtin_amdgcn_sched_barrier(0)
                    {   v4u* sp_ = (v4u*)(sst0 + (size_t)n * 32768) + (w * 8) * 64 + lane;
#pragma unroll
                        for (int s = 0; s < 8; ++s) __builtin_nontemporal_store(__builtin_bit_cast(v4u, Sb[s]), sp_ + s * 64); }
                    f32x16 vn[2];
#pragma unroll
                    for (int rt = 0; rt < 2; ++rt) {
#pragma unroll
                        for (int q = 0; q < 2; ++q) { const v4u u4 = *(const LAS v4u*)(st + SL_U + (((w * 2 + rt) * 64 + lane) << 5) + q * 16);
                            vn[rt][8 * q + 0] = bflo(u4.x); vn[rt][8 * q + 1] = bfhi(u4.x); vn[rt][8 * q + 2] = bflo(u4.y); vn[rt][8 * q + 3] = bfhi(u4.y);
                            vn[rt][8 * q + 4] = bflo(u4.z); vn[rt][8 * q + 5] = bfhi(u4.z); vn[rt][8 * q + 6] = bflo(u4.w); vn[rt][8 * q + 7] = bfhi(u4.w); } }
                    const float egl = *(const LAS float*)(st + SL_SC + 512);
                    bf16x8 fq[4], ga[4], gb[4], vb[4];
#define LDW(rt_, s_) FRAG(0, (rt_) * 8 + (s_))
#define LD8(dst, sp) do { dst[0] = FRAG(SL_KT, sp); dst[1] = FRAG(SL_KT, 4 + (sp)); dst[2] = FRAG(SL_KT, 8 + (sp)); dst[3] = FRAG(SL_KT, 12 + (sp)); } while (0)
#define CVB(sp) do { const int rt_ = (sp) >> 1, base_ = 8 * ((sp) & 1); unsigned pv_[4]; \
        _Pragma("unroll") for (int jj = 0; jj < 4; ++jj) pv_[jj] = pk2(vn[rt_][base_ + 2 * jj], vn[rt_][base_ + 2 * jj + 1]); \
        vb[sp] = __builtin_bit_cast(bf16x8, (v4u){pv_[0], pv_[1], pv_[2], pv_[3]}); } while (0)
#define CSB(s_) do { const int d_ = (s_) >> 1, base_ = 8 * ((s_) & 1); unsigned pv_[4]; \
        _Pragma("unroll") for (int jj = 0; jj < 4; ++jj) pv_[jj] = pk2(S[d_][base_ + 2 * jj], S[d_][base_ + 2 * jj + 1]); \
        Sb[s_] = __builtin_bit_cast(bf16x8, (v4u){pv_[0], pv_[1], pv_[2], pv_[3]}); } while (0)
                    fq[0] = LDW(0, 0); fq[1] = LDW(0, 1); fq[2] = LDW(0, 2); fq[3] = LDW(0, 3);
                    SB();
#pragma unroll
                    for (int t = 0; t < 16; ++t) { const int rt = t >> 3, s_ = t & 7;
                        vn[rt] = MF(fq[t & 3], Sb[s_], vn[rt]);
                        SB();
                        if (t + 4 < 16) fq[t & 3] = LDW((t + 4) >> 3, (t + 4) & 7);
                        if (t == 12) LD8(ga, 0);
                        if (t == 13) LD8(gb, 1);
#pragma unroll
                        for (int i = 0; i < 4; ++i) S[t >> 2][4 * (t & 3) + i] *= egl;
                        if (t == 9) CVB(0);
                        if (t == 10) CVB(1);
                        SB();
                    }
                    S[0] = MF(ga[0], vb[0], S[0]); S[1] = MF(ga[1], vb[0], S[1]); S[2] = MF(ga[2], vb[0], S[2]); S[3] = MF(ga[3], vb[0], S[3]);
                    SB();
                    LD8(ga, 2); CVB(2);
                    SB();
                    S[0] = MF(gb[0], vb[1], S[0]); S[1] = MF(gb[1], vb[1], S[1]); S[2] = MF(gb[2], vb[1], S[2]); S[3] = MF(gb[3], vb[1], S[3]);
                    SB();
                    LD8(gb, 3); CVB(3);
                    SB();
                    S[0] = MF(ga[0], vb[2], S[0]); S[0] = MF(gb[0], vb[3], S[0]);
                    SB();
                    S[1] = MF(ga[1], vb[2], S[1]); S[1] = MF(gb[1], vb[3], S[1]);
                    SB();
                    CSB(0); CSB(1);
                    SB();
                    S[2] = MF(ga[2], vb[2], S[2]); S[2] = MF(gb[2], vb[3], S[2]);
                    SB();
                    CSB(2); CSB(3);
                    SB();
                    S[3] = MF(ga[3], vb[2], S[3]); S[3] = MF(gb[3], vb[3], S[3]);
                    SB();
                    CSB(4); CSB(5);
                    SB();
                    CSB(6); CSB(7);
#undef LDW
#undef CVB
#undef CSB
#undef LD8
#undef FRAG
#undef MF
#undef SB
                }
            }
            }
        } } else if (!(args.flags & 2)) {
            pg8::DenseOrder S; S.init(T, D, D_POOL, F.G - NB * NH, (int)blockIdx.x - NB * NH); EpiPool E{GP, MP};
            if (!(args.flags & 8)) pg8::gemm_phase<EpiPool, pg8::DenseOrder, false, true, true, true>(F.lds + RING_OFF, DBUF, WCOMB, D_POOL, S, E);
        }
        if (!(args.flags & 4)) {
            constexpr int IT_GU = NE * (D / 128) * 32, PER_DN = (DE / 128) * (D / 32), IT_ALL = IT_GU + NE * PER_DN;
            for (;;) {
                int it0 = 0; if (lane == 0) it0 = (int)atomicAdd(&F.ctl[CW_TR], 4u);
                it0 = __builtin_amdgcn_readfirstlane(it0);
                if (it0 >= IT_ALL) break;
#pragma unroll 1
                for (int it = it0; it < it0 + 4; ++it) {
                    if (it < IT_GU) {
                        const int e = it / (16 * 32), rem = it % (16 * 32), kb = rem / 32, nb = rem % 32;
                        const int r0 = 32 * nb, pn = r0 >> 8, rin = r0 & 255; const bool up = rin >= 128; const int c0 = pn * 128 + (rin & 127);
                        transpose_item((up ? F.in[I_W_UP] : F.in[I_W_GATE]) + (size_t)e * D * DE, DE, D, 128 * kb, c0, 32, WGU + (size_t)e * 1024 * D, r0, nullptr, lane);
                    } else {
                        const int j = it - IT_GU, e = j / PER_DN, rem = j % PER_DN, kb = rem / (D / 32), nb = rem % (D / 32);
                        transpose_item(F.in[I_W_DOWN] + (size_t)e * DE * D, D, DE, 128 * kb, 32 * nb, 32, WDN + (size_t)e * D * DE, 32 * nb, nullptr, lane);
                    }
                }
            }
        }
        __syncthreads();
    }
    SEAM(PH_DN);
    if (IN(PH_YDN)) {
        const int hb = F.tid >> 8, t4 = F.tid & 255, wq = t4 >> 6, r = lane & 31, h2 = lane >> 5;
        LAS unsigned char* hl = F.lds + RING_OFF + hb * 58368;
        LAS bf16* OT = (LAS bf16*)(hl + 40960);
        LAS float* dnl = (LAS float*)(F.lds + OT_OFF);
        const int orow = t4 >> 3, opc = t4 & 7;
        if (F.tid < 128) dnl[F.tid] = F.in[I_DN_NORM][F.tid];
        v4u sg[10]; bf16x8 Sb[8]; v4u un[2][2];
#define YD_SG(u_) do { const unsigned char* pk_ = PKG + (size_t)(u_) * PKG_BYTES; _Pragma("unroll") for (int i = 0; i < 10; ++i) sg[i] = __builtin_nontemporal_load((const v4u*)(pk_ + (size_t)(t4 + 256 * i) * 16)); } while (0)
#define YD_SU(u_) do { const unsigned char* sst_ = SST_OF(u_); const bf16* ut_ = UT + (size_t)(u_) * 8192; \
        _Pragma("unroll") for (int s = 0; s < 8; ++s) Sb[s] = __builtin_bit_cast(bf16x8, __builtin_nontemporal_load((const v4u*)sst_ + (wq * 8 + s) * 64 + lane)); \
        _Pragma("unroll") for (int rt = 0; rt < 2; ++rt) { const v4u* up_ = (const v4u*)(ut_ + (((wq * 2 + rt) * 64 + lane) << 4)); un[rt][0] = up_[0]; un[rt][1] = up_[1]; } } while (0)
        if (F.vcu < DN_UNITS / 2) { YD_SG(F.vcu * 2 + hb); YD_SU(F.vcu * 2 + hb); }
        for (int up = F.vcu; up < DN_UNITS / 2; up += F.G) {
            const int unit = up * 2 + hb, bh = unit >> 7, cch = unit & 127, b = bh >> 3, h = bh & 7; const size_t tok0 = (size_t)b * SEQ + (size_t)cch * 64;
            const int unext = ((up + F.G < DN_UNITS / 2) ? up + F.G : up) * 2 + hb;
            const size_t goff = (tok0 + orow) * D_Z + h * 128 + 8 * opc;
            LDS_BARRIER();
#pragma unroll
            for (int i = 0; i < 10; ++i) *(LAS v4u*)(hl + (t4 + 256 * i) * 16) = sg[i];
            LDS_BARRIER();
            v4u zq[4];
#pragma unroll
            for (int q = 0; q < 4; ++q) zq[q] = *(const v4u*)(ZS + goff + (size_t)(q >> 1) * 32 * D_Z + 64 * (q & 1));
            __builtin_amdgcn_sched_barrier(0);
            YD_SG(unext);
            __builtin_amdgcn_sched_barrier(0);
            f32x16 vn[2], qs[2];
#pragma unroll
            for (int rt = 0; rt < 2; ++rt) {
#pragma unroll
                for (int q = 0; q < 2; ++q) { const v4u u4 = un[rt][q];
                    vn[rt][8 * q + 0] = bflo(u4.x); vn[rt][8 * q + 1] = bfhi(u4.x); vn[rt][8 * q + 2] = bflo(u4.y); vn[rt][8 * q + 3] = bfhi(u4.y);
                    vn[rt][8 * q + 4] = bflo(u4.z); vn[rt][8 * q + 5] = bfhi(u4.z); vn[rt][8 * q + 6] = bflo(u4.w); vn[rt][8 * q + 7] = bfhi(u4.w); }
#pragma unroll
                for (int i = 0; i < 16; ++i) qs[rt][i] = 0.f; }
#define FRAGH(off, f) (*(const LAS bf16x8*)(hl + (off) + (f) * 1024 + lane * 16))
#pragma unroll
            for (int s = 0; s < 8; ++s)
#pragma unroll
                for (int rt = 0; rt < 2; ++rt) {
                    vn[rt] = __builtin_amdgcn_mfma_f32_32x32x16_bf16(FRAGH(0, rt * 8 + s), Sb[s], vn[rt], 0, 0, 0);
                    qs[rt] = __builtin_amdgcn_mfma_f32_32x32x16_bf16(FRAGH(16384, rt * 8 + s), Sb[s], qs[rt], 0, 0, 0); }
            __builtin_amdgcn_sched_barrier(0);
            YD_SU(unext);
            __builtin_amdgcn_sched_barrier(0);
            bf16x8 vb[4];
#pragma unroll
            for (int sp = 0; sp < 4; ++sp) { const int rt = sp >> 1, base = 8 * (sp & 1); unsigned pv[4];
#pragma unroll
                for (int jj = 0; jj < 4; ++jj) pv[jj] = pk2(vn[rt][base + 2 * jj], vn[rt][base + 2 * jj + 1]);
                vb[sp] = __builtin_bit_cast(bf16x8, (v4u){pv[0], pv[1], pv[2], pv[3]}); }
#pragma unroll
            for (int sp = 0; sp < 4; ++sp)
#pragma unroll
                for (int rt = 0; rt < 2; ++rt) qs[rt] = __builtin_amdgcn_mfma_f32_32x32x16_bf16(FRAGH(32768, rt * 4 + sp), vb[sp], qs[rt], 0, 0, 0);
#undef FRAGH
#pragma unroll
            for (int rt = 0; rt < 2; ++rt)
#pragma unroll
                for (int rp = 0; rp < 8; ++rp) { const int reg = 2 * rp, row = 32 * rt + (reg & 3) + 8 * (reg >> 2) + 4 * h2; const unsigned pv = pk2(qs[rt][reg], qs[rt][reg + 1]);
                    OT[row * 136 + 32 * wq + r] = (bf16)(pv & 0xffffu); OT[(row + 1) * 136 + 32 * wq + r] = (bf16)(pv >> 16); }
            LDS_BARRIER();
            {
                float ov[32], zv[32];
#pragma unroll
                for (int q = 0; q < 4; ++q) { unpack8bf(*(const LAS v4u*)(OT + (orow + 32 * (q >> 1)) * 136 + 64 * (q & 1) + 8 * opc), ov + 8 * q); unpack8bf(zq[q], zv + 8 * q); }
#pragma unroll
                for (int p2 = 0; p2 < 2; ++p2) { float ss = 0.f;
#pragma unroll
                    for (int i = 0; i < 16; ++i) ss += ov[16 * p2 + i] * ov[16 * p2 + i];
                    ss += __shfl_xor(ss, 1); ss += __shfl_xor(ss, 2); ss += __shfl_xor(ss, 4);
                    const float rr = __builtin_amdgcn_rsqf(ss * (1.f / 128.f) + EPS);
#pragma unroll
                    for (int j = 0; j < 2; ++j) { const int q = 2 * p2 + j; const f32x4 g0 = *(const LAS f32x4*)(dnl + 64 * j + 8 * opc), g1 = *(const LAS f32x4*)(dnl + 64 * j + 8 * opc + 4); float yv[8];
#pragma unroll
                        for (int i = 0; i < 4; ++i) { yv[i] = ov[8 * q + i] * rr * g0[i] * zv[8 * q + i]; yv[4 + i] = ov[8 * q + 4 + i] * rr * g1[i] * zv[8 * q + 4 + i]; }
                        store8bf(YDN + goff + (size_t)p2 * 32 * D_Z + 64 * j, yv); } }
            }
        }
#undef YD_SG
#undef YD_SU
        __syncthreads();
    }
    SEAM(PH_YDN);
    if (IN(PH_MERGE)) { pg8::DenseOrder S; S.init(T, D, D_Z, F.G, (int)blockIdx.x); EpiMerge E{GD, MP, MERGED}; pg8::gemm_phase<EpiMerge, pg8::DenseOrder, false, true, true, true>(F.lds + RING_OFF, YDN, WUPDN, D_Z, S, E); }
    SEAM(PH_MERGE);
    if (IN(PH_OUT)) { pg8::DenseOrder S; S.init(T, D, D, F.G, (int)blockIdx.x); EpiResid E{F.in[I_X], H}; pg8::gemm_phase<EpiResid, pg8::DenseOrder, false, true, true, true>(F.lds + RING_OFF, MERGED, WOUT, D, S, E); }
    SEAM(PH_OUT);
    if (IN(PH_ROUTE)) {
        const float* gain = F.in[I_NORM_MOE];
        LAS float* LGp = (LAS float*)(F.lds + RING_OFF);
        LAS float* LGs = LGp + 8 * 768;
        LAS float* SSp = LGs + 768;
        LAS float* RS = SSp + 128;
        LAS unsigned* LCNT = (LAS unsigned*)(RS + 16);
        LAS int* ENT = (LAS int*)(LCNT + 64);
        LAS float* GL = (LAS float*)(F.lds + RING_OFF + 65536);
        if (F.tid < 64) LCNT[F.tid] = 0u;
        for (int i = F.tid; i < D; i += NTHR) GL[i] = gain[i];
        int ntok = 0;
        __syncthreads();
        const int row = lane & 15, g = lane >> 4, wv = F.wave;
        const bf16* wph = WRH + (size_t)row * D + 256 * wv + 8 * g;
#define RT_LOAD(dst, tsk) do { const bf16* hp_ = H + (size_t)((tsk) * 16 + row) * D + 256 * wv + 8 * g; _Pragma("unroll") for (int J = 0; J < 8; ++J) dst[J] = *(const v4u*)(hp_ + 32 * J); } while (0)
#define RT_BODY(a, an, task, ntask) do { \
            const int r0 = (task) * 16; \
            f32x4 acc0 = (f32x4){0.f, 0.f, 0.f, 0.f}, acc1 = acc0, acc2 = acc0; float ss = 0.f; \
            _Pragma("unroll") for (int J = 0; J < 8; ++J) { \
                float xf[8]; unpack8bf(a[J], xf); \
                ss += ((xf[0] * xf[0] + xf[1] * xf[1]) + (xf[2] * xf[2] + xf[3] * xf[3])) + ((xf[4] * xf[4] + xf[5] * xf[5]) + (xf[6] * xf[6] + xf[7] * xf[7])); \
                const bf16x8 ah = __builtin_bit_cast(bf16x8, a[J]); \
                acc0 = __builtin_amdgcn_mfma_f32_16x16x32_bf16(ah, wb[J][0], acc0, 0, 0, 0); acc1 = __builtin_amdgcn_mfma_f32_16x16x32_bf16(ah, wb[J][1], acc1, 0, 0, 0); acc2 = __builtin_amdgcn_mfma_f32_16x16x32_bf16(ah, wb[J][2], acc2, 0, 0, 0); } \
            ss += __shfl_xor(ss, 16); ss += __shfl_xor(ss, 32); \
            LDS_BARRIER(); \
            _Pragma("unroll") for (int reg = 0; reg < 4; ++reg) { LAS float* q = LGp + wv * 768 + (4 * g + reg) * 48 + row; q[0] = acc0[reg]; q[16] = acc1[reg]; q[32] = acc2[reg]; } \
            if (g == 0) SSp[wv * 16 + row] = ss; \
            LDS_BARRIER(); \
            for (int e = F.tid; e < 768; e += NTHR) { float s8 = 0.f; _Pragma("unroll") for (int w8 = 0; w8 < 8; ++w8) s8 += LGp[w8 * 768 + e]; LGs[e] = s8; } \
            if (F.tid < 16) { float s8 = 0.f; _Pragma("unroll") for (int w8 = 0; w8 < 8; ++w8) s8 += SSp[w8 * 16 + F.tid]; RS[F.tid] = 1.0f / sqrtf(s8 * (1.f / D) + EPS); } \
            LDS_BARRIER(); \
            if (F.tid < 16) route_row(F, LGs + F.tid * 48, RS[F.tid], r0 + F.tid, LCNT, ENT, 2 * (ntok + F.tid)); ntok += 16; \
            { const float rs = RS[row]; bf16* op = N1 + (size_t)(r0 + row) * D + 256 * wv + 8 * g; const LAS float* gp = GL + 256 * wv + 8 * g; \
              _Pragma("unroll") for (int J = 0; J < 8; ++J) { const f32x4 g0 = *(const LAS f32x4*)(gp + 32 * J), g1 = *(const LAS f32x4*)(gp + 32 * J + 4); float xf[8]; unpack8bf(a[J], xf); \
                v4u o; o.x = pk2(xf[0] * rs * g0.x, xf[1] * rs * g0.y); o.y = pk2(xf[2] * rs * g0.z, xf[3] * rs * g0.w); o.z = pk2(xf[4] * rs * g1.x, xf[5] * rs * g1.y); o.w = pk2(xf[6] * rs * g1.z, xf[7] * rs * g1.w); \
                *(v4u*)(op + 32 * J) = o; } } } while (0)
        v4u ra[8];
        bf16x8 wb[8][3];
#pragma unroll
        for (int J = 0; J < 8; ++J)
#pragma unroll
            for (int t3 = 0; t3 < 3; ++t3) wb[J][t3] = *(const bf16x8*)(wph + 16 * t3 * D + 32 * J);
        {
            v4u rb[8]; int task = F.vcu;
            if (task < T / 16) RT_LOAD(ra, task);
#pragma unroll 1
            for (; task < T / 16; task += F.G) {
                const int tn = (task + F.G < T / 16) ? task + F.G : task;
                RT_LOAD(rb, tn);
                RT_BODY(ra, rb, task, tn);
#pragma unroll
                for (int J = 0; J < 8; ++J) ra[J] = rb[J];
            }
        }
#undef RT_LOAD
#undef RT_BODY
        __syncthreads();
        if (F.tid < NE) LCNT[32 + F.tid] = atomicAdd(&F.ctl[CW_CNT + 64 * F.tid], LCNT[F.tid]);
        __syncthreads();
        for (int i = F.tid; i < 2 * ntok; i += NTHR) { const int es = ENT[4 * i], e = es >> 16, slot = (int)LCNT[32 + e] + (es & 0xffff); LTK[(size_t)e * T + slot] = ENT[4 * i + 1]; LW[(size_t)e * T + slot] = __int_as_float(ENT[4 * i + 2]); }
        __syncthreads();
    }
    SEAM(PH_ROUTE);
    if (IN(PH_MOE1)) {
        LAS int* pre = (LAS int*)(F.lds + MISC_OFF + 256); LAS int* base = pre + 40;
        moe_tables<256>(F, pre, base);
        MoeSched<256, true> S{pre, base, LTK, 4, F.G, F.vcu, D, 1024};
        EpiMoe1 E{HMID}; pg8::gemm_phase<EpiMoe1, MoeSched<256, true>, true>(F.lds + RING_OFF, N1, WGU, D, S, E);
        {   __syncthreads();
            const int rem = (pre[NE] * 4) % F.G;
            pg8::TwoTierOrder S2; S2.init(T, D, D_PLE, F.G, F.vcu, rem, 5); EpiBf16Plain E2{PP};
            pg8::gemm_phase<EpiBf16Plain, pg8::TwoTierOrder, false>(F.lds + RING_OFF, PBF, WPLEP, D_PLE, S2, E2); }
    }
    SEAM(PH_MOE1);
    if (IN(PH_MOE2)) {
        LAS int* pre = (LAS int*)(F.lds + MISC_OFF + 256); LAS int* base = pre + 40;
        moe_tables<256>(F, pre, base);
        MoeSched<256, false> S{pre, base, LTK, 8, F.G, F.vcu, DE, D};
        EpiMoe2 E{LTK, LW, Y0, Y1}; pg8::gemm_phase<EpiMoe2, MoeSched<256, false>, false>(F.lds + RING_OFF, HMID, WDN, DE, S, E);
    }
    SEAM(PH_MOE2);
    if (IN(PH_N3)) {
        const float* gain = F.in[I_NORM_PLE];
        for (int t = gw; t < T; t += 2 * NGW) {
            v4u hv[2][4], ya[2][4], yb[2][4]; float xv[2][4][8]; float s[2] = {0.f, 0.f};
#pragma unroll
            for (int q = 0; q < 2; ++q) { const size_t ro = (size_t)(t + q * NGW) * D + 8 * lane;
#pragma unroll
                for (int j = 0; j < 4; ++j) { hv[q][j] = *(const v4u*)(H + ro + 512 * j); ya[q][j] = __builtin_nontemporal_load((const v4u*)(Y0 + ro + 512 * j)); yb[q][j] = __builtin_nontemporal_load((const v4u*)(Y1 + ro + 512 * j)); } }
#pragma unroll
            for (int q = 0; q < 2; ++q) { const size_t ro = (size_t)(t + q * NGW) * D + 8 * lane;
#pragma unroll
                for (int j = 0; j < 4; ++j) { float a[8], b[8]; unpack8bf(hv[q][j], xv[q][j]); unpack8bf(ya[q][j], a); unpack8bf(yb[q][j], b);
#pragma unroll
                    for (int i = 0; i < 8; ++i) { xv[q][j][i] += a[i] + b[i]; s[q] += xv[q][j][i] * xv[q][j][i]; }
                    store8bf(H + ro + 512 * j, xv[q][j]); } }
#pragma unroll
            for (int q = 0; q < 2; ++q) { const float rstd = __builtin_amdgcn_rsqf(wave_sum(s[q]) * (1.f / D) + EPS); const size_t ro = (size_t)(t + q * NGW) * D + 8 * lane;
#pragma unroll
                for (int j = 0; j < 4; ++j) { const f32x4 g0 = *(const f32x4*)(gain + 512 * j + 8 * lane), g1 = *(const f32x4*)(gain + 512 * j + 8 * lane + 4); float o[8];
#pragma unroll
                    for (int i = 0; i < 4; ++i) { o[i] = xv[q][j][i] * rstd * g0[i]; o[4 + i] = xv[q][j][4 + i] * rstd * g1[i]; }
                    store8bf(N1 + ro + 512 * j, o); } }
        }
    }
    SEAM(PH_N3);
    if (IN(PH_PLE)) { pg8::DenseOrder S; S.init(T, D, D, F.G, (int)blockIdx.x); EpiPle E{PP, H}; pg8::gemm_phase<EpiPle, pg8::DenseOrder, false, true, true, true>(F.lds + RING_OFF, N1, WPLEG, D, S, E); }
    SEAM(PH_PLE);
    if (IN(PH_FINAL)) {
        const float* gain = F.in[I_NORM_FINAL];
        for (int t = gw; t < T; t += 2 * NGW) {
            v4u hv[2][4]; float s[2] = {0.f, 0.f};
#pragma unroll
            for (int q = 0; q < 2; ++q)
#pragma unroll
                for (int j = 0; j < 4; ++j) hv[q][j] = __builtin_nontemporal_load((const v4u*)(H + (size_t)(t + q * NGW) * D + 8 * lane + 512 * j));
#pragma unroll
            for (int q = 0; q < 2; ++q)
#pragma unroll
                for (int j = 0; j < 4; ++j) { float a[8]; unpack8bf(hv[q][j], a);
#pragma unroll
                    for (int i = 0; i < 8; ++i) s[q] += a[i] * a[i]; }
#pragma unroll
            for (int q = 0; q < 2; ++q) { const float rstd = __builtin_amdgcn_rsqf(wave_sum(s[q]) * (1.f / D) + EPS); float* orow = F.out + (size_t)(t + q * NGW) * D + 8 * lane;
#pragma unroll
                for (int j = 0; j < 4; ++j) { const f32x4 g0 = *(const f32x4*)(gain + 512 * j + 8 * lane), g1 = *(const f32x4*)(gain + 512 * j + 8 * lane + 4); float a[8]; unpack8bf(hv[q][j], a);
                    __builtin_nontemporal_store((f32x4){a[0] * rstd * g0[0], a[1] * rstd * g0[1], a[2] * rstd * g0[2], a[3] * rstd * g0[3]}, (f32x4*)(orow + 512 * j));
                    __builtin_nontemporal_store((f32x4){a[4] * rstd * g1[0], a[5] * rstd * g1[1], a[6] * rstd * g1[2], a[7] * rstd * g1[3]}, (f32x4*)(orow + 512 * j + 4)); } }
        }
    }
#undef IN
#undef SEAM
}

extern "C" void kernel_launch(void* const* d_in, const int* in_sizes, int n_in, void* d_out, int out_size, void* d_ws, size_t ws_size, hipStream_t stream) {
    static int grid = 0;
    if (grid == 0) {
        if (n_in != 25 || in_sizes[0] != T * D || out_size != T * D || ws_size < WS_END) { fprintf(stderr, "kernel_launch: unexpected shapes (n_in %d, in0 %d, out %d, ws %zu); nothing launched\n", n_in, n_in > 0 ? in_sizes[0] : -1, out_size, ws_size); grid = -1; return; }
        int dev = 0, cus = 0, per_cu = 0;
        if (hipGetDevice(&dev) != hipSuccess || hipDeviceGetAttribute(&cus, hipDeviceAttributeMultiprocessorCount, dev) != hipSuccess) { grid = -1; return; }
        if (hipFuncSetAttribute((const void*)fwd, hipFuncAttributeMaxDynamicSharedMemorySize, LDS_BYTES) != hipSuccess) { fprintf(stderr, "kernel_launch: hipFuncSetAttribute failed\n"); grid = -1; return; }
        if (hipOccupancyMaxActiveBlocksPerMultiprocessor(&per_cu, (const void*)fwd, NTHR, LDS_BYTES) != hipSuccess || per_cu < 1) fprintf(stderr, "kernel_launch: occupancy query reports %d\n", per_cu);
        (void)hipGetLastError();
        if (cus < 256) { fprintf(stderr, "kernel_launch: this kernel is built for a 256-CU MI355X (found %d CUs); nothing launched\n", cus); grid = -1; return; }
        grid = 256;
    }
    if (grid < 0) return;
    (void)hipMemsetAsync((char*)d_ws + WS_CTL, 0, CTL_ZERO_BYTES, stream);
    Args a{};
    for (int i = 0; i < 25; ++i) a.in[i] = (const float*)d_in[i];
    a.out = (float*)d_out; a.ws = (unsigned char*)d_ws;
    if (MK_N_LAUNCHES == 1) { a.ph_lo = 0; a.ph_hi = NPHASE; hipLaunchKernelGGL(fwd, dim3(grid), dim3(NTHR), LDS_BYTES, stream, a); }
    else for (int k = 0; k < NPHASE; ++k) { a.ph_lo = k; a.ph_hi = k + 1; hipLaunchKernelGGL(fwd, dim3(grid), dim3(NTHR), LDS_BYTES, stream, a); }
}
```
